# Optimizing an MI355X kernel written in HIP

```python
import jax, jax.numpy as jnp
from jax import lax
import numpy as np

D_MODEL = 2048
BATCH = 4
SEQ = 8192
DEPTH = 1

HEAD_DIM = 64
SWA_Q_HEADS = 16
SWA_KV_HEADS = 2
SWA_GROUP = SWA_Q_HEADS // SWA_KV_HEADS
WINDOW = 128
FOX_HEADS = 16
FOX_BLOCK = 128
D_FF = 4 * D_MODEL
ROPE_THETA = 10000.0
RMS_EPS = 1e-6

SWA_Q_W = SWA_Q_HEADS * HEAD_DIM
SWA_KV_W = SWA_KV_HEADS * HEAD_DIM
FOX_W = FOX_HEADS * HEAD_DIM
IN_WIDTHS = (SWA_Q_W, SWA_KV_W, SWA_KV_W, FOX_W, FOX_W, FOX_W, FOX_HEADS, D_MODEL, D_MODEL)
D_IN = sum(IN_WIDTHS)
IN_SPLITS = tuple(int(v) for v in np.cumsum(IN_WIDTHS)[:-1])

kernel_name = "hybrid_swa_sink_fox_gated_block"


def rmsnorm(x, gain):
    xf = x.astype(jnp.float32)
    out = xf * lax.rsqrt(jnp.mean(xf * xf, axis=-1, keepdims=True) + RMS_EPS) * gain.astype(jnp.float32)
    return out.astype(x.dtype)


def apply_rope(t, positions):
    inv_freq = ROPE_THETA ** (-jnp.arange(0, HEAD_DIM, 2, dtype=jnp.float32) / HEAD_DIM)
    ang = positions.astype(jnp.float32)[..., None] * inv_freq
    cos = jnp.cos(ang)[:, :, None, :]
    sin = jnp.sin(ang)[:, :, None, :]
    tf = t.astype(jnp.float32)
    t1, t2 = tf[..., : HEAD_DIM // 2], tf[..., HEAD_DIM // 2:]
    out = jnp.concatenate([t1 * cos - t2 * sin, t2 * cos + t1 * sin], axis=-1)
    return out.astype(t.dtype)


def sliding_window_gqa_sinks(q, k, v, sinks):
    B, S = q.shape[0], q.shape[1]
    nb = S // WINDOW
    scale = HEAD_DIM ** -0.5
    qb = q.reshape(B, nb, WINDOW, SWA_KV_HEADS, SWA_GROUP, HEAD_DIM)
    kb = k.reshape(B, nb, WINDOW, SWA_KV_HEADS, HEAD_DIM)
    vb = v.reshape(B, nb, WINDOW, SWA_KV_HEADS, HEAD_DIM)
    pad = ((0, 0), (1, 0), (0, 0), (0, 0), (0, 0))
    kk = jnp.concatenate([jnp.pad(kb, pad)[:, :-1], kb], axis=2)
    vv = jnp.concatenate([jnp.pad(vb, pad)[:, :-1], vb], axis=2)
    logits = jnp.einsum('bnqhgd,bnkhd->bnhgqk', qb, kk).astype(jnp.float32) * scale
    blk = jnp.arange(nb)[:, None, None]
    qi = jnp.arange(WINDOW)[None, :, None] + WINDOW
    kj = jnp.arange(2 * WINDOW)[None, None, :]
    diff = qi - kj
    allowed = (diff >= 0) & (diff < WINDOW) & (blk * WINDOW + kj - WINDOW >= 0)
    logits = jnp.where(allowed[None, :, None, None], logits, -jnp.inf)
    sink_col = jnp.broadcast_to(
        sinks.astype(jnp.float32).reshape(SWA_KV_HEADS, SWA_GROUP)[None, None, :, :, None, None],
        logits.shape[:-1] + (1,))
    probs = jax.nn.softmax(jnp.concatenate([logits, sink_col], axis=-1), axis=-1)[..., :-1]
    out = jnp.einsum('bnhgqk,bnkhd->bnqhgd', probs.astype(v.dtype), vv)
    return out.reshape(B, S, SWA_Q_HEADS * HEAD_DIM)


def forgetting_attention(q, k, v, log_f):
    B, S = q.shape[0], q.shape[1]
    nb = S // FOX_BLOCK
    scale = HEAD_DIM ** -0.5
    qh = jnp.transpose(q, (0, 2, 1, 3))
    kh = jnp.transpose(k, (0, 2, 1, 3))
    vh = jnp.transpose(v, (0, 2, 1, 3))
    c = jnp.cumsum(jnp.transpose(log_f, (0, 2, 1)), axis=-1)
    key_pos = jnp.arange(S)

    def block(i):
        start = i * FOX_BLOCK
        qi = lax.dynamic_slice_in_dim(qh, start, FOX_BLOCK, axis=2)
        ci = lax.dynamic_slice_in_dim(c, start, FOX_BLOCK, axis=2)
        logits = jnp.einsum('bhqd,bhkd->bhqk', qi, kh).astype(jnp.float32) * scale
        logits = logits + (ci[..., :, None] - c[..., None, :])
        qpos = start + jnp.arange(FOX_BLOCK)
        causal = key_pos[None, :] <= qpos[:, None]
        logits = jnp.where(causal[None, None], logits, -jnp.inf)
        probs = jax.nn.softmax(logits, axis=-1)
        return jnp.einsum('bhqk,bhkd->bhqd', probs.astype(vh.dtype), vh)

    out = lax.map(block, jnp.arange(nb))
    out = jnp.transpose(out, (1, 0, 3, 2, 4))
    return out.reshape(B, S, FOX_HEADS * HEAD_DIM)


def setup_inputs(seed: int = 0) -> dict:
    key = jax.random.key(seed)
    ks = jax.random.split(key, 14)
    f32 = jnp.float32
    x = jax.random.normal(ks[0], (BATCH, SEQ, D_MODEL), f32)
    positions = jnp.broadcast_to(jnp.arange(SEQ, dtype=jnp.int32)[None, :], (BATCH, SEQ))
    attn_norm = 1.0 + 0.05 * jax.random.normal(ks[1], (DEPTH, D_MODEL), f32)
    w_in = jax.random.normal(ks[2], (DEPTH, D_MODEL, D_IN), f32) * D_MODEL ** -0.5
    fox_f_bias = jax.random.uniform(ks[3], (DEPTH, FOX_HEADS), f32, 1.0, 6.0)
    swa_sinks = 0.5 * jax.random.normal(ks[4], (DEPTH, SWA_Q_HEADS), f32)
    w_branch_swa = jax.random.normal(ks[5], (DEPTH, SWA_Q_W, D_MODEL), f32) * SWA_Q_W ** -0.5
    w_branch_fox = jax.random.normal(ks[6], (DEPTH, FOX_W, D_MODEL), f32) * FOX_W ** -0.5
    w_out = jax.random.normal(ks[7], (DEPTH, D_MODEL, D_MODEL), f32) * D_MODEL ** -0.5
    mlp_norm = 1.0 + 0.05 * jax.random.normal(ks[8], (DEPTH, D_MODEL), f32)
    w_up = jax.random.normal(ks[9], (DEPTH, D_MODEL, D_FF), f32) * D_MODEL ** -0.5
    w_down = jax.random.normal(ks[10], (DEPTH, D_FF, D_MODEL), f32) * D_FF ** -0.5
    final_norm = 1.0 + 0.05 * jax.random.normal(ks[11], (D_MODEL,), f32)
    return {"x": x, "positions": positions, "attn_norm": attn_norm, "w_in": w_in,
            "fox_f_bias": fox_f_bias, "swa_sinks": swa_sinks, "w_branch_swa": w_branch_swa,
            "w_branch_fox": w_branch_fox, "w_out": w_out, "mlp_norm": mlp_norm,
            "w_up": w_up, "w_down": w_down, "final_norm": final_norm}


def reference(x, positions, attn_norm, w_in, fox_f_bias, swa_sinks, w_branch_swa,
              w_branch_fox, w_out, mlp_norm, w_up, w_down, final_norm):
    B, S = x.shape[0], x.shape[1]
    for l in range(DEPTH):
        h = rmsnorm(x, attn_norm[l])
        proj = jnp.einsum('bsd,de->bse', h, w_in[l])
        (a_q, a_k, a_v, f_q, f_k, f_v, f_logit, g_a, g_b) = jnp.split(proj, IN_SPLITS, axis=-1)
        a_q = apply_rope(a_q.reshape(B, S, SWA_Q_HEADS, HEAD_DIM), positions)
        a_k = apply_rope(a_k.reshape(B, S, SWA_KV_HEADS, HEAD_DIM), positions)
        a_v = a_v.reshape(B, S, SWA_KV_HEADS, HEAD_DIM)
        o_a = sliding_window_gqa_sinks(a_q, a_k, a_v, swa_sinks[l])
        log_f = jax.nn.log_sigmoid(f_logit.astype(jnp.float32) + fox_f_bias[l].astype(jnp.float32))
        o_b = forgetting_attention(f_q.reshape(B, S, FOX_HEADS, HEAD_DIM),
                                   f_k.reshape(B, S, FOX_HEADS, HEAD_DIM),
                                   f_v.reshape(B, S, FOX_HEADS, HEAD_DIM), log_f)
        merged = (jax.nn.sigmoid(g_a) * jnp.einsum('bse,ed->bsd', o_a, w_branch_swa[l])
                  + jax.nn.sigmoid(g_b) * jnp.einsum('bse,ed->bsd', o_b, w_branch_fox[l]))
        x = x + jnp.einsum('bsd,de->bse', merged, w_out[l])
        h = rmsnorm(x, mlp_norm[l])
        u = jax.nn.relu(jnp.einsum('bsd,df->bsf', h, w_up[l]))
        x = x + jnp.einsum('bsf,fd->bsd', u * u, w_down[l])
    return rmsnorm(x, final_norm)
```

```cpp
#include <hip/hip_runtime.h>
#include <hip/hip_cooperative_groups.h>
#include <cstdio>
#include <cstdint>
namespace cg = cooperative_groups;

constexpr int BATCH = 4, SEQ = 8192, DM = 2048, M = BATCH * SEQ, DFF = 8192, NIN = 8704  , DIN = 8464;
constexpr float RMS_EPS = 1e-6f;
constexpr float LOG2E = 1.4426950408889634f;
constexpr float C2 = 0.125f * 1.4426950408889634f;

constexpr size_t MiB = 1u << 20;
constexpr size_t WS_CTL = 0, CTL_ZERO_BYTES = 1 * MiB;
constexpr size_t WS_WIN = 1 * MiB, WS_WBS = 35 * MiB, WS_WBF = 39 * MiB, WS_WOUT = 43 * MiB, WS_WUP = 51 * MiB, WS_WDN = 83 * MiB;
constexpr size_t WS_CS = 115 * MiB;
constexpr size_t WS_FL = 123 * MiB, WS_C = 125 * MiB;
constexpr size_t WS_FK = 128 * MiB, WS_FV = 192 * MiB, WS_X1B = 128 * MiB;
constexpr size_t WS_XN = 256 * MiB, WS_MG = 256 * MiB;
constexpr size_t WS_AQ = 384 * MiB, WS_FQ = 448 * MiB, WS_G = 512 * MiB;
constexpr size_t WS_U = 256 * MiB;
constexpr size_t WS_AK = 768 * MiB, WS_AV = 776 * MiB, WS_END = 784 * MiB;

namespace pg8 {
#define PG8_LAS __attribute__((address_space(3)))
typedef unsigned short bf16_t;
typedef short bf16x8 __attribute__((ext_vector_type(8)));
typedef float f32x4 __attribute__((ext_vector_type(4)));
typedef unsigned u32x4 __attribute__((ext_vector_type(4)));
typedef unsigned u32x2 __attribute__((ext_vector_type(2)));
constexpr int BM = 256, BK = 64, HALF = 128, HTB = HALF * BK * 2  , STAGE_BYTES = 8 * HTB, NXCD = 8, WGM = 8;

__host__ __device__ __forceinline__ int lds_byte(int r, int c) { const int st = (r >> 4) * 2 + (c >> 5), rr = r & 15, cc = c & 31, ob = rr * 64 + cc * 2; return st * 1024 + (ob ^ (((ob >> 9) & 1) << 5)); }
__host__ __device__ __forceinline__ void stage_rc(int b, int& R, int& C) { const int st = b / 1024, sb = b % 1024, swz = sb ^ (((sb >> 9) & 1) << 5); R = (st >> 1) * 16 + swz / 64; C = (st & 1) * 32 + (swz % 64) / 2; }
__host__ __device__ __forceinline__ int perm32(int rho) { const int n = rho >> 4, i = rho & 15; return 8 * (i >> 2) + 4 * n + (i & 3); }

struct Unit { int pm, pn, z; };
struct Gemm { const bf16_t* A0; const bf16_t* B0; const bf16_t* A1; const bf16_t* B1; int K; };

struct StaticOrder {
    int nM, nN, nwg, G, c;
    __host__ __device__ void init(int M_, int N_, int G_, int c_) { nM = M_ / BM; nN = N_ / BM; nwg = nM * nN; G = G_; c = c_; }
    __host__ __device__ bool next(int i, Unit& u) const {
        const long L = (long)i * G + c; if (L >= nwg) return false;
        int wgid = (int)L; { const int q = nwg / NXCD, r = nwg % NXCD, xcd = wgid % NXCD, off = wgid / NXCD; wgid = (xcd < r ? xcd * (q + 1) : r * (q + 1) + (xcd - r) * q) + off; }
        const int nig = WGM * nN, gid = wgid / nig, fm = gid * WGM, gsz = (nM - fm) < WGM ? (nM - fm) : WGM;
        u.pm = fm + ((wgid % nig) % gsz); u.pn = (wgid % nig) / gsz; u.z = 0; return true;
    }
};
struct PairOrder {
    StaticOrder s;
    __host__ __device__ bool next(int i, Unit& u) const { const bool ok = s.next(i >> 1, u); u.z = i & 1; return ok; }
};

__device__ __forceinline__ unsigned cvt_pk_bf16(float lo, float hi) { unsigned r; asm("v_cvt_pk_bf16_f32 %0, %1, %2" : "=v"(r) : "v"(lo), "v"(hi)); return r; }
__device__ __forceinline__ float bf_lo(unsigned w) { return __uint_as_float(w << 16); }
__device__ __forceinline__ float bf_hi(unsigned w) { return __uint_as_float(w & 0xffff0000u); }
__device__ __forceinline__ float sigmoidf_(float x) { return __builtin_amdgcn_rcpf(1.0f + __builtin_amdgcn_exp2f(-x * LOG2E)); }


struct EpiIn {
    static constexpr bool PERM = true;
    unsigned char* ws;
    __device__ __forceinline__ bool keep(const Unit&) const { return false; }
    __device__ __forceinline__ void operator()(f32x4 (&acc)[2][2][4][2], const Unit& u, int wr, int wc, int fr, int fq) const {
        const int pn = u.pn; const int row0 = u.pm * BM + wr * 64 + fr;
        if (pn <= 16) {
            size_t doff; int pitch, colbase; bool rope = false; float sc = 1.f;
            if (pn < 4) { doff = WS_AQ; pitch = 1024; colbase = (4 * pn + wc) * 64; rope = true; sc = C2; }
            else if (pn == 4) { if (wc < 2) { doff = WS_AK; pitch = 128; colbase = wc * 64; rope = true; } else { doff = WS_AV; pitch = 128; colbase = (wc - 2) * 64; } }
            else { const int t = pn - 5, seg = t >> 2, tin = t & 3; doff = WS_FQ; if (seg == 1) doff = WS_FK; if (seg == 2) doff = WS_FV; pitch = 1024; colbase = (4 * tin + wc) * 64; sc = seg == 0 ? C2 : 1.f; }
            bf16_t* dst = (bf16_t*)(ws + doff); const float* cs = (const float*)(ws + WS_CS);
#pragma unroll
            for (int ai = 0; ai < 2; ++ai)
#pragma unroll
                for (int m = 0; m < 4; ++m) {
                    const int row = row0 + ai * HALF + m * 16;
                    f32x4 v00 = acc[ai][0][m][0], v01 = acc[ai][0][m][1], v10 = acc[ai][1][m][0], v11 = acc[ai][1][m][1];
                    if (rope) {
                        const float* cp = cs + (size_t)row * 32 + 8 * fq; const float* sp = cp + (size_t)M * 32;
                        const f32x4 c0 = *(const f32x4*)cp, c1 = *(const f32x4*)(cp + 4), s0 = *(const f32x4*)sp, s1 = *(const f32x4*)(sp + 4);
                        const f32x4 o00 = v00 * c0 - v10 * s0, o10 = v10 * c0 + v00 * s0, o01 = v01 * c1 - v11 * s1, o11 = v11 * c1 + v01 * s1;
                        v00 = o00; v10 = o10; v01 = o01; v11 = o11;
                    }
                    v00 = v00 * sc; v01 = v01 * sc; v10 = v10 * sc; v11 = v11 * sc;
                    bf16_t* rp = dst + (size_t)row * pitch + colbase + 8 * fq;
                    u32x4 w0, w1;
                    w0.x = cvt_pk_bf16(v00[0], v00[1]); w0.y = cvt_pk_bf16(v00[2], v00[3]); w0.z = cvt_pk_bf16(v01[0], v01[1]); w0.w = cvt_pk_bf16(v01[2], v01[3]);
                    w1.x = cvt_pk_bf16(v10[0], v10[1]); w1.y = cvt_pk_bf16(v10[2], v10[3]); w1.z = cvt_pk_bf16(v11[0], v11[1]); w1.w = cvt_pk_bf16(v11[2], v11[3]);
                    *(u32x4*)rp = w0; *(u32x4*)(rp + 32) = w1;
                }
        } else if (pn <= 32) {
            const int col0 = (pn - 17) * BM + wc * 32 + 8 * fq;
#pragma unroll
            for (int ai = 0; ai < 2; ++ai)
#pragma unroll
                for (int m = 0; m < 4; ++m) {
                    bf16_t* rp = (bf16_t*)(ws + WS_G) + (size_t)(row0 + ai * HALF + m * 16) * 4096 + col0;
#pragma unroll
                    for (int bj = 0; bj < 2; ++bj) {
                        const f32x4 a = acc[ai][bj][m][0], b = acc[ai][bj][m][1]; u32x4 w;
                        float s[8];
#pragma unroll
                        for (int i = 0; i < 4; ++i) { s[i] = fmaxf(sigmoidf_(a[i]), 1e-30f); s[4 + i] = fmaxf(sigmoidf_(b[i]), 1e-30f); }
                        w.x = cvt_pk_bf16(s[0], s[1]); w.y = cvt_pk_bf16(s[2], s[3]); w.z = cvt_pk_bf16(s[4], s[5]); w.w = cvt_pk_bf16(s[6], s[7]);
                        *(u32x4*)(rp + bj * HALF) = w;
                    }
                }
        } else {
            if (wc == 0 && fq < 2) {
#pragma unroll
                for (int ai = 0; ai < 2; ++ai)
#pragma unroll
                    for (int m = 0; m < 4; ++m) {
                        float* rp = (float*)(ws + WS_FL) + (size_t)(row0 + ai * HALF + m * 16) * 16 + 8 * fq;
                        *(f32x4*)rp = acc[ai][0][m][0]; *(f32x4*)(rp + 4) = acc[ai][0][m][1];
                    }
            }
        }
    }
};

struct EpiBranch {
    static constexpr bool PERM = true;
    const bf16_t* G; bf16_t* MG;
    __device__ __forceinline__ bool keep(const Unit& u) const { return u.z == 0; }
    __device__ __forceinline__ void operator()(f32x4 (&acc)[2][2][4][2], const Unit& u, int wr, int wc, int fr, int fq) const {
        const int row0 = u.pm * BM + wr * 64 + fr, col0 = u.pn * BM + wc * 32 + 8 * fq; const int z = u.z;
#pragma unroll
        for (int ai = 0; ai < 2; ++ai)
#pragma unroll
            for (int m = 0; m < 4; ++m) {
                const size_t row = (size_t)(row0 + ai * HALF + m * 16);
#pragma unroll
                for (int bj = 0; bj < 2; ++bj) {
                    const bf16_t* gp = G + row * 4096 + col0 + bj * HALF;
                    const u32x4 gb = *(const u32x4*)(gp + 2048);
                    float sb[8];
#pragma unroll
                    for (int i = 0; i < 4; ++i) { sb[2 * i] = bf_lo(gb[i]); sb[2 * i + 1] = bf_hi(gb[i]); }
                    if (z == 0) {
                        const u32x4 ga = *(const u32x4*)gp;
#pragma unroll
                        for (int i = 0; i < 4; ++i) {
                            const float r0 = bf_lo(ga[i]) * __builtin_amdgcn_rcpf(sb[2 * i]), r1 = bf_hi(ga[i]) * __builtin_amdgcn_rcpf(sb[2 * i + 1]);
                            const int e0 = 2 * i, e1 = 2 * i + 1;
                            acc[ai][bj][m][e0 >> 2][e0 & 3] *= r0; acc[ai][bj][m][e1 >> 2][e1 & 3] *= r1;
                        }
                    } else {
                        const f32x4 a = acc[ai][bj][m][0], b = acc[ai][bj][m][1]; u32x4 w;
                        w.x = cvt_pk_bf16(a[0] * sb[0], a[1] * sb[1]); w.y = cvt_pk_bf16(a[2] * sb[2], a[3] * sb[3]);
                        w.z = cvt_pk_bf16(b[0] * sb[4], b[1] * sb[5]); w.w = cvt_pk_bf16(b[2] * sb[6], b[3] * sb[7]);
                        *(u32x4*)(MG + row * 2048 + col0 + bj * HALF) = w;
                    }
                }
            }
    }
};

template <bool WRITE_BF> struct EpiRes {
    static constexpr bool PERM = false;
    const float* base; float* out; bf16_t* xb; float* ss;
    __device__ __forceinline__ bool keep(const Unit&) const { return false; }
    __device__ __forceinline__ void operator()(f32x4 (&acc)[2][2][4][2], const Unit& u, int wr, int wc, int fr, int fq) const {
        const int row0 = u.pm * BM + wr * 64 + fr, col0 = u.pn * BM + wc * 32 + 4 * fq;
#pragma unroll
        for (int ai = 0; ai < 2; ++ai)
#pragma unroll
            for (int m = 0; m < 4; ++m) {
                const size_t row = (size_t)(row0 + ai * HALF + m * 16); const size_t off = row * DM + col0; float q = 0.f;
#pragma unroll
                for (int bj = 0; bj < 2; ++bj)
#pragma unroll
                    for (int n = 0; n < 2; ++n) {
                        const size_t o = off + bj * HALF + n * 16;
                        const f32x4 v = *(const f32x4*)(base + o) + acc[ai][bj][m][n];
                        *(f32x4*)(out + o) = v; q += (v[0] * v[0] + v[1] * v[1]) + (v[2] * v[2] + v[3] * v[3]);
                        if (WRITE_BF) { u32x2 w; w.x = cvt_pk_bf16(v[0], v[1]); w.y = cvt_pk_bf16(v[2], v[3]); *(u32x2*)(xb + o) = w; }
                    }
                q += __shfl_xor(q, 16); q += __shfl_xor(q, 32);
                if (fq == 0) atomicAdd(ss + row, q);
            }
    }
};

struct EpiUp {
    static constexpr bool PERM = true;
    const float* ss; bf16_t* U;
    __device__ __forceinline__ bool keep(const Unit&) const { return false; }
    __device__ __forceinline__ void operator()(f32x4 (&acc)[2][2][4][2], const Unit& u, int wr, int wc, int fr, int fq) const {
        const int row0 = u.pm * BM + wr * 64 + fr, col0 = u.pn * BM + wc * 32 + 8 * fq;
#pragma unroll
        for (int ai = 0; ai < 2; ++ai)
#pragma unroll
            for (int m = 0; m < 4; ++m) {
                const size_t row = (size_t)(row0 + ai * HALF + m * 16);
                const float rstd = __builtin_amdgcn_rsqf(ss[row] * (1.0f / DM) + RMS_EPS);
#pragma unroll
                for (int bj = 0; bj < 2; ++bj) {
                    f32x4 a = acc[ai][bj][m][0] * rstd, b = acc[ai][bj][m][1] * rstd; u32x4 w;
#pragma unroll
                    for (int i = 0; i < 4; ++i) { a[i] = fmaxf(a[i], 0.f); a[i] *= a[i]; b[i] = fmaxf(b[i], 0.f); b[i] *= b[i]; }
                    w.x = cvt_pk_bf16(a[0], a[1]); w.y = cvt_pk_bf16(a[2], a[3]); w.z = cvt_pk_bf16(b[0], b[1]); w.w = cvt_pk_bf16(b[2], b[3]);
                    *(u32x4*)(U + row * DFF + col0 + bj * HALF) = w;
                }
            }
    }
};

template <class Epi, class Sched, bool ALIGN_EPI = false, bool SP2 = false>
__device__ __forceinline__ void gemm_phase(PG8_LAS unsigned char* lds, const Gemm g, const Sched& S, const Epi& E) {
    const int tid = threadIdx.x, wid = __builtin_amdgcn_readfirstlane(tid >> 6), lane = tid & 63, wr = wid >> 2, wc = wid & 3, fr = lane & 15, fq = lane >> 4;
    const int K = g.K, nt = K / BK;
    unsigned voffA[2], voffB[2];
#pragma unroll
    for (int i = 0; i < 2; ++i) { int R, C; stage_rc(tid * 16 + i * 8192, R, C); const int Rb = Epi::PERM ? ((R & ~31) + perm32(R & 31)) : R;
        voffA[i] = (unsigned)(R * K + C) * 2u; voffB[i] = (unsigned)(Rb * K + C) * 2u; }
    const size_t kstep = (size_t)(BK * 2);
    const size_t hstep = (size_t)HALF * K * 2;
    const size_t tstep = 2 * hstep;
    const unsigned ldsw = (unsigned)wid * 1024u;
    const int aoff = lds_byte(wr * 64 + fr, fq * 8), boff = lds_byte(wc * 32 + fr, fq * 8);
#define PG8_SA(b, h) (((b) * 2 + (h)) * HTB)
#define PG8_SB(b, h) ((4 + (b) * 2 + (h)) * HTB)
#define PG8_STAGE(bufoff, gbase, voff) do { _Pragma("unroll") for (int _i = 0; _i < 2; ++_i) \
        __builtin_amdgcn_global_load_lds((const unsigned*)((const char*)(gbase) + (voff)[_i]), (PG8_LAS unsigned*)(lds + (bufoff) + ldsw + _i * 8192), 16, 0, 0); } while (0)
#define PG8_LDA(dst, b, h) do { _Pragma("unroll") for (int m = 0; m < 4; ++m) _Pragma("unroll") for (int k = 0; k < 2; ++k) dst[m][k] = *(const PG8_LAS bf16x8*)(lds + PG8_SA(b, h) + aoff + m * 2048 + k * 1024); } while (0)
#define PG8_LDB(dst, b, h) do { _Pragma("unroll") for (int n = 0; n < 2; ++n) _Pragma("unroll") for (int k = 0; k < 2; ++k) dst[n][k] = *(const PG8_LAS bf16x8*)(lds + PG8_SB(b, h) + boff + n * 2048 + k * 1024); } while (0)
#define PG8_MMA(ai, bj, At, Bt) do { __builtin_amdgcn_s_setprio(1); _Pragma("unroll") for (int m = 0; m < 4; ++m) _Pragma("unroll") for (int n = 0; n < 2; ++n) _Pragma("unroll") for (int k = 0; k < 2; ++k) \
        acc[ai][bj][m][n] = __builtin_amdgcn_mfma_f32_16x16x32_bf16(Bt[n][k], At[m][k], acc[ai][bj][m][n], 0, 0, 0); __builtin_amdgcn_s_setprio(0); } while (0)
#define PG8_WAIT_V(n) asm volatile("s_waitcnt vmcnt(" #n ")" ::: "memory")
#define PG8_WAIT_L(n) asm volatile("s_waitcnt lgkmcnt(" #n ")" ::: "memory")
#define PG8_BAR __builtin_amdgcn_s_barrier()
#define PG8_SCHED __builtin_amdgcn_sched_barrier(0)
    Unit cur, nxt; int ui = 0;
    if (!S.next(0, cur)) return;
    f32x4 acc[2][2][4][2];
#pragma unroll
    for (int a = 0; a < 2; ++a)
#pragma unroll
        for (int b = 0; b < 2; ++b)
#pragma unroll
            for (int m = 0; m < 4; ++m)
#pragma unroll
                for (int n = 0; n < 2; ++n) acc[a][b][m][n] = (f32x4){0.f, 0.f, 0.f, 0.f};
    bf16x8 At[4][2], B0[2][2], B1[2][2];
    const char* cA = (const char*)(cur.z ? g.A1 : g.A0) + (size_t)cur.pm * tstep; const char* cB = (const char*)(cur.z ? g.B1 : g.B0) + (size_t)cur.pn * tstep;
    if constexpr (SP2) {
        PG8_STAGE(PG8_SB(0, 0), cB, voffB); PG8_STAGE(PG8_SB(0, 1), cB + hstep, voffB); PG8_STAGE(PG8_SA(0, 0), cA, voffA); PG8_STAGE(PG8_SA(0, 1), cA + hstep, voffA);
        if (wr == 1) PG8_BAR;
        PG8_WAIT_V(2); PG8_BAR;
        PG8_STAGE(PG8_SB(1, 0), cB + kstep, voffB); PG8_STAGE(PG8_SA(1, 0), cA + kstep, voffA); PG8_STAGE(PG8_SB(1, 1), cB + hstep + kstep, voffB);
        PG8_WAIT_V(6); PG8_BAR;
    } else {
        PG8_STAGE(PG8_SB(0, 0), cB, voffB); PG8_STAGE(PG8_SA(0, 0), cA, voffA); PG8_STAGE(PG8_SB(0, 1), cB + hstep, voffB); PG8_STAGE(PG8_SA(0, 1), cA + hstep, voffA);
        if (wr == 1) PG8_BAR;
        PG8_WAIT_V(4); PG8_BAR;
        PG8_STAGE(PG8_SB(1, 0), cB + kstep, voffB); PG8_STAGE(PG8_SA(1, 0), cA + kstep, voffA); PG8_STAGE(PG8_SB(1, 1), cB + hstep + kstep, voffB);
        PG8_WAIT_V(6); PG8_BAR;
    }
    for (;;) {
        const bool has_next = S.next(ui + 1, nxt);
        const char* nA = has_next ? (const char*)(nxt.z ? g.A1 : g.A0) + (size_t)nxt.pm * tstep : cA; const char* nB = has_next ? (const char*)(nxt.z ? g.B1 : g.B0) + (size_t)nxt.pn * tstep : cB;
        for (int t = 0; t < nt; t += 2) {
            const bool last = (t == nt - 2);
            const char* a1 = cA + (size_t)(t + 1) * kstep;
            const char* a2 = last ? nA : cA + (size_t)(t + 2) * kstep; const char* b2 = last ? nB : cB + (size_t)(t + 2) * kstep;
            const char* a3 = a2 + kstep; const char* b3 = b2 + kstep;
            if constexpr (SP2) {
            PG8_LDB(B0, 0, 0); PG8_LDB(B1, 0, 1); PG8_SCHED; PG8_LDA(At, 0, 0); PG8_STAGE(PG8_SA(1, 1), a1 + hstep, voffA);
            PG8_WAIT_V(8); PG8_WAIT_L(0); PG8_BAR; PG8_MMA(0, 0, At, B0); PG8_MMA(0, 1, At, B1); PG8_BAR; PG8_SCHED;
            PG8_LDA(At, 0, 1); PG8_STAGE(PG8_SB(0, 0), b2, voffB); PG8_STAGE(PG8_SB(0, 1), b2 + hstep, voffB); PG8_STAGE(PG8_SA(0, 0), a2, voffA);
            PG8_WAIT_V(8); PG8_WAIT_L(0); PG8_BAR; PG8_MMA(1, 0, At, B0); PG8_MMA(1, 1, At, B1); PG8_BAR; PG8_SCHED;
            PG8_LDB(B0, 1, 0); PG8_LDB(B1, 1, 1); PG8_SCHED; PG8_LDA(At, 1, 0); PG8_STAGE(PG8_SA(0, 1), a2 + hstep, voffA);
            PG8_WAIT_V(8); PG8_WAIT_L(0); PG8_BAR; PG8_MMA(0, 0, At, B0); PG8_MMA(0, 1, At, B1); PG8_BAR; PG8_SCHED;
            PG8_LDA(At, 1, 1); PG8_STAGE(PG8_SB(1, 0), b3, voffB); PG8_STAGE(PG8_SB(1, 1), b3 + hstep, voffB); PG8_STAGE(PG8_SA(1, 0), a3, voffA);
            PG8_WAIT_V(8); PG8_WAIT_L(0); PG8_BAR; PG8_MMA(1, 0, At, B0); PG8_MMA(1, 1, At, B1); PG8_BAR; PG8_SCHED;
            } else {
            PG8_LDB(B0, 0, 0); PG8_SCHED; PG8_LDA(At, 0, 0); PG8_STAGE(PG8_SA(1, 1), a1 + hstep, voffA);
            PG8_WAIT_L(8); PG8_BAR; PG8_WAIT_L(0); PG8_MMA(0, 0, At, B0); PG8_BAR; PG8_SCHED;
            PG8_LDB(B1, 0, 1); PG8_STAGE(PG8_SB(0, 0), b2, voffB);
            PG8_BAR; PG8_WAIT_L(0); PG8_MMA(0, 1, At, B1); PG8_BAR;
            PG8_LDA(At, 0, 1); PG8_STAGE(PG8_SA(0, 0), a2, voffA);
            PG8_BAR; PG8_WAIT_L(0); PG8_MMA(1, 0, At, B0); PG8_BAR; PG8_SCHED;
            PG8_STAGE(PG8_SB(0, 1), b2 + hstep, voffB);
            PG8_WAIT_V(6); PG8_BAR; PG8_MMA(1, 1, At, B1); PG8_BAR;
            PG8_LDB(B0, 1, 0); PG8_SCHED; PG8_LDA(At, 1, 0); PG8_STAGE(PG8_SA(0, 1), a2 + hstep, voffA);
            PG8_WAIT_L(8); PG8_BAR; PG8_WAIT_L(0); PG8_MMA(0, 0, At, B0); PG8_BAR; PG8_SCHED;
            PG8_LDB(B1, 1, 1); PG8_STAGE(PG8_SB(1, 0), b3, voffB);
            PG8_BAR; PG8_WAIT_L(0); PG8_MMA(0, 1, At, B1); PG8_BAR;
            PG8_LDA(At, 1, 1); PG8_STAGE(PG8_SA(1, 0), a3, voffA);
            PG8_BAR; PG8_WAIT_L(0); PG8_MMA(1, 0, At, B0); PG8_BAR; PG8_SCHED;
            PG8_STAGE(PG8_SB(1, 1), b3 + hstep, voffB);
            PG8_WAIT_V(6); PG8_BAR; PG8_MMA(1, 1, At, B1); PG8_BAR;
            }
        }
        if constexpr (ALIGN_EPI) { if (wr == 0) PG8_BAR; }
        E(acc, cur, wr, wc, fr, fq);
        if (!has_next) break;
        if (!E.keep(cur))
#pragma unroll
        for (int a = 0; a < 2; ++a)
#pragma unroll
            for (int b = 0; b < 2; ++b)
#pragma unroll
                for (int m = 0; m < 4; ++m)
#pragma unroll
                    for (int n = 0; n < 2; ++n) acc[a][b][m][n] = (f32x4){0.f, 0.f, 0.f, 0.f};
        cur = nxt; cA = nA; cB = nB; ++ui;
        if constexpr (ALIGN_EPI) { if (wr == 1) PG8_BAR; }
    }
    PG8_WAIT_V(0);
    if constexpr (!ALIGN_EPI) { if (wr == 0) PG8_BAR; }
    PG8_BAR;
#undef PG8_SA
#undef PG8_SB
#undef PG8_STAGE
#undef PG8_LDA
#undef PG8_LDB
#undef PG8_MMA
#undef PG8_WAIT_V
#undef PG8_WAIT_L
#undef PG8_BAR
#undef PG8_SCHED
}
}


#define LAS __attribute__((address_space(3)))
typedef unsigned short bf16;
typedef float f32x4 __attribute__((ext_vector_type(4)));
typedef unsigned v4u __attribute__((ext_vector_type(4)));
typedef unsigned v2u __attribute__((ext_vector_type(2)));
constexpr int NWAVES = 8;
constexpr int RING_BYTES = 131072, LDS_BYTES = 147456;

__device__ __forceinline__ float wave_sum(float v) {
#pragma unroll
    for (int o = 1; o < 64; o <<= 1) v += __shfl_xor(v, o);
    return v;
}
#define LDS_WAIT() asm volatile("s_waitcnt lgkmcnt(0)" ::: "memory")

__device__ __forceinline__ void tr_item(const float* W, int K, int N, bf16* WT, int dst_row0, int src_col0, int nvalid, int kb, const float* kscale, LAS float* scr, int lane) {
    const int k0 = 64 * kb, c = lane & 31;
#pragma unroll 8
    for (int i = 0; i < 32; ++i) { const int kk = 2 * i + (lane >> 5); float v = 0.f; if (c < nvalid) v = W[(size_t)(k0 + kk) * N + src_col0 + c]; if (kscale) v *= kscale[k0 + kk]; scr[kk * 33 + c] = v; }
    LDS_WAIT(); asm volatile("" ::: "memory");
    const int ch = lane & 7;
#pragma unroll
    for (int j = 0; j < 4; ++j) { const int n = (lane >> 3) + 8 * j; const LAS float* s = scr + (8 * ch) * 33 + n;
        v4u o; o.x = pg8::cvt_pk_bf16(s[0 * 33], s[1 * 33]); o.y = pg8::cvt_pk_bf16(s[2 * 33], s[3 * 33]); o.z = pg8::cvt_pk_bf16(s[4 * 33], s[5 * 33]); o.w = pg8::cvt_pk_bf16(s[6 * 33], s[7 * 33]);
        *(v4u*)(WT + (size_t)(dst_row0 + n) * K + k0 + 8 * ch) = o; }
    LDS_WAIT(); asm volatile("" ::: "memory");
}
__device__ __forceinline__ void win_map(int db, int& src, int& nv) {
    const int pn = db >> 3, bj = (db >> 2) & 1, wc = db & 3; nv = 32;
    if (pn < 4) src = (4 * pn + wc) * 64 + 32 * bj;
    else if (pn == 4) src = (wc < 2 ? 1024 + wc * 64 : 1152 + (wc - 2) * 64) + 32 * bj;
    else if (pn < 17) { const int t = pn - 5; src = 1280 + (t >> 2) * 1024 + (4 * (t & 3) + wc) * 64 + 32 * bj; }
    else if (pn < 33) src = 4368 + (db - 136) * 32;
    else { src = 4352; nv = (db == 264) ? 16 : 0; }
}

struct Args { const float* x; const int* pos; const float* attn_norm; const float* w_in; const float* fbias; const float* sinks; const float* w_bs; const float* w_bf;
              const float* w_out; const float* mlp_norm; const float* w_up; const float* w_dn; const float* final_norm; float* out; unsigned char* ws; };

__device__ __forceinline__ void rms_row_to_bf16(const float* xrow, const float* gain, bf16* orow, int lane) {
    const f32x4* xr = (const f32x4*)xrow + lane; f32x4 v[8]; float s = 0.f;
#pragma unroll
    for (int j = 0; j < 8; ++j) { v[j] = xr[64 * j]; s += (v[j].x * v[j].x + v[j].y * v[j].y) + (v[j].z * v[j].z + v[j].w * v[j].w); }
    const float rstd = __builtin_amdgcn_rsqf(wave_sum(s) * (1.f / DM) + RMS_EPS);
    const f32x4* gr = (const f32x4*)gain + lane; v2u* o8 = (v2u*)orow + lane;
#pragma unroll
    for (int j = 0; j < 8; ++j) { const f32x4 g = gr[64 * j]; v2u w; w.x = pg8::cvt_pk_bf16(v[j].x * rstd * g.x, v[j].y * rstd * g.y); w.y = pg8::cvt_pk_bf16(v[j].z * rstd * g.z, v[j].w * rstd * g.w); o8[64 * j] = w; }
}

__device__ __forceinline__ void p0_prologue(const Args& a, LAS unsigned char* lds, int vcu, int G, int wave, int lane) {
    unsigned char* ws = a.ws;
    LAS float* scr = (LAS float*)(lds + wave * 16384);
    const int gw = vcu * NWAVES + wave, NGW = G * NWAVES;
    constexpr int I_IN = (NIN / 32) * (DM / 64), I_BS = (DM / 32) * (1024 / 64), I_OUT = (DM / 32) * (DM / 64), I_UP = (DFF / 32) * (DM / 64), I_DN = (DM / 32) * (DFF / 64);
    constexpr int NITEMS = I_IN + 2 * I_BS + I_OUT + I_UP + I_DN;
    for (int it = gw; it < NITEMS; it += NGW) {
        int r = it;
        if (r < I_IN) { const int db = r / (DM / 64), kb = r % (DM / 64); int src, nv; win_map(db, src, nv); tr_item(a.w_in, DM, DIN, (bf16*)(ws + WS_WIN), db * 32, src, nv, kb, nullptr, scr, lane); continue; } r -= I_IN;
        if (r < I_BS) { const int db = r / 16, kb = r % 16; tr_item(a.w_bs, 1024, DM, (bf16*)(ws + WS_WBS), db * 32, db * 32, 32, kb, nullptr, scr, lane); continue; } r -= I_BS;
        if (r < I_BS) { const int db = r / 16, kb = r % 16; tr_item(a.w_bf, 1024, DM, (bf16*)(ws + WS_WBF), db * 32, db * 32, 32, kb, nullptr, scr, lane); continue; } r -= I_BS;
        if (r < I_OUT) { const int db = r / 32, kb = r % 32; tr_item(a.w_out, DM, DM, (bf16*)(ws + WS_WOUT), db * 32, db * 32, 32, kb, nullptr, scr, lane); continue; } r -= I_OUT;
        if (r < I_UP) { const int db = r / 32, kb = r % 32; tr_item(a.w_up, DM, DFF, (bf16*)(ws + WS_WUP), db * 32, db * 32, 32, kb, a.mlp_norm, scr, lane); continue; } r -= I_UP;
        { const int db = r / 128, kb = r % 128; tr_item(a.w_dn, DFF, DM, (bf16*)(ws + WS_WDN), db * 32, db * 32, 32, kb, nullptr, scr, lane); }
    }
    for (int m = gw; m < M; m += NGW) rms_row_to_bf16(a.x + (size_t)m * DM, a.attn_norm, (bf16*)(ws + WS_XN) + (size_t)m * DM, lane);
    float* cs = (float*)(ws + WS_CS);
    for (int e = gw * 64 + lane; e < M * 32; e += NGW * 64) {
        const int tok = e >> 5, i = e & 31;
        const float inv_freq = powf(10000.0f, -(float)(2 * i) / 64.0f);
        const float ang = (float)a.pos[tok] * inv_freq;
        double rev = (double)ang * 0.15915494309189535; rev -= floor(rev);
        const float rf = (float)rev;
        cs[e] = __builtin_amdgcn_cosf(rf); cs[(size_t)M * 32 + e] = __builtin_amdgcn_sinf(rf);
    }
}

__device__ __forceinline__ void cumsum_unit(const Args& a, int bh, LAS unsigned char* lds) {
    const float* FL = (const float*)(a.ws + WS_FL); float* Cp = (float*)(a.ws + WS_C);
    LAS double* sh = (LAS double*)lds;
    const int b = bh >> 4, h = bh & 15, tid = threadIdx.x, s0 = tid * 16; const float fb = a.fbias[h];
    float ls[16]; double run = 0.0;
#pragma unroll
    for (int i = 0; i < 16; ++i) { const float z = FL[(size_t)(b * SEQ + s0 + i) * 16 + h] + fb; const float v = fminf(z, 0.f) - log1pf(expf(-fabsf(z))); ls[i] = v; run += (double)v; }
    sh[tid] = run; __syncthreads();
    double pre = 0.0; for (int k = 0; k < tid; ++k) pre += sh[k];
#pragma unroll
    for (int i = 0; i < 16; ++i) { pre += (double)ls[i]; Cp[(size_t)bh * SEQ + s0 + i] = (float)(pre * 1.4426950408889634); }
    __syncthreads();
}

__device__ __forceinline__ void naive_swa_unit(const Args& a, int unit) {
    const bf16* AQ = (const bf16*)(a.ws + WS_AQ); const bf16* AK = (const bf16*)(a.ws + WS_AK); const bf16* AV = (const bf16*)(a.ws + WS_AV); bf16* OA = (bf16*)(a.ws + WS_AQ);
    const int tid = threadIdx.x, head = tid & 15, tok = unit * 32 + (tid >> 4), b = tok / SEQ, s = tok % SEQ, kvh = head >> 3;
    float q[64], o[64]; float m = -INFINITY, l = 0.f;
    { const v4u* qp = (const v4u*)(AQ + (size_t)tok * 1024 + head * 64);
#pragma unroll
      for (int c = 0; c < 8; ++c) { const v4u w = qp[c];
#pragma unroll
          for (int e = 0; e < 4; ++e) { q[8 * c + 2 * e] = pg8::bf_lo(w[e]); q[8 * c + 2 * e + 1] = pg8::bf_hi(w[e]); } } }
#pragma unroll
    for (int d = 0; d < 64; ++d) o[d] = 0.f;
    for (int i = 0; i < 128; ++i) {
        const int j = s - i; const bool valid = j >= 0; const int jj = valid ? j : 0;
        const v4u* kp = (const v4u*)(AK + (size_t)(b * SEQ + jj) * 128 + kvh * 64); const v4u* vp = (const v4u*)(AV + (size_t)(b * SEQ + jj) * 128 + kvh * 64);
        float dot = 0.f;
#pragma unroll
        for (int c = 0; c < 8; ++c) { const v4u w = kp[c];
#pragma unroll
            for (int e = 0; e < 4; ++e) { dot += q[8 * c + 2 * e] * pg8::bf_lo(w[e]); dot += q[8 * c + 2 * e + 1] * pg8::bf_hi(w[e]); } }
        const float lg = valid ? dot : -INFINITY;
        const float mn = fmaxf(m, lg), al = __builtin_amdgcn_exp2f(m - mn), p = __builtin_amdgcn_exp2f(lg - mn);
        l = l * al + p; m = mn;
#pragma unroll
        for (int c = 0; c < 8; ++c) { const v4u w = vp[c];
#pragma unroll
            for (int e = 0; e < 4; ++e) { o[8 * c + 2 * e] = o[8 * c + 2 * e] * al + p * pg8::bf_lo(w[e]); o[8 * c + 2 * e + 1] = o[8 * c + 2 * e + 1] * al + p * pg8::bf_hi(w[e]); } }
    }
    { const float sk = a.sinks[head] * LOG2E; const float m2 = fmaxf(m, sk), al = __builtin_amdgcn_exp2f(m - m2); l = l * al + __builtin_amdgcn_exp2f(sk - m2);
      const float rl = al / l;
      v4u* op = (v4u*)(OA + (size_t)tok * 1024 + head * 64);
#pragma unroll
      for (int c = 0; c < 8; ++c) { v4u w;
#pragma unroll
          for (int e = 0; e < 4; ++e) w[e] = pg8::cvt_pk_bf16(o[8 * c + 2 * e] * rl, o[8 * c + 2 * e + 1] * rl);
          op[c] = w; } }
}
__device__ __forceinline__ void naive_fox_unit(const Args& a, int bh, int qblk) {
    const bf16* FQ = (const bf16*)(a.ws + WS_FQ); const bf16* FK = (const bf16*)(a.ws + WS_FK); const bf16* FV = (const bf16*)(a.ws + WS_FV); bf16* OB = (bf16*)(a.ws + WS_FQ);
    const float* Cp = (const float*)(a.ws + WS_C) + (size_t)bh * SEQ;
    const int tid = threadIdx.x, b = bh >> 4, h = bh & 15, s = qblk * 512 + tid; const size_t tok = (size_t)b * SEQ + s;
    float q[64], o[64]; float m = -INFINITY, l = 0.f;
    { const v4u* qp = (const v4u*)(FQ + tok * 1024 + h * 64);
#pragma unroll
      for (int c = 0; c < 8; ++c) { const v4u w = qp[c];
#pragma unroll
          for (int e = 0; e < 4; ++e) { q[8 * c + 2 * e] = pg8::bf_lo(w[e]); q[8 * c + 2 * e + 1] = pg8::bf_hi(w[e]); } } }
#pragma unroll
    for (int d = 0; d < 64; ++d) o[d] = 0.f;
    const float cq = Cp[s];
    const int jend = __builtin_amdgcn_readfirstlane(qblk * 512 + (tid | 63));
    for (int j = 0; j <= jend; ++j) {
        const v4u* kp = (const v4u*)(FK + ((size_t)b * SEQ + j) * 1024 + h * 64); const v4u* vp = (const v4u*)(FV + ((size_t)b * SEQ + j) * 1024 + h * 64);
        float dot = 0.f;
#pragma unroll
        for (int c = 0; c < 8; ++c) { const v4u w = kp[c];
#pragma unroll
            for (int e = 0; e < 4; ++e) { dot += q[8 * c + 2 * e] * pg8::bf_lo(w[e]); dot += q[8 * c + 2 * e + 1] * pg8::bf_hi(w[e]); } }
        float lg = dot + (cq - Cp[j]); lg = (j <= s) ? lg : -INFINITY;
        const float mn = fmaxf(m, lg), al = __builtin_amdgcn_exp2f(m - mn), p = __builtin_amdgcn_exp2f(lg - mn);
        l = l * al + p; m = mn;
#pragma unroll
        for (int c = 0; c < 8; ++c) { const v4u w = vp[c];
#pragma unroll
            for (int e = 0; e < 4; ++e) { o[8 * c + 2 * e] = o[8 * c + 2 * e] * al + p * pg8::bf_lo(w[e]); o[8 * c + 2 * e + 1] = o[8 * c + 2 * e + 1] * al + p * pg8::bf_hi(w[e]); } }
    }
    { const float rl = 1.0f / l; v4u* op = (v4u*)(OB + tok * 1024 + h * 64);
#pragma unroll
      for (int c = 0; c < 8; ++c) { v4u w;
#pragma unroll
          for (int e = 0; e < 4; ++e) w[e] = pg8::cvt_pk_bf16(o[8 * c + 2 * e] * rl, o[8 * c + 2 * e + 1] * rl);
          op[c] = w; } }
}

__global__ void __launch_bounds__(NWAVES * 64, 2) mega_fwd(Args a) {
    extern __shared__ __attribute__((aligned(16))) unsigned char lds_raw[];
    LAS unsigned char* lds = (LAS unsigned char*)lds_raw;
    cg::grid_group grid = cg::this_grid();
    const int tid = threadIdx.x, lane = tid & 63, wave = __builtin_amdgcn_readfirstlane(tid >> 6);
    const int G = gridDim.x, bx = blockIdx.x, vcu = (G % 8 == 0) ? (bx % 8) * (G / 8) + bx / 8 : bx;
    unsigned char* ws = a.ws;
    float* SS1 = (float*)(ws + WS_CTL); float* SS2 = SS1 + M;
#define GRID_SYNC() do { __threadfence(); grid.sync(); __threadfence(); } while (0)

    p0_prologue(a, lds, vcu, G, wave, lane);
    GRID_SYNC();

    {
        pg8::Gemm g{(const bf16*)(ws + WS_XN), (const bf16*)(ws + WS_WIN), nullptr, nullptr, DM};
        pg8::StaticOrder S; S.init(M, NIN, G, bx);
        pg8::EpiIn E{ws};
        pg8::gemm_phase<pg8::EpiIn, pg8::StaticOrder, true, true>(lds, g, S, E);
    }
    GRID_SYNC();

    if (bx < 64) cumsum_unit(a, bx, lds);
    for (int u = bx; u < M / 32; u += G) naive_swa_unit(a, u);
    GRID_SYNC();

    for (int i = 0; i < 4; ++i) { const int hi4 = bx >> 6, qblk = (i & 1) ? 4 * i + 3 - hi4 : 4 * i + hi4; naive_fox_unit(a, bx & 63, qblk); }
    GRID_SYNC();

    {
        pg8::Gemm g{(const bf16*)(ws + WS_AQ), (const bf16*)(ws + WS_WBS), (const bf16*)(ws + WS_FQ), (const bf16*)(ws + WS_WBF), 1024};
        pg8::PairOrder S; S.s.init(M, DM, G, bx);
        pg8::EpiBranch E{(const bf16*)(ws + WS_G), (bf16*)(ws + WS_MG)};
        pg8::gemm_phase<pg8::EpiBranch, pg8::PairOrder, true, true>(lds, g, S, E);
    }
    GRID_SYNC();

    {
        pg8::Gemm g{(const bf16*)(ws + WS_MG), (const bf16*)(ws + WS_WOUT), nullptr, nullptr, DM};
        pg8::StaticOrder S; S.init(M, DM, G, bx);
        pg8::EpiRes<true> E{a.x, a.out, (bf16*)(ws + WS_X1B), SS1};
        pg8::gemm_phase<pg8::EpiRes<true>, pg8::StaticOrder, true, true>(lds, g, S, E);
    }
    GRID_SYNC();

    {
        pg8::Gemm g{(const bf16*)(ws + WS_X1B), (const bf16*)(ws + WS_WUP), nullptr, nullptr, DM};
        pg8::StaticOrder S; S.init(M, DFF, G, bx);
        pg8::EpiUp E{SS1, (bf16*)(ws + WS_U)};
        pg8::gemm_phase<pg8::EpiUp, pg8::StaticOrder, true, true>(lds, g, S, E);
    }
    GRID_SYNC();

    {
        pg8::Gemm g{(const bf16*)(ws + WS_U), (const bf16*)(ws + WS_WDN), nullptr, nullptr, DFF};
        pg8::StaticOrder S; S.init(M, DM, G, bx);
        pg8::EpiRes<false> E{a.out, a.out, nullptr, SS2};
        pg8::gemm_phase<pg8::EpiRes<false>, pg8::StaticOrder, true, true>(lds, g, S, E);
    }
    GRID_SYNC();

    {
        const int gw = vcu * NWAVES + wave, NGW = G * NWAVES;
        for (int m = gw; m < M; m += NGW) {
            const float rstd = __builtin_amdgcn_rsqf(SS2[m] * (1.f / DM) + RMS_EPS);
            f32x4* xr = (f32x4*)(a.out + (size_t)m * DM) + lane; const f32x4* gr = (const f32x4*)a.final_norm + lane;
#pragma unroll
            for (int j = 0; j < 8; ++j) { const f32x4 v = xr[64 * j], g = gr[64 * j]; xr[64 * j] = v * rstd * g; }
        }
    }
}

extern "C" void kernel_launch(void* const* d_in, const int* in_sizes, int n_in, void* d_out, int out_size, void* d_ws, size_t ws_size, hipStream_t stream) {
    static int grid = 0;
    if (grid == 0) {
        if (n_in != 13 || in_sizes[0] != M * DM || out_size != M * DM || ws_size < WS_END) { fprintf(stderr, "kernel_launch: unexpected shapes (n_in %d, in0 %d, out %d, ws %zu)\n", n_in, n_in > 0 ? in_sizes[0] : -1, out_size, ws_size); grid = -1; return; }
        int dev = 0, cus = 0, per_cu = 0;
        if (hipGetDevice(&dev) != hipSuccess || hipDeviceGetAttribute(&cus, hipDeviceAttributeMultiprocessorCount, dev) != hipSuccess) { grid = -1; return; }
        if (hipFuncSetAttribute((const void*)mega_fwd, hipFuncAttributeMaxDynamicSharedMemorySize, LDS_BYTES) != hipSuccess) { fprintf(stderr, "kernel_launch: hipFuncSetAttribute failed\n"); grid = -1; return; }
        if (hipOccupancyMaxActiveBlocksPerMultiprocessor(&per_cu, (const void*)mega_fwd, NWAVES * 64, LDS_BYTES) != hipSuccess || per_cu < 1) { fprintf(stderr, "kernel_launch: occupancy query says %d\n", per_cu); per_cu = 1; }
        (void)hipGetLastError();
        grid = cus * 1;
    }
    if (grid < 0) return;
    (void)hipMemsetAsync((char*)d_ws + WS_CTL, 0, CTL_ZERO_BYTES, stream);
    Args a{};
    a.x = (const float*)d_in[0]; a.pos = (const int*)d_in[1]; a.attn_norm = (const float*)d_in[2]; a.w_in = (const float*)d_in[3]; a.fbias = (const float*)d_in[4]; a.sinks = (const float*)d_in[5];
    a.w_bs = (const float*)d_in[6]; a.w_bf = (const float*)d_in[7]; a.w_out = (const float*)d_in[8]; a.mlp_norm = (const float*)d_in[9]; a.w_up = (const float*)d_in[10]; a.w_dn = (const float*)d_in[11];
    a.final_norm = (const float*)d_in[12]; a.out = (float*)d_out; a.ws = (unsigned char*)d_ws;
    void* kargs[] = {&a};
    const hipError_t le = hipLaunchCooperativeKernel((const void*)mega_fwd, dim3(grid), dim3(NWAVES * 64), kargs, LDS_BYTES, stream);
    if (le != hipSuccess) fprintf(stderr, "kernel_launch: cooperative launch failed: %s (grid %d)\n", hipGetErrorString(le), grid);
}
```

```cpp
#include <hip/hip_runtime.h>
#include <hip/hip_cooperative_groups.h>
#include <cstdio>
#include <cstdint>
namespace cg = cooperative_groups;

constexpr int BATCH = 4, SEQ = 8192, DM = 2048, M = BATCH * SEQ, DFF = 8192, NIN = 8704  , DIN = 8464;
constexpr float RMS_EPS = 1e-6f;
constexpr float LOG2E = 1.4426950408889634f;
constexpr float C2 = 0.125f * 1.4426950408889634f;

constexpr size_t MiB = 1u << 20;
constexpr size_t WS_CTL = 0, CTL_ZERO_BYTES = 1 * MiB;
constexpr size_t WS_WIN = 1 * MiB, WS_WBS = 35 * MiB, WS_WBF = 39 * MiB, WS_WOUT = 43 * MiB, WS_WUP = 51 * MiB, WS_WDN = 83 * MiB;
constexpr size_t WS_CS = 115 * MiB;
constexpr size_t WS_FL = 123 * MiB, WS_C = 125 * MiB;
constexpr size_t WS_FK = 128 * MiB, WS_FV = 192 * MiB, WS_X1B = 128 * MiB;
constexpr size_t WS_XN = 256 * MiB, WS_MG = 256 * MiB;
constexpr size_t WS_AQ = 384 * MiB, WS_FQ = 448 * MiB, WS_G = 512 * MiB;
constexpr size_t WS_U = 256 * MiB;
constexpr size_t WS_AK = 768 * MiB, WS_AV = 776 * MiB, WS_END = 784 * MiB;

namespace pg8 {
#define PG8_LAS __attribute__((address_space(3)))
typedef unsigned short bf16_t;
typedef short bf16x8 __attribute__((ext_vector_type(8)));
typedef float f32x4 __attribute__((ext_vector_type(4)));
typedef unsigned u32x4 __attribute__((ext_vector_type(4)));
typedef unsigned u32x2 __attribute__((ext_vector_type(2)));
constexpr int BM = 256, BK = 64, HALF = 128, HTB = HALF * BK * 2  , STAGE_BYTES = 8 * HTB, NXCD = 8, WGM = 8;

__host__ __device__ __forceinline__ int lds_byte(int r, int c) { const int st = (r >> 4) * 2 + (c >> 5), rr = r & 15, cc = c & 31, ob = rr * 64 + cc * 2; return st * 1024 + (ob ^ (((ob >> 9) & 1) << 5)); }
__host__ __device__ __forceinline__ void stage_rc(int b, int& R, int& C) { const int st = b / 1024, sb = b % 1024, swz = sb ^ (((sb >> 9) & 1) << 5); R = (st >> 1) * 16 + swz / 64; C = (st & 1) * 32 + (swz % 64) / 2; }
__host__ __device__ __forceinline__ int perm32(int rho) { const int n = rho >> 4, i = rho & 15; return 8 * (i >> 2) + 4 * n + (i & 3); }

struct Unit { int pm, pn, z; };
struct Gemm { const bf16_t* A0; const bf16_t* B0; const bf16_t* A1; const bf16_t* B1; int K; };

struct StaticOrder {
    int nM, nN, nwg, G, c;
    __host__ __device__ void init(int M_, int N_, int G_, int c_) { nM = M_ / BM; nN = N_ / BM; nwg = nM * nN; G = G_; c = c_; }
    __host__ __device__ bool next(int i, Unit& u) const {
        const long L = (long)i * G + c; if (L >= nwg) return false;
        int wgid = (int)L; { const int q = nwg / NXCD, r = nwg % NXCD, xcd = wgid % NXCD, off = wgid / NXCD; wgid = (xcd < r ? xcd * (q + 1) : r * (q + 1) + (xcd - r) * q) + off; }
        const int nig = WGM * nN, gid = wgid / nig, fm = gid * WGM, gsz = (nM - fm) < WGM ? (nM - fm) : WGM;
        u.pm = fm + ((wgid % nig) % gsz); u.pn = (wgid % nig) / gsz; u.z = 0; return true;
    }
};
struct PairOrder {
    StaticOrder s;
    __host__ __device__ bool next(int i, Unit& u) const { const bool ok = s.next(i >> 1, u); u.z = i & 1; return ok; }
};

__device__ __forceinline__ unsigned cvt_pk_bf16(float lo, float hi) { unsigned r; asm("v_cvt_pk_bf16_f32 %0, %1, %2" : "=v"(r) : "v"(lo), "v"(hi)); return r; }
__device__ __forceinline__ float bf_lo(unsigned w) { return __uint_as_float(w << 16); }
__device__ __forceinline__ float bf_hi(unsigned w) { return __uint_as_float(w & 0xffff0000u); }
__device__ __forceinline__ float sigmoidf_(float x) { return __builtin_amdgcn_rcpf(1.0f + __builtin_amdgcn_exp2f(-x * LOG2E)); }


struct EpiIn {
    static constexpr bool PERM = true;
    unsigned char* ws;
    __device__ __forceinline__ bool keep(const Unit&) const { return false; }
    __device__ __forceinline__ void operator()(f32x4 (&acc)[2][2][4][2], const Unit& u, int wr, int wc, int fr, int fq) const {
        const int pn = u.pn; const int row0 = u.pm * BM + wr * 64 + fr;
        if (pn <= 16) {
            size_t doff; int pitch, colbase; bool rope = false; float sc = 1.f;
            if (pn < 4) { doff = WS_AQ; pitch = 1024; colbase = (4 * pn + wc) * 64; rope = true; sc = C2; }
            else if (pn == 4) { if (wc < 2) { doff = WS_AK; pitch = 128; colbase = wc * 64; rope = true; } else { doff = WS_AV; pitch = 128; colbase = (wc - 2) * 64; } }
            else { const int t = pn - 5, seg = t >> 2, tin = t & 3; doff = WS_FQ; if (seg == 1) doff = WS_FK; if (seg == 2) doff = WS_FV; pitch = 1024; colbase = (4 * tin + wc) * 64; sc = seg == 0 ? C2 : 1.f; }
            bf16_t* dst = (bf16_t*)(ws + doff); const float* cs = (const float*)(ws + WS_CS);
#pragma unroll
            for (int ai = 0; ai < 2; ++ai)
#pragma unroll
                for (int m = 0; m < 4; ++m) {
                    const int row = row0 + ai * HALF + m * 16;
                    f32x4 v00 = acc[ai][0][m][0], v01 = acc[ai][0][m][1], v10 = acc[ai][1][m][0], v11 = acc[ai][1][m][1];
                    if (rope) {
                        const float* cp = cs + (size_t)row * 32 + 8 * fq; const float* sp = cp + (size_t)M * 32;
                        const f32x4 c0 = *(const f32x4*)cp, c1 = *(const f32x4*)(cp + 4), s0 = *(const f32x4*)sp, s1 = *(const f32x4*)(sp + 4);
                        const f32x4 o00 = v00 * c0 - v10 * s0, o10 = v10 * c0 + v00 * s0, o01 = v01 * c1 - v11 * s1, o11 = v11 * c1 + v01 * s1;
                        v00 = o00; v10 = o10; v01 = o01; v11 = o11;
                    }
                    v00 = v00 * sc; v01 = v01 * sc; v10 = v10 * sc; v11 = v11 * sc;
                    bf16_t* rp = dst + (size_t)row * pitch + colbase + 8 * fq;
                    u32x4 w0, w1;
                    w0.x = cvt_pk_bf16(v00[0], v00[1]); w0.y = cvt_pk_bf16(v00[2], v00[3]); w0.z = cvt_pk_bf16(v01[0], v01[1]); w0.w = cvt_pk_bf16(v01[2], v01[3]);
                    w1.x = cvt_pk_bf16(v10[0], v10[1]); w1.y = cvt_pk_bf16(v10[2], v10[3]); w1.z = cvt_pk_bf16(v11[0], v11[1]); w1.w = cvt_pk_bf16(v11[2], v11[3]);
                    *(u32x4*)rp = w0; *(u32x4*)(rp + 32) = w1;
                }
        } else if (pn <= 32) {
            const int col0 = (pn - 17) * BM + wc * 32 + 8 * fq;
#pragma unroll
            for (int ai = 0; ai < 2; ++ai)
#pragma unroll
                for (int m = 0; m < 4; ++m) {
                    bf16_t* rp = (bf16_t*)(ws + WS_G) + (size_t)(row0 + ai * HALF + m * 16) * 4096 + col0;
#pragma unroll
                    for (int bj = 0; bj < 2; ++bj) {
                        const f32x4 a = acc[ai][bj][m][0], b = acc[ai][bj][m][1]; u32x4 w;
                        float s[8];
#pragma unroll
                        for (int i = 0; i < 4; ++i) { s[i] = fmaxf(sigmoidf_(a[i]), 1e-30f); s[4 + i] = fmaxf(sigmoidf_(b[i]), 1e-30f); }
                        w.x = cvt_pk_bf16(s[0], s[1]); w.y = cvt_pk_bf16(s[2], s[3]); w.z = cvt_pk_bf16(s[4], s[5]); w.w = cvt_pk_bf16(s[6], s[7]);
                        *(u32x4*)(rp + bj * HALF) = w;
                    }
                }
        } else {
            if (wc == 0 && fq < 2) {
#pragma unroll
                for (int ai = 0; ai < 2; ++ai)
#pragma unroll
                    for (int m = 0; m < 4; ++m) {
                        float* rp = (float*)(ws + WS_FL) + (size_t)(row0 + ai * HALF + m * 16) * 16 + 8 * fq;
                        *(f32x4*)rp = acc[ai][0][m][0]; *(f32x4*)(rp + 4) = acc[ai][0][m][1];
                    }
            }
        }
    }
};

struct EpiBranch {
    static constexpr bool PERM = true;
    const bf16_t* G; bf16_t* MG;
    __device__ __forceinline__ bool keep(const Unit& u) const { return u.z == 0; }
    __device__ __forceinline__ void operator()(f32x4 (&acc)[2][2][4][2], const Unit& u, int wr, int wc, int fr, int fq) const {
        const int row0 = u.pm * BM + wr * 64 + fr, col0 = u.pn * BM + wc * 32 + 8 * fq; const int z = u.z;
#pragma unroll
        for (int ai = 0; ai < 2; ++ai)
#pragma unroll
            for (int m = 0; m < 4; ++m) {
                const size_t row = (size_t)(row0 + ai * HALF + m * 16);
#pragma unroll
                for (int bj = 0; bj < 2; ++bj) {
                    const bf16_t* gp = G + row * 4096 + col0 + bj * HALF;
                    const u32x4 gb = *(const u32x4*)(gp + 2048);
                    float sb[8];
#pragma unroll
                    for (int i = 0; i < 4; ++i) { sb[2 * i] = bf_lo(gb[i]); sb[2 * i + 1] = bf_hi(gb[i]); }
                    if (z == 0) {
                        const u32x4 ga = *(const u32x4*)gp;
#pragma unroll
                        for (int i = 0; i < 4; ++i) {
                            const float r0 = bf_lo(ga[i]) * __builtin_amdgcn_rcpf(sb[2 * i]), r1 = bf_hi(ga[i]) * __builtin_amdgcn_rcpf(sb[2 * i + 1]);
                            const int e0 = 2 * i, e1 = 2 * i + 1;
                            acc[ai][bj][m][e0 >> 2][e0 & 3] *= r0; acc[ai][bj][m][e1 >> 2][e1 & 3] *= r1;
                        }
                    } else {
                        const f32x4 a = acc[ai][bj][m][0], b = acc[ai][bj][m][1]; u32x4 w;
                        w.x = cvt_pk_bf16(a[0] * sb[0], a[1] * sb[1]); w.y = cvt_pk_bf16(a[2] * sb[2], a[3] * sb[3]);
                        w.z = cvt_pk_bf16(b[0] * sb[4], b[1] * sb[5]); w.w = cvt_pk_bf16(b[2] * sb[6], b[3] * sb[7]);
                        *(u32x4*)(MG + row * 2048 + col0 + bj * HALF) = w;
                    }
                }
            }
    }
};

template <bool WRITE_BF> struct EpiRes {
    static constexpr bool PERM = false;
    const float* base; float* out; bf16_t* xb; float* ss;
    __device__ __forceinline__ bool keep(const Unit&) const { return false; }
    __device__ __forceinline__ void operator()(f32x4 (&acc)[2][2][4][2], const Unit& u, int wr, int wc, int fr, int fq) const {
        const int row0 = u.pm * BM + wr * 64 + fr, col0 = u.pn * BM + wc * 32 + 4 * fq;
#pragma unroll
        for (int ai = 0; ai < 2; ++ai)
#pragma unroll
            for (int m = 0; m < 4; ++m) {
                const size_t row = (size_t)(row0 + ai * HALF + m * 16); const size_t off = row * DM + col0; float q = 0.f;
#pragma unroll
                for (int bj = 0; bj < 2; ++bj)
#pragma unroll
                    for (int n = 0; n < 2; ++n) {
                        const size_t o = off + bj * HALF + n * 16;
                        const f32x4 v = *(const f32x4*)(base + o) + acc[ai][bj][m][n];
                        *(f32x4*)(out + o) = v; q += (v[0] * v[0] + v[1] * v[1]) + (v[2] * v[2] + v[3] * v[3]);
                        if (WRITE_BF) { u32x2 w; w.x = cvt_pk_bf16(v[0], v[1]); w.y = cvt_pk_bf16(v[2], v[3]); *(u32x2*)(xb + o) = w; }
                    }
                q += __shfl_xor(q, 16); q += __shfl_xor(q, 32);
                if (fq == 0) atomicAdd(ss + row, q);
            }
    }
};

struct EpiUp {
    static constexpr bool PERM = true;
    const float* ss; bf16_t* U;
    __device__ __forceinline__ bool keep(const Unit&) const { return false; }
    __device__ __forceinline__ void operator()(f32x4 (&acc)[2][2][4][2], const Unit& u, int wr, int wc, int fr, int fq) const {
        const int row0 = u.pm * BM + wr * 64 + fr, col0 = u.pn * BM + wc * 32 + 8 * fq;
#pragma unroll
        for (int ai = 0; ai < 2; ++ai)
#pragma unroll
            for (int m = 0; m < 4; ++m) {
                const size_t row = (size_t)(row0 + ai * HALF + m * 16);
                const float rstd = __builtin_amdgcn_rsqf(ss[row] * (1.0f / DM) + RMS_EPS);
#pragma unroll
                for (int bj = 0; bj < 2; ++bj) {
                    f32x4 a = acc[ai][bj][m][0] * rstd, b = acc[ai][bj][m][1] * rstd; u32x4 w;
#pragma unroll
                    for (int i = 0; i < 4; ++i) { a[i] = fmaxf(a[i], 0.f); a[i] *= a[i]; b[i] = fmaxf(b[i], 0.f); b[i] *= b[i]; }
                    w.x = cvt_pk_bf16(a[0], a[1]); w.y = cvt_pk_bf16(a[2], a[3]); w.z = cvt_pk_bf16(b[0], b[1]); w.w = cvt_pk_bf16(b[2], b[3]);
                    *(u32x4*)(U + row * DFF + col0 + bj * HALF) = w;
                }
            }
    }
};

template <class Epi, class Sched, bool ALIGN_EPI = false, bool SP2 = false>
__device__ __forceinline__ void gemm_phase(PG8_LAS unsigned char* lds, const Gemm g, const Sched& S, const Epi& E) {
    int tid_ = threadIdx.x; asm volatile("" : "+v"(tid_));
    const int tid = tid_, wid = __builtin_amdgcn_readfirstlane(tid >> 6), lane = tid & 63, wr = wid >> 2, wc = wid & 3, fr = lane & 15, fq = lane >> 4;
    const int K = g.K, nt = K / BK;
    unsigned voffA[2], voffB[2];
#pragma unroll
    for (int i = 0; i < 2; ++i) { int R, C; stage_rc(tid * 16 + i * 8192, R, C); const int Rb = Epi::PERM ? ((R & ~31) + perm32(R & 31)) : R;
        voffA[i] = (unsigned)(R * K + C) * 2u; voffB[i] = (unsigned)(Rb * K + C) * 2u; }
    const size_t kstep = (size_t)(BK * 2);
    const size_t hstep = (size_t)HALF * K * 2;
    const size_t tstep = 2 * hstep;
    const unsigned ldsw = (unsigned)wid * 1024u;
    const int aoff = lds_byte(wr * 64 + fr, fq * 8), boff = lds_byte(wc * 32 + fr, fq * 8);
#define PG8_SA(b, h) (((b) * 2 + (h)) * HTB)
#define PG8_SB(b, h) ((4 + (b) * 2 + (h)) * HTB)
#define PG8_STAGE(bufoff, gbase, voff) do { _Pragma("unroll") for (int _i = 0; _i < 2; ++_i) \
        __builtin_amdgcn_global_load_lds((const unsigned*)((const char*)(gbase) + (voff)[_i]), (PG8_LAS unsigned*)(lds + (bufoff) + ldsw + _i * 8192), 16, 0, 0); } while (0)
#define PG8_LDA(dst, b, h) do { _Pragma("unroll") for (int m = 0; m < 4; ++m) _Pragma("unroll") for (int k = 0; k < 2; ++k) dst[m][k] = *(const PG8_LAS bf16x8*)(lds + PG8_SA(b, h) + aoff + m * 2048 + k * 1024); } while (0)
#define PG8_LDB(dst, b, h) do { _Pragma("unroll") for (int n = 0; n < 2; ++n) _Pragma("unroll") for (int k = 0; k < 2; ++k) dst[n][k] = *(const PG8_LAS bf16x8*)(lds + PG8_SB(b, h) + boff + n * 2048 + k * 1024); } while (0)
#define PG8_MMA(ai, bj, At, Bt) do { __builtin_amdgcn_s_setprio(1); _Pragma("unroll") for (int m = 0; m < 4; ++m) _Pragma("unroll") for (int n = 0; n < 2; ++n) _Pragma("unroll") for (int k = 0; k < 2; ++k) \
        acc[ai][bj][m][n] = __builtin_amdgcn_mfma_f32_16x16x32_bf16(Bt[n][k], At[m][k], acc[ai][bj][m][n], 0, 0, 0); __builtin_amdgcn_s_setprio(0); } while (0)
#define PG8_WAIT_V(n) asm volatile("s_waitcnt vmcnt(" #n ")" ::: "memory")
#define PG8_WAIT_L(n) asm volatile("s_waitcnt lgkmcnt(" #n ")" ::: "memory")
#define PG8_BAR __builtin_amdgcn_s_barrier()
#define PG8_SCHED __builtin_amdgcn_sched_barrier(0)
    Unit cur, nxt; int ui = 0;
    if (!S.next(0, cur)) return;
    f32x4 acc[2][2][4][2];
#pragma unroll
    for (int a = 0; a < 2; ++a)
#pragma unroll
        for (int b = 0; b < 2; ++b)
#pragma unroll
            for (int m = 0; m < 4; ++m)
#pragma unroll
                for (int n = 0; n < 2; ++n) acc[a][b][m][n] = (f32x4){0.f, 0.f, 0.f, 0.f};
    bf16x8 At[4][2], B0[2][2], B1[2][2];
    const char* cA = (const char*)(cur.z ? g.A1 : g.A0) + (size_t)cur.pm * tstep; const char* cB = (const char*)(cur.z ? g.B1 : g.B0) + (size_t)cur.pn * tstep;
    if constexpr (SP2) {
        PG8_STAGE(PG8_SB(0, 0), cB, voffB); PG8_STAGE(PG8_SB(0, 1), cB + hstep, voffB); PG8_STAGE(PG8_SA(0, 0), cA, voffA); PG8_STAGE(PG8_SA(0, 1), cA + hstep, voffA);
        if (wr == 1) PG8_BAR;
        PG8_WAIT_V(2); PG8_BAR;
        PG8_STAGE(PG8_SB(1, 0), cB + kstep, voffB); PG8_STAGE(PG8_SA(1, 0), cA + kstep, voffA); PG8_STAGE(PG8_SB(1, 1), cB + hstep + kstep, voffB);
        PG8_WAIT_V(6); PG8_BAR;
    } else {
        PG8_STAGE(PG8_SB(0, 0), cB, voffB); PG8_STAGE(PG8_SA(0, 0), cA, voffA); PG8_STAGE(PG8_SB(0, 1), cB + hstep, voffB); PG8_STAGE(PG8_SA(0, 1), cA + hstep, voffA);
        if (wr == 1) PG8_BAR;
        PG8_WAIT_V(4); PG8_BAR;
        PG8_STAGE(PG8_SB(1, 0), cB + kstep, voffB); PG8_STAGE(PG8_SA(1, 0), cA + kstep, voffA); PG8_STAGE(PG8_SB(1, 1), cB + hstep + kstep, voffB);
        PG8_WAIT_V(6); PG8_BAR;
    }
    for (;;) {
        const bool has_next = S.next(ui + 1, nxt);
        const char* nA = has_next ? (const char*)(nxt.z ? g.A1 : g.A0) + (size_t)nxt.pm * tstep : cA; const char* nB = has_next ? (const char*)(nxt.z ? g.B1 : g.B0) + (size_t)nxt.pn * tstep : cB;
        for (int t = 0; t < nt; t += 2) {
            const bool last = (t == nt - 2);
            const char* a1 = cA + (size_t)(t + 1) * kstep;
            const char* a2 = last ? nA : cA + (size_t)(t + 2) * kstep; const char* b2 = last ? nB : cB + (size_t)(t + 2) * kstep;
            const char* a3 = a2 + kstep; const char* b3 = b2 + kstep;
            if constexpr (SP2) {
            PG8_LDB(B0, 0, 0); PG8_LDB(B1, 0, 1); PG8_SCHED; PG8_LDA(At, 0, 0); PG8_STAGE(PG8_SA(1, 1), a1 + hstep, voffA);
            PG8_WAIT_V(8); PG8_WAIT_L(0); PG8_BAR; PG8_MMA(0, 0, At, B0); PG8_MMA(0, 1, At, B1); PG8_BAR; PG8_SCHED;
            PG8_LDA(At, 0, 1); PG8_STAGE(PG8_SB(0, 0), b2, voffB); PG8_STAGE(PG8_SB(0, 1), b2 + hstep, voffB); PG8_STAGE(PG8_SA(0, 0), a2, voffA);
            PG8_WAIT_V(8); PG8_WAIT_L(0); PG8_BAR; PG8_MMA(1, 0, At, B0); PG8_MMA(1, 1, At, B1); PG8_BAR; PG8_SCHED;
            PG8_LDB(B0, 1, 0); PG8_LDB(B1, 1, 1); PG8_SCHED; PG8_LDA(At, 1, 0); PG8_STAGE(PG8_SA(0, 1), a2 + hstep, voffA);
            PG8_WAIT_V(8); PG8_WAIT_L(0); PG8_BAR; PG8_MMA(0, 0, At, B0); PG8_MMA(0, 1, At, B1); PG8_BAR; PG8_SCHED;
            PG8_LDA(At, 1, 1); PG8_STAGE(PG8_SB(1, 0), b3, voffB); PG8_STAGE(PG8_SB(1, 1), b3 + hstep, voffB); PG8_STAGE(PG8_SA(1, 0), a3, voffA);
            PG8_WAIT_V(8); PG8_WAIT_L(0); PG8_BAR; PG8_MMA(1, 0, At, B0); PG8_MMA(1, 1, At, B1); PG8_BAR; PG8_SCHED;
            } else {
            PG8_LDB(B0, 0, 0); PG8_SCHED; PG8_LDA(At, 0, 0); PG8_STAGE(PG8_SA(1, 1), a1 + hstep, voffA);
            PG8_WAIT_L(8); PG8_BAR; PG8_WAIT_L(0); PG8_MMA(0, 0, At, B0); PG8_BAR; PG8_SCHED;
            PG8_LDB(B1, 0, 1); PG8_STAGE(PG8_SB(0, 0), b2, voffB);
            PG8_BAR; PG8_WAIT_L(0); PG8_MMA(0, 1, At, B1); PG8_BAR;
            PG8_LDA(At, 0, 1); PG8_STAGE(PG8_SA(0, 0), a2, voffA);
            PG8_BAR; PG8_WAIT_L(0); PG8_MMA(1, 0, At, B0); PG8_BAR; PG8_SCHED;
            PG8_STAGE(PG8_SB(0, 1), b2 + hstep, voffB);
            PG8_WAIT_V(6); PG8_BAR; PG8_MMA(1, 1, At, B1); PG8_BAR;
            PG8_LDB(B0, 1, 0); PG8_SCHED; PG8_LDA(At, 1, 0); PG8_STAGE(PG8_SA(0, 1), a2 + hstep, voffA);
            PG8_WAIT_L(8); PG8_BAR; PG8_WAIT_L(0); PG8_MMA(0, 0, At, B0); PG8_BAR; PG8_SCHED;
            PG8_LDB(B1, 1, 1); PG8_STAGE(PG8_SB(1, 0), b3, voffB);
            PG8_BAR; PG8_WAIT_L(0); PG8_MMA(0, 1, At, B1); PG8_BAR;
            PG8_LDA(At, 1, 1); PG8_STAGE(PG8_SA(1, 0), a3, voffA);
            PG8_BAR; PG8_WAIT_L(0); PG8_MMA(1, 0, At, B0); PG8_BAR; PG8_SCHED;
            PG8_STAGE(PG8_SB(1, 1), b3 + hstep, voffB);
            PG8_WAIT_V(6); PG8_BAR; PG8_MMA(1, 1, At, B1); PG8_BAR;
            }
        }
        if constexpr (ALIGN_EPI) { if (wr == 0) PG8_BAR; }
        E(acc, cur, wr, wc, fr, fq);
        if (!has_next) break;
        if (!E.keep(cur))
#pragma unroll
        for (int a = 0; a < 2; ++a)
#pragma unroll
            for (int b = 0; b < 2; ++b)
#pragma unroll
                for (int m = 0; m < 4; ++m)
#pragma unroll
                    for (int n = 0; n < 2; ++n) acc[a][b][m][n] = (f32x4){0.f, 0.f, 0.f, 0.f};
        cur = nxt; cA = nA; cB = nB; ++ui;
        if constexpr (ALIGN_EPI) { if (wr == 1) PG8_BAR; }
    }
    PG8_WAIT_V(0);
    if constexpr (!ALIGN_EPI) { if (wr == 0) PG8_BAR; }
    PG8_BAR;
#undef PG8_SA
#undef PG8_SB
#undef PG8_STAGE
#undef PG8_LDA
#undef PG8_LDB
#undef PG8_MMA
#undef PG8_WAIT_V
#undef PG8_WAIT_L
#undef PG8_BAR
#undef PG8_SCHED
}
}


namespace attn_body {
using bf16=unsigned short;
using bf16x8=__attribute__((ext_vector_type(8)))short;
using s16x4=__attribute__((ext_vector_type(4)))short;
using f32x16=__attribute__((ext_vector_type(16)))float;
using u32x4=__attribute__((ext_vector_type(4)))unsigned;
using f32x4v=__attribute__((ext_vector_type(4)))float;
constexpr int BATCH=4,NHEAD=16,SEQ=8192,D=64,DM=NHEAD*D;
constexpr int NW=8,QBLK=32,QB=QBLK*NW,KVBLK=64,NQB=SEQ/QB;
constexpr int ATTN_PITCH=DM, ATTN_UNIT_ROWS=QB;
__device__ __forceinline__ int crow(int r,int hi){return (r&3)+8*(r>>2)+4*hi;}
#define SBAR() __builtin_amdgcn_sched_barrier(0)
template<bool SWA> __device__ __forceinline__ void cmask(f32x16&p0,f32x16&p1,int jb,int qrel,int hi){
  const float NEG=-INFINITY; int kb=64*jb+4*hi;
  #pragma unroll
  for(int r=0;r<16;++r){int kv=kb+(r&3)+8*(r>>2);
    if(SWA){ if(kv>qrel||kv<=qrel-128)p0[r]=NEG; if(kv+32>qrel||kv+32<=qrel-128)p1[r]=NEG; }
    else{ if(kv>qrel)p0[r]=NEG; if(kv+32>qrel)p1[r]=NEG; } }
}

constexpr int NSLOT=3, SLOTB=8192;
#ifndef NVB
#define NVB 8
#endif
constexpr int LDS_K=0, LDS_V=NSLOT*SLOTB, LDS_WS=2*NSLOT*SLOTB, LDS_OST=LDS_WS+NW*64*4, LDS_CB=LDS_OST+NW*4096, LDS_BYTES=LDS_CB+4*256;
constexpr float C2=0.125f*1.4426950408889634f;
__device__ __forceinline__ void glds16(const void*gsrc,unsigned lds_dst){unsigned keep;
  asm volatile("s_mov_b32 %0, m0\n\ts_mov_b32 m0, %2\n\ts_nop 0\n\tglobal_load_lds_dwordx4 %1, off\n\ts_mov_b32 m0, %0":"=&s"(keep):"v"(gsrc),"s"(lds_dst):"memory");}
__device__ __forceinline__ void glds4(const void*gsrc,unsigned lds_dst){unsigned keep;
  asm volatile("s_mov_b32 %0, m0\n\ts_mov_b32 m0, %2\n\ts_nop 0\n\tglobal_load_lds_dword %1, off\n\ts_mov_b32 m0, %0":"=&s"(keep):"v"(gsrc),"s"(lds_dst):"memory");}
__device__ __forceinline__ float max3f(float a,float b,float c){float r;asm("v_max3_f32 %0, %1, %2, %3":"=v"(r):"v"(a),"v"(b),"v"(c));return r;}
__device__ __forceinline__ float max2f(float a,float b){float r;asm("v_max_f32_e32 %0, %1, %2":"=v"(r):"v"(a),"v"(b));return r;}
__device__ __forceinline__ float fadd_s(float a,float b){float r;asm("v_add_f32_e32 %0, %1, %2":"=v"(r):"v"(a),"v"(b));return r;}
__device__ __forceinline__ float fsub_s(float a,float b){float r;asm("v_sub_f32_e32 %0, %1, %2":"=v"(r):"v"(a),"v"(b));return r;}
typedef float f32x2_t __attribute__((ext_vector_type(2))); typedef __bf16 bf16x2_t __attribute__((ext_vector_type(2)));
__device__ __forceinline__ unsigned cvtpk_s(float lo,float hi){f32x2_t v={lo,hi};bf16x2_t b=__builtin_convertvector(v,bf16x2_t);return __builtin_bit_cast(unsigned,b);}
#define WAIT_BAR(N) asm volatile("s_waitcnt vmcnt(" #N ") lgkmcnt(0)\n\ts_barrier":::"memory")

__device__ __forceinline__ void qkt(f32x16&p0,f32x16&p1,const char*Kslot,const bf16x8*qr,int r32,int hi){
  const char*kb=Kslot+hi*1024+r32*16;
  #pragma unroll
  for(int d0=0;d0<4;++d0){
    const bf16x8 b0=*reinterpret_cast<const bf16x8*>(kb+d0*2048);
    const bf16x8 b1=*reinterpret_cast<const bf16x8*>(kb+d0*2048+512);
    {p0=__builtin_amdgcn_mfma_f32_32x32x16_bf16(b0,qr[d0],p0,0,0,0);p1=__builtin_amdgcn_mfma_f32_32x32x16_bf16(b1,qr[d0],p1,0,0,0);}}
}
typedef __attribute__((address_space(3))) const char* lds_cptr;
typedef short v4i16_t __attribute__((ext_vector_type(4)));
__device__ __forceinline__ void kload8(bf16x8*kf,lds_cptr kp){
  kf[0]=*(const __attribute__((address_space(3))) bf16x8*)(kp);      kf[1]=*(const __attribute__((address_space(3))) bf16x8*)(kp+512);
  kf[2]=*(const __attribute__((address_space(3))) bf16x8*)(kp+2048); kf[3]=*(const __attribute__((address_space(3))) bf16x8*)(kp+2560);
  kf[4]=*(const __attribute__((address_space(3))) bf16x8*)(kp+4096); kf[5]=*(const __attribute__((address_space(3))) bf16x8*)(kp+4608);
  kf[6]=*(const __attribute__((address_space(3))) bf16x8*)(kp+6144); kf[7]=*(const __attribute__((address_space(3))) bf16x8*)(kp+6656);
}
__device__ __forceinline__ void kload2(bf16x8*kf,lds_cptr kp,int j){ kf[2*j]=*(const __attribute__((address_space(3))) bf16x8*)(kp+j*2048); kf[2*j+1]=*(const __attribute__((address_space(3))) bf16x8*)(kp+j*2048+512); }
__device__ __forceinline__ s16x4 vtr(lds_cptr p){ return __builtin_bit_cast(s16x4,__builtin_amdgcn_ds_read_tr16_b64_v4i16((__attribute__((address_space(3))) v4i16_t*)p)); }
__device__ __forceinline__ float rowmax(const f32x16&p0,const f32x16&p1){
  float a=max3f(p0[0],p0[1],p1[0]),b=max3f(p0[2],p0[3],p1[1]);a=max3f(a,p1[2],p1[3]);
  #pragma unroll
  for(int r=4;r<16;r+=4){a=max3f(a,p0[r],p0[r+1]);b=max3f(b,p0[r+2],p0[r+3]);a=max3f(a,p1[r],p1[r+1]);b=max3f(b,p1[r+2],p1[r+3]);}
  const float m=max2f(a,b);
  auto rr=__builtin_amdgcn_permlane32_swap(__float_as_uint(m),__float_as_uint(m),false,false);
  return max2f(__uint_as_float(rr[0]),__uint_as_float(rr[1]));
}
__device__ __forceinline__ void pv(f32x16*o,int vb,bf16x8 pa0,bf16x8 pa1,bf16x8 pa2,bf16x8 pa3){
  #pragma unroll
  for(int d0=0;d0<2;++d0){s16x4 lo[4],hi[4];
    #pragma unroll
    for(int ks=0;ks<4;++ks){
      asm volatile("ds_read_b64_tr_b16 %0,%1 offset:%c2":"=&v"(lo[ks]):"v"(vb),"i"(d0*4096+ks*1024):"memory");
      asm volatile("ds_read_b64_tr_b16 %0,%1 offset:%c2":"=&v"(hi[ks]):"v"(vb),"i"(d0*4096+ks*1024+512):"memory");}
    asm volatile("s_waitcnt lgkmcnt(0)":::"memory");SBAR();
    #define PK(k) (bf16x8){lo[k][0],lo[k][1],lo[k][2],lo[k][3],hi[k][0],hi[k][1],hi[k][2],hi[k][3]}
    o[d0]=__builtin_amdgcn_mfma_f32_32x32x16_bf16(pa0,PK(0),o[d0],0,0,0);
    o[d0]=__builtin_amdgcn_mfma_f32_32x32x16_bf16(pa1,PK(1),o[d0],0,0,0);
    o[d0]=__builtin_amdgcn_mfma_f32_32x32x16_bf16(pa2,PK(2),o[d0],0,0,0);
    o[d0]=__builtin_amdgcn_mfma_f32_32x32x16_bf16(pa3,PK(3),o[d0],0,0,0);
    #undef PK
  }
}

typedef __attribute__((address_space(3))) const f32x4v* lds_f4ptr;
__device__ __forceinline__ void fill_bias(f32x16&c0,f32x16&c1,lds_cptr cb,float negmh){
  #pragma unroll
  for(int g=0;g<4;++g){ const f32x4v v=*(lds_f4ptr)(cb+g*32), w=*(lds_f4ptr)(cb+128+g*32);
    #pragma unroll
    for(int i=0;i<4;++i){ c0[4*g+i]=negmh-v[i]; c1[4*g+i]=negmh-w[i]; } }
}
#ifndef ATTN_STORE16
#define ATTN_STORE16(p,v) (*(u32x4*)(p)=(v))
#endif
template<int THRL,bool FOX,int KP> __device__ __forceinline__ void attn_unit(int b,int h,int qb,const bf16*Q,const bf16*__restrict__ K,const bf16*__restrict__ V,bf16*O,const float*__restrict__ Cb,float sink2,char*shm){
  int tid_=threadIdx.x; asm volatile("":"+v"(tid_));
  const int tid=tid_,lane=tid&63,r32=lane&31,hi=lane>>5; const int wid=__builtin_amdgcn_readfirstlane(tid>>6);
  const long rowbase=(long)b*SEQ; const int q0=qb*QB;
  const bf16*Qw=Q+(rowbase+q0+wid*QBLK)*DM+h*D;
  const int kvh=FOX?h:(h>>3); const int T0=FOX?0:(qb==0?0:4*qb-2);
  const bf16*Kh=K+(rowbase+(long)T0*KVBLK)*KP+kvh*D,*Vh=V+(rowbase+(long)T0*KVBLK)*KP+kvh*D; const float*Cs=FOX?Cb+lane:nullptr;
  const unsigned lds0=(unsigned)(uintptr_t)shm;
  float*wsf=(float*)(shm+LDS_WS)+wid*64;
  const bf16*ksrc=Kh+(long)lane*KP+wid*8;
  const bf16*vsrc=Vh+(long)(16*(wid&3)+(lane>>2))*KP+(wid>>2)*32+(lane&3)*8;
  const unsigned kdst=lds0+LDS_K+wid*1024, vdst=lds0+LDS_V+wid*1024;
  #define DMA_K(t,slot) glds16(ksrc+(long)(t)*KVBLK*KP,(unsigned)__builtin_amdgcn_readfirstlane(kdst+(slot)))
  #define DMA_C(t) do{ if(FOX) glds4(Cs+(long)(t)*KVBLK,(unsigned)__builtin_amdgcn_readfirstlane(lds0+LDS_CB+(((t)&3)<<8))); }while(0)
  #define PREFILL(X0,X1,t) do{ if(FOX){ fill_bias(X0,X1,cb0+(((t)&3)<<8),-mhat); } else { _Pragma("unroll") for(int r=0;r<16;++r){X0[r]=-mhat;X1[r]=-mhat;} } }while(0)
  #define DMA_V(t,slot) glds16(vsrc+(long)(t)*KVBLK*KP,(unsigned)__builtin_amdgcn_readfirstlane(vdst+(slot)))
  const int vb0=(int)(lds0+LDS_V)+((lane>>4)&1)*32+(lane&3)*8+(4*hi+((lane&15)>>2))*64;
  const char*Kbase=shm+LDS_K; bf16x8 kf[8];
  const lds_cptr shm3=(lds_cptr)shm; const lds_cptr cb0=shm3+LDS_CB+hi*16; const lds_cptr kp0=shm3+LDS_K+hi*1024+r32*16; const lds_cptr vp0=shm3+LDS_V+((lane>>4)&1)*32+(lane&3)*8+(4*hi+((lane&15)>>2))*64;
  const int NT=FOX?(q0+QB)/KVBLK:(qb==0?4:6);
  DMA_K(0,0);DMA_C(0);DMA_V(0,0);DMA_K(1,SLOTB);DMA_C(1);
  bf16x8 qr[4];
  #pragma unroll
  for(int d0=0;d0<4;++d0)qr[d0]=*reinterpret_cast<const bf16x8*>(&Qw[(long)r32*DM+d0*16+hi*8]);
  float mhat=0.f,l_reg=0.f;f32x16 o[2];o[0]=f32x16{};o[1]=f32x16{};
  const int qrel=wid*QBLK+r32;
  #define CMASK(P0,P1,t) do{int jb_=(t)-(NT-4); if(!FOX||jb_>=0)cmask<!FOX>(P0,P1,jb_,qrel,hi);}while(0)
  bool resc=false;
  #define START(P0,P1) do{ float rm=rowmax(P0,P1); if(!FOX) rm=(rm==-INFINITY)?0.f:rm; resc=false; \
    { const float dl=rm; mhat=fadd_s(mhat,dl); \
      _Pragma("unroll") for(int r=0;r<16;++r){P0[r]=fsub_s(P0[r],dl);P1[r]=fsub_s(P1[r],dl);} } \
    _Pragma("unroll") for(int r=0;r<16;++r)P0[r]=__builtin_amdgcn_exp2f(P0[r]); }while(0)
  #define RESC() do{ if(resc){ asm volatile("s_waitcnt lgkmcnt(0)":::"memory"); \
      _Pragma("unroll") for(int d_=0;d_<2;++d_) _Pragma("unroll") for(int r=0;r<16;++r)o[d_][r]*=wsf[crow(r,hi)]; } }while(0)
  f32x16 pA0,pA1,pB0,pB1;
  int sl_prev=0,sl_cur=0,sl_next=SLOTB;
  #define ROT() do{sl_prev=sl_cur;sl_cur=sl_next;sl_next=(sl_next==(NSLOT-1)*SLOTB)?0:sl_next+SLOTB;}while(0)
  DMA_K(2,2*SLOTB);DMA_C(2);
  if(FOX){WAIT_BAR(5);}else{WAIT_BAR(3);}
  PREFILL(pA0,pA1,0); qkt(pA0,pA1,Kbase,qr,r32,hi);asm volatile("s_nop 15\n\ts_nop 7":"+v"(pA0),"+v"(pA1));CMASK(pA0,pA1,0);
  START(pA0,pA1);
  _Pragma("unroll") for(int r=0;r<16;++r)pA1[r]=__builtin_amdgcn_exp2f(pA1[r]);
  WAIT_BAR(0);
  DMA_K(3,0);DMA_C(3);DMA_V(1,SLOTB);
  ROT();
  kload8(kf,kp0+sl_cur);
  if(FOX){ WAIT_BAR(3); }else{ WAIT_BAR(2); }
  s16x4 vlo[NVB],vhi[NVB]; u32x4 pw0,pw1,pw2,pw3;
  #define PKW(P,B) cvtpk_s(P[B],P[B+1])
  #define PAF(k) __builtin_bit_cast(bf16x8,pw##k)
  #define VFR(j) (bf16x8){vlo[(j)%NVB][0],vlo[(j)%NVB][1],vlo[(j)%NVB][2],vlo[(j)%NVB][3],vhi[(j)%NVB][0],vhi[(j)%NVB][1],vhi[(j)%NVB][2],vhi[(j)%NVB][3]}
  #define PIN(x) asm volatile("":"+v"(x))
  #define MX3(a,b,c) __builtin_fmaxf(__builtin_fmaxf((a),(b)),(c))
  #define GAPA(MF,A0,A1,A2,A3,W0,W1,PW) do{ MF; sacc+=A0; sacc+=A1; sacc+=A2; sacc+=A3; PIN(sacc); W0; W1; PIN(PW); SBAR(); }while(0)
  #define EX(v) __builtin_amdgcn_exp2f(v)
  #define GAPB(MF,VR,X,B) do{ MF; VR; X[B]=EX(X[B]); X[B+1]=EX(X[B+1]); X[B+2]=EX(X[B+2]); X[B+3]=EX(X[B+3]); PIN(X); SBAR(); }while(0)
  #define VOFF(j) ((((j)&1)*4096)+(((j)>>1)*1024))
  #define VRD(j) do{ if((j)>=0&&(j)<8){ vlo[(j)%NVB]=vtr(vp_+VOFF(j)); vhi[(j)%NVB]=vtr(vp_+VOFF(j)+512); } }while(0)
  #define KRD(G,j) do{ if(G){ kload2(kf,kp0+sl_next,j); SBAR(); } }while(0)
  #define STEP(C0,C1,P0,P1,t,GK,GV,GL) do{ SBAR(); PREFILL(C0,C1,t); SBAR(); \
    const lds_cptr vp_=vp0+sl_prev; \
    VRD(0-(8-NVB)); SBAR(); float sacc=(P0[0]+P0[1]); \
    GAPA(C0=__builtin_amdgcn_mfma_f32_32x32x16_bf16(kf[0],qr[0],C0,0,0,0), P0[2],P0[3],P0[4],P0[5],     pw0[0]=PKW(P0,0), pw0[1]=PKW(P0,2), pw0); \
    VRD(1-(8-NVB)); SBAR(); GAPA(C1=__builtin_amdgcn_mfma_f32_32x32x16_bf16(kf[1],qr[0],C1,0,0,0), P0[6],P0[7],P0[8],P0[9],     pw0[2]=PKW(P0,4), pw0[3]=PKW(P0,6), pw0); \
    VRD(2-(8-NVB)); SBAR(); GAPA(C0=__builtin_amdgcn_mfma_f32_32x32x16_bf16(kf[2],qr[1],C0,0,0,0),   P0[10],P0[11],P0[12],P0[13], pw1[0]=PKW(P0,8), pw1[1]=PKW(P0,10), pw1); \
    VRD(3-(8-NVB)); SBAR(); GAPA(C1=__builtin_amdgcn_mfma_f32_32x32x16_bf16(kf[3],qr[1],C1,0,0,0),   P0[14],P0[15],P1[0],P1[1],   pw1[2]=PKW(P0,12),pw1[3]=PKW(P0,14), pw1); \
    VRD(4-(8-NVB)); SBAR(); GAPA(C0=__builtin_amdgcn_mfma_f32_32x32x16_bf16(kf[4],qr[2],C0,0,0,0),   P1[2],P1[3],P1[4],P1[5],     pw2[0]=PKW(P1,0), pw2[1]=PKW(P1,2), pw2); \
    VRD(5-(8-NVB)); SBAR(); GAPA(C1=__builtin_amdgcn_mfma_f32_32x32x16_bf16(kf[5],qr[2],C1,0,0,0),   P1[6],P1[7],P1[8],P1[9],     pw2[2]=PKW(P1,4), pw2[3]=PKW(P1,6), pw2); \
    VRD(6-(8-NVB)); SBAR(); GAPA(C0=__builtin_amdgcn_mfma_f32_32x32x16_bf16(kf[6],qr[3],C0,0,0,0),   P1[10],P1[11],P1[12],P1[13], pw3[0]=PKW(P1,8), pw3[1]=PKW(P1,10), pw3); \
    VRD(7-(8-NVB)); SBAR(); GAPA(C1=__builtin_amdgcn_mfma_f32_32x32x16_bf16(kf[7],qr[3],C1,0,0,0),   P1[14],P1[15],0.f,0.f,       pw3[2]=PKW(P1,12),pw3[3]=PKW(P1,14), pw3); \
    l_reg+=sacc; \
    if(GK){DMA_K((t)+3,sl_cur);DMA_C((t)+3);} if(GV){DMA_V((t)+1,sl_next);} \
    CMASK(C0,C1,t); \
    { float a=MX3(C0[0],C0[1],C1[0]),b=MX3(C0[2],C0[3],C1[1]); a=MX3(a,C1[2],C1[3]); \
      _Pragma("unroll") for(int r=4;r<16;r+=4){a=MX3(a,C0[r],C0[r+1]);b=MX3(b,C0[r+2],C0[r+3]);a=MX3(a,C1[r],C1[r+1]);b=MX3(b,C1[r+2],C1[r+3]);} \
      float rm=__builtin_fmaxf(a,b); { auto rr=__builtin_amdgcn_permlane32_swap(__float_as_uint(rm),__float_as_uint(rm),false,false); rm=__builtin_fmaxf(__uint_as_float(rr[0]),__uint_as_float(rr[1])); } \
      resc=false; \
      if(__builtin_expect(__any(rm>(float)THRL),0)){ const float dl=__builtin_fmaxf(rm,0.f); mhat+=dl; \
        _Pragma("unroll") for(int r=0;r<16;++r){C0[r]-=dl;C1[r]-=dl;} \
        const float f=__builtin_amdgcn_exp2f(-dl); l_reg*=f; if(hi==0)wsf[r32]=f; resc=true; } } \
    SBAR(); \
    GAPB(o[0]=__builtin_amdgcn_mfma_f32_32x32x16_bf16(PAF(0),VFR(0),o[0],0,0,0), VRD(0+NVB), C0,0); \
    GAPB(o[1]=__builtin_amdgcn_mfma_f32_32x32x16_bf16(PAF(0),VFR(1),o[1],0,0,0), VRD(1+NVB), C0,4); \
    KRD(GL,0); GAPB(o[0]=__builtin_amdgcn_mfma_f32_32x32x16_bf16(PAF(1),VFR(2),o[0],0,0,0), VRD(2+NVB), C0,8); \
    KRD(GL,1); GAPB(o[1]=__builtin_amdgcn_mfma_f32_32x32x16_bf16(PAF(1),VFR(3),o[1],0,0,0), VRD(3+NVB), C0,12); \
    KRD(GL,2); GAPB(o[0]=__builtin_amdgcn_mfma_f32_32x32x16_bf16(PAF(2),VFR(4),o[0],0,0,0), VRD(4+NVB), C1,0); \
    KRD(GL,3); GAPB(o[1]=__builtin_amdgcn_mfma_f32_32x32x16_bf16(PAF(2),VFR(5),o[1],0,0,0), VRD(5+NVB), C1,4); \
    GAPB(o[0]=__builtin_amdgcn_mfma_f32_32x32x16_bf16(PAF(3),VFR(6),o[0],0,0,0), VRD(6+NVB), C1,8); \
    GAPB(o[1]=__builtin_amdgcn_mfma_f32_32x32x16_bf16(PAF(3),VFR(7),o[1],0,0,0), VRD(7+NVB), C1,12); \
    }while(0)
  int t=1;
  #undef CMASK
  #define CMASK(P0,P1,t) do{}while(0)
  for(;t+5<NT;t+=2){
    STEP(pB0,pB1,pA0,pA1,t,true,true,true);     if(FOX){WAIT_BAR(3);}else{WAIT_BAR(2);} RESC(); ROT();
    STEP(pA0,pA1,pB0,pB1,t+1,true,true,true);   if(FOX){WAIT_BAR(3);}else{WAIT_BAR(2);} RESC(); ROT();
  }
  #undef CMASK
  #define CMASK(P0,P1,t) do{int jb_=(t)-(NT-4); if(!FOX||jb_>=0)cmask<!FOX>(P0,P1,jb_,qrel,hi);}while(0)
  #define ENDW(tt) do{ if((tt)+3<NT){ if(FOX){WAIT_BAR(3);}else{WAIT_BAR(2);} } else if((tt)+2<NT){WAIT_BAR(1);} else {WAIT_BAR(0);} }while(0)
  for(;t+1<NT;t+=2){
    STEP(pB0,pB1,pA0,pA1,t,(t+3<NT),(t+1<NT),(t+1<NT));       ENDW(t);   RESC(); ROT();
    STEP(pA0,pA1,pB0,pB1,t+1,(t+4<NT),(t+2<NT),(t+2<NT));     ENDW(t+1); RESC(); ROT();
  }
  STEP(pB0,pB1,pA0,pA1,NT-1,false,false,false); RESC();
  { float sacc=pB0[0]+pB0[1]; _Pragma("unroll") for(int r=2;r<16;++r)sacc+=pB0[r]; _Pragma("unroll") for(int r=0;r<16;++r)sacc+=pB1[r]; l_reg+=sacc;
    pw0=(u32x4){PKW(pB0,0),PKW(pB0,2),PKW(pB0,4),PKW(pB0,6)};pw1=(u32x4){PKW(pB0,8),PKW(pB0,10),PKW(pB0,12),PKW(pB0,14)};pw2=(u32x4){PKW(pB1,0),PKW(pB1,2),PKW(pB1,4),PKW(pB1,6)};pw3=(u32x4){PKW(pB1,8),PKW(pB1,10),PKW(pB1,12),PKW(pB1,14)};
    SBAR(); pv(o,vb0+sl_cur,PAF(0),PAF(1),PAF(2),PAF(3)); }
  #undef PKW
  #undef PAF
  #undef VFR
  #undef PIN
  #undef MX3
  #undef GAPA
  #undef GAPB
  #undef EX
  #undef VRD
  #undef VOFF
  #undef KRD
  #undef STEP
  #undef ENDW
  {auto rr=__builtin_amdgcn_permlane32_swap(__float_as_uint(l_reg),__float_as_uint(l_reg),false,false);l_reg=__uint_as_float(rr[0])+__uint_as_float(rr[1]);}
  if(!FOX) l_reg+=__builtin_amdgcn_exp2f(sink2-mhat);
  if(hi==0)wsf[32+r32]=l_reg;asm volatile("s_waitcnt lgkmcnt(0)":::"memory");
  float rli[16];
  #pragma unroll
  for(int r=0;r<16;++r)rli[r]=__builtin_amdgcn_rcpf(wsf[32+crow(r,hi)]);
  bf16*Ow=O+(rowbase+q0+wid*QBLK)*DM+h*D;
  { bf16*stg=(bf16*)(shm+LDS_OST)+wid*2048;
    #pragma unroll
    for(int r=0;r<16;++r){const int orow=crow(r,hi);
      #pragma unroll
      for(int d0=0;d0<2;++d0)stg[orow*64+d0*32+r32]=(bf16)(cvtpk_s(o[d0][r]*rli[r],0.f)&0xffffu);}
    asm volatile("s_waitcnt lgkmcnt(0)":::"memory");
    #pragma unroll
    for(int i=0;i<4;++i){const int row=i*8+(lane>>3),ch=lane&7; const u32x4 v=*(const u32x4*)(stg+row*64+ch*8); ATTN_STORE16(Ow+(long)row*DM+ch*8,v);} }
  asm volatile("s_waitcnt lgkmcnt(0)\n\ts_barrier":::"memory");
  #undef DMA_K
  #undef DMA_V
  #undef DMA_C
  #undef PREFILL
  #undef CMASK
  #undef START
  #undef RESC
  #undef ROT
}
constexpr int ATTN_LDS_BYTES=LDS_BYTES;
#undef SBAR
#undef WAIT_BAR
}

#ifndef NAIVE_SWA
#define NAIVE_SWA 0
#endif
#ifndef NAIVE_FOX
#define NAIVE_FOX 0
#endif
#define LAS __attribute__((address_space(3)))
typedef unsigned short bf16;
typedef float f32x4 __attribute__((ext_vector_type(4)));
typedef unsigned v4u __attribute__((ext_vector_type(4)));
typedef unsigned v2u __attribute__((ext_vector_type(2)));
constexpr int NWAVES = 8;
constexpr int RING_BYTES = 131072, LDS_BYTES = 147456;

__device__ __forceinline__ float wave_sum(float v) {
#pragma unroll
    for (int o = 1; o < 64; o <<= 1) v += __shfl_xor(v, o);
    return v;
}
#define LDS_WAIT() asm volatile("s_waitcnt lgkmcnt(0)" ::: "memory")

__device__ __forceinline__ void tr_item(const float* W, int K, int N, bf16* WT, int dst_row0, int src_col0, int nvalid, int kb, const float* kscale, LAS float* scr, int lane) {
    const int k0 = 64 * kb, c = lane & 31;
#pragma unroll 8
    for (int i = 0; i < 32; ++i) { const int kk = 2 * i + (lane >> 5); float v = 0.f; if (c < nvalid) v = W[(size_t)(k0 + kk) * N + src_col0 + c]; if (kscale) v *= kscale[k0 + kk]; scr[kk * 33 + c] = v; }
    LDS_WAIT(); asm volatile("" ::: "memory");
    const int ch = lane & 7;
#pragma unroll
    for (int j = 0; j < 4; ++j) { const int n = (lane >> 3) + 8 * j; const LAS float* s = scr + (8 * ch) * 33 + n;
        v4u o; o.x = pg8::cvt_pk_bf16(s[0 * 33], s[1 * 33]); o.y = pg8::cvt_pk_bf16(s[2 * 33], s[3 * 33]); o.z = pg8::cvt_pk_bf16(s[4 * 33], s[5 * 33]); o.w = pg8::cvt_pk_bf16(s[6 * 33], s[7 * 33]);
        *(v4u*)(WT + (size_t)(dst_row0 + n) * K + k0 + 8 * ch) = o; }
    LDS_WAIT(); asm volatile("" ::: "memory");
}
__device__ __forceinline__ void win_map(int db, int& src, int& nv) {
    const int pn = db >> 3, bj = (db >> 2) & 1, wc = db & 3; nv = 32;
    if (pn < 4) src = (4 * pn + wc) * 64 + 32 * bj;
    else if (pn == 4) src = (wc < 2 ? 1024 + wc * 64 : 1152 + (wc - 2) * 64) + 32 * bj;
    else if (pn < 17) { const int t = pn - 5; src = 1280 + (t >> 2) * 1024 + (4 * (t & 3) + wc) * 64 + 32 * bj; }
    else if (pn < 33) src = 4368 + (db - 136) * 32;
    else { src = 4352; nv = (db == 264) ? 16 : 0; }
}

struct Args { const float* x; const int* pos; const float* attn_norm; const float* w_in; const float* fbias; const float* sinks; const float* w_bs; const float* w_bf;
              const float* w_out; const float* mlp_norm; const float* w_up; const float* w_dn; const float* final_norm; float* out; unsigned char* ws; };

__device__ __forceinline__ void rms_row_to_bf16(const float* xrow, const float* gain, bf16* orow, int lane) {
    const f32x4* xr = (const f32x4*)xrow + lane; f32x4 v[8]; float s = 0.f;
#pragma unroll
    for (int j = 0; j < 8; ++j) { v[j] = xr[64 * j]; s += (v[j].x * v[j].x + v[j].y * v[j].y) + (v[j].z * v[j].z + v[j].w * v[j].w); }
    const float rstd = __builtin_amdgcn_rsqf(wave_sum(s) * (1.f / DM) + RMS_EPS);
    const f32x4* gr = (const f32x4*)gain + lane; v2u* o8 = (v2u*)orow + lane;
#pragma unroll
    for (int j = 0; j < 8; ++j) { const f32x4 g = gr[64 * j]; v2u w; w.x = pg8::cvt_pk_bf16(v[j].x * rstd * g.x, v[j].y * rstd * g.y); w.y = pg8::cvt_pk_bf16(v[j].z * rstd * g.z, v[j].w * rstd * g.w); o8[64 * j] = w; }
}

__device__ __forceinline__ void p0_prologue(const Args& a, LAS unsigned char* lds, int vcu, int G, int wave, int lane) {
    unsigned char* ws = a.ws;
    LAS float* scr = (LAS float*)(lds + wave * 16384);
    const int gw = vcu * NWAVES + wave, NGW = G * NWAVES;
    constexpr int I_IN = (NIN / 32) * (DM / 64), I_BS = (DM / 32) * (1024 / 64), I_OUT = (DM / 32) * (DM / 64), I_UP = (DFF / 32) * (DM / 64), I_DN = (DM / 32) * (DFF / 64);
    constexpr int NITEMS = I_IN + 2 * I_BS + I_OUT + I_UP + I_DN;
    for (int it = gw; it < NITEMS; it += NGW) {
        int r = it;
        if (r < I_IN) { const int db = r / (DM / 64), kb = r % (DM / 64); int src, nv; win_map(db, src, nv); tr_item(a.w_in, DM, DIN, (bf16*)(ws + WS_WIN), db * 32, src, nv, kb, nullptr, scr, lane); continue; } r -= I_IN;
        if (r < I_BS) { const int db = r / 16, kb = r % 16; tr_item(a.w_bs, 1024, DM, (bf16*)(ws + WS_WBS), db * 32, db * 32, 32, kb, nullptr, scr, lane); continue; } r -= I_BS;
        if (r < I_BS) { const int db = r / 16, kb = r % 16; tr_item(a.w_bf, 1024, DM, (bf16*)(ws + WS_WBF), db * 32, db * 32, 32, kb, nullptr, scr, lane); continue; } r -= I_BS;
        if (r < I_OUT) { const int db = r / 32, kb = r % 32; tr_item(a.w_out, DM, DM, (bf16*)(ws + WS_WOUT), db * 32, db * 32, 32, kb, nullptr, scr, lane); continue; } r -= I_OUT;
        if (r < I_UP) { const int db = r / 32, kb = r % 32; tr_item(a.w_up, DM, DFF, (bf16*)(ws + WS_WUP), db * 32, db * 32, 32, kb, a.mlp_norm, scr, lane); continue; } r -= I_UP;
        { const int db = r / 128, kb = r % 128; tr_item(a.w_dn, DFF, DM, (bf16*)(ws + WS_WDN), db * 32, db * 32, 32, kb, nullptr, scr, lane); }
    }
    for (int m = gw; m < M; m += NGW) rms_row_to_bf16(a.x + (size_t)m * DM, a.attn_norm, (bf16*)(ws + WS_XN) + (size_t)m * DM, lane);
    float* cs = (float*)(ws + WS_CS);
    for (int e = gw * 64 + lane; e < M * 32; e += NGW * 64) {
        const int tok = e >> 5, i = e & 31;
        const float inv_freq = powf(10000.0f, -(float)(2 * i) / 64.0f);
        const float ang = (float)a.pos[tok] * inv_freq;
        double rev = (double)ang * 0.15915494309189535; rev -= floor(rev);
        const float rf = (float)rev;
        cs[e] = __builtin_amdgcn_cosf(rf); cs[(size_t)M * 32 + e] = __builtin_amdgcn_sinf(rf);
    }
}

__device__ __forceinline__ void cumsum_unit(const Args& a, int bh, LAS unsigned char* lds) {
    const float* FL = (const float*)(a.ws + WS_FL); float* Cp = (float*)(a.ws + WS_C);
    LAS double* sh = (LAS double*)lds;
    const int b = bh >> 4, h = bh & 15, tid = threadIdx.x, s0 = tid * 16; const float fb = a.fbias[h];
    float ls[16]; double run = 0.0;
#pragma unroll
    for (int i = 0; i < 16; ++i) { const float z = FL[(size_t)(b * SEQ + s0 + i) * 16 + h] + fb; const float v = fminf(z, 0.f) - log1pf(expf(-fabsf(z))); ls[i] = v; run += (double)v; }
    sh[tid] = run; __syncthreads();
    double pre = 0.0; for (int k = 0; k < tid; ++k) pre += sh[k];
#pragma unroll
    for (int i = 0; i < 16; ++i) { pre += (double)ls[i]; Cp[(size_t)bh * SEQ + s0 + i] = (float)(pre * 1.4426950408889634); }
    __syncthreads();
}

__device__ __forceinline__ void naive_swa_unit(const Args& a, int unit) {
    const bf16* AQ = (const bf16*)(a.ws + WS_AQ); const bf16* AK = (const bf16*)(a.ws + WS_AK); const bf16* AV = (const bf16*)(a.ws + WS_AV); bf16* OA = (bf16*)(a.ws + WS_AQ);
    const int tid = threadIdx.x, head = tid & 15, tok = unit * 32 + (tid >> 4), b = tok / SEQ, s = tok % SEQ, kvh = head >> 3;
    float q[64], o[64]; float m = -INFINITY, l = 0.f;
    { const v4u* qp = (const v4u*)(AQ + (size_t)tok * 1024 + head * 64);
#pragma unroll
      for (int c = 0; c < 8; ++c) { const v4u w = qp[c];
#pragma unroll
          for (int e = 0; e < 4; ++e) { q[8 * c + 2 * e] = pg8::bf_lo(w[e]); q[8 * c + 2 * e + 1] = pg8::bf_hi(w[e]); } } }
#pragma unroll
    for (int d = 0; d < 64; ++d) o[d] = 0.f;
    for (int i = 0; i < 128; ++i) {
        const int j = s - i; const bool valid = j >= 0; const int jj = valid ? j : 0;
        const v4u* kp = (const v4u*)(AK + (size_t)(b * SEQ + jj) * 128 + kvh * 64); const v4u* vp = (const v4u*)(AV + (size_t)(b * SEQ + jj) * 128 + kvh * 64);
        float dot = 0.f;
#pragma unroll
        for (int c = 0; c < 8; ++c) { const v4u w = kp[c];
#pragma unroll
            for (int e = 0; e < 4; ++e) { dot += q[8 * c + 2 * e] * pg8::bf_lo(w[e]); dot += q[8 * c + 2 * e + 1] * pg8::bf_hi(w[e]); } }
        const float lg = valid ? dot : -INFINITY;
        const float mn = fmaxf(m, lg), al = __builtin_amdgcn_exp2f(m - mn), p = __builtin_amdgcn_exp2f(lg - mn);
        l = l * al + p; m = mn;
#pragma unroll
        for (int c = 0; c < 8; ++c) { const v4u w = vp[c];
#pragma unroll
            for (int e = 0; e < 4; ++e) { o[8 * c + 2 * e] = o[8 * c + 2 * e] * al + p * pg8::bf_lo(w[e]); o[8 * c + 2 * e + 1] = o[8 * c + 2 * e + 1] * al + p * pg8::bf_hi(w[e]); } }
    }
    { const float sk = a.sinks[head] * LOG2E; const float m2 = fmaxf(m, sk), al = __builtin_amdgcn_exp2f(m - m2); l = l * al + __builtin_amdgcn_exp2f(sk - m2);
      const float rl = al / l;
      v4u* op = (v4u*)(OA + (size_t)tok * 1024 + head * 64);
#pragma unroll
      for (int c = 0; c < 8; ++c) { v4u w;
#pragma unroll
          for (int e = 0; e < 4; ++e) w[e] = pg8::cvt_pk_bf16(o[8 * c + 2 * e] * rl, o[8 * c + 2 * e + 1] * rl);
          op[c] = w; } }
}
__device__ __forceinline__ void naive_fox_unit(const Args& a, int bh, int qblk) {
    const bf16* FQ = (const bf16*)(a.ws + WS_FQ); const bf16* FK = (const bf16*)(a.ws + WS_FK); const bf16* FV = (const bf16*)(a.ws + WS_FV); bf16* OB = (bf16*)(a.ws + WS_FQ);
    const float* Cp = (const float*)(a.ws + WS_C) + (size_t)bh * SEQ;
    const int tid = threadIdx.x, b = bh >> 4, h = bh & 15, s = qblk * 512 + tid; const size_t tok = (size_t)b * SEQ + s;
    float q[64], o[64]; float m = -INFINITY, l = 0.f;
    { const v4u* qp = (const v4u*)(FQ + tok * 1024 + h * 64);
#pragma unroll
      for (int c = 0; c < 8; ++c) { const v4u w = qp[c];
#pragma unroll
          for (int e = 0; e < 4; ++e) { q[8 * c + 2 * e] = pg8::bf_lo(w[e]); q[8 * c + 2 * e + 1] = pg8::bf_hi(w[e]); } } }
#pragma unroll
    for (int d = 0; d < 64; ++d) o[d] = 0.f;
    const float cq = Cp[s];
    const int jend = __builtin_amdgcn_readfirstlane(qblk * 512 + (tid | 63));
    for (int j = 0; j <= jend; ++j) {
        const v4u* kp = (const v4u*)(FK + ((size_t)b * SEQ + j) * 1024 + h * 64); const v4u* vp = (const v4u*)(FV + ((size_t)b * SEQ + j) * 1024 + h * 64);
        float dot = 0.f;
#pragma unroll
        for (int c = 0; c < 8; ++c) { const v4u w = kp[c];
#pragma unroll
            for (int e = 0; e < 4; ++e) { dot += q[8 * c + 2 * e] * pg8::bf_lo(w[e]); dot += q[8 * c + 2 * e + 1] * pg8::bf_hi(w[e]); } }
        float lg = dot + (cq - Cp[j]); lg = (j <= s) ? lg : -INFINITY;
        const float mn = fmaxf(m, lg), al = __builtin_amdgcn_exp2f(m - mn), p = __builtin_amdgcn_exp2f(lg - mn);
        l = l * al + p; m = mn;
#pragma unroll
        for (int c = 0; c < 8; ++c) { const v4u w = vp[c];
#pragma unroll
            for (int e = 0; e < 4; ++e) { o[8 * c + 2 * e] = o[8 * c + 2 * e] * al + p * pg8::bf_lo(w[e]); o[8 * c + 2 * e + 1] = o[8 * c + 2 * e + 1] * al + p * pg8::bf_hi(w[e]); } }
    }
    { const float rl = 1.0f / l; v4u* op = (v4u*)(OB + tok * 1024 + h * 64);
#pragma unroll
      for (int c = 0; c < 8; ++c) { v4u w;
#pragma unroll
          for (int e = 0; e < 4; ++e) w[e] = pg8::cvt_pk_bf16(o[8 * c + 2 * e] * rl, o[8 * c + 2 * e + 1] * rl);
          op[c] = w; } }
}

__global__ void __launch_bounds__(NWAVES * 64, 2) mega_fwd(Args a) {
    extern __shared__ __attribute__((aligned(16))) unsigned char lds_raw[];
    LAS unsigned char* lds = (LAS unsigned char*)lds_raw;
    cg::grid_group grid = cg::this_grid();
    int tid_ = threadIdx.x; asm volatile("" : "+v"(tid_));
    const int tid = tid_, lane = tid & 63, wave = __builtin_amdgcn_readfirstlane(tid >> 6);
    const int G = gridDim.x, bx = blockIdx.x, vcu = (G % 8 == 0) ? (bx % 8) * (G / 8) + bx / 8 : bx;
    unsigned char* ws = a.ws;
    float* SS1 = (float*)(ws + WS_CTL); float* SS2 = SS1 + M;
#define GRID_SYNC() do { __threadfence(); grid.sync(); __threadfence(); } while (0)

    p0_prologue(a, lds, vcu, G, wave, lane);
    GRID_SYNC();

    {
        pg8::Gemm g{(const bf16*)(ws + WS_XN), (const bf16*)(ws + WS_WIN), nullptr, nullptr, DM};
        pg8::StaticOrder S; S.init(M, NIN, G, bx);
        pg8::EpiIn E{ws};
        pg8::gemm_phase<pg8::EpiIn, pg8::StaticOrder, true, true>(lds, g, S, E);
    }
    GRID_SYNC();

    for (int u = bx; u < 64; u += G) cumsum_unit(a, u, lds);
#if NAIVE_SWA
    for (int u = bx; u < M / 32; u += G) naive_swa_unit(a, u);
#else
    for (int u = vcu; u < 2048; u += G) { const int bh = u >> 5, qb = u & 31, b_ = bh >> 4, h_ = bh & 15;
        attn_body::attn_unit<8, false, 128>(b_, h_, qb, (const bf16*)(ws + WS_AQ), (const bf16*)(ws + WS_AK), (const bf16*)(ws + WS_AV), (bf16*)(ws + WS_AQ), nullptr, a.sinks[h_] * LOG2E, (char*)lds_raw); }
#endif
    GRID_SYNC();

#if NAIVE_FOX
    for (int u = bx; u < 1024; u += G) { const int r = u >> 6, i = r >> 2, hi4 = r & 3, qblk = (i & 1) ? 4 * i + 3 - hi4 : 4 * i + hi4; naive_fox_unit(a, u & 63, qblk); }
#else
    for (int e = vcu; e < 2048; e += G) { const int cuv = e & 255, i = e >> 8, bh = (cuv >> 3) + 32 * (i >> 2), s_ = cuv & 7, k_ = i & 3, qb = k_ == 0 ? s_ : (k_ == 1 ? 15 - s_ : (k_ == 2 ? 16 + s_ : 31 - s_));
        attn_body::attn_unit<8, true, 1024>(bh >> 4, bh & 15, qb, (const bf16*)(ws + WS_FQ), (const bf16*)(ws + WS_FK), (const bf16*)(ws + WS_FV), (bf16*)(ws + WS_FQ), (const float*)(ws + WS_C) + (size_t)bh * SEQ, 0.f, (char*)lds_raw); }
#endif
    GRID_SYNC();

    {
        pg8::Gemm g{(const bf16*)(ws + WS_AQ), (const bf16*)(ws + WS_WBS), (const bf16*)(ws + WS_FQ), (const bf16*)(ws + WS_WBF), 1024};
        pg8::PairOrder S; S.s.init(M, DM, G, bx);
        pg8::EpiBranch E{(const bf16*)(ws + WS_G), (bf16*)(ws + WS_MG)};
        pg8::gemm_phase<pg8::EpiBranch, pg8::PairOrder, true, true>(lds, g, S, E);
    }
    GRID_SYNC();

    {
        pg8::Gemm g{(const bf16*)(ws + WS_MG), (const bf16*)(ws + WS_WOUT), nullptr, nullptr, DM};
        pg8::StaticOrder S; S.init(M, DM, G, bx);
        pg8::EpiRes<true> E{a.x, a.out, (bf16*)(ws + WS_X1B), SS1};
        pg8::gemm_phase<pg8::EpiRes<true>, pg8::StaticOrder, true, true>(lds, g, S, E);
    }
    GRID_SYNC();

    {
        pg8::Gemm g{(const bf16*)(ws + WS_X1B), (const bf16*)(ws + WS_WUP), nullptr, nullptr, DM};
        pg8::StaticOrder S; S.init(M, DFF, G, bx);
        pg8::EpiUp E{SS1, (bf16*)(ws + WS_U)};
        pg8::gemm_phase<pg8::EpiUp, pg8::StaticOrder, true, true>(lds, g, S, E);
    }
    GRID_SYNC();

    {
        pg8::Gemm g{(const bf16*)(ws + WS_U), (const bf16*)(ws + WS_WDN), nullptr, nullptr, DFF};
        pg8::StaticOrder S; S.init(M, DM, G, bx);
        pg8::EpiRes<false> E{a.out, a.out, nullptr, SS2};
        pg8::gemm_phase<pg8::EpiRes<false>, pg8::StaticOrder, true, true>(lds, g, S, E);
    }
    GRID_SYNC();

    {
        const int gw = vcu * NWAVES + wave, NGW = G * NWAVES;
        for (int m = gw; m < M; m += NGW) {
            const float rstd = __builtin_amdgcn_rsqf(SS2[m] * (1.f / DM) + RMS_EPS);
            f32x4* xr = (f32x4*)(a.out + (size_t)m * DM) + lane; const f32x4* gr = (const f32x4*)a.final_norm + lane;
#pragma unroll
            for (int j = 0; j < 8; ++j) { const f32x4 v = xr[64 * j], g = gr[64 * j]; xr[64 * j] = v * rstd * g; }
        }
    }
}

extern "C" void kernel_launch(void* const* d_in, const int* in_sizes, int n_in, void* d_out, int out_size, void* d_ws, size_t ws_size, hipStream_t stream) {
    static int grid = 0;
    if (grid == 0) {
        if (n_in != 13 || in_sizes[0] != M * DM || out_size != M * DM || ws_size < WS_END) { fprintf(stderr, "kernel_launch: unexpected shapes (n_in %d, in0 %d, out %d, ws %zu)\n", n_in, n_in > 0 ? in_sizes[0] : -1, out_size, ws_size); grid = -1; return; }
        int dev = 0, cus = 0, per_cu = 0;
        if (hipGetDevice(&dev) != hipSuccess || hipDeviceGetAttribute(&cus, hipDeviceAttributeMultiprocessorCount, dev) != hipSuccess) { grid = -1; return; }
        if (hipFuncSetAttribute((const void*)mega_fwd, hipFuncAttributeMaxDynamicSharedMemorySize, LDS_BYTES) != hipSuccess) { fprintf(stderr, "kernel_launch: hipFuncSetAttribute failed\n"); grid = -1; return; }
        if (hipOccupancyMaxActiveBlocksPerMultiprocessor(&per_cu, (const void*)mega_fwd, NWAVES * 64, LDS_BYTES) != hipSuccess || per_cu < 1) { fprintf(stderr, "kernel_launch: occupancy query says %d\n", per_cu); per_cu = 1; }
        (void)hipGetLastError();
        grid = cus * 1;
    }
    if (grid < 0) return;
    (void)hipMemsetAsync((char*)d_ws + WS_CTL, 0, CTL_ZERO_BYTES, stream);
    Args a{};
    a.x = (const float*)d_in[0]; a.pos = (const int*)d_in[1]; a.attn_norm = (const float*)d_in[2]; a.w_in = (const float*)d_in[3]; a.fbias = (const float*)d_in[4]; a.sinks = (const float*)d_in[5];
    a.w_bs = (const float*)d_in[6]; a.w_bf = (const float*)d_in[7]; a.w_out = (const float*)d_in[8]; a.mlp_norm = (const float*)d_in[9]; a.w_up = (const float*)d_in[10]; a.w_dn = (const float*)d_in[11];
    a.final_norm = (const float*)d_in[12]; a.out = (float*)d_out; a.ws = (unsigned char*)d_ws;
    void* kargs[] = {&a};
    const hipError_t le = hipLaunchCooperativeKernel((const void*)mega_fwd, dim3(grid), dim3(NWAVES * 64), kargs, LDS_BYTES, stream);
    if (le != hipSuccess) fprintf(stderr, "kernel_launch: cooperative launch failed: %s (grid %d)\n", hipGetErrorString(le), grid);
}
```

```cpp
#include <hip/hip_runtime.h>
#include <hip/hip_cooperative_groups.h>
#include <cstdio>
#include <cstdint>
namespace cg = cooperative_groups;

constexpr int BATCH = 4, SEQ = 8192, DM = 2048, M = BATCH * SEQ, DFF = 8192, NIN = 8704  , DIN = 8464;
constexpr float RMS_EPS = 1e-6f;
constexpr float LOG2E = 1.4426950408889634f;
constexpr float C2 = 0.125f * 1.4426950408889634f;

constexpr size_t MiB = 1u << 20;
constexpr size_t WS_CTL = 0, CTL_ZERO_BYTES = 1 * MiB;
constexpr size_t WS_WIN = 1 * MiB, WS_WBS = 35 * MiB, WS_WBF = 39 * MiB, WS_WOUT = 43 * MiB, WS_WUP = 51 * MiB, WS_WDN = 83 * MiB;
constexpr size_t WS_CS = 115 * MiB;
constexpr size_t WS_FL = 123 * MiB, WS_C = 125 * MiB;
constexpr size_t WS_FK = 128 * MiB, WS_FV = 192 * MiB, WS_X1B = 128 * MiB;
constexpr size_t WS_XN = 256 * MiB, WS_MG = 256 * MiB;
constexpr size_t WS_AQ = 384 * MiB, WS_FQ = 448 * MiB, WS_G = 512 * MiB;
constexpr size_t WS_U = 256 * MiB;
constexpr size_t WS_AK = 768 * MiB, WS_AV = 776 * MiB, WS_OA = 784 * MiB, WS_OB = 848 * MiB, WS_END = 912 * MiB;

namespace pg8 {
#define PG8_LAS __attribute__((address_space(3)))
typedef unsigned short bf16_t;
typedef short bf16x8 __attribute__((ext_vector_type(8)));
typedef float f32x4 __attribute__((ext_vector_type(4)));
typedef unsigned u32x4 __attribute__((ext_vector_type(4)));
typedef unsigned u32x2 __attribute__((ext_vector_type(2)));
constexpr int BM = 256, BK = 64, HALF = 128, HTB = HALF * BK * 2  , STAGE_BYTES = 8 * HTB, NXCD = 8, WGM = 8;

__host__ __device__ __forceinline__ int lds_byte(int r, int c) { const int st = (r >> 4) * 2 + (c >> 5), rr = r & 15, cc = c & 31, ob = rr * 64 + cc * 2; return st * 1024 + (ob ^ (((ob >> 9) & 1) << 5)); }
__host__ __device__ __forceinline__ void stage_rc(int b, int& R, int& C) { const int st = b / 1024, sb = b % 1024, swz = sb ^ (((sb >> 9) & 1) << 5); R = (st >> 1) * 16 + swz / 64; C = (st & 1) * 32 + (swz % 64) / 2; }
__host__ __device__ __forceinline__ int perm32(int rho) { const int n = rho >> 4, i = rho & 15; return 8 * (i >> 2) + 4 * n + (i & 3); }

struct Unit { int pm, pn, z; };
struct Gemm { const bf16_t* A0; const bf16_t* B0; const bf16_t* A1; const bf16_t* B1; int K; };

struct StaticOrder {
    int nM, nN, nwg, G, c;
    __host__ __device__ void init(int M_, int N_, int G_, int c_) { nM = M_ / BM; nN = N_ / BM; nwg = nM * nN; G = G_; c = c_; }
    __host__ __device__ bool next(int i, Unit& u) const {
        const long L = (long)i * G + c; if (L >= nwg) return false;
        int wgid = (int)L; { const int q = nwg / NXCD, r = nwg % NXCD, xcd = wgid % NXCD, off = wgid / NXCD; wgid = (xcd < r ? xcd * (q + 1) : r * (q + 1) + (xcd - r) * q) + off; }
        const int nig = WGM * nN, gid = wgid / nig, fm = gid * WGM, gsz = (nM - fm) < WGM ? (nM - fm) : WGM;
        u.pm = fm + ((wgid % nig) % gsz); u.pn = (wgid % nig) / gsz; u.z = 0; return true;
    }
};
struct PairOrder {
    StaticOrder s;
    __host__ __device__ bool next(int i, Unit& u) const { const bool ok = s.next(i >> 1, u); u.z = i & 1; return ok; }
};

__device__ __forceinline__ unsigned cvt_pk_bf16(float lo, float hi) { unsigned r; asm("v_cvt_pk_bf16_f32 %0, %1, %2" : "=v"(r) : "v"(lo), "v"(hi)); return r; }
__device__ __forceinline__ float bf_lo(unsigned w) { return __uint_as_float(w << 16); }
__device__ __forceinline__ float bf_hi(unsigned w) { return __uint_as_float(w & 0xffff0000u); }
__device__ __forceinline__ float sigmoidf_(float x) { return __builtin_amdgcn_rcpf(1.0f + __builtin_amdgcn_exp2f(-x * LOG2E)); }


struct EpiIn {
    static constexpr bool PERM = true;
    unsigned char* ws;
    __device__ __forceinline__ bool keep(const Unit&) const { return false; }
    __device__ __forceinline__ void operator()(f32x4 (&acc)[2][2][4][2], const Unit& u, int wr, int wc, int fr, int fq) const {
        const int pn = u.pn; const int row0 = u.pm * BM + wr * 64 + fr;
        if (pn <= 16) {
            size_t doff; int pitch, colbase; bool rope = false; float sc = 1.f;
            if (pn < 4) { doff = WS_AQ; pitch = 1024; colbase = (4 * pn + wc) * 64; rope = true; sc = C2; }
            else if (pn == 4) { if (wc < 2) { doff = WS_AK; pitch = 128; colbase = wc * 64; rope = true; } else { doff = WS_AV; pitch = 128; colbase = (wc - 2) * 64; } }
            else { const int t = pn - 5, seg = t >> 2, tin = t & 3; doff = WS_FQ; if (seg == 1) doff = WS_FK; if (seg == 2) doff = WS_FV; pitch = 1024; colbase = (4 * tin + wc) * 64; sc = seg == 0 ? C2 : 1.f; }
            bf16_t* dst = (bf16_t*)(ws + doff); const float* cs = (const float*)(ws + WS_CS);
#pragma unroll
            for (int ai = 0; ai < 2; ++ai)
#pragma unroll
                for (int m = 0; m < 4; ++m) {
                    const int row = row0 + ai * HALF + m * 16;
                    f32x4 v00 = acc[ai][0][m][0], v01 = acc[ai][0][m][1], v10 = acc[ai][1][m][0], v11 = acc[ai][1][m][1];
                    if (rope) {
                        const float* cp = cs + (size_t)row * 32 + 8 * fq; const float* sp = cp + (size_t)M * 32;
                        const f32x4 c0 = *(const f32x4*)cp, c1 = *(const f32x4*)(cp + 4), s0 = *(const f32x4*)sp, s1 = *(const f32x4*)(sp + 4);
                        const f32x4 o00 = v00 * c0 - v10 * s0, o10 = v10 * c0 + v00 * s0, o01 = v01 * c1 - v11 * s1, o11 = v11 * c1 + v01 * s1;
                        v00 = o00; v10 = o10; v01 = o01; v11 = o11;
                    }
                    v00 = v00 * sc; v01 = v01 * sc; v10 = v10 * sc; v11 = v11 * sc;
                    bf16_t* rp = dst + (size_t)row * pitch + colbase + 8 * fq;
                    u32x4 w0, w1;
                    w0.x = cvt_pk_bf16(v00[0], v00[1]); w0.y = cvt_pk_bf16(v00[2], v00[3]); w0.z = cvt_pk_bf16(v01[0], v01[1]); w0.w = cvt_pk_bf16(v01[2], v01[3]);
                    w1.x = cvt_pk_bf16(v10[0], v10[1]); w1.y = cvt_pk_bf16(v10[2], v10[3]); w1.z = cvt_pk_bf16(v11[0], v11[1]); w1.w = cvt_pk_bf16(v11[2], v11[3]);
                    *(u32x4*)rp = w0; *(u32x4*)(rp + 32) = w1;
                }
        } else if (pn <= 32) {
            const int col0 = (pn - 17) * BM + wc * 32 + 8 * fq;
#pragma unroll
            for (int ai = 0; ai < 2; ++ai)
#pragma unroll
                for (int m = 0; m < 4; ++m) {
                    bf16_t* rp = (bf16_t*)(ws + WS_G) + (size_t)(row0 + ai * HALF + m * 16) * 4096 + col0;
#pragma unroll
                    for (int bj = 0; bj < 2; ++bj) {
                        const f32x4 a = acc[ai][bj][m][0], b = acc[ai][bj][m][1]; u32x4 w;
                        float s[8];
#pragma unroll
                        for (int i = 0; i < 4; ++i) { s[i] = fmaxf(sigmoidf_(a[i]), 1e-30f); s[4 + i] = fmaxf(sigmoidf_(b[i]), 1e-30f); }
                        w.x = cvt_pk_bf16(s[0], s[1]); w.y = cvt_pk_bf16(s[2], s[3]); w.z = cvt_pk_bf16(s[4], s[5]); w.w = cvt_pk_bf16(s[6], s[7]);
                        *(u32x4*)(rp + bj * HALF) = w;
                    }
                }
        } else {
            if (wc == 0 && fq < 2) {
#pragma unroll
                for (int ai = 0; ai < 2; ++ai)
#pragma unroll
                    for (int m = 0; m < 4; ++m) {
                        float* rp = (float*)(ws + WS_FL) + (size_t)(row0 + ai * HALF + m * 16) * 16 + 8 * fq;
                        *(f32x4*)rp = acc[ai][0][m][0]; *(f32x4*)(rp + 4) = acc[ai][0][m][1];
                    }
            }
        }
    }
};

struct EpiBranch {
    static constexpr bool PERM = true;
    const bf16_t* G; bf16_t* MG;
    __device__ __forceinline__ bool keep(const Unit& u) const { return u.z == 0; }
    __device__ __forceinline__ void operator()(f32x4 (&acc)[2][2][4][2], const Unit& u, int wr, int wc, int fr, int fq) const {
        const int row0 = u.pm * BM + wr * 64 + fr, col0 = u.pn * BM + wc * 32 + 8 * fq; const int z = u.z;
#pragma unroll
        for (int ai = 0; ai < 2; ++ai)
#pragma unroll
            for (int m = 0; m < 4; ++m) {
                const size_t row = (size_t)(row0 + ai * HALF + m * 16);
#pragma unroll
                for (int bj = 0; bj < 2; ++bj) {
                    const bf16_t* gp = G + row * 4096 + col0 + bj * HALF;
                    const u32x4 gb = *(const u32x4*)(gp + 2048);
                    float sb[8];
#pragma unroll
                    for (int i = 0; i < 4; ++i) { sb[2 * i] = bf_lo(gb[i]); sb[2 * i + 1] = bf_hi(gb[i]); }
                    if (z == 0) {
                        const u32x4 ga = *(const u32x4*)gp;
#pragma unroll
                        for (int i = 0; i < 4; ++i) {
                            const float r0 = bf_lo(ga[i]) * __builtin_amdgcn_rcpf(sb[2 * i]), r1 = bf_hi(ga[i]) * __builtin_amdgcn_rcpf(sb[2 * i + 1]);
                            const int e0 = 2 * i, e1 = 2 * i + 1;
                            acc[ai][bj][m][e0 >> 2][e0 & 3] *= r0; acc[ai][bj][m][e1 >> 2][e1 & 3] *= r1;
                        }
                    } else {
                        const f32x4 a = acc[ai][bj][m][0], b = acc[ai][bj][m][1]; u32x4 w;
                        w.x = cvt_pk_bf16(a[0] * sb[0], a[1] * sb[1]); w.y = cvt_pk_bf16(a[2] * sb[2], a[3] * sb[3]);
                        w.z = cvt_pk_bf16(b[0] * sb[4], b[1] * sb[5]); w.w = cvt_pk_bf16(b[2] * sb[6], b[3] * sb[7]);
                        *(u32x4*)(MG + row * 2048 + col0 + bj * HALF) = w;
                    }
                }
            }
    }
};

template <bool WRITE_BF> struct EpiRes {
    static constexpr bool PERM = false;
    const float* base; float* out; bf16_t* xb; float* ss;
    __device__ __forceinline__ bool keep(const Unit&) const { return false; }
    __device__ __forceinline__ void operator()(f32x4 (&acc)[2][2][4][2], const Unit& u, int wr, int wc, int fr, int fq) const {
        const int row0 = u.pm * BM + wr * 64 + fr, col0 = u.pn * BM + wc * 32 + 4 * fq;
#pragma unroll
        for (int ai = 0; ai < 2; ++ai)
#pragma unroll
            for (int m = 0; m < 4; ++m) {
                const size_t row = (size_t)(row0 + ai * HALF + m * 16); const size_t off = row * DM + col0; float q = 0.f;
#pragma unroll
                for (int bj = 0; bj < 2; ++bj)
#pragma unroll
                    for (int n = 0; n < 2; ++n) {
                        const size_t o = off + bj * HALF + n * 16;
                        const f32x4 v = *(const f32x4*)(base + o) + acc[ai][bj][m][n];
                        *(f32x4*)(out + o) = v; q += (v[0] * v[0] + v[1] * v[1]) + (v[2] * v[2] + v[3] * v[3]);
                        if (WRITE_BF) { u32x2 w; w.x = cvt_pk_bf16(v[0], v[1]); w.y = cvt_pk_bf16(v[2], v[3]); *(u32x2*)(xb + o) = w; }
                    }
                q += __shfl_xor(q, 16); q += __shfl_xor(q, 32);
                if (fq == 0) atomicAdd(ss + row, q);
            }
    }
};

struct EpiUp {
    static constexpr bool PERM = true;
    const float* ss; bf16_t* U;
    __device__ __forceinline__ bool keep(const Unit&) const { return false; }
    __device__ __forceinline__ void operator()(f32x4 (&acc)[2][2][4][2], const Unit& u, int wr, int wc, int fr, int fq) const {
        const int row0 = u.pm * BM + wr * 64 + fr, col0 = u.pn * BM + wc * 32 + 8 * fq;
#pragma unroll
        for (int ai = 0; ai < 2; ++ai)
#pragma unroll
            for (int m = 0; m < 4; ++m) {
                const size_t row = (size_t)(row0 + ai * HALF + m * 16);
                const float rstd = __builtin_amdgcn_rsqf(ss[row] * (1.0f / DM) + RMS_EPS);
#pragma unroll
                for (int bj = 0; bj < 2; ++bj) {
                    f32x4 a = acc[ai][bj][m][0] * rstd, b = acc[ai][bj][m][1] * rstd; u32x4 w;
#pragma unroll
                    for (int i = 0; i < 4; ++i) { a[i] = fmaxf(a[i], 0.f); a[i] *= a[i]; b[i] = fmaxf(b[i], 0.f); b[i] *= b[i]; }
                    w.x = cvt_pk_bf16(a[0], a[1]); w.y = cvt_pk_bf16(a[2], a[3]); w.z = cvt_pk_bf16(b[0], b[1]); w.w = cvt_pk_bf16(b[2], b[3]);
                    *(u32x4*)(U + row * DFF + col0 + bj * HALF) = w;
                }
            }
    }
};

template <class Epi, class Sched, bool ALIGN_EPI = false, bool SP2 = false>
__device__ __forceinline__ void gemm_phase(PG8_LAS unsigned char* lds, const Gemm g, const Sched& S, const Epi& E) {
    int tid_ = threadIdx.x; asm volatile("" : "+v"(tid_));
    const int tid = tid_, wid = __builtin_amdgcn_readfirstlane(tid >> 6), lane = tid & 63, wr = wid >> 2, wc = wid & 3, fr = lane & 15, fq = lane >> 4;
    const int K = g.K, nt = K / BK;
    unsigned voffA[2], voffB[2];
#pragma unroll
    for (int i = 0; i < 2; ++i) { int R, C; stage_rc(tid * 16 + i * 8192, R, C); const int Rb = Epi::PERM ? ((R & ~31) + perm32(R & 31)) : R;
        voffA[i] = (unsigned)(R * K + C) * 2u; voffB[i] = (unsigned)(Rb * K + C) * 2u; }
    const size_t kstep = (size_t)(BK * 2);
    const size_t hstep = (size_t)HALF * K * 2;
    const size_t tstep = 2 * hstep;
    const unsigned ldsw = (unsigned)wid * 1024u;
    const int aoff = lds_byte(wr * 64 + fr, fq * 8), boff = lds_byte(wc * 32 + fr, fq * 8);
#define PG8_SA(b, h) (((b) * 2 + (h)) * HTB)
#define PG8_SB(b, h) ((4 + (b) * 2 + (h)) * HTB)
#define PG8_STAGE(bufoff, gbase, voff) do { _Pragma("unroll") for (int _i = 0; _i < 2; ++_i) \
        __builtin_amdgcn_global_load_lds((const unsigned*)((const char*)(gbase) + (voff)[_i]), (PG8_LAS unsigned*)(lds + (bufoff) + ldsw + _i * 8192), 16, 0, 0); } while (0)
#define PG8_LDA(dst, b, h) do { _Pragma("unroll") for (int m = 0; m < 4; ++m) _Pragma("unroll") for (int k = 0; k < 2; ++k) dst[m][k] = *(const PG8_LAS bf16x8*)(lds + PG8_SA(b, h) + aoff + m * 2048 + k * 1024); } while (0)
#define PG8_LDB(dst, b, h) do { _Pragma("unroll") for (int n = 0; n < 2; ++n) _Pragma("unroll") for (int k = 0; k < 2; ++k) dst[n][k] = *(const PG8_LAS bf16x8*)(lds + PG8_SB(b, h) + boff + n * 2048 + k * 1024); } while (0)
#define PG8_MMA(ai, bj, At, Bt) do { __builtin_amdgcn_s_setprio(1); _Pragma("unroll") for (int m = 0; m < 4; ++m) _Pragma("unroll") for (int n = 0; n < 2; ++n) _Pragma("unroll") for (int k = 0; k < 2; ++k) \
        acc[ai][bj][m][n] = __builtin_amdgcn_mfma_f32_16x16x32_bf16(Bt[n][k], At[m][k], acc[ai][bj][m][n], 0, 0, 0); __builtin_amdgcn_s_setprio(0); } while (0)
#define PG8_WAIT_V(n) asm volatile("s_waitcnt vmcnt(" #n ")" ::: "memory")
#define PG8_WAIT_L(n) asm volatile("s_waitcnt lgkmcnt(" #n ")" ::: "memory")
#define PG8_BAR __builtin_amdgcn_s_barrier()
#define PG8_SCHED __builtin_amdgcn_sched_barrier(0)
    Unit cur, nxt; int ui = 0;
    if (!S.next(0, cur)) return;
    f32x4 acc[2][2][4][2];
#pragma unroll
    for (int a = 0; a < 2; ++a)
#pragma unroll
        for (int b = 0; b < 2; ++b)
#pragma unroll
            for (int m = 0; m < 4; ++m)
#pragma unroll
                for (int n = 0; n < 2; ++n) acc[a][b][m][n] = (f32x4){0.f, 0.f, 0.f, 0.f};
    bf16x8 At[4][2], B0[2][2], B1[2][2];
    const char* cA = (const char*)(cur.z ? g.A1 : g.A0) + (size_t)cur.pm * tstep; const char* cB = (const char*)(cur.z ? g.B1 : g.B0) + (size_t)cur.pn * tstep;
    if constexpr (SP2) {
        PG8_STAGE(PG8_SB(0, 0), cB, voffB); PG8_STAGE(PG8_SB(0, 1), cB + hstep, voffB); PG8_STAGE(PG8_SA(0, 0), cA, voffA); PG8_STAGE(PG8_SA(0, 1), cA + hstep, voffA);
        if (wr == 1) PG8_BAR;
        PG8_WAIT_V(2); PG8_BAR;
        PG8_STAGE(PG8_SB(1, 0), cB + kstep, voffB); PG8_STAGE(PG8_SA(1, 0), cA + kstep, voffA); PG8_STAGE(PG8_SB(1, 1), cB + hstep + kstep, voffB);
        PG8_WAIT_V(6); PG8_BAR;
    } else {
        PG8_STAGE(PG8_SB(0, 0), cB, voffB); PG8_STAGE(PG8_SA(0, 0), cA, voffA); PG8_STAGE(PG8_SB(0, 1), cB + hstep, voffB); PG8_STAGE(PG8_SA(0, 1), cA + hstep, voffA);
        if (wr == 1) PG8_BAR;
        PG8_WAIT_V(4); PG8_BAR;
        PG8_STAGE(PG8_SB(1, 0), cB + kstep, voffB); PG8_STAGE(PG8_SA(1, 0), cA + kstep, voffA); PG8_STAGE(PG8_SB(1, 1), cB + hstep + kstep, voffB);
        PG8_WAIT_V(6); PG8_BAR;
    }
    for (;;) {
        const bool has_next = S.next(ui + 1, nxt);
        const char* nA = has_next ? (const char*)(nxt.z ? g.A1 : g.A0) + (size_t)nxt.pm * tstep : cA; const char* nB = has_next ? (const char*)(nxt.z ? g.B1 : g.B0) + (size_t)nxt.pn * tstep : cB;
        for (int t = 0; t < nt; t += 2) {
            const bool last = (t == nt - 2);
            const char* a1 = cA + (size_t)(t + 1) * kstep;
            const char* a2 = last ? nA : cA + (size_t)(t + 2) * kstep; const char* b2 = last ? nB : cB + (size_t)(t + 2) * kstep;
            const char* a3 = a2 + kstep; const char* b3 = b2 + kstep;
            if constexpr (SP2) {
            PG8_LDB(B0, 0, 0); PG8_LDB(B1, 0, 1); PG8_SCHED; PG8_LDA(At, 0, 0); PG8_STAGE(PG8_SA(1, 1), a1 + hstep, voffA);
            PG8_WAIT_V(8); PG8_WAIT_L(0); PG8_BAR; PG8_MMA(0, 0, At, B0); PG8_MMA(0, 1, At, B1); PG8_BAR; PG8_SCHED;
            PG8_LDA(At, 0, 1); PG8_STAGE(PG8_SB(0, 0), b2, voffB); PG8_STAGE(PG8_SB(0, 1), b2 + hstep, voffB); PG8_STAGE(PG8_SA(0, 0), a2, voffA);
            PG8_WAIT_V(8); PG8_WAIT_L(0); PG8_BAR; PG8_MMA(1, 0, At, B0); PG8_MMA(1, 1, At, B1); PG8_BAR; PG8_SCHED;
            PG8_LDB(B0, 1, 0); PG8_LDB(B1, 1, 1); PG8_SCHED; PG8_LDA(At, 1, 0); PG8_STAGE(PG8_SA(0, 1), a2 + hstep, voffA);
            PG8_WAIT_V(8); PG8_WAIT_L(0); PG8_BAR; PG8_MMA(0, 0, At, B0); PG8_MMA(0, 1, At, B1); PG8_BAR; PG8_SCHED;
            PG8_LDA(At, 1, 1); PG8_STAGE(PG8_SB(1, 0), b3, voffB); PG8_STAGE(PG8_SB(1, 1), b3 + hstep, voffB); PG8_STAGE(PG8_SA(1, 0), a3, voffA);
            PG8_WAIT_V(8); PG8_WAIT_L(0); PG8_BAR; PG8_MMA(1, 0, At, B0); PG8_MMA(1, 1, At, B1); PG8_BAR; PG8_SCHED;
            } else {
            PG8_LDB(B0, 0, 0); PG8_SCHED; PG8_LDA(At, 0, 0); PG8_STAGE(PG8_SA(1, 1), a1 + hstep, voffA);
            PG8_WAIT_L(8); PG8_BAR; PG8_WAIT_L(0); PG8_MMA(0, 0, At, B0); PG8_BAR; PG8_SCHED;
            PG8_LDB(B1, 0, 1); PG8_STAGE(PG8_SB(0, 0), b2, voffB);
            PG8_BAR; PG8_WAIT_L(0); PG8_MMA(0, 1, At, B1); PG8_BAR;
            PG8_LDA(At, 0, 1); PG8_STAGE(PG8_SA(0, 0), a2, voffA);
            PG8_BAR; PG8_WAIT_L(0); PG8_MMA(1, 0, At, B0); PG8_BAR; PG8_SCHED;
            PG8_STAGE(PG8_SB(0, 1), b2 + hstep, voffB);
            PG8_WAIT_V(6); PG8_BAR; PG8_MMA(1, 1, At, B1); PG8_BAR;
            PG8_LDB(B0, 1, 0); PG8_SCHED; PG8_LDA(At, 1, 0); PG8_STAGE(PG8_SA(0, 1), a2 + hstep, voffA);
            PG8_WAIT_L(8); PG8_BAR; PG8_WAIT_L(0); PG8_MMA(0, 0, At, B0); PG8_BAR; PG8_SCHED;
            PG8_LDB(B1, 1, 1); PG8_STAGE(PG8_SB(1, 0), b3, voffB);
            PG8_BAR; PG8_WAIT_L(0); PG8_MMA(0, 1, At, B1); PG8_BAR;
            PG8_LDA(At, 1, 1); PG8_STAGE(PG8_SA(1, 0), a3, voffA);
            PG8_BAR; PG8_WAIT_L(0); PG8_MMA(1, 0, At, B0); PG8_BAR; PG8_SCHED;
            PG8_STAGE(PG8_SB(1, 1), b3 + hstep, voffB);
            PG8_WAIT_V(6); PG8_BAR; PG8_MMA(1, 1, At, B1); PG8_BAR;
            }
        }
        if constexpr (ALIGN_EPI) { if (wr == 0) PG8_BAR; }
        E(acc, cur, wr, wc, fr, fq);
        if (!has_next) break;
        if (!E.keep(cur))
#pragma unroll
        for (int a = 0; a < 2; ++a)
#pragma unroll
            for (int b = 0; b < 2; ++b)
#pragma unroll
                for (int m = 0; m < 4; ++m)
#pragma unroll
                    for (int n = 0; n < 2; ++n) acc[a][b][m][n] = (f32x4){0.f, 0.f, 0.f, 0.f};
        cur = nxt; cA = nA; cB = nB; ++ui;
        if constexpr (ALIGN_EPI) { if (wr == 1) PG8_BAR; }
    }
    PG8_WAIT_V(0);
    if constexpr (!ALIGN_EPI) { if (wr == 0) PG8_BAR; }
    PG8_BAR;
#undef PG8_SA
#undef PG8_SB
#undef PG8_STAGE
#undef PG8_LDA
#undef PG8_LDB
#undef PG8_MMA
#undef PG8_WAIT_V
#undef PG8_WAIT_L
#undef PG8_BAR
#undef PG8_SCHED
}
}


namespace attn_body {
using bf16=unsigned short;
using bf16x8=__attribute__((ext_vector_type(8)))short;
using s16x4=__attribute__((ext_vector_type(4)))short;
using f32x16=__attribute__((ext_vector_type(16)))float;
using u32x4=__attribute__((ext_vector_type(4)))unsigned;
using f32x4v=__attribute__((ext_vector_type(4)))float;
constexpr int BATCH=4,NHEAD=16,SEQ=8192,D=64,DM=NHEAD*D;
constexpr int NW=8,QBLK=32,QB=QBLK*NW,KVBLK=64,NQB=SEQ/QB;
constexpr int ATTN_PITCH=DM, ATTN_UNIT_ROWS=QB;
__device__ __forceinline__ int crow(int r,int hi){return (r&3)+8*(r>>2)+4*hi;}
#define SBAR() __builtin_amdgcn_sched_barrier(0)
template<bool SWA> __device__ __forceinline__ void cmask(f32x16&p0,f32x16&p1,int jb,int qrel,int hi){
  const float NEG=-INFINITY; int kb=64*jb+4*hi;
  #pragma unroll
  for(int r=0;r<16;++r){int kv=kb+(r&3)+8*(r>>2);
    if(SWA){ if(kv>qrel||kv<=qrel-128)p0[r]=NEG; if(kv+32>qrel||kv+32<=qrel-128)p1[r]=NEG; }
    else{ if(kv>qrel)p0[r]=NEG; if(kv+32>qrel)p1[r]=NEG; } }
}

constexpr int NSLOT=3, SLOTB=8192;
#ifndef NVB
#define NVB 8
#endif
constexpr int LDS_K=0, LDS_V=NSLOT*SLOTB, LDS_WS=2*NSLOT*SLOTB, LDS_OST=LDS_WS+NW*64*4, LDS_CB=LDS_OST+NW*4096, LDS_BYTES=LDS_CB+4*256;
constexpr float C2=0.125f*1.4426950408889634f;
__device__ __forceinline__ void glds16(const void*gsrc,unsigned lds_dst){unsigned keep;
  asm volatile("s_mov_b32 %0, m0\n\ts_mov_b32 m0, %2\n\ts_nop 0\n\tglobal_load_lds_dwordx4 %1, off\n\ts_mov_b32 m0, %0":"=&s"(keep):"v"(gsrc),"s"(lds_dst):"memory");}
__device__ __forceinline__ void glds4(const void*gsrc,unsigned lds_dst){unsigned keep;
  asm volatile("s_mov_b32 %0, m0\n\ts_mov_b32 m0, %2\n\ts_nop 0\n\tglobal_load_lds_dword %1, off\n\ts_mov_b32 m0, %0":"=&s"(keep):"v"(gsrc),"s"(lds_dst):"memory");}
__device__ __forceinline__ float max3f(float a,float b,float c){float r;asm("v_max3_f32 %0, %1, %2, %3":"=v"(r):"v"(a),"v"(b),"v"(c));return r;}
__device__ __forceinline__ float max2f(float a,float b){float r;asm("v_max_f32_e32 %0, %1, %2":"=v"(r):"v"(a),"v"(b));return r;}
__device__ __forceinline__ float fadd_s(float a,float b){float r;asm("v_add_f32_e32 %0, %1, %2":"=v"(r):"v"(a),"v"(b));return r;}
__device__ __forceinline__ float fsub_s(float a,float b){float r;asm("v_sub_f32_e32 %0, %1, %2":"=v"(r):"v"(a),"v"(b));return r;}
typedef float f32x2_t __attribute__((ext_vector_type(2))); typedef __bf16 bf16x2_t __attribute__((ext_vector_type(2)));
__device__ __forceinline__ unsigned cvtpk_s(float lo,float hi){f32x2_t v={lo,hi};bf16x2_t b=__builtin_convertvector(v,bf16x2_t);return __builtin_bit_cast(unsigned,b);}
#define WAIT_BAR(N) asm volatile("s_waitcnt vmcnt(" #N ") lgkmcnt(0)\n\ts_barrier":::"memory")

__device__ __forceinline__ void qkt(f32x16&p0,f32x16&p1,const char*Kslot,const bf16x8*qr,int r32,int hi){
  const char*kb=Kslot+hi*1024+r32*16;
  #pragma unroll
  for(int d0=0;d0<4;++d0){
    const bf16x8 b0=*reinterpret_cast<const bf16x8*>(kb+d0*2048);
    const bf16x8 b1=*reinterpret_cast<const bf16x8*>(kb+d0*2048+512);
    {p0=__builtin_amdgcn_mfma_f32_32x32x16_bf16(b0,qr[d0],p0,0,0,0);p1=__builtin_amdgcn_mfma_f32_32x32x16_bf16(b1,qr[d0],p1,0,0,0);}}
}
typedef __attribute__((address_space(3))) const char* lds_cptr;
typedef short v4i16_t __attribute__((ext_vector_type(4)));
__device__ __forceinline__ void kload8(bf16x8*kf,lds_cptr kp){
  kf[0]=*(const __attribute__((address_space(3))) bf16x8*)(kp);      kf[1]=*(const __attribute__((address_space(3))) bf16x8*)(kp+512);
  kf[2]=*(const __attribute__((address_space(3))) bf16x8*)(kp+2048); kf[3]=*(const __attribute__((address_space(3))) bf16x8*)(kp+2560);
  kf[4]=*(const __attribute__((address_space(3))) bf16x8*)(kp+4096); kf[5]=*(const __attribute__((address_space(3))) bf16x8*)(kp+4608);
  kf[6]=*(const __attribute__((address_space(3))) bf16x8*)(kp+6144); kf[7]=*(const __attribute__((address_space(3))) bf16x8*)(kp+6656);
}
__device__ __forceinline__ void kload2(bf16x8*kf,lds_cptr kp,int j){ kf[2*j]=*(const __attribute__((address_space(3))) bf16x8*)(kp+j*2048); kf[2*j+1]=*(const __attribute__((address_space(3))) bf16x8*)(kp+j*2048+512); }
__device__ __forceinline__ s16x4 vtr(lds_cptr p){ return __builtin_bit_cast(s16x4,__builtin_amdgcn_ds_read_tr16_b64_v4i16((__attribute__((address_space(3))) v4i16_t*)p)); }
__device__ __forceinline__ float rowmax(const f32x16&p0,const f32x16&p1){
  float a=max3f(p0[0],p0[1],p1[0]),b=max3f(p0[2],p0[3],p1[1]);a=max3f(a,p1[2],p1[3]);
  #pragma unroll
  for(int r=4;r<16;r+=4){a=max3f(a,p0[r],p0[r+1]);b=max3f(b,p0[r+2],p0[r+3]);a=max3f(a,p1[r],p1[r+1]);b=max3f(b,p1[r+2],p1[r+3]);}
  const float m=max2f(a,b);
  auto rr=__builtin_amdgcn_permlane32_swap(__float_as_uint(m),__float_as_uint(m),false,false);
  return max2f(__uint_as_float(rr[0]),__uint_as_float(rr[1]));
}
__device__ __forceinline__ void pv(f32x16*o,int vb,bf16x8 pa0,bf16x8 pa1,bf16x8 pa2,bf16x8 pa3){
  #pragma unroll
  for(int d0=0;d0<2;++d0){s16x4 lo[4],hi[4];
    #pragma unroll
    for(int ks=0;ks<4;++ks){
      asm volatile("ds_read_b64_tr_b16 %0,%1 offset:%c2":"=&v"(lo[ks]):"v"(vb),"i"(d0*4096+ks*1024):"memory");
      asm volatile("ds_read_b64_tr_b16 %0,%1 offset:%c2":"=&v"(hi[ks]):"v"(vb),"i"(d0*4096+ks*1024+512):"memory");}
    asm volatile("s_waitcnt lgkmcnt(0)":::"memory");SBAR();
    #define PK(k) (bf16x8){lo[k][0],lo[k][1],lo[k][2],lo[k][3],hi[k][0],hi[k][1],hi[k][2],hi[k][3]}
    o[d0]=__builtin_amdgcn_mfma_f32_32x32x16_bf16(pa0,PK(0),o[d0],0,0,0);
    o[d0]=__builtin_amdgcn_mfma_f32_32x32x16_bf16(pa1,PK(1),o[d0],0,0,0);
    o[d0]=__builtin_amdgcn_mfma_f32_32x32x16_bf16(pa2,PK(2),o[d0],0,0,0);
    o[d0]=__builtin_amdgcn_mfma_f32_32x32x16_bf16(pa3,PK(3),o[d0],0,0,0);
    #undef PK
  }
}

typedef __attribute__((address_space(3))) const f32x4v* lds_f4ptr;
__device__ __forceinline__ void fill_bias(f32x16&c0,f32x16&c1,lds_cptr cb,float negmh){
  #pragma unroll
  for(int g=0;g<4;++g){ const f32x4v v=*(lds_f4ptr)(cb+g*32), w=*(lds_f4ptr)(cb+128+g*32);
    #pragma unroll
    for(int i=0;i<4;++i){ c0[4*g+i]=negmh-v[i]; c1[4*g+i]=negmh-w[i]; } }
}
#ifndef ATTN_STORE16
#define ATTN_STORE16(p,v) (*(u32x4*)(p)=(v))
#endif
template<int THRL,bool FOX,int KP> __device__ __forceinline__ void attn_unit(int b,int h,int qb,const bf16*Q,const bf16*__restrict__ K,const bf16*__restrict__ V,bf16*O,const float*__restrict__ Cb,float sink2,char*shm){
  int tid_=threadIdx.x; asm volatile("":"+v"(tid_));
  const int tid=tid_,lane=tid&63,r32=lane&31,hi=lane>>5; const int wid=__builtin_amdgcn_readfirstlane(tid>>6);
  const long rowbase=(long)b*SEQ; const int q0=qb*QB;
  const bf16*Qw=Q+(rowbase+q0+wid*QBLK)*DM+h*D;
  const int kvh=FOX?h:(h>>3); const int T0=FOX?0:(qb==0?0:4*qb-2);
  const bf16*Kh=K+(rowbase+(long)T0*KVBLK)*KP+kvh*D,*Vh=V+(rowbase+(long)T0*KVBLK)*KP+kvh*D; const float*Cs=FOX?Cb+lane:nullptr;
  const unsigned lds0=(unsigned)(uintptr_t)shm;
  float*wsf=(float*)(shm+LDS_WS)+wid*64;
  const bf16*ksrc=Kh+(long)lane*KP+wid*8;
  const bf16*vsrc=Vh+(long)(16*(wid&3)+(lane>>2))*KP+(wid>>2)*32+(lane&3)*8;
  const unsigned kdst=lds0+LDS_K+wid*1024, vdst=lds0+LDS_V+wid*1024;
  #define DMA_K(t,slot) glds16(ksrc+(long)(t)*KVBLK*KP,(unsigned)__builtin_amdgcn_readfirstlane(kdst+(slot)))
  #define DMA_C(t) do{ if(FOX) glds4(Cs+(long)(t)*KVBLK,(unsigned)__builtin_amdgcn_readfirstlane(lds0+LDS_CB+(((t)&3)<<8))); }while(0)
  #define PREFILL(X0,X1,t) do{ if(FOX){ fill_bias(X0,X1,cb0+(((t)&3)<<8),-mhat); } else { _Pragma("unroll") for(int r=0;r<16;++r){X0[r]=-mhat;X1[r]=-mhat;} } }while(0)
  #define DMA_V(t,slot) glds16(vsrc+(long)(t)*KVBLK*KP,(unsigned)__builtin_amdgcn_readfirstlane(vdst+(slot)))
  const int vb0=(int)(lds0+LDS_V)+((lane>>4)&1)*32+(lane&3)*8+(4*hi+((lane&15)>>2))*64;
  const char*Kbase=shm+LDS_K; bf16x8 kf[8];
  const lds_cptr shm3=(lds_cptr)shm; const lds_cptr cb0=shm3+LDS_CB+hi*16; const lds_cptr kp0=shm3+LDS_K+hi*1024+r32*16; const lds_cptr vp0=shm3+LDS_V+((lane>>4)&1)*32+(lane&3)*8+(4*hi+((lane&15)>>2))*64;
  const int NT=FOX?(q0+QB)/KVBLK:(qb==0?4:6);
  DMA_K(0,0);DMA_C(0);DMA_V(0,0);DMA_K(1,SLOTB);DMA_C(1);
  bf16x8 qr[4];
  #pragma unroll
  for(int d0=0;d0<4;++d0)qr[d0]=*reinterpret_cast<const bf16x8*>(&Qw[(long)r32*DM+d0*16+hi*8]);
  float mhat=FOX?-Cb[q0+wid*QBLK+r32]:0.f,l_reg=0.f;    f32x16 o[2];o[0]=f32x16{};o[1]=f32x16{};
  const int qrel=wid*QBLK+r32;
  #define CMASK(P0,P1,t) do{int jb_=(t)-(NT-4); if(!FOX||jb_>=0)cmask<!FOX>(P0,P1,jb_,qrel,hi);}while(0)
  bool resc=false;
  #define START(P0,P1) do{ float rm=__builtin_fmaxf(rowmax(P0,P1),0.f); resc=false;     \
    { const float dl=rm; mhat=fadd_s(mhat,dl); \
      _Pragma("unroll") for(int r=0;r<16;++r){P0[r]=fsub_s(P0[r],dl);P1[r]=fsub_s(P1[r],dl);} } \
    _Pragma("unroll") for(int r=0;r<16;++r)P0[r]=__builtin_amdgcn_exp2f(P0[r]); }while(0)
  #define RESC() do{ if(resc){ asm volatile("s_waitcnt lgkmcnt(0)":::"memory"); \
      _Pragma("unroll") for(int d_=0;d_<2;++d_) _Pragma("unroll") for(int r=0;r<16;++r)o[d_][r]*=wsf[crow(r,hi)]; } }while(0)
  f32x16 pA0,pA1,pB0,pB1;
  int sl_prev=0,sl_cur=0,sl_next=SLOTB;
  #define ROT() do{sl_prev=sl_cur;sl_cur=sl_next;sl_next=(sl_next==(NSLOT-1)*SLOTB)?0:sl_next+SLOTB;}while(0)
  DMA_K(2,2*SLOTB);DMA_C(2);
  if(FOX){WAIT_BAR(5);}else{WAIT_BAR(3);}
  PREFILL(pA0,pA1,0); qkt(pA0,pA1,Kbase,qr,r32,hi);asm volatile("s_nop 15\n\ts_nop 7":"+v"(pA0),"+v"(pA1));CMASK(pA0,pA1,0);
  START(pA0,pA1);
  _Pragma("unroll") for(int r=0;r<16;++r)pA1[r]=__builtin_amdgcn_exp2f(pA1[r]);
  WAIT_BAR(0);
  DMA_K(3,0);DMA_C(3);DMA_V(1,SLOTB);
  ROT();
  kload8(kf,kp0+sl_cur);
  PREFILL(pB0,pB1,1); if(FOX){ WAIT_BAR(3); }else{ WAIT_BAR(2); }
  s16x4 vlo[NVB],vhi[NVB]; u32x4 pw0,pw1,pw2,pw3;
  #define PKW(P,B) cvtpk_s(P[B],P[B+1])
  #define PAF(k) __builtin_bit_cast(bf16x8,pw##k)
  #define VFR(j) (bf16x8){vlo[(j)%NVB][0],vlo[(j)%NVB][1],vlo[(j)%NVB][2],vlo[(j)%NVB][3],vhi[(j)%NVB][0],vhi[(j)%NVB][1],vhi[(j)%NVB][2],vhi[(j)%NVB][3]}
  #define PIN(x) asm volatile("":"+v"(x))
  #define MX3(a,b,c) __builtin_fmaxf(__builtin_fmaxf((a),(b)),(c))
  #define GAPA(MF,A0,A1,A2,A3,W0,W1,PW) do{ MF; sacc+=A0; sacc+=A1; sacc+=A2; sacc+=A3; PIN(sacc); W0; W1; PIN(PW); SBAR(); }while(0)
  #define EX(v) __builtin_amdgcn_exp2f(v)
  #define GAPB(MF,VR,X,B) do{ MF; VR; X[B]=EX(X[B]); X[B+1]=EX(X[B+1]); X[B+2]=EX(X[B+2]); X[B+3]=EX(X[B+3]); PIN(X); SBAR(); }while(0)
  #define VOFF(j) ((((j)&1)*4096)+(((j)>>1)*1024))
  #define VRD(j) do{ if((j)>=0&&(j)<8){ vlo[(j)%NVB]=vtr(vp_+VOFF(j)); vhi[(j)%NVB]=vtr(vp_+VOFF(j)+512); } }while(0)
  #define KRD(G,j) do{ if(G){ kload2(kf,kp0+sl_next,j); SBAR(); } }while(0)
  #define STEP(C0,C1,P0,P1,t,GK,GV,GL) do{ SBAR(); \
    const lds_cptr vp_=vp0+sl_prev; \
    VRD(0-(8-NVB)); SBAR(); float sacc=(P0[0]+P0[1]); \
    GAPA(C0=__builtin_amdgcn_mfma_f32_32x32x16_bf16(kf[0],qr[0],C0,0,0,0), P0[2],P0[3],P0[4],P0[5],     pw0[0]=PKW(P0,0), pw0[1]=PKW(P0,2), pw0); \
    VRD(1-(8-NVB)); SBAR(); GAPA(C1=__builtin_amdgcn_mfma_f32_32x32x16_bf16(kf[1],qr[0],C1,0,0,0), P0[6],P0[7],P0[8],P0[9],     pw0[2]=PKW(P0,4), pw0[3]=PKW(P0,6), pw0); \
    VRD(2-(8-NVB)); SBAR(); GAPA(C0=__builtin_amdgcn_mfma_f32_32x32x16_bf16(kf[2],qr[1],C0,0,0,0),   P0[10],P0[11],P0[12],P0[13], pw1[0]=PKW(P0,8), pw1[1]=PKW(P0,10), pw1); \
    VRD(3-(8-NVB)); SBAR(); GAPA(C1=__builtin_amdgcn_mfma_f32_32x32x16_bf16(kf[3],qr[1],C1,0,0,0),   P0[14],P0[15],P1[0],P1[1],   pw1[2]=PKW(P0,12),pw1[3]=PKW(P0,14), pw1); \
    VRD(4-(8-NVB)); SBAR(); GAPA(C0=__builtin_amdgcn_mfma_f32_32x32x16_bf16(kf[4],qr[2],C0,0,0,0),   P1[2],P1[3],P1[4],P1[5],     pw2[0]=PKW(P1,0), pw2[1]=PKW(P1,2), pw2); \
    VRD(5-(8-NVB)); SBAR(); GAPA(C1=__builtin_amdgcn_mfma_f32_32x32x16_bf16(kf[5],qr[2],C1,0,0,0),   P1[6],P1[7],P1[8],P1[9],     pw2[2]=PKW(P1,4), pw2[3]=PKW(P1,6), pw2); \
    VRD(6-(8-NVB)); SBAR(); GAPA(C0=__builtin_amdgcn_mfma_f32_32x32x16_bf16(kf[6],qr[3],C0,0,0,0),   P1[10],P1[11],P1[12],P1[13], pw3[0]=PKW(P1,8), pw3[1]=PKW(P1,10), pw3); \
    VRD(7-(8-NVB)); SBAR(); GAPA(C1=__builtin_amdgcn_mfma_f32_32x32x16_bf16(kf[7],qr[3],C1,0,0,0),   P1[14],P1[15],0.f,0.f,       pw3[2]=PKW(P1,12),pw3[3]=PKW(P1,14), pw3); \
    l_reg+=sacc; \
    if(GK){DMA_K((t)+3,sl_cur);DMA_C((t)+3);} if(GV){DMA_V((t)+1,sl_next);} \
    CMASK(C0,C1,t); \
    { float a=MX3(C0[0],C0[1],C1[0]),b=MX3(C0[2],C0[3],C1[1]); a=MX3(a,C1[2],C1[3]); \
      _Pragma("unroll") for(int r=4;r<16;r+=4){a=MX3(a,C0[r],C0[r+1]);b=MX3(b,C0[r+2],C0[r+3]);a=MX3(a,C1[r],C1[r+1]);b=MX3(b,C1[r+2],C1[r+3]);} \
      float rm=__builtin_fmaxf(a,b); { auto rr=__builtin_amdgcn_permlane32_swap(__float_as_uint(rm),__float_as_uint(rm),false,false); rm=__builtin_fmaxf(__uint_as_float(rr[0]),__uint_as_float(rr[1])); } \
      resc=false; \
      if(__builtin_expect(__any(rm>(float)THRL),0)){ const float dl=__builtin_fmaxf(rm,0.f); mhat+=dl; \
        _Pragma("unroll") for(int r=0;r<16;++r){C0[r]-=dl;C1[r]-=dl;} \
        const float f=__builtin_amdgcn_exp2f(-dl); l_reg*=f; if(hi==0)wsf[r32]=f; resc=true; } } \
    SBAR(); \
    GAPB(o[0]=__builtin_amdgcn_mfma_f32_32x32x16_bf16(PAF(0),VFR(0),o[0],0,0,0), VRD(0+NVB), C0,0); \
    GAPB(o[1]=__builtin_amdgcn_mfma_f32_32x32x16_bf16(PAF(0),VFR(1),o[1],0,0,0), VRD(1+NVB), C0,4); \
    KRD(GL,0); GAPB(o[0]=__builtin_amdgcn_mfma_f32_32x32x16_bf16(PAF(1),VFR(2),o[0],0,0,0), VRD(2+NVB), C0,8); \
    KRD(GL,1); GAPB(o[1]=__builtin_amdgcn_mfma_f32_32x32x16_bf16(PAF(1),VFR(3),o[1],0,0,0), VRD(3+NVB), C0,12); \
    KRD(GL,2); GAPB(o[0]=__builtin_amdgcn_mfma_f32_32x32x16_bf16(PAF(2),VFR(4),o[0],0,0,0), VRD(4+NVB), C1,0); \
    KRD(GL,3); GAPB(o[1]=__builtin_amdgcn_mfma_f32_32x32x16_bf16(PAF(2),VFR(5),o[1],0,0,0), VRD(5+NVB), C1,4); \
    GAPB(o[0]=__builtin_amdgcn_mfma_f32_32x32x16_bf16(PAF(3),VFR(6),o[0],0,0,0), VRD(6+NVB), C1,8); \
    GAPB(o[1]=__builtin_amdgcn_mfma_f32_32x32x16_bf16(PAF(3),VFR(7),o[1],0,0,0), VRD(7+NVB), C1,12); \
    if(GL){ PREFILL(P0,P1,(t)+1); } \
    }while(0)
  int t=1;
  #undef CMASK
  #define CMASK(P0,P1,t) do{}while(0)
  for(;t+5<NT;t+=2){
    STEP(pB0,pB1,pA0,pA1,t,true,true,true);     if(FOX){WAIT_BAR(3);}else{WAIT_BAR(2);} RESC(); ROT();
    STEP(pA0,pA1,pB0,pB1,t+1,true,true,true);   if(FOX){WAIT_BAR(3);}else{WAIT_BAR(2);} RESC(); ROT();
  }
  #undef CMASK
  #define CMASK(P0,P1,t) do{int jb_=(t)-(NT-4); if(!FOX||jb_>=0)cmask<!FOX>(P0,P1,jb_,qrel,hi);}while(0)
  #define ENDW(tt) do{ if((tt)+3<NT){ if(FOX){WAIT_BAR(3);}else{WAIT_BAR(2);} } else if((tt)+2<NT){WAIT_BAR(1);} else {WAIT_BAR(0);} }while(0)
  for(;t+1<NT;t+=2){
    STEP(pB0,pB1,pA0,pA1,t,(t+3<NT),(t+1<NT),(t+1<NT));       ENDW(t);   RESC(); ROT();
    STEP(pA0,pA1,pB0,pB1,t+1,(t+4<NT),(t+2<NT),(t+2<NT));     ENDW(t+1); RESC(); ROT();
  }
  STEP(pB0,pB1,pA0,pA1,NT-1,false,false,false); RESC();
  { float sacc=pB0[0]+pB0[1]; _Pragma("unroll") for(int r=2;r<16;++r)sacc+=pB0[r]; _Pragma("unroll") for(int r=0;r<16;++r)sacc+=pB1[r]; l_reg+=sacc;
    pw0=(u32x4){PKW(pB0,0),PKW(pB0,2),PKW(pB0,4),PKW(pB0,6)};pw1=(u32x4){PKW(pB0,8),PKW(pB0,10),PKW(pB0,12),PKW(pB0,14)};pw2=(u32x4){PKW(pB1,0),PKW(pB1,2),PKW(pB1,4),PKW(pB1,6)};pw3=(u32x4){PKW(pB1,8),PKW(pB1,10),PKW(pB1,12),PKW(pB1,14)};
    SBAR(); pv(o,vb0+sl_cur,PAF(0),PAF(1),PAF(2),PAF(3)); }
  #undef PKW
  #undef PAF
  #undef VFR
  #undef PIN
  #undef MX3
  #undef GAPA
  #undef GAPB
  #undef EX
  #undef VRD
  #undef VOFF
  #undef KRD
  #undef STEP
  #undef ENDW
  {auto rr=__builtin_amdgcn_permlane32_swap(__float_as_uint(l_reg),__float_as_uint(l_reg),false,false);l_reg=__uint_as_float(rr[0])+__uint_as_float(rr[1]);}
  if(!FOX) l_reg+=__builtin_amdgcn_exp2f(sink2-mhat);
  if(hi==0)wsf[32+r32]=l_reg;asm volatile("s_waitcnt lgkmcnt(0)":::"memory");
  float rli[16];
  #pragma unroll
  for(int r=0;r<16;++r)rli[r]=__builtin_amdgcn_rcpf(wsf[32+crow(r,hi)]);
  bf16*Ow=O+(rowbase+q0+wid*QBLK)*DM+h*D;
  { bf16*stg=(bf16*)(shm+LDS_OST)+wid*2048;
    #pragma unroll
    for(int r=0;r<16;++r){const int orow=crow(r,hi);
      #pragma unroll
      for(int d0=0;d0<2;++d0)stg[orow*64+d0*32+r32]=(bf16)(cvtpk_s(o[d0][r]*rli[r],0.f)&0xffffu);}
    asm volatile("s_waitcnt lgkmcnt(0)":::"memory");
    #pragma unroll
    for(int i=0;i<4;++i){const int row=i*8+(lane>>3),ch=lane&7; const u32x4 v=*(const u32x4*)(stg+row*64+ch*8); ATTN_STORE16(Ow+(long)row*DM+ch*8,v);} }
  asm volatile("s_waitcnt lgkmcnt(0)\n\ts_barrier":::"memory");
  #undef DMA_K
  #undef DMA_V
  #undef DMA_C
  #undef PREFILL
  #undef CMASK
  #undef START
  #undef RESC
  #undef ROT
}
constexpr int ATTN_LDS_BYTES=LDS_BYTES;
#undef SBAR
#undef WAIT_BAR
}

#ifndef REP_PHASE
#define REP_PHASE 0
#endif
#ifndef NAIVE_SWA
#define NAIVE_SWA 0
#endif
#ifndef NAIVE_FOX
#define NAIVE_FOX 0
#endif
#define LAS __attribute__((address_space(3)))
typedef unsigned short bf16;
typedef float f32x4 __attribute__((ext_vector_type(4)));
typedef unsigned v4u __attribute__((ext_vector_type(4)));
typedef unsigned v2u __attribute__((ext_vector_type(2)));
constexpr int NWAVES = 8;
constexpr int RING_BYTES = 131072, LDS_BYTES = 147456;

__device__ __forceinline__ float wave_sum(float v) {
#pragma unroll
    for (int o = 1; o < 64; o <<= 1) v += __shfl_xor(v, o);
    return v;
}
#define LDS_WAIT() asm volatile("s_waitcnt lgkmcnt(0)" ::: "memory")

__device__ __forceinline__ void tr_item(const float* W, int K, int N, bf16* WT, int dst_row0, int src_col0, int nvalid, int kb, const float* kscale, LAS float* scr, int lane) {
    const int k0 = 64 * kb, c = lane & 31;
#pragma unroll 8
    for (int i = 0; i < 32; ++i) { const int kk = 2 * i + (lane >> 5); float v = 0.f; if (c < nvalid) v = W[(size_t)(k0 + kk) * N + src_col0 + c]; if (kscale) v *= kscale[k0 + kk]; scr[kk * 33 + c] = v; }
    LDS_WAIT(); asm volatile("" ::: "memory");
    const int ch = lane & 7;
#pragma unroll
    for (int j = 0; j < 4; ++j) { const int n = (lane >> 3) + 8 * j; const LAS float* s = scr + (8 * ch) * 33 + n;
        v4u o; o.x = pg8::cvt_pk_bf16(s[0 * 33], s[1 * 33]); o.y = pg8::cvt_pk_bf16(s[2 * 33], s[3 * 33]); o.z = pg8::cvt_pk_bf16(s[4 * 33], s[5 * 33]); o.w = pg8::cvt_pk_bf16(s[6 * 33], s[7 * 33]);
        *(v4u*)(WT + (size_t)(dst_row0 + n) * K + k0 + 8 * ch) = o; }
    LDS_WAIT(); asm volatile("" ::: "memory");
}
__device__ __forceinline__ void win_map(int db, int& src, int& nv) {
    const int pn = db >> 3, bj = (db >> 2) & 1, wc = db & 3; nv = 32;
    if (pn < 4) src = (4 * pn + wc) * 64 + 32 * bj;
    else if (pn == 4) src = (wc < 2 ? 1024 + wc * 64 : 1152 + (wc - 2) * 64) + 32 * bj;
    else if (pn < 17) { const int t = pn - 5; src = 1280 + (t >> 2) * 1024 + (4 * (t & 3) + wc) * 64 + 32 * bj; }
    else if (pn < 33) src = 4368 + (db - 136) * 32;
    else { src = 4352; nv = (db == 264) ? 16 : 0; }
}

struct Args { const float* x; const int* pos; const float* attn_norm; const float* w_in; const float* fbias; const float* sinks; const float* w_bs; const float* w_bf;
              const float* w_out; const float* mlp_norm; const float* w_up; const float* w_dn; const float* final_norm; float* out; unsigned char* ws; };

__device__ __forceinline__ void rms_row_to_bf16(const float* xrow, const float* gain, bf16* orow, int lane) {
    const f32x4* xr = (const f32x4*)xrow + lane; f32x4 v[8]; float s = 0.f;
#pragma unroll
    for (int j = 0; j < 8; ++j) { v[j] = xr[64 * j]; s += (v[j].x * v[j].x + v[j].y * v[j].y) + (v[j].z * v[j].z + v[j].w * v[j].w); }
    const float rstd = __builtin_amdgcn_rsqf(wave_sum(s) * (1.f / DM) + RMS_EPS);
    const f32x4* gr = (const f32x4*)gain + lane; v2u* o8 = (v2u*)orow + lane;
#pragma unroll
    for (int j = 0; j < 8; ++j) { const f32x4 g = gr[64 * j]; v2u w; w.x = pg8::cvt_pk_bf16(v[j].x * rstd * g.x, v[j].y * rstd * g.y); w.y = pg8::cvt_pk_bf16(v[j].z * rstd * g.z, v[j].w * rstd * g.w); o8[64 * j] = w; }
}

__device__ __forceinline__ void p0_prologue(const Args& a, LAS unsigned char* lds, int vcu, int G, int wave, int lane) {
    unsigned char* ws = a.ws;
    LAS float* scr = (LAS float*)(lds + wave * 16384);
    const int gw = vcu * NWAVES + wave, NGW = G * NWAVES;
    constexpr int I_IN = (NIN / 32) * (DM / 64), I_BS = (DM / 32) * (1024 / 64), I_OUT = (DM / 32) * (DM / 64), I_UP = (DFF / 32) * (DM / 64), I_DN = (DM / 32) * (DFF / 64);
    constexpr int NITEMS = I_IN + 2 * I_BS + I_OUT + I_UP + I_DN;
    for (int it = gw; it < NITEMS; it += NGW) {
        int r = it;
        if (r < I_IN) { const int db = r / (DM / 64), kb = r % (DM / 64); int src, nv; win_map(db, src, nv); tr_item(a.w_in, DM, DIN, (bf16*)(ws + WS_WIN), db * 32, src, nv, kb, nullptr, scr, lane); continue; } r -= I_IN;
        if (r < I_BS) { const int db = r / 16, kb = r % 16; tr_item(a.w_bs, 1024, DM, (bf16*)(ws + WS_WBS), db * 32, db * 32, 32, kb, nullptr, scr, lane); continue; } r -= I_BS;
        if (r < I_BS) { const int db = r / 16, kb = r % 16; tr_item(a.w_bf, 1024, DM, (bf16*)(ws + WS_WBF), db * 32, db * 32, 32, kb, nullptr, scr, lane); continue; } r -= I_BS;
        if (r < I_OUT) { const int db = r / 32, kb = r % 32; tr_item(a.w_out, DM, DM, (bf16*)(ws + WS_WOUT), db * 32, db * 32, 32, kb, nullptr, scr, lane); continue; } r -= I_OUT;
        if (r < I_UP) { const int db = r / 32, kb = r % 32; tr_item(a.w_up, DM, DFF, (bf16*)(ws + WS_WUP), db * 32, db * 32, 32, kb, a.mlp_norm, scr, lane); continue; } r -= I_UP;
        { const int db = r / 128, kb = r % 128; tr_item(a.w_dn, DFF, DM, (bf16*)(ws + WS_WDN), db * 32, db * 32, 32, kb, nullptr, scr, lane); }
    }
    for (int m = gw; m < M; m += NGW) rms_row_to_bf16(a.x + (size_t)m * DM, a.attn_norm, (bf16*)(ws + WS_XN) + (size_t)m * DM, lane);
    float* cs = (float*)(ws + WS_CS);
    for (int e = gw * 64 + lane; e < M * 32; e += NGW * 64) {
        const int tok = e >> 5, i = e & 31;
        const float inv_freq = powf(10000.0f, -(float)(2 * i) / 64.0f);
        const float ang = (float)a.pos[tok] * inv_freq;
        double rev = (double)ang * 0.15915494309189535; rev -= floor(rev);
        const float rf = (float)rev;
        cs[e] = __builtin_amdgcn_cosf(rf); cs[(size_t)M * 32 + e] = __builtin_amdgcn_sinf(rf);
    }
}

__device__ __forceinline__ void cumsum_unit(const Args& a, int bh, LAS unsigned char* lds) {
    const float* FL = (const float*)(a.ws + WS_FL); float* Cp = (float*)(a.ws + WS_C);
    LAS double* sh = (LAS double*)lds;
    const int b = bh >> 4, h = bh & 15, tid = threadIdx.x, s0 = tid * 16; const float fb = a.fbias[h];
    float ls[16]; double run = 0.0;
#pragma unroll
    for (int i = 0; i < 16; ++i) { const float z = FL[(size_t)(b * SEQ + s0 + i) * 16 + h] + fb; const float v = fminf(z, 0.f) - log1pf(expf(-fabsf(z))); ls[i] = v; run += (double)v; }
    sh[tid] = run; __syncthreads();
    double pre = 0.0; for (int k = 0; k < tid; ++k) pre += sh[k];
#pragma unroll
    for (int i = 0; i < 16; ++i) { pre += (double)ls[i]; Cp[(size_t)bh * SEQ + s0 + i] = (float)(pre * 1.4426950408889634); }
    __syncthreads();
}

__device__ __forceinline__ void naive_swa_unit(const Args& a, int unit) {
    const bf16* AQ = (const bf16*)(a.ws + WS_AQ); const bf16* AK = (const bf16*)(a.ws + WS_AK); const bf16* AV = (const bf16*)(a.ws + WS_AV); bf16* OA = (bf16*)(a.ws + WS_OA);
    const int tid = threadIdx.x, head = tid & 15, tok = unit * 32 + (tid >> 4), b = tok / SEQ, s = tok % SEQ, kvh = head >> 3;
    float q[64], o[64]; float m = -INFINITY, l = 0.f;
    { const v4u* qp = (const v4u*)(AQ + (size_t)tok * 1024 + head * 64);
#pragma unroll
      for (int c = 0; c < 8; ++c) { const v4u w = qp[c];
#pragma unroll
          for (int e = 0; e < 4; ++e) { q[8 * c + 2 * e] = pg8::bf_lo(w[e]); q[8 * c + 2 * e + 1] = pg8::bf_hi(w[e]); } } }
#pragma unroll
    for (int d = 0; d < 64; ++d) o[d] = 0.f;
    for (int i = 0; i < 128; ++i) {
        const int j = s - i; const bool valid = j >= 0; const int jj = valid ? j : 0;
        const v4u* kp = (const v4u*)(AK + (size_t)(b * SEQ + jj) * 128 + kvh * 64); const v4u* vp = (const v4u*)(AV + (size_t)(b * SEQ + jj) * 128 + kvh * 64);
        float dot = 0.f;
#pragma unroll
        for (int c = 0; c < 8; ++c) { const v4u w = kp[c];
#pragma unroll
            for (int e = 0; e < 4; ++e) { dot += q[8 * c + 2 * e] * pg8::bf_lo(w[e]); dot += q[8 * c + 2 * e + 1] * pg8::bf_hi(w[e]); } }
        const float lg = valid ? dot : -INFINITY;
        const float mn = fmaxf(m, lg), al = __builtin_amdgcn_exp2f(m - mn), p = __builtin_amdgcn_exp2f(lg - mn);
        l = l * al + p; m = mn;
#pragma unroll
        for (int c = 0; c < 8; ++c) { const v4u w = vp[c];
#pragma unroll
            for (int e = 0; e < 4; ++e) { o[8 * c + 2 * e] = o[8 * c + 2 * e] * al + p * pg8::bf_lo(w[e]); o[8 * c + 2 * e + 1] = o[8 * c + 2 * e + 1] * al + p * pg8::bf_hi(w[e]); } }
    }
    { const float sk = a.sinks[head] * LOG2E; const float m2 = fmaxf(m, sk), al = __builtin_amdgcn_exp2f(m - m2); l = l * al + __builtin_amdgcn_exp2f(sk - m2);
      const float rl = al / l;
      v4u* op = (v4u*)(OA + (size_t)tok * 1024 + head * 64);
#pragma unroll
      for (int c = 0; c < 8; ++c) { v4u w;
#pragma unroll
          for (int e = 0; e < 4; ++e) w[e] = pg8::cvt_pk_bf16(o[8 * c + 2 * e] * rl, o[8 * c + 2 * e + 1] * rl);
          op[c] = w; } }
}
__device__ __forceinline__ void naive_fox_unit(const Args& a, int bh, int qblk) {
    const bf16* FQ = (const bf16*)(a.ws + WS_FQ); const bf16* FK = (const bf16*)(a.ws + WS_FK); const bf16* FV = (const bf16*)(a.ws + WS_FV); bf16* OB = (bf16*)(a.ws + WS_OB);
    const float* Cp = (const float*)(a.ws + WS_C) + (size_t)bh * SEQ;
    const int tid = threadIdx.x, b = bh >> 4, h = bh & 15, s = qblk * 512 + tid; const size_t tok = (size_t)b * SEQ + s;
    float q[64], o[64]; float m = -INFINITY, l = 0.f;
    { const v4u* qp = (const v4u*)(FQ + tok * 1024 + h * 64);
#pragma unroll
      for (int c = 0; c < 8; ++c) { const v4u w = qp[c];
#pragma unroll
          for (int e = 0; e < 4; ++e) { q[8 * c + 2 * e] = pg8::bf_lo(w[e]); q[8 * c + 2 * e + 1] = pg8::bf_hi(w[e]); } } }
#pragma unroll
    for (int d = 0; d < 64; ++d) o[d] = 0.f;
    const float cq = Cp[s];
    const int jend = __builtin_amdgcn_readfirstlane(qblk * 512 + (tid | 63));
    for (int j = 0; j <= jend; ++j) {
        const v4u* kp = (const v4u*)(FK + ((size_t)b * SEQ + j) * 1024 + h * 64); const v4u* vp = (const v4u*)(FV + ((size_t)b * SEQ + j) * 1024 + h * 64);
        float dot = 0.f;
#pragma unroll
        for (int c = 0; c < 8; ++c) { const v4u w = kp[c];
#pragma unroll
            for (int e = 0; e < 4; ++e) { dot += q[8 * c + 2 * e] * pg8::bf_lo(w[e]); dot += q[8 * c + 2 * e + 1] * pg8::bf_hi(w[e]); } }
        float lg = dot + (cq - Cp[j]); lg = (j <= s) ? lg : -INFINITY;
        const float mn = fmaxf(m, lg), al = __builtin_amdgcn_exp2f(m - mn), p = __builtin_amdgcn_exp2f(lg - mn);
        l = l * al + p; m = mn;
#pragma unroll
        for (int c = 0; c < 8; ++c) { const v4u w = vp[c];
#pragma unroll
            for (int e = 0; e < 4; ++e) { o[8 * c + 2 * e] = o[8 * c + 2 * e] * al + p * pg8::bf_lo(w[e]); o[8 * c + 2 * e + 1] = o[8 * c + 2 * e + 1] * al + p * pg8::bf_hi(w[e]); } }
    }
    { const float rl = 1.0f / l; v4u* op = (v4u*)(OB + tok * 1024 + h * 64);
#pragma unroll
      for (int c = 0; c < 8; ++c) { v4u w;
#pragma unroll
          for (int e = 0; e < 4; ++e) w[e] = pg8::cvt_pk_bf16(o[8 * c + 2 * e] * rl, o[8 * c + 2 * e + 1] * rl);
          op[c] = w; } }
}

__global__ void __launch_bounds__(NWAVES * 64, 2) mega_fwd(Args a) {
    extern __shared__ __attribute__((aligned(16))) unsigned char lds_raw[];
    LAS unsigned char* lds = (LAS unsigned char*)lds_raw;
    cg::grid_group grid = cg::this_grid();
    int tid_ = threadIdx.x; asm volatile("" : "+v"(tid_));
    const int tid = tid_, lane = tid & 63, wave = __builtin_amdgcn_readfirstlane(tid >> 6);
    const int G = gridDim.x, bx = blockIdx.x, vcu = (G % 8 == 0) ? (bx % 8) * (G / 8) + bx / 8 : bx;
    unsigned char* ws = a.ws;
    float* SS1 = (float*)(ws + WS_CTL); float* SS2 = SS1 + M;
#define GRID_SYNC() do { asm volatile("s_waitcnt vmcnt(0) lgkmcnt(0)" ::: "memory"); grid.sync(); } while (0)

    for (int rp_ = 0; rp_ < (REP_PHASE == 100 ? 2 : 1); ++rp_) { p0_prologue(a, lds, vcu, G, wave, lane); __syncthreads(); }
    GRID_SYNC();

    {
        pg8::Gemm g{(const bf16*)(ws + WS_XN), (const bf16*)(ws + WS_WIN), nullptr, nullptr, DM};
        pg8::StaticOrder S; S.init(M, NIN, G, bx);
        pg8::EpiIn E{ws};
        for (int rp_ = 0; rp_ < (REP_PHASE == 1 ? 2 : 1); ++rp_) pg8::gemm_phase<pg8::EpiIn, pg8::StaticOrder, true, true>(lds, g, S, E);
    }
    GRID_SYNC();

    for (int u = bx; u < 64; u += G) cumsum_unit(a, u, lds);
#if NAIVE_SWA
    for (int u = bx; u < M / 32; u += G) naive_swa_unit(a, u);
#else
    for (int rp_ = 0; rp_ < (REP_PHASE == 2 ? 2 : 1); ++rp_)
    for (int u = vcu; u < 2048; u += G) { const int bh = u >> 5, qb = u & 31, b_ = bh >> 4, h_ = bh & 15;
        attn_body::attn_unit<8, false, 128>(b_, h_, qb, (const bf16*)(ws + WS_AQ), (const bf16*)(ws + WS_AK), (const bf16*)(ws + WS_AV), (bf16*)(ws + WS_OA), nullptr, a.sinks[h_] * LOG2E, (char*)lds_raw); }
#endif
    GRID_SYNC();

#if NAIVE_FOX
    for (int u = bx; u < 1024; u += G) { const int r = u >> 6, i = r >> 2, hi4 = r & 3, qblk = (i & 1) ? 4 * i + 3 - hi4 : 4 * i + hi4; naive_fox_unit(a, u & 63, qblk); }
#else
    for (int rp_ = 0; rp_ < (REP_PHASE == 3 ? 2 : 1); ++rp_)
    for (int e = vcu; e < 2048; e += G) { const int cuv = e & 255, i = e >> 8, bh = (cuv >> 3) + 32 * (i >> 2), s_ = cuv & 7, k_ = i & 3, qb = k_ == 0 ? s_ : (k_ == 1 ? 15 - s_ : (k_ == 2 ? 16 + s_ : 31 - s_));
        attn_body::attn_unit<8, true, 1024>(bh >> 4, bh & 15, qb, (const bf16*)(ws + WS_FQ), (const bf16*)(ws + WS_FK), (const bf16*)(ws + WS_FV), (bf16*)(ws + WS_OB), (const float*)(ws + WS_C) + (size_t)bh * SEQ, 0.f, (char*)lds_raw); }
#endif
    GRID_SYNC();

    {
        pg8::Gemm g{(const bf16*)(ws + WS_OA), (const bf16*)(ws + WS_WBS), (const bf16*)(ws + WS_OB), (const bf16*)(ws + WS_WBF), 1024};
        pg8::PairOrder S; S.s.init(M, DM, G, bx);
        pg8::EpiBranch E{(const bf16*)(ws + WS_G), (bf16*)(ws + WS_MG)};
        for (int rp_ = 0; rp_ < (REP_PHASE == 4 ? 2 : 1); ++rp_) pg8::gemm_phase<pg8::EpiBranch, pg8::PairOrder, true, true>(lds, g, S, E);
    }
    GRID_SYNC();

    {
        pg8::Gemm g{(const bf16*)(ws + WS_MG), (const bf16*)(ws + WS_WOUT), nullptr, nullptr, DM};
        pg8::StaticOrder S; S.init(M, DM, G, bx);
        pg8::EpiRes<true> E{a.x, a.out, (bf16*)(ws + WS_X1B), SS1};
        pg8::gemm_phase<pg8::EpiRes<true>, pg8::StaticOrder, true, true>(lds, g, S, E);
    }
    GRID_SYNC();

    {
        pg8::Gemm g{(const bf16*)(ws + WS_X1B), (const bf16*)(ws + WS_WUP), nullptr, nullptr, DM};
        pg8::StaticOrder S; S.init(M, DFF, G, bx);
        pg8::EpiUp E{SS1, (bf16*)(ws + WS_U)};
        for (int rp_ = 0; rp_ < (REP_PHASE == 6 ? 2 : 1); ++rp_) pg8::gemm_phase<pg8::EpiUp, pg8::StaticOrder, true, true>(lds, g, S, E);
    }
    GRID_SYNC();

    {
        pg8::Gemm g{(const bf16*)(ws + WS_U), (const bf16*)(ws + WS_WDN), nullptr, nullptr, DFF};
        pg8::StaticOrder S; S.init(M, DM, G, bx);
        pg8::EpiRes<false> E{a.out, a.out, nullptr, SS2};
        pg8::gemm_phase<pg8::EpiRes<false>, pg8::StaticOrder, true, true>(lds, g, S, E);
    }
    GRID_SYNC();

    {
        const int gw = vcu * NWAVES + wave, NGW = G * NWAVES;
        for (int m = gw; m < M; m += NGW) {
            const float rstd = __builtin_amdgcn_rsqf(SS2[m] * (1.f / DM) + RMS_EPS);
            f32x4* xr = (f32x4*)(a.out + (size_t)m * DM) + lane; const f32x4* gr = (const f32x4*)a.final_norm + lane;
#pragma unroll
            for (int j = 0; j < 8; ++j) { const f32x4 v = xr[64 * j], g = gr[64 * j]; xr[64 * j] = v * rstd * g; }
        }
    }
}

extern "C" void kernel_launch(void* const* d_in, const int* in_sizes, int n_in, void* d_out, int out_size, void* d_ws, size_t ws_size, hipStream_t stream) {
    static int grid = 0;
    if (grid == 0) {
        if (n_in != 13 || in_sizes[0] != M * DM || out_size != M * DM || ws_size < WS_END) { fprintf(stderr, "kernel_launch: unexpected shapes (n_in %d, in0 %d, out %d, ws %zu)\n", n_in, n_in > 0 ? in_sizes[0] : -1, out_size, ws_size); grid = -1; return; }
        int dev = 0, cus = 0, per_cu = 0;
        if (hipGetDevice(&dev) != hipSuccess || hipDeviceGetAttribute(&cus, hipDeviceAttributeMultiprocessorCount, dev) != hipSuccess) { grid = -1; return; }
        if (hipFuncSetAttribute((const void*)mega_fwd, hipFuncAttributeMaxDynamicSharedMemorySize, LDS_BYTES) != hipSuccess) { fprintf(stderr, "kernel_launch: hipFuncSetAttribute failed\n"); grid = -1; return; }
        if (hipOccupancyMaxActiveBlocksPerMultiprocessor(&per_cu, (const void*)mega_fwd, NWAVES * 64, LDS_BYTES) != hipSuccess || per_cu < 1) { fprintf(stderr, "kernel_launch: occupancy query says %d\n", per_cu); per_cu = 1; }
        (void)hipGetLastError();
        grid = cus * 1;
    }
    if (grid < 0) return;
    (void)hipMemsetAsync((char*)d_ws + WS_CTL, 0, CTL_ZERO_BYTES, stream);
    Args a{};
    a.x = (const float*)d_in[0]; a.pos = (const int*)d_in[1]; a.attn_norm = (const float*)d_in[2]; a.w_in = (const float*)d_in[3]; a.fbias = (const float*)d_in[4]; a.sinks = (const float*)d_in[5];
    a.w_bs = (const float*)d_in[6]; a.w_bf = (const float*)d_in[7]; a.w_out = (const float*)d_in[8]; a.mlp_norm = (const float*)d_in[9]; a.w_up = (const float*)d_in[10]; a.w_dn = (const float*)d_in[11];
    a.final_norm = (const float*)d_in[12]; a.out = (float*)d_out; a.ws = (unsigned char*)d_ws;
    void* kargs[] = {&a};
    const hipError_t le = hipLaunchCooperativeKernel((const void*)mega_fwd, dim3(grid), dim3(NWAVES * 64), kargs, LDS_BYTES, stream);
    if (le != hipSuccess) fprintf(stderr, "kernel_launch: cooperative launch failed: %s (grid %d)\n", hipGetErrorString(le), grid);
}
```

```cpp
#include <hip/hip_runtime.h>
#include <hip/hip_cooperative_groups.h>
#include <cstdio>
#include <cstdint>
namespace cg = cooperative_groups;

constexpr int BATCH = 4, SEQ = 8192, DM = 2048, M = BATCH * SEQ, DFF = 8192, NIN = 8704  , DIN = 8464;
constexpr float RMS_EPS = 1e-6f;
constexpr float LOG2E = 1.4426950408889634f;
constexpr float C2 = 0.125f * 1.4426950408889634f;

constexpr size_t MiB = 1u << 20;
constexpr size_t WS_CTL = 0, CTL_ZERO_BYTES = 1 * MiB;
constexpr size_t WS_WIN = 1 * MiB, WS_WBS = 35 * MiB, WS_WBF = 39 * MiB, WS_WOUT = 43 * MiB, WS_WUP = 51 * MiB, WS_WDN = 83 * MiB;
constexpr size_t WS_CS = 115 * MiB;
constexpr size_t WS_FL = 123 * MiB, WS_C = 125 * MiB;
constexpr size_t WS_FK = 128 * MiB, WS_FV = 192 * MiB, WS_X1B = 128 * MiB;
constexpr size_t WS_XN = 256 * MiB, WS_MG = 256 * MiB;
constexpr size_t WS_AQ = 384 * MiB, WS_FQ = 448 * MiB, WS_G = 512 * MiB;
constexpr size_t WS_U = 256 * MiB;
constexpr size_t WS_AK = 768 * MiB, WS_AV = 776 * MiB, WS_OA = 784 * MiB, WS_OB = 848 * MiB, WS_END = 912 * MiB;

namespace pg8 {
#define PG8_LAS __attribute__((address_space(3)))
typedef unsigned short bf16_t;
typedef short bf16x8 __attribute__((ext_vector_type(8)));
typedef float f32x4 __attribute__((ext_vector_type(4)));
typedef unsigned u32x4 __attribute__((ext_vector_type(4)));
typedef unsigned u32x2 __attribute__((ext_vector_type(2)));
constexpr int BM = 256, BK = 64, HALF = 128, HTB = HALF * BK * 2  , STAGE_BYTES = 8 * HTB, NXCD = 8, WGM = 8;

__host__ __device__ __forceinline__ int lds_byte(int r, int c) { const int st = (r >> 4) * 2 + (c >> 5), rr = r & 15, cc = c & 31, ob = rr * 64 + cc * 2; return st * 1024 + (ob ^ (((ob >> 9) & 1) << 5)); }
__host__ __device__ __forceinline__ void stage_rc(int b, int& R, int& C) { const int st = b / 1024, sb = b % 1024, swz = sb ^ (((sb >> 9) & 1) << 5); R = (st >> 1) * 16 + swz / 64; C = (st & 1) * 32 + (swz % 64) / 2; }
__host__ __device__ __forceinline__ int perm32(int rho) { const int n = rho >> 4, i = rho & 15; return 8 * (i >> 2) + 4 * n + (i & 3); }

struct Unit { int pm, pn, z; };
struct Gemm { const bf16_t* A0; const bf16_t* B0; const bf16_t* A1; const bf16_t* B1; int K; };

struct StaticOrder {
    int nM, nN, nwg, G, c;
    __host__ __device__ void init(int M_, int N_, int G_, int c_) { nM = M_ / BM; nN = N_ / BM; nwg = nM * nN; G = G_; c = c_; }
    __host__ __device__ bool next(int i, Unit& u) const {
        const long L = (long)i * G + c; if (L >= nwg) return false;
        int wgid = (int)L; { const int q = nwg / NXCD, r = nwg % NXCD, xcd = wgid % NXCD, off = wgid / NXCD; wgid = (xcd < r ? xcd * (q + 1) : r * (q + 1) + (xcd - r) * q) + off; }
        const int nig = WGM * nN, gid = wgid / nig, fm = gid * WGM, gsz = (nM - fm) < WGM ? (nM - fm) : WGM;
        u.pm = fm + ((wgid % nig) % gsz); u.pn = (wgid % nig) / gsz; u.z = 0; return true;
    }
};
struct PairOrder {
    StaticOrder s;
    __host__ __device__ bool next(int i, Unit& u) const { const bool ok = s.next(i >> 1, u); u.z = i & 1; return ok; }
};

__device__ __forceinline__ unsigned cvt_pk_bf16(float lo, float hi) { unsigned r; asm("v_cvt_pk_bf16_f32 %0, %1, %2" : "=v"(r) : "v"(lo), "v"(hi)); return r; }
__device__ __forceinline__ float bf_lo(unsigned w) { return __uint_as_float(w << 16); }
__device__ __forceinline__ float bf_hi(unsigned w) { return __uint_as_float(w & 0xffff0000u); }
__device__ __forceinline__ float sigmoidf_(float x) { return __builtin_amdgcn_rcpf(1.0f + __builtin_amdgcn_exp2f(-x * LOG2E)); }


struct EpiIn {
    static constexpr bool PERM = true;
    unsigned char* ws;
    __device__ __forceinline__ bool keep(const Unit&) const { return false; }
    __device__ __forceinline__ void operator()(f32x4 (&acc)[2][2][4][2], const Unit& u, int wr, int wc, int fr, int fq) const {
        const int pn = u.pn; const int row0 = u.pm * BM + wr * 64 + fr;
        if (pn <= 16) {
            size_t doff; int pitch, colbase; bool rope = false; float sc = 1.f;
            if (pn < 4) { doff = WS_AQ; pitch = 1024; colbase = (4 * pn + wc) * 64; rope = true; sc = C2; }
            else if (pn == 4) { if (wc < 2) { doff = WS_AK; pitch = 128; colbase = wc * 64; rope = true; } else { doff = WS_AV; pitch = 128; colbase = (wc - 2) * 64; } }
            else { const int t = pn - 5, seg = t >> 2, tin = t & 3; doff = WS_FQ; if (seg == 1) doff = WS_FK; if (seg == 2) doff = WS_FV; pitch = 1024; colbase = (4 * tin + wc) * 64; sc = seg == 0 ? C2 : 1.f; }
            bf16_t* dst = (bf16_t*)(ws + doff); const float* cs = (const float*)(ws + WS_CS);
#pragma unroll
            for (int ai = 0; ai < 2; ++ai)
#pragma unroll
                for (int m = 0; m < 4; ++m) {
                    const int row = row0 + ai * HALF + m * 16;
                    f32x4 v00 = acc[ai][0][m][0], v01 = acc[ai][0][m][1], v10 = acc[ai][1][m][0], v11 = acc[ai][1][m][1];
                    if (rope) {
                        const float* cp = cs + (size_t)row * 32 + 8 * fq; const float* sp = cp + (size_t)M * 32;
                        const f32x4 c0 = *(const f32x4*)cp, c1 = *(const f32x4*)(cp + 4), s0 = *(const f32x4*)sp, s1 = *(const f32x4*)(sp + 4);
                        const f32x4 o00 = v00 * c0 - v10 * s0, o10 = v10 * c0 + v00 * s0, o01 = v01 * c1 - v11 * s1, o11 = v11 * c1 + v01 * s1;
                        v00 = o00; v10 = o10; v01 = o01; v11 = o11;
                    }
                    v00 = v00 * sc; v01 = v01 * sc; v10 = v10 * sc; v11 = v11 * sc;
                    bf16_t* rp = dst + (size_t)row * pitch + colbase + 8 * fq;
                    u32x4 w0, w1;
                    w0.x = cvt_pk_bf16(v00[0], v00[1]); w0.y = cvt_pk_bf16(v00[2], v00[3]); w0.z = cvt_pk_bf16(v01[0], v01[1]); w0.w = cvt_pk_bf16(v01[2], v01[3]);
                    w1.x = cvt_pk_bf16(v10[0], v10[1]); w1.y = cvt_pk_bf16(v10[2], v10[3]); w1.z = cvt_pk_bf16(v11[0], v11[1]); w1.w = cvt_pk_bf16(v11[2], v11[3]);
                    *(u32x4*)rp = w0; *(u32x4*)(rp + 32) = w1;
                }
        } else if (pn <= 32) {
            const int col0 = (pn - 17) * BM + wc * 32 + 8 * fq;
#pragma unroll
            for (int ai = 0; ai < 2; ++ai)
#pragma unroll
                for (int m = 0; m < 4; ++m) {
                    bf16_t* rp = (bf16_t*)(ws + WS_G) + (size_t)(row0 + ai * HALF + m * 16) * 4096 + col0;
#pragma unroll
                    for (int bj = 0; bj < 2; ++bj) {
                        const f32x4 a = acc[ai][bj][m][0], b = acc[ai][bj][m][1]; u32x4 w;
                        float s[8];
#pragma unroll
                        for (int i = 0; i < 4; ++i) { s[i] = fmaxf(sigmoidf_(a[i]), 1e-30f); s[4 + i] = fmaxf(sigmoidf_(b[i]), 1e-30f); }
                        w.x = cvt_pk_bf16(s[0], s[1]); w.y = cvt_pk_bf16(s[2], s[3]); w.z = cvt_pk_bf16(s[4], s[5]); w.w = cvt_pk_bf16(s[6], s[7]);
                        *(u32x4*)(rp + bj * HALF) = w;
                    }
                }
        } else {
            if (wc == 0 && fq < 2) {
#pragma unroll
                for (int ai = 0; ai < 2; ++ai)
#pragma unroll
                    for (int m = 0; m < 4; ++m) {
                        float* rp = (float*)(ws + WS_FL) + (size_t)(row0 + ai * HALF + m * 16) * 16 + 8 * fq;
                        *(f32x4*)rp = acc[ai][0][m][0]; *(f32x4*)(rp + 4) = acc[ai][0][m][1];
                    }
            }
        }
    }
};

struct EpiBranch {
    static constexpr bool PERM = true;
    const bf16_t* G; bf16_t* MG;
    __device__ __forceinline__ bool keep(const Unit& u) const { return u.z == 0; }
    __device__ __forceinline__ void operator()(f32x4 (&acc)[2][2][4][2], const Unit& u, int wr, int wc, int fr, int fq) const {
        const int row0 = u.pm * BM + wr * 64 + fr, col0 = u.pn * BM + wc * 32 + 8 * fq; const int z = u.z;
#pragma unroll
        for (int ai = 0; ai < 2; ++ai)
#pragma unroll
            for (int m = 0; m < 4; ++m) {
                const size_t row = (size_t)(row0 + ai * HALF + m * 16);
#pragma unroll
                for (int bj = 0; bj < 2; ++bj) {
                    const bf16_t* gp = G + row * 4096 + col0 + bj * HALF;
                    const u32x4 gb = *(const u32x4*)(gp + 2048);
                    float sb[8];
#pragma unroll
                    for (int i = 0; i < 4; ++i) { sb[2 * i] = bf_lo(gb[i]); sb[2 * i + 1] = bf_hi(gb[i]); }
                    if (z == 0) {
                        const u32x4 ga = *(const u32x4*)gp;
#pragma unroll
                        for (int i = 0; i < 4; ++i) {
                            const float r0 = bf_lo(ga[i]) * __builtin_amdgcn_rcpf(sb[2 * i]), r1 = bf_hi(ga[i]) * __builtin_amdgcn_rcpf(sb[2 * i + 1]);
                            const int e0 = 2 * i, e1 = 2 * i + 1;
                            acc[ai][bj][m][e0 >> 2][e0 & 3] *= r0; acc[ai][bj][m][e1 >> 2][e1 & 3] *= r1;
                        }
                    } else {
                        const f32x4 a = acc[ai][bj][m][0], b = acc[ai][bj][m][1]; u32x4 w;
                        w.x = cvt_pk_bf16(a[0] * sb[0], a[1] * sb[1]); w.y = cvt_pk_bf16(a[2] * sb[2], a[3] * sb[3]);
                        w.z = cvt_pk_bf16(b[0] * sb[4], b[1] * sb[5]); w.w = cvt_pk_bf16(b[2] * sb[6], b[3] * sb[7]);
                        *(u32x4*)(MG + row * 2048 + col0 + bj * HALF) = w;
                    }
                }
            }
    }
};

template <bool WRITE_BF> struct EpiRes {
    static constexpr bool PERM = false;
    const float* base; float* out; bf16_t* xb; float* ss;
    __device__ __forceinline__ bool keep(const Unit&) const { return false; }
    __device__ __forceinline__ void operator()(f32x4 (&acc)[2][2][4][2], const Unit& u, int wr, int wc, int fr, int fq) const {
        const int row0 = u.pm * BM + wr * 64 + fr, col0 = u.pn * BM + wc * 32 + 4 * fq;
#pragma unroll
        for (int ai = 0; ai < 2; ++ai)
#pragma unroll
            for (int m = 0; m < 4; ++m) {
                const size_t row = (size_t)(row0 + ai * HALF + m * 16); const size_t off = row * DM + col0; float q = 0.f;
#pragma unroll
                for (int bj = 0; bj < 2; ++bj)
#pragma unroll
                    for (int n = 0; n < 2; ++n) {
                        const size_t o = off + bj * HALF + n * 16;
                        const f32x4 v = *(const f32x4*)(base + o) + acc[ai][bj][m][n];
                        *(f32x4*)(out + o) = v; q += (v[0] * v[0] + v[1] * v[1]) + (v[2] * v[2] + v[3] * v[3]);
                        if (WRITE_BF) { u32x2 w; w.x = cvt_pk_bf16(v[0], v[1]); w.y = cvt_pk_bf16(v[2], v[3]); *(u32x2*)(xb + o) = w; }
                    }
                q += __shfl_xor(q, 16); q += __shfl_xor(q, 32);
                if (fq == 0) atomicAdd(ss + row, q);
            }
    }
};

struct EpiUp {
    static constexpr bool PERM = true;
    const float* ss; bf16_t* U;
    __device__ __forceinline__ bool keep(const Unit&) const { return false; }
    __device__ __forceinline__ void operator()(f32x4 (&acc)[2][2][4][2], const Unit& u, int wr, int wc, int fr, int fq) const {
        const int row0 = u.pm * BM + wr * 64 + fr, col0 = u.pn * BM + wc * 32 + 8 * fq;
#pragma unroll
        for (int ai = 0; ai < 2; ++ai)
#pragma unroll
            for (int m = 0; m < 4; ++m) {
                const size_t row = (size_t)(row0 + ai * HALF + m * 16);
                const float rstd = __builtin_amdgcn_rsqf(ss[row] * (1.0f / DM) + RMS_EPS);
#pragma unroll
                for (int bj = 0; bj < 2; ++bj) {
                    f32x4 a = acc[ai][bj][m][0] * rstd, b = acc[ai][bj][m][1] * rstd; u32x4 w;
#pragma unroll
                    for (int i = 0; i < 4; ++i) { a[i] = fmaxf(a[i], 0.f); a[i] *= a[i]; b[i] = fmaxf(b[i], 0.f); b[i] *= b[i]; }
                    w.x = cvt_pk_bf16(a[0], a[1]); w.y = cvt_pk_bf16(a[2], a[3]); w.z = cvt_pk_bf16(b[0], b[1]); w.w = cvt_pk_bf16(b[2], b[3]);
                    *(u32x4*)(U + row * DFF + col0 + bj * HALF) = w;
                }
            }
    }
};

template <class Epi, class Sched, bool ALIGN_EPI = false, bool SP2 = false>
__device__ __forceinline__ void gemm_phase(PG8_LAS unsigned char* lds, const Gemm g, const Sched& S, const Epi& E) {
    int tid_ = threadIdx.x; asm volatile("" : "+v"(tid_));
    const int tid = tid_, wid = __builtin_amdgcn_readfirstlane(tid >> 6), lane = tid & 63, wr = wid >> 2, wc = wid & 3, fr = lane & 15, fq = lane >> 4;
    const int K = g.K, nt = K / BK;
    unsigned voffA[2], voffB[2];
#pragma unroll
    for (int i = 0; i < 2; ++i) { int R, C; stage_rc(tid * 16 + i * 8192, R, C); const int Rb = Epi::PERM ? ((R & ~31) + perm32(R & 31)) : R;
        voffA[i] = (unsigned)(R * K + C) * 2u; voffB[i] = (unsigned)(Rb * K + C) * 2u; }
    const size_t kstep = (size_t)(BK * 2);
    const size_t hstep = (size_t)HALF * K * 2;
    const size_t tstep = 2 * hstep;
    const unsigned ldsw = (unsigned)wid * 1024u;
    const int aoff = lds_byte(wr * 64 + fr, fq * 8), boff = lds_byte(wc * 32 + fr, fq * 8);
#define PG8_SA(b, h) (((b) * 2 + (h)) * HTB)
#define PG8_SB(b, h) ((4 + (b) * 2 + (h)) * HTB)
#define PG8_STAGE(bufoff, gbase, voff) do { _Pragma("unroll") for (int _i = 0; _i < 2; ++_i) \
        __builtin_amdgcn_global_load_lds((const unsigned*)((const char*)(gbase) + (voff)[_i]), (PG8_LAS unsigned*)(lds + (bufoff) + ldsw + _i * 8192), 16, 0, 0); } while (0)
#define PG8_LDA(dst, b, h) do { _Pragma("unroll") for (int m = 0; m < 4; ++m) _Pragma("unroll") for (int k = 0; k < 2; ++k) dst[m][k] = *(const PG8_LAS bf16x8*)(lds + PG8_SA(b, h) + aoff + m * 2048 + k * 1024); } while (0)
#define PG8_LDB(dst, b, h) do { _Pragma("unroll") for (int n = 0; n < 2; ++n) _Pragma("unroll") for (int k = 0; k < 2; ++k) dst[n][k] = *(const PG8_LAS bf16x8*)(lds + PG8_SB(b, h) + boff + n * 2048 + k * 1024); } while (0)
#define PG8_MMA(ai, bj, At, Bt) do { __builtin_amdgcn_s_setprio(1); _Pragma("unroll") for (int m = 0; m < 4; ++m) _Pragma("unroll") for (int n = 0; n < 2; ++n) _Pragma("unroll") for (int k = 0; k < 2; ++k) \
        acc[ai][bj][m][n] = __builtin_amdgcn_mfma_f32_16x16x32_bf16(Bt[n][k], At[m][k], acc[ai][bj][m][n], 0, 0, 0); __builtin_amdgcn_s_setprio(0); } while (0)
#define PG8_WAIT_V(n) asm volatile("s_waitcnt vmcnt(" #n ")" ::: "memory")
#define PG8_WAIT_L(n) asm volatile("s_waitcnt lgkmcnt(" #n ")" ::: "memory")
#define PG8_BAR __builtin_amdgcn_s_barrier()
#define PG8_SCHED __builtin_amdgcn_sched_barrier(0)
    Unit cur, nxt; int ui = 0;
    if (!S.next(0, cur)) return;
    f32x4 acc[2][2][4][2];
#pragma unroll
    for (int a = 0; a < 2; ++a)
#pragma unroll
        for (int b = 0; b < 2; ++b)
#pragma unroll
            for (int m = 0; m < 4; ++m)
#pragma unroll
                for (int n = 0; n < 2; ++n) acc[a][b][m][n] = (f32x4){0.f, 0.f, 0.f, 0.f};
    bf16x8 At[4][2], B0[2][2], B1[2][2];
    const char* cA = (const char*)(cur.z ? g.A1 : g.A0) + (size_t)cur.pm * tstep; const char* cB = (const char*)(cur.z ? g.B1 : g.B0) + (size_t)cur.pn * tstep;
    if constexpr (SP2) {
        PG8_STAGE(PG8_SB(0, 0), cB, voffB); PG8_STAGE(PG8_SB(0, 1), cB + hstep, voffB); PG8_STAGE(PG8_SA(0, 0), cA, voffA); PG8_STAGE(PG8_SA(0, 1), cA + hstep, voffA);
        if (wr == 1) PG8_BAR;
        PG8_WAIT_V(2); PG8_BAR;
        PG8_STAGE(PG8_SB(1, 0), cB + kstep, voffB); PG8_STAGE(PG8_SA(1, 0), cA + kstep, voffA); PG8_STAGE(PG8_SB(1, 1), cB + hstep + kstep, voffB);
        PG8_WAIT_V(6); PG8_BAR;
    } else {
        PG8_STAGE(PG8_SB(0, 0), cB, voffB); PG8_STAGE(PG8_SA(0, 0), cA, voffA); PG8_STAGE(PG8_SB(0, 1), cB + hstep, voffB); PG8_STAGE(PG8_SA(0, 1), cA + hstep, voffA);
        if (wr == 1) PG8_BAR;
        PG8_WAIT_V(4); PG8_BAR;
        PG8_STAGE(PG8_SB(1, 0), cB + kstep, voffB); PG8_STAGE(PG8_SA(1, 0), cA + kstep, voffA); PG8_STAGE(PG8_SB(1, 1), cB + hstep + kstep, voffB);
        PG8_WAIT_V(6); PG8_BAR;
    }
    for (;;) {
        const bool has_next = S.next(ui + 1, nxt);
        const char* nA = has_next ? (const char*)(nxt.z ? g.A1 : g.A0) + (size_t)nxt.pm * tstep : cA; const char* nB = has_next ? (const char*)(nxt.z ? g.B1 : g.B0) + (size_t)nxt.pn * tstep : cB;
        for (int t = 0; t < nt; t += 2) {
            const bool last = (t == nt - 2);
            const char* a1 = cA + (size_t)(t + 1) * kstep;
            const char* a2 = last ? nA : cA + (size_t)(t + 2) * kstep; const char* b2 = last ? nB : cB + (size_t)(t + 2) * kstep;
            const char* a3 = a2 + kstep; const char* b3 = b2 + kstep;
            if constexpr (SP2) {
            PG8_LDB(B0, 0, 0); PG8_LDB(B1, 0, 1); PG8_SCHED; PG8_LDA(At, 0, 0); PG8_STAGE(PG8_SA(1, 1), a1 + hstep, voffA);
            PG8_WAIT_V(8); PG8_WAIT_L(0); PG8_BAR; PG8_MMA(0, 0, At, B0); PG8_MMA(0, 1, At, B1); PG8_BAR; PG8_SCHED;
            PG8_LDA(At, 0, 1); PG8_STAGE(PG8_SB(0, 0), b2, voffB); PG8_STAGE(PG8_SB(0, 1), b2 + hstep, voffB); PG8_STAGE(PG8_SA(0, 0), a2, voffA);
            PG8_WAIT_V(8); PG8_WAIT_L(0); PG8_BAR; PG8_MMA(1, 0, At, B0); PG8_MMA(1, 1, At, B1); PG8_BAR; PG8_SCHED;
            PG8_LDB(B0, 1, 0); PG8_LDB(B1, 1, 1); PG8_SCHED; PG8_LDA(At, 1, 0); PG8_STAGE(PG8_SA(0, 1), a2 + hstep, voffA);
            PG8_WAIT_V(8); PG8_WAIT_L(0); PG8_BAR; PG8_MMA(0, 0, At, B0); PG8_MMA(0, 1, At, B1); PG8_BAR; PG8_SCHED;
            PG8_LDA(At, 1, 1); PG8_STAGE(PG8_SB(1, 0), b3, voffB); PG8_STAGE(PG8_SB(1, 1), b3 + hstep, voffB); PG8_STAGE(PG8_SA(1, 0), a3, voffA);
            PG8_WAIT_V(8); PG8_WAIT_L(0); PG8_BAR; PG8_MMA(1, 0, At, B0); PG8_MMA(1, 1, At, B1); PG8_BAR; PG8_SCHED;
            } else {
            PG8_LDB(B0, 0, 0); PG8_SCHED; PG8_LDA(At, 0, 0); PG8_STAGE(PG8_SA(1, 1), a1 + hstep, voffA);
            PG8_WAIT_L(8); PG8_BAR; PG8_WAIT_L(0); PG8_MMA(0, 0, At, B0); PG8_BAR; PG8_SCHED;
            PG8_LDB(B1, 0, 1); PG8_STAGE(PG8_SB(0, 0), b2, voffB);
            PG8_BAR; PG8_WAIT_L(0); PG8_MMA(0, 1, At, B1); PG8_BAR;
            PG8_LDA(At, 0, 1); PG8_STAGE(PG8_SA(0, 0), a2, voffA);
            PG8_BAR; PG8_WAIT_L(0); PG8_MMA(1, 0, At, B0); PG8_BAR; PG8_SCHED;
            PG8_STAGE(PG8_SB(0, 1), b2 + hstep, voffB);
            PG8_WAIT_V(6); PG8_BAR; PG8_MMA(1, 1, At, B1); PG8_BAR;
            PG8_LDB(B0, 1, 0); PG8_SCHED; PG8_LDA(At, 1, 0); PG8_STAGE(PG8_SA(0, 1), a2 + hstep, voffA);
            PG8_WAIT_L(8); PG8_BAR; PG8_WAIT_L(0); PG8_MMA(0, 0, At, B0); PG8_BAR; PG8_SCHED;
            PG8_LDB(B1, 1, 1); PG8_STAGE(PG8_SB(1, 0), b3, voffB);
            PG8_BAR; PG8_WAIT_L(0); PG8_MMA(0, 1, At, B1); PG8_BAR;
            PG8_LDA(At, 1, 1); PG8_STAGE(PG8_SA(1, 0), a3, voffA);
            PG8_BAR; PG8_WAIT_L(0); PG8_MMA(1, 0, At, B0); PG8_BAR; PG8_SCHED;
            PG8_STAGE(PG8_SB(1, 1), b3 + hstep, voffB);
            PG8_WAIT_V(6); PG8_BAR; PG8_MMA(1, 1, At, B1); PG8_BAR;
            }
        }
        if constexpr (ALIGN_EPI) { if (wr == 0) PG8_BAR; }
        E(acc, cur, wr, wc, fr, fq);
        if (!has_next) break;
        if (!E.keep(cur))
#pragma unroll
        for (int a = 0; a < 2; ++a)
#pragma unroll
            for (int b = 0; b < 2; ++b)
#pragma unroll
                for (int m = 0; m < 4; ++m)
#pragma unroll
                    for (int n = 0; n < 2; ++n) acc[a][b][m][n] = (f32x4){0.f, 0.f, 0.f, 0.f};
        cur = nxt; cA = nA; cB = nB; ++ui;
        if constexpr (ALIGN_EPI) { if (wr == 1) PG8_BAR; }
    }
    PG8_WAIT_V(0);
    if constexpr (!ALIGN_EPI) { if (wr == 0) PG8_BAR; }
    PG8_BAR;
#undef PG8_SA
#undef PG8_SB
#undef PG8_STAGE
#undef PG8_LDA
#undef PG8_LDB
#undef PG8_MMA
#undef PG8_WAIT_V
#undef PG8_WAIT_L
#undef PG8_BAR
#undef PG8_SCHED
}
}


namespace attn_body {
using bf16=unsigned short;
using bf16x8=__attribute__((ext_vector_type(8)))short;
using s16x4=__attribute__((ext_vector_type(4)))short;
using f32x16=__attribute__((ext_vector_type(16)))float;
using u32x4=__attribute__((ext_vector_type(4)))unsigned;
using f32x4v=__attribute__((ext_vector_type(4)))float;
constexpr int BATCH=4,NHEAD=16,SEQ=8192,D=64,DM=NHEAD*D;
constexpr int NW=8,QBLK=32,QB=QBLK*NW,KVBLK=64,NQB=SEQ/QB;
constexpr int ATTN_PITCH=DM, ATTN_UNIT_ROWS=QB;
__device__ __forceinline__ int crow(int r,int hi){return (r&3)+8*(r>>2)+4*hi;}
#define SBAR() __builtin_amdgcn_sched_barrier(0)
template<bool SWA> __device__ __forceinline__ void cmask(f32x16&p0,f32x16&p1,int jb,int qrel,int hi){
  const float NEG=-INFINITY; int kb=64*jb+4*hi;
  #pragma unroll
  for(int r=0;r<16;++r){int kv=kb+(r&3)+8*(r>>2);
    if(SWA){ if(kv>qrel||kv<=qrel-128)p0[r]=NEG; if(kv+32>qrel||kv+32<=qrel-128)p1[r]=NEG; }
    else{ if(kv>qrel)p0[r]=NEG; if(kv+32>qrel)p1[r]=NEG; } }
}

constexpr int NSLOT=3, SLOTB=8192;
#ifndef NVB
#define NVB 8
#endif
constexpr int LDS_K=0, LDS_V=NSLOT*SLOTB, LDS_WS=2*NSLOT*SLOTB, LDS_OST=LDS_WS+NW*64*4, LDS_CB=LDS_OST+NW*4096, LDS_BYTES=LDS_CB+4*256;
constexpr float C2=0.125f*1.4426950408889634f;
__device__ __forceinline__ void glds16(const void*gsrc,unsigned lds_dst){unsigned keep;
  asm volatile("s_mov_b32 %0, m0\n\ts_mov_b32 m0, %2\n\ts_nop 0\n\tglobal_load_lds_dwordx4 %1, off\n\ts_mov_b32 m0, %0":"=&s"(keep):"v"(gsrc),"s"(lds_dst):"memory");}
__device__ __forceinline__ void glds4(const void*gsrc,unsigned lds_dst){unsigned keep;
  asm volatile("s_mov_b32 %0, m0\n\ts_mov_b32 m0, %2\n\ts_nop 0\n\tglobal_load_lds_dword %1, off\n\ts_mov_b32 m0, %0":"=&s"(keep):"v"(gsrc),"s"(lds_dst):"memory");}
__device__ __forceinline__ float max3f(float a,float b,float c){float r;asm("v_max3_f32 %0, %1, %2, %3":"=v"(r):"v"(a),"v"(b),"v"(c));return r;}
__device__ __forceinline__ float max2f(float a,float b){float r;asm("v_max_f32_e32 %0, %1, %2":"=v"(r):"v"(a),"v"(b));return r;}
__device__ __forceinline__ float fadd_s(float a,float b){float r;asm("v_add_f32_e32 %0, %1, %2":"=v"(r):"v"(a),"v"(b));return r;}
__device__ __forceinline__ float fsub_s(float a,float b){float r;asm("v_sub_f32_e32 %0, %1, %2":"=v"(r):"v"(a),"v"(b));return r;}
typedef float f32x2_t __attribute__((ext_vector_type(2))); typedef __bf16 bf16x2_t __attribute__((ext_vector_type(2)));
__device__ __forceinline__ unsigned cvtpk_s(float lo,float hi){f32x2_t v={lo,hi};bf16x2_t b=__builtin_convertvector(v,bf16x2_t);return __builtin_bit_cast(unsigned,b);}
#define WAIT_BAR(N) asm volatile("s_waitcnt vmcnt(" #N ") lgkmcnt(0)\n\ts_barrier":::"memory")

__device__ __forceinline__ void qkt(f32x16&p0,f32x16&p1,const char*Kslot,const bf16x8*qr,int r32,int hi){
  const char*kb=Kslot+hi*1024+r32*16;
  #pragma unroll
  for(int d0=0;d0<4;++d0){
    const bf16x8 b0=*reinterpret_cast<const bf16x8*>(kb+d0*2048);
    const bf16x8 b1=*reinterpret_cast<const bf16x8*>(kb+d0*2048+512);
    {p0=__builtin_amdgcn_mfma_f32_32x32x16_bf16(b0,qr[d0],p0,0,0,0);p1=__builtin_amdgcn_mfma_f32_32x32x16_bf16(b1,qr[d0],p1,0,0,0);}}
}
typedef __attribute__((address_space(3))) const char* lds_cptr;
typedef short v4i16_t __attribute__((ext_vector_type(4)));
__device__ __forceinline__ void kload8(bf16x8*kf,lds_cptr kp){
  kf[0]=*(const __attribute__((address_space(3))) bf16x8*)(kp);      kf[1]=*(const __attribute__((address_space(3))) bf16x8*)(kp+512);
  kf[2]=*(const __attribute__((address_space(3))) bf16x8*)(kp+2048); kf[3]=*(const __attribute__((address_space(3))) bf16x8*)(kp+2560);
  kf[4]=*(const __attribute__((address_space(3))) bf16x8*)(kp+4096); kf[5]=*(const __attribute__((address_space(3))) bf16x8*)(kp+4608);
  kf[6]=*(const __attribute__((address_space(3))) bf16x8*)(kp+6144); kf[7]=*(const __attribute__((address_space(3))) bf16x8*)(kp+6656);
}
__device__ __forceinline__ void kload2(bf16x8*kf,lds_cptr kp,int j){ kf[2*j]=*(const __attribute__((address_space(3))) bf16x8*)(kp+j*2048); kf[2*j+1]=*(const __attribute__((address_space(3))) bf16x8*)(kp+j*2048+512); }
__device__ __forceinline__ s16x4 vtr(lds_cptr p){ return __builtin_bit_cast(s16x4,__builtin_amdgcn_ds_read_tr16_b64_v4i16((__attribute__((address_space(3))) v4i16_t*)p)); }
__device__ __forceinline__ float rowmax(const f32x16&p0,const f32x16&p1){
  float a=max3f(p0[0],p0[1],p1[0]),b=max3f(p0[2],p0[3],p1[1]);a=max3f(a,p1[2],p1[3]);
  #pragma unroll
  for(int r=4;r<16;r+=4){a=max3f(a,p0[r],p0[r+1]);b=max3f(b,p0[r+2],p0[r+3]);a=max3f(a,p1[r],p1[r+1]);b=max3f(b,p1[r+2],p1[r+3]);}
  const float m=max2f(a,b);
  auto rr=__builtin_amdgcn_permlane32_swap(__float_as_uint(m),__float_as_uint(m),false,false);
  return max2f(__uint_as_float(rr[0]),__uint_as_float(rr[1]));
}
__device__ __forceinline__ void pv(f32x16*o,int vb,bf16x8 pa0,bf16x8 pa1,bf16x8 pa2,bf16x8 pa3){
  #pragma unroll
  for(int d0=0;d0<2;++d0){s16x4 lo[4],hi[4];
    #pragma unroll
    for(int ks=0;ks<4;++ks){
      asm volatile("ds_read_b64_tr_b16 %0,%1 offset:%c2":"=&v"(lo[ks]):"v"(vb),"i"(d0*4096+ks*1024):"memory");
      asm volatile("ds_read_b64_tr_b16 %0,%1 offset:%c2":"=&v"(hi[ks]):"v"(vb),"i"(d0*4096+ks*1024+512):"memory");}
    asm volatile("s_waitcnt lgkmcnt(0)":::"memory");SBAR();
    #define PK(k) (bf16x8){lo[k][0],lo[k][1],lo[k][2],lo[k][3],hi[k][0],hi[k][1],hi[k][2],hi[k][3]}
    o[d0]=__builtin_amdgcn_mfma_f32_32x32x16_bf16(pa0,PK(0),o[d0],0,0,0);
    o[d0]=__builtin_amdgcn_mfma_f32_32x32x16_bf16(pa1,PK(1),o[d0],0,0,0);
    o[d0]=__builtin_amdgcn_mfma_f32_32x32x16_bf16(pa2,PK(2),o[d0],0,0,0);
    o[d0]=__builtin_amdgcn_mfma_f32_32x32x16_bf16(pa3,PK(3),o[d0],0,0,0);
    #undef PK
  }
}

typedef __attribute__((address_space(3))) const f32x4v* lds_f4ptr;
__device__ __forceinline__ void fill_bias(f32x16&c0,f32x16&c1,lds_cptr cb,float negmh){
  #pragma unroll
  for(int g=0;g<4;++g){ const f32x4v v=*(lds_f4ptr)(cb+g*32), w=*(lds_f4ptr)(cb+128+g*32);
    #pragma unroll
    for(int i=0;i<4;++i){ c0[4*g+i]=negmh-v[i]; c1[4*g+i]=negmh-w[i]; } }
}
#ifndef ATTN_STORE16
#define ATTN_STORE16(p,v) (*(u32x4*)(p)=(v))
#endif
template<int THRL,bool FOX,int KP> __device__ __forceinline__ void attn_unit(int b,int h,int qb,const bf16*Q,const bf16*__restrict__ K,const bf16*__restrict__ V,bf16*O,const float*__restrict__ Cb,float sink2,char*shm){
  int tid_=threadIdx.x; asm volatile("":"+v"(tid_));
  const int tid=tid_,lane=tid&63,r32=lane&31,hi=lane>>5; const int wid=__builtin_amdgcn_readfirstlane(tid>>6);
  const long rowbase=(long)b*SEQ; const int q0=qb*QB;
  const bf16*Qw=Q+(rowbase+q0+wid*QBLK)*DM+h*D;
  const int kvh=FOX?h:(h>>3); const int T0=FOX?0:(qb==0?0:4*qb-2);
  const bf16*Kh=K+(rowbase+(long)T0*KVBLK)*KP+kvh*D,*Vh=V+(rowbase+(long)T0*KVBLK)*KP+kvh*D; const float*Cs=FOX?Cb+lane:nullptr;
  const unsigned lds0=(unsigned)(uintptr_t)shm;
  float*wsf=(float*)(shm+LDS_WS)+wid*64;
  const bf16*ksrc=Kh+(long)lane*KP+wid*8;
  const bf16*vsrc=Vh+(long)(16*(wid&3)+(lane>>2))*KP+(wid>>2)*32+(lane&3)*8;
  const unsigned kdst=lds0+LDS_K+wid*1024, vdst=lds0+LDS_V+wid*1024;
  #define DMA_K(t,slot) glds16(ksrc+(long)(t)*KVBLK*KP,(unsigned)__builtin_amdgcn_readfirstlane(kdst+(slot)))
  #define DMA_C(t) do{ if(FOX) glds4(Cs+(long)(t)*KVBLK,(unsigned)__builtin_amdgcn_readfirstlane(lds0+LDS_CB+(((t)&3)<<8))); }while(0)
  #define PREFILL(X0,X1,t) do{ if(FOX){ fill_bias(X0,X1,cb0+(((t)&3)<<8),-mhat); } else { _Pragma("unroll") for(int r=0;r<16;++r){X0[r]=-mhat;X1[r]=-mhat;} } }while(0)
  #define DMA_V(t,slot) glds16(vsrc+(long)(t)*KVBLK*KP,(unsigned)__builtin_amdgcn_readfirstlane(vdst+(slot)))
  const int vb0=(int)(lds0+LDS_V)+((lane>>4)&1)*32+(lane&3)*8+(4*hi+((lane&15)>>2))*64;
  const char*Kbase=shm+LDS_K; bf16x8 kf[8];
  const lds_cptr shm3=(lds_cptr)shm; const lds_cptr cb0=shm3+LDS_CB+hi*16; const lds_cptr kp0=shm3+LDS_K+hi*1024+r32*16; const lds_cptr vp0=shm3+LDS_V+((lane>>4)&1)*32+(lane&3)*8+(4*hi+((lane&15)>>2))*64;
  const int NT=FOX?(q0+QB)/KVBLK:(qb==0?4:6);
  DMA_K(0,0);DMA_C(0);DMA_V(0,0);DMA_K(1,SLOTB);DMA_C(1);
  bf16x8 qr[4];
  #pragma unroll
  for(int d0=0;d0<4;++d0)qr[d0]=*reinterpret_cast<const bf16x8*>(&Qw[(long)r32*DM+d0*16+hi*8]);
  float mhat=FOX?-Cb[q0+wid*QBLK+r32]:0.f,l_reg=0.f;    f32x16 o[2];o[0]=f32x16{};o[1]=f32x16{};
  const int qrel=wid*QBLK+r32;
  #define CMASK(P0,P1,t) do{int jb_=(t)-(NT-4); if(!FOX||jb_>=0)cmask<!FOX>(P0,P1,jb_,qrel,hi);}while(0)
  bool resc=false;
  #define START(P0,P1) do{ float rm=__builtin_fmaxf(rowmax(P0,P1),0.f); resc=false;     \
    { const float dl=rm; mhat=fadd_s(mhat,dl); \
      _Pragma("unroll") for(int r=0;r<16;++r){P0[r]=fsub_s(P0[r],dl);P1[r]=fsub_s(P1[r],dl);} } \
    _Pragma("unroll") for(int r=0;r<16;++r)P0[r]=__builtin_amdgcn_exp2f(P0[r]); }while(0)
  #define RESC() do{ if(resc){ asm volatile("s_waitcnt lgkmcnt(0)":::"memory"); \
      _Pragma("unroll") for(int d_=0;d_<2;++d_) _Pragma("unroll") for(int r=0;r<16;++r)o[d_][r]*=wsf[crow(r,hi)]; } }while(0)
  f32x16 pA0,pA1,pB0,pB1;
  int sl_prev=0,sl_cur=0,sl_next=SLOTB;
  #define ROT() do{sl_prev=sl_cur;sl_cur=sl_next;sl_next=(sl_next==(NSLOT-1)*SLOTB)?0:sl_next+SLOTB;}while(0)
  DMA_K(2,2*SLOTB);DMA_C(2);
  if(FOX){WAIT_BAR(5);}else{WAIT_BAR(3);}
  PREFILL(pA0,pA1,0); qkt(pA0,pA1,Kbase,qr,r32,hi);asm volatile("s_nop 15\n\ts_nop 7":"+v"(pA0),"+v"(pA1));CMASK(pA0,pA1,0);
  START(pA0,pA1);
  _Pragma("unroll") for(int r=0;r<16;++r)pA1[r]=__builtin_amdgcn_exp2f(pA1[r]);
  WAIT_BAR(0);
  DMA_K(3,0);DMA_C(3);DMA_V(1,SLOTB);
  ROT();
  kload8(kf,kp0+sl_cur);
  PREFILL(pB0,pB1,1); if(FOX){ WAIT_BAR(3); }else{ WAIT_BAR(2); }
  s16x4 vlo[NVB],vhi[NVB]; u32x4 pw0,pw1,pw2,pw3;
  #define PKW(P,B) cvtpk_s(P[B],P[B+1])
  #define PAF(k) __builtin_bit_cast(bf16x8,pw##k)
  #define VFR(j) (bf16x8){vlo[(j)%NVB][0],vlo[(j)%NVB][1],vlo[(j)%NVB][2],vlo[(j)%NVB][3],vhi[(j)%NVB][0],vhi[(j)%NVB][1],vhi[(j)%NVB][2],vhi[(j)%NVB][3]}
  #define PIN(x) asm volatile("":"+v"(x))
  #define MX3(a,b,c) __builtin_fmaxf(__builtin_fmaxf((a),(b)),(c))
  #define GAPA(MF,A0,A1,A2,A3,W0,W1,PW) do{ MF; sacc+=A0; sacc+=A1; sacc+=A2; sacc+=A3; PIN(sacc); W0; W1; PIN(PW); SBAR(); }while(0)
  #define EX(v) __builtin_amdgcn_exp2f(v)
  #define GAPB(MF,VR,X,B) do{ MF; VR; X[B]=EX(X[B]); X[B+1]=EX(X[B+1]); X[B+2]=EX(X[B+2]); X[B+3]=EX(X[B+3]); PIN(X); SBAR(); }while(0)
  #define VOFF(j) ((((j)&1)*4096)+(((j)>>1)*1024))
  #define VRD(j) do{ if((j)>=0&&(j)<8){ vlo[(j)%NVB]=vtr(vp_+VOFF(j)); vhi[(j)%NVB]=vtr(vp_+VOFF(j)+512); } }while(0)
  #define KRD(G,j) do{ if(G){ kload2(kf,kp0+sl_next,j); SBAR(); } }while(0)
  #define STEP(C0,C1,P0,P1,t,GK,GV,GL) do{ SBAR(); \
    const lds_cptr vp_=vp0+sl_prev; \
    VRD(0-(8-NVB)); SBAR(); float sacc=(P0[0]+P0[1]); \
    GAPA(C0=__builtin_amdgcn_mfma_f32_32x32x16_bf16(kf[0],qr[0],C0,0,0,0), P0[2],P0[3],P0[4],P0[5],     pw0[0]=PKW(P0,0), pw0[1]=PKW(P0,2), pw0); \
    VRD(1-(8-NVB)); SBAR(); GAPA(C1=__builtin_amdgcn_mfma_f32_32x32x16_bf16(kf[1],qr[0],C1,0,0,0), P0[6],P0[7],P0[8],P0[9],     pw0[2]=PKW(P0,4), pw0[3]=PKW(P0,6), pw0); \
    VRD(2-(8-NVB)); SBAR(); GAPA(C0=__builtin_amdgcn_mfma_f32_32x32x16_bf16(kf[2],qr[1],C0,0,0,0),   P0[10],P0[11],P0[12],P0[13], pw1[0]=PKW(P0,8), pw1[1]=PKW(P0,10), pw1); \
    VRD(3-(8-NVB)); SBAR(); GAPA(C1=__builtin_amdgcn_mfma_f32_32x32x16_bf16(kf[3],qr[1],C1,0,0,0),   P0[14],P0[15],P1[0],P1[1],   pw1[2]=PKW(P0,12),pw1[3]=PKW(P0,14), pw1); \
    VRD(4-(8-NVB)); SBAR(); GAPA(C0=__builtin_amdgcn_mfma_f32_32x32x16_bf16(kf[4],qr[2],C0,0,0,0),   P1[2],P1[3],P1[4],P1[5],     pw2[0]=PKW(P1,0), pw2[1]=PKW(P1,2), pw2); \
    VRD(5-(8-NVB)); SBAR(); GAPA(C1=__builtin_amdgcn_mfma_f32_32x32x16_bf16(kf[5],qr[2],C1,0,0,0),   P1[6],P1[7],P1[8],P1[9],     pw2[2]=PKW(P1,4), pw2[3]=PKW(P1,6), pw2); \
    VRD(6-(8-NVB)); SBAR(); GAPA(C0=__builtin_amdgcn_mfma_f32_32x32x16_bf16(kf[6],qr[3],C0,0,0,0),   P1[10],P1[11],P1[12],P1[13], pw3[0]=PKW(P1,8), pw3[1]=PKW(P1,10), pw3); \
    VRD(7-(8-NVB)); SBAR(); GAPA(C1=__builtin_amdgcn_mfma_f32_32x32x16_bf16(kf[7],qr[3],C1,0,0,0),   P1[14],P1[15],0.f,0.f,       pw3[2]=PKW(P1,12),pw3[3]=PKW(P1,14), pw3); \
    l_reg+=sacc; \
    if(GK){DMA_K((t)+3,sl_cur);DMA_C((t)+3);} if(GV){DMA_V((t)+1,sl_next);} \
    CMASK(C0,C1,t); \
    { float a=MX3(C0[0],C0[1],C1[0]),b=MX3(C0[2],C0[3],C1[1]); a=MX3(a,C1[2],C1[3]); \
      _Pragma("unroll") for(int r=4;r<16;r+=4){a=MX3(a,C0[r],C0[r+1]);b=MX3(b,C0[r+2],C0[r+3]);a=MX3(a,C1[r],C1[r+1]);b=MX3(b,C1[r+2],C1[r+3]);} \
      float rm=__builtin_fmaxf(a,b); { auto rr=__builtin_amdgcn_permlane32_swap(__float_as_uint(rm),__float_as_uint(rm),false,false); rm=__builtin_fmaxf(__uint_as_float(rr[0]),__uint_as_float(rr[1])); } \
      resc=false; \
      if(__builtin_expect(__any(rm>(float)THRL),0)){ const float dl=__builtin_fmaxf(rm,0.f); mhat+=dl; \
        _Pragma("unroll") for(int r=0;r<16;++r){C0[r]-=dl;C1[r]-=dl;} \
        const float f=__builtin_amdgcn_exp2f(-dl); l_reg*=f; if(hi==0)wsf[r32]=f; resc=true; } } \
    SBAR(); \
    GAPB(o[0]=__builtin_amdgcn_mfma_f32_32x32x16_bf16(PAF(0),VFR(0),o[0],0,0,0), VRD(0+NVB), C0,0); \
    GAPB(o[1]=__builtin_amdgcn_mfma_f32_32x32x16_bf16(PAF(0),VFR(1),o[1],0,0,0), VRD(1+NVB), C0,4); \
    KRD(GL,0); GAPB(o[0]=__builtin_amdgcn_mfma_f32_32x32x16_bf16(PAF(1),VFR(2),o[0],0,0,0), VRD(2+NVB), C0,8); \
    KRD(GL,1); GAPB(o[1]=__builtin_amdgcn_mfma_f32_32x32x16_bf16(PAF(1),VFR(3),o[1],0,0,0), VRD(3+NVB), C0,12); \
    KRD(GL,2); GAPB(o[0]=__builtin_amdgcn_mfma_f32_32x32x16_bf16(PAF(2),VFR(4),o[0],0,0,0), VRD(4+NVB), C1,0); \
    KRD(GL,3); GAPB(o[1]=__builtin_amdgcn_mfma_f32_32x32x16_bf16(PAF(2),VFR(5),o[1],0,0,0), VRD(5+NVB), C1,4); \
    GAPB(o[0]=__builtin_amdgcn_mfma_f32_32x32x16_bf16(PAF(3),VFR(6),o[0],0,0,0), VRD(6+NVB), C1,8); \
    GAPB(o[1]=__builtin_amdgcn_mfma_f32_32x32x16_bf16(PAF(3),VFR(7),o[1],0,0,0), VRD(7+NVB), C1,12); \
    if(GL){ PREFILL(P0,P1,(t)+1); } \
    }while(0)
  int t=1;
  #undef CMASK
  #define CMASK(P0,P1,t) do{}while(0)
  for(;t+5<NT;t+=2){
    STEP(pB0,pB1,pA0,pA1,t,true,true,true);     if(FOX){WAIT_BAR(3);}else{WAIT_BAR(2);} RESC(); ROT();
    STEP(pA0,pA1,pB0,pB1,t+1,true,true,true);   if(FOX){WAIT_BAR(3);}else{WAIT_BAR(2);} RESC(); ROT();
  }
  #undef CMASK
  #define CMASK(P0,P1,t) do{int jb_=(t)-(NT-4); if(!FOX||jb_>=0)cmask<!FOX>(P0,P1,jb_,qrel,hi);}while(0)
  #define ENDW(tt) do{ if((tt)+3<NT){ if(FOX){WAIT_BAR(3);}else{WAIT_BAR(2);} } else if((tt)+2<NT){WAIT_BAR(1);} else {WAIT_BAR(0);} }while(0)
  for(;t+1<NT;t+=2){
    STEP(pB0,pB1,pA0,pA1,t,(t+3<NT),(t+1<NT),(t+1<NT));       ENDW(t);   RESC(); ROT();
    STEP(pA0,pA1,pB0,pB1,t+1,(t+4<NT),(t+2<NT),(t+2<NT));     ENDW(t+1); RESC(); ROT();
  }
  STEP(pB0,pB1,pA0,pA1,NT-1,false,false,false); RESC();
  { float sacc=pB0[0]+pB0[1]; _Pragma("unroll") for(int r=2;r<16;++r)sacc+=pB0[r]; _Pragma("unroll") for(int r=0;r<16;++r)sacc+=pB1[r]; l_reg+=sacc;
    pw0=(u32x4){PKW(pB0,0),PKW(pB0,2),PKW(pB0,4),PKW(pB0,6)};pw1=(u32x4){PKW(pB0,8),PKW(pB0,10),PKW(pB0,12),PKW(pB0,14)};pw2=(u32x4){PKW(pB1,0),PKW(pB1,2),PKW(pB1,4),PKW(pB1,6)};pw3=(u32x4){PKW(pB1,8),PKW(pB1,10),PKW(pB1,12),PKW(pB1,14)};
    SBAR(); pv(o,vb0+sl_cur,PAF(0),PAF(1),PAF(2),PAF(3)); }
  #undef PKW
  #undef PAF
  #undef VFR
  #undef PIN
  #undef MX3
  #undef GAPA
  #undef GAPB
  #undef EX
  #undef VRD
  #undef VOFF
  #undef KRD
  #undef STEP
  #undef ENDW
  {auto rr=__builtin_amdgcn_permlane32_swap(__float_as_uint(l_reg),__float_as_uint(l_reg),false,false);l_reg=__uint_as_float(rr[0])+__uint_as_float(rr[1]);}
  if(!FOX) l_reg+=__builtin_amdgcn_exp2f(sink2-mhat);
  if(hi==0)wsf[32+r32]=l_reg;asm volatile("s_waitcnt lgkmcnt(0)":::"memory");
  float rli[16];
  #pragma unroll
  for(int r=0;r<16;++r)rli[r]=__builtin_amdgcn_rcpf(wsf[32+crow(r,hi)]);
  bf16*Ow=O+(rowbase+q0+wid*QBLK)*DM+h*D;
  { bf16*stg=(bf16*)(shm+LDS_OST)+wid*2048;
    #pragma unroll
    for(int r=0;r<16;++r){const int orow=crow(r,hi);
      #pragma unroll
      for(int d0=0;d0<2;++d0)stg[orow*64+d0*32+r32]=(bf16)(cvtpk_s(o[d0][r]*rli[r],0.f)&0xffffu);}
    asm volatile("s_waitcnt lgkmcnt(0)":::"memory");
    #pragma unroll
    for(int i=0;i<4;++i){const int row=i*8+(lane>>3),ch=lane&7; const u32x4 v=*(const u32x4*)(stg+row*64+ch*8); ATTN_STORE16(Ow+(long)row*DM+ch*8,v);} }
  asm volatile("s_waitcnt lgkmcnt(0)\n\ts_barrier":::"memory");
  #undef DMA_K
  #undef DMA_V
  #undef DMA_C
  #undef PREFILL
  #undef CMASK
  #undef START
  #undef RESC
  #undef ROT
}
constexpr int ATTN_LDS_BYTES=LDS_BYTES;
#undef SBAR
#undef WAIT_BAR
}

#ifndef REP_PHASE
#define REP_PHASE 0
#endif
#ifndef NAIVE_SWA
#define NAIVE_SWA 0
#endif
#ifndef NAIVE_FOX
#define NAIVE_FOX 0
#endif
#define LAS __attribute__((address_space(3)))
typedef unsigned short bf16;
typedef float f32x4 __attribute__((ext_vector_type(4)));
typedef unsigned v4u __attribute__((ext_vector_type(4)));
typedef unsigned v2u __attribute__((ext_vector_type(2)));
constexpr int NWAVES = 8;
constexpr int RING_BYTES = 131072, LDS_BYTES = 147456;

__device__ __forceinline__ float wave_sum(float v) {
#pragma unroll
    for (int o = 1; o < 64; o <<= 1) v += __shfl_xor(v, o);
    return v;
}
#define LDS_WAIT() asm volatile("s_waitcnt lgkmcnt(0)" ::: "memory")

__device__ __forceinline__ void tr_item(const float* W, int K, int N, bf16* WT, int dst_row0, int src_col0, int nvalid, int kb, const float* kscale, LAS float* scr, int lane) {
    const int k0 = 64 * kb, c = lane & 31;
    float tv[32];
    const float* wp = W + (size_t)(k0 + (lane >> 5)) * N + src_col0 + c;
#pragma unroll
    for (int i = 0; i < 32; ++i) { tv[i] = 0.f; if (c < nvalid) tv[i] = __builtin_nontemporal_load(wp + (size_t)(2 * i) * N); }
#pragma unroll
    for (int i = 0; i < 32; ++i) { const int kk = 2 * i + (lane >> 5); float v = tv[i]; if (kscale) v *= kscale[k0 + kk]; scr[kk * 33 + c] = v; }
    LDS_WAIT(); asm volatile("" ::: "memory");
    const int ch = lane & 7;
#pragma unroll
    for (int j = 0; j < 4; ++j) { const int n = (lane >> 3) + 8 * j; const LAS float* s = scr + (8 * ch) * 33 + n;
        v4u o; o.x = pg8::cvt_pk_bf16(s[0 * 33], s[1 * 33]); o.y = pg8::cvt_pk_bf16(s[2 * 33], s[3 * 33]); o.z = pg8::cvt_pk_bf16(s[4 * 33], s[5 * 33]); o.w = pg8::cvt_pk_bf16(s[6 * 33], s[7 * 33]);
        *(v4u*)(WT + (size_t)(dst_row0 + n) * K + k0 + 8 * ch) = o; }
    LDS_WAIT(); asm volatile("" ::: "memory");
}
__device__ __forceinline__ void win_map(int db, int& src, int& nv) {
    const int pn = db >> 3, bj = (db >> 2) & 1, wc = db & 3; nv = 32;
    if (pn < 4) src = (4 * pn + wc) * 64 + 32 * bj;
    else if (pn == 4) src = (wc < 2 ? 1024 + wc * 64 : 1152 + (wc - 2) * 64) + 32 * bj;
    else if (pn < 17) { const int t = pn - 5; src = 1280 + (t >> 2) * 1024 + (4 * (t & 3) + wc) * 64 + 32 * bj; }
    else if (pn < 33) src = 4368 + (db - 136) * 32;
    else { src = 4352; nv = (db == 264) ? 16 : 0; }
}

struct Args { const float* x; const int* pos; const float* attn_norm; const float* w_in; const float* fbias; const float* sinks; const float* w_bs; const float* w_bf;
              const float* w_out; const float* mlp_norm; const float* w_up; const float* w_dn; const float* final_norm; float* out; unsigned char* ws; };

__device__ __forceinline__ void rms_row_to_bf16(const float* xrow, const float* gain, bf16* orow, int lane) {
    const f32x4* xr = (const f32x4*)xrow + lane; f32x4 v[8]; float s = 0.f;
#pragma unroll
    for (int j = 0; j < 8; ++j) { v[j] = xr[64 * j]; s += (v[j].x * v[j].x + v[j].y * v[j].y) + (v[j].z * v[j].z + v[j].w * v[j].w); }
    const float rstd = __builtin_amdgcn_rsqf(wave_sum(s) * (1.f / DM) + RMS_EPS);
    const f32x4* gr = (const f32x4*)gain + lane; v2u* o8 = (v2u*)orow + lane;
#pragma unroll
    for (int j = 0; j < 8; ++j) { const f32x4 g = gr[64 * j]; v2u w; w.x = pg8::cvt_pk_bf16(v[j].x * rstd * g.x, v[j].y * rstd * g.y); w.y = pg8::cvt_pk_bf16(v[j].z * rstd * g.z, v[j].w * rstd * g.w); o8[64 * j] = w; }
}

__device__ __forceinline__ void rms_row2_to_bf16(const float* x0, const float* x1, const float* gain, bf16* o0, bf16* o1, int lane) {
    const f32x4* xr0 = (const f32x4*)x0 + lane; const f32x4* xr1 = (const f32x4*)x1 + lane; f32x4 v[8], w[8]; float s = 0.f, t = 0.f;
#pragma unroll
    for (int j = 0; j < 8; ++j) { v[j] = __builtin_nontemporal_load(xr0 + 64 * j); w[j] = __builtin_nontemporal_load(xr1 + 64 * j); }
#pragma unroll
    for (int j = 0; j < 8; ++j) { s += (v[j].x * v[j].x + v[j].y * v[j].y) + (v[j].z * v[j].z + v[j].w * v[j].w); t += (w[j].x * w[j].x + w[j].y * w[j].y) + (w[j].z * w[j].z + w[j].w * w[j].w); }
    const float rs = __builtin_amdgcn_rsqf(wave_sum(s) * (1.f / DM) + RMS_EPS), rt = __builtin_amdgcn_rsqf(wave_sum(t) * (1.f / DM) + RMS_EPS);
    const f32x4* gr = (const f32x4*)gain + lane; v2u* p0 = (v2u*)o0 + lane; v2u* p1 = (v2u*)o1 + lane;
#pragma unroll
    for (int j = 0; j < 8; ++j) { const f32x4 g = gr[64 * j]; v2u a, c;
        a.x = pg8::cvt_pk_bf16(v[j].x * rs * g.x, v[j].y * rs * g.y); a.y = pg8::cvt_pk_bf16(v[j].z * rs * g.z, v[j].w * rs * g.w);
        c.x = pg8::cvt_pk_bf16(w[j].x * rt * g.x, w[j].y * rt * g.y); c.y = pg8::cvt_pk_bf16(w[j].z * rt * g.z, w[j].w * rt * g.w);
        p0[64 * j] = a; p1[64 * j] = c; }
}
__device__ __forceinline__ void p0_prologue(const Args& a, LAS unsigned char* lds, int vcu, int G, int wave, int lane) {
    unsigned char* ws = a.ws;
    LAS float* scr = (LAS float*)(lds + wave * 16384);
    const int gw = vcu * NWAVES + wave, NGW = G * NWAVES;
    constexpr int I_IN = (NIN / 32) * (DM / 64), I_BS = (DM / 32) * (1024 / 64), I_OUT = (DM / 32) * (DM / 64), I_UP = (DFF / 32) * (DM / 64), I_DN = (DM / 32) * (DFF / 64);
    constexpr int NITEMS = I_IN + 2 * I_BS + I_OUT + I_UP + I_DN;
    for (int it = gw; it < NITEMS; it += NGW) {
        int r = it;
        if (r < I_IN) { const int db = r / (DM / 64), kb = r % (DM / 64); int src, nv; win_map(db, src, nv); tr_item(a.w_in, DM, DIN, (bf16*)(ws + WS_WIN), db * 32, src, nv, kb, nullptr, scr, lane); continue; } r -= I_IN;
        if (r < I_BS) { const int db = r / 16, kb = r % 16; tr_item(a.w_bs, 1024, DM, (bf16*)(ws + WS_WBS), db * 32, db * 32, 32, kb, nullptr, scr, lane); continue; } r -= I_BS;
        if (r < I_BS) { const int db = r / 16, kb = r % 16; tr_item(a.w_bf, 1024, DM, (bf16*)(ws + WS_WBF), db * 32, db * 32, 32, kb, nullptr, scr, lane); continue; } r -= I_BS;
        if (r < I_OUT) { const int db = r / 32, kb = r % 32; tr_item(a.w_out, DM, DM, (bf16*)(ws + WS_WOUT), db * 32, db * 32, 32, kb, nullptr, scr, lane); continue; } r -= I_OUT;
        if (r < I_UP) { const int db = r / 32, kb = r % 32; tr_item(a.w_up, DM, DFF, (bf16*)(ws + WS_WUP), db * 32, db * 32, 32, kb, a.mlp_norm, scr, lane); continue; } r -= I_UP;
        { const int db = r / 128, kb = r % 128; tr_item(a.w_dn, DFF, DM, (bf16*)(ws + WS_WDN), db * 32, db * 32, 32, kb, nullptr, scr, lane); }
    }
    for (int m = gw; m < M; m += 2 * NGW) rms_row2_to_bf16(a.x + (size_t)m * DM, a.x + (size_t)(m + NGW) * DM, a.attn_norm, (bf16*)(ws + WS_XN) + (size_t)m * DM, (bf16*)(ws + WS_XN) + (size_t)(m + NGW) * DM, lane);
    float* cs = (float*)(ws + WS_CS);
    for (int e = gw * 64 + lane; e < M * 32; e += NGW * 64) {
        const int tok = e >> 5, i = e & 31;
        const float inv_freq = powf(10000.0f, -(float)(2 * i) / 64.0f);
        const float ang = (float)a.pos[tok] * inv_freq;
        double rev = (double)ang * 0.15915494309189535; rev -= floor(rev);
        const float rf = (float)rev;
        cs[e] = __builtin_amdgcn_cosf(rf); cs[(size_t)M * 32 + e] = __builtin_amdgcn_sinf(rf);
    }
}

__device__ __forceinline__ void cumsum_unit(const Args& a, int bh, LAS unsigned char* lds) {
    const float* FL = (const float*)(a.ws + WS_FL); float* Cp = (float*)(a.ws + WS_C);
    LAS double* sh = (LAS double*)lds;
    const int b = bh >> 4, h = bh & 15, tid = threadIdx.x, s0 = tid * 16; const float fb = a.fbias[h];
    float ls[16]; double run = 0.0;
#pragma unroll
    for (int i = 0; i < 16; ++i) { const float z = FL[(size_t)(b * SEQ + s0 + i) * 16 + h] + fb; const float v = fminf(z, 0.f) - log1pf(expf(-fabsf(z))); ls[i] = v; run += (double)v; }
    sh[tid] = run; __syncthreads();
    double pre = 0.0; for (int k = 0; k < tid; ++k) pre += sh[k];
#pragma unroll
    for (int i = 0; i < 16; ++i) { pre += (double)ls[i]; Cp[(size_t)bh * SEQ + s0 + i] = (float)(pre * 1.4426950408889634); }
    __syncthreads();
}

__device__ __forceinline__ void naive_swa_unit(const Args& a, int unit) {
    const bf16* AQ = (const bf16*)(a.ws + WS_AQ); const bf16* AK = (const bf16*)(a.ws + WS_AK); const bf16* AV = (const bf16*)(a.ws + WS_AV); bf16* OA = (bf16*)(a.ws + WS_OA);
    const int tid = threadIdx.x, head = tid & 15, tok = unit * 32 + (tid >> 4), b = tok / SEQ, s = tok % SEQ, kvh = head >> 3;
    float q[64], o[64]; float m = -INFINITY, l = 0.f;
    { const v4u* qp = (const v4u*)(AQ + (size_t)tok * 1024 + head * 64);
#pragma unroll
      for (int c = 0; c < 8; ++c) { const v4u w = qp[c];
#pragma unroll
          for (int e = 0; e < 4; ++e) { q[8 * c + 2 * e] = pg8::bf_lo(w[e]); q[8 * c + 2 * e + 1] = pg8::bf_hi(w[e]); } } }
#pragma unroll
    for (int d = 0; d < 64; ++d) o[d] = 0.f;
    for (int i = 0; i < 128; ++i) {
        const int j = s - i; const bool valid = j >= 0; const int jj = valid ? j : 0;
        const v4u* kp = (const v4u*)(AK + (size_t)(b * SEQ + jj) * 128 + kvh * 64); const v4u* vp = (const v4u*)(AV + (size_t)(b * SEQ + jj) * 128 + kvh * 64);
        float dot = 0.f;
#pragma unroll
        for (int c = 0; c < 8; ++c) { const v4u w = kp[c];
#pragma unroll
            for (int e = 0; e < 4; ++e) { dot += q[8 * c + 2 * e] * pg8::bf_lo(w[e]); dot += q[8 * c + 2 * e + 1] * pg8::bf_hi(w[e]); } }
        const float lg = valid ? dot : -INFINITY;
        const float mn = fmaxf(m, lg), al = __builtin_amdgcn_exp2f(m - mn), p = __builtin_amdgcn_exp2f(lg - mn);
        l = l * al + p; m = mn;
#pragma unroll
        for (int c = 0; c < 8; ++c) { const v4u w = vp[c];
#pragma unroll
            for (int e = 0; e < 4; ++e) { o[8 * c + 2 * e] = o[8 * c + 2 * e] * al + p * pg8::bf_lo(w[e]); o[8 * c + 2 * e + 1] = o[8 * c + 2 * e + 1] * al + p * pg8::bf_hi(w[e]); } }
    }
    { const float sk = a.sinks[head] * LOG2E; const float m2 = fmaxf(m, sk), al = __builtin_amdgcn_exp2f(m - m2); l = l * al + __builtin_amdgcn_exp2f(sk - m2);
      const float rl = al / l;
      v4u* op = (v4u*)(OA + (size_t)tok * 1024 + head * 64);
#pragma unroll
      for (int c = 0; c < 8; ++c) { v4u w;
#pragma unroll
          for (int e = 0; e < 4; ++e) w[e] = pg8::cvt_pk_bf16(o[8 * c + 2 * e] * rl, o[8 * c + 2 * e + 1] * rl);
          op[c] = w; } }
}
__device__ __forceinline__ void naive_fox_unit(const Args& a, int bh, int qblk) {
    const bf16* FQ = (const bf16*)(a.ws + WS_FQ); const bf16* FK = (const bf16*)(a.ws + WS_FK); const bf16* FV = (const bf16*)(a.ws + WS_FV); bf16* OB = (bf16*)(a.ws + WS_OB);
    const float* Cp = (const float*)(a.ws + WS_C) + (size_t)bh * SEQ;
    const int tid = threadIdx.x, b = bh >> 4, h = bh & 15, s = qblk * 512 + tid; const size_t tok = (size_t)b * SEQ + s;
    float q[64], o[64]; float m = -INFINITY, l = 0.f;
    { const v4u* qp = (const v4u*)(FQ + tok * 1024 + h * 64);
#pragma unroll
      for (int c = 0; c < 8; ++c) { const v4u w = qp[c];
#pragma unroll
          for (int e = 0; e < 4; ++e) { q[8 * c + 2 * e] = pg8::bf_lo(w[e]); q[8 * c + 2 * e + 1] = pg8::bf_hi(w[e]); } } }
#pragma unroll
    for (int d = 0; d < 64; ++d) o[d] = 0.f;
    const float cq = Cp[s];
    const int jend = __builtin_amdgcn_readfirstlane(qblk * 512 + (tid | 63));
    for (int j = 0; j <= jend; ++j) {
        const v4u* kp = (const v4u*)(FK + ((size_t)b * SEQ + j) * 1024 + h * 64); const v4u* vp = (const v4u*)(FV + ((size_t)b * SEQ + j) * 1024 + h * 64);
        float dot = 0.f;
#pragma unroll
        for (int c = 0; c < 8; ++c) { const v4u w = kp[c];
#pragma unroll
            for (int e = 0; e < 4; ++e) { dot += q[8 * c + 2 * e] * pg8::bf_lo(w[e]); dot += q[8 * c + 2 * e + 1] * pg8::bf_hi(w[e]); } }
        float lg = dot + (cq - Cp[j]); lg = (j <= s) ? lg : -INFINITY;
        const float mn = fmaxf(m, lg), al = __builtin_amdgcn_exp2f(m - mn), p = __builtin_amdgcn_exp2f(lg - mn);
        l = l * al + p; m = mn;
#pragma unroll
        for (int c = 0; c < 8; ++c) { const v4u w = vp[c];
#pragma unroll
            for (int e = 0; e < 4; ++e) { o[8 * c + 2 * e] = o[8 * c + 2 * e] * al + p * pg8::bf_lo(w[e]); o[8 * c + 2 * e + 1] = o[8 * c + 2 * e + 1] * al + p * pg8::bf_hi(w[e]); } }
    }
    { const float rl = 1.0f / l; v4u* op = (v4u*)(OB + tok * 1024 + h * 64);
#pragma unroll
      for (int c = 0; c < 8; ++c) { v4u w;
#pragma unroll
          for (int e = 0; e < 4; ++e) w[e] = pg8::cvt_pk_bf16(o[8 * c + 2 * e] * rl, o[8 * c + 2 * e + 1] * rl);
          op[c] = w; } }
}

__global__ void __launch_bounds__(NWAVES * 64, 2) mega_fwd(Args a) {
    extern __shared__ __attribute__((aligned(16))) unsigned char lds_raw[];
    LAS unsigned char* lds = (LAS unsigned char*)lds_raw;
    cg::grid_group grid = cg::this_grid();
    int tid_ = threadIdx.x; asm volatile("" : "+v"(tid_));
    const int tid = tid_, lane = tid & 63, wave = __builtin_amdgcn_readfirstlane(tid >> 6);
    const int G = gridDim.x, bx = blockIdx.x, vcu = (G % 8 == 0) ? (bx % 8) * (G / 8) + bx / 8 : bx;
    unsigned char* ws = a.ws;
    float* SS1 = (float*)(ws + WS_CTL); float* SS2 = SS1 + M;
#define GRID_SYNC() do { asm volatile("s_waitcnt vmcnt(0) lgkmcnt(0)" ::: "memory"); grid.sync(); } while (0)

    for (int rp_ = 0; rp_ < (REP_PHASE == 100 ? 2 : 1); ++rp_) { p0_prologue(a, lds, vcu, G, wave, lane); __syncthreads(); }
    GRID_SYNC();

    {
        pg8::Gemm g{(const bf16*)(ws + WS_XN), (const bf16*)(ws + WS_WIN), nullptr, nullptr, DM};
        pg8::StaticOrder S; S.init(M, NIN, G, bx);
        pg8::EpiIn E{ws};
        for (int rp_ = 0; rp_ < (REP_PHASE == 1 ? 2 : 1); ++rp_) pg8::gemm_phase<pg8::EpiIn, pg8::StaticOrder, true, true>(lds, g, S, E);
    }
    GRID_SYNC();

    for (int u = bx; u < 64; u += G) cumsum_unit(a, u, lds);
#if NAIVE_SWA
    for (int u = bx; u < M / 32; u += G) naive_swa_unit(a, u);
#else
    for (int rp_ = 0; rp_ < (REP_PHASE == 2 ? 2 : 1); ++rp_)
    for (int u = vcu; u < 2048; u += G) { const int bh = u >> 5, qb = u & 31, b_ = bh >> 4, h_ = bh & 15;
        attn_body::attn_unit<8, false, 128>(b_, h_, qb, (const bf16*)(ws + WS_AQ), (const bf16*)(ws + WS_AK), (const bf16*)(ws + WS_AV), (bf16*)(ws + WS_OA), nullptr, a.sinks[h_] * LOG2E, (char*)lds_raw); }
#endif
    GRID_SYNC();

#if NAIVE_FOX
    for (int u = bx; u < 1024; u += G) { const int r = u >> 6, i = r >> 2, hi4 = r & 3, qblk = (i & 1) ? 4 * i + 3 - hi4 : 4 * i + hi4; naive_fox_unit(a, u & 63, qblk); }
#else
    for (int rp_ = 0; rp_ < (REP_PHASE == 3 ? 2 : 1); ++rp_)
    for (int e = vcu; e < 2048; e += G) { const int cuv = e & 255, i = e >> 8, bh = (cuv >> 3) + 32 * (i >> 2), s_ = cuv & 7, k_ = i & 3, qb = k_ == 0 ? s_ : (k_ == 1 ? 15 - s_ : (k_ == 2 ? 16 + s_ : 31 - s_));
        attn_body::attn_unit<8, true, 1024>(bh >> 4, bh & 15, qb, (const bf16*)(ws + WS_FQ), (const bf16*)(ws + WS_FK), (const bf16*)(ws + WS_FV), (bf16*)(ws + WS_OB), (const float*)(ws + WS_C) + (size_t)bh * SEQ, 0.f, (char*)lds_raw); }
#endif
    GRID_SYNC();

    {
        pg8::Gemm g{(const bf16*)(ws + WS_OA), (const bf16*)(ws + WS_WBS), (const bf16*)(ws + WS_OB), (const bf16*)(ws + WS_WBF), 1024};
        pg8::PairOrder S; S.s.init(M, DM, G, bx);
        pg8::EpiBranch E{(const bf16*)(ws + WS_G), (bf16*)(ws + WS_MG)};
        for (int rp_ = 0; rp_ < (REP_PHASE == 4 ? 2 : 1); ++rp_) pg8::gemm_phase<pg8::EpiBranch, pg8::PairOrder, true, true>(lds, g, S, E);
    }
    GRID_SYNC();

    {
        pg8::Gemm g{(const bf16*)(ws + WS_MG), (const bf16*)(ws + WS_WOUT), nullptr, nullptr, DM};
        pg8::StaticOrder S; S.init(M, DM, G, bx);
        pg8::EpiRes<true> E{a.x, a.out, (bf16*)(ws + WS_X1B), SS1};
        pg8::gemm_phase<pg8::EpiRes<true>, pg8::StaticOrder, true, true>(lds, g, S, E);
    }
    GRID_SYNC();

    {
        pg8::Gemm g{(const bf16*)(ws + WS_X1B), (const bf16*)(ws + WS_WUP), nullptr, nullptr, DM};
        pg8::StaticOrder S; S.init(M, DFF, G, bx);
        pg8::EpiUp E{SS1, (bf16*)(ws + WS_U)};
        for (int rp_ = 0; rp_ < (REP_PHASE == 6 ? 2 : 1); ++rp_) pg8::gemm_phase<pg8::EpiUp, pg8::StaticOrder, true, true>(lds, g, S, E);
    }
    GRID_SYNC();

    {
        pg8::Gemm g{(const bf16*)(ws + WS_U), (const bf16*)(ws + WS_WDN), nullptr, nullptr, DFF};
        pg8::StaticOrder S; S.init(M, DM, G, bx);
        pg8::EpiRes<false> E{a.out, a.out, nullptr, SS2};
        pg8::gemm_phase<pg8::EpiRes<false>, pg8::StaticOrder, true, true>(lds, g, S, E);
    }
    GRID_SYNC();

    {
        const int gw = vcu * NWAVES + wave, NGW = G * NWAVES;
        for (int m = gw; m < M; m += NGW) {
            const float rstd = __builtin_amdgcn_rsqf(SS2[m] * (1.f / DM) + RMS_EPS);
            f32x4* xr = (f32x4*)(a.out + (size_t)m * DM) + lane; const f32x4* gr = (const f32x4*)a.final_norm + lane;
#pragma unroll
            for (int j = 0; j < 8; ++j) { const f32x4 v = xr[64 * j], g = gr[64 * j]; xr[64 * j] = v * rstd * g; }
        }
    }
}

extern "C" void kernel_launch(void* const* d_in, const int* in_sizes, int n_in, void* d_out, int out_size, void* d_ws, size_t ws_size, hipStream_t stream) {
    static int grid = 0;
    if (grid == 0) {
        if (n_in != 13 || in_sizes[0] != M * DM || out_size != M * DM || ws_size < WS_END) { fprintf(stderr, "kernel_launch: unexpected shapes (n_in %d, in0 %d, out %d, ws %zu)\n", n_in, n_in > 0 ? in_sizes[0] : -1, out_size, ws_size); grid = -1; return; }
        int dev = 0, cus = 0, per_cu = 0;
        if (hipGetDevice(&dev) != hipSuccess || hipDeviceGetAttribute(&cus, hipDeviceAttributeMultiprocessorCount, dev) != hipSuccess) { grid = -1; return; }
        if (hipFuncSetAttribute((const void*)mega_fwd, hipFuncAttributeMaxDynamicSharedMemorySize, LDS_BYTES) != hipSuccess) { fprintf(stderr, "kernel_launch: hipFuncSetAttribute failed\n"); grid = -1; return; }
        if (hipOccupancyMaxActiveBlocksPerMultiprocessor(&per_cu, (const void*)mega_fwd, NWAVES * 64, LDS_BYTES) != hipSuccess || per_cu < 1) { fprintf(stderr, "kernel_launch: occupancy query says %d\n", per_cu); per_cu = 1; }
        (void)hipGetLastError();
        grid = cus * 1;
    }
    if (grid < 0) return;
    (void)hipMemsetAsync((char*)d_ws + WS_CTL, 0, CTL_ZERO_BYTES, stream);
    Args a{};
    a.x = (const float*)d_in[0]; a.pos = (const int*)d_in[1]; a.attn_norm = (const float*)d_in[2]; a.w_in = (const float*)d_in[3]; a.fbias = (const float*)d_in[4]; a.sinks = (const float*)d_in[5];
    a.w_bs = (const float*)d_in[6]; a.w_bf = (const float*)d_in[7]; a.w_out = (const float*)d_in[8]; a.mlp_norm = (const float*)d_in[9]; a.w_up = (const float*)d_in[10]; a.w_dn = (const float*)d_in[11];
    a.final_norm = (const float*)d_in[12]; a.out = (float*)d_out; a.ws = (unsigned char*)d_ws;
    void* kargs[] = {&a};
    const hipError_t le = hipLaunchCooperativeKernel((const void*)mega_fwd, dim3(grid), dim3(NWAVES * 64), kargs, LDS_BYTES, stream);
    if (le != hipSuccess) fprintf(stderr, "kernel_launch: cooperative launch failed: %s (grid %d)\n", hipGetErrorString(le), grid);
}
```

```cpp
#include <hip/hip_runtime.h>
#include <hip/hip_cooperative_groups.h>
#include <cstdio>
#include <cstdint>
namespace cg = cooperative_groups;

constexpr int BATCH = 4, SEQ = 8192, DM = 2048, M = BATCH * SEQ, DFF = 8192, NIN = 8704  , DIN = 8464;
constexpr float RMS_EPS = 1e-6f;
constexpr float LOG2E = 1.4426950408889634f;
constexpr float C2 = 0.125f * 1.4426950408889634f;

constexpr size_t MiB = 1u << 20;
constexpr size_t WS_CTL = 0, CTL_ZERO_BYTES = 1 * MiB;
constexpr size_t WS_WIN = 1 * MiB, WS_WBS = 35 * MiB, WS_WBF = 39 * MiB, WS_WOUT = 43 * MiB, WS_WUP = 51 * MiB, WS_WDN = 83 * MiB;
constexpr size_t WS_CS = 115 * MiB;
constexpr size_t WS_FL = 123 * MiB, WS_C = 125 * MiB;
constexpr size_t WS_FK = 128 * MiB, WS_FV = 192 * MiB, WS_X1B = 128 * MiB;
constexpr size_t WS_XN = 256 * MiB, WS_MG = 256 * MiB;
constexpr size_t WS_AQ = 384 * MiB, WS_FQ = 448 * MiB, WS_G = 512 * MiB;
constexpr size_t WS_U = 256 * MiB;
constexpr size_t WS_AK = 768 * MiB, WS_AV = 776 * MiB, WS_OA = 784 * MiB, WS_OB = 848 * MiB, WS_END = 912 * MiB;

namespace pg8 {
#define PG8_LAS __attribute__((address_space(3)))
typedef unsigned short bf16_t;
typedef short bf16x8 __attribute__((ext_vector_type(8)));
typedef float f32x4 __attribute__((ext_vector_type(4)));
typedef unsigned u32x4 __attribute__((ext_vector_type(4)));
typedef unsigned u32x2 __attribute__((ext_vector_type(2)));
constexpr int BM = 256, BK = 64, HALF = 128, HTB = HALF * BK * 2  , STAGE_BYTES = 8 * HTB, NXCD = 8, WGM = 8;

__host__ __device__ __forceinline__ int lds_byte(int r, int c) { const int st = (r >> 4) * 2 + (c >> 5), rr = r & 15, cc = c & 31, ob = rr * 64 + cc * 2; return st * 1024 + (ob ^ (((ob >> 9) & 1) << 5)); }
__host__ __device__ __forceinline__ void stage_rc(int b, int& R, int& C) { const int st = b / 1024, sb = b % 1024, swz = sb ^ (((sb >> 9) & 1) << 5); R = (st >> 1) * 16 + swz / 64; C = (st & 1) * 32 + (swz % 64) / 2; }
__host__ __device__ __forceinline__ int perm32(int rho) { const int n = rho >> 4, i = rho & 15; return 8 * (i >> 2) + 4 * n + (i & 3); }

struct Unit { int pm, pn, z; };
struct Gemm { const bf16_t* A0; const bf16_t* B0; const bf16_t* A1; const bf16_t* B1; int K; };

struct StaticOrder {
    int nM, nN, nwg, G, c;
    __host__ __device__ void init(int M_, int N_, int G_, int c_) { nM = M_ / BM; nN = N_ / BM; nwg = nM * nN; G = G_; c = c_; }
    __host__ __device__ bool next(int i, Unit& u) const {
        const long L = (long)i * G + c; if (L >= nwg) return false;
        int wgid = (int)L; { const int q = nwg / NXCD, r = nwg % NXCD, xcd = wgid % NXCD, off = wgid / NXCD; wgid = (xcd < r ? xcd * (q + 1) : r * (q + 1) + (xcd - r) * q) + off; }
        const int nig = WGM * nN, gid = wgid / nig, fm = gid * WGM, gsz = (nM - fm) < WGM ? (nM - fm) : WGM;
        u.pm = fm + ((wgid % nig) % gsz); u.pn = (wgid % nig) / gsz; u.z = 0; return true;
    }
};
struct PairOrder {
    StaticOrder s;
    __host__ __device__ bool next(int i, Unit& u) const { const bool ok = s.next(i >> 1, u); u.z = i & 1; return ok; }
};

__device__ __forceinline__ unsigned cvt_pk_bf16(float lo, float hi) { unsigned r; asm("v_cvt_pk_bf16_f32 %0, %1, %2" : "=v"(r) : "v"(lo), "v"(hi)); return r; }
__device__ __forceinline__ float bf_lo(unsigned w) { return __uint_as_float(w << 16); }
__device__ __forceinline__ float bf_hi(unsigned w) { return __uint_as_float(w & 0xffff0000u); }
__device__ __forceinline__ float sigmoidf_(float x) { return __builtin_amdgcn_rcpf(1.0f + __builtin_amdgcn_exp2f(-x * LOG2E)); }


struct EpiIn {
    static constexpr bool PERM = true;
    unsigned char* ws;
    __device__ __forceinline__ bool keep(const Unit&) const { return false; }
    __device__ __forceinline__ void operator()(f32x4 (&acc)[2][2][4][2], const Unit& u, int wr, int wc, int fr, int fq) const {
        const int pn = u.pn; const int row0 = u.pm * BM + wr * 64 + fr;
        if (pn <= 16) {
            size_t doff; int pitch, colbase; bool rope = false; float sc = 1.f;
            if (pn < 4) { doff = WS_AQ; pitch = 1024; colbase = (4 * pn + wc) * 64; rope = true; sc = C2; }
            else if (pn == 4) { if (wc < 2) { doff = WS_AK; pitch = 128; colbase = wc * 64; rope = true; } else { doff = WS_AV; pitch = 128; colbase = (wc - 2) * 64; } }
            else { const int t = pn - 5, seg = t >> 2, tin = t & 3; doff = WS_FQ; if (seg == 1) doff = WS_FK; if (seg == 2) doff = WS_FV; pitch = 1024; colbase = (4 * tin + wc) * 64; sc = seg == 0 ? C2 : 1.f; }
            bf16_t* dst = (bf16_t*)(ws + doff); const float* cs = (const float*)(ws + WS_CS);
#pragma unroll
            for (int ai = 0; ai < 2; ++ai) {
                f32x4 cc[4][4];
                if (rope) {
#pragma unroll
                    for (int m = 0; m < 4; ++m) { const float* cp = cs + (size_t)(row0 + ai * HALF + m * 16) * 32 + 8 * fq; const float* sp = cp + (size_t)M * 32;
                        cc[m][0] = *(const f32x4*)cp; cc[m][1] = *(const f32x4*)(cp + 4); cc[m][2] = *(const f32x4*)sp; cc[m][3] = *(const f32x4*)(sp + 4); }
                    asm volatile("" ::: "memory");
                }
#pragma unroll
                for (int m = 0; m < 4; ++m) {
                    const int row = row0 + ai * HALF + m * 16;
                    f32x4 v00 = acc[ai][0][m][0], v01 = acc[ai][0][m][1], v10 = acc[ai][1][m][0], v11 = acc[ai][1][m][1];
                    if (rope) {
                        const f32x4 c0 = cc[m][0], c1 = cc[m][1], s0 = cc[m][2], s1 = cc[m][3];
                        const f32x4 o00 = v00 * c0 - v10 * s0, o10 = v10 * c0 + v00 * s0, o01 = v01 * c1 - v11 * s1, o11 = v11 * c1 + v01 * s1;
                        v00 = o00; v10 = o10; v01 = o01; v11 = o11;
                    }
                    v00 = v00 * sc; v01 = v01 * sc; v10 = v10 * sc; v11 = v11 * sc;
                    bf16_t* rp = dst + (size_t)row * pitch + colbase + 8 * fq;
                    u32x4 w0, w1;
                    w0.x = cvt_pk_bf16(v00[0], v00[1]); w0.y = cvt_pk_bf16(v00[2], v00[3]); w0.z = cvt_pk_bf16(v01[0], v01[1]); w0.w = cvt_pk_bf16(v01[2], v01[3]);
                    w1.x = cvt_pk_bf16(v10[0], v10[1]); w1.y = cvt_pk_bf16(v10[2], v10[3]); w1.z = cvt_pk_bf16(v11[0], v11[1]); w1.w = cvt_pk_bf16(v11[2], v11[3]);
                    *(u32x4*)rp = w0; *(u32x4*)(rp + 32) = w1;
                }
                asm volatile("" ::: "memory");
            }
        } else if (pn <= 32) {
            const int col0 = (pn - 17) * BM + wc * 32 + 8 * fq;
#pragma unroll
            for (int ai = 0; ai < 2; ++ai)
#pragma unroll
                for (int m = 0; m < 4; ++m) {
                    bf16_t* rp = (bf16_t*)(ws + WS_G) + (size_t)(row0 + ai * HALF + m * 16) * 4096 + col0;
#pragma unroll
                    for (int bj = 0; bj < 2; ++bj) {
                        const f32x4 a = acc[ai][bj][m][0], b = acc[ai][bj][m][1]; u32x4 w;
                        float s[8];
#pragma unroll
                        for (int i = 0; i < 4; ++i) { s[i] = fmaxf(sigmoidf_(a[i]), 1e-30f); s[4 + i] = fmaxf(sigmoidf_(b[i]), 1e-30f); }
                        w.x = cvt_pk_bf16(s[0], s[1]); w.y = cvt_pk_bf16(s[2], s[3]); w.z = cvt_pk_bf16(s[4], s[5]); w.w = cvt_pk_bf16(s[6], s[7]);
                        *(u32x4*)(rp + bj * HALF) = w;
                    }
                }
        } else {
            if (wc == 0 && fq < 2) {
#pragma unroll
                for (int ai = 0; ai < 2; ++ai)
#pragma unroll
                    for (int m = 0; m < 4; ++m) {
                        float* rp = (float*)(ws + WS_FL) + (size_t)(row0 + ai * HALF + m * 16) * 16 + 8 * fq;
                        *(f32x4*)rp = acc[ai][0][m][0]; *(f32x4*)(rp + 4) = acc[ai][0][m][1];
                    }
            }
        }
    }
};

struct EpiBranch {
    static constexpr bool PERM = true;
    const bf16_t* G; bf16_t* MG;
    __device__ __forceinline__ bool keep(const Unit& u) const { return u.z == 0; }
    __device__ __forceinline__ void operator()(f32x4 (&acc)[2][2][4][2], const Unit& u, int wr, int wc, int fr, int fq) const {
        const int row0 = u.pm * BM + wr * 64 + fr, col0 = u.pn * BM + wc * 32 + 8 * fq; const int z = u.z;
#pragma unroll
        for (int ai = 0; ai < 2; ++ai) {
            u32x4 gbv[4][2], gav[4][2];
#pragma unroll
            for (int m = 0; m < 4; ++m)
#pragma unroll
                for (int bj = 0; bj < 2; ++bj) { const bf16_t* gp = G + (size_t)(row0 + ai * HALF + m * 16) * 4096 + col0 + bj * HALF;
                    gbv[m][bj] = *(const u32x4*)(gp + 2048); if (z == 0) gav[m][bj] = *(const u32x4*)gp; }
            asm volatile("" ::: "memory");
#pragma unroll
            for (int m = 0; m < 4; ++m) {
                const size_t row = (size_t)(row0 + ai * HALF + m * 16);
#pragma unroll
                for (int bj = 0; bj < 2; ++bj) {
                    const u32x4 gb = gbv[m][bj];
                    float sb[8];
#pragma unroll
                    for (int i = 0; i < 4; ++i) { sb[2 * i] = bf_lo(gb[i]); sb[2 * i + 1] = bf_hi(gb[i]); }
                    if (z == 0) {
                        const u32x4 ga = gav[m][bj];
#pragma unroll
                        for (int i = 0; i < 4; ++i) {
                            const float r0 = bf_lo(ga[i]) * __builtin_amdgcn_rcpf(sb[2 * i]), r1 = bf_hi(ga[i]) * __builtin_amdgcn_rcpf(sb[2 * i + 1]);
                            const int e0 = 2 * i, e1 = 2 * i + 1;
                            acc[ai][bj][m][e0 >> 2][e0 & 3] *= r0; acc[ai][bj][m][e1 >> 2][e1 & 3] *= r1;
                        }
                    } else {
                        const f32x4 a = acc[ai][bj][m][0], b = acc[ai][bj][m][1]; u32x4 w;
                        w.x = cvt_pk_bf16(a[0] * sb[0], a[1] * sb[1]); w.y = cvt_pk_bf16(a[2] * sb[2], a[3] * sb[3]);
                        w.z = cvt_pk_bf16(b[0] * sb[4], b[1] * sb[5]); w.w = cvt_pk_bf16(b[2] * sb[6], b[3] * sb[7]);
                        *(u32x4*)(MG + row * 2048 + col0 + bj * HALF) = w;
                    }
                }
            }
            asm volatile("" ::: "memory");
        }
    }
};

template <bool WRITE_BF> struct EpiRes {
    static constexpr bool PERM = false;
    const float* base; float* out; bf16_t* xb; float* ss;
    __device__ __forceinline__ bool keep(const Unit&) const { return false; }
    __device__ __forceinline__ void operator()(f32x4 (&acc)[2][2][4][2], const Unit& u, int wr, int wc, int fr, int fq) const {
        const int row0 = u.pm * BM + wr * 64 + fr, col0 = u.pn * BM + wc * 32 + 4 * fq;
#pragma unroll
        for (int ai = 0; ai < 2; ++ai) {
            f32x4 pre[4][2][2];
#pragma unroll
            for (int m = 0; m < 4; ++m)
#pragma unroll
                for (int bj = 0; bj < 2; ++bj)
#pragma unroll
                    for (int n = 0; n < 2; ++n) pre[m][bj][n] = *(const f32x4*)(base + (size_t)(row0 + ai * HALF + m * 16) * DM + col0 + bj * HALF + n * 16);
            asm volatile("" ::: "memory");
#pragma unroll
            for (int m = 0; m < 4; ++m) {
                const size_t row = (size_t)(row0 + ai * HALF + m * 16); const size_t off = row * DM + col0; float q = 0.f;
#pragma unroll
                for (int bj = 0; bj < 2; ++bj)
#pragma unroll
                    for (int n = 0; n < 2; ++n) {
                        const size_t o = off + bj * HALF + n * 16;
                        const f32x4 v = pre[m][bj][n] + acc[ai][bj][m][n];
                        *(f32x4*)(out + o) = v; q += (v[0] * v[0] + v[1] * v[1]) + (v[2] * v[2] + v[3] * v[3]);
                        if (WRITE_BF) { u32x2 w; w.x = cvt_pk_bf16(v[0], v[1]); w.y = cvt_pk_bf16(v[2], v[3]); *(u32x2*)(xb + o) = w; }
                    }
                q += __shfl_xor(q, 16); q += __shfl_xor(q, 32);
                if (fq == 0) atomicAdd(ss + row, q);
            }
            asm volatile("" ::: "memory");
        }
    }
};

struct EpiUp {
    static constexpr bool PERM = true;
    const float* ss; bf16_t* U;
    __device__ __forceinline__ bool keep(const Unit&) const { return false; }
    __device__ __forceinline__ void operator()(f32x4 (&acc)[2][2][4][2], const Unit& u, int wr, int wc, int fr, int fq) const {
        const int row0 = u.pm * BM + wr * 64 + fr, col0 = u.pn * BM + wc * 32 + 8 * fq;
        float rs[2][4];
#pragma unroll
        for (int ai = 0; ai < 2; ++ai)
#pragma unroll
            for (int m = 0; m < 4; ++m) rs[ai][m] = ss[row0 + ai * HALF + m * 16];
        asm volatile("" ::: "memory");
#pragma unroll
        for (int ai = 0; ai < 2; ++ai)
#pragma unroll
            for (int m = 0; m < 4; ++m) {
                const size_t row = (size_t)(row0 + ai * HALF + m * 16);
                const float rstd = __builtin_amdgcn_rsqf(rs[ai][m] * (1.0f / DM) + RMS_EPS);
#pragma unroll
                for (int bj = 0; bj < 2; ++bj) {
                    f32x4 a = acc[ai][bj][m][0] * rstd, b = acc[ai][bj][m][1] * rstd; u32x4 w;
#pragma unroll
                    for (int i = 0; i < 4; ++i) { a[i] = fmaxf(a[i], 0.f); a[i] *= a[i]; b[i] = fmaxf(b[i], 0.f); b[i] *= b[i]; }
                    w.x = cvt_pk_bf16(a[0], a[1]); w.y = cvt_pk_bf16(a[2], a[3]); w.z = cvt_pk_bf16(b[0], b[1]); w.w = cvt_pk_bf16(b[2], b[3]);
                    *(u32x4*)(U + row * DFF + col0 + bj * HALF) = w;
                }
            }
    }
};

template <class Epi, class Sched, bool ALIGN_EPI = false, bool SP2 = false>
__device__ __forceinline__ void gemm_phase(PG8_LAS unsigned char* lds, const Gemm g, const Sched& S, const Epi& E) {
    int tid_ = threadIdx.x; asm volatile("" : "+v"(tid_));
    const int tid = tid_, wid = __builtin_amdgcn_readfirstlane(tid >> 6), lane = tid & 63, wr = wid >> 2, wc = wid & 3, fr = lane & 15, fq = lane >> 4;
    const int K = g.K, nt = K / BK;
    unsigned voffA[2], voffB[2];
#pragma unroll
    for (int i = 0; i < 2; ++i) { int R, C; stage_rc(tid * 16 + i * 8192, R, C); const int Rb = Epi::PERM ? ((R & ~31) + perm32(R & 31)) : R;
        voffA[i] = (unsigned)(R * K + C) * 2u; voffB[i] = (unsigned)(Rb * K + C) * 2u; }
    const size_t kstep = (size_t)(BK * 2);
    const size_t hstep = (size_t)HALF * K * 2;
    const size_t tstep = 2 * hstep;
    const unsigned ldsw = (unsigned)wid * 1024u;
    const int aoff = lds_byte(wr * 64 + fr, fq * 8), boff = lds_byte(wc * 32 + fr, fq * 8);
#define PG8_SA(b, h) (((b) * 2 + (h)) * HTB)
#define PG8_SB(b, h) ((4 + (b) * 2 + (h)) * HTB)
#define PG8_STAGE(bufoff, gbase, voff) do { _Pragma("unroll") for (int _i = 0; _i < 2; ++_i) \
        __builtin_amdgcn_global_load_lds((const unsigned*)((const char*)(gbase) + (voff)[_i]), (PG8_LAS unsigned*)(lds + (bufoff) + ldsw + _i * 8192), 16, 0, 0); } while (0)
#define PG8_LDA(dst, b, h) do { _Pragma("unroll") for (int m = 0; m < 4; ++m) _Pragma("unroll") for (int k = 0; k < 2; ++k) dst[m][k] = *(const PG8_LAS bf16x8*)(lds + PG8_SA(b, h) + aoff + m * 2048 + k * 1024); } while (0)
#define PG8_LDB(dst, b, h) do { _Pragma("unroll") for (int n = 0; n < 2; ++n) _Pragma("unroll") for (int k = 0; k < 2; ++k) dst[n][k] = *(const PG8_LAS bf16x8*)(lds + PG8_SB(b, h) + boff + n * 2048 + k * 1024); } while (0)
#define PG8_MMA(ai, bj, At, Bt) do { __builtin_amdgcn_s_setprio(1); _Pragma("unroll") for (int m = 0; m < 4; ++m) _Pragma("unroll") for (int n = 0; n < 2; ++n) _Pragma("unroll") for (int k = 0; k < 2; ++k) \
        acc[ai][bj][m][n] = __builtin_amdgcn_mfma_f32_16x16x32_bf16(Bt[n][k], At[m][k], acc[ai][bj][m][n], 0, 0, 0); __builtin_amdgcn_s_setprio(0); } while (0)
#define PG8_WAIT_V(n) asm volatile("s_waitcnt vmcnt(" #n ")" ::: "memory")
#define PG8_WAIT_L(n) asm volatile("s_waitcnt lgkmcnt(" #n ")" ::: "memory")
#define PG8_BAR __builtin_amdgcn_s_barrier()
#define PG8_SCHED __builtin_amdgcn_sched_barrier(0)
    Unit cur, nxt; int ui = 0;
    if (!S.next(0, cur)) return;
    f32x4 acc[2][2][4][2];
#pragma unroll
    for (int a = 0; a < 2; ++a)
#pragma unroll
        for (int b = 0; b < 2; ++b)
#pragma unroll
            for (int m = 0; m < 4; ++m)
#pragma unroll
                for (int n = 0; n < 2; ++n) acc[a][b][m][n] = (f32x4){0.f, 0.f, 0.f, 0.f};
    bf16x8 At[4][2], B0[2][2], B1[2][2];
    const char* cA = (const char*)(cur.z ? g.A1 : g.A0) + (size_t)cur.pm * tstep; const char* cB = (const char*)(cur.z ? g.B1 : g.B0) + (size_t)cur.pn * tstep;
    if constexpr (SP2) {
        PG8_STAGE(PG8_SB(0, 0), cB, voffB); PG8_STAGE(PG8_SB(0, 1), cB + hstep, voffB); PG8_STAGE(PG8_SA(0, 0), cA, voffA); PG8_STAGE(PG8_SA(0, 1), cA + hstep, voffA);
        if (wr == 1) PG8_BAR;
        PG8_WAIT_V(2); PG8_BAR;
        PG8_STAGE(PG8_SB(1, 0), cB + kstep, voffB); PG8_STAGE(PG8_SA(1, 0), cA + kstep, voffA); PG8_STAGE(PG8_SB(1, 1), cB + hstep + kstep, voffB);
        PG8_WAIT_V(6); PG8_BAR;
    } else {
        PG8_STAGE(PG8_SB(0, 0), cB, voffB); PG8_STAGE(PG8_SA(0, 0), cA, voffA); PG8_STAGE(PG8_SB(0, 1), cB + hstep, voffB); PG8_STAGE(PG8_SA(0, 1), cA + hstep, voffA);
        if (wr == 1) PG8_BAR;
        PG8_WAIT_V(4); PG8_BAR;
        PG8_STAGE(PG8_SB(1, 0), cB + kstep, voffB); PG8_STAGE(PG8_SA(1, 0), cA + kstep, voffA); PG8_STAGE(PG8_SB(1, 1), cB + hstep + kstep, voffB);
        PG8_WAIT_V(6); PG8_BAR;
    }
    for (;;) {
        const bool has_next = S.next(ui + 1, nxt);
        const char* nA = has_next ? (const char*)(nxt.z ? g.A1 : g.A0) + (size_t)nxt.pm * tstep : cA; const char* nB = has_next ? (const char*)(nxt.z ? g.B1 : g.B0) + (size_t)nxt.pn * tstep : cB;
        for (int t = 0; t < nt; t += 2) {
            const bool last = (t == nt - 2);
            const char* a1 = cA + (size_t)(t + 1) * kstep;
            const char* a2 = last ? nA : cA + (size_t)(t + 2) * kstep; const char* b2 = last ? nB : cB + (size_t)(t + 2) * kstep;
            const char* a3 = a2 + kstep; const char* b3 = b2 + kstep;
            if constexpr (SP2) {
            PG8_LDB(B0, 0, 0); PG8_LDB(B1, 0, 1); PG8_SCHED; PG8_LDA(At, 0, 0); PG8_STAGE(PG8_SA(1, 1), a1 + hstep, voffA);
            PG8_WAIT_V(8); PG8_WAIT_L(0); PG8_BAR; PG8_MMA(0, 0, At, B0); PG8_MMA(0, 1, At, B1); PG8_BAR; PG8_SCHED;
            PG8_LDA(At, 0, 1); PG8_STAGE(PG8_SB(0, 0), b2, voffB); PG8_STAGE(PG8_SB(0, 1), b2 + hstep, voffB); PG8_STAGE(PG8_SA(0, 0), a2, voffA);
            PG8_WAIT_V(8); PG8_WAIT_L(0); PG8_BAR; PG8_MMA(1, 0, At, B0); PG8_MMA(1, 1, At, B1); PG8_BAR; PG8_SCHED;
            PG8_LDB(B0, 1, 0); PG8_LDB(B1, 1, 1); PG8_SCHED; PG8_LDA(At, 1, 0); PG8_STAGE(PG8_SA(0, 1), a2 + hstep, voffA);
            PG8_WAIT_V(8); PG8_WAIT_L(0); PG8_BAR; PG8_MMA(0, 0, At, B0); PG8_MMA(0, 1, At, B1); PG8_BAR; PG8_SCHED;
            PG8_LDA(At, 1, 1); PG8_STAGE(PG8_SB(1, 0), b3, voffB); PG8_STAGE(PG8_SB(1, 1), b3 + hstep, voffB); PG8_STAGE(PG8_SA(1, 0), a3, voffA);
            PG8_WAIT_V(8); PG8_WAIT_L(0); PG8_BAR; PG8_MMA(1, 0, At, B0); PG8_MMA(1, 1, At, B1); PG8_BAR; PG8_SCHED;
            } else {
            PG8_LDB(B0, 0, 0); PG8_SCHED; PG8_LDA(At, 0, 0); PG8_STAGE(PG8_SA(1, 1), a1 + hstep, voffA);
            PG8_WAIT_L(8); PG8_BAR; PG8_WAIT_L(0); PG8_MMA(0, 0, At, B0); PG8_BAR; PG8_SCHED;
            PG8_LDB(B1, 0, 1); PG8_STAGE(PG8_SB(0, 0), b2, voffB);
            PG8_BAR; PG8_WAIT_L(0); PG8_MMA(0, 1, At, B1); PG8_BAR;
            PG8_LDA(At, 0, 1); PG8_STAGE(PG8_SA(0, 0), a2, voffA);
            PG8_BAR; PG8_WAIT_L(0); PG8_MMA(1, 0, At, B0); PG8_BAR; PG8_SCHED;
            PG8_STAGE(PG8_SB(0, 1), b2 + hstep, voffB);
            PG8_WAIT_V(6); PG8_BAR; PG8_MMA(1, 1, At, B1); PG8_BAR;
            PG8_LDB(B0, 1, 0); PG8_SCHED; PG8_LDA(At, 1, 0); PG8_STAGE(PG8_SA(0, 1), a2 + hstep, voffA);
            PG8_WAIT_L(8); PG8_BAR; PG8_WAIT_L(0); PG8_MMA(0, 0, At, B0); PG8_BAR; PG8_SCHED;
            PG8_LDB(B1, 1, 1); PG8_STAGE(PG8_SB(1, 0), b3, voffB);
            PG8_BAR; PG8_WAIT_L(0); PG8_MMA(0, 1, At, B1); PG8_BAR;
            PG8_LDA(At, 1, 1); PG8_STAGE(PG8_SA(1, 0), a3, voffA);
            PG8_BAR; PG8_WAIT_L(0); PG8_MMA(1, 0, At, B0); PG8_BAR; PG8_SCHED;
            PG8_STAGE(PG8_SB(1, 1), b3 + hstep, voffB);
            PG8_WAIT_V(6); PG8_BAR; PG8_MMA(1, 1, At, B1); PG8_BAR;
            }
        }
        if constexpr (ALIGN_EPI) { if (wr == 0) PG8_BAR; }
        E(acc, cur, wr, wc, fr, fq);
        if (!has_next) break;
        if (!E.keep(cur))
#pragma unroll
        for (int a = 0; a < 2; ++a)
#pragma unroll
            for (int b = 0; b < 2; ++b)
#pragma unroll
                for (int m = 0; m < 4; ++m)
#pragma unroll
                    for (int n = 0; n < 2; ++n) acc[a][b][m][n] = (f32x4){0.f, 0.f, 0.f, 0.f};
        cur = nxt; cA = nA; cB = nB; ++ui;
        if constexpr (ALIGN_EPI) { if (wr == 1) PG8_BAR; }
    }
    PG8_WAIT_V(0);
    if constexpr (!ALIGN_EPI) { if (wr == 0) PG8_BAR; }
    PG8_BAR;
#undef PG8_SA
#undef PG8_SB
#undef PG8_STAGE
#undef PG8_LDA
#undef PG8_LDB
#undef PG8_MMA
#undef PG8_WAIT_V
#undef PG8_WAIT_L
#undef PG8_BAR
#undef PG8_SCHED
}
}


namespace attn_body {
using bf16=unsigned short;
using bf16x8=__attribute__((ext_vector_type(8)))short;
using s16x4=__attribute__((ext_vector_type(4)))short;
using f32x16=__attribute__((ext_vector_type(16)))float;
using u32x4=__attribute__((ext_vector_type(4)))unsigned;
using f32x4v=__attribute__((ext_vector_type(4)))float;
constexpr int BATCH=4,NHEAD=16,SEQ=8192,D=64,DM=NHEAD*D;
constexpr int NW=8,QBLK=32,QB=QBLK*NW,KVBLK=64,NQB=SEQ/QB;
constexpr int ATTN_PITCH=DM, ATTN_UNIT_ROWS=QB;
__device__ __forceinline__ int crow(int r,int hi){return (r&3)+8*(r>>2)+4*hi;}
#define SBAR() __builtin_amdgcn_sched_barrier(0)
template<bool SWA> __device__ __forceinline__ void cmask(f32x16&p0,f32x16&p1,int jb,int qrel,int hi){
  const float NEG=-INFINITY; int kb=64*jb+4*hi;
  #pragma unroll
  for(int r=0;r<16;++r){int kv=kb+(r&3)+8*(r>>2);
    if(SWA){ if(kv>qrel||kv<=qrel-128)p0[r]=NEG; if(kv+32>qrel||kv+32<=qrel-128)p1[r]=NEG; }
    else{ if(kv>qrel)p0[r]=NEG; if(kv+32>qrel)p1[r]=NEG; } }
}

constexpr int NSLOT=3, SLOTB=8192;
#ifndef NVB
#define NVB 8
#endif
constexpr int LDS_K=0, LDS_V=NSLOT*SLOTB, LDS_WS=2*NSLOT*SLOTB, LDS_OST=LDS_WS+NW*64*4, LDS_CB=LDS_OST+NW*4096, LDS_BYTES=LDS_CB+4*256;
constexpr float C2=0.125f*1.4426950408889634f;
__device__ __forceinline__ void glds16(const void*gsrc,unsigned lds_dst){unsigned keep;
  asm volatile("s_mov_b32 %0, m0\n\ts_mov_b32 m0, %2\n\ts_nop 0\n\tglobal_load_lds_dwordx4 %1, off\n\ts_mov_b32 m0, %0":"=&s"(keep):"v"(gsrc),"s"(lds_dst):"memory");}
__device__ __forceinline__ void glds4(const void*gsrc,unsigned lds_dst){unsigned keep;
  asm volatile("s_mov_b32 %0, m0\n\ts_mov_b32 m0, %2\n\ts_nop 0\n\tglobal_load_lds_dword %1, off\n\ts_mov_b32 m0, %0":"=&s"(keep):"v"(gsrc),"s"(lds_dst):"memory");}
__device__ __forceinline__ float max3f(float a,float b,float c){float r;asm("v_max3_f32 %0, %1, %2, %3":"=v"(r):"v"(a),"v"(b),"v"(c));return r;}
__device__ __forceinline__ float max2f(float a,float b){float r;asm("v_max_f32_e32 %0, %1, %2":"=v"(r):"v"(a),"v"(b));return r;}
__device__ __forceinline__ float fadd_s(float a,float b){float r;asm("v_add_f32_e32 %0, %1, %2":"=v"(r):"v"(a),"v"(b));return r;}
__device__ __forceinline__ float fsub_s(float a,float b){float r;asm("v_sub_f32_e32 %0, %1, %2":"=v"(r):"v"(a),"v"(b));return r;}
typedef float f32x2_t __attribute__((ext_vector_type(2))); typedef __bf16 bf16x2_t __attribute__((ext_vector_type(2)));
__device__ __forceinline__ unsigned cvtpk_s(float lo,float hi){f32x2_t v={lo,hi};bf16x2_t b=__builtin_convertvector(v,bf16x2_t);return __builtin_bit_cast(unsigned,b);}
#define WAIT_BAR(N) asm volatile("s_waitcnt vmcnt(" #N ") lgkmcnt(0)\n\ts_barrier":::"memory")

__device__ __forceinline__ void qkt(f32x16&p0,f32x16&p1,const char*Kslot,const bf16x8*qr,int r32,int hi){
  const char*kb=Kslot+hi*1024+r32*16;
  #pragma unroll
  for(int d0=0;d0<4;++d0){
    const bf16x8 b0=*reinterpret_cast<const bf16x8*>(kb+d0*2048);
    const bf16x8 b1=*reinterpret_cast<const bf16x8*>(kb+d0*2048+512);
    {p0=__builtin_amdgcn_mfma_f32_32x32x16_bf16(b0,qr[d0],p0,0,0,0);p1=__builtin_amdgcn_mfma_f32_32x32x16_bf16(b1,qr[d0],p1,0,0,0);}}
}
typedef __attribute__((address_space(3))) const char* lds_cptr;
typedef short v4i16_t __attribute__((ext_vector_type(4)));
__device__ __forceinline__ void kload8(bf16x8*kf,lds_cptr kp){
  kf[0]=*(const __attribute__((address_space(3))) bf16x8*)(kp);      kf[1]=*(const __attribute__((address_space(3))) bf16x8*)(kp+512);
  kf[2]=*(const __attribute__((address_space(3))) bf16x8*)(kp+2048); kf[3]=*(const __attribute__((address_space(3))) bf16x8*)(kp+2560);
  kf[4]=*(const __attribute__((address_space(3))) bf16x8*)(kp+4096); kf[5]=*(const __attribute__((address_space(3))) bf16x8*)(kp+4608);
  kf[6]=*(const __attribute__((address_space(3))) bf16x8*)(kp+6144); kf[7]=*(const __attribute__((address_space(3))) bf16x8*)(kp+6656);
}
__device__ __forceinline__ void kload2(bf16x8*kf,lds_cptr kp,int j){ kf[2*j]=*(const __attribute__((address_space(3))) bf16x8*)(kp+j*2048); kf[2*j+1]=*(const __attribute__((address_space(3))) bf16x8*)(kp+j*2048+512); }
__device__ __forceinline__ s16x4 vtr(lds_cptr p){ return __builtin_bit_cast(s16x4,__builtin_amdgcn_ds_read_tr16_b64_v4i16((__attribute__((address_space(3))) v4i16_t*)p)); }
__device__ __forceinline__ float rowmax(const f32x16&p0,const f32x16&p1){
  float a=max3f(p0[0],p0[1],p1[0]),b=max3f(p0[2],p0[3],p1[1]);a=max3f(a,p1[2],p1[3]);
  #pragma unroll
  for(int r=4;r<16;r+=4){a=max3f(a,p0[r],p0[r+1]);b=max3f(b,p0[r+2],p0[r+3]);a=max3f(a,p1[r],p1[r+1]);b=max3f(b,p1[r+2],p1[r+3]);}
  const float m=max2f(a,b);
  auto rr=__builtin_amdgcn_permlane32_swap(__float_as_uint(m),__float_as_uint(m),false,false);
  return max2f(__uint_as_float(rr[0]),__uint_as_float(rr[1]));
}
__device__ __forceinline__ void pv(f32x16*o,int vb,bf16x8 pa0,bf16x8 pa1,bf16x8 pa2,bf16x8 pa3){
  #pragma unroll
  for(int d0=0;d0<2;++d0){s16x4 lo[4],hi[4];
    #pragma unroll
    for(int ks=0;ks<4;++ks){
      asm volatile("ds_read_b64_tr_b16 %0,%1 offset:%c2":"=&v"(lo[ks]):"v"(vb),"i"(d0*4096+ks*1024):"memory");
      asm volatile("ds_read_b64_tr_b16 %0,%1 offset:%c2":"=&v"(hi[ks]):"v"(vb),"i"(d0*4096+ks*1024+512):"memory");}
    asm volatile("s_waitcnt lgkmcnt(0)":::"memory");SBAR();
    #define PK(k) (bf16x8){lo[k][0],lo[k][1],lo[k][2],lo[k][3],hi[k][0],hi[k][1],hi[k][2],hi[k][3]}
    o[d0]=__builtin_amdgcn_mfma_f32_32x32x16_bf16(pa0,PK(0),o[d0],0,0,0);
    o[d0]=__builtin_amdgcn_mfma_f32_32x32x16_bf16(pa1,PK(1),o[d0],0,0,0);
    o[d0]=__builtin_amdgcn_mfma_f32_32x32x16_bf16(pa2,PK(2),o[d0],0,0,0);
    o[d0]=__builtin_amdgcn_mfma_f32_32x32x16_bf16(pa3,PK(3),o[d0],0,0,0);
    #undef PK
  }
}

typedef __attribute__((address_space(3))) const f32x4v* lds_f4ptr;
__device__ __forceinline__ void fill_bias(f32x16&c0,f32x16&c1,lds_cptr cb,float negmh){
  #pragma unroll
  for(int g=0;g<4;++g){ const f32x4v v=*(lds_f4ptr)(cb+g*32), w=*(lds_f4ptr)(cb+128+g*32);
    #pragma unroll
    for(int i=0;i<4;++i){ c0[4*g+i]=negmh-v[i]; c1[4*g+i]=negmh-w[i]; } }
}
#ifndef ATTN_STORE16
#define ATTN_STORE16(p,v) (*(u32x4*)(p)=(v))
#endif
template<int THRL,bool FOX,int KP> __device__ __forceinline__ void attn_unit(int b,int h,int qb,const bf16*Q,const bf16*__restrict__ K,const bf16*__restrict__ V,bf16*O,const float*__restrict__ Cb,float sink2,char*shm){
  int tid_=threadIdx.x; asm volatile("":"+v"(tid_));
  const int tid=tid_,lane=tid&63,r32=lane&31,hi=lane>>5; const int wid=__builtin_amdgcn_readfirstlane(tid>>6);
  const long rowbase=(long)b*SEQ; const int q0=qb*QB;
  const bf16*Qw=Q+(rowbase+q0+wid*QBLK)*DM+h*D;
  const int kvh=FOX?h:(h>>3); const int T0=FOX?0:(qb==0?0:4*qb-2);
  const bf16*Kh=K+(rowbase+(long)T0*KVBLK)*KP+kvh*D,*Vh=V+(rowbase+(long)T0*KVBLK)*KP+kvh*D; const float*Cs=FOX?Cb+lane:nullptr;
  const unsigned lds0=(unsigned)(uintptr_t)shm;
  float*wsf=(float*)(shm+LDS_WS)+wid*64;
  const bf16*ksrc=Kh+(long)lane*KP+wid*8;
  const bf16*vsrc=Vh+(long)(16*(wid&3)+(lane>>2))*KP+(wid>>2)*32+(lane&3)*8;
  const unsigned kdst=lds0+LDS_K+wid*1024, vdst=lds0+LDS_V+wid*1024;
  #define DMA_K(t,slot) glds16(ksrc+(long)(t)*KVBLK*KP,(unsigned)__builtin_amdgcn_readfirstlane(kdst+(slot)))
  #define DMA_C(t) do{ if(FOX) glds4(Cs+(long)(t)*KVBLK,(unsigned)__builtin_amdgcn_readfirstlane(lds0+LDS_CB+(((t)&3)<<8))); }while(0)
  #define PREFILL(X0,X1,t) do{ if(FOX){ fill_bias(X0,X1,cb0+(((t)&3)<<8),-mhat); } else { _Pragma("unroll") for(int r=0;r<16;++r){X0[r]=-mhat;X1[r]=-mhat;} } }while(0)
  #define DMA_V(t,slot) glds16(vsrc+(long)(t)*KVBLK*KP,(unsigned)__builtin_amdgcn_readfirstlane(vdst+(slot)))
  const int vb0=(int)(lds0+LDS_V)+((lane>>4)&1)*32+(lane&3)*8+(4*hi+((lane&15)>>2))*64;
  const char*Kbase=shm+LDS_K; bf16x8 kf[8];
  const lds_cptr shm3=(lds_cptr)shm; const lds_cptr cb0=shm3+LDS_CB+hi*16; const lds_cptr kp0=shm3+LDS_K+hi*1024+r32*16; const lds_cptr vp0=shm3+LDS_V+((lane>>4)&1)*32+(lane&3)*8+(4*hi+((lane&15)>>2))*64;
  const int NT=FOX?(q0+QB)/KVBLK:(qb==0?4:6);
  DMA_K(0,0);DMA_C(0);DMA_V(0,0);DMA_K(1,SLOTB);DMA_C(1);
  bf16x8 qr[4];
  #pragma unroll
  for(int d0=0;d0<4;++d0)qr[d0]=*reinterpret_cast<const bf16x8*>(&Qw[(long)r32*DM+d0*16+hi*8]);
  float mhat=FOX?-Cb[q0+wid*QBLK+r32]:0.f,l_reg=0.f;    f32x16 o[2];o[0]=f32x16{};o[1]=f32x16{};
  const int qrel=wid*QBLK+r32;
  #define CMASK(P0,P1,t) do{int jb_=(t)-(NT-4); if(!FOX||jb_>=0)cmask<!FOX>(P0,P1,jb_,qrel,hi);}while(0)
  bool resc=false;
  #define START(P0,P1) do{ float rm=__builtin_fmaxf(rowmax(P0,P1),0.f); resc=false;     \
    { const float dl=rm; mhat=fadd_s(mhat,dl); \
      _Pragma("unroll") for(int r=0;r<16;++r){P0[r]=fsub_s(P0[r],dl);P1[r]=fsub_s(P1[r],dl);} } \
    _Pragma("unroll") for(int r=0;r<16;++r)P0[r]=__builtin_amdgcn_exp2f(P0[r]); }while(0)
  #define RESC() do{ if(resc){ asm volatile("s_waitcnt lgkmcnt(0)":::"memory"); \
      _Pragma("unroll") for(int d_=0;d_<2;++d_) _Pragma("unroll") for(int r=0;r<16;++r)o[d_][r]*=wsf[crow(r,hi)]; } }while(0)
  f32x16 pA0,pA1,pB0,pB1;
  int sl_prev=0,sl_cur=0,sl_next=SLOTB;
  #define ROT() do{sl_prev=sl_cur;sl_cur=sl_next;sl_next=(sl_next==(NSLOT-1)*SLOTB)?0:sl_next+SLOTB;}while(0)
  DMA_K(2,2*SLOTB);DMA_C(2);
  if(FOX){WAIT_BAR(5);}else{WAIT_BAR(3);}
  PREFILL(pA0,pA1,0); qkt(pA0,pA1,Kbase,qr,r32,hi);asm volatile("s_nop 15\n\ts_nop 7":"+v"(pA0),"+v"(pA1));CMASK(pA0,pA1,0);
  START(pA0,pA1);
  _Pragma("unroll") for(int r=0;r<16;++r)pA1[r]=__builtin_amdgcn_exp2f(pA1[r]);
  WAIT_BAR(0);
  DMA_K(3,0);DMA_C(3);DMA_V(1,SLOTB);
  ROT();
  kload8(kf,kp0+sl_cur);
  PREFILL(pB0,pB1,1); if(FOX){ WAIT_BAR(3); }else{ WAIT_BAR(2); }
  s16x4 vlo[NVB],vhi[NVB]; u32x4 pw0,pw1,pw2,pw3;
  #define PKW(P,B) cvtpk_s(P[B],P[B+1])
  #define PAF(k) __builtin_bit_cast(bf16x8,pw##k)
  #define VFR(j) (bf16x8){vlo[(j)%NVB][0],vlo[(j)%NVB][1],vlo[(j)%NVB][2],vlo[(j)%NVB][3],vhi[(j)%NVB][0],vhi[(j)%NVB][1],vhi[(j)%NVB][2],vhi[(j)%NVB][3]}
  #define PIN(x) asm volatile("":"+v"(x))
  #define MX3(a,b,c) __builtin_fmaxf(__builtin_fmaxf((a),(b)),(c))
  #define GAPA(MF,A0,A1,A2,A3,W0,W1,PW) do{ MF; sacc+=A0; sacc+=A1; sacc+=A2; sacc+=A3; PIN(sacc); W0; W1; PIN(PW); SBAR(); }while(0)
  #define EX(v) __builtin_amdgcn_exp2f(v)
  #define GAPB(MF,VR,BX_,X,B) do{ MF; VR; BX_; X[B]=EX(X[B]); X[B+1]=EX(X[B+1]); X[B+2]=EX(X[B+2]); X[B+3]=EX(X[B+3]); PIN(X); SBAR(); }while(0)
  #define VOFF(j) ((((j)&1)*4096)+(((j)>>1)*1024))
  #define VRD(j) do{ if((j)>=0&&(j)<8){ vlo[(j)%NVB]=vtr(vp_+VOFF(j)); vhi[(j)%NVB]=vtr(vp_+VOFF(j)+512); } }while(0)
  #define KRD(G,j) do{ if(G){ kload2(kf,kp0+sl_next,j); SBAR(); } }while(0)
  #define BSUBX(X,g) do{ X[4*(g)+0]=nmh_-bt[0]; X[4*(g)+1]=nmh_-bt[1]; X[4*(g)+2]=nmh_-bt[2]; X[4*(g)+3]=nmh_-bt[3]; }while(0)
  #define BXX(Y0,Y1,j,G) do{ if(FOX&&(G)){ if((j)>=1&&(j)<=4){BSUBX(Y0,((j)-1)&3);} if((j)>=5){BSUBX(Y1,((j)-5)&3);} if((j)<8){ bt=*(lds_f4ptr)(cbn_+(((j)&3)*32+((j)>>2)*128)); } } }while(0)
  #define STEP(C0,C1,P0,P1,t,GK,GV,GL) do{ SBAR(); f32x4v bt; const lds_cptr cbn_=cb0+((((t)+1)&3)<<8); \
    const lds_cptr vp_=vp0+sl_prev; \
    VRD(0-(8-NVB)); SBAR(); float sacc=(P0[0]+P0[1]); \
    GAPA(C0=__builtin_amdgcn_mfma_f32_32x32x16_bf16(kf[0],qr[0],C0,0,0,0), P0[2],P0[3],P0[4],P0[5],     pw0[0]=PKW(P0,0), pw0[1]=PKW(P0,2), pw0); \
    VRD(1-(8-NVB)); SBAR(); GAPA(C1=__builtin_amdgcn_mfma_f32_32x32x16_bf16(kf[1],qr[0],C1,0,0,0), P0[6],P0[7],P0[8],P0[9],     pw0[2]=PKW(P0,4), pw0[3]=PKW(P0,6), pw0); \
    VRD(2-(8-NVB)); SBAR(); GAPA(C0=__builtin_amdgcn_mfma_f32_32x32x16_bf16(kf[2],qr[1],C0,0,0,0),   P0[10],P0[11],P0[12],P0[13], pw1[0]=PKW(P0,8), pw1[1]=PKW(P0,10), pw1); \
    VRD(3-(8-NVB)); SBAR(); GAPA(C1=__builtin_amdgcn_mfma_f32_32x32x16_bf16(kf[3],qr[1],C1,0,0,0),   P0[14],P0[15],P1[0],P1[1],   pw1[2]=PKW(P0,12),pw1[3]=PKW(P0,14), pw1); \
    VRD(4-(8-NVB)); SBAR(); GAPA(C0=__builtin_amdgcn_mfma_f32_32x32x16_bf16(kf[4],qr[2],C0,0,0,0),   P1[2],P1[3],P1[4],P1[5],     pw2[0]=PKW(P1,0), pw2[1]=PKW(P1,2), pw2); \
    VRD(5-(8-NVB)); SBAR(); GAPA(C1=__builtin_amdgcn_mfma_f32_32x32x16_bf16(kf[5],qr[2],C1,0,0,0),   P1[6],P1[7],P1[8],P1[9],     pw2[2]=PKW(P1,4), pw2[3]=PKW(P1,6), pw2); \
    VRD(6-(8-NVB)); SBAR(); GAPA(C0=__builtin_amdgcn_mfma_f32_32x32x16_bf16(kf[6],qr[3],C0,0,0,0),   P1[10],P1[11],P1[12],P1[13], pw3[0]=PKW(P1,8), pw3[1]=PKW(P1,10), pw3); \
    VRD(7-(8-NVB)); SBAR(); GAPA(C1=__builtin_amdgcn_mfma_f32_32x32x16_bf16(kf[7],qr[3],C1,0,0,0),   P1[14],P1[15],0.f,0.f,       pw3[2]=PKW(P1,12),pw3[3]=PKW(P1,14), pw3); \
    l_reg+=sacc; \
    if(GK){DMA_K((t)+3,sl_cur);DMA_C((t)+3);} if(GV){DMA_V((t)+1,sl_next);} \
    CMASK(C0,C1,t); \
    { float a=MX3(C0[0],C0[1],C1[0]),b=MX3(C0[2],C0[3],C1[1]); a=MX3(a,C1[2],C1[3]); \
      _Pragma("unroll") for(int r=4;r<16;r+=4){a=MX3(a,C0[r],C0[r+1]);b=MX3(b,C0[r+2],C0[r+3]);a=MX3(a,C1[r],C1[r+1]);b=MX3(b,C1[r+2],C1[r+3]);} \
      float rm=__builtin_fmaxf(a,b); { auto rr=__builtin_amdgcn_permlane32_swap(__float_as_uint(rm),__float_as_uint(rm),false,false); rm=__builtin_fmaxf(__uint_as_float(rr[0]),__uint_as_float(rr[1])); } \
      resc=false; \
      if(__builtin_expect(__any(rm>(float)THRL),0)){ const float dl=__builtin_fmaxf(rm,0.f); mhat+=dl; \
        _Pragma("unroll") for(int r=0;r<16;++r){C0[r]-=dl;C1[r]-=dl;} \
        const float f=__builtin_amdgcn_exp2f(-dl); l_reg*=f; if(hi==0)wsf[r32]=f; resc=true; } } \
    const float nmh_=-mhat; SBAR(); \
    GAPB(o[0]=__builtin_amdgcn_mfma_f32_32x32x16_bf16(PAF(0),VFR(0),o[0],0,0,0), VRD(0+NVB), BXX(P0,P1,0,GL), C0,0); \
    GAPB(o[1]=__builtin_amdgcn_mfma_f32_32x32x16_bf16(PAF(0),VFR(1),o[1],0,0,0), VRD(1+NVB), BXX(P0,P1,1,GL), C0,4); \
    KRD(GL,0); GAPB(o[0]=__builtin_amdgcn_mfma_f32_32x32x16_bf16(PAF(1),VFR(2),o[0],0,0,0), VRD(2+NVB), BXX(P0,P1,2,GL), C0,8); \
    KRD(GL,1); GAPB(o[1]=__builtin_amdgcn_mfma_f32_32x32x16_bf16(PAF(1),VFR(3),o[1],0,0,0), VRD(3+NVB), BXX(P0,P1,3,GL), C0,12); \
    KRD(GL,2); GAPB(o[0]=__builtin_amdgcn_mfma_f32_32x32x16_bf16(PAF(2),VFR(4),o[0],0,0,0), VRD(4+NVB), BXX(P0,P1,4,GL), C1,0); \
    KRD(GL,3); GAPB(o[1]=__builtin_amdgcn_mfma_f32_32x32x16_bf16(PAF(2),VFR(5),o[1],0,0,0), VRD(5+NVB), BXX(P0,P1,5,GL), C1,4); \
    GAPB(o[0]=__builtin_amdgcn_mfma_f32_32x32x16_bf16(PAF(3),VFR(6),o[0],0,0,0), VRD(6+NVB), BXX(P0,P1,6,GL), C1,8); \
    GAPB(o[1]=__builtin_amdgcn_mfma_f32_32x32x16_bf16(PAF(3),VFR(7),o[1],0,0,0), VRD(7+NVB), BXX(P0,P1,7,GL), C1,12); \
    BXX(P0,P1,8,GL); if(!FOX&&(GL)){ PREFILL(P0,P1,(t)+1); } \
    }while(0)
  int t=1;
  #undef CMASK
  #define CMASK(P0,P1,t) do{}while(0)
  for(;t+5<NT;t+=2){
    STEP(pB0,pB1,pA0,pA1,t,true,true,true);     if(FOX){WAIT_BAR(3);}else{WAIT_BAR(2);} RESC(); ROT();
    STEP(pA0,pA1,pB0,pB1,t+1,true,true,true);   if(FOX){WAIT_BAR(3);}else{WAIT_BAR(2);} RESC(); ROT();
  }
  #undef CMASK
  #define CMASK(P0,P1,t) do{int jb_=(t)-(NT-4); if(!FOX||jb_>=0)cmask<!FOX>(P0,P1,jb_,qrel,hi);}while(0)
  #define ENDW(tt) do{ if((tt)+3<NT){ if(FOX){WAIT_BAR(3);}else{WAIT_BAR(2);} } else if((tt)+2<NT){WAIT_BAR(1);} else {WAIT_BAR(0);} }while(0)
  for(;t+1<NT;t+=2){
    STEP(pB0,pB1,pA0,pA1,t,(t+3<NT),(t+1<NT),(t+1<NT));       ENDW(t);   RESC(); ROT();
    STEP(pA0,pA1,pB0,pB1,t+1,(t+4<NT),(t+2<NT),(t+2<NT));     ENDW(t+1); RESC(); ROT();
  }
  STEP(pB0,pB1,pA0,pA1,NT-1,false,false,false); RESC();
  { float sacc=pB0[0]+pB0[1]; _Pragma("unroll") for(int r=2;r<16;++r)sacc+=pB0[r]; _Pragma("unroll") for(int r=0;r<16;++r)sacc+=pB1[r]; l_reg+=sacc;
    pw0=(u32x4){PKW(pB0,0),PKW(pB0,2),PKW(pB0,4),PKW(pB0,6)};pw1=(u32x4){PKW(pB0,8),PKW(pB0,10),PKW(pB0,12),PKW(pB0,14)};pw2=(u32x4){PKW(pB1,0),PKW(pB1,2),PKW(pB1,4),PKW(pB1,6)};pw3=(u32x4){PKW(pB1,8),PKW(pB1,10),PKW(pB1,12),PKW(pB1,14)};
    SBAR(); pv(o,vb0+sl_cur,PAF(0),PAF(1),PAF(2),PAF(3)); }
  #undef PKW
  #undef PAF
  #undef VFR
  #undef PIN
  #undef MX3
  #undef GAPA
  #undef GAPB
  #undef EX
  #undef VRD
  #undef VOFF
  #undef KRD
  #undef STEP
  #undef ENDW
  {auto rr=__builtin_amdgcn_permlane32_swap(__float_as_uint(l_reg),__float_as_uint(l_reg),false,false);l_reg=__uint_as_float(rr[0])+__uint_as_float(rr[1]);}
  if(!FOX) l_reg+=__builtin_amdgcn_exp2f(sink2-mhat);
  if(hi==0)wsf[32+r32]=l_reg;asm volatile("s_waitcnt lgkmcnt(0)":::"memory");
  float rli[16];
  #pragma unroll
  for(int r=0;r<16;++r)rli[r]=__builtin_amdgcn_rcpf(wsf[32+crow(r,hi)]);
  bf16*Ow=O+(rowbase+q0+wid*QBLK)*DM+h*D;
  { bf16*stg=(bf16*)(shm+LDS_OST)+wid*2048;
    #pragma unroll
    for(int r=0;r<16;++r){const int orow=crow(r,hi);
      #pragma unroll
      for(int d0=0;d0<2;++d0)stg[orow*64+d0*32+r32]=(bf16)(cvtpk_s(o[d0][r]*rli[r],0.f)&0xffffu);}
    asm volatile("s_waitcnt lgkmcnt(0)":::"memory");
    #pragma unroll
    for(int i=0;i<4;++i){const int row=i*8+(lane>>3),ch=lane&7; const u32x4 v=*(const u32x4*)(stg+row*64+ch*8); ATTN_STORE16(Ow+(long)row*DM+ch*8,v);} }
  asm volatile("s_waitcnt lgkmcnt(0)\n\ts_barrier":::"memory");
  #undef DMA_K
  #undef DMA_V
  #undef DMA_C
  #undef PREFILL
  #undef BSUBX
  #undef BXX
  #undef CMASK
  #undef START
  #undef RESC
  #undef ROT
}
constexpr int ATTN_LDS_BYTES=LDS_BYTES;
#undef SBAR
#undef WAIT_BAR
}

#ifndef REP_PHASE
#define REP_PHASE 0
#endif
#ifndef NAIVE_SWA
#define NAIVE_SWA 0
#endif
#ifndef NAIVE_FOX
#define NAIVE_FOX 0
#endif
#define LAS __attribute__((address_space(3)))
typedef unsigned short bf16;
typedef float f32x4 __attribute__((ext_vector_type(4)));
typedef unsigned v4u __attribute__((ext_vector_type(4)));
typedef unsigned v2u __attribute__((ext_vector_type(2)));
constexpr int NWAVES = 8;
constexpr int RING_BYTES = 131072, LDS_BYTES = 147456;

__device__ __forceinline__ float wave_sum(float v) {
#pragma unroll
    for (int o = 1; o < 64; o <<= 1) v += __shfl_xor(v, o);
    return v;
}
#define LDS_WAIT() asm volatile("s_waitcnt lgkmcnt(0)" ::: "memory")

__device__ __forceinline__ void tr_item(const float* W, int K, int N, bf16* WT, int dst_row0, int src_col0, int nvalid, int kb, const float* kscale, LAS float* scr, int lane) {
    const int k0 = 64 * kb, c = lane & 31;
    float tv[32];
    const float* wp = W + (size_t)(k0 + (lane >> 5)) * N + src_col0 + c;
#pragma unroll
    for (int i = 0; i < 32; ++i) { tv[i] = 0.f; if (c < nvalid) tv[i] = __builtin_nontemporal_load(wp + (size_t)(2 * i) * N); }
#pragma unroll
    for (int i = 0; i < 32; ++i) { const int kk = 2 * i + (lane >> 5); float v = tv[i]; if (kscale) v *= kscale[k0 + kk]; scr[kk * 33 + c] = v; }
    LDS_WAIT(); asm volatile("" ::: "memory");
    const int ch = lane & 7;
#pragma unroll
    for (int j = 0; j < 4; ++j) { const int n = (lane >> 3) + 8 * j; const LAS float* s = scr + (8 * ch) * 33 + n;
        v4u o; o.x = pg8::cvt_pk_bf16(s[0 * 33], s[1 * 33]); o.y = pg8::cvt_pk_bf16(s[2 * 33], s[3 * 33]); o.z = pg8::cvt_pk_bf16(s[4 * 33], s[5 * 33]); o.w = pg8::cvt_pk_bf16(s[6 * 33], s[7 * 33]);
        *(v4u*)(WT + (size_t)(dst_row0 + n) * K + k0 + 8 * ch) = o; }
    LDS_WAIT(); asm volatile("" ::: "memory");
}
__device__ __forceinline__ void win_map(int db, int& src, int& nv) {
    const int pn = db >> 3, bj = (db >> 2) & 1, wc = db & 3; nv = 32;
    if (pn < 4) src = (4 * pn + wc) * 64 + 32 * bj;
    else if (pn == 4) src = (wc < 2 ? 1024 + wc * 64 : 1152 + (wc - 2) * 64) + 32 * bj;
    else if (pn < 17) { const int t = pn - 5; src = 1280 + (t >> 2) * 1024 + (4 * (t & 3) + wc) * 64 + 32 * bj; }
    else if (pn < 33) src = 4368 + (db - 136) * 32;
    else { src = 4352; nv = (db == 264) ? 16 : 0; }
}

struct Args { const float* x; const int* pos; const float* attn_norm; const float* w_in; const float* fbias; const float* sinks; const float* w_bs; const float* w_bf;
              const float* w_out; const float* mlp_norm; const float* w_up; const float* w_dn; const float* final_norm; float* out; unsigned char* ws; };

__device__ __forceinline__ void rms_row_to_bf16(const float* xrow, const float* gain, bf16* orow, int lane) {
    const f32x4* xr = (const f32x4*)xrow + lane; f32x4 v[8]; float s = 0.f;
#pragma unroll
    for (int j = 0; j < 8; ++j) { v[j] = xr[64 * j]; s += (v[j].x * v[j].x + v[j].y * v[j].y) + (v[j].z * v[j].z + v[j].w * v[j].w); }
    const float rstd = __builtin_amdgcn_rsqf(wave_sum(s) * (1.f / DM) + RMS_EPS);
    const f32x4* gr = (const f32x4*)gain + lane; v2u* o8 = (v2u*)orow + lane;
#pragma unroll
    for (int j = 0; j < 8; ++j) { const f32x4 g = gr[64 * j]; v2u w; w.x = pg8::cvt_pk_bf16(v[j].x * rstd * g.x, v[j].y * rstd * g.y); w.y = pg8::cvt_pk_bf16(v[j].z * rstd * g.z, v[j].w * rstd * g.w); o8[64 * j] = w; }
}

__device__ __forceinline__ void rms_row2_to_bf16(const float* x0, const float* x1, const float* gain, bf16* o0, bf16* o1, int lane) {
    const f32x4* xr0 = (const f32x4*)x0 + lane; const f32x4* xr1 = (const f32x4*)x1 + lane; f32x4 v[8], w[8]; float s = 0.f, t = 0.f;
#pragma unroll
    for (int j = 0; j < 8; ++j) { v[j] = __builtin_nontemporal_load(xr0 + 64 * j); w[j] = __builtin_nontemporal_load(xr1 + 64 * j); }
#pragma unroll
    for (int j = 0; j < 8; ++j) { s += (v[j].x * v[j].x + v[j].y * v[j].y) + (v[j].z * v[j].z + v[j].w * v[j].w); t += (w[j].x * w[j].x + w[j].y * w[j].y) + (w[j].z * w[j].z + w[j].w * w[j].w); }
    const float rs = __builtin_amdgcn_rsqf(wave_sum(s) * (1.f / DM) + RMS_EPS), rt = __builtin_amdgcn_rsqf(wave_sum(t) * (1.f / DM) + RMS_EPS);
    const f32x4* gr = (const f32x4*)gain + lane; v2u* p0 = (v2u*)o0 + lane; v2u* p1 = (v2u*)o1 + lane;
#pragma unroll
    for (int j = 0; j < 8; ++j) { const f32x4 g = gr[64 * j]; v2u a, c;
        a.x = pg8::cvt_pk_bf16(v[j].x * rs * g.x, v[j].y * rs * g.y); a.y = pg8::cvt_pk_bf16(v[j].z * rs * g.z, v[j].w * rs * g.w);
        c.x = pg8::cvt_pk_bf16(w[j].x * rt * g.x, w[j].y * rt * g.y); c.y = pg8::cvt_pk_bf16(w[j].z * rt * g.z, w[j].w * rt * g.w);
        p0[64 * j] = a; p1[64 * j] = c; }
}
__device__ __forceinline__ void p0_prologue(const Args& a, LAS unsigned char* lds, int vcu, int G, int wave, int lane) {
    unsigned char* ws = a.ws;
    LAS float* scr = (LAS float*)(lds + wave * 16384);
    const int gw = vcu * NWAVES + wave, NGW = G * NWAVES;
    constexpr int I_IN = (NIN / 32) * (DM / 64), I_BS = (DM / 32) * (1024 / 64), I_OUT = (DM / 32) * (DM / 64), I_UP = (DFF / 32) * (DM / 64), I_DN = (DM / 32) * (DFF / 64);
    constexpr int NITEMS = I_IN + 2 * I_BS + I_OUT + I_UP + I_DN;
    for (int it = gw; it < NITEMS; it += NGW) {
        int r = it;
        if (r < I_IN) { const int db = r / (DM / 64), kb = r % (DM / 64); int src, nv; win_map(db, src, nv); tr_item(a.w_in, DM, DIN, (bf16*)(ws + WS_WIN), db * 32, src, nv, kb, nullptr, scr, lane); continue; } r -= I_IN;
        if (r < I_BS) { const int db = r / 16, kb = r % 16; tr_item(a.w_bs, 1024, DM, (bf16*)(ws + WS_WBS), db * 32, db * 32, 32, kb, nullptr, scr, lane); continue; } r -= I_BS;
        if (r < I_BS) { const int db = r / 16, kb = r % 16; tr_item(a.w_bf, 1024, DM, (bf16*)(ws + WS_WBF), db * 32, db * 32, 32, kb, nullptr, scr, lane); continue; } r -= I_BS;
        if (r < I_OUT) { const int db = r / 32, kb = r % 32; tr_item(a.w_out, DM, DM, (bf16*)(ws + WS_WOUT), db * 32, db * 32, 32, kb, nullptr, scr, lane); continue; } r -= I_OUT;
        if (r < I_UP) { const int db = r / 32, kb = r % 32; tr_item(a.w_up, DM, DFF, (bf16*)(ws + WS_WUP), db * 32, db * 32, 32, kb, a.mlp_norm, scr, lane); continue; } r -= I_UP;
        { const int db = r / 128, kb = r % 128; tr_item(a.w_dn, DFF, DM, (bf16*)(ws + WS_WDN), db * 32, db * 32, 32, kb, nullptr, scr, lane); }
    }
    for (int m = gw; m < M; m += 2 * NGW) rms_row2_to_bf16(a.x + (size_t)m * DM, a.x + (size_t)(m + NGW) * DM, a.attn_norm, (bf16*)(ws + WS_XN) + (size_t)m * DM, (bf16*)(ws + WS_XN) + (size_t)(m + NGW) * DM, lane);
    float* cs = (float*)(ws + WS_CS);
    for (int e = gw * 64 + lane; e < M * 32; e += NGW * 64) {
        const int tok = e >> 5, i = e & 31;
        const float inv_freq = powf(10000.0f, -(float)(2 * i) / 64.0f);
        const float ang = (float)a.pos[tok] * inv_freq;
        double rev = (double)ang * 0.15915494309189535; rev -= floor(rev);
        const float rf = (float)rev;
        cs[e] = __builtin_amdgcn_cosf(rf); cs[(size_t)M * 32 + e] = __builtin_amdgcn_sinf(rf);
    }
}

__device__ __forceinline__ void cumsum_unit(const Args& a, int bh, LAS unsigned char* lds) {
    const float* FL = (const float*)(a.ws + WS_FL); float* Cp = (float*)(a.ws + WS_C);
    LAS double* sh = (LAS double*)lds;
    const int b = bh >> 4, h = bh & 15, tid = threadIdx.x, s0 = tid * 16; const float fb = a.fbias[h];
    float ls[16]; double run = 0.0;
#pragma unroll
    for (int i = 0; i < 16; ++i) { const float z = FL[(size_t)(b * SEQ + s0 + i) * 16 + h] + fb; const float v = fminf(z, 0.f) - log1pf(expf(-fabsf(z))); ls[i] = v; run += (double)v; }
    sh[tid] = run; __syncthreads();
    double pre = 0.0; for (int k = 0; k < tid; ++k) pre += sh[k];
#pragma unroll
    for (int i = 0; i < 16; ++i) { pre += (double)ls[i]; Cp[(size_t)bh * SEQ + s0 + i] = (float)(pre * 1.4426950408889634); }
    __syncthreads();
}

__device__ __forceinline__ void naive_swa_unit(const Args& a, int unit) {
    const bf16* AQ = (const bf16*)(a.ws + WS_AQ); const bf16* AK = (const bf16*)(a.ws + WS_AK); const bf16* AV = (const bf16*)(a.ws + WS_AV); bf16* OA = (bf16*)(a.ws + WS_OA);
    const int tid = threadIdx.x, head = tid & 15, tok = unit * 32 + (tid >> 4), b = tok / SEQ, s = tok % SEQ, kvh = head >> 3;
    float q[64], o[64]; float m = -INFINITY, l = 0.f;
    { const v4u* qp = (const v4u*)(AQ + (size_t)tok * 1024 + head * 64);
#pragma unroll
      for (int c = 0; c < 8; ++c) { const v4u w = qp[c];
#pragma unroll
          for (int e = 0; e < 4; ++e) { q[8 * c + 2 * e] = pg8::bf_lo(w[e]); q[8 * c + 2 * e + 1] = pg8::bf_hi(w[e]); } } }
#pragma unroll
    for (int d = 0; d < 64; ++d) o[d] = 0.f;
    for (int i = 0; i < 128; ++i) {
        const int j = s - i; const bool valid = j >= 0; const int jj = valid ? j : 0;
        const v4u* kp = (const v4u*)(AK + (size_t)(b * SEQ + jj) * 128 + kvh * 64); const v4u* vp = (const v4u*)(AV + (size_t)(b * SEQ + jj) * 128 + kvh * 64);
        float dot = 0.f;
#pragma unroll
        for (int c = 0; c < 8; ++c) { const v4u w = kp[c];
#pragma unroll
            for (int e = 0; e < 4; ++e) { dot += q[8 * c + 2 * e] * pg8::bf_lo(w[e]); dot += q[8 * c + 2 * e + 1] * pg8::bf_hi(w[e]); } }
        const float lg = valid ? dot : -INFINITY;
        const float mn = fmaxf(m, lg), al = __builtin_amdgcn_exp2f(m - mn), p = __builtin_amdgcn_exp2f(lg - mn);
        l = l * al + p; m = mn;
#pragma unroll
        for (int c = 0; c < 8; ++c) { const v4u w = vp[c];
#pragma unroll
            for (int e = 0; e < 4; ++e) { o[8 * c + 2 * e] = o[8 * c + 2 * e] * al + p * pg8::bf_lo(w[e]); o[8 * c + 2 * e + 1] = o[8 * c + 2 * e + 1] * al + p * pg8::bf_hi(w[e]); } }
    }
    { const float sk = a.sinks[head] * LOG2E; const float m2 = fmaxf(m, sk), al = __builtin_amdgcn_exp2f(m - m2); l = l * al + __builtin_amdgcn_exp2f(sk - m2);
      const float rl = al / l;
      v4u* op = (v4u*)(OA + (size_t)tok * 1024 + head * 64);
#pragma unroll
      for (int c = 0; c < 8; ++c) { v4u w;
#pragma unroll
          for (int e = 0; e < 4; ++e) w[e] = pg8::cvt_pk_bf16(o[8 * c + 2 * e] * rl, o[8 * c + 2 * e + 1] * rl);
          op[c] = w; } }
}
__device__ __forceinline__ void naive_fox_unit(const Args& a, int bh, int qblk) {
    const bf16* FQ = (const bf16*)(a.ws + WS_FQ); const bf16* FK = (const bf16*)(a.ws + WS_FK); const bf16* FV = (const bf16*)(a.ws + WS_FV); bf16* OB = (bf16*)(a.ws + WS_OB);
    const float* Cp = (const float*)(a.ws + WS_C) + (size_t)bh * SEQ;
    const int tid = threadIdx.x, b = bh >> 4, h = bh & 15, s = qblk * 512 + tid; const size_t tok = (size_t)b * SEQ + s;
    float q[64], o[64]; float m = -INFINITY, l = 0.f;
    { const v4u* qp = (const v4u*)(FQ + tok * 1024 + h * 64);
#pragma unroll
      for (int c = 0; c < 8; ++c) { const v4u w = qp[c];
#pragma unroll
          for (int e = 0; e < 4; ++e) { q[8 * c + 2 * e] = pg8::bf_lo(w[e]); q[8 * c + 2 * e + 1] = pg8::bf_hi(w[e]); } } }
#pragma unroll
    for (int d = 0; d < 64; ++d) o[d] = 0.f;
    const float cq = Cp[s];
    const int jend = __builtin_amdgcn_readfirstlane(qblk * 512 + (tid | 63));
    for (int j = 0; j <= jend; ++j) {
        const v4u* kp = (const v4u*)(FK + ((size_t)b * SEQ + j) * 1024 + h * 64); const v4u* vp = (const v4u*)(FV + ((size_t)b * SEQ + j) * 1024 + h * 64);
        float dot = 0.f;
#pragma unroll
        for (int c = 0; c < 8; ++c) { const v4u w = kp[c];
#pragma unroll
            for (int e = 0; e < 4; ++e) { dot += q[8 * c + 2 * e] * pg8::bf_lo(w[e]); dot += q[8 * c + 2 * e + 1] * pg8::bf_hi(w[e]); } }
        float lg = dot + (cq - Cp[j]); lg = (j <= s) ? lg : -INFINITY;
        const float mn = fmaxf(m, lg), al = __builtin_amdgcn_exp2f(m - mn), p = __builtin_amdgcn_exp2f(lg - mn);
        l = l * al + p; m = mn;
#pragma unroll
        for (int c = 0; c < 8; ++c) { const v4u w = vp[c];
#pragma unroll
            for (int e = 0; e < 4; ++e) { o[8 * c + 2 * e] = o[8 * c + 2 * e] * al + p * pg8::bf_lo(w[e]); o[8 * c + 2 * e + 1] = o[8 * c + 2 * e + 1] * al + p * pg8::bf_hi(w[e]); } }
    }
    { const float rl = 1.0f / l; v4u* op = (v4u*)(OB + tok * 1024 + h * 64);
#pragma unroll
      for (int c = 0; c < 8; ++c) { v4u w;
#pragma unroll
          for (int e = 0; e < 4; ++e) w[e] = pg8::cvt_pk_bf16(o[8 * c + 2 * e] * rl, o[8 * c + 2 * e + 1] * rl);
          op[c] = w; } }
}

__global__ void __launch_bounds__(NWAVES * 64, 2) mega_fwd(Args a) {
    extern __shared__ __attribute__((aligned(16))) unsigned char lds_raw[];
    LAS unsigned char* lds = (LAS unsigned char*)lds_raw;
    cg::grid_group grid = cg::this_grid();
    int tid_ = threadIdx.x; asm volatile("" : "+v"(tid_));
    const int tid = tid_, lane = tid & 63, wave = __builtin_amdgcn_readfirstlane(tid >> 6);
    const int G = gridDim.x, bx = blockIdx.x, vcu = (G % 8 == 0) ? (bx % 8) * (G / 8) + bx / 8 : bx;
    unsigned char* ws = a.ws;
    float* SS1 = (float*)(ws + WS_CTL); float* SS2 = SS1 + M;
#define GRID_SYNC() do { asm volatile("s_waitcnt vmcnt(0) lgkmcnt(0)" ::: "memory"); grid.sync(); } while (0)

    for (int rp_ = 0; rp_ < (REP_PHASE == 100 ? 2 : 1); ++rp_) { p0_prologue(a, lds, vcu, G, wave, lane); __syncthreads(); }
    GRID_SYNC();

    {
        pg8::Gemm g{(const bf16*)(ws + WS_XN), (const bf16*)(ws + WS_WIN), nullptr, nullptr, DM};
        pg8::StaticOrder S; S.init(M, NIN, G, bx);
        pg8::EpiIn E{ws};
        for (int rp_ = 0; rp_ < (REP_PHASE == 1 ? 2 : 1); ++rp_) pg8::gemm_phase<pg8::EpiIn, pg8::StaticOrder, true, true>(lds, g, S, E);
    }
    GRID_SYNC();

    for (int u = bx; u < 64; u += G) cumsum_unit(a, u, lds);
#if NAIVE_SWA
    for (int u = bx; u < M / 32; u += G) naive_swa_unit(a, u);
#else
    for (int rp_ = 0; rp_ < (REP_PHASE == 2 ? 2 : 1); ++rp_)
    for (int u = vcu; u < 2048; u += G) { const int bh = u >> 5, qb = u & 31, b_ = bh >> 4, h_ = bh & 15;
        attn_body::attn_unit<8, false, 128>(b_, h_, qb, (const bf16*)(ws + WS_AQ), (const bf16*)(ws + WS_AK), (const bf16*)(ws + WS_AV), (bf16*)(ws + WS_OA), nullptr, a.sinks[h_] * LOG2E, (char*)lds_raw); }
#endif
    GRID_SYNC();

#if NAIVE_FOX
    for (int u = bx; u < 1024; u += G) { const int r = u >> 6, i = r >> 2, hi4 = r & 3, qblk = (i & 1) ? 4 * i + 3 - hi4 : 4 * i + hi4; naive_fox_unit(a, u & 63, qblk); }
#else
    for (int rp_ = 0; rp_ < (REP_PHASE == 3 ? 2 : 1); ++rp_)
    for (int e = vcu; e < 2048; e += G) { const int cuv = e & 255, i = e >> 8, bh = (cuv >> 3) + 32 * (i >> 2), s_ = cuv & 7, k_ = i & 3, qb = k_ == 0 ? s_ : (k_ == 1 ? 15 - s_ : (k_ == 2 ? 16 + s_ : 31 - s_));
        attn_body::attn_unit<8, true, 1024>(bh >> 4, bh & 15, qb, (const bf16*)(ws + WS_FQ), (const bf16*)(ws + WS_FK), (const bf16*)(ws + WS_FV), (bf16*)(ws + WS_OB), (const float*)(ws + WS_C) + (size_t)bh * SEQ, 0.f, (char*)lds_raw); }
#endif
    GRID_SYNC();

    {
        pg8::Gemm g{(const bf16*)(ws + WS_OA), (const bf16*)(ws + WS_WBS), (const bf16*)(ws + WS_OB), (const bf16*)(ws + WS_WBF), 1024};
        pg8::PairOrder S; S.s.init(M, DM, G, bx);
        pg8::EpiBranch E{(const bf16*)(ws + WS_G), (bf16*)(ws + WS_MG)};
        for (int rp_ = 0; rp_ < (REP_PHASE == 4 ? 2 : 1); ++rp_) pg8::gemm_phase<pg8::EpiBranch, pg8::PairOrder, true, true>(lds, g, S, E);
    }
    GRID_SYNC();

    {
        pg8::Gemm g{(const bf16*)(ws + WS_MG), (const bf16*)(ws + WS_WOUT), nullptr, nullptr, DM};
        pg8::StaticOrder S; S.init(M, DM, G, bx);
        pg8::EpiRes<true> E{a.x, a.out, (bf16*)(ws + WS_X1B), SS1};
        pg8::gemm_phase<pg8::EpiRes<true>, pg8::StaticOrder, true, true>(lds, g, S, E);
    }
    GRID_SYNC();

    {
        pg8::Gemm g{(const bf16*)(ws + WS_X1B), (const bf16*)(ws + WS_WUP), nullptr, nullptr, DM};
        pg8::StaticOrder S; S.init(M, DFF, G, bx);
        pg8::EpiUp E{SS1, (bf16*)(ws + WS_U)};
        for (int rp_ = 0; rp_ < (REP_PHASE == 6 ? 2 : 1); ++rp_) pg8::gemm_phase<pg8::EpiUp, pg8::StaticOrder, true, true>(lds, g, S, E);
    }
    GRID_SYNC();

    {
        pg8::Gemm g{(const bf16*)(ws + WS_U), (const bf16*)(ws + WS_WDN), nullptr, nullptr, DFF};
        pg8::StaticOrder S; S.init(M, DM, G, bx);
        pg8::EpiRes<false> E{a.out, a.out, nullptr, SS2};
        pg8::gemm_phase<pg8::EpiRes<false>, pg8::StaticOrder, true, true>(lds, g, S, E);
    }
    GRID_SYNC();

    {
        const int gw = vcu * NWAVES + wave, NGW = G * NWAVES;
        for (int m = gw; m < M; m += NGW) {
            const float rstd = __builtin_amdgcn_rsqf(SS2[m] * (1.f / DM) + RMS_EPS);
            f32x4* xr = (f32x4*)(a.out + (size_t)m * DM) + lane; const f32x4* gr = (const f32x4*)a.final_norm + lane;
#pragma unroll
            for (int j = 0; j < 8; ++j) { const f32x4 v = xr[64 * j], g = gr[64 * j]; xr[64 * j] = v * rstd * g; }
        }
    }
}

extern "C" void kernel_launch(void* const* d_in, const int* in_sizes, int n_in, void* d_out, int out_size, void* d_ws, size_t ws_size, hipStream_t stream) {
    static int grid = 0;
    if (grid == 0) {
        if (n_in != 13 || in_sizes[0] != M * DM || out_size != M * DM || ws_size < WS_END) { fprintf(stderr, "kernel_launch: unexpected shapes (n_in %d, in0 %d, out %d, ws %zu)\n", n_in, n_in > 0 ? in_sizes[0] : -1, out_size, ws_size); grid = -1; return; }
        int dev = 0, cus = 0, per_cu = 0;
        if (hipGetDevice(&dev) != hipSuccess || hipDeviceGetAttribute(&cus, hipDeviceAttributeMultiprocessorCount, dev) != hipSuccess) { grid = -1; return; }
        if (hipFuncSetAttribute((const void*)mega_fwd, hipFuncAttributeMaxDynamicSharedMemorySize, LDS_BYTES) != hipSuccess) { fprintf(stderr, "kernel_launch: hipFuncSetAttribute failed\n"); grid = -1; return; }
        if (hipOccupancyMaxActiveBlocksPerMultiprocessor(&per_cu, (const void*)mega_fwd, NWAVES * 64, LDS_BYTES) != hipSuccess || per_cu < 1) { fprintf(stderr, "kernel_launch: occupancy query says %d\n", per_cu); per_cu = 1; }
        (void)hipGetLastError();
        grid = cus * 1;
    }
    if (grid < 0) return;
    (void)hipMemsetAsync((char*)d_ws + WS_CTL, 0, CTL_ZERO_BYTES, stream);
    Args a{};
    a.x = (const float*)d_in[0]; a.pos = (const int*)d_in[1]; a.attn_norm = (const float*)d_in[2]; a.w_in = (const float*)d_in[3]; a.fbias = (const float*)d_in[4]; a.sinks = (const float*)d_in[5];
    a.w_bs = (const float*)d_in[6]; a.w_bf = (const float*)d_in[7]; a.w_out = (const float*)d_in[8]; a.mlp_norm = (const float*)d_in[9]; a.w_up = (const float*)d_in[10]; a.w_dn = (const float*)d_in[11];
    a.final_norm = (const float*)d_in[12]; a.out = (float*)d_out; a.ws = (unsigned char*)d_ws;
    void* kargs[] = {&a};
    const hipError_t le = hipLaunchCooperativeKernel((const void*)mega_fwd, dim3(grid), dim3(NWAVES * 64), kargs, LDS_BYTES, stream);
    if (le != hipSuccess) fprintf(stderr, "kernel_launch: cooperative launch failed: %s (grid %d)\n", hipGetErrorString(le), grid);
}
```

```cpp
#include <hip/hip_runtime.h>
#include <hip/hip_cooperative_groups.h>
#include <cstdio>
#include <cstdint>
namespace cg = cooperative_groups;

constexpr int BATCH = 4, SEQ = 8192, DM = 2048, M = BATCH * SEQ, DFF = 8192, NIN = 8704  , DIN = 8464;
constexpr float RMS_EPS = 1e-6f;
constexpr float LOG2E = 1.4426950408889634f;
constexpr float C2 = 0.125f * 1.4426950408889634f;

constexpr size_t MiB = 1u << 20;
constexpr size_t WS_CTL = 0, CTL_ZERO_BYTES = 1 * MiB;
constexpr size_t WS_WIN = 1 * MiB, WS_WBS = 35 * MiB, WS_WBF = 39 * MiB, WS_WOUT = 43 * MiB, WS_WUP = 51 * MiB, WS_WDN = 83 * MiB;
constexpr size_t WS_CS = 115 * MiB;
constexpr size_t WS_FL = 123 * MiB, WS_C = 125 * MiB;
constexpr size_t WS_FK = 128 * MiB, WS_FV = 192 * MiB, WS_X1B = 128 * MiB;
constexpr size_t WS_XN = 256 * MiB, WS_MG = 256 * MiB;
constexpr size_t WS_AQ = 384 * MiB, WS_FQ = 448 * MiB, WS_G = 512 * MiB;
constexpr size_t WS_U = 256 * MiB;
constexpr size_t WS_AK = 768 * MiB, WS_AV = 776 * MiB, WS_OA = 784 * MiB, WS_OB = 848 * MiB, WS_END = 912 * MiB;
constexpr size_t WS_X2B = 784 * MiB;

namespace pg8 {
#define PG8_LAS __attribute__((address_space(3)))
typedef unsigned short bf16_t;
typedef short bf16x8 __attribute__((ext_vector_type(8)));
typedef float f32x4 __attribute__((ext_vector_type(4)));
typedef unsigned u32x4 __attribute__((ext_vector_type(4)));
typedef unsigned u32x2 __attribute__((ext_vector_type(2)));
constexpr int BM = 256, BK = 64, HALF = 128, HTB = HALF * BK * 2  , STAGE_BYTES = 8 * HTB, NXCD = 8, WGM = 8;

__host__ __device__ __forceinline__ int lds_byte(int r, int c) { const int st = (r >> 4) * 2 + (c >> 5), rr = r & 15, cc = c & 31, ob = rr * 64 + cc * 2; return st * 1024 + (ob ^ (((ob >> 9) & 1) << 5)); }
__host__ __device__ __forceinline__ void stage_rc(int b, int& R, int& C) { const int st = b / 1024, sb = b % 1024, swz = sb ^ (((sb >> 9) & 1) << 5); R = (st >> 1) * 16 + swz / 64; C = (st & 1) * 32 + (swz % 64) / 2; }
__host__ __device__ __forceinline__ int perm32(int rho) { const int n = rho >> 4, i = rho & 15; return 8 * (i >> 2) + 4 * n + (i & 3); }

struct Unit { int pm, pn, z, f; };
struct Gemm { const bf16_t* A0; const bf16_t* B0; const bf16_t* A1; const bf16_t* B1; int K; };

struct StaticOrder {
    int nM, nN, nwg, G, c;
    __host__ __device__ void init(int M_, int N_, int G_, int c_) { nM = M_ / BM; nN = N_ / BM; nwg = nM * nN; G = G_; c = c_; }
    __host__ __device__ bool next(int i, Unit& u) const {
        const long L = (long)i * G + c; if (L >= nwg) return false;
        int wgid = (int)L; { const int q = nwg / NXCD, r = nwg % NXCD, xcd = wgid % NXCD, off = wgid / NXCD; wgid = (xcd < r ? xcd * (q + 1) : r * (q + 1) + (xcd - r) * q) + off; }
        const int nig = WGM * nN, gid = wgid / nig, fm = gid * WGM, gsz = (nM - fm) < WGM ? (nM - fm) : WGM;
        u.pm = fm + ((wgid % nig) % gsz); u.pn = (wgid % nig) / gsz; u.z = 0; u.f = i & 1; return true;
    }
};
struct PairOrder {
    StaticOrder s;
    __host__ __device__ bool next(int i, Unit& u) const { const bool ok = s.next(i >> 1, u); u.z = i & 1; return ok; }
};

__device__ __forceinline__ unsigned cvt_pk_bf16(float lo, float hi) { unsigned r; asm("v_cvt_pk_bf16_f32 %0, %1, %2" : "=v"(r) : "v"(lo), "v"(hi)); return r; }
__device__ __forceinline__ float bf_lo(unsigned w) { return __uint_as_float(w << 16); }
__device__ __forceinline__ float bf_hi(unsigned w) { return __uint_as_float(w & 0xffff0000u); }
__device__ __forceinline__ float sigmoidf_(float x) { return __builtin_amdgcn_rcpf(1.0f + __builtin_amdgcn_exp2f(-x * LOG2E)); }


struct EpiIn {
    static constexpr bool PERM = true;
    unsigned char* ws;
    __device__ __forceinline__ bool keep(const Unit&) const { return false; }
    __device__ __forceinline__ void operator()(f32x4 (&acc)[2][2][4][2], const Unit& u, int wr, int wc, int fr, int fq) const {
        const int pn = u.pn; const int row0 = u.pm * BM + wr * 64 + fr;
        if (pn <= 16) {
            size_t doff; int pitch, colbase; bool rope = false; float sc = 1.f;
            if (pn < 4) { doff = WS_AQ; pitch = 1024; colbase = (4 * pn + wc) * 64; rope = true; sc = C2; }
            else if (pn == 4) { if (wc < 2) { doff = WS_AK; pitch = 128; colbase = wc * 64; rope = true; } else { doff = WS_AV; pitch = 128; colbase = (wc - 2) * 64; } }
            else { const int t = pn - 5, seg = t >> 2, tin = t & 3; doff = WS_FQ; if (seg == 1) doff = WS_FK; if (seg == 2) doff = WS_FV; pitch = 1024; colbase = (4 * tin + wc) * 64; sc = seg == 0 ? C2 : 1.f; }
            bf16_t* dst = (bf16_t*)(ws + doff); const float* cs = (const float*)(ws + WS_CS);
#pragma unroll
            for (int ai = 0; ai < 2; ++ai) {
                f32x4 cc[4][4];
                if (rope) {
#pragma unroll
                    for (int m = 0; m < 4; ++m) { const float* cp = cs + (size_t)(row0 + ai * HALF + m * 16) * 32 + 8 * fq; const float* sp = cp + (size_t)M * 32;
                        cc[m][0] = *(const f32x4*)cp; cc[m][1] = *(const f32x4*)(cp + 4); cc[m][2] = *(const f32x4*)sp; cc[m][3] = *(const f32x4*)(sp + 4); }
                    asm volatile("" ::: "memory");
                }
#pragma unroll
                for (int m = 0; m < 4; ++m) {
                    const int row = row0 + ai * HALF + m * 16;
                    f32x4 v00 = acc[ai][0][m][0], v01 = acc[ai][0][m][1], v10 = acc[ai][1][m][0], v11 = acc[ai][1][m][1];
                    if (rope) {
                        const f32x4 c0 = cc[m][0], c1 = cc[m][1], s0 = cc[m][2], s1 = cc[m][3];
                        const f32x4 o00 = v00 * c0 - v10 * s0, o10 = v10 * c0 + v00 * s0, o01 = v01 * c1 - v11 * s1, o11 = v11 * c1 + v01 * s1;
                        v00 = o00; v10 = o10; v01 = o01; v11 = o11;
                    }
                    v00 = v00 * sc; v01 = v01 * sc; v10 = v10 * sc; v11 = v11 * sc;
                    bf16_t* rp = dst + (size_t)row * pitch + colbase + 8 * fq;
                    u32x4 w0, w1;
                    w0.x = cvt_pk_bf16(v00[0], v00[1]); w0.y = cvt_pk_bf16(v00[2], v00[3]); w0.z = cvt_pk_bf16(v01[0], v01[1]); w0.w = cvt_pk_bf16(v01[2], v01[3]);
                    w1.x = cvt_pk_bf16(v10[0], v10[1]); w1.y = cvt_pk_bf16(v10[2], v10[3]); w1.z = cvt_pk_bf16(v11[0], v11[1]); w1.w = cvt_pk_bf16(v11[2], v11[3]);
                    *(u32x4*)rp = w0; *(u32x4*)(rp + 32) = w1;
                }
                asm volatile("" ::: "memory");
            }
        } else if (pn <= 32) {
            const int col0 = (pn - 17) * BM + wc * 32 + 8 * fq;
#pragma unroll
            for (int ai = 0; ai < 2; ++ai)
#pragma unroll
                for (int m = 0; m < 4; ++m) {
                    bf16_t* rp = (bf16_t*)(ws + WS_G) + (size_t)(row0 + ai * HALF + m * 16) * 4096 + col0;
#pragma unroll
                    for (int bj = 0; bj < 2; ++bj) {
                        const f32x4 a = acc[ai][bj][m][0], b = acc[ai][bj][m][1]; u32x4 w;
                        float s[8];
#pragma unroll
                        for (int i = 0; i < 4; ++i) { s[i] = fmaxf(sigmoidf_(a[i]), 1e-6f); s[4 + i] = fmaxf(sigmoidf_(b[i]), 1e-6f); }
                        w.x = cvt_pk_bf16(s[0], s[1]); w.y = cvt_pk_bf16(s[2], s[3]); w.z = cvt_pk_bf16(s[4], s[5]); w.w = cvt_pk_bf16(s[6], s[7]);
                        *(u32x4*)(rp + bj * HALF) = w;
                    }
                }
        } else {
            if (wc == 0 && fq < 2) {
#pragma unroll
                for (int ai = 0; ai < 2; ++ai)
#pragma unroll
                    for (int m = 0; m < 4; ++m) {
                        float* rp = (float*)(ws + WS_FL) + (size_t)(row0 + ai * HALF + m * 16) * 16 + 8 * fq;
                        *(f32x4*)rp = acc[ai][0][m][0]; *(f32x4*)(rp + 4) = acc[ai][0][m][1];
                    }
            }
        }
    }
};

struct EpiBranch {
    static constexpr bool PERM = true;
    const bf16_t* G; bf16_t* MG;
    __device__ __forceinline__ bool keep(const Unit& u) const { return u.z == 0; }
    __device__ __forceinline__ void operator()(f32x4 (&acc)[2][2][4][2], const Unit& u, int wr, int wc, int fr, int fq) const {
        const int row0 = u.pm * BM + wr * 64 + fr, col0 = u.pn * BM + wc * 32 + 8 * fq; const int z = u.z;
#pragma unroll
        for (int ai = 0; ai < 2; ++ai) {
            u32x4 gbv[4][2], gav[4][2];
#pragma unroll
            for (int m = 0; m < 4; ++m)
#pragma unroll
                for (int bj = 0; bj < 2; ++bj) { const bf16_t* gp = G + (size_t)(row0 + ai * HALF + m * 16) * 4096 + col0 + bj * HALF;
                    gbv[m][bj] = *(const u32x4*)(gp + 2048); if (z == 0) gav[m][bj] = *(const u32x4*)gp; }
            asm volatile("" ::: "memory");
#pragma unroll
            for (int m = 0; m < 4; ++m) {
                const size_t row = (size_t)(row0 + ai * HALF + m * 16);
#pragma unroll
                for (int bj = 0; bj < 2; ++bj) {
                    const u32x4 gb = gbv[m][bj];
                    float sb[8];
#pragma unroll
                    for (int i = 0; i < 4; ++i) { sb[2 * i] = bf_lo(gb[i]); sb[2 * i + 1] = bf_hi(gb[i]); }
                    if (z == 0) {
                        const u32x4 ga = gav[m][bj];
#pragma unroll
                        for (int i = 0; i < 4; ++i) {
                            const float r0 = bf_lo(ga[i]) * __builtin_amdgcn_rcpf(sb[2 * i]), r1 = bf_hi(ga[i]) * __builtin_amdgcn_rcpf(sb[2 * i + 1]);
                            const int e0 = 2 * i, e1 = 2 * i + 1;
                            acc[ai][bj][m][e0 >> 2][e0 & 3] *= r0; acc[ai][bj][m][e1 >> 2][e1 & 3] *= r1;
                        }
                    } else {
                        const f32x4 a = acc[ai][bj][m][0], b = acc[ai][bj][m][1]; u32x4 w;
                        w.x = cvt_pk_bf16(a[0] * sb[0], a[1] * sb[1]); w.y = cvt_pk_bf16(a[2] * sb[2], a[3] * sb[3]);
                        w.z = cvt_pk_bf16(b[0] * sb[4], b[1] * sb[5]); w.w = cvt_pk_bf16(b[2] * sb[6], b[3] * sb[7]);
                        *(u32x4*)(MG + row * 2048 + col0 + bj * HALF) = w;
                    }
                }
            }
            asm volatile("" ::: "memory");
        }
    }
};

template <bool WRITE_BF> struct EpiRes {
    static constexpr bool PERM = false;
    const float* base; float* out; bf16_t* xb; float* ss;
    __device__ __forceinline__ bool keep(const Unit&) const { return false; }
    __device__ __forceinline__ void operator()(f32x4 (&acc)[2][2][4][2], const Unit& u, int wr, int wc, int fr, int fq) const {
        const int row0 = u.pm * BM + wr * 64 + fr, col0 = u.pn * BM + wc * 32 + 4 * fq;
#pragma unroll
        for (int ai = 0; ai < 2; ++ai) {
            f32x4 pre[4][2][2];
#pragma unroll
            for (int m = 0; m < 4; ++m)
#pragma unroll
                for (int bj = 0; bj < 2; ++bj)
#pragma unroll
                    for (int n = 0; n < 2; ++n) pre[m][bj][n] = *(const f32x4*)(base + (size_t)(row0 + ai * HALF + m * 16) * DM + col0 + bj * HALF + n * 16);
            asm volatile("" ::: "memory");
#pragma unroll
            for (int m = 0; m < 4; ++m) {
                const size_t row = (size_t)(row0 + ai * HALF + m * 16); const size_t off = row * DM + col0; float q = 0.f;
#pragma unroll
                for (int bj = 0; bj < 2; ++bj)
#pragma unroll
                    for (int n = 0; n < 2; ++n) {
                        const size_t o = off + bj * HALF + n * 16;
                        const f32x4 v = pre[m][bj][n] + acc[ai][bj][m][n];
                        *(f32x4*)(out + o) = v; q += (v[0] * v[0] + v[1] * v[1]) + (v[2] * v[2] + v[3] * v[3]);
                        if (WRITE_BF) { u32x2 w; w.x = cvt_pk_bf16(v[0], v[1]); w.y = cvt_pk_bf16(v[2], v[3]); *(u32x2*)(xb + o) = w; }
                    }
                q += __shfl_xor(q, 16); q += __shfl_xor(q, 32);
                if (fq == 0) atomicAdd(ss + row, q);
            }
            asm volatile("" ::: "memory");
        }
    }
};

struct EpiFinal {
    static constexpr bool PERM = false;
    float* out; float* ss; unsigned* cnt; const float* gain;
    __device__ __forceinline__ bool keep(const Unit&) const { return false; }
    __device__ __forceinline__ void operator()(f32x4 (&acc)[2][2][4][2], const Unit& u, int wr, int wc, int fr, int fq) const {
        const int row0 = u.pm * BM + wr * 64 + fr, col0 = u.pn * BM + wc * 32 + 4 * fq; const bool second = u.f != 0;
#pragma unroll
        for (int ai = 0; ai < 2; ++ai) {
            f32x4 pre[4][2][2];
#pragma unroll
            for (int m = 0; m < 4; ++m)
#pragma unroll
                for (int bj = 0; bj < 2; ++bj)
#pragma unroll
                    for (int n = 0; n < 2; ++n) pre[m][bj][n] = *(const f32x4*)(out + (size_t)(row0 + ai * HALF + m * 16) * DM + col0 + bj * HALF + n * 16);
            asm volatile("" ::: "memory");
#pragma unroll
            for (int m = 0; m < 4; ++m) {
                const size_t row = (size_t)(row0 + ai * HALF + m * 16); const size_t off = row * DM + col0; float q = 0.f;
#pragma unroll
                for (int bj = 0; bj < 2; ++bj)
#pragma unroll
                    for (int n = 0; n < 2; ++n) {
                        const f32x4 v = pre[m][bj][n] + acc[ai][bj][m][n]; acc[ai][bj][m][n] = v;
                        q += (v[0] * v[0] + v[1] * v[1]) + (v[2] * v[2] + v[3] * v[3]);
                        if (!second) *(f32x4*)(out + off + bj * HALF + n * 16) = v;
                    }
                q += __shfl_xor(q, 16); q += __shfl_xor(q, 32);
                if (fq == 0) atomicAdd(ss + row, q);
            }
            asm volatile("" ::: "memory");
        }
        asm volatile("s_waitcnt vmcnt(0)" ::: "memory");
        unsigned* pc = cnt + 16 * u.pm;
        if ((threadIdx.x & 63) == 0) __hip_atomic_fetch_add(pc, 1u, __ATOMIC_RELAXED, __HIP_MEMORY_SCOPE_AGENT);
        if (!second) return;
        { const unsigned long long t0 = __builtin_amdgcn_s_memrealtime();
          while ((unsigned)__builtin_amdgcn_readfirstlane(__hip_atomic_load(pc, __ATOMIC_RELAXED, __HIP_MEMORY_SCOPE_AGENT)) < 64u) {
              if (__builtin_amdgcn_s_memrealtime() - t0 > 2000000ull) break;
              __builtin_amdgcn_s_sleep(4); }
          asm volatile("" ::: "memory"); }
#pragma unroll
        for (int ai = 0; ai < 2; ++ai)
#pragma unroll
            for (int m = 0; m < 4; ++m) {
                const size_t row = (size_t)(row0 + ai * HALF + m * 16); const size_t off = row * DM + col0;
                const float rstd = __builtin_amdgcn_rsqf(__hip_atomic_load(ss + row, __ATOMIC_RELAXED, __HIP_MEMORY_SCOPE_AGENT) * (1.0f / DM) + RMS_EPS);
#pragma unroll
                for (int bj = 0; bj < 2; ++bj)
#pragma unroll
                    for (int n = 0; n < 2; ++n) {
                        const size_t o = off + bj * HALF + n * 16; const int c = col0 + bj * HALF + n * 16;
                        const f32x4 gB = *(const f32x4*)(gain + c), gA = *(const f32x4*)(gain + c - 1024), vA = *(const f32x4*)(out + o - 1024);
                        *(f32x4*)(out + o) = acc[ai][bj][m][n] * rstd * gB;
                        *(f32x4*)(out + o - 1024) = vA * rstd * gA;
                    }
            }
    }
};

template <bool BASE_BF> struct EpiResB {
    static constexpr bool PERM = true;
    const void* base; bf16_t* yb; float* ss;
    __device__ __forceinline__ bool keep(const Unit&) const { return false; }
    __device__ __forceinline__ void operator()(f32x4 (&acc)[2][2][4][2], const Unit& u, int wr, int wc, int fr, int fq) const {
        const int row0 = u.pm * BM + wr * 64 + fr, col0 = u.pn * BM + wc * 32 + 8 * fq;
#pragma unroll
        for (int ai = 0; ai < 2; ++ai) {
            f32x4 pf[4][2][2]; u32x4 pb[4][2];
#pragma unroll
            for (int m = 0; m < 4; ++m)
#pragma unroll
                for (int bj = 0; bj < 2; ++bj) { const size_t o = (size_t)(row0 + ai * HALF + m * 16) * DM + col0 + bj * HALF;
                    if (BASE_BF) pb[m][bj] = *(const u32x4*)((const bf16_t*)base + o);
                    else { pf[m][bj][0] = *(const f32x4*)((const float*)base + o); pf[m][bj][1] = *(const f32x4*)((const float*)base + o + 4); } }
            asm volatile("" ::: "memory");
#pragma unroll
            for (int m = 0; m < 4; ++m) {
                const size_t row = (size_t)(row0 + ai * HALF + m * 16); float q = 0.f;
#pragma unroll
                for (int bj = 0; bj < 2; ++bj) {
                    f32x4 x0, x1;
                    if (BASE_BF) { const u32x4 w = pb[m][bj]; x0 = (f32x4){bf_lo(w.x), bf_hi(w.x), bf_lo(w.y), bf_hi(w.y)}; x1 = (f32x4){bf_lo(w.z), bf_hi(w.z), bf_lo(w.w), bf_hi(w.w)}; }
                    else { x0 = pf[m][bj][0]; x1 = pf[m][bj][1]; }
                    const f32x4 v0 = x0 + acc[ai][bj][m][0], v1 = x1 + acc[ai][bj][m][1];
                    q += ((v0[0] * v0[0] + v0[1] * v0[1]) + (v0[2] * v0[2] + v0[3] * v0[3])) + ((v1[0] * v1[0] + v1[1] * v1[1]) + (v1[2] * v1[2] + v1[3] * v1[3]));
                    u32x4 w; w.x = cvt_pk_bf16(v0[0], v0[1]); w.y = cvt_pk_bf16(v0[2], v0[3]); w.z = cvt_pk_bf16(v1[0], v1[1]); w.w = cvt_pk_bf16(v1[2], v1[3]);
                    *(u32x4*)(yb + row * DM + col0 + bj * HALF) = w;
                }
                q += __shfl_xor(q, 16); q += __shfl_xor(q, 32);
                if (fq == 0) atomicAdd(ss + row, q);
            }
            asm volatile("" ::: "memory");
        }
    }
};

struct EpiUp {
    static constexpr bool PERM = true;
    const float* ss; bf16_t* U;
    __device__ __forceinline__ bool keep(const Unit&) const { return false; }
    __device__ __forceinline__ void operator()(f32x4 (&acc)[2][2][4][2], const Unit& u, int wr, int wc, int fr, int fq) const {
        const int row0 = u.pm * BM + wr * 64 + fr, col0 = u.pn * BM + wc * 32 + 8 * fq;
        float rs[2][4];
#pragma unroll
        for (int ai = 0; ai < 2; ++ai)
#pragma unroll
            for (int m = 0; m < 4; ++m) rs[ai][m] = ss[row0 + ai * HALF + m * 16];
        asm volatile("" ::: "memory");
#pragma unroll
        for (int ai = 0; ai < 2; ++ai)
#pragma unroll
            for (int m = 0; m < 4; ++m) {
                const size_t row = (size_t)(row0 + ai * HALF + m * 16);
                const float rstd = __builtin_amdgcn_rsqf(rs[ai][m] * (1.0f / DM) + RMS_EPS);
#pragma unroll
                for (int bj = 0; bj < 2; ++bj) {
                    f32x4 a = acc[ai][bj][m][0] * rstd, b = acc[ai][bj][m][1] * rstd; u32x4 w;
#pragma unroll
                    for (int i = 0; i < 4; ++i) { a[i] = fmaxf(a[i], 0.f); a[i] *= a[i]; b[i] = fmaxf(b[i], 0.f); b[i] *= b[i]; }
                    w.x = cvt_pk_bf16(a[0], a[1]); w.y = cvt_pk_bf16(a[2], a[3]); w.z = cvt_pk_bf16(b[0], b[1]); w.w = cvt_pk_bf16(b[2], b[3]);
                    *(u32x4*)(U + row * DFF + col0 + bj * HALF) = w;
                }
            }
    }
};

template <class Epi, class Sched, bool ALIGN_EPI = false, bool SP2 = false>
__device__ __forceinline__ void gemm_phase(PG8_LAS unsigned char* lds, const Gemm g, const Sched& S, const Epi& E) {
    int tid_ = threadIdx.x; asm volatile("" : "+v"(tid_));
    const int tid = tid_, wid = __builtin_amdgcn_readfirstlane(tid >> 6), lane = tid & 63, wr = wid >> 2, wc = wid & 3, fr = lane & 15, fq = lane >> 4;
    const int K = g.K, nt = K / BK;
    unsigned voffA[2], voffB[2];
#pragma unroll
    for (int i = 0; i < 2; ++i) { int R, C; stage_rc(tid * 16 + i * 8192, R, C); const int Rb = Epi::PERM ? ((R & ~31) + perm32(R & 31)) : R;
        voffA[i] = (unsigned)(R * K + C) * 2u; voffB[i] = (unsigned)(Rb * K + C) * 2u; }
    const size_t kstep = (size_t)(BK * 2);
    const size_t hstep = (size_t)HALF * K * 2;
    const size_t tstep = 2 * hstep;
    const unsigned ldsw = (unsigned)wid * 1024u;
    const int aoff = lds_byte(wr * 64 + fr, fq * 8), boff = lds_byte(wc * 32 + fr, fq * 8);
#define PG8_SA(b, h) (((b) * 2 + (h)) * HTB)
#define PG8_SB(b, h) ((4 + (b) * 2 + (h)) * HTB)
#define PG8_STAGE(bufoff, gbase, voff) do { _Pragma("unroll") for (int _i = 0; _i < 2; ++_i) \
        __builtin_amdgcn_global_load_lds((const unsigned*)((const char*)(gbase) + (voff)[_i]), (PG8_LAS unsigned*)(lds + (bufoff) + ldsw + _i * 8192), 16, 0, 0); } while (0)
#define PG8_LDA(dst, b, h) do { _Pragma("unroll") for (int m = 0; m < 4; ++m) _Pragma("unroll") for (int k = 0; k < 2; ++k) dst[m][k] = *(const PG8_LAS bf16x8*)(lds + PG8_SA(b, h) + aoff + m * 2048 + k * 1024); } while (0)
#define PG8_LDB(dst, b, h) do { _Pragma("unroll") for (int n = 0; n < 2; ++n) _Pragma("unroll") for (int k = 0; k < 2; ++k) dst[n][k] = *(const PG8_LAS bf16x8*)(lds + PG8_SB(b, h) + boff + n * 2048 + k * 1024); } while (0)
#define PG8_MMA(ai, bj, At, Bt) do { __builtin_amdgcn_s_setprio(1); _Pragma("unroll") for (int m = 0; m < 4; ++m) _Pragma("unroll") for (int n = 0; n < 2; ++n) _Pragma("unroll") for (int k = 0; k < 2; ++k) \
        acc[ai][bj][m][n] = __builtin_amdgcn_mfma_f32_16x16x32_bf16(Bt[n][k], At[m][k], acc[ai][bj][m][n], 0, 0, 0); __builtin_amdgcn_s_setprio(0); } while (0)
#define PG8_WAIT_V(n) asm volatile("s_waitcnt vmcnt(" #n ")" ::: "memory")
#define PG8_WAIT_L(n) asm volatile("s_waitcnt lgkmcnt(" #n ")" ::: "memory")
#define PG8_BAR __builtin_amdgcn_s_barrier()
#define PG8_SCHED __builtin_amdgcn_sched_barrier(0)
    Unit cur, nxt; int ui = 0;
    if (!S.next(0, cur)) return;
    f32x4 acc[2][2][4][2];
#pragma unroll
    for (int a = 0; a < 2; ++a)
#pragma unroll
        for (int b = 0; b < 2; ++b)
#pragma unroll
            for (int m = 0; m < 4; ++m)
#pragma unroll
                for (int n = 0; n < 2; ++n) acc[a][b][m][n] = (f32x4){0.f, 0.f, 0.f, 0.f};
    bf16x8 At[4][2], B0[2][2], B1[2][2];
    const char* cA = (const char*)(cur.z ? g.A1 : g.A0) + (size_t)cur.pm * tstep; const char* cB = (const char*)(cur.z ? g.B1 : g.B0) + (size_t)cur.pn * tstep;
    if constexpr (SP2) {
        PG8_STAGE(PG8_SB(0, 0), cB, voffB); PG8_STAGE(PG8_SB(0, 1), cB + hstep, voffB); PG8_STAGE(PG8_SA(0, 0), cA, voffA); PG8_STAGE(PG8_SA(0, 1), cA + hstep, voffA);
        if (wr == 1) PG8_BAR;
        PG8_WAIT_V(2); PG8_BAR;
        PG8_STAGE(PG8_SB(1, 0), cB + kstep, voffB); PG8_STAGE(PG8_SA(1, 0), cA + kstep, voffA); PG8_STAGE(PG8_SB(1, 1), cB + hstep + kstep, voffB);
        PG8_WAIT_V(6); PG8_BAR;
    } else {
        PG8_STAGE(PG8_SB(0, 0), cB, voffB); PG8_STAGE(PG8_SA(0, 0), cA, voffA); PG8_STAGE(PG8_SB(0, 1), cB + hstep, voffB); PG8_STAGE(PG8_SA(0, 1), cA + hstep, voffA);
        if (wr == 1) PG8_BAR;
        PG8_WAIT_V(4); PG8_BAR;
        PG8_STAGE(PG8_SB(1, 0), cB + kstep, voffB); PG8_STAGE(PG8_SA(1, 0), cA + kstep, voffA); PG8_STAGE(PG8_SB(1, 1), cB + hstep + kstep, voffB);
        PG8_WAIT_V(6); PG8_BAR;
    }
    for (;;) {
        const bool has_next = S.next(ui + 1, nxt);
        const char* nA = has_next ? (const char*)(nxt.z ? g.A1 : g.A0) + (size_t)nxt.pm * tstep : cA; const char* nB = has_next ? (const char*)(nxt.z ? g.B1 : g.B0) + (size_t)nxt.pn * tstep : cB;
        for (int t = 0; t < nt; t += 2) {
            const bool last = (t == nt - 2);
            const char* a1 = cA + (size_t)(t + 1) * kstep;
            const char* a2 = last ? nA : cA + (size_t)(t + 2) * kstep; const char* b2 = last ? nB : cB + (size_t)(t + 2) * kstep;
            const char* a3 = a2 + kstep; const char* b3 = b2 + kstep;
            if constexpr (SP2) {
            PG8_LDB(B0, 0, 0); PG8_LDB(B1, 0, 1); PG8_SCHED; PG8_LDA(At, 0, 0); PG8_STAGE(PG8_SA(1, 1), a1 + hstep, voffA);
            PG8_WAIT_V(8); PG8_WAIT_L(0); PG8_BAR; PG8_MMA(0, 0, At, B0); PG8_MMA(0, 1, At, B1); PG8_BAR; PG8_SCHED;
            PG8_LDA(At, 0, 1); PG8_STAGE(PG8_SB(0, 0), b2, voffB); PG8_STAGE(PG8_SB(0, 1), b2 + hstep, voffB); PG8_STAGE(PG8_SA(0, 0), a2, voffA);
            PG8_WAIT_V(8); PG8_WAIT_L(0); PG8_BAR; PG8_MMA(1, 0, At, B0); PG8_MMA(1, 1, At, B1); PG8_BAR; PG8_SCHED;
            PG8_LDB(B0, 1, 0); PG8_LDB(B1, 1, 1); PG8_SCHED; PG8_LDA(At, 1, 0); PG8_STAGE(PG8_SA(0, 1), a2 + hstep, voffA);
            PG8_WAIT_V(8); PG8_WAIT_L(0); PG8_BAR; PG8_MMA(0, 0, At, B0); PG8_MMA(0, 1, At, B1); PG8_BAR; PG8_SCHED;
            PG8_LDA(At, 1, 1); PG8_STAGE(PG8_SB(1, 0), b3, voffB); PG8_STAGE(PG8_SB(1, 1), b3 + hstep, voffB); PG8_STAGE(PG8_SA(1, 0), a3, voffA);
            PG8_WAIT_V(8); PG8_WAIT_L(0); PG8_BAR; PG8_MMA(1, 0, At, B0); PG8_MMA(1, 1, At, B1); PG8_BAR; PG8_SCHED;
            } else {
            PG8_LDB(B0, 0, 0); PG8_SCHED; PG8_LDA(At, 0, 0); PG8_STAGE(PG8_SA(1, 1), a1 + hstep, voffA);
            PG8_WAIT_L(8); PG8_BAR; PG8_WAIT_L(0); PG8_MMA(0, 0, At, B0); PG8_BAR; PG8_SCHED;
            PG8_LDB(B1, 0, 1); PG8_STAGE(PG8_SB(0, 0), b2, voffB);
            PG8_BAR; PG8_WAIT_L(0); PG8_MMA(0, 1, At, B1); PG8_BAR;
            PG8_LDA(At, 0, 1); PG8_STAGE(PG8_SA(0, 0), a2, voffA);
            PG8_BAR; PG8_WAIT_L(0); PG8_MMA(1, 0, At, B0); PG8_BAR; PG8_SCHED;
            PG8_STAGE(PG8_SB(0, 1), b2 + hstep, voffB);
            PG8_WAIT_V(6); PG8_BAR; PG8_MMA(1, 1, At, B1); PG8_BAR;
            PG8_LDB(B0, 1, 0); PG8_SCHED; PG8_LDA(At, 1, 0); PG8_STAGE(PG8_SA(0, 1), a2 + hstep, voffA);
            PG8_WAIT_L(8); PG8_BAR; PG8_WAIT_L(0); PG8_MMA(0, 0, At, B0); PG8_BAR; PG8_SCHED;
            PG8_LDB(B1, 1, 1); PG8_STAGE(PG8_SB(1, 0), b3, voffB);
            PG8_BAR; PG8_WAIT_L(0); PG8_MMA(0, 1, At, B1); PG8_BAR;
            PG8_LDA(At, 1, 1); PG8_STAGE(PG8_SA(1, 0), a3, voffA);
            PG8_BAR; PG8_WAIT_L(0); PG8_MMA(1, 0, At, B0); PG8_BAR; PG8_SCHED;
            PG8_STAGE(PG8_SB(1, 1), b3 + hstep, voffB);
            PG8_WAIT_V(6); PG8_BAR; PG8_MMA(1, 1, At, B1); PG8_BAR;
            }
        }
        if constexpr (ALIGN_EPI) { if (wr == 0) PG8_BAR; }
        E(acc, cur, wr, wc, fr, fq);
        if (!has_next) break;
        if (!E.keep(cur))
#pragma unroll
        for (int a = 0; a < 2; ++a)
#pragma unroll
            for (int b = 0; b < 2; ++b)
#pragma unroll
                for (int m = 0; m < 4; ++m)
#pragma unroll
                    for (int n = 0; n < 2; ++n) acc[a][b][m][n] = (f32x4){0.f, 0.f, 0.f, 0.f};
        cur = nxt; cA = nA; cB = nB; ++ui;
        if constexpr (ALIGN_EPI) { if (wr == 1) PG8_BAR; }
    }
    PG8_WAIT_V(0);
    if constexpr (!ALIGN_EPI) { if (wr == 0) PG8_BAR; }
    PG8_BAR;
#undef PG8_SA
#undef PG8_SB
#undef PG8_STAGE
#undef PG8_LDA
#undef PG8_LDB
#undef PG8_MMA
#undef PG8_WAIT_V
#undef PG8_WAIT_L
#undef PG8_BAR
#undef PG8_SCHED
}
}


namespace attn_body {
using bf16=unsigned short;
using bf16x8=__attribute__((ext_vector_type(8)))short;
using s16x4=__attribute__((ext_vector_type(4)))short;
using f32x16=__attribute__((ext_vector_type(16)))float;
using u32x4=__attribute__((ext_vector_type(4)))unsigned;
using f32x4v=__attribute__((ext_vector_type(4)))float;
constexpr int BATCH=4,NHEAD=16,SEQ=8192,D=64,DM=NHEAD*D;
constexpr int NW=8,QBLK=32,QB=QBLK*NW,KVBLK=64,NQB=SEQ/QB;
constexpr int ATTN_PITCH=DM, ATTN_UNIT_ROWS=QB;
__device__ __forceinline__ int crow(int r,int hi){return (r&3)+8*(r>>2)+4*hi;}
#define SBAR() __builtin_amdgcn_sched_barrier(0)
template<bool SWA> __device__ __forceinline__ void cmask(f32x16&p0,f32x16&p1,int jb,int qrel,int hi){
  const float NEG=-INFINITY; int kb=64*jb+4*hi;
  #pragma unroll
  for(int r=0;r<16;++r){int kv=kb+(r&3)+8*(r>>2);
    if(SWA){ if(kv>qrel||kv<=qrel-128)p0[r]=NEG; if(kv+32>qrel||kv+32<=qrel-128)p1[r]=NEG; }
    else{ if(kv>qrel)p0[r]=NEG; if(kv+32>qrel)p1[r]=NEG; } }
}

constexpr int NSLOT=3, SLOTB=8192;
#ifndef NVB
#define NVB 4
#endif
constexpr int LDS_K=0, LDS_V=NSLOT*SLOTB, LDS_WS=2*NSLOT*SLOTB, LDS_OST=LDS_WS+NW*64*4, LDS_CB=LDS_OST+NW*4096, LDS_BYTES=LDS_CB+4*256;
constexpr float C2=0.125f*1.4426950408889634f;
__device__ __forceinline__ void glds16(const void*gsrc,unsigned lds_dst){unsigned keep;
  asm volatile("s_mov_b32 %0, m0\n\ts_mov_b32 m0, %2\n\ts_nop 0\n\tglobal_load_lds_dwordx4 %1, off\n\ts_mov_b32 m0, %0":"=&s"(keep):"v"(gsrc),"s"(lds_dst):"memory");}
__device__ __forceinline__ void glds4(const void*gsrc,unsigned lds_dst){unsigned keep;
  asm volatile("s_mov_b32 %0, m0\n\ts_mov_b32 m0, %2\n\ts_nop 0\n\tglobal_load_lds_dword %1, off\n\ts_mov_b32 m0, %0":"=&s"(keep):"v"(gsrc),"s"(lds_dst):"memory");}
__device__ __forceinline__ float max3f(float a,float b,float c){float r;asm("v_max3_f32 %0, %1, %2, %3":"=v"(r):"v"(a),"v"(b),"v"(c));return r;}
__device__ __forceinline__ float max2f(float a,float b){float r;asm("v_max_f32_e32 %0, %1, %2":"=v"(r):"v"(a),"v"(b));return r;}
__device__ __forceinline__ float fadd_s(float a,float b){float r;asm("v_add_f32_e32 %0, %1, %2":"=v"(r):"v"(a),"v"(b));return r;}
__device__ __forceinline__ float fsub_s(float a,float b){float r;asm("v_sub_f32_e32 %0, %1, %2":"=v"(r):"v"(a),"v"(b));return r;}
typedef float f32x2_t __attribute__((ext_vector_type(2))); typedef __bf16 bf16x2_t __attribute__((ext_vector_type(2)));
__device__ __forceinline__ unsigned cvtpk_s(float lo,float hi){f32x2_t v={lo,hi};bf16x2_t b=__builtin_convertvector(v,bf16x2_t);return __builtin_bit_cast(unsigned,b);}
#define WAIT_BAR(N) asm volatile("s_waitcnt vmcnt(" #N ") lgkmcnt(0)\n\ts_barrier":::"memory")

__device__ __forceinline__ void qkt(f32x16&p0,f32x16&p1,const char*Kslot,const bf16x8*qr,int r32,int hi){
  const char*kb=Kslot+hi*1024+r32*16;
  #pragma unroll
  for(int d0=0;d0<4;++d0){
    const bf16x8 b0=*reinterpret_cast<const bf16x8*>(kb+d0*2048);
    const bf16x8 b1=*reinterpret_cast<const bf16x8*>(kb+d0*2048+512);
    {p0=__builtin_amdgcn_mfma_f32_32x32x16_bf16(b0,qr[d0],p0,0,0,0);p1=__builtin_amdgcn_mfma_f32_32x32x16_bf16(b1,qr[d0],p1,0,0,0);}}
}
typedef __attribute__((address_space(3))) const char* lds_cptr;
typedef short v4i16_t __attribute__((ext_vector_type(4)));
__device__ __forceinline__ void kload8(bf16x8*kf,lds_cptr kp){
  kf[0]=*(const __attribute__((address_space(3))) bf16x8*)(kp);      kf[1]=*(const __attribute__((address_space(3))) bf16x8*)(kp+512);
  kf[2]=*(const __attribute__((address_space(3))) bf16x8*)(kp+2048); kf[3]=*(const __attribute__((address_space(3))) bf16x8*)(kp+2560);
  kf[4]=*(const __attribute__((address_space(3))) bf16x8*)(kp+4096); kf[5]=*(const __attribute__((address_space(3))) bf16x8*)(kp+4608);
  kf[6]=*(const __attribute__((address_space(3))) bf16x8*)(kp+6144); kf[7]=*(const __attribute__((address_space(3))) bf16x8*)(kp+6656);
}
__device__ __forceinline__ void kload2(bf16x8*kf,lds_cptr kp,int j){ kf[2*j]=*(const __attribute__((address_space(3))) bf16x8*)(kp+j*2048); kf[2*j+1]=*(const __attribute__((address_space(3))) bf16x8*)(kp+j*2048+512); }
__device__ __forceinline__ s16x4 vtr(lds_cptr p){ return __builtin_bit_cast(s16x4,__builtin_amdgcn_ds_read_tr16_b64_v4i16((__attribute__((address_space(3))) v4i16_t*)p)); }
__device__ __forceinline__ float rowmax(const f32x16&p0,const f32x16&p1){
  float a=max3f(p0[0],p0[1],p1[0]),b=max3f(p0[2],p0[3],p1[1]);a=max3f(a,p1[2],p1[3]);
  #pragma unroll
  for(int r=4;r<16;r+=4){a=max3f(a,p0[r],p0[r+1]);b=max3f(b,p0[r+2],p0[r+3]);a=max3f(a,p1[r],p1[r+1]);b=max3f(b,p1[r+2],p1[r+3]);}
  const float m=max2f(a,b);
  auto rr=__builtin_amdgcn_permlane32_swap(__float_as_uint(m),__float_as_uint(m),false,false);
  return max2f(__uint_as_float(rr[0]),__uint_as_float(rr[1]));
}
__device__ __forceinline__ void pv(f32x16*o,int vb,bf16x8 pa0,bf16x8 pa1,bf16x8 pa2,bf16x8 pa3){
  #pragma unroll
  for(int d0=0;d0<2;++d0){s16x4 lo[4],hi[4];
    #pragma unroll
    for(int ks=0;ks<4;++ks){
      asm volatile("ds_read_b64_tr_b16 %0,%1 offset:%c2":"=&v"(lo[ks]):"v"(vb),"i"(d0*4096+ks*1024):"memory");
      asm volatile("ds_read_b64_tr_b16 %0,%1 offset:%c2":"=&v"(hi[ks]):"v"(vb),"i"(d0*4096+ks*1024+512):"memory");}
    asm volatile("s_waitcnt lgkmcnt(0)":::"memory");SBAR();
    #define PK(k) (bf16x8){lo[k][0],lo[k][1],lo[k][2],lo[k][3],hi[k][0],hi[k][1],hi[k][2],hi[k][3]}
    o[d0]=__builtin_amdgcn_mfma_f32_32x32x16_bf16(pa0,PK(0),o[d0],0,0,0);
    o[d0]=__builtin_amdgcn_mfma_f32_32x32x16_bf16(pa1,PK(1),o[d0],0,0,0);
    o[d0]=__builtin_amdgcn_mfma_f32_32x32x16_bf16(pa2,PK(2),o[d0],0,0,0);
    o[d0]=__builtin_amdgcn_mfma_f32_32x32x16_bf16(pa3,PK(3),o[d0],0,0,0);
    #undef PK
  }
}

typedef __attribute__((address_space(3))) const f32x4v* lds_f4ptr;
__device__ __forceinline__ void fill_bias(f32x16&c0,f32x16&c1,lds_cptr cb,float negmh){
  #pragma unroll
  for(int g=0;g<4;++g){ const f32x4v v=*(lds_f4ptr)(cb+g*32), w=*(lds_f4ptr)(cb+128+g*32);
    #pragma unroll
    for(int i=0;i<4;i+=2){ const f32x2_t nm={negmh,negmh}; const f32x2_t a=nm-(f32x2_t){v[i],v[i+1]}, b=nm-(f32x2_t){w[i],w[i+1]}; c0[4*g+i]=a.x; c0[4*g+i+1]=a.y; c1[4*g+i]=b.x; c1[4*g+i+1]=b.y; } }
}
#ifndef ATTN_STORE16
#define ATTN_STORE16(p,v) (*(u32x4*)(p)=(v))
#endif
template<int THRL,bool FOX,int KP> __device__ __forceinline__ void attn_unit(int b,int h,int qb,const bf16*Q,const bf16*__restrict__ K,const bf16*__restrict__ V,bf16*O,const float*__restrict__ Cb,float sink2,char*shm){
  int tid_=threadIdx.x; asm volatile("":"+v"(tid_));
  const int tid=tid_,lane=tid&63,r32=lane&31,hi=lane>>5; const int wid=__builtin_amdgcn_readfirstlane(tid>>6);
  const long rowbase=(long)b*SEQ; const int q0=qb*QB;
  const bf16*Qw=Q+(rowbase+q0+wid*QBLK)*DM+h*D;
  const int kvh=FOX?h:(h>>3); const int T0=FOX?0:(qb==0?0:4*qb-2);
  const bf16*Kh=K+(rowbase+(long)T0*KVBLK)*KP+kvh*D,*Vh=V+(rowbase+(long)T0*KVBLK)*KP+kvh*D; const float*Cs=FOX?Cb+lane:nullptr;
  const unsigned lds0=(unsigned)(uintptr_t)shm;
  float*wsf=(float*)(shm+LDS_WS)+wid*64;
  const bf16*ksrc=Kh+(long)lane*KP+wid*8;
  const bf16*vsrc=Vh+(long)(16*(wid&3)+(lane>>2))*KP+(wid>>2)*32+(lane&3)*8;
  const unsigned kdst=lds0+LDS_K+wid*1024, vdst=lds0+LDS_V+wid*1024;
  #define DMA_K(t,slot) glds16(ksrc+(long)(t)*KVBLK*KP,(unsigned)__builtin_amdgcn_readfirstlane(kdst+(slot)))
  #define DMA_C(t) do{ if(FOX) glds4(Cs+(long)(t)*KVBLK,(unsigned)__builtin_amdgcn_readfirstlane(lds0+LDS_CB+(((t)&3)<<8))); }while(0)
  #define PREFILL(X0,X1,t) do{ if(FOX){ fill_bias(X0,X1,cb0+(((t)&3)<<8),-mhat); } else { _Pragma("unroll") for(int r=0;r<16;++r){X0[r]=-mhat;X1[r]=-mhat;} } }while(0)
  #define DMA_V(t,slot) glds16(vsrc+(long)(t)*KVBLK*KP,(unsigned)__builtin_amdgcn_readfirstlane(vdst+(slot)))
  const int vb0=(int)(lds0+LDS_V)+((lane>>4)&1)*32+(lane&3)*8+(4*hi+((lane&15)>>2))*64;
  const char*Kbase=shm+LDS_K; bf16x8 kf[8];
  const lds_cptr shm3=(lds_cptr)shm; const lds_cptr cb0=shm3+LDS_CB+hi*16; const lds_cptr kp0=shm3+LDS_K+hi*1024+r32*16; const lds_cptr vp0=shm3+LDS_V+((lane>>4)&1)*32+(lane&3)*8+(4*hi+((lane&15)>>2))*64;
  const int NT=FOX?(q0+QB)/KVBLK:(qb==0?4:6);
  DMA_K(0,0);DMA_C(0);DMA_V(0,0);DMA_K(1,SLOTB);DMA_C(1);
  bf16x8 qr[4];
  #pragma unroll
  for(int d0=0;d0<4;++d0)qr[d0]=*reinterpret_cast<const bf16x8*>(&Qw[(long)r32*DM+d0*16+hi*8]);
  float mhat=FOX?-Cb[q0+wid*QBLK+r32]:0.f,l_reg=0.f;    f32x16 o[2];o[0]=f32x16{};o[1]=f32x16{};
  const int qrel=wid*QBLK+r32;
  #define CMASK(P0,P1,t) do{int jb_=(t)-(NT-4); if(!FOX||jb_>=0)cmask<!FOX>(P0,P1,jb_,qrel,hi);}while(0)
  bool resc=false;
  #define START(P0,P1) do{ float rm=__builtin_fmaxf(rowmax(P0,P1),0.f); resc=false;     \
    { const float dl=rm; mhat=fadd_s(mhat,dl); \
      _Pragma("unroll") for(int r=0;r<16;++r){P0[r]=fsub_s(P0[r],dl);P1[r]=fsub_s(P1[r],dl);} } \
    _Pragma("unroll") for(int r=0;r<16;++r)P0[r]=__builtin_amdgcn_exp2f(P0[r]); }while(0)
  #define RESC() do{ if(resc){ asm volatile("s_waitcnt lgkmcnt(0)":::"memory"); \
      _Pragma("unroll") for(int d_=0;d_<2;++d_) _Pragma("unroll") for(int r=0;r<16;++r)o[d_][r]*=wsf[crow(r,hi)]; } }while(0)
  f32x16 pA0,pA1,pB0,pB1;
  int sl_prev=0,sl_cur=0,sl_next=SLOTB;
  #define ROT() do{sl_prev=sl_cur;sl_cur=sl_next;sl_next=(sl_next==(NSLOT-1)*SLOTB)?0:sl_next+SLOTB;}while(0)
  DMA_K(2,2*SLOTB);DMA_C(2);
  if(FOX){WAIT_BAR(5);}else{WAIT_BAR(3);}
  PREFILL(pA0,pA1,0); qkt(pA0,pA1,Kbase,qr,r32,hi);asm volatile("s_nop 15\n\ts_nop 7":"+v"(pA0),"+v"(pA1));CMASK(pA0,pA1,0);
  START(pA0,pA1);
  _Pragma("unroll") for(int r=0;r<16;++r)pA1[r]=__builtin_amdgcn_exp2f(pA1[r]);
  WAIT_BAR(0);
  DMA_K(3,0);DMA_C(3);DMA_V(1,SLOTB);
  ROT();
  kload8(kf,kp0+sl_cur);
  PREFILL(pB0,pB1,1); if(FOX){ WAIT_BAR(3); }else{ WAIT_BAR(2); }
  s16x4 vlo[NVB],vhi[NVB]; u32x4 pw0,pw1,pw2,pw3;
  #define PKW(P,B) cvtpk_s(P[B],P[B+1])
  #define PAF(k) __builtin_bit_cast(bf16x8,pw##k)
  #define VFR(j) (bf16x8){vlo[(j)%NVB][0],vlo[(j)%NVB][1],vlo[(j)%NVB][2],vlo[(j)%NVB][3],vhi[(j)%NVB][0],vhi[(j)%NVB][1],vhi[(j)%NVB][2],vhi[(j)%NVB][3]}
  #define PIN(x) asm volatile("":"+v"(x))
  #define MX3(a,b,c) __builtin_fmaxf(__builtin_fmaxf((a),(b)),(c))
  #define GAPA(MF,A0,A1,A2,A3,W0,W1,PW) do{ MF; sacc+=(f32x2_t){A0,A1}; sacc+=(f32x2_t){A2,A3}; PIN(sacc); W0; W1; PIN(PW); SBAR(); }while(0)
  #define EX(v) __builtin_amdgcn_exp2f(v)
  #define GAPB(MF,VR,BX_,X,B) do{ MF; VR; BX_; X[B]=EX(X[B]); X[B+1]=EX(X[B+1]); X[B+2]=EX(X[B+2]); X[B+3]=EX(X[B+3]); PIN(X); SBAR(); }while(0)
  #define VOFF(j) ((((j)&1)*4096)+(((j)>>1)*1024))
  #define VRD(j) do{ if((j)>=0&&(j)<8){ vlo[(j)%NVB]=vtr(vp_+VOFF(j)); vhi[(j)%NVB]=vtr(vp_+VOFF(j)+512); } }while(0)
  #define KRD(G,j) do{ if(G){ kload2(kf,kp0+sl_next,j); SBAR(); } }while(0)
  #define BSUBX(X,g) do{ const f32x2_t nm_={nmh_,nmh_}; const f32x2_t a_=nm_-(f32x2_t){bt[0],bt[1]}, b_=nm_-(f32x2_t){bt[2],bt[3]}; X[4*(g)+0]=a_.x; X[4*(g)+1]=a_.y; X[4*(g)+2]=b_.x; X[4*(g)+3]=b_.y; }while(0)
  #define BXX(Y0,Y1,j,G) do{ if(FOX&&(G)){ if((j)>=1&&(j)<=4){BSUBX(Y0,((j)-1)&3);} if((j)>=5){BSUBX(Y1,((j)-5)&3);} if((j)<8){ bt=*(lds_f4ptr)(cbn_+(((j)&3)*32+((j)>>2)*128)); } } }while(0)
  #define STEP(C0,C1,P0,P1,t,GK,GV,GL) do{ SBAR(); f32x4v bt; const lds_cptr cbn_=cb0+((((t)+1)&3)<<8); \
    const lds_cptr vp_=vp0+sl_prev; \
    VRD(0-(8-NVB)); SBAR(); f32x2_t sacc={P0[0],P0[1]}; \
    GAPA(C0=__builtin_amdgcn_mfma_f32_32x32x16_bf16(kf[0],qr[0],C0,0,0,0), P0[2],P0[3],P0[4],P0[5],     pw0[0]=PKW(P0,0), pw0[1]=PKW(P0,2), pw0); \
    VRD(1-(8-NVB)); SBAR(); GAPA(C1=__builtin_amdgcn_mfma_f32_32x32x16_bf16(kf[1],qr[0],C1,0,0,0), P0[6],P0[7],P0[8],P0[9],     pw0[2]=PKW(P0,4), pw0[3]=PKW(P0,6), pw0); \
    VRD(2-(8-NVB)); SBAR(); GAPA(C0=__builtin_amdgcn_mfma_f32_32x32x16_bf16(kf[2],qr[1],C0,0,0,0),   P0[10],P0[11],P0[12],P0[13], pw1[0]=PKW(P0,8), pw1[1]=PKW(P0,10), pw1); \
    VRD(3-(8-NVB)); SBAR(); GAPA(C1=__builtin_amdgcn_mfma_f32_32x32x16_bf16(kf[3],qr[1],C1,0,0,0),   P0[14],P0[15],P1[0],P1[1],   pw1[2]=PKW(P0,12),pw1[3]=PKW(P0,14), pw1); \
    VRD(4-(8-NVB)); SBAR(); GAPA(C0=__builtin_amdgcn_mfma_f32_32x32x16_bf16(kf[4],qr[2],C0,0,0,0),   P1[2],P1[3],P1[4],P1[5],     pw2[0]=PKW(P1,0), pw2[1]=PKW(P1,2), pw2); \
    VRD(5-(8-NVB)); SBAR(); GAPA(C1=__builtin_amdgcn_mfma_f32_32x32x16_bf16(kf[5],qr[2],C1,0,0,0),   P1[6],P1[7],P1[8],P1[9],     pw2[2]=PKW(P1,4), pw2[3]=PKW(P1,6), pw2); \
    VRD(6-(8-NVB)); SBAR(); GAPA(C0=__builtin_amdgcn_mfma_f32_32x32x16_bf16(kf[6],qr[3],C0,0,0,0),   P1[10],P1[11],P1[12],P1[13], pw3[0]=PKW(P1,8), pw3[1]=PKW(P1,10), pw3); \
    VRD(7-(8-NVB)); SBAR(); GAPA(C1=__builtin_amdgcn_mfma_f32_32x32x16_bf16(kf[7],qr[3],C1,0,0,0),   P1[14],P1[15],0.f,0.f,       pw3[2]=PKW(P1,12),pw3[3]=PKW(P1,14), pw3); \
    l_reg+=sacc.x+sacc.y; \
    if(GK){DMA_K((t)+3,sl_cur);DMA_C((t)+3);} if(GV){DMA_V((t)+1,sl_next);} \
    CMASK(C0,C1,t); \
    { float a=MX3(C0[0],C0[1],C1[0]),b=MX3(C0[2],C0[3],C1[1]); a=MX3(a,C1[2],C1[3]); \
      _Pragma("unroll") for(int r=4;r<16;r+=4){a=MX3(a,C0[r],C0[r+1]);b=MX3(b,C0[r+2],C0[r+3]);a=MX3(a,C1[r],C1[r+1]);b=MX3(b,C1[r+2],C1[r+3]);} \
      float rm=__builtin_fmaxf(a,b); { auto rr=__builtin_amdgcn_permlane32_swap(__float_as_uint(rm),__float_as_uint(rm),false,false); rm=__builtin_fmaxf(__uint_as_float(rr[0]),__uint_as_float(rr[1])); } \
      resc=false; \
      if(__builtin_expect(__any(rm>(float)THRL),0)){ const float dl=__builtin_fmaxf(rm,0.f); mhat+=dl; \
        _Pragma("unroll") for(int r=0;r<16;++r){C0[r]-=dl;C1[r]-=dl;} \
        const float f=__builtin_amdgcn_exp2f(-dl); l_reg*=f; if(hi==0)wsf[r32]=f; resc=true; } } \
    const float nmh_=-mhat; SBAR(); \
    GAPB(o[0]=__builtin_amdgcn_mfma_f32_32x32x16_bf16(PAF(0),VFR(0),o[0],0,0,0), VRD(0+NVB), BXX(P0,P1,0,GL), C0,0); \
    GAPB(o[1]=__builtin_amdgcn_mfma_f32_32x32x16_bf16(PAF(0),VFR(1),o[1],0,0,0), VRD(1+NVB), BXX(P0,P1,1,GL), C0,4); \
    KRD(GL,0); GAPB(o[0]=__builtin_amdgcn_mfma_f32_32x32x16_bf16(PAF(1),VFR(2),o[0],0,0,0), VRD(2+NVB), BXX(P0,P1,2,GL), C0,8); \
    KRD(GL,1); GAPB(o[1]=__builtin_amdgcn_mfma_f32_32x32x16_bf16(PAF(1),VFR(3),o[1],0,0,0), VRD(3+NVB), BXX(P0,P1,3,GL), C0,12); \
    KRD(GL,2); GAPB(o[0]=__builtin_amdgcn_mfma_f32_32x32x16_bf16(PAF(2),VFR(4),o[0],0,0,0), VRD(4+NVB), BXX(P0,P1,4,GL), C1,0); \
    KRD(GL,3); GAPB(o[1]=__builtin_amdgcn_mfma_f32_32x32x16_bf16(PAF(2),VFR(5),o[1],0,0,0), VRD(5+NVB), BXX(P0,P1,5,GL), C1,4); \
    GAPB(o[0]=__builtin_amdgcn_mfma_f32_32x32x16_bf16(PAF(3),VFR(6),o[0],0,0,0), VRD(6+NVB), BXX(P0,P1,6,GL), C1,8); \
    GAPB(o[1]=__builtin_amdgcn_mfma_f32_32x32x16_bf16(PAF(3),VFR(7),o[1],0,0,0), VRD(7+NVB), BXX(P0,P1,7,GL), C1,12); \
    BXX(P0,P1,8,GL); if(!FOX&&(GL)){ PREFILL(P0,P1,(t)+1); } \
    }while(0)
  int t=1;
  #undef CMASK
  #define CMASK(P0,P1,t) do{}while(0)
  for(;t+5<NT;t+=2){
    STEP(pB0,pB1,pA0,pA1,t,true,true,true);     if(FOX){WAIT_BAR(3);}else{WAIT_BAR(2);} RESC(); ROT();
    STEP(pA0,pA1,pB0,pB1,t+1,true,true,true);   if(FOX){WAIT_BAR(3);}else{WAIT_BAR(2);} RESC(); ROT();
  }
  #undef CMASK
  #define CMASK(P0,P1,t) do{int jb_=(t)-(NT-4); if(!FOX||jb_>=0)cmask<!FOX>(P0,P1,jb_,qrel,hi);}while(0)
  #define ENDW(tt) do{ if((tt)+3<NT){ if(FOX){WAIT_BAR(3);}else{WAIT_BAR(2);} } else if((tt)+2<NT){WAIT_BAR(1);} else {WAIT_BAR(0);} }while(0)
  for(;t+1<NT;t+=2){
    STEP(pB0,pB1,pA0,pA1,t,(t+3<NT),(t+1<NT),(t+1<NT));       ENDW(t);   RESC(); ROT();
    STEP(pA0,pA1,pB0,pB1,t+1,(t+4<NT),(t+2<NT),(t+2<NT));     ENDW(t+1); RESC(); ROT();
  }
  STEP(pB0,pB1,pA0,pA1,NT-1,false,false,false); RESC();
  { float sacc=pB0[0]+pB0[1]; _Pragma("unroll") for(int r=2;r<16;++r)sacc+=pB0[r]; _Pragma("unroll") for(int r=0;r<16;++r)sacc+=pB1[r]; l_reg+=sacc;
    pw0=(u32x4){PKW(pB0,0),PKW(pB0,2),PKW(pB0,4),PKW(pB0,6)};pw1=(u32x4){PKW(pB0,8),PKW(pB0,10),PKW(pB0,12),PKW(pB0,14)};pw2=(u32x4){PKW(pB1,0),PKW(pB1,2),PKW(pB1,4),PKW(pB1,6)};pw3=(u32x4){PKW(pB1,8),PKW(pB1,10),PKW(pB1,12),PKW(pB1,14)};
    SBAR(); pv(o,vb0+sl_cur,PAF(0),PAF(1),PAF(2),PAF(3)); }
  #undef PKW
  #undef PAF
  #undef VFR
  #undef PIN
  #undef MX3
  #undef GAPA
  #undef GAPB
  #undef EX
  #undef VRD
  #undef VOFF
  #undef KRD
  #undef STEP
  #undef ENDW
  {auto rr=__builtin_amdgcn_permlane32_swap(__float_as_uint(l_reg),__float_as_uint(l_reg),false,false);l_reg=__uint_as_float(rr[0])+__uint_as_float(rr[1]);}
  if(!FOX) l_reg+=__builtin_amdgcn_exp2f(sink2-mhat);
  if(hi==0)wsf[32+r32]=l_reg;asm volatile("s_waitcnt lgkmcnt(0)":::"memory");
  float rli[16];
  #pragma unroll
  for(int r=0;r<16;++r)rli[r]=__builtin_amdgcn_rcpf(wsf[32+crow(r,hi)]);
  bf16*Ow=O+(rowbase+q0+wid*QBLK)*DM+h*D;
  { bf16*stg=(bf16*)(shm+LDS_OST)+wid*2048;
    #pragma unroll
    for(int r=0;r<16;++r){const int orow=crow(r,hi);
      #pragma unroll
      for(int d0=0;d0<2;++d0)stg[orow*64+d0*32+r32]=(bf16)(cvtpk_s(o[d0][r]*rli[r],0.f)&0xffffu);}
    asm volatile("s_waitcnt lgkmcnt(0)":::"memory");
    #pragma unroll
    for(int i=0;i<4;++i){const int row=i*8+(lane>>3),ch=lane&7; const u32x4 v=*(const u32x4*)(stg+row*64+ch*8); ATTN_STORE16(Ow+(long)row*DM+ch*8,v);} }
  asm volatile("s_waitcnt lgkmcnt(0)\n\ts_barrier":::"memory");
  #undef DMA_K
  #undef DMA_V
  #undef DMA_C
  #undef PREFILL
  #undef BSUBX
  #undef BXX
  #undef CMASK
  #undef START
  #undef RESC
  #undef ROT
}
constexpr int ATTN_LDS_BYTES=LDS_BYTES;
#undef SBAR
#undef WAIT_BAR
}

#ifndef REP_PHASE
#define REP_PHASE 0
#endif
#ifndef FUSED_FINAL
#define FUSED_FINAL 0
#endif
#ifndef NAIVE_SWA
#define NAIVE_SWA 0
#endif
#ifndef NAIVE_FOX
#define NAIVE_FOX 0
#endif
#define LAS __attribute__((address_space(3)))
typedef unsigned short bf16;
typedef float f32x4 __attribute__((ext_vector_type(4)));
typedef unsigned v4u __attribute__((ext_vector_type(4)));
typedef unsigned v2u __attribute__((ext_vector_type(2)));
constexpr int NWAVES = 8;
constexpr int RING_BYTES = 131072, LDS_BYTES = 147456;

__device__ __forceinline__ float wave_sum(float v) {
#pragma unroll
    for (int o = 1; o < 64; o <<= 1) v += __shfl_xor(v, o);
    return v;
}
#define LDS_WAIT() asm volatile("s_waitcnt lgkmcnt(0)" ::: "memory")

__device__ __forceinline__ void tr_item(const float* W, int K, int N, bf16* WT, int dst_row0, int src_col0, int nvalid, int kb, const float* kscale, LAS float* scr, int lane) {
    const int k0 = 64 * kb, c = lane & 31;
    float tv[32];
    const float* wp = W + (size_t)(k0 + (lane >> 5)) * N + src_col0 + c;
#pragma unroll
    for (int i = 0; i < 32; ++i) { tv[i] = 0.f; if (c < nvalid) tv[i] = __builtin_nontemporal_load(wp + (size_t)(2 * i) * N); }
#pragma unroll
    for (int i = 0; i < 32; ++i) { const int kk = 2 * i + (lane >> 5); float v = tv[i]; if (kscale) v *= kscale[k0 + kk]; scr[kk * 33 + c] = v; }
    LDS_WAIT(); asm volatile("" ::: "memory");
    const int ch = lane & 7;
#pragma unroll
    for (int j = 0; j < 4; ++j) { const int n = (lane >> 3) + 8 * j; const LAS float* s = scr + (8 * ch) * 33 + n;
        v4u o; o.x = pg8::cvt_pk_bf16(s[0 * 33], s[1 * 33]); o.y = pg8::cvt_pk_bf16(s[2 * 33], s[3 * 33]); o.z = pg8::cvt_pk_bf16(s[4 * 33], s[5 * 33]); o.w = pg8::cvt_pk_bf16(s[6 * 33], s[7 * 33]);
        *(v4u*)(WT + (size_t)(dst_row0 + n) * K + k0 + 8 * ch) = o; }
    LDS_WAIT(); asm volatile("" ::: "memory");
}
__device__ __forceinline__ void win_map(int db, int& src, int& nv) {
    const int pn = db >> 3, bj = (db >> 2) & 1, wc = db & 3; nv = 32;
    if (pn < 4) src = (4 * pn + wc) * 64 + 32 * bj;
    else if (pn == 4) src = (wc < 2 ? 1024 + wc * 64 : 1152 + (wc - 2) * 64) + 32 * bj;
    else if (pn < 17) { const int t = pn - 5; src = 1280 + (t >> 2) * 1024 + (4 * (t & 3) + wc) * 64 + 32 * bj; }
    else if (pn < 33) src = 4368 + (db - 136) * 32;
    else { src = 4352; nv = (db == 264) ? 16 : 0; }
}

struct Args { const float* x; const int* pos; const float* attn_norm; const float* w_in; const float* fbias; const float* sinks; const float* w_bs; const float* w_bf;
              const float* w_out; const float* mlp_norm; const float* w_up; const float* w_dn; const float* final_norm; float* out; unsigned char* ws; long long fused_final; };

__device__ __forceinline__ void rms_row_to_bf16(const float* xrow, const float* gain, bf16* orow, int lane) {
    const f32x4* xr = (const f32x4*)xrow + lane; f32x4 v[8]; float s = 0.f;
#pragma unroll
    for (int j = 0; j < 8; ++j) { v[j] = xr[64 * j]; s += (v[j].x * v[j].x + v[j].y * v[j].y) + (v[j].z * v[j].z + v[j].w * v[j].w); }
    const float rstd = __builtin_amdgcn_rsqf(wave_sum(s) * (1.f / DM) + RMS_EPS);
    const f32x4* gr = (const f32x4*)gain + lane; v2u* o8 = (v2u*)orow + lane;
#pragma unroll
    for (int j = 0; j < 8; ++j) { const f32x4 g = gr[64 * j]; v2u w; w.x = pg8::cvt_pk_bf16(v[j].x * rstd * g.x, v[j].y * rstd * g.y); w.y = pg8::cvt_pk_bf16(v[j].z * rstd * g.z, v[j].w * rstd * g.w); o8[64 * j] = w; }
}

__device__ __forceinline__ void rms_row2_to_bf16(const float* x0, const float* x1, const float* gain, bf16* o0, bf16* o1, int lane) {
    const f32x4* xr0 = (const f32x4*)x0 + lane; const f32x4* xr1 = (const f32x4*)x1 + lane; f32x4 v[8], w[8]; float s = 0.f, t = 0.f;
#pragma unroll
    for (int j = 0; j < 8; ++j) { v[j] = __builtin_nontemporal_load(xr0 + 64 * j); w[j] = __builtin_nontemporal_load(xr1 + 64 * j); }
#pragma unroll
    for (int j = 0; j < 8; ++j) { s += (v[j].x * v[j].x + v[j].y * v[j].y) + (v[j].z * v[j].z + v[j].w * v[j].w); t += (w[j].x * w[j].x + w[j].y * w[j].y) + (w[j].z * w[j].z + w[j].w * w[j].w); }
    const float rs = __builtin_amdgcn_rsqf(wave_sum(s) * (1.f / DM) + RMS_EPS), rt = __builtin_amdgcn_rsqf(wave_sum(t) * (1.f / DM) + RMS_EPS);
    const f32x4* gr = (const f32x4*)gain + lane; v2u* p0 = (v2u*)o0 + lane; v2u* p1 = (v2u*)o1 + lane;
#pragma unroll
    for (int j = 0; j < 8; ++j) { const f32x4 g = gr[64 * j]; v2u a, c;
        a.x = pg8::cvt_pk_bf16(v[j].x * rs * g.x, v[j].y * rs * g.y); a.y = pg8::cvt_pk_bf16(v[j].z * rs * g.z, v[j].w * rs * g.w);
        c.x = pg8::cvt_pk_bf16(w[j].x * rt * g.x, w[j].y * rt * g.y); c.y = pg8::cvt_pk_bf16(w[j].z * rt * g.z, w[j].w * rt * g.w);
        p0[64 * j] = a; p1[64 * j] = c; }
}
__device__ __forceinline__ void p0_prologue(const Args& a, LAS unsigned char* lds, int vcu, int G, int wave, int lane) {
    unsigned char* ws = a.ws;
    LAS float* scr = (LAS float*)(lds + wave * 16384);
    const int gw = vcu * NWAVES + wave, NGW = G * NWAVES;
    constexpr int I_IN = (NIN / 32) * (DM / 64), I_BS = (DM / 32) * (1024 / 64), I_OUT = (DM / 32) * (DM / 64), I_UP = (DFF / 32) * (DM / 64), I_DN = (DM / 32) * (DFF / 64);
    constexpr int NITEMS = I_IN + 2 * I_BS + I_OUT + I_UP + I_DN;
    for (int it = gw; it < NITEMS; it += NGW) {
        int r = it;
        if (r < I_IN) { const int db = r / (DM / 64), kb = r % (DM / 64); int src, nv; win_map(db, src, nv); tr_item(a.w_in, DM, DIN, (bf16*)(ws + WS_WIN), db * 32, src, nv, kb, nullptr, scr, lane); continue; } r -= I_IN;
        if (r < I_BS) { const int db = r / 16, kb = r % 16; tr_item(a.w_bs, 1024, DM, (bf16*)(ws + WS_WBS), db * 32, db * 32, 32, kb, nullptr, scr, lane); continue; } r -= I_BS;
        if (r < I_BS) { const int db = r / 16, kb = r % 16; tr_item(a.w_bf, 1024, DM, (bf16*)(ws + WS_WBF), db * 32, db * 32, 32, kb, nullptr, scr, lane); continue; } r -= I_BS;
        if (r < I_OUT) { const int db = r / 32, kb = r % 32; tr_item(a.w_out, DM, DM, (bf16*)(ws + WS_WOUT), db * 32, db * 32, 32, kb, nullptr, scr, lane); continue; } r -= I_OUT;
        if (r < I_UP) { const int db = r / 32, kb = r % 32; tr_item(a.w_up, DM, DFF, (bf16*)(ws + WS_WUP), db * 32, db * 32, 32, kb, a.mlp_norm, scr, lane); continue; } r -= I_UP;
        { const int db = r / 128, kb = r % 128; tr_item(a.w_dn, DFF, DM, (bf16*)(ws + WS_WDN), db * 32, db * 32, 32, kb, nullptr, scr, lane); }
    }
    for (int m = gw; m < M; m += 2 * NGW) rms_row2_to_bf16(a.x + (size_t)m * DM, a.x + (size_t)(m + NGW) * DM, a.attn_norm, (bf16*)(ws + WS_XN) + (size_t)m * DM, (bf16*)(ws + WS_XN) + (size_t)(m + NGW) * DM, lane);
    float* cs = (float*)(ws + WS_CS);
    for (int e = gw * 64 + lane; e < M * 32; e += NGW * 64) {
        const int tok = e >> 5, i = e & 31;
        const float inv_freq = powf(10000.0f, -(float)(2 * i) / 64.0f);
        const float ang = (float)a.pos[tok] * inv_freq;
        double rev = (double)ang * 0.15915494309189535; rev -= floor(rev);
        const float rf = (float)rev;
        cs[e] = __builtin_amdgcn_cosf(rf); cs[(size_t)M * 32 + e] = __builtin_amdgcn_sinf(rf);
    }
}

__device__ __forceinline__ void cumsum_unit(const Args& a, int bh, LAS unsigned char* lds) {
    const float* FL = (const float*)(a.ws + WS_FL); float* Cp = (float*)(a.ws + WS_C);
    LAS double* sh = (LAS double*)lds;
    const int b = bh >> 4, h = bh & 15, tid = threadIdx.x, s0 = tid * 16; const float fb = a.fbias[h];
    float ls[16]; double run = 0.0;
#pragma unroll
    for (int i = 0; i < 16; ++i) { const float z = FL[(size_t)(b * SEQ + s0 + i) * 16 + h] + fb; const float v = fminf(z, 0.f) - log1pf(expf(-fabsf(z))); ls[i] = v; run += (double)v; }
    sh[tid] = run; __syncthreads();
    double pre = 0.0; for (int k = 0; k < tid; ++k) pre += sh[k];
#pragma unroll
    for (int i = 0; i < 16; ++i) { pre += (double)ls[i]; Cp[(size_t)bh * SEQ + s0 + i] = (float)(pre * 1.4426950408889634); }
    __syncthreads();
}

__device__ __forceinline__ void naive_swa_unit(const Args& a, int unit) {
    const bf16* AQ = (const bf16*)(a.ws + WS_AQ); const bf16* AK = (const bf16*)(a.ws + WS_AK); const bf16* AV = (const bf16*)(a.ws + WS_AV); bf16* OA = (bf16*)(a.ws + WS_OA);
    const int tid = threadIdx.x, head = tid & 15, tok = unit * 32 + (tid >> 4), b = tok / SEQ, s = tok % SEQ, kvh = head >> 3;
    float q[64], o[64]; float m = -INFINITY, l = 0.f;
    { const v4u* qp = (const v4u*)(AQ + (size_t)tok * 1024 + head * 64);
#pragma unroll
      for (int c = 0; c < 8; ++c) { const v4u w = qp[c];
#pragma unroll
          for (int e = 0; e < 4; ++e) { q[8 * c + 2 * e] = pg8::bf_lo(w[e]); q[8 * c + 2 * e + 1] = pg8::bf_hi(w[e]); } } }
#pragma unroll
    for (int d = 0; d < 64; ++d) o[d] = 0.f;
    for (int i = 0; i < 128; ++i) {
        const int j = s - i; const bool valid = j >= 0; const int jj = valid ? j : 0;
        const v4u* kp = (const v4u*)(AK + (size_t)(b * SEQ + jj) * 128 + kvh * 64); const v4u* vp = (const v4u*)(AV + (size_t)(b * SEQ + jj) * 128 + kvh * 64);
        float dot = 0.f;
#pragma unroll
        for (int c = 0; c < 8; ++c) { const v4u w = kp[c];
#pragma unroll
            for (int e = 0; e < 4; ++e) { dot += q[8 * c + 2 * e] * pg8::bf_lo(w[e]); dot += q[8 * c + 2 * e + 1] * pg8::bf_hi(w[e]); } }
        const float lg = valid ? dot : -INFINITY;
        const float mn = fmaxf(m, lg), al = __builtin_amdgcn_exp2f(m - mn), p = __builtin_amdgcn_exp2f(lg - mn);
        l = l * al + p; m = mn;
#pragma unroll
        for (int c = 0; c < 8; ++c) { const v4u w = vp[c];
#pragma unroll
            for (int e = 0; e < 4; ++e) { o[8 * c + 2 * e] = o[8 * c + 2 * e] * al + p * pg8::bf_lo(w[e]); o[8 * c + 2 * e + 1] = o[8 * c + 2 * e + 1] * al + p * pg8::bf_hi(w[e]); } }
    }
    { const float sk = a.sinks[head] * LOG2E; const float m2 = fmaxf(m, sk), al = __builtin_amdgcn_exp2f(m - m2); l = l * al + __builtin_amdgcn_exp2f(sk - m2);
      const float rl = al / l;
      v4u* op = (v4u*)(OA + (size_t)tok * 1024 + head * 64);
#pragma unroll
      for (int c = 0; c < 8; ++c) { v4u w;
#pragma unroll
          for (int e = 0; e < 4; ++e) w[e] = pg8::cvt_pk_bf16(o[8 * c + 2 * e] * rl, o[8 * c + 2 * e + 1] * rl);
          op[c] = w; } }
}
__device__ __forceinline__ void naive_fox_unit(const Args& a, int bh, int qblk) {
    const bf16* FQ = (const bf16*)(a.ws + WS_FQ); const bf16* FK = (const bf16*)(a.ws + WS_FK); const bf16* FV = (const bf16*)(a.ws + WS_FV); bf16* OB = (bf16*)(a.ws + WS_OB);
    const float* Cp = (const float*)(a.ws + WS_C) + (size_t)bh * SEQ;
    const int tid = threadIdx.x, b = bh >> 4, h = bh & 15, s = qblk * 512 + tid; const size_t tok = (size_t)b * SEQ + s;
    float q[64], o[64]; float m = -INFINITY, l = 0.f;
    { const v4u* qp = (const v4u*)(FQ + tok * 1024 + h * 64);
#pragma unroll
      for (int c = 0; c < 8; ++c) { const v4u w = qp[c];
#pragma unroll
          for (int e = 0; e < 4; ++e) { q[8 * c + 2 * e] = pg8::bf_lo(w[e]); q[8 * c + 2 * e + 1] = pg8::bf_hi(w[e]); } } }
#pragma unroll
    for (int d = 0; d < 64; ++d) o[d] = 0.f;
    const float cq = Cp[s];
    const int jend = __builtin_amdgcn_readfirstlane(qblk * 512 + (tid | 63));
    for (int j = 0; j <= jend; ++j) {
        const v4u* kp = (const v4u*)(FK + ((size_t)b * SEQ + j) * 1024 + h * 64); const v4u* vp = (const v4u*)(FV + ((size_t)b * SEQ + j) * 1024 + h * 64);
        float dot = 0.f;
#pragma unroll
        for (int c = 0; c < 8; ++c) { const v4u w = kp[c];
#pragma unroll
            for (int e = 0; e < 4; ++e) { dot += q[8 * c + 2 * e] * pg8::bf_lo(w[e]); dot += q[8 * c + 2 * e + 1] * pg8::bf_hi(w[e]); } }
        float lg = dot + (cq - Cp[j]); lg = (j <= s) ? lg : -INFINITY;
        const float mn = fmaxf(m, lg), al = __builtin_amdgcn_exp2f(m - mn), p = __builtin_amdgcn_exp2f(lg - mn);
        l = l * al + p; m = mn;
#pragma unroll
        for (int c = 0; c < 8; ++c) { const v4u w = vp[c];
#pragma unroll
            for (int e = 0; e < 4; ++e) { o[8 * c + 2 * e] = o[8 * c + 2 * e] * al + p * pg8::bf_lo(w[e]); o[8 * c + 2 * e + 1] = o[8 * c + 2 * e + 1] * al + p * pg8::bf_hi(w[e]); } }
    }
    { const float rl = 1.0f / l; v4u* op = (v4u*)(OB + tok * 1024 + h * 64);
#pragma unroll
      for (int c = 0; c < 8; ++c) { v4u w;
#pragma unroll
          for (int e = 0; e < 4; ++e) w[e] = pg8::cvt_pk_bf16(o[8 * c + 2 * e] * rl, o[8 * c + 2 * e + 1] * rl);
          op[c] = w; } }
}

__global__ void __launch_bounds__(NWAVES * 64, 2) mega_fwd(Args a) {
    extern __shared__ __attribute__((aligned(16))) unsigned char lds_raw[];
    LAS unsigned char* lds = (LAS unsigned char*)lds_raw;
    cg::grid_group grid = cg::this_grid();
    int tid_ = threadIdx.x; asm volatile("" : "+v"(tid_));
    const int tid = tid_, lane = tid & 63, wave = __builtin_amdgcn_readfirstlane(tid >> 6);
    const int G = gridDim.x, bx = blockIdx.x, vcu = (G % 8 == 0) ? (bx % 8) * (G / 8) + bx / 8 : bx;
    unsigned char* ws = a.ws;
    float* SS1 = (float*)(ws + WS_CTL); float* SS2 = SS1 + M;
#define GRID_SYNC() do { asm volatile("s_waitcnt vmcnt(0) lgkmcnt(0)" ::: "memory"); grid.sync(); } while (0)

    for (int rp_ = 0; rp_ < (REP_PHASE == 100 ? 2 : 1); ++rp_) { p0_prologue(a, lds, vcu, G, wave, lane); __syncthreads(); }
    GRID_SYNC();

    {
        pg8::Gemm g{(const bf16*)(ws + WS_XN), (const bf16*)(ws + WS_WIN), nullptr, nullptr, DM};
        pg8::StaticOrder S; S.init(M, NIN, G, bx);
        pg8::EpiIn E{ws};
        for (int rp_ = 0; rp_ < (REP_PHASE == 1 ? 2 : 1); ++rp_) pg8::gemm_phase<pg8::EpiIn, pg8::StaticOrder, true, true>(lds, g, S, E);
    }
    GRID_SYNC();

    for (int u = bx; u < 64; u += G) cumsum_unit(a, u, lds);
#if NAIVE_SWA
    for (int u = bx; u < M / 32; u += G) naive_swa_unit(a, u);
#else
    for (int rp_ = 0; rp_ < (REP_PHASE == 2 ? 2 : 1); ++rp_)
    for (int u = vcu; u < 2048; u += G) { const int bh = u >> 5, qb = u & 31, b_ = bh >> 4, h_ = bh & 15;
        attn_body::attn_unit<8, false, 128>(b_, h_, qb, (const bf16*)(ws + WS_AQ), (const bf16*)(ws + WS_AK), (const bf16*)(ws + WS_AV), (bf16*)(ws + WS_OA), nullptr, a.sinks[h_] * LOG2E, (char*)lds_raw); }
#endif
    GRID_SYNC();

#if NAIVE_FOX
    for (int u = bx; u < 1024; u += G) { const int r = u >> 6, i = r >> 2, hi4 = r & 3, qblk = (i & 1) ? 4 * i + 3 - hi4 : 4 * i + hi4; naive_fox_unit(a, u & 63, qblk); }
#else
    for (int rp_ = 0; rp_ < (REP_PHASE == 3 ? 2 : 1); ++rp_)
    for (int e = vcu; e < 2048; e += G) { const int cuv = e & 255, i = e >> 8, bh = (cuv >> 3) + 32 * (i >> 2), s_ = cuv & 7, k_ = i & 3, qb = k_ == 0 ? s_ : (k_ == 1 ? 15 - s_ : (k_ == 2 ? 16 + s_ : 31 - s_));
        attn_body::attn_unit<8, true, 1024>(bh >> 4, bh & 15, qb, (const bf16*)(ws + WS_FQ), (const bf16*)(ws + WS_FK), (const bf16*)(ws + WS_FV), (bf16*)(ws + WS_OB), (const float*)(ws + WS_C) + (size_t)bh * SEQ, 0.f, (char*)lds_raw); }
#endif
    GRID_SYNC();

    {
        pg8::Gemm g{(const bf16*)(ws + WS_OA), (const bf16*)(ws + WS_WBS), (const bf16*)(ws + WS_OB), (const bf16*)(ws + WS_WBF), 1024};
        pg8::PairOrder S; S.s.init(M, DM, G, bx);
        pg8::EpiBranch E{(const bf16*)(ws + WS_G), (bf16*)(ws + WS_MG)};
        for (int rp_ = 0; rp_ < (REP_PHASE == 4 ? 2 : 1); ++rp_) pg8::gemm_phase<pg8::EpiBranch, pg8::PairOrder, true, true>(lds, g, S, E);
    }
    GRID_SYNC();

    {
        pg8::Gemm g{(const bf16*)(ws + WS_MG), (const bf16*)(ws + WS_WOUT), nullptr, nullptr, DM};
        pg8::StaticOrder S; S.init(M, DM, G, bx);
        pg8::EpiResB<false> E{a.x, (bf16*)(ws + WS_X1B), SS1};
        pg8::gemm_phase<pg8::EpiResB<false>, pg8::StaticOrder, true, true>(lds, g, S, E);
    }
    GRID_SYNC();

    {
        pg8::Gemm g{(const bf16*)(ws + WS_X1B), (const bf16*)(ws + WS_WUP), nullptr, nullptr, DM};
        pg8::StaticOrder S; S.init(M, DFF, G, bx);
        pg8::EpiUp E{SS1, (bf16*)(ws + WS_U)};
        for (int rp_ = 0; rp_ < (REP_PHASE == 6 ? 2 : 1); ++rp_) pg8::gemm_phase<pg8::EpiUp, pg8::StaticOrder, true, true>(lds, g, S, E);
    }
    GRID_SYNC();

    {
        pg8::Gemm g{(const bf16*)(ws + WS_U), (const bf16*)(ws + WS_WDN), nullptr, nullptr, DFF};
        pg8::StaticOrder S; S.init(M, DM, G, bx);
        pg8::EpiResB<true> E{(const void*)(ws + WS_X1B), (bf16*)(ws + WS_X2B), SS2};
        pg8::gemm_phase<pg8::EpiResB<true>, pg8::StaticOrder, true, true>(lds, g, S, E);
    }
    GRID_SYNC();

    {
        const int gw = vcu * NWAVES + wave, NGW = G * NWAVES;
        for (int m = gw; m < M; m += NGW) {
            const float rstd = __builtin_amdgcn_rsqf(SS2[m] * (1.f / DM) + RMS_EPS);
            f32x4* xr = (f32x4*)(a.out + (size_t)m * DM) + lane; const f32x4* gr = (const f32x4*)a.final_norm + lane; const v2u* br = (const v2u*)((const bf16*)(ws + WS_X2B) + (size_t)m * DM) + lane;
            v2u w[8];
#pragma unroll
            for (int j = 0; j < 8; ++j) w[j] = __builtin_nontemporal_load(br + 64 * j);
#pragma unroll
            for (int j = 0; j < 8; ++j) { const f32x4 g = gr[64 * j]; const f32x4 v = (f32x4){pg8::bf_lo(w[j].x), pg8::bf_hi(w[j].x), pg8::bf_lo(w[j].y), pg8::bf_hi(w[j].y)}; __builtin_nontemporal_store(v * rstd * g, xr + 64 * j); }
        }
    }
}

extern "C" void kernel_launch(void* const* d_in, const int* in_sizes, int n_in, void* d_out, int out_size, void* d_ws, size_t ws_size, hipStream_t stream) {
    static int grid = 0; static int fused_final = 0;
    if (grid == 0) {
        if (n_in != 13 || in_sizes[0] != M * DM || out_size != M * DM || ws_size < WS_END) { fprintf(stderr, "kernel_launch: unexpected shapes (n_in %d, in0 %d, out %d, ws %zu)\n", n_in, n_in > 0 ? in_sizes[0] : -1, out_size, ws_size); grid = -1; return; }
        int dev = 0, cus = 0, per_cu = 0;
        if (hipGetDevice(&dev) != hipSuccess || hipDeviceGetAttribute(&cus, hipDeviceAttributeMultiprocessorCount, dev) != hipSuccess) { grid = -1; return; }
        if (hipFuncSetAttribute((const void*)mega_fwd, hipFuncAttributeMaxDynamicSharedMemorySize, LDS_BYTES) != hipSuccess) { fprintf(stderr, "kernel_launch: hipFuncSetAttribute failed\n"); grid = -1; return; }
        if (hipOccupancyMaxActiveBlocksPerMultiprocessor(&per_cu, (const void*)mega_fwd, NWAVES * 64, LDS_BYTES) != hipSuccess || per_cu < 1) { fprintf(stderr, "kernel_launch: occupancy query says %d\n", per_cu); per_cu = 1; }
        (void)hipGetLastError();
        grid = cus * 1;
        { pg8::StaticOrder S; S.init(M, DM, grid, 0); bool ok = (M / 256) * (DM / 256) == 4 * grid;
          for (int c = 0; c < grid && ok; ++c) { S.c = c; for (int i = 0; i < 4 && ok; i += 2) { pg8::Unit u0, u1; ok = S.next(i, u0) && S.next(i + 1, u1) && u0.pm == u1.pm && u1.pn == u0.pn + 4 && u0.pn < 4 && u0.f == 0 && u1.f == 1; } }
          fused_final = (ok && FUSED_FINAL) ? 1 : 0; if (!ok) fprintf(stderr, "kernel_launch: note: unit order does not pair tiles; using the separate final-norm pass\n"); }
    }
    if (grid < 0) return;
    (void)hipMemsetAsync((char*)d_ws + WS_CTL, 0, CTL_ZERO_BYTES, stream);
    Args a{};
    a.x = (const float*)d_in[0]; a.pos = (const int*)d_in[1]; a.attn_norm = (const float*)d_in[2]; a.w_in = (const float*)d_in[3]; a.fbias = (const float*)d_in[4]; a.sinks = (const float*)d_in[5];
    a.w_bs = (const float*)d_in[6]; a.w_bf = (const float*)d_in[7]; a.w_out = (const float*)d_in[8]; a.mlp_norm = (const float*)d_in[9]; a.w_up = (const float*)d_in[10]; a.w_dn = (const float*)d_in[11];
    a.final_norm = (const float*)d_in[12]; a.out = (float*)d_out; a.ws = (unsigned char*)d_ws; a.fused_final = fused_final;
    void* kargs[] = {&a};
    const hipError_t le = hipLaunchCooperativeKernel((const void*)mega_fwd, dim3(grid), dim3(NWAVES * 64), kargs, LDS_BYTES, stream);
    if (le != hipSuccess) fprintf(stderr, "kernel_launch: cooperative launch failed: %s (grid %d)\n", hipGetErrorString(le), grid);
}
```

```cpp
#include <hip/hip_runtime.h>
#include <hip/hip_cooperative_groups.h>
#include <cstdio>
#include <cstdint>
namespace cg = cooperative_groups;

constexpr int BATCH = 4, SEQ = 8192, DM = 2048, M = BATCH * SEQ, DFF = 8192, NIN = 8704  , DIN = 8464;
constexpr float RMS_EPS = 1e-6f;
constexpr float LOG2E = 1.4426950408889634f;
constexpr float C2 = 0.125f * 1.4426950408889634f;

constexpr size_t MiB = 1u << 20;
constexpr size_t WS_CTL = 0, CTL_ZERO_BYTES = 1 * MiB;
constexpr size_t WS_WIN = 1 * MiB, WS_WBS = 35 * MiB, WS_WBF = 39 * MiB, WS_WOUT = 43 * MiB, WS_WUP = 51 * MiB, WS_WDN = 83 * MiB;
constexpr size_t WS_CS = 115 * MiB;
constexpr size_t WS_FL = 123 * MiB, WS_C = 125 * MiB;
constexpr size_t WS_FK = 128 * MiB, WS_FV = 192 * MiB, WS_X1B = 128 * MiB;
constexpr size_t WS_XN = 256 * MiB, WS_MG = 256 * MiB;
constexpr size_t WS_AQ = 384 * MiB, WS_FQ = 448 * MiB, WS_G = 512 * MiB;
constexpr size_t WS_U = 256 * MiB;
constexpr size_t WS_AK = 768 * MiB, WS_AV = 776 * MiB, WS_OA = 784 * MiB, WS_OB = 848 * MiB, WS_END = 912 * MiB;
constexpr size_t WS_X2B = 784 * MiB;

namespace pg8 {
#define PG8_LAS __attribute__((address_space(3)))
typedef unsigned short bf16_t;
typedef short bf16x8 __attribute__((ext_vector_type(8)));
typedef float f32x4 __attribute__((ext_vector_type(4)));
typedef unsigned u32x4 __attribute__((ext_vector_type(4)));
typedef unsigned u32x2 __attribute__((ext_vector_type(2)));
constexpr int BM = 256, BK = 64, HALF = 128, HTB = HALF * BK * 2  , STAGE_BYTES = 8 * HTB, NXCD = 8, WGM = 8;

__host__ __device__ __forceinline__ int lds_byte(int r, int c) { const int st = (r >> 4) * 2 + (c >> 5), rr = r & 15, cc = c & 31, ob = rr * 64 + cc * 2; return st * 1024 + (ob ^ (((ob >> 9) & 1) << 5)); }
__host__ __device__ __forceinline__ void stage_rc(int b, int& R, int& C) { const int st = b / 1024, sb = b % 1024, swz = sb ^ (((sb >> 9) & 1) << 5); R = (st >> 1) * 16 + swz / 64; C = (st & 1) * 32 + (swz % 64) / 2; }
__host__ __device__ __forceinline__ int perm32(int rho) { const int n = rho >> 4, i = rho & 15; return 8 * (i >> 2) + 4 * n + (i & 3); }

struct Unit { int pm, pn, z, f; };
struct Gemm { const bf16_t* A0; const bf16_t* B0; const bf16_t* A1; const bf16_t* B1; int K; };

struct StaticOrder {
    int nM, nN, nwg, G, c;
    __host__ __device__ void init(int M_, int N_, int G_, int c_) { nM = M_ / BM; nN = N_ / BM; nwg = nM * nN; G = G_; c = c_; }
    __host__ __device__ bool next(int i, Unit& u) const {
        const long L = (long)i * G + c; if (L >= nwg) return false;
        int wgid = (int)L; { const int q = nwg / NXCD, r = nwg % NXCD, xcd = wgid % NXCD, off = wgid / NXCD; wgid = (xcd < r ? xcd * (q + 1) : r * (q + 1) + (xcd - r) * q) + off; }
        const int nig = WGM * nN, gid = wgid / nig, fm = gid * WGM, gsz = (nM - fm) < WGM ? (nM - fm) : WGM;
        u.pm = fm + ((wgid % nig) % gsz); u.pn = (wgid % nig) / gsz; u.z = 0; u.f = i & 1; return true;
    }
};
struct PairOrder {
    StaticOrder s;
    __host__ __device__ bool next(int i, Unit& u) const { const bool ok = s.next(i >> 1, u); u.z = i & 1; return ok; }
};

__device__ __forceinline__ unsigned cvt_pk_bf16(float lo, float hi) { unsigned r; asm("v_cvt_pk_bf16_f32 %0, %1, %2" : "=v"(r) : "v"(lo), "v"(hi)); return r; }
__device__ __forceinline__ float bf_lo(unsigned w) { return __uint_as_float(w << 16); }
__device__ __forceinline__ float bf_hi(unsigned w) { return __uint_as_float(w & 0xffff0000u); }
__device__ __forceinline__ float sigmoidf_(float x) { return __builtin_amdgcn_rcpf(1.0f + __builtin_amdgcn_exp2f(-x * LOG2E)); }


struct EpiIn {
    static constexpr bool PERM = true;
    unsigned char* ws;
    __device__ __forceinline__ bool keep(const Unit&) const { return false; }
    __device__ __forceinline__ void operator()(f32x4 (&acc)[2][2][4][2], const Unit& u, int wr, int wc, int fr, int fq) const {
        const int pn = u.pn; const int row0 = u.pm * BM + wr * 64 + fr;
        if (pn <= 16) {
            size_t doff; int pitch, colbase; bool rope = false; float sc = 1.f;
            if (pn < 4) { doff = WS_AQ; pitch = 1024; colbase = (4 * pn + wc) * 64; rope = true; sc = C2; }
            else if (pn == 4) { if (wc < 2) { doff = WS_AK; pitch = 128; colbase = wc * 64; rope = true; } else { doff = WS_AV; pitch = 128; colbase = (wc - 2) * 64; } }
            else { const int t = pn - 5, seg = t >> 2, tin = t & 3; doff = WS_FQ; if (seg == 1) doff = WS_FK; if (seg == 2) doff = WS_FV; pitch = 1024; colbase = (4 * tin + wc) * 64; sc = seg == 0 ? C2 : 1.f; }
            bf16_t* dst = (bf16_t*)(ws + doff); const float* cs = (const float*)(ws + WS_CS);
#pragma unroll
            for (int ai = 0; ai < 2; ++ai) {
                f32x4 cc[4][4];
                if (rope) {
#pragma unroll
                    for (int m = 0; m < 4; ++m) { const float* cp = cs + (size_t)(row0 + ai * HALF + m * 16) * 32 + 8 * fq; const float* sp = cp + (size_t)M * 32;
                        cc[m][0] = *(const f32x4*)cp; cc[m][1] = *(const f32x4*)(cp + 4); cc[m][2] = *(const f32x4*)sp; cc[m][3] = *(const f32x4*)(sp + 4); }
                    asm volatile("" ::: "memory");
                }
#pragma unroll
                for (int m = 0; m < 4; ++m) {
                    const int row = row0 + ai * HALF + m * 16;
                    f32x4 v00 = acc[ai][0][m][0], v01 = acc[ai][0][m][1], v10 = acc[ai][1][m][0], v11 = acc[ai][1][m][1];
                    if (rope) {
                        const f32x4 c0 = cc[m][0], c1 = cc[m][1], s0 = cc[m][2], s1 = cc[m][3];
                        const f32x4 o00 = v00 * c0 - v10 * s0, o10 = v10 * c0 + v00 * s0, o01 = v01 * c1 - v11 * s1, o11 = v11 * c1 + v01 * s1;
                        v00 = o00; v10 = o10; v01 = o01; v11 = o11;
                    }
                    v00 = v00 * sc; v01 = v01 * sc; v10 = v10 * sc; v11 = v11 * sc;
                    bf16_t* rp = dst + (size_t)row * pitch + colbase + 8 * fq;
                    u32x4 w0, w1;
                    w0.x = cvt_pk_bf16(v00[0], v00[1]); w0.y = cvt_pk_bf16(v00[2], v00[3]); w0.z = cvt_pk_bf16(v01[0], v01[1]); w0.w = cvt_pk_bf16(v01[2], v01[3]);
                    w1.x = cvt_pk_bf16(v10[0], v10[1]); w1.y = cvt_pk_bf16(v10[2], v10[3]); w1.z = cvt_pk_bf16(v11[0], v11[1]); w1.w = cvt_pk_bf16(v11[2], v11[3]);
                    *(u32x4*)rp = w0; *(u32x4*)(rp + 32) = w1;
                }
                asm volatile("" ::: "memory");
            }
        } else if (pn <= 32) {
            const int col0 = (pn - 17) * BM + wc * 32 + 8 * fq;
#pragma unroll
            for (int ai = 0; ai < 2; ++ai)
#pragma unroll
                for (int m = 0; m < 4; ++m) {
                    unsigned char* rp = ws + WS_G + (size_t)(row0 + ai * HALF + m * 16) * 4096 + col0;
#pragma unroll
                    for (int bj = 0; bj < 2; ++bj) {
                        const f32x4 a = acc[ai][bj][m][0], b = acc[ai][bj][m][1]; u32x2 w; w.x = 0u; w.y = 0u;
#pragma unroll
                        for (int i = 0; i < 4; ++i) { w.x = __builtin_amdgcn_cvt_pk_u8_f32(fmaxf(sigmoidf_(a[i]) * 255.0f, 1.0f), i, w.x); w.y = __builtin_amdgcn_cvt_pk_u8_f32(fmaxf(sigmoidf_(b[i]) * 255.0f, 1.0f), i, w.y); }
                        *(u32x2*)(rp + bj * HALF) = w;
                    }
                }
        } else {
            if (wc == 0 && fq < 2) {
#pragma unroll
                for (int ai = 0; ai < 2; ++ai)
#pragma unroll
                    for (int m = 0; m < 4; ++m) {
                        float* rp = (float*)(ws + WS_FL) + (size_t)(row0 + ai * HALF + m * 16) * 16 + 8 * fq;
                        *(f32x4*)rp = acc[ai][0][m][0]; *(f32x4*)(rp + 4) = acc[ai][0][m][1];
                    }
            }
        }
    }
};

struct EpiBranch {
    static constexpr bool PERM = true;
    const unsigned char* G; bf16_t* MG;
    __device__ __forceinline__ bool keep(const Unit& u) const { return u.z == 0; }
    __device__ __forceinline__ void operator()(f32x4 (&acc)[2][2][4][2], const Unit& u, int wr, int wc, int fr, int fq) const {
        const int row0 = u.pm * BM + wr * 64 + fr, col0 = u.pn * BM + wc * 32 + 8 * fq; const int z = u.z;
#pragma unroll
        for (int ai = 0; ai < 2; ++ai) {
            u32x2 gbv[4][2], gav[4][2];
#pragma unroll
            for (int m = 0; m < 4; ++m)
#pragma unroll
                for (int bj = 0; bj < 2; ++bj) { const unsigned char* gp = G + (size_t)(row0 + ai * HALF + m * 16) * 4096 + col0 + bj * HALF;
                    gbv[m][bj] = *(const u32x2*)(gp + 2048); if (z == 0) gav[m][bj] = *(const u32x2*)gp; }
            asm volatile("" ::: "memory");
#pragma unroll
            for (int m = 0; m < 4; ++m) {
                const size_t row = (size_t)(row0 + ai * HALF + m * 16);
#pragma unroll
                for (int bj = 0; bj < 2; ++bj) {
                    const u32x2 gb = gbv[m][bj];
                    float sb[8];
#pragma unroll
                    for (int i = 0; i < 4; ++i) { sb[i] = (float)((gb.x >> (8 * i)) & 0xffu); sb[4 + i] = (float)((gb.y >> (8 * i)) & 0xffu); }
                    if (z == 0) {
                        const u32x2 ga = gav[m][bj];
#pragma unroll
                        for (int i = 0; i < 4; ++i) {
                            acc[ai][bj][m][0][i] *= (float)((ga.x >> (8 * i)) & 0xffu) * __builtin_amdgcn_rcpf(sb[i]);
                            acc[ai][bj][m][1][i] *= (float)((ga.y >> (8 * i)) & 0xffu) * __builtin_amdgcn_rcpf(sb[4 + i]);
                        }
                    } else {
#pragma unroll
                        for (int i = 0; i < 8; ++i) sb[i] *= (1.0f / 255.0f);
                        const f32x4 a = acc[ai][bj][m][0], b = acc[ai][bj][m][1]; u32x4 w;
                        w.x = cvt_pk_bf16(a[0] * sb[0], a[1] * sb[1]); w.y = cvt_pk_bf16(a[2] * sb[2], a[3] * sb[3]);
                        w.z = cvt_pk_bf16(b[0] * sb[4], b[1] * sb[5]); w.w = cvt_pk_bf16(b[2] * sb[6], b[3] * sb[7]);
                        *(u32x4*)(MG + row * 2048 + col0 + bj * HALF) = w;
                    }
                }
            }
            asm volatile("" ::: "memory");
        }
    }
};

template <bool WRITE_BF> struct EpiRes {
    static constexpr bool PERM = false;
    const float* base; float* out; bf16_t* xb; float* ss;
    __device__ __forceinline__ bool keep(const Unit&) const { return false; }
    __device__ __forceinline__ void operator()(f32x4 (&acc)[2][2][4][2], const Unit& u, int wr, int wc, int fr, int fq) const {
        const int row0 = u.pm * BM + wr * 64 + fr, col0 = u.pn * BM + wc * 32 + 4 * fq;
#pragma unroll
        for (int ai = 0; ai < 2; ++ai) {
            f32x4 pre[4][2][2];
#pragma unroll
            for (int m = 0; m < 4; ++m)
#pragma unroll
                for (int bj = 0; bj < 2; ++bj)
#pragma unroll
                    for (int n = 0; n < 2; ++n) pre[m][bj][n] = *(const f32x4*)(base + (size_t)(row0 + ai * HALF + m * 16) * DM + col0 + bj * HALF + n * 16);
            asm volatile("" ::: "memory");
#pragma unroll
            for (int m = 0; m < 4; ++m) {
                const size_t row = (size_t)(row0 + ai * HALF + m * 16); const size_t off = row * DM + col0; float q = 0.f;
#pragma unroll
                for (int bj = 0; bj < 2; ++bj)
#pragma unroll
                    for (int n = 0; n < 2; ++n) {
                        const size_t o = off + bj * HALF + n * 16;
                        const f32x4 v = pre[m][bj][n] + acc[ai][bj][m][n];
                        *(f32x4*)(out + o) = v; q += (v[0] * v[0] + v[1] * v[1]) + (v[2] * v[2] + v[3] * v[3]);
                        if (WRITE_BF) { u32x2 w; w.x = cvt_pk_bf16(v[0], v[1]); w.y = cvt_pk_bf16(v[2], v[3]); *(u32x2*)(xb + o) = w; }
                    }
                q += __shfl_xor(q, 16); q += __shfl_xor(q, 32);
                if (fq == 0) atomicAdd(ss + row, q);
            }
            asm volatile("" ::: "memory");
        }
    }
};

struct EpiFinal {
    static constexpr bool PERM = false;
    float* out; float* ss; unsigned* cnt; const float* gain;
    __device__ __forceinline__ bool keep(const Unit&) const { return false; }
    __device__ __forceinline__ void operator()(f32x4 (&acc)[2][2][4][2], const Unit& u, int wr, int wc, int fr, int fq) const {
        const int row0 = u.pm * BM + wr * 64 + fr, col0 = u.pn * BM + wc * 32 + 4 * fq; const bool second = u.f != 0;
#pragma unroll
        for (int ai = 0; ai < 2; ++ai) {
            f32x4 pre[4][2][2];
#pragma unroll
            for (int m = 0; m < 4; ++m)
#pragma unroll
                for (int bj = 0; bj < 2; ++bj)
#pragma unroll
                    for (int n = 0; n < 2; ++n) pre[m][bj][n] = *(const f32x4*)(out + (size_t)(row0 + ai * HALF + m * 16) * DM + col0 + bj * HALF + n * 16);
            asm volatile("" ::: "memory");
#pragma unroll
            for (int m = 0; m < 4; ++m) {
                const size_t row = (size_t)(row0 + ai * HALF + m * 16); const size_t off = row * DM + col0; float q = 0.f;
#pragma unroll
                for (int bj = 0; bj < 2; ++bj)
#pragma unroll
                    for (int n = 0; n < 2; ++n) {
                        const f32x4 v = pre[m][bj][n] + acc[ai][bj][m][n]; acc[ai][bj][m][n] = v;
                        q += (v[0] * v[0] + v[1] * v[1]) + (v[2] * v[2] + v[3] * v[3]);
                        if (!second) *(f32x4*)(out + off + bj * HALF + n * 16) = v;
                    }
                q += __shfl_xor(q, 16); q += __shfl_xor(q, 32);
                if (fq == 0) atomicAdd(ss + row, q);
            }
            asm volatile("" ::: "memory");
        }
        asm volatile("s_waitcnt vmcnt(0)" ::: "memory");
        unsigned* pc = cnt + 16 * u.pm;
        if ((threadIdx.x & 63) == 0) __hip_atomic_fetch_add(pc, 1u, __ATOMIC_RELAXED, __HIP_MEMORY_SCOPE_AGENT);
        if (!second) return;
        { const unsigned long long t0 = __builtin_amdgcn_s_memrealtime();
          while ((unsigned)__builtin_amdgcn_readfirstlane(__hip_atomic_load(pc, __ATOMIC_RELAXED, __HIP_MEMORY_SCOPE_AGENT)) < 64u) {
              if (__builtin_amdgcn_s_memrealtime() - t0 > 2000000ull) break;
              __builtin_amdgcn_s_sleep(4); }
          asm volatile("" ::: "memory"); }
#pragma unroll
        for (int ai = 0; ai < 2; ++ai)
#pragma unroll
            for (int m = 0; m < 4; ++m) {
                const size_t row = (size_t)(row0 + ai * HALF + m * 16); const size_t off = row * DM + col0;
                const float rstd = __builtin_amdgcn_rsqf(__hip_atomic_load(ss + row, __ATOMIC_RELAXED, __HIP_MEMORY_SCOPE_AGENT) * (1.0f / DM) + RMS_EPS);
#pragma unroll
                for (int bj = 0; bj < 2; ++bj)
#pragma unroll
                    for (int n = 0; n < 2; ++n) {
                        const size_t o = off + bj * HALF + n * 16; const int c = col0 + bj * HALF + n * 16;
                        const f32x4 gB = *(const f32x4*)(gain + c), gA = *(const f32x4*)(gain + c - 1024), vA = *(const f32x4*)(out + o - 1024);
                        *(f32x4*)(out + o) = acc[ai][bj][m][n] * rstd * gB;
                        *(f32x4*)(out + o - 1024) = vA * rstd * gA;
                    }
            }
    }
};

template <bool BASE_BF> struct EpiResB {
    static constexpr bool PERM = true;
    const void* base; bf16_t* yb; float* ss;
    __device__ __forceinline__ bool keep(const Unit&) const { return false; }
    __device__ __forceinline__ void operator()(f32x4 (&acc)[2][2][4][2], const Unit& u, int wr, int wc, int fr, int fq) const {
        const int row0 = u.pm * BM + wr * 64 + fr, col0 = u.pn * BM + wc * 32 + 8 * fq;
#pragma unroll
        for (int ai = 0; ai < 2; ++ai) {
            f32x4 pf[4][2][2]; u32x4 pb[4][2];
#pragma unroll
            for (int m = 0; m < 4; ++m)
#pragma unroll
                for (int bj = 0; bj < 2; ++bj) { const size_t o = (size_t)(row0 + ai * HALF + m * 16) * DM + col0 + bj * HALF;
                    if (BASE_BF) pb[m][bj] = *(const u32x4*)((const bf16_t*)base + o);
                    else { pf[m][bj][0] = *(const f32x4*)((const float*)base + o); pf[m][bj][1] = *(const f32x4*)((const float*)base + o + 4); } }
            asm volatile("" ::: "memory");
#pragma unroll
            for (int m = 0; m < 4; ++m) {
                const size_t row = (size_t)(row0 + ai * HALF + m * 16); float q = 0.f;
#pragma unroll
                for (int bj = 0; bj < 2; ++bj) {
                    f32x4 x0, x1;
                    if (BASE_BF) { const u32x4 w = pb[m][bj]; x0 = (f32x4){bf_lo(w.x), bf_hi(w.x), bf_lo(w.y), bf_hi(w.y)}; x1 = (f32x4){bf_lo(w.z), bf_hi(w.z), bf_lo(w.w), bf_hi(w.w)}; }
                    else { x0 = pf[m][bj][0]; x1 = pf[m][bj][1]; }
                    const f32x4 v0 = x0 + acc[ai][bj][m][0], v1 = x1 + acc[ai][bj][m][1];
                    q += ((v0[0] * v0[0] + v0[1] * v0[1]) + (v0[2] * v0[2] + v0[3] * v0[3])) + ((v1[0] * v1[0] + v1[1] * v1[1]) + (v1[2] * v1[2] + v1[3] * v1[3]));
                    u32x4 w; w.x = cvt_pk_bf16(v0[0], v0[1]); w.y = cvt_pk_bf16(v0[2], v0[3]); w.z = cvt_pk_bf16(v1[0], v1[1]); w.w = cvt_pk_bf16(v1[2], v1[3]);
                    *(u32x4*)(yb + row * DM + col0 + bj * HALF) = w;
                }
                q += __shfl_xor(q, 16); q += __shfl_xor(q, 32);
                if (fq == 0) atomicAdd(ss + row, q);
            }
            asm volatile("" ::: "memory");
        }
    }
};

struct EpiUp {
    static constexpr bool PERM = true;
    const float* ss; bf16_t* U;
    __device__ __forceinline__ bool keep(const Unit&) const { return false; }
    __device__ __forceinline__ void operator()(f32x4 (&acc)[2][2][4][2], const Unit& u, int wr, int wc, int fr, int fq) const {
        const int row0 = u.pm * BM + wr * 64 + fr, col0 = u.pn * BM + wc * 32 + 8 * fq;
        float rs[2][4];
#pragma unroll
        for (int ai = 0; ai < 2; ++ai)
#pragma unroll
            for (int m = 0; m < 4; ++m) rs[ai][m] = ss[row0 + ai * HALF + m * 16];
        asm volatile("" ::: "memory");
#pragma unroll
        for (int ai = 0; ai < 2; ++ai)
#pragma unroll
            for (int m = 0; m < 4; ++m) {
                const size_t row = (size_t)(row0 + ai * HALF + m * 16);
                const float rstd = __builtin_amdgcn_rsqf(rs[ai][m] * (1.0f / DM) + RMS_EPS);
#pragma unroll
                for (int bj = 0; bj < 2; ++bj) {
                    f32x4 a = acc[ai][bj][m][0] * rstd, b = acc[ai][bj][m][1] * rstd; u32x4 w;
#pragma unroll
                    for (int i = 0; i < 4; ++i) { a[i] = fmaxf(a[i], 0.f); a[i] *= a[i]; b[i] = fmaxf(b[i], 0.f); b[i] *= b[i]; }
                    w.x = cvt_pk_bf16(a[0], a[1]); w.y = cvt_pk_bf16(a[2], a[3]); w.z = cvt_pk_bf16(b[0], b[1]); w.w = cvt_pk_bf16(b[2], b[3]);
                    *(u32x4*)(U + row * DFF + col0 + bj * HALF) = w;
                }
            }
    }
};

template <class Epi, class Sched, bool ALIGN_EPI = false, bool SP2 = false>
__device__ __forceinline__ void gemm_phase(PG8_LAS unsigned char* lds, const Gemm g, const Sched& S, const Epi& E) {
    int tid_ = threadIdx.x; asm volatile("" : "+v"(tid_));
    const int tid = tid_, wid = __builtin_amdgcn_readfirstlane(tid >> 6), lane = tid & 63, wr = wid >> 2, wc = wid & 3, fr = lane & 15, fq = lane >> 4;
    const int K = g.K, nt = K / BK;
    unsigned voffA[2], voffB[2];
#pragma unroll
    for (int i = 0; i < 2; ++i) { int R, C; stage_rc(tid * 16 + i * 8192, R, C); const int Rb = Epi::PERM ? ((R & ~31) + perm32(R & 31)) : R;
        voffA[i] = (unsigned)(R * K + C) * 2u; voffB[i] = (unsigned)(Rb * K + C) * 2u; }
    const size_t kstep = (size_t)(BK * 2);
    const size_t hstep = (size_t)HALF * K * 2;
    const size_t tstep = 2 * hstep;
    const unsigned ldsw = (unsigned)wid * 1024u;
    const int aoff = lds_byte(wr * 64 + fr, fq * 8), boff = lds_byte(wc * 32 + fr, fq * 8);
#define PG8_SA(b, h) (((b) * 2 + (h)) * HTB)
#define PG8_SB(b, h) ((4 + (b) * 2 + (h)) * HTB)
#define PG8_STAGE(bufoff, gbase, voff) do { _Pragma("unroll") for (int _i = 0; _i < 2; ++_i) \
        __builtin_amdgcn_global_load_lds((const unsigned*)((const char*)(gbase) + (voff)[_i]), (PG8_LAS unsigned*)(lds + (bufoff) + ldsw + _i * 8192), 16, 0, 0); } while (0)
#define PG8_LDA(dst, b, h) do { _Pragma("unroll") for (int m = 0; m < 4; ++m) _Pragma("unroll") for (int k = 0; k < 2; ++k) dst[m][k] = *(const PG8_LAS bf16x8*)(lds + PG8_SA(b, h) + aoff + m * 2048 + k * 1024); } while (0)
#define PG8_LDB(dst, b, h) do { _Pragma("unroll") for (int n = 0; n < 2; ++n) _Pragma("unroll") for (int k = 0; k < 2; ++k) dst[n][k] = *(const PG8_LAS bf16x8*)(lds + PG8_SB(b, h) + boff + n * 2048 + k * 1024); } while (0)
#define PG8_MMA(ai, bj, At, Bt) do { __builtin_amdgcn_s_setprio(1); _Pragma("unroll") for (int m = 0; m < 4; ++m) _Pragma("unroll") for (int n = 0; n < 2; ++n) _Pragma("unroll") for (int k = 0; k < 2; ++k) \
        acc[ai][bj][m][n] = __builtin_amdgcn_mfma_f32_16x16x32_bf16(Bt[n][k], At[m][k], acc[ai][bj][m][n], 0, 0, 0); __builtin_amdgcn_s_setprio(0); } while (0)
#define PG8_WAIT_V(n) asm volatile("s_waitcnt vmcnt(" #n ")" ::: "memory")
#define PG8_WAIT_L(n) asm volatile("s_waitcnt lgkmcnt(" #n ")" ::: "memory")
#define PG8_BAR __builtin_amdgcn_s_barrier()
#define PG8_SCHED __builtin_amdgcn_sched_barrier(0)
    Unit cur, nxt; int ui = 0;
    if (!S.next(0, cur)) return;
    f32x4 acc[2][2][4][2];
#pragma unroll
    for (int a = 0; a < 2; ++a)
#pragma unroll
        for (int b = 0; b < 2; ++b)
#pragma unroll
            for (int m = 0; m < 4; ++m)
#pragma unroll
                for (int n = 0; n < 2; ++n) acc[a][b][m][n] = (f32x4){0.f, 0.f, 0.f, 0.f};
    bf16x8 At[4][2], B0[2][2], B1[2][2];
    const char* cA = (const char*)(cur.z ? g.A1 : g.A0) + (size_t)cur.pm * tstep; const char* cB = (const char*)(cur.z ? g.B1 : g.B0) + (size_t)cur.pn * tstep;
    if constexpr (SP2) {
        PG8_STAGE(PG8_SB(0, 0), cB, voffB); PG8_STAGE(PG8_SB(0, 1), cB + hstep, voffB); PG8_STAGE(PG8_SA(0, 0), cA, voffA); PG8_STAGE(PG8_SA(0, 1), cA + hstep, voffA);
        if (wr == 1) PG8_BAR;
        PG8_WAIT_V(2); PG8_BAR;
        PG8_STAGE(PG8_SB(1, 0), cB + kstep, voffB); PG8_STAGE(PG8_SA(1, 0), cA + kstep, voffA); PG8_STAGE(PG8_SB(1, 1), cB + hstep + kstep, voffB);
        PG8_WAIT_V(6); PG8_BAR;
    } else {
        PG8_STAGE(PG8_SB(0, 0), cB, voffB); PG8_STAGE(PG8_SA(0, 0), cA, voffA); PG8_STAGE(PG8_SB(0, 1), cB + hstep, voffB); PG8_STAGE(PG8_SA(0, 1), cA + hstep, voffA);
        if (wr == 1) PG8_BAR;
        PG8_WAIT_V(4); PG8_BAR;
        PG8_STAGE(PG8_SB(1, 0), cB + kstep, voffB); PG8_STAGE(PG8_SA(1, 0), cA + kstep, voffA); PG8_STAGE(PG8_SB(1, 1), cB + hstep + kstep, voffB);
        PG8_WAIT_V(6); PG8_BAR;
    }
    for (;;) {
        const bool has_next = S.next(ui + 1, nxt);
        const char* nA = has_next ? (const char*)(nxt.z ? g.A1 : g.A0) + (size_t)nxt.pm * tstep : cA; const char* nB = has_next ? (const char*)(nxt.z ? g.B1 : g.B0) + (size_t)nxt.pn * tstep : cB;
        for (int t = 0; t < nt; t += 2) {
            const bool last = (t == nt - 2);
            const char* a1 = cA + (size_t)(t + 1) * kstep;
            const char* a2 = last ? nA : cA + (size_t)(t + 2) * kstep; const char* b2 = last ? nB : cB + (size_t)(t + 2) * kstep;
            const char* a3 = a2 + kstep; const char* b3 = b2 + kstep;
            if constexpr (SP2) {
            PG8_LDB(B0, 0, 0); PG8_LDB(B1, 0, 1); PG8_SCHED; PG8_LDA(At, 0, 0); PG8_STAGE(PG8_SA(1, 1), a1 + hstep, voffA);
            PG8_WAIT_V(8); PG8_WAIT_L(0); PG8_BAR; PG8_MMA(0, 0, At, B0); PG8_MMA(0, 1, At, B1); PG8_BAR; PG8_SCHED;
            PG8_LDA(At, 0, 1); PG8_STAGE(PG8_SB(0, 0), b2, voffB); PG8_STAGE(PG8_SB(0, 1), b2 + hstep, voffB); PG8_STAGE(PG8_SA(0, 0), a2, voffA);
            PG8_WAIT_V(8); PG8_WAIT_L(0); PG8_BAR; PG8_MMA(1, 0, At, B0); PG8_MMA(1, 1, At, B1); PG8_BAR; PG8_SCHED;
            PG8_LDB(B0, 1, 0); PG8_LDB(B1, 1, 1); PG8_SCHED; PG8_LDA(At, 1, 0); PG8_STAGE(PG8_SA(0, 1), a2 + hstep, voffA);
            PG8_WAIT_V(8); PG8_WAIT_L(0); PG8_BAR; PG8_MMA(0, 0, At, B0); PG8_MMA(0, 1, At, B1); PG8_BAR; PG8_SCHED;
            PG8_LDA(At, 1, 1); PG8_STAGE(PG8_SB(1, 0), b3, voffB); PG8_STAGE(PG8_SB(1, 1), b3 + hstep, voffB); PG8_STAGE(PG8_SA(1, 0), a3, voffA);
            PG8_WAIT_V(8); PG8_WAIT_L(0); PG8_BAR; PG8_MMA(1, 0, At, B0); PG8_MMA(1, 1, At, B1); PG8_BAR; PG8_SCHED;
            } else {
            PG8_LDB(B0, 0, 0); PG8_SCHED; PG8_LDA(At, 0, 0); PG8_STAGE(PG8_SA(1, 1), a1 + hstep, voffA);
            PG8_WAIT_L(8); PG8_BAR; PG8_WAIT_L(0); PG8_MMA(0, 0, At, B0); PG8_BAR; PG8_SCHED;
            PG8_LDB(B1, 0, 1); PG8_STAGE(PG8_SB(0, 0), b2, voffB);
            PG8_BAR; PG8_WAIT_L(0); PG8_MMA(0, 1, At, B1); PG8_BAR;
            PG8_LDA(At, 0, 1); PG8_STAGE(PG8_SA(0, 0), a2, voffA);
            PG8_BAR; PG8_WAIT_L(0); PG8_MMA(1, 0, At, B0); PG8_BAR; PG8_SCHED;
            PG8_STAGE(PG8_SB(0, 1), b2 + hstep, voffB);
            PG8_WAIT_V(6); PG8_BAR; PG8_MMA(1, 1, At, B1); PG8_BAR;
            PG8_LDB(B0, 1, 0); PG8_SCHED; PG8_LDA(At, 1, 0); PG8_STAGE(PG8_SA(0, 1), a2 + hstep, voffA);
            PG8_WAIT_L(8); PG8_BAR; PG8_WAIT_L(0); PG8_MMA(0, 0, At, B0); PG8_BAR; PG8_SCHED;
            PG8_LDB(B1, 1, 1); PG8_STAGE(PG8_SB(1, 0), b3, voffB);
            PG8_BAR; PG8_WAIT_L(0); PG8_MMA(0, 1, At, B1); PG8_BAR;
            PG8_LDA(At, 1, 1); PG8_STAGE(PG8_SA(1, 0), a3, voffA);
            PG8_BAR; PG8_WAIT_L(0); PG8_MMA(1, 0, At, B0); PG8_BAR; PG8_SCHED;
            PG8_STAGE(PG8_SB(1, 1), b3 + hstep, voffB);
            PG8_WAIT_V(6); PG8_BAR; PG8_MMA(1, 1, At, B1); PG8_BAR;
            }
        }
        if constexpr (ALIGN_EPI) { if (wr == 0) PG8_BAR; }
        E(acc, cur, wr, wc, fr, fq);
        if (!has_next) break;
        if (!E.keep(cur))
#pragma unroll
        for (int a = 0; a < 2; ++a)
#pragma unroll
            for (int b = 0; b < 2; ++b)
#pragma unroll
                for (int m = 0; m < 4; ++m)
#pragma unroll
                    for (int n = 0; n < 2; ++n) acc[a][b][m][n] = (f32x4){0.f, 0.f, 0.f, 0.f};
        cur = nxt; cA = nA; cB = nB; ++ui;
        if constexpr (ALIGN_EPI) { if (wr == 1) PG8_BAR; }
    }
    PG8_WAIT_V(0);
    if constexpr (!ALIGN_EPI) { if (wr == 0) PG8_BAR; }
    PG8_BAR;
#undef PG8_SA
#undef PG8_SB
#undef PG8_STAGE
#undef PG8_LDA
#undef PG8_LDB
#undef PG8_MMA
#undef PG8_WAIT_V
#undef PG8_WAIT_L
#undef PG8_BAR
#undef PG8_SCHED
}
}


namespace attn_body {
using bf16=unsigned short;
using bf16x8=__attribute__((ext_vector_type(8)))short;
using s16x4=__attribute__((ext_vector_type(4)))short;
using f32x16=__attribute__((ext_vector_type(16)))float;
using u32x4=__attribute__((ext_vector_type(4)))unsigned;
using f32x4v=__attribute__((ext_vector_type(4)))float;
constexpr int BATCH=4,NHEAD=16,SEQ=8192,D=64,DM=NHEAD*D;
constexpr int NW=8,QBLK=32,QB=QBLK*NW,KVBLK=64,NQB=SEQ/QB;
constexpr int ATTN_PITCH=DM, ATTN_UNIT_ROWS=QB;
__device__ __forceinline__ int crow(int r,int hi){return (r&3)+8*(r>>2)+4*hi;}
#define SBAR() __builtin_amdgcn_sched_barrier(0)
template<bool SWA> __device__ __forceinline__ void cmask(f32x16&p0,f32x16&p1,int jb,int qrel,int hi){
  const float NEG=-INFINITY; int kb=64*jb+4*hi;
  #pragma unroll
  for(int r=0;r<16;++r){int kv=kb+(r&3)+8*(r>>2);
    if(SWA){ if(kv>qrel||kv<=qrel-128)p0[r]=NEG; if(kv+32>qrel||kv+32<=qrel-128)p1[r]=NEG; }
    else{ if(kv>qrel)p0[r]=NEG; if(kv+32>qrel)p1[r]=NEG; } }
}

constexpr int NSLOT=3, SLOTB=8192;
#ifndef NVB
#define NVB 8
#endif
constexpr int LDS_K=0, LDS_V=NSLOT*SLOTB, LDS_WS=2*NSLOT*SLOTB, LDS_OST=LDS_WS+NW*64*4, LDS_CB=LDS_OST+NW*4096, LDS_BYTES=LDS_CB+4*256;
constexpr float C2=0.125f*1.4426950408889634f;
__device__ __forceinline__ void glds16(const void*gsrc,unsigned lds_dst){unsigned keep;
  asm volatile("s_mov_b32 %0, m0\n\ts_mov_b32 m0, %2\n\ts_nop 0\n\tglobal_load_lds_dwordx4 %1, off\n\ts_mov_b32 m0, %0":"=&s"(keep):"v"(gsrc),"s"(lds_dst):"memory");}
__device__ __forceinline__ void glds4(const void*gsrc,unsigned lds_dst){unsigned keep;
  asm volatile("s_mov_b32 %0, m0\n\ts_mov_b32 m0, %2\n\ts_nop 0\n\tglobal_load_lds_dword %1, off\n\ts_mov_b32 m0, %0":"=&s"(keep):"v"(gsrc),"s"(lds_dst):"memory");}
__device__ __forceinline__ float max3f(float a,float b,float c){float r;asm("v_max3_f32 %0, %1, %2, %3":"=v"(r):"v"(a),"v"(b),"v"(c));return r;}
__device__ __forceinline__ float max2f(float a,float b){float r;asm("v_max_f32_e32 %0, %1, %2":"=v"(r):"v"(a),"v"(b));return r;}
__device__ __forceinline__ float fadd_s(float a,float b){float r;asm("v_add_f32_e32 %0, %1, %2":"=v"(r):"v"(a),"v"(b));return r;}
__device__ __forceinline__ float fsub_s(float a,float b){float r;asm("v_sub_f32_e32 %0, %1, %2":"=v"(r):"v"(a),"v"(b));return r;}
typedef float f32x2_t __attribute__((ext_vector_type(2))); typedef __bf16 bf16x2_t __attribute__((ext_vector_type(2)));
__device__ __forceinline__ unsigned cvtpk_s(float lo,float hi){f32x2_t v={lo,hi};bf16x2_t b=__builtin_convertvector(v,bf16x2_t);return __builtin_bit_cast(unsigned,b);}
#define WAIT_BAR(N) asm volatile("s_waitcnt vmcnt(" #N ") lgkmcnt(0)\n\ts_barrier":::"memory")

__device__ __forceinline__ void qkt(f32x16&p0,f32x16&p1,const char*Kslot,const bf16x8*qr,int r32,int hi){
  const char*kb=Kslot+hi*1024+r32*16;
  #pragma unroll
  for(int d0=0;d0<4;++d0){
    const bf16x8 b0=*reinterpret_cast<const bf16x8*>(kb+d0*2048);
    const bf16x8 b1=*reinterpret_cast<const bf16x8*>(kb+d0*2048+512);
    {p0=__builtin_amdgcn_mfma_f32_32x32x16_bf16(b0,qr[d0],p0,0,0,0);p1=__builtin_amdgcn_mfma_f32_32x32x16_bf16(b1,qr[d0],p1,0,0,0);}}
}
typedef __attribute__((address_space(3))) const char* lds_cptr;
typedef short v4i16_t __attribute__((ext_vector_type(4)));
__device__ __forceinline__ void kload8(bf16x8*kf,lds_cptr kp){
  kf[0]=*(const __attribute__((address_space(3))) bf16x8*)(kp);      kf[1]=*(const __attribute__((address_space(3))) bf16x8*)(kp+512);
  kf[2]=*(const __attribute__((address_space(3))) bf16x8*)(kp+2048); kf[3]=*(const __attribute__((address_space(3))) bf16x8*)(kp+2560);
  kf[4]=*(const __attribute__((address_space(3))) bf16x8*)(kp+4096); kf[5]=*(const __attribute__((address_space(3))) bf16x8*)(kp+4608);
  kf[6]=*(const __attribute__((address_space(3))) bf16x8*)(kp+6144); kf[7]=*(const __attribute__((address_space(3))) bf16x8*)(kp+6656);
}
__device__ __forceinline__ void kload2(bf16x8*kf,lds_cptr kp,int j){ kf[2*j]=*(const __attribute__((address_space(3))) bf16x8*)(kp+j*2048); kf[2*j+1]=*(const __attribute__((address_space(3))) bf16x8*)(kp+j*2048+512); }
__device__ __forceinline__ s16x4 vtr(lds_cptr p){ return __builtin_bit_cast(s16x4,__builtin_amdgcn_ds_read_tr16_b64_v4i16((__attribute__((address_space(3))) v4i16_t*)p)); }
__device__ __forceinline__ float rowmax(const f32x16&p0,const f32x16&p1){
  float a=max3f(p0[0],p0[1],p1[0]),b=max3f(p0[2],p0[3],p1[1]);a=max3f(a,p1[2],p1[3]);
  #pragma unroll
  for(int r=4;r<16;r+=4){a=max3f(a,p0[r],p0[r+1]);b=max3f(b,p0[r+2],p0[r+3]);a=max3f(a,p1[r],p1[r+1]);b=max3f(b,p1[r+2],p1[r+3]);}
  const float m=max2f(a,b);
  auto rr=__builtin_amdgcn_permlane32_swap(__float_as_uint(m),__float_as_uint(m),false,false);
  return max2f(__uint_as_float(rr[0]),__uint_as_float(rr[1]));
}
__device__ __forceinline__ void pv(f32x16*o,int vb,bf16x8 pa0,bf16x8 pa1,bf16x8 pa2,bf16x8 pa3){
  #pragma unroll
  for(int d0=0;d0<2;++d0){s16x4 lo[4],hi[4];
    #pragma unroll
    for(int ks=0;ks<4;++ks){
      asm volatile("ds_read_b64_tr_b16 %0,%1 offset:%c2":"=&v"(lo[ks]):"v"(vb),"i"(d0*4096+ks*1024):"memory");
      asm volatile("ds_read_b64_tr_b16 %0,%1 offset:%c2":"=&v"(hi[ks]):"v"(vb),"i"(d0*4096+ks*1024+512):"memory");}
    asm volatile("s_waitcnt lgkmcnt(0)":::"memory");SBAR();
    #define PK(k) (bf16x8){lo[k][0],lo[k][1],lo[k][2],lo[k][3],hi[k][0],hi[k][1],hi[k][2],hi[k][3]}
    o[d0]=__builtin_amdgcn_mfma_f32_32x32x16_bf16(pa0,PK(0),o[d0],0,0,0);
    o[d0]=__builtin_amdgcn_mfma_f32_32x32x16_bf16(pa1,PK(1),o[d0],0,0,0);
    o[d0]=__builtin_amdgcn_mfma_f32_32x32x16_bf16(pa2,PK(2),o[d0],0,0,0);
    o[d0]=__builtin_amdgcn_mfma_f32_32x32x16_bf16(pa3,PK(3),o[d0],0,0,0);
    #undef PK
  }
}

typedef __attribute__((address_space(3))) const f32x4v* lds_f4ptr;
__device__ __forceinline__ void fill_bias(f32x16&c0,f32x16&c1,lds_cptr cb,float negmh){
  #pragma unroll
  for(int g=0;g<4;++g){ const f32x4v v=*(lds_f4ptr)(cb+g*32), w=*(lds_f4ptr)(cb+128+g*32);
    #pragma unroll
    for(int i=0;i<4;i+=2){ const f32x2_t nm={negmh,negmh}; const f32x2_t a=nm-(f32x2_t){v[i],v[i+1]}, b=nm-(f32x2_t){w[i],w[i+1]}; c0[4*g+i]=a.x; c0[4*g+i+1]=a.y; c1[4*g+i]=b.x; c1[4*g+i+1]=b.y; } }
}
#ifndef ATTN_STORE16
#define ATTN_STORE16(p,v) (*(u32x4*)(p)=(v))
#endif
template<int THRL,bool FOX,int KP> __device__ __forceinline__ void attn_unit(int b,int h,int qb,const bf16*Q,const bf16*__restrict__ K,const bf16*__restrict__ V,bf16*O,const float*__restrict__ Cb,float sink2,char*shm){
  int tid_=threadIdx.x; asm volatile("":"+v"(tid_));
  const int tid=tid_,lane=tid&63,r32=lane&31,hi=lane>>5; const int wid=__builtin_amdgcn_readfirstlane(tid>>6);
  const long rowbase=(long)b*SEQ; const int q0=qb*QB;
  const bf16*Qw=Q+(rowbase+q0+wid*QBLK)*DM+h*D;
  const int kvh=FOX?h:(h>>3); const int T0=FOX?0:(qb==0?0:4*qb-2);
  const bf16*Kh=K+(rowbase+(long)T0*KVBLK)*KP+kvh*D,*Vh=V+(rowbase+(long)T0*KVBLK)*KP+kvh*D; const float*Cs=FOX?Cb+lane:nullptr;
  const unsigned lds0=(unsigned)(uintptr_t)shm;
  float*wsf=(float*)(shm+LDS_WS)+wid*64;
  const bf16*ksrc=Kh+(long)lane*KP+wid*8;
  const bf16*vsrc=Vh+(long)(16*(wid&3)+(lane>>2))*KP+(wid>>2)*32+(lane&3)*8;
  const unsigned kdst=lds0+LDS_K+wid*1024, vdst=lds0+LDS_V+wid*1024;
  #define DMA_K(t,slot) glds16(ksrc+(long)(t)*KVBLK*KP,(unsigned)__builtin_amdgcn_readfirstlane(kdst+(slot)))
  #define DMA_C(t) do{ if(FOX) glds4(Cs+(long)(t)*KVBLK,(unsigned)__builtin_amdgcn_readfirstlane(lds0+LDS_CB+(((t)&3)<<8))); }while(0)
  #define PREFILL(X0,X1,t) do{ if(FOX){ fill_bias(X0,X1,cb0+(((t)&3)<<8),-mhat); } else { _Pragma("unroll") for(int r=0;r<16;++r){X0[r]=-mhat;X1[r]=-mhat;} } }while(0)
  #define DMA_V(t,slot) glds16(vsrc+(long)(t)*KVBLK*KP,(unsigned)__builtin_amdgcn_readfirstlane(vdst+(slot)))
  const int vb0=(int)(lds0+LDS_V)+((lane>>4)&1)*32+(lane&3)*8+(4*hi+((lane&15)>>2))*64;
  const char*Kbase=shm+LDS_K; bf16x8 kf[8];
  const lds_cptr shm3=(lds_cptr)shm; const lds_cptr cb0=shm3+LDS_CB+hi*16; const lds_cptr kp0=shm3+LDS_K+hi*1024+r32*16; const lds_cptr vp0=shm3+LDS_V+((lane>>4)&1)*32+(lane&3)*8+(4*hi+((lane&15)>>2))*64;
  const int NT=FOX?(q0+QB)/KVBLK:(qb==0?4:6);
  DMA_K(0,0);DMA_C(0);DMA_V(0,0);DMA_K(1,SLOTB);DMA_C(1);
  bf16x8 qr[4];
  #pragma unroll
  for(int d0=0;d0<4;++d0)qr[d0]=*reinterpret_cast<const bf16x8*>(&Qw[(long)r32*DM+d0*16+hi*8]);
  float mhat=FOX?-Cb[q0+wid*QBLK+r32]:0.f,l_reg=0.f;    f32x16 o[2];o[0]=f32x16{};o[1]=f32x16{};
  const int qrel=wid*QBLK+r32;
  #define CMASK(P0,P1,t) do{int jb_=(t)-(NT-4); if(!FOX||jb_>=0)cmask<!FOX>(P0,P1,jb_,qrel,hi);}while(0)
  bool resc=false;
  #define START(P0,P1) do{ float rm=__builtin_fmaxf(rowmax(P0,P1),0.f); resc=false;     \
    { const float dl=rm; mhat=fadd_s(mhat,dl); \
      _Pragma("unroll") for(int r=0;r<16;++r){P0[r]=fsub_s(P0[r],dl);P1[r]=fsub_s(P1[r],dl);} } \
    _Pragma("unroll") for(int r=0;r<16;++r)P0[r]=__builtin_amdgcn_exp2f(P0[r]); }while(0)
  #define RESC() do{ if(resc){ asm volatile("s_waitcnt lgkmcnt(0)":::"memory"); \
      _Pragma("unroll") for(int d_=0;d_<2;++d_) _Pragma("unroll") for(int r=0;r<16;++r)o[d_][r]*=wsf[crow(r,hi)]; } }while(0)
  f32x16 pA0,pA1,pB0,pB1;
  int sl_prev=0,sl_cur=0,sl_next=SLOTB;
  #define ROT() do{sl_prev=sl_cur;sl_cur=sl_next;sl_next=(sl_next==(NSLOT-1)*SLOTB)?0:sl_next+SLOTB;}while(0)
  DMA_K(2,2*SLOTB);DMA_C(2);
  if(FOX){WAIT_BAR(5);}else{WAIT_BAR(3);}
  PREFILL(pA0,pA1,0); qkt(pA0,pA1,Kbase,qr,r32,hi);asm volatile("s_nop 15\n\ts_nop 7":"+v"(pA0),"+v"(pA1));CMASK(pA0,pA1,0);
  START(pA0,pA1);
  _Pragma("unroll") for(int r=0;r<16;++r)pA1[r]=__builtin_amdgcn_exp2f(pA1[r]);
  WAIT_BAR(0);
  DMA_K(3,0);DMA_C(3);DMA_V(1,SLOTB);
  ROT();
  kload8(kf,kp0+sl_cur);
  PREFILL(pB0,pB1,1); if(FOX){ WAIT_BAR(3); }else{ WAIT_BAR(2); }
  s16x4 vlo[NVB],vhi[NVB]; u32x4 pw0,pw1,pw2,pw3;
  #define PKW(P,B) cvtpk_s(P[B],P[B+1])
  #define PAF(k) __builtin_bit_cast(bf16x8,pw##k)
  #define VFR(j) (bf16x8){vlo[(j)%NVB][0],vlo[(j)%NVB][1],vlo[(j)%NVB][2],vlo[(j)%NVB][3],vhi[(j)%NVB][0],vhi[(j)%NVB][1],vhi[(j)%NVB][2],vhi[(j)%NVB][3]}
  #define PIN(x) asm volatile("":"+v"(x))
  #define MX3(a,b,c) __builtin_fmaxf(__builtin_fmaxf((a),(b)),(c))
  #define GAPA(MF,A0,A1,A2,A3,W0,W1,PW) do{ MF; sacc+=(f32x2_t){A0,A1}; sacc+=(f32x2_t){A2,A3}; PIN(sacc); W0; W1; PIN(PW); SBAR(); }while(0)
  #define EX(v) __builtin_amdgcn_exp2f(v)
  #define GAPB(MF,VR,BX_,X,B) do{ MF; VR; BX_; X[B]=EX(X[B]); X[B+1]=EX(X[B+1]); X[B+2]=EX(X[B+2]); X[B+3]=EX(X[B+3]); PIN(X); SBAR(); }while(0)
  #define VOFF(j) ((((j)&1)*4096)+(((j)>>1)*1024))
  #define VRD(j) do{ if((j)>=0&&(j)<8){ vlo[(j)%NVB]=vtr(vp_+VOFF(j)); vhi[(j)%NVB]=vtr(vp_+VOFF(j)+512); } }while(0)
  #define KRD(G,j) do{ if(G){ kload2(kf,kp0+sl_next,j); SBAR(); } }while(0)
  #define BSUBX(X,g) do{ const f32x2_t nm_={nmh_,nmh_}; const f32x2_t a_=nm_-(f32x2_t){bt[0],bt[1]}, b_=nm_-(f32x2_t){bt[2],bt[3]}; X[4*(g)+0]=a_.x; X[4*(g)+1]=a_.y; X[4*(g)+2]=b_.x; X[4*(g)+3]=b_.y; }while(0)
  #define BXX(Y0,Y1,j,G) do{ if(FOX&&(G)){ if((j)>=1&&(j)<=4){BSUBX(Y0,((j)-1)&3);} if((j)>=5){BSUBX(Y1,((j)-5)&3);} if((j)<8){ bt=*(lds_f4ptr)(cbn_+(((j)&3)*32+((j)>>2)*128)); } } }while(0)
  #define STEP(C0,C1,P0,P1,t,GK,GV,GL) do{ SBAR(); f32x4v bt; const lds_cptr cbn_=cb0+((((t)+1)&3)<<8); \
    const lds_cptr vp_=vp0+sl_prev; \
    VRD(0-(8-NVB)); SBAR(); f32x2_t sacc={P0[0],P0[1]}; \
    GAPA(C0=__builtin_amdgcn_mfma_f32_32x32x16_bf16(kf[0],qr[0],C0,0,0,0), P0[2],P0[3],P0[4],P0[5],     pw0[0]=PKW(P0,0), pw0[1]=PKW(P0,2), pw0); \
    VRD(1-(8-NVB)); SBAR(); GAPA(C1=__builtin_amdgcn_mfma_f32_32x32x16_bf16(kf[1],qr[0],C1,0,0,0), P0[6],P0[7],P0[8],P0[9],     pw0[2]=PKW(P0,4), pw0[3]=PKW(P0,6), pw0); \
    VRD(2-(8-NVB)); SBAR(); GAPA(C0=__builtin_amdgcn_mfma_f32_32x32x16_bf16(kf[2],qr[1],C0,0,0,0),   P0[10],P0[11],P0[12],P0[13], pw1[0]=PKW(P0,8), pw1[1]=PKW(P0,10), pw1); \
    VRD(3-(8-NVB)); SBAR(); GAPA(C1=__builtin_amdgcn_mfma_f32_32x32x16_bf16(kf[3],qr[1],C1,0,0,0),   P0[14],P0[15],P1[0],P1[1],   pw1[2]=PKW(P0,12),pw1[3]=PKW(P0,14), pw1); \
    VRD(4-(8-NVB)); SBAR(); GAPA(C0=__builtin_amdgcn_mfma_f32_32x32x16_bf16(kf[4],qr[2],C0,0,0,0),   P1[2],P1[3],P1[4],P1[5],     pw2[0]=PKW(P1,0), pw2[1]=PKW(P1,2), pw2); \
    VRD(5-(8-NVB)); SBAR(); GAPA(C1=__builtin_amdgcn_mfma_f32_32x32x16_bf16(kf[5],qr[2],C1,0,0,0),   P1[6],P1[7],P1[8],P1[9],     pw2[2]=PKW(P1,4), pw2[3]=PKW(P1,6), pw2); \
    VRD(6-(8-NVB)); SBAR(); GAPA(C0=__builtin_amdgcn_mfma_f32_32x32x16_bf16(kf[6],qr[3],C0,0,0,0),   P1[10],P1[11],P1[12],P1[13], pw3[0]=PKW(P1,8), pw3[1]=PKW(P1,10), pw3); \
    VRD(7-(8-NVB)); SBAR(); GAPA(C1=__builtin_amdgcn_mfma_f32_32x32x16_bf16(kf[7],qr[3],C1,0,0,0),   P1[14],P1[15],0.f,0.f,       pw3[2]=PKW(P1,12),pw3[3]=PKW(P1,14), pw3); \
    l_reg+=sacc.x+sacc.y; \
    if(GK){DMA_K((t)+3,sl_cur);DMA_C((t)+3);} if(GV){DMA_V((t)+1,sl_next);} \
    CMASK(C0,C1,t); \
    { float a=MX3(C0[0],C0[1],C1[0]),b=MX3(C0[2],C0[3],C1[1]); a=MX3(a,C1[2],C1[3]); \
      _Pragma("unroll") for(int r=4;r<16;r+=4){a=MX3(a,C0[r],C0[r+1]);b=MX3(b,C0[r+2],C0[r+3]);a=MX3(a,C1[r],C1[r+1]);b=MX3(b,C1[r+2],C1[r+3]);} \
      float rm=__builtin_fmaxf(a,b); { auto rr=__builtin_amdgcn_permlane32_swap(__float_as_uint(rm),__float_as_uint(rm),false,false); rm=__builtin_fmaxf(__uint_as_float(rr[0]),__uint_as_float(rr[1])); } \
      resc=false; \
      if(__builtin_expect(__any(rm>(float)THRL),0)){ const float dl=__builtin_fmaxf(rm,0.f); mhat+=dl; \
        _Pragma("unroll") for(int r=0;r<16;++r){C0[r]-=dl;C1[r]-=dl;} \
        const float f=__builtin_amdgcn_exp2f(-dl); l_reg*=f; if(hi==0)wsf[r32]=f; resc=true; } } \
    const float nmh_=-mhat; SBAR(); \
    GAPB(o[0]=__builtin_amdgcn_mfma_f32_32x32x16_bf16(PAF(0),VFR(0),o[0],0,0,0), VRD(0+NVB), BXX(P0,P1,0,GL), C0,0); \
    GAPB(o[1]=__builtin_amdgcn_mfma_f32_32x32x16_bf16(PAF(0),VFR(1),o[1],0,0,0), VRD(1+NVB), BXX(P0,P1,1,GL), C0,4); \
    KRD(GL,0); GAPB(o[0]=__builtin_amdgcn_mfma_f32_32x32x16_bf16(PAF(1),VFR(2),o[0],0,0,0), VRD(2+NVB), BXX(P0,P1,2,GL), C0,8); \
    KRD(GL,1); GAPB(o[1]=__builtin_amdgcn_mfma_f32_32x32x16_bf16(PAF(1),VFR(3),o[1],0,0,0), VRD(3+NVB), BXX(P0,P1,3,GL), C0,12); \
    KRD(GL,2); GAPB(o[0]=__builtin_amdgcn_mfma_f32_32x32x16_bf16(PAF(2),VFR(4),o[0],0,0,0), VRD(4+NVB), BXX(P0,P1,4,GL), C1,0); \
    KRD(GL,3); GAPB(o[1]=__builtin_amdgcn_mfma_f32_32x32x16_bf16(PAF(2),VFR(5),o[1],0,0,0), VRD(5+NVB), BXX(P0,P1,5,GL), C1,4); \
    GAPB(o[0]=__builtin_amdgcn_mfma_f32_32x32x16_bf16(PAF(3),VFR(6),o[0],0,0,0), VRD(6+NVB), BXX(P0,P1,6,GL), C1,8); \
    GAPB(o[1]=__builtin_amdgcn_mfma_f32_32x32x16_bf16(PAF(3),VFR(7),o[1],0,0,0), VRD(7+NVB), BXX(P0,P1,7,GL), C1,12); \
    BXX(P0,P1,8,GL); if(!FOX&&(GL)){ PREFILL(P0,P1,(t)+1); } \
    }while(0)
  int t=1;
  #undef CMASK
  #define CMASK(P0,P1,t) do{}while(0)
  for(;t+5<NT;t+=2){
    STEP(pB0,pB1,pA0,pA1,t,true,true,true);     if(FOX){WAIT_BAR(3);}else{WAIT_BAR(2);} RESC(); ROT();
    STEP(pA0,pA1,pB0,pB1,t+1,true,true,true);   if(FOX){WAIT_BAR(3);}else{WAIT_BAR(2);} RESC(); ROT();
  }
  #undef CMASK
  #define CMASK(P0,P1,t) do{int jb_=(t)-(NT-4); if(!FOX||jb_>=0)cmask<!FOX>(P0,P1,jb_,qrel,hi);}while(0)
  #define ENDW(tt) do{ if((tt)+3<NT){ if(FOX){WAIT_BAR(3);}else{WAIT_BAR(2);} } else if((tt)+2<NT){WAIT_BAR(1);} else {WAIT_BAR(0);} }while(0)
  for(;t+1<NT;t+=2){
    STEP(pB0,pB1,pA0,pA1,t,(t+3<NT),(t+1<NT),(t+1<NT));       ENDW(t);   RESC(); ROT();
    STEP(pA0,pA1,pB0,pB1,t+1,(t+4<NT),(t+2<NT),(t+2<NT));     ENDW(t+1); RESC(); ROT();
  }
  STEP(pB0,pB1,pA0,pA1,NT-1,false,false,false); RESC();
  { float sacc=pB0[0]+pB0[1]; _Pragma("unroll") for(int r=2;r<16;++r)sacc+=pB0[r]; _Pragma("unroll") for(int r=0;r<16;++r)sacc+=pB1[r]; l_reg+=sacc;
    pw0=(u32x4){PKW(pB0,0),PKW(pB0,2),PKW(pB0,4),PKW(pB0,6)};pw1=(u32x4){PKW(pB0,8),PKW(pB0,10),PKW(pB0,12),PKW(pB0,14)};pw2=(u32x4){PKW(pB1,0),PKW(pB1,2),PKW(pB1,4),PKW(pB1,6)};pw3=(u32x4){PKW(pB1,8),PKW(pB1,10),PKW(pB1,12),PKW(pB1,14)};
    SBAR(); pv(o,vb0+sl_cur,PAF(0),PAF(1),PAF(2),PAF(3)); }
  #undef PKW
  #undef PAF
  #undef VFR
  #undef PIN
  #undef MX3
  #undef GAPA
  #undef GAPB
  #undef EX
  #undef VRD
  #undef VOFF
  #undef KRD
  #undef STEP
  #undef ENDW
  {auto rr=__builtin_amdgcn_permlane32_swap(__float_as_uint(l_reg),__float_as_uint(l_reg),false,false);l_reg=__uint_as_float(rr[0])+__uint_as_float(rr[1]);}
  if(!FOX) l_reg+=__builtin_amdgcn_exp2f(sink2-mhat);
  if(hi==0)wsf[32+r32]=l_reg;asm volatile("s_waitcnt lgkmcnt(0)":::"memory");
  float rli[16];
  #pragma unroll
  for(int r=0;r<16;++r)rli[r]=__builtin_amdgcn_rcpf(wsf[32+crow(r,hi)]);
  bf16*Ow=O+(rowbase+q0+wid*QBLK)*DM+h*D;
  { bf16*stg=(bf16*)(shm+LDS_OST)+wid*2048;
    #pragma unroll
    for(int r=0;r<16;++r){const int orow=crow(r,hi);
      #pragma unroll
      for(int d0=0;d0<2;++d0)stg[orow*64+d0*32+r32]=(bf16)(cvtpk_s(o[d0][r]*rli[r],0.f)&0xffffu);}
    asm volatile("s_waitcnt lgkmcnt(0)":::"memory");
    #pragma unroll
    for(int i=0;i<4;++i){const int row=i*8+(lane>>3),ch=lane&7; const u32x4 v=*(const u32x4*)(stg+row*64+ch*8); ATTN_STORE16(Ow+(long)row*DM+ch*8,v);} }
  asm volatile("s_waitcnt lgkmcnt(0)\n\ts_barrier":::"memory");
  #undef DMA_K
  #undef DMA_V
  #undef DMA_C
  #undef PREFILL
  #undef BSUBX
  #undef BXX
  #undef CMASK
  #undef START
  #undef RESC
  #undef ROT
}
constexpr int ATTN_LDS_BYTES=LDS_BYTES;
#undef SBAR
#undef WAIT_BAR
}

#ifndef REP_PHASE
#define REP_PHASE 0
#endif
#ifndef FUSED_FINAL
#define FUSED_FINAL 0
#endif
#ifndef NAIVE_SWA
#define NAIVE_SWA 0
#endif
#ifndef NAIVE_FOX
#define NAIVE_FOX 0
#endif
#define LAS __attribute__((address_space(3)))
typedef unsigned short bf16;
typedef float f32x4 __attribute__((ext_vector_type(4)));
typedef unsigned v4u __attribute__((ext_vector_type(4)));
typedef unsigned v2u __attribute__((ext_vector_type(2)));
constexpr int NWAVES = 8;
constexpr int RING_BYTES = 131072, LDS_BYTES = 147456;

__device__ __forceinline__ float wave_sum(float v) {
#pragma unroll
    for (int o = 1; o < 64; o <<= 1) v += __shfl_xor(v, o);
    return v;
}
#define LDS_WAIT() asm volatile("s_waitcnt lgkmcnt(0)" ::: "memory")

__device__ __forceinline__ void tr_item(const float* W, int K, int N, bf16* WT, int dst_row0, int src_col0, int nvalid, int kb, const float* kscale, LAS float* scr, int lane) {
    const int k0 = 64 * kb, c = lane & 31;
    float tv[32];
    const float* wp = W + (size_t)(k0 + (lane >> 5)) * N + src_col0 + c;
#pragma unroll
    for (int i = 0; i < 32; ++i) { tv[i] = 0.f; if (c < nvalid) tv[i] = __builtin_nontemporal_load(wp + (size_t)(2 * i) * N); }
#pragma unroll
    for (int i = 0; i < 32; ++i) { const int kk = 2 * i + (lane >> 5); float v = tv[i]; if (kscale) v *= kscale[k0 + kk]; scr[kk * 33 + c] = v; }
    LDS_WAIT(); asm volatile("" ::: "memory");
    const int ch = lane & 7;
#pragma unroll
    for (int j = 0; j < 4; ++j) { const int n = (lane >> 3) + 8 * j; const LAS float* s = scr + (8 * ch) * 33 + n;
        v4u o; o.x = pg8::cvt_pk_bf16(s[0 * 33], s[1 * 33]); o.y = pg8::cvt_pk_bf16(s[2 * 33], s[3 * 33]); o.z = pg8::cvt_pk_bf16(s[4 * 33], s[5 * 33]); o.w = pg8::cvt_pk_bf16(s[6 * 33], s[7 * 33]);
        *(v4u*)(WT + (size_t)(dst_row0 + n) * K + k0 + 8 * ch) = o; }
    LDS_WAIT(); asm volatile("" ::: "memory");
}
__device__ __forceinline__ void win_map(int db, int& src, int& nv) {
    const int pn = db >> 3, bj = (db >> 2) & 1, wc = db & 3; nv = 32;
    if (pn < 4) src = (4 * pn + wc) * 64 + 32 * bj;
    else if (pn == 4) src = (wc < 2 ? 1024 + wc * 64 : 1152 + (wc - 2) * 64) + 32 * bj;
    else if (pn < 17) { const int t = pn - 5; src = 1280 + (t >> 2) * 1024 + (4 * (t & 3) + wc) * 64 + 32 * bj; }
    else if (pn < 33) src = 4368 + (db - 136) * 32;
    else { src = 4352; nv = (db == 264) ? 16 : 0; }
}

struct Args { const float* x; const int* pos; const float* attn_norm; const float* w_in; const float* fbias; const float* sinks; const float* w_bs; const float* w_bf;
              const float* w_out; const float* mlp_norm; const float* w_up; const float* w_dn; const float* final_norm; float* out; unsigned char* ws; long long fused_final; };

__device__ __forceinline__ void rms_row_to_bf16(const float* xrow, const float* gain, bf16* orow, int lane) {
    const f32x4* xr = (const f32x4*)xrow + lane; f32x4 v[8]; float s = 0.f;
#pragma unroll
    for (int j = 0; j < 8; ++j) { v[j] = xr[64 * j]; s += (v[j].x * v[j].x + v[j].y * v[j].y) + (v[j].z * v[j].z + v[j].w * v[j].w); }
    const float rstd = __builtin_amdgcn_rsqf(wave_sum(s) * (1.f / DM) + RMS_EPS);
    const f32x4* gr = (const f32x4*)gain + lane; v2u* o8 = (v2u*)orow + lane;
#pragma unroll
    for (int j = 0; j < 8; ++j) { const f32x4 g = gr[64 * j]; v2u w; w.x = pg8::cvt_pk_bf16(v[j].x * rstd * g.x, v[j].y * rstd * g.y); w.y = pg8::cvt_pk_bf16(v[j].z * rstd * g.z, v[j].w * rstd * g.w); o8[64 * j] = w; }
}

__device__ __forceinline__ void rms_row2_to_bf16(const float* x0, const float* x1, const float* gain, bf16* o0, bf16* o1, int lane) {
    const f32x4* xr0 = (const f32x4*)x0 + lane; const f32x4* xr1 = (const f32x4*)x1 + lane; f32x4 v[8], w[8]; float s = 0.f, t = 0.f;
#pragma unroll
    for (int j = 0; j < 8; ++j) { v[j] = __builtin_nontemporal_load(xr0 + 64 * j); w[j] = __builtin_nontemporal_load(xr1 + 64 * j); }
#pragma unroll
    for (int j = 0; j < 8; ++j) { s += (v[j].x * v[j].x + v[j].y * v[j].y) + (v[j].z * v[j].z + v[j].w * v[j].w); t += (w[j].x * w[j].x + w[j].y * w[j].y) + (w[j].z * w[j].z + w[j].w * w[j].w); }
    const float rs = __builtin_amdgcn_rsqf(wave_sum(s) * (1.f / DM) + RMS_EPS), rt = __builtin_amdgcn_rsqf(wave_sum(t) * (1.f / DM) + RMS_EPS);
    const f32x4* gr = (const f32x4*)gain + lane; v2u* p0 = (v2u*)o0 + lane; v2u* p1 = (v2u*)o1 + lane;
#pragma unroll
    for (int j = 0; j < 8; ++j) { const f32x4 g = gr[64 * j]; v2u a, c;
        a.x = pg8::cvt_pk_bf16(v[j].x * rs * g.x, v[j].y * rs * g.y); a.y = pg8::cvt_pk_bf16(v[j].z * rs * g.z, v[j].w * rs * g.w);
        c.x = pg8::cvt_pk_bf16(w[j].x * rt * g.x, w[j].y * rt * g.y); c.y = pg8::cvt_pk_bf16(w[j].z * rt * g.z, w[j].w * rt * g.w);
        p0[64 * j] = a; p1[64 * j] = c; }
}
__device__ __forceinline__ void p0_prologue(const Args& a, LAS unsigned char* lds, int vcu, int G, int wave, int lane) {
    unsigned char* ws = a.ws;
    LAS float* scr = (LAS float*)(lds + wave * 16384);
    const int gw = vcu * NWAVES + wave, NGW = G * NWAVES;
    constexpr int I_IN = (NIN / 32) * (DM / 64), I_BS = (DM / 32) * (1024 / 64), I_OUT = (DM / 32) * (DM / 64), I_UP = (DFF / 32) * (DM / 64), I_DN = (DM / 32) * (DFF / 64);
    constexpr int NITEMS = I_IN + 2 * I_BS + I_OUT + I_UP + I_DN;
    for (int it = gw; it < NITEMS; it += NGW) {
        int r = it;
        if (r < I_IN) { const int db = r / (DM / 64), kb = r % (DM / 64); int src, nv; win_map(db, src, nv); tr_item(a.w_in, DM, DIN, (bf16*)(ws + WS_WIN), db * 32, src, nv, kb, nullptr, scr, lane); continue; } r -= I_IN;
        if (r < I_BS) { const int db = r / 16, kb = r % 16; tr_item(a.w_bs, 1024, DM, (bf16*)(ws + WS_WBS), db * 32, db * 32, 32, kb, nullptr, scr, lane); continue; } r -= I_BS;
        if (r < I_BS) { const int db = r / 16, kb = r % 16; tr_item(a.w_bf, 1024, DM, (bf16*)(ws + WS_WBF), db * 32, db * 32, 32, kb, nullptr, scr, lane); continue; } r -= I_BS;
        if (r < I_OUT) { const int db = r / 32, kb = r % 32; tr_item(a.w_out, DM, DM, (bf16*)(ws + WS_WOUT), db * 32, db * 32, 32, kb, nullptr, scr, lane); continue; } r -= I_OUT;
        if (r < I_UP) { const int db = r / 32, kb = r % 32; tr_item(a.w_up, DM, DFF, (bf16*)(ws + WS_WUP), db * 32, db * 32, 32, kb, a.mlp_norm, scr, lane); continue; } r -= I_UP;
        { const int db = r / 128, kb = r % 128; tr_item(a.w_dn, DFF, DM, (bf16*)(ws + WS_WDN), db * 32, db * 32, 32, kb, nullptr, scr, lane); }
    }
    for (int m = gw; m < M; m += 2 * NGW) rms_row2_to_bf16(a.x + (size_t)m * DM, a.x + (size_t)(m + NGW) * DM, a.attn_norm, (bf16*)(ws + WS_XN) + (size_t)m * DM, (bf16*)(ws + WS_XN) + (size_t)(m + NGW) * DM, lane);
    float* cs = (float*)(ws + WS_CS);
    for (int e = gw * 64 + lane; e < M * 32; e += NGW * 64) {
        const int tok = e >> 5, i = e & 31;
        const float inv_freq = powf(10000.0f, -(float)(2 * i) / 64.0f);
        const float ang = (float)a.pos[tok] * inv_freq;
        double rev = (double)ang * 0.15915494309189535; rev -= floor(rev);
        const float rf = (float)rev;
        cs[e] = __builtin_amdgcn_cosf(rf); cs[(size_t)M * 32 + e] = __builtin_amdgcn_sinf(rf);
    }
}

__device__ __forceinline__ void cumsum_unit(const Args& a, int bh, LAS unsigned char* lds) {
    const float* FL = (const float*)(a.ws + WS_FL); float* Cp = (float*)(a.ws + WS_C);
    LAS double* sh = (LAS double*)lds;
    const int b = bh >> 4, h = bh & 15, tid = threadIdx.x, s0 = tid * 16; const float fb = a.fbias[h];
    float ls[16]; double run = 0.0;
#pragma unroll
    for (int i = 0; i < 16; ++i) { const float z = FL[(size_t)(b * SEQ + s0 + i) * 16 + h] + fb; const float v = fminf(z, 0.f) - log1pf(expf(-fabsf(z))); ls[i] = v; run += (double)v; }
    sh[tid] = run; __syncthreads();
    double pre = 0.0; for (int k = 0; k < tid; ++k) pre += sh[k];
#pragma unroll
    for (int i = 0; i < 16; ++i) { pre += (double)ls[i]; Cp[(size_t)bh * SEQ + s0 + i] = (float)(pre * 1.4426950408889634); }
    __syncthreads();
}

__device__ __forceinline__ void naive_swa_unit(const Args& a, int unit) {
    const bf16* AQ = (const bf16*)(a.ws + WS_AQ); const bf16* AK = (const bf16*)(a.ws + WS_AK); const bf16* AV = (const bf16*)(a.ws + WS_AV); bf16* OA = (bf16*)(a.ws + WS_OA);
    const int tid = threadIdx.x, head = tid & 15, tok = unit * 32 + (tid >> 4), b = tok / SEQ, s = tok % SEQ, kvh = head >> 3;
    float q[64], o[64]; float m = -INFINITY, l = 0.f;
    { const v4u* qp = (const v4u*)(AQ + (size_t)tok * 1024 + head * 64);
#pragma unroll
      for (int c = 0; c < 8; ++c) { const v4u w = qp[c];
#pragma unroll
          for (int e = 0; e < 4; ++e) { q[8 * c + 2 * e] = pg8::bf_lo(w[e]); q[8 * c + 2 * e + 1] = pg8::bf_hi(w[e]); } } }
#pragma unroll
    for (int d = 0; d < 64; ++d) o[d] = 0.f;
    for (int i = 0; i < 128; ++i) {
        const int j = s - i; const bool valid = j >= 0; const int jj = valid ? j : 0;
        const v4u* kp = (const v4u*)(AK + (size_t)(b * SEQ + jj) * 128 + kvh * 64); const v4u* vp = (const v4u*)(AV + (size_t)(b * SEQ + jj) * 128 + kvh * 64);
        float dot = 0.f;
#pragma unroll
        for (int c = 0; c < 8; ++c) { const v4u w = kp[c];
#pragma unroll
            for (int e = 0; e < 4; ++e) { dot += q[8 * c + 2 * e] * pg8::bf_lo(w[e]); dot += q[8 * c + 2 * e + 1] * pg8::bf_hi(w[e]); } }
        const float lg = valid ? dot : -INFINITY;
        const float mn = fmaxf(m, lg), al = __builtin_amdgcn_exp2f(m - mn), p = __builtin_amdgcn_exp2f(lg - mn);
        l = l * al + p; m = mn;
#pragma unroll
        for (int c = 0; c < 8; ++c) { const v4u w = vp[c];
#pragma unroll
            for (int e = 0; e < 4; ++e) { o[8 * c + 2 * e] = o[8 * c + 2 * e] * al + p * pg8::bf_lo(w[e]); o[8 * c + 2 * e + 1] = o[8 * c + 2 * e + 1] * al + p * pg8::bf_hi(w[e]); } }
    }
    { const float sk = a.sinks[head] * LOG2E; const float m2 = fmaxf(m, sk), al = __builtin_amdgcn_exp2f(m - m2); l = l * al + __builtin_amdgcn_exp2f(sk - m2);
      const float rl = al / l;
      v4u* op = (v4u*)(OA + (size_t)tok * 1024 + head * 64);
#pragma unroll
      for (int c = 0; c < 8; ++c) { v4u w;
#pragma unroll
          for (int e = 0; e < 4; ++e) w[e] = pg8::cvt_pk_bf16(o[8 * c + 2 * e] * rl, o[8 * c + 2 * e + 1] * rl);
          op[c] = w; } }
}
__device__ __forceinline__ void naive_fox_unit(const Args& a, int bh, int qblk) {
    const bf16* FQ = (const bf16*)(a.ws + WS_FQ); const bf16* FK = (const bf16*)(a.ws + WS_FK); const bf16* FV = (const bf16*)(a.ws + WS_FV); bf16* OB = (bf16*)(a.ws + WS_OB);
    const float* Cp = (const float*)(a.ws + WS_C) + (size_t)bh * SEQ;
    const int tid = threadIdx.x, b = bh >> 4, h = bh & 15, s = qblk * 512 + tid; const size_t tok = (size_t)b * SEQ + s;
    float q[64], o[64]; float m = -INFINITY, l = 0.f;
    { const v4u* qp = (const v4u*)(FQ + tok * 1024 + h * 64);
#pragma unroll
      for (int c = 0; c < 8; ++c) { const v4u w = qp[c];
#pragma unroll
          for (int e = 0; e < 4; ++e) { q[8 * c + 2 * e] = pg8::bf_lo(w[e]); q[8 * c + 2 * e + 1] = pg8::bf_hi(w[e]); } } }
#pragma unroll
    for (int d = 0; d < 64; ++d) o[d] = 0.f;
    const float cq = Cp[s];
    const int jend = __builtin_amdgcn_readfirstlane(qblk * 512 + (tid | 63));
    for (int j = 0; j <= jend; ++j) {
        const v4u* kp = (const v4u*)(FK + ((size_t)b * SEQ + j) * 1024 + h * 64); const v4u* vp = (const v4u*)(FV + ((size_t)b * SEQ + j) * 1024 + h * 64);
        float dot = 0.f;
#pragma unroll
        for (int c = 0; c < 8; ++c) { const v4u w = kp[c];
#pragma unroll
            for (int e = 0; e < 4; ++e) { dot += q[8 * c + 2 * e] * pg8::bf_lo(w[e]); dot += q[8 * c + 2 * e + 1] * pg8::bf_hi(w[e]); } }
        float lg = dot + (cq - Cp[j]); lg = (j <= s) ? lg : -INFINITY;
        const float mn = fmaxf(m, lg), al = __builtin_amdgcn_exp2f(m - mn), p = __builtin_amdgcn_exp2f(lg - mn);
        l = l * al + p; m = mn;
#pragma unroll
        for (int c = 0; c < 8; ++c) { const v4u w = vp[c];
#pragma unroll
            for (int e = 0; e < 4; ++e) { o[8 * c + 2 * e] = o[8 * c + 2 * e] * al + p * pg8::bf_lo(w[e]); o[8 * c + 2 * e + 1] = o[8 * c + 2 * e + 1] * al + p * pg8::bf_hi(w[e]); } }
    }
    { const float rl = 1.0f / l; v4u* op = (v4u*)(OB + tok * 1024 + h * 64);
#pragma unroll
      for (int c = 0; c < 8; ++c) { v4u w;
#pragma unroll
          for (int e = 0; e < 4; ++e) w[e] = pg8::cvt_pk_bf16(o[8 * c + 2 * e] * rl, o[8 * c + 2 * e + 1] * rl);
          op[c] = w; } }
}

__global__ void __launch_bounds__(NWAVES * 64, 2) mega_fwd(Args a) {
    extern __shared__ __attribute__((aligned(16))) unsigned char lds_raw[];
    LAS unsigned char* lds = (LAS unsigned char*)lds_raw;
    cg::grid_group grid = cg::this_grid();
    int tid_ = threadIdx.x; asm volatile("" : "+v"(tid_));
    const int tid = tid_, lane = tid & 63, wave = __builtin_amdgcn_readfirstlane(tid >> 6);
    const int G = gridDim.x, bx = blockIdx.x, vcu = (G % 8 == 0) ? (bx % 8) * (G / 8) + bx / 8 : bx;
    unsigned char* ws = a.ws;
    float* SS1 = (float*)(ws + WS_CTL); float* SS2 = SS1 + M;
#define GRID_SYNC() do { asm volatile("s_waitcnt vmcnt(0) lgkmcnt(0)" ::: "memory"); grid.sync(); } while (0)

    for (int rp_ = 0; rp_ < (REP_PHASE == 100 ? 2 : 1); ++rp_) { p0_prologue(a, lds, vcu, G, wave, lane); __syncthreads(); }
    GRID_SYNC();

    {
        pg8::Gemm g{(const bf16*)(ws + WS_XN), (const bf16*)(ws + WS_WIN), nullptr, nullptr, DM};
        pg8::StaticOrder S; S.init(M, NIN, G, bx);
        pg8::EpiIn E{ws};
        for (int rp_ = 0; rp_ < (REP_PHASE == 1 ? 2 : 1); ++rp_) pg8::gemm_phase<pg8::EpiIn, pg8::StaticOrder, true, true>(lds, g, S, E);
    }
    GRID_SYNC();

    for (int u = bx; u < 64; u += G) cumsum_unit(a, u, lds);
#if NAIVE_SWA
    for (int u = bx; u < M / 32; u += G) naive_swa_unit(a, u);
#else
    for (int rp_ = 0; rp_ < (REP_PHASE == 2 ? 2 : 1); ++rp_)
    for (int u = vcu; u < 2048; u += G) { const int bh = u >> 5, qb = u & 31, b_ = bh >> 4, h_ = bh & 15;
        attn_body::attn_unit<8, false, 128>(b_, h_, qb, (const bf16*)(ws + WS_AQ), (const bf16*)(ws + WS_AK), (const bf16*)(ws + WS_AV), (bf16*)(ws + WS_OA), nullptr, a.sinks[h_] * LOG2E, (char*)lds_raw); }
#endif
    GRID_SYNC();

#if NAIVE_FOX
    for (int u = bx; u < 1024; u += G) { const int r = u >> 6, i = r >> 2, hi4 = r & 3, qblk = (i & 1) ? 4 * i + 3 - hi4 : 4 * i + hi4; naive_fox_unit(a, u & 63, qblk); }
#else
    for (int rp_ = 0; rp_ < (REP_PHASE == 3 ? 2 : 1); ++rp_)
    for (int e = vcu; e < 2048; e += G) { const int cuv = e & 255, i = e >> 8, bh = (cuv >> 3) + 32 * (i >> 2), s_ = cuv & 7, k_ = i & 3, qb = k_ == 0 ? s_ : (k_ == 1 ? 15 - s_ : (k_ == 2 ? 16 + s_ : 31 - s_));
        attn_body::attn_unit<8, true, 1024>(bh >> 4, bh & 15, qb, (const bf16*)(ws + WS_FQ), (const bf16*)(ws + WS_FK), (const bf16*)(ws + WS_FV), (bf16*)(ws + WS_OB), (const float*)(ws + WS_C) + (size_t)bh * SEQ, 0.f, (char*)lds_raw); }
#endif
    GRID_SYNC();

    {
        pg8::Gemm g{(const bf16*)(ws + WS_OA), (const bf16*)(ws + WS_WBS), (const bf16*)(ws + WS_OB), (const bf16*)(ws + WS_WBF), 1024};
        pg8::PairOrder S; S.s.init(M, DM, G, bx);
        pg8::EpiBranch E{(const unsigned char*)(ws + WS_G), (bf16*)(ws + WS_MG)};
        for (int rp_ = 0; rp_ < (REP_PHASE == 4 ? 2 : 1); ++rp_) pg8::gemm_phase<pg8::EpiBranch, pg8::PairOrder, true, true>(lds, g, S, E);
    }
    GRID_SYNC();

    {
        pg8::Gemm g{(const bf16*)(ws + WS_MG), (const bf16*)(ws + WS_WOUT), nullptr, nullptr, DM};
        pg8::StaticOrder S; S.init(M, DM, G, bx);
        pg8::EpiResB<false> E{a.x, (bf16*)(ws + WS_X1B), SS1};
        pg8::gemm_phase<pg8::EpiResB<false>, pg8::StaticOrder, true, true>(lds, g, S, E);
    }
    GRID_SYNC();

    {
        pg8::Gemm g{(const bf16*)(ws + WS_X1B), (const bf16*)(ws + WS_WUP), nullptr, nullptr, DM};
        pg8::StaticOrder S; S.init(M, DFF, G, bx);
        pg8::EpiUp E{SS1, (bf16*)(ws + WS_U)};
        for (int rp_ = 0; rp_ < (REP_PHASE == 6 ? 2 : 1); ++rp_) pg8::gemm_phase<pg8::EpiUp, pg8::StaticOrder, true, true>(lds, g, S, E);
    }
    GRID_SYNC();

    {
        pg8::Gemm g{(const bf16*)(ws + WS_U), (const bf16*)(ws + WS_WDN), nullptr, nullptr, DFF};
        pg8::StaticOrder S; S.init(M, DM, G, bx);
        pg8::EpiResB<true> E{(const void*)(ws + WS_X1B), (bf16*)(ws + WS_X2B), SS2};
        pg8::gemm_phase<pg8::EpiResB<true>, pg8::StaticOrder, true, true>(lds, g, S, E);
    }
    GRID_SYNC();

    {
        const int gw = vcu * NWAVES + wave, NGW = G * NWAVES;
        for (int m = gw; m < M; m += NGW) {
            const float rstd = __builtin_amdgcn_rsqf(SS2[m] * (1.f / DM) + RMS_EPS);
            f32x4* xr = (f32x4*)(a.out + (size_t)m * DM) + lane; const f32x4* gr = (const f32x4*)a.final_norm + lane; const v2u* br = (const v2u*)((const bf16*)(ws + WS_X2B) + (size_t)m * DM) + lane;
            v2u w[8];
#pragma unroll
            for (int j = 0; j < 8; ++j) w[j] = __builtin_nontemporal_load(br + 64 * j);
#pragma unroll
            for (int j = 0; j < 8; ++j) { const f32x4 g = gr[64 * j]; const f32x4 v = (f32x4){pg8::bf_lo(w[j].x), pg8::bf_hi(w[j].x), pg8::bf_lo(w[j].y), pg8::bf_hi(w[j].y)}; __builtin_nontemporal_store(v * rstd * g, xr + 64 * j); }
        }
    }
}

extern "C" void kernel_launch(void* const* d_in, const int* in_sizes, int n_in, void* d_out, int out_size, void* d_ws, size_t ws_size, hipStream_t stream) {
    static int grid = 0; static int fused_final = 0;
    if (grid == 0) {
        if (n_in != 13 || in_sizes[0] != M * DM || out_size != M * DM || ws_size < WS_END) { fprintf(stderr, "kernel_launch: unexpected shapes (n_in %d, in0 %d, out %d, ws %zu)\n", n_in, n_in > 0 ? in_sizes[0] : -1, out_size, ws_size); grid = -1; return; }
        int dev = 0, cus = 0, per_cu = 0;
        if (hipGetDevice(&dev) != hipSuccess || hipDeviceGetAttribute(&cus, hipDeviceAttributeMultiprocessorCount, dev) != hipSuccess) { grid = -1; return; }
        if (hipFuncSetAttribute((const void*)mega_fwd, hipFuncAttributeMaxDynamicSharedMemorySize, LDS_BYTES) != hipSuccess) { fprintf(stderr, "kernel_launch: hipFuncSetAttribute failed\n"); grid = -1; return; }
        if (hipOccupancyMaxActiveBlocksPerMultiprocessor(&per_cu, (const void*)mega_fwd, NWAVES * 64, LDS_BYTES) != hipSuccess || per_cu < 1) { fprintf(stderr, "kernel_launch: occupancy query says %d\n", per_cu); per_cu = 1; }
        (void)hipGetLastError();
        grid = cus * 1;
        { pg8::StaticOrder S; S.init(M, DM, grid, 0); bool ok = (M / 256) * (DM / 256) == 4 * grid;
          for (int c = 0; c < grid && ok; ++c) { S.c = c; for (int i = 0; i < 4 && ok; i += 2) { pg8::Unit u0, u1; ok = S.next(i, u0) && S.next(i + 1, u1) && u0.pm == u1.pm && u1.pn == u0.pn + 4 && u0.pn < 4 && u0.f == 0 && u1.f == 1; } }
          fused_final = (ok && FUSED_FINAL) ? 1 : 0; if (!ok) fprintf(stderr, "kernel_launch: note: unit order does not pair tiles; using the separate final-norm pass\n"); }
    }
    if (grid < 0) return;
    (void)hipMemsetAsync((char*)d_ws + WS_CTL, 0, CTL_ZERO_BYTES, stream);
    Args a{};
    a.x = (const float*)d_in[0]; a.pos = (const int*)d_in[1]; a.attn_norm = (const float*)d_in[2]; a.w_in = (const float*)d_in[3]; a.fbias = (const float*)d_in[4]; a.sinks = (const float*)d_in[5];
    a.w_bs = (const float*)d_in[6]; a.w_bf = (const float*)d_in[7]; a.w_out = (const float*)d_in[8]; a.mlp_norm = (const float*)d_in[9]; a.w_up = (const float*)d_in[10]; a.w_dn = (const float*)d_in[11];
    a.final_norm = (const float*)d_in[12]; a.out = (float*)d_out; a.ws = (unsigned char*)d_ws; a.fused_final = fused_final;
    void* kargs[] = {&a};
    const hipError_t le = hipLaunchCooperativeKernel((const void*)mega_fwd, dim3(grid), dim3(NWAVES * 64), kargs, LDS_BYTES, stream);
    if (le != hipSuccess) fprintf(stderr, "kernel_launch: cooperative launch failed: %s (grid %d)\n", hipGetErrorString(le), grid);
}
```

```cpp
#include <hip/hip_runtime.h>
#include <hip/hip_cooperative_groups.h>
#include <cstdio>
#include <cstdint>
namespace cg = cooperative_groups;

constexpr int BATCH = 4, SEQ = 8192, DM = 2048, M = BATCH * SEQ, DFF = 8192, NIN = 8704  , DIN = 8464;
constexpr float RMS_EPS = 1e-6f;
constexpr float LOG2E = 1.4426950408889634f;
constexpr float C2 = 0.125f * 1.4426950408889634f;

constexpr size_t MiB = 1u << 20;
constexpr size_t WS_CTL = 0, CTL_ZERO_BYTES = 1 * MiB;
constexpr size_t WS_WIN = 1 * MiB, WS_WBS = 35 * MiB, WS_WBF = 39 * MiB, WS_WOUT = 43 * MiB, WS_WUP = 51 * MiB, WS_WDN = 83 * MiB;
constexpr size_t WS_CS = 115 * MiB;
constexpr size_t WS_FL = 123 * MiB, WS_C = 125 * MiB;
constexpr size_t WS_FK = 128 * MiB, WS_FV = 192 * MiB, WS_X1B = 128 * MiB;
constexpr size_t WS_XN = 256 * MiB, WS_MG = 256 * MiB;
constexpr size_t WS_AQ = 384 * MiB, WS_FQ = 448 * MiB, WS_G = 512 * MiB;
constexpr size_t WS_U = 256 * MiB;
constexpr size_t WS_AK = 768 * MiB, WS_AV = 776 * MiB, WS_OA = 784 * MiB, WS_OB = 848 * MiB, WS_END = 912 * MiB;
constexpr size_t WS_X2B = 784 * MiB;

namespace pg8 {
#define PG8_LAS __attribute__((address_space(3)))
typedef unsigned short bf16_t;
typedef short bf16x8 __attribute__((ext_vector_type(8)));
typedef float f32x4 __attribute__((ext_vector_type(4)));
typedef unsigned u32x4 __attribute__((ext_vector_type(4)));
typedef unsigned u32x2 __attribute__((ext_vector_type(2)));
constexpr int BM = 256, BK = 64, HALF = 128, HTB = HALF * BK * 2  , STAGE_BYTES = 8 * HTB, NXCD = 8, WGM = 8;

__host__ __device__ __forceinline__ int lds_byte(int r, int c) { const int st = (r >> 4) * 2 + (c >> 5), rr = r & 15, cc = c & 31, ob = rr * 64 + cc * 2; return st * 1024 + (ob ^ (((ob >> 9) & 1) << 5)); }
__host__ __device__ __forceinline__ void stage_rc(int b, int& R, int& C) { const int st = b / 1024, sb = b % 1024, swz = sb ^ (((sb >> 9) & 1) << 5); R = (st >> 1) * 16 + swz / 64; C = (st & 1) * 32 + (swz % 64) / 2; }
__host__ __device__ __forceinline__ int perm32(int rho) { const int n = rho >> 4, i = rho & 15; return 8 * (i >> 2) + 4 * n + (i & 3); }

struct Unit { int pm, pn, z, f; };
struct Gemm { const bf16_t* A0; const bf16_t* B0; const bf16_t* A1; const bf16_t* B1; int K; };

struct StaticOrder {
    int nM, nN, nwg, G, c;
    __host__ __device__ void init(int M_, int N_, int G_, int c_) { nM = M_ / BM; nN = N_ / BM; nwg = nM * nN; G = G_; c = c_; }
    __host__ __device__ bool next(int i, Unit& u) const {
        const long L = (long)i * G + c; if (L >= nwg) return false;
        int wgid = (int)L; { const int q = nwg / NXCD, r = nwg % NXCD, xcd = wgid % NXCD, off = wgid / NXCD; wgid = (xcd < r ? xcd * (q + 1) : r * (q + 1) + (xcd - r) * q) + off; }
        const int nig = WGM * nN, gid = wgid / nig, fm = gid * WGM, gsz = (nM - fm) < WGM ? (nM - fm) : WGM;
        u.pm = fm + ((wgid % nig) % gsz); u.pn = (wgid % nig) / gsz; u.z = 0; u.f = i & 1; return true;
    }
};
struct PairOrder {
    StaticOrder s;
    __host__ __device__ bool next(int i, Unit& u) const { const bool ok = s.next(i >> 1, u); u.z = i & 1; return ok; }
};

__device__ __forceinline__ unsigned cvt_pk_bf16(float lo, float hi) { unsigned r; asm("v_cvt_pk_bf16_f32 %0, %1, %2" : "=v"(r) : "v"(lo), "v"(hi)); return r; }
__device__ __forceinline__ float bf_lo(unsigned w) { return __uint_as_float(w << 16); }
__device__ __forceinline__ float bf_hi(unsigned w) { return __uint_as_float(w & 0xffff0000u); }
__device__ __forceinline__ float sigmoidf_(float x) { return __builtin_amdgcn_rcpf(1.0f + __builtin_amdgcn_exp2f(-x * LOG2E)); }


struct EpiIn {
    static constexpr bool PERM = true;
    unsigned char* ws;
    __device__ __forceinline__ bool keep(const Unit&) const { return false; }
    __device__ __forceinline__ void operator()(f32x4 (&acc)[2][2][4][2], const Unit& u, int wr, int wc, int fr, int fq) const {
        const int pn = u.pn; const int row0 = u.pm * BM + wr * 64 + fr;
        if (pn <= 16) {
            size_t doff; int pitch, colbase; bool rope = false; float sc = 1.f;
            if (pn < 4) { doff = WS_AQ; pitch = 1024; colbase = (4 * pn + wc) * 64; rope = true; sc = C2; }
            else if (pn == 4) { if (wc < 2) { doff = WS_AK; pitch = 128; colbase = wc * 64; rope = true; } else { doff = WS_AV; pitch = 128; colbase = (wc - 2) * 64; } }
            else { const int t = pn - 5, seg = t >> 2, tin = t & 3; doff = WS_FQ; if (seg == 1) doff = WS_FK; if (seg == 2) doff = WS_FV; pitch = 1024; colbase = (4 * tin + wc) * 64; sc = seg == 0 ? C2 : 1.f; }
            bf16_t* dst = (bf16_t*)(ws + doff); const float* cs = (const float*)(ws + WS_CS);
#pragma unroll
            for (int ai = 0; ai < 2; ++ai) {
                f32x4 cc[4][4];
                if (rope) {
#pragma unroll
                    for (int m = 0; m < 4; ++m) { const float* cp = cs + (size_t)(row0 + ai * HALF + m * 16) * 32 + 8 * fq; const float* sp = cp + (size_t)M * 32;
                        cc[m][0] = *(const f32x4*)cp; cc[m][1] = *(const f32x4*)(cp + 4); cc[m][2] = *(const f32x4*)sp; cc[m][3] = *(const f32x4*)(sp + 4); }
                    asm volatile("" ::: "memory");
                }
#pragma unroll
                for (int m = 0; m < 4; ++m) {
                    const int row = row0 + ai * HALF + m * 16;
                    f32x4 v00 = acc[ai][0][m][0], v01 = acc[ai][0][m][1], v10 = acc[ai][1][m][0], v11 = acc[ai][1][m][1];
                    if (rope) {
                        const f32x4 c0 = cc[m][0], c1 = cc[m][1], s0 = cc[m][2], s1 = cc[m][3];
                        const f32x4 o00 = v00 * c0 - v10 * s0, o10 = v10 * c0 + v00 * s0, o01 = v01 * c1 - v11 * s1, o11 = v11 * c1 + v01 * s1;
                        v00 = o00; v10 = o10; v01 = o01; v11 = o11;
                    }
                    v00 = v00 * sc; v01 = v01 * sc; v10 = v10 * sc; v11 = v11 * sc;
                    bf16_t* rp = dst + (size_t)row * pitch + colbase + 8 * fq;
                    u32x4 w0, w1;
                    w0.x = cvt_pk_bf16(v00[0], v00[1]); w0.y = cvt_pk_bf16(v00[2], v00[3]); w0.z = cvt_pk_bf16(v01[0], v01[1]); w0.w = cvt_pk_bf16(v01[2], v01[3]);
                    w1.x = cvt_pk_bf16(v10[0], v10[1]); w1.y = cvt_pk_bf16(v10[2], v10[3]); w1.z = cvt_pk_bf16(v11[0], v11[1]); w1.w = cvt_pk_bf16(v11[2], v11[3]);
                    *(u32x4*)rp = w0; *(u32x4*)(rp + 32) = w1;
                }
                asm volatile("" ::: "memory");
            }
        } else if (pn <= 32) {
            const int col0 = (pn - 17) * BM + wc * 32 + 8 * fq;
#pragma unroll
            for (int ai = 0; ai < 2; ++ai)
#pragma unroll
                for (int m = 0; m < 4; ++m) {
                    unsigned char* rp = ws + WS_G + (size_t)(row0 + ai * HALF + m * 16) * 4096 + col0;
#pragma unroll
                    for (int bj = 0; bj < 2; ++bj) {
                        const f32x4 a = acc[ai][bj][m][0], b = acc[ai][bj][m][1]; u32x2 w; w.x = 0u; w.y = 0u;
#pragma unroll
                        for (int i = 0; i < 4; ++i) { w.x = __builtin_amdgcn_cvt_pk_u8_f32(fmaxf(sigmoidf_(a[i]) * 255.0f, 1.0f), i, w.x); w.y = __builtin_amdgcn_cvt_pk_u8_f32(fmaxf(sigmoidf_(b[i]) * 255.0f, 1.0f), i, w.y); }
                        *(u32x2*)(rp + bj * HALF) = w;
                    }
                }
        } else {
            if (wc == 0 && fq < 2) {
#pragma unroll
                for (int ai = 0; ai < 2; ++ai)
#pragma unroll
                    for (int m = 0; m < 4; ++m) {
                        float* rp = (float*)(ws + WS_FL) + (size_t)(row0 + ai * HALF + m * 16) * 16 + 8 * fq;
                        *(f32x4*)rp = acc[ai][0][m][0]; *(f32x4*)(rp + 4) = acc[ai][0][m][1];
                    }
            }
        }
    }
};

struct EpiBranch {
    static constexpr bool PERM = true;
    const unsigned char* G; bf16_t* MG;
    __device__ __forceinline__ bool keep(const Unit& u) const { return u.z == 0; }
    __device__ __forceinline__ void operator()(f32x4 (&acc)[2][2][4][2], const Unit& u, int wr, int wc, int fr, int fq) const {
        const int row0 = u.pm * BM + wr * 64 + fr, col0 = u.pn * BM + wc * 32 + 8 * fq; const int z = u.z;
#pragma unroll
        for (int ai = 0; ai < 2; ++ai) {
            u32x2 gbv[4][2], gav[4][2];
#pragma unroll
            for (int m = 0; m < 4; ++m)
#pragma unroll
                for (int bj = 0; bj < 2; ++bj) { const unsigned char* gp = G + (size_t)(row0 + ai * HALF + m * 16) * 4096 + col0 + bj * HALF;
                    gbv[m][bj] = *(const u32x2*)(gp + 2048); if (z == 0) gav[m][bj] = *(const u32x2*)gp; }
            asm volatile("" ::: "memory");
#pragma unroll
            for (int m = 0; m < 4; ++m) {
                const size_t row = (size_t)(row0 + ai * HALF + m * 16);
#pragma unroll
                for (int bj = 0; bj < 2; ++bj) {
                    const u32x2 gb = gbv[m][bj];
                    float sb[8];
#pragma unroll
                    for (int i = 0; i < 4; ++i) { sb[i] = (float)((gb.x >> (8 * i)) & 0xffu); sb[4 + i] = (float)((gb.y >> (8 * i)) & 0xffu); }
                    if (z == 0) {
                        const u32x2 ga = gav[m][bj];
#pragma unroll
                        for (int i = 0; i < 4; ++i) {
                            acc[ai][bj][m][0][i] *= (float)((ga.x >> (8 * i)) & 0xffu) * __builtin_amdgcn_rcpf(sb[i]);
                            acc[ai][bj][m][1][i] *= (float)((ga.y >> (8 * i)) & 0xffu) * __builtin_amdgcn_rcpf(sb[4 + i]);
                        }
                    } else {
#pragma unroll
                        for (int i = 0; i < 8; ++i) sb[i] *= (1.0f / 255.0f);
                        const f32x4 a = acc[ai][bj][m][0], b = acc[ai][bj][m][1]; u32x4 w;
                        w.x = cvt_pk_bf16(a[0] * sb[0], a[1] * sb[1]); w.y = cvt_pk_bf16(a[2] * sb[2], a[3] * sb[3]);
                        w.z = cvt_pk_bf16(b[0] * sb[4], b[1] * sb[5]); w.w = cvt_pk_bf16(b[2] * sb[6], b[3] * sb[7]);
                        *(u32x4*)(MG + row * 2048 + col0 + bj * HALF) = w;
                    }
                }
            }
            asm volatile("" ::: "memory");
        }
    }
};

template <bool WRITE_BF> struct EpiRes {
    static constexpr bool PERM = false;
    const float* base; float* out; bf16_t* xb; float* ss;
    __device__ __forceinline__ bool keep(const Unit&) const { return false; }
    __device__ __forceinline__ void operator()(f32x4 (&acc)[2][2][4][2], const Unit& u, int wr, int wc, int fr, int fq) const {
        const int row0 = u.pm * BM + wr * 64 + fr, col0 = u.pn * BM + wc * 32 + 4 * fq;
#pragma unroll
        for (int ai = 0; ai < 2; ++ai) {
            f32x4 pre[4][2][2];
#pragma unroll
            for (int m = 0; m < 4; ++m)
#pragma unroll
                for (int bj = 0; bj < 2; ++bj)
#pragma unroll
                    for (int n = 0; n < 2; ++n) pre[m][bj][n] = *(const f32x4*)(base + (size_t)(row0 + ai * HALF + m * 16) * DM + col0 + bj * HALF + n * 16);
            asm volatile("" ::: "memory");
#pragma unroll
            for (int m = 0; m < 4; ++m) {
                const size_t row = (size_t)(row0 + ai * HALF + m * 16); const size_t off = row * DM + col0; float q = 0.f;
#pragma unroll
                for (int bj = 0; bj < 2; ++bj)
#pragma unroll
                    for (int n = 0; n < 2; ++n) {
                        const size_t o = off + bj * HALF + n * 16;
                        const f32x4 v = pre[m][bj][n] + acc[ai][bj][m][n];
                        *(f32x4*)(out + o) = v; q += (v[0] * v[0] + v[1] * v[1]) + (v[2] * v[2] + v[3] * v[3]);
                        if (WRITE_BF) { u32x2 w; w.x = cvt_pk_bf16(v[0], v[1]); w.y = cvt_pk_bf16(v[2], v[3]); *(u32x2*)(xb + o) = w; }
                    }
                q += __shfl_xor(q, 16); q += __shfl_xor(q, 32);
                if (fq == 0) atomicAdd(ss + row, q);
            }
            asm volatile("" ::: "memory");
        }
    }
};

struct EpiFinal {
    static constexpr bool PERM = false;
    float* out; float* ss; unsigned* cnt; const float* gain;
    __device__ __forceinline__ bool keep(const Unit&) const { return false; }
    __device__ __forceinline__ void operator()(f32x4 (&acc)[2][2][4][2], const Unit& u, int wr, int wc, int fr, int fq) const {
        const int row0 = u.pm * BM + wr * 64 + fr, col0 = u.pn * BM + wc * 32 + 4 * fq; const bool second = u.f != 0;
#pragma unroll
        for (int ai = 0; ai < 2; ++ai) {
            f32x4 pre[4][2][2];
#pragma unroll
            for (int m = 0; m < 4; ++m)
#pragma unroll
                for (int bj = 0; bj < 2; ++bj)
#pragma unroll
                    for (int n = 0; n < 2; ++n) pre[m][bj][n] = *(const f32x4*)(out + (size_t)(row0 + ai * HALF + m * 16) * DM + col0 + bj * HALF + n * 16);
            asm volatile("" ::: "memory");
#pragma unroll
            for (int m = 0; m < 4; ++m) {
                const size_t row = (size_t)(row0 + ai * HALF + m * 16); const size_t off = row * DM + col0; float q = 0.f;
#pragma unroll
                for (int bj = 0; bj < 2; ++bj)
#pragma unroll
                    for (int n = 0; n < 2; ++n) {
                        const f32x4 v = pre[m][bj][n] + acc[ai][bj][m][n]; acc[ai][bj][m][n] = v;
                        q += (v[0] * v[0] + v[1] * v[1]) + (v[2] * v[2] + v[3] * v[3]);
                        if (!second) *(f32x4*)(out + off + bj * HALF + n * 16) = v;
                    }
                q += __shfl_xor(q, 16); q += __shfl_xor(q, 32);
                if (fq == 0) atomicAdd(ss + row, q);
            }
            asm volatile("" ::: "memory");
        }
        asm volatile("s_waitcnt vmcnt(0)" ::: "memory");
        unsigned* pc = cnt + 16 * u.pm;
        if ((threadIdx.x & 63) == 0) __hip_atomic_fetch_add(pc, 1u, __ATOMIC_RELAXED, __HIP_MEMORY_SCOPE_AGENT);
        if (!second) return;
        { const unsigned long long t0 = __builtin_amdgcn_s_memrealtime();
          while ((unsigned)__builtin_amdgcn_readfirstlane(__hip_atomic_load(pc, __ATOMIC_RELAXED, __HIP_MEMORY_SCOPE_AGENT)) < 64u) {
              if (__builtin_amdgcn_s_memrealtime() - t0 > 2000000ull) break;
              __builtin_amdgcn_s_sleep(4); }
          asm volatile("" ::: "memory"); }
#pragma unroll
        for (int ai = 0; ai < 2; ++ai)
#pragma unroll
            for (int m = 0; m < 4; ++m) {
                const size_t row = (size_t)(row0 + ai * HALF + m * 16); const size_t off = row * DM + col0;
                const float rstd = __builtin_amdgcn_rsqf(__hip_atomic_load(ss + row, __ATOMIC_RELAXED, __HIP_MEMORY_SCOPE_AGENT) * (1.0f / DM) + RMS_EPS);
#pragma unroll
                for (int bj = 0; bj < 2; ++bj)
#pragma unroll
                    for (int n = 0; n < 2; ++n) {
                        const size_t o = off + bj * HALF + n * 16; const int c = col0 + bj * HALF + n * 16;
                        const f32x4 gB = *(const f32x4*)(gain + c), gA = *(const f32x4*)(gain + c - 1024), vA = *(const f32x4*)(out + o - 1024);
                        *(f32x4*)(out + o) = acc[ai][bj][m][n] * rstd * gB;
                        *(f32x4*)(out + o - 1024) = vA * rstd * gA;
                    }
            }
    }
};

template <bool BASE_BF> struct EpiResB {
    static constexpr bool PERM = true;
    const void* base; bf16_t* yb; float* ss;
    __device__ __forceinline__ bool keep(const Unit&) const { return false; }
    __device__ __forceinline__ void operator()(f32x4 (&acc)[2][2][4][2], const Unit& u, int wr, int wc, int fr, int fq) const {
        const int row0 = u.pm * BM + wr * 64 + fr, col0 = u.pn * BM + wc * 32 + 8 * fq;
#pragma unroll
        for (int ai = 0; ai < 2; ++ai) {
            f32x4 pf[4][2][2]; u32x4 pb[4][2];
#pragma unroll
            for (int m = 0; m < 4; ++m)
#pragma unroll
                for (int bj = 0; bj < 2; ++bj) { const size_t o = (size_t)(row0 + ai * HALF + m * 16) * DM + col0 + bj * HALF;
                    if (BASE_BF) pb[m][bj] = *(const u32x4*)((const bf16_t*)base + o);
                    else { pf[m][bj][0] = *(const f32x4*)((const float*)base + o); pf[m][bj][1] = *(const f32x4*)((const float*)base + o + 4); } }
            asm volatile("" ::: "memory");
#pragma unroll
            for (int m = 0; m < 4; ++m) {
                const size_t row = (size_t)(row0 + ai * HALF + m * 16); float q = 0.f;
#pragma unroll
                for (int bj = 0; bj < 2; ++bj) {
                    f32x4 x0, x1;
                    if (BASE_BF) { const u32x4 w = pb[m][bj]; x0 = (f32x4){bf_lo(w.x), bf_hi(w.x), bf_lo(w.y), bf_hi(w.y)}; x1 = (f32x4){bf_lo(w.z), bf_hi(w.z), bf_lo(w.w), bf_hi(w.w)}; }
                    else { x0 = pf[m][bj][0]; x1 = pf[m][bj][1]; }
                    const f32x4 v0 = x0 + acc[ai][bj][m][0], v1 = x1 + acc[ai][bj][m][1];
                    q += ((v0[0] * v0[0] + v0[1] * v0[1]) + (v0[2] * v0[2] + v0[3] * v0[3])) + ((v1[0] * v1[0] + v1[1] * v1[1]) + (v1[2] * v1[2] + v1[3] * v1[3]));
                    u32x4 w; w.x = cvt_pk_bf16(v0[0], v0[1]); w.y = cvt_pk_bf16(v0[2], v0[3]); w.z = cvt_pk_bf16(v1[0], v1[1]); w.w = cvt_pk_bf16(v1[2], v1[3]);
                    *(u32x4*)(yb + row * DM + col0 + bj * HALF) = w;
                }
                q += __shfl_xor(q, 16); q += __shfl_xor(q, 32);
                if (fq == 0) atomicAdd(ss + row, q);
            }
            asm volatile("" ::: "memory");
        }
    }
};

struct EpiUp {
    static constexpr bool PERM = true;
    const float* ss; bf16_t* U;
    __device__ __forceinline__ bool keep(const Unit&) const { return false; }
    __device__ __forceinline__ void operator()(f32x4 (&acc)[2][2][4][2], const Unit& u, int wr, int wc, int fr, int fq) const {
        const int row0 = u.pm * BM + wr * 64 + fr, col0 = u.pn * BM + wc * 32 + 8 * fq;
        float rs[2][4];
#pragma unroll
        for (int ai = 0; ai < 2; ++ai)
#pragma unroll
            for (int m = 0; m < 4; ++m) rs[ai][m] = ss[row0 + ai * HALF + m * 16];
        asm volatile("" ::: "memory");
#pragma unroll
        for (int ai = 0; ai < 2; ++ai)
#pragma unroll
            for (int m = 0; m < 4; ++m) {
                const size_t row = (size_t)(row0 + ai * HALF + m * 16);
                const float rstd = __builtin_amdgcn_rsqf(rs[ai][m] * (1.0f / DM) + RMS_EPS);
#pragma unroll
                for (int bj = 0; bj < 2; ++bj) {
                    f32x4 a = acc[ai][bj][m][0] * rstd, b = acc[ai][bj][m][1] * rstd; u32x4 w;
#pragma unroll
                    for (int i = 0; i < 4; ++i) { a[i] = fmaxf(a[i], 0.f); a[i] *= a[i]; b[i] = fmaxf(b[i], 0.f); b[i] *= b[i]; }
                    w.x = cvt_pk_bf16(a[0], a[1]); w.y = cvt_pk_bf16(a[2], a[3]); w.z = cvt_pk_bf16(b[0], b[1]); w.w = cvt_pk_bf16(b[2], b[3]);
                    *(u32x4*)(U + row * DFF + col0 + bj * HALF) = w;
                }
            }
    }
};

template <class Epi, class Sched, bool ALIGN_EPI = false, bool SP2 = false>
__device__ __forceinline__ void gemm_phase(PG8_LAS unsigned char* lds, const Gemm g, const Sched& S, const Epi& E) {
    int tid_ = threadIdx.x; asm volatile("" : "+v"(tid_));
    const int tid = tid_, wid = __builtin_amdgcn_readfirstlane(tid >> 6), lane = tid & 63, wr = wid >> 2, wc = wid & 3, fr = lane & 15, fq = lane >> 4;
    const int K = g.K, nt = K / BK;
    unsigned voffA[2], voffB[2];
#pragma unroll
    for (int i = 0; i < 2; ++i) { int R, C; stage_rc(tid * 16 + i * 8192, R, C); const int Rb = Epi::PERM ? ((R & ~31) + perm32(R & 31)) : R;
        voffA[i] = (unsigned)(R * K + C) * 2u; voffB[i] = (unsigned)(Rb * K + C) * 2u; }
    const size_t kstep = (size_t)(BK * 2);
    const size_t hstep = (size_t)HALF * K * 2;
    const size_t tstep = 2 * hstep;
    const unsigned ldsw = (unsigned)wid * 1024u;
    const int aoff = lds_byte(wr * 64 + fr, fq * 8), boff = lds_byte(wc * 32 + fr, fq * 8);
#define PG8_SA(b, h) (((b) * 2 + (h)) * HTB)
#define PG8_SB(b, h) ((4 + (b) * 2 + (h)) * HTB)
#define PG8_STAGE(bufoff, gbase, voff) do { _Pragma("unroll") for (int _i = 0; _i < 2; ++_i) \
        __builtin_amdgcn_global_load_lds((const unsigned*)((const char*)(gbase) + (voff)[_i]), (PG8_LAS unsigned*)(lds + (bufoff) + ldsw + _i * 8192), 16, 0, 0); } while (0)
#define PG8_LDA(dst, b, h) do { _Pragma("unroll") for (int m = 0; m < 4; ++m) _Pragma("unroll") for (int k = 0; k < 2; ++k) dst[m][k] = *(const PG8_LAS bf16x8*)(lds + PG8_SA(b, h) + aoff + m * 2048 + k * 1024); } while (0)
#define PG8_LDB(dst, b, h) do { _Pragma("unroll") for (int n = 0; n < 2; ++n) _Pragma("unroll") for (int k = 0; k < 2; ++k) dst[n][k] = *(const PG8_LAS bf16x8*)(lds + PG8_SB(b, h) + boff + n * 2048 + k * 1024); } while (0)
#define PG8_MMA(ai, bj, At, Bt) do { __builtin_amdgcn_s_setprio(1); _Pragma("unroll") for (int m = 0; m < 4; ++m) _Pragma("unroll") for (int n = 0; n < 2; ++n) _Pragma("unroll") for (int k = 0; k < 2; ++k) \
        acc[ai][bj][m][n] = __builtin_amdgcn_mfma_f32_16x16x32_bf16(Bt[n][k], At[m][k], acc[ai][bj][m][n], 0, 0, 0); __builtin_amdgcn_s_setprio(0); } while (0)
#define PG8_WAIT_V(n) asm volatile("s_waitcnt vmcnt(" #n ")" ::: "memory")
#define PG8_WAIT_L(n) asm volatile("s_waitcnt lgkmcnt(" #n ")" ::: "memory")
#define PG8_BAR __builtin_amdgcn_s_barrier()
#define PG8_SCHED __builtin_amdgcn_sched_barrier(0)
    Unit cur, nxt; int ui = 0;
    if (!S.next(0, cur)) return;
    f32x4 acc[2][2][4][2];
#pragma unroll
    for (int a = 0; a < 2; ++a)
#pragma unroll
        for (int b = 0; b < 2; ++b)
#pragma unroll
            for (int m = 0; m < 4; ++m)
#pragma unroll
                for (int n = 0; n < 2; ++n) acc[a][b][m][n] = (f32x4){0.f, 0.f, 0.f, 0.f};
    bf16x8 At[4][2], B0[2][2], B1[2][2];
    const char* cA = (const char*)(cur.z ? g.A1 : g.A0) + (size_t)cur.pm * tstep; const char* cB = (const char*)(cur.z ? g.B1 : g.B0) + (size_t)cur.pn * tstep;
    if constexpr (SP2) {
        PG8_STAGE(PG8_SB(0, 0), cB, voffB); PG8_STAGE(PG8_SB(0, 1), cB + hstep, voffB); PG8_STAGE(PG8_SA(0, 0), cA, voffA); PG8_STAGE(PG8_SA(0, 1), cA + hstep, voffA);
        if (wr == 1) PG8_BAR;
        PG8_WAIT_V(2); PG8_BAR;
        PG8_STAGE(PG8_SB(1, 0), cB + kstep, voffB); PG8_STAGE(PG8_SA(1, 0), cA + kstep, voffA); PG8_STAGE(PG8_SB(1, 1), cB + hstep + kstep, voffB);
        PG8_WAIT_V(6); PG8_BAR;
    } else {
        PG8_STAGE(PG8_SB(0, 0), cB, voffB); PG8_STAGE(PG8_SA(0, 0), cA, voffA); PG8_STAGE(PG8_SB(0, 1), cB + hstep, voffB); PG8_STAGE(PG8_SA(0, 1), cA + hstep, voffA);
        if (wr == 1) PG8_BAR;
        PG8_WAIT_V(4); PG8_BAR;
        PG8_STAGE(PG8_SB(1, 0), cB + kstep, voffB); PG8_STAGE(PG8_SA(1, 0), cA + kstep, voffA); PG8_STAGE(PG8_SB(1, 1), cB + hstep + kstep, voffB);
        PG8_WAIT_V(6); PG8_BAR;
    }
    for (;;) {
        const bool has_next = S.next(ui + 1, nxt);
        const char* nA = has_next ? (const char*)(nxt.z ? g.A1 : g.A0) + (size_t)nxt.pm * tstep : cA; const char* nB = has_next ? (const char*)(nxt.z ? g.B1 : g.B0) + (size_t)nxt.pn * tstep : cB;
        for (int t = 0; t < nt; t += 2) {
            const bool last = (t == nt - 2);
            const char* a1 = cA + (size_t)(t + 1) * kstep;
            const char* a2 = last ? nA : cA + (size_t)(t + 2) * kstep; const char* b2 = last ? nB : cB + (size_t)(t + 2) * kstep;
            const char* a3 = a2 + kstep; const char* b3 = b2 + kstep;
            if constexpr (SP2) {
            PG8_LDB(B0, 0, 0); PG8_LDB(B1, 0, 1); PG8_SCHED; PG8_LDA(At, 0, 0); PG8_STAGE(PG8_SA(1, 1), a1 + hstep, voffA);
            PG8_WAIT_V(8); PG8_WAIT_L(0); PG8_BAR; PG8_MMA(0, 0, At, B0); PG8_MMA(0, 1, At, B1); PG8_BAR; PG8_SCHED;
            PG8_LDA(At, 0, 1); PG8_STAGE(PG8_SB(0, 0), b2, voffB); PG8_STAGE(PG8_SB(0, 1), b2 + hstep, voffB); PG8_STAGE(PG8_SA(0, 0), a2, voffA);
            PG8_WAIT_V(8); PG8_WAIT_L(0); PG8_BAR; PG8_MMA(1, 0, At, B0); PG8_MMA(1, 1, At, B1); PG8_BAR; PG8_SCHED;
            PG8_LDB(B0, 1, 0); PG8_LDB(B1, 1, 1); PG8_SCHED; PG8_LDA(At, 1, 0); PG8_STAGE(PG8_SA(0, 1), a2 + hstep, voffA);
            PG8_WAIT_V(8); PG8_WAIT_L(0); PG8_BAR; PG8_MMA(0, 0, At, B0); PG8_MMA(0, 1, At, B1); PG8_BAR; PG8_SCHED;
            PG8_LDA(At, 1, 1); PG8_STAGE(PG8_SB(1, 0), b3, voffB); PG8_STAGE(PG8_SB(1, 1), b3 + hstep, voffB); PG8_STAGE(PG8_SA(1, 0), a3, voffA);
            PG8_WAIT_V(8); PG8_WAIT_L(0); PG8_BAR; PG8_MMA(1, 0, At, B0); PG8_MMA(1, 1, At, B1); PG8_BAR; PG8_SCHED;
            } else {
            PG8_LDB(B0, 0, 0); PG8_SCHED; PG8_LDA(At, 0, 0); PG8_STAGE(PG8_SA(1, 1), a1 + hstep, voffA);
            PG8_WAIT_L(8); PG8_BAR; PG8_WAIT_L(0); PG8_MMA(0, 0, At, B0); PG8_BAR; PG8_SCHED;
            PG8_LDB(B1, 0, 1); PG8_STAGE(PG8_SB(0, 0), b2, voffB);
            PG8_BAR; PG8_WAIT_L(0); PG8_MMA(0, 1, At, B1); PG8_BAR;
            PG8_LDA(At, 0, 1); PG8_STAGE(PG8_SA(0, 0), a2, voffA);
            PG8_BAR; PG8_WAIT_L(0); PG8_MMA(1, 0, At, B0); PG8_BAR; PG8_SCHED;
            PG8_STAGE(PG8_SB(0, 1), b2 + hstep, voffB);
            PG8_WAIT_V(6); PG8_BAR; PG8_MMA(1, 1, At, B1); PG8_BAR;
            PG8_LDB(B0, 1, 0); PG8_SCHED; PG8_LDA(At, 1, 0); PG8_STAGE(PG8_SA(0, 1), a2 + hstep, voffA);
            PG8_WAIT_L(8); PG8_BAR; PG8_WAIT_L(0); PG8_MMA(0, 0, At, B0); PG8_BAR; PG8_SCHED;
            PG8_LDB(B1, 1, 1); PG8_STAGE(PG8_SB(1, 0), b3, voffB);
            PG8_BAR; PG8_WAIT_L(0); PG8_MMA(0, 1, At, B1); PG8_BAR;
            PG8_LDA(At, 1, 1); PG8_STAGE(PG8_SA(1, 0), a3, voffA);
            PG8_BAR; PG8_WAIT_L(0); PG8_MMA(1, 0, At, B0); PG8_BAR; PG8_SCHED;
            PG8_STAGE(PG8_SB(1, 1), b3 + hstep, voffB);
            PG8_WAIT_V(6); PG8_BAR; PG8_MMA(1, 1, At, B1); PG8_BAR;
            }
        }
        if constexpr (ALIGN_EPI) { if (wr == 0) PG8_BAR; }
        E(acc, cur, wr, wc, fr, fq);
        if (!has_next) break;
        if (!E.keep(cur))
#pragma unroll
        for (int a = 0; a < 2; ++a)
#pragma unroll
            for (int b = 0; b < 2; ++b)
#pragma unroll
                for (int m = 0; m < 4; ++m)
#pragma unroll
                    for (int n = 0; n < 2; ++n) acc[a][b][m][n] = (f32x4){0.f, 0.f, 0.f, 0.f};
        cur = nxt; cA = nA; cB = nB; ++ui;
        if constexpr (ALIGN_EPI) { if (wr == 1) PG8_BAR; }
    }
    PG8_WAIT_V(0);
    if constexpr (!ALIGN_EPI) { if (wr == 0) PG8_BAR; }
    PG8_BAR;
#undef PG8_SA
#undef PG8_SB
#undef PG8_STAGE
#undef PG8_LDA
#undef PG8_LDB
#undef PG8_MMA
#undef PG8_WAIT_V
#undef PG8_WAIT_L
#undef PG8_BAR
#undef PG8_SCHED
}
}


namespace attn_body {
using bf16=unsigned short;
using bf16x8=__attribute__((ext_vector_type(8)))short;
using s16x4=__attribute__((ext_vector_type(4)))short;
using f32x16=__attribute__((ext_vector_type(16)))float;
using u32x4=__attribute__((ext_vector_type(4)))unsigned;
using f32x4v=__attribute__((ext_vector_type(4)))float;
constexpr int BATCH=4,NHEAD=16,SEQ=8192,D=64,DM=NHEAD*D;
constexpr int NW=8,QBLK=32,QB=QBLK*NW,KVBLK=64,NQB=SEQ/QB;
constexpr int ATTN_PITCH=DM, ATTN_UNIT_ROWS=QB;
__device__ __forceinline__ int crow(int r,int hi){return (r&3)+8*(r>>2)+4*hi;}
#define SBAR() __builtin_amdgcn_sched_barrier(0)
template<bool SWA> __device__ __forceinline__ void cmask(f32x16&p0,f32x16&p1,int jb,int qrel,int hi){
  const float NEG=-INFINITY; int kb=64*jb+4*hi;
  #pragma unroll
  for(int r=0;r<16;++r){int kv=kb+(r&3)+8*(r>>2);
    if(SWA){ if(kv>qrel||kv<=qrel-128)p0[r]=NEG; if(kv+32>qrel||kv+32<=qrel-128)p1[r]=NEG; }
    else{ if(kv>qrel)p0[r]=NEG; if(kv+32>qrel)p1[r]=NEG; } }
}

constexpr int NSLOT=3, SLOTB=8192;
#ifndef NVB
#define NVB 8
#endif
constexpr int LDS_K=0, LDS_V=NSLOT*SLOTB, LDS_WS=2*NSLOT*SLOTB, LDS_OST=LDS_WS+NW*64*4, LDS_CB=LDS_OST+NW*4096, LDS_BYTES=LDS_CB+4*256;
constexpr float C2=0.125f*1.4426950408889634f;
__device__ __forceinline__ void glds16(const void*gsrc,unsigned lds_dst){unsigned keep;
  asm volatile("s_mov_b32 %0, m0\n\ts_mov_b32 m0, %2\n\ts_nop 0\n\tglobal_load_lds_dwordx4 %1, off\n\ts_mov_b32 m0, %0":"=&s"(keep):"v"(gsrc),"s"(lds_dst):"memory");}
__device__ __forceinline__ void glds4(const void*gsrc,unsigned lds_dst){unsigned keep;
  asm volatile("s_mov_b32 %0, m0\n\ts_mov_b32 m0, %2\n\ts_nop 0\n\tglobal_load_lds_dword %1, off\n\ts_mov_b32 m0, %0":"=&s"(keep):"v"(gsrc),"s"(lds_dst):"memory");}
__device__ __forceinline__ float max3f(float a,float b,float c){float r;asm("v_max3_f32 %0, %1, %2, %3":"=v"(r):"v"(a),"v"(b),"v"(c));return r;}
__device__ __forceinline__ float max2f(float a,float b){float r;asm("v_max_f32_e32 %0, %1, %2":"=v"(r):"v"(a),"v"(b));return r;}
__device__ __forceinline__ float fadd_s(float a,float b){float r;asm("v_add_f32_e32 %0, %1, %2":"=v"(r):"v"(a),"v"(b));return r;}
__device__ __forceinline__ float fsub_s(float a,float b){float r;asm("v_sub_f32_e32 %0, %1, %2":"=v"(r):"v"(a),"v"(b));return r;}
typedef float f32x2_t __attribute__((ext_vector_type(2))); typedef __bf16 bf16x2_t __attribute__((ext_vector_type(2)));
__device__ __forceinline__ unsigned cvtpk_s(float lo,float hi){f32x2_t v={lo,hi};bf16x2_t b=__builtin_convertvector(v,bf16x2_t);return __builtin_bit_cast(unsigned,b);}
#define WAIT_BAR(N) asm volatile("s_waitcnt vmcnt(" #N ") lgkmcnt(0)\n\ts_barrier":::"memory")

__device__ __forceinline__ void qkt(f32x16&p0,f32x16&p1,const char*Kslot,const bf16x8*qr,int r32,int hi){
  const char*kb=Kslot+hi*1024+r32*16;
  #pragma unroll
  for(int d0=0;d0<4;++d0){
    const bf16x8 b0=*reinterpret_cast<const bf16x8*>(kb+d0*2048);
    const bf16x8 b1=*reinterpret_cast<const bf16x8*>(kb+d0*2048+512);
    {p0=__builtin_amdgcn_mfma_f32_32x32x16_bf16(b0,qr[d0],p0,0,0,0);p1=__builtin_amdgcn_mfma_f32_32x32x16_bf16(b1,qr[d0],p1,0,0,0);}}
}
typedef __attribute__((address_space(3))) const char* lds_cptr;
typedef short v4i16_t __attribute__((ext_vector_type(4)));
__device__ __forceinline__ void kload8(bf16x8*kf,lds_cptr kp){
  kf[0]=*(const __attribute__((address_space(3))) bf16x8*)(kp);      kf[1]=*(const __attribute__((address_space(3))) bf16x8*)(kp+512);
  kf[2]=*(const __attribute__((address_space(3))) bf16x8*)(kp+2048); kf[3]=*(const __attribute__((address_space(3))) bf16x8*)(kp+2560);
  kf[4]=*(const __attribute__((address_space(3))) bf16x8*)(kp+4096); kf[5]=*(const __attribute__((address_space(3))) bf16x8*)(kp+4608);
  kf[6]=*(const __attribute__((address_space(3))) bf16x8*)(kp+6144); kf[7]=*(const __attribute__((address_space(3))) bf16x8*)(kp+6656);
}
__device__ __forceinline__ void kload2(bf16x8*kf,lds_cptr kp,int j){ kf[2*j]=*(const __attribute__((address_space(3))) bf16x8*)(kp+j*2048); kf[2*j+1]=*(const __attribute__((address_space(3))) bf16x8*)(kp+j*2048+512); }
__device__ __forceinline__ s16x4 vtr(lds_cptr p){ return __builtin_bit_cast(s16x4,__builtin_amdgcn_ds_read_tr16_b64_v4i16((__attribute__((address_space(3))) v4i16_t*)p)); }
__device__ __forceinline__ float rowmax(const f32x16&p0,const f32x16&p1){
  float a=max3f(p0[0],p0[1],p1[0]),b=max3f(p0[2],p0[3],p1[1]);a=max3f(a,p1[2],p1[3]);
  #pragma unroll
  for(int r=4;r<16;r+=4){a=max3f(a,p0[r],p0[r+1]);b=max3f(b,p0[r+2],p0[r+3]);a=max3f(a,p1[r],p1[r+1]);b=max3f(b,p1[r+2],p1[r+3]);}
  const float m=max2f(a,b);
  auto rr=__builtin_amdgcn_permlane32_swap(__float_as_uint(m),__float_as_uint(m),false,false);
  return max2f(__uint_as_float(rr[0]),__uint_as_float(rr[1]));
}
__device__ __forceinline__ void pv(f32x16*o,int vb,bf16x8 pa0,bf16x8 pa1,bf16x8 pa2,bf16x8 pa3){
  #pragma unroll
  for(int d0=0;d0<2;++d0){s16x4 lo[4],hi[4];
    #pragma unroll
    for(int ks=0;ks<4;++ks){
      asm volatile("ds_read_b64_tr_b16 %0,%1 offset:%c2":"=&v"(lo[ks]):"v"(vb),"i"(d0*4096+ks*1024):"memory");
      asm volatile("ds_read_b64_tr_b16 %0,%1 offset:%c2":"=&v"(hi[ks]):"v"(vb),"i"(d0*4096+ks*1024+512):"memory");}
    asm volatile("s_waitcnt lgkmcnt(0)":::"memory");SBAR();
    #define PK(k) (bf16x8){lo[k][0],lo[k][1],lo[k][2],lo[k][3],hi[k][0],hi[k][1],hi[k][2],hi[k][3]}
    o[d0]=__builtin_amdgcn_mfma_f32_32x32x16_bf16(pa0,PK(0),o[d0],0,0,0);
    o[d0]=__builtin_amdgcn_mfma_f32_32x32x16_bf16(pa1,PK(1),o[d0],0,0,0);
    o[d0]=__builtin_amdgcn_mfma_f32_32x32x16_bf16(pa2,PK(2),o[d0],0,0,0);
    o[d0]=__builtin_amdgcn_mfma_f32_32x32x16_bf16(pa3,PK(3),o[d0],0,0,0);
    #undef PK
  }
}

typedef __attribute__((address_space(3))) const f32x4v* lds_f4ptr;
__device__ __forceinline__ void fill_bias(f32x16&c0,f32x16&c1,lds_cptr cb,float negmh){
  #pragma unroll
  for(int g=0;g<4;++g){ const f32x4v v=*(lds_f4ptr)(cb+g*32), w=*(lds_f4ptr)(cb+128+g*32);
    #pragma unroll
    for(int i=0;i<4;i+=2){ const f32x2_t nm={negmh,negmh}; const f32x2_t a=nm-(f32x2_t){v[i],v[i+1]}, b=nm-(f32x2_t){w[i],w[i+1]}; c0[4*g+i]=a.x; c0[4*g+i+1]=a.y; c1[4*g+i]=b.x; c1[4*g+i+1]=b.y; } }
}
#ifndef ATTN_STORE16
#define ATTN_STORE16(p,v) (*(u32x4*)(p)=(v))
#endif
template<int THRL,bool FOX,int KP> __device__ __forceinline__ void attn_unit(int b,int h,int qb,const bf16*Q,const bf16*__restrict__ K,const bf16*__restrict__ V,bf16*O,const float*__restrict__ Cb,float sink2,char*shm){
  int tid_=threadIdx.x; asm volatile("":"+v"(tid_));
  const int tid=tid_,lane=tid&63,r32=lane&31,hi=lane>>5; const int wid=__builtin_amdgcn_readfirstlane(tid>>6);
  const long rowbase=(long)b*SEQ; const int q0=qb*QB;
  const bf16*Qw=Q+(rowbase+q0+wid*QBLK)*DM+h*D;
  const int kvh=FOX?h:(h>>3); const int T0=FOX?0:(qb==0?0:4*qb-2);
  const bf16*Kh=K+(rowbase+(long)T0*KVBLK)*KP+kvh*D,*Vh=V+(rowbase+(long)T0*KVBLK)*KP+kvh*D; const float*Cs=FOX?Cb+lane:nullptr;
  const unsigned lds0=(unsigned)(uintptr_t)shm;
  float*wsf=(float*)(shm+LDS_WS)+wid*64;
  const bf16*ksrc=Kh+(long)lane*KP+wid*8;
  const bf16*vsrc=Vh+(long)(16*(wid&3)+(lane>>2))*KP+(wid>>2)*32+(lane&3)*8;
  const unsigned kdst=lds0+LDS_K+wid*1024, vdst=lds0+LDS_V+wid*1024;
  #define DMA_K(t,slot) glds16(ksrc+(long)(t)*KVBLK*KP,(unsigned)__builtin_amdgcn_readfirstlane(kdst+(slot)))
  #define DMA_C(t) do{ if(FOX) glds4(Cs+(long)(t)*KVBLK,(unsigned)__builtin_amdgcn_readfirstlane(lds0+LDS_CB+(((t)&3)<<8))); }while(0)
  #define PREFILL(X0,X1,t) do{ if(FOX){ fill_bias(X0,X1,cb0+(((t)&3)<<8),-mhat); } else { _Pragma("unroll") for(int r=0;r<16;++r){X0[r]=-mhat;X1[r]=-mhat;} } }while(0)
  #define DMA_V(t,slot) glds16(vsrc+(long)(t)*KVBLK*KP,(unsigned)__builtin_amdgcn_readfirstlane(vdst+(slot)))
  const int vb0=(int)(lds0+LDS_V)+((lane>>4)&1)*32+(lane&3)*8+(4*hi+((lane&15)>>2))*64;
  const char*Kbase=shm+LDS_K; bf16x8 kf[8];
  const lds_cptr shm3=(lds_cptr)shm; const lds_cptr cb0=shm3+LDS_CB+hi*16; const lds_cptr kp0=shm3+LDS_K+hi*1024+r32*16; const lds_cptr vp0=shm3+LDS_V+((lane>>4)&1)*32+(lane&3)*8+(4*hi+((lane&15)>>2))*64;
  const int NT=FOX?(q0+QB)/KVBLK:(qb==0?4:6);
  DMA_K(0,0);DMA_C(0);DMA_V(0,0);DMA_K(1,SLOTB);DMA_C(1);
  bf16x8 qr[4];
  #pragma unroll
  for(int d0=0;d0<4;++d0)qr[d0]=*reinterpret_cast<const bf16x8*>(&Qw[(long)r32*DM+d0*16+hi*8]);
  float mhat=FOX?-Cb[q0+wid*QBLK+r32]:0.f,l_reg=0.f;    f32x16 o[2];o[0]=f32x16{};o[1]=f32x16{};
  const int qrel=wid*QBLK+r32;
  #define CMASK(P0,P1,t) do{int jb_=(t)-(NT-4); if(!FOX||jb_>=0)cmask<!FOX>(P0,P1,jb_,qrel,hi);}while(0)
  bool resc=false;
  #define START(P0,P1) do{ float rm=__builtin_fmaxf(rowmax(P0,P1),0.f); resc=false;     \
    { const float dl=rm; mhat=fadd_s(mhat,dl); \
      _Pragma("unroll") for(int r=0;r<16;++r){P0[r]=fsub_s(P0[r],dl);P1[r]=fsub_s(P1[r],dl);} } \
    _Pragma("unroll") for(int r=0;r<16;++r)P0[r]=__builtin_amdgcn_exp2f(P0[r]); }while(0)
  #define RESC() do{ if(resc){ asm volatile("s_waitcnt lgkmcnt(0)":::"memory"); \
      _Pragma("unroll") for(int d_=0;d_<2;++d_) _Pragma("unroll") for(int r=0;r<16;++r)o[d_][r]*=wsf[crow(r,hi)]; } }while(0)
  f32x16 pA0,pA1,pB0,pB1;
  int sl_prev=0,sl_cur=0,sl_next=SLOTB;
  #define ROT() do{sl_prev=sl_cur;sl_cur=sl_next;sl_next=(sl_next==(NSLOT-1)*SLOTB)?0:sl_next+SLOTB;}while(0)
  DMA_K(2,2*SLOTB);DMA_C(2);
  if(FOX){WAIT_BAR(5);}else{WAIT_BAR(3);}
  PREFILL(pA0,pA1,0); qkt(pA0,pA1,Kbase,qr,r32,hi);asm volatile("s_nop 15\n\ts_nop 7":"+v"(pA0),"+v"(pA1));CMASK(pA0,pA1,0);
  START(pA0,pA1);
  _Pragma("unroll") for(int r=0;r<16;++r)pA1[r]=__builtin_amdgcn_exp2f(pA1[r]);
  WAIT_BAR(0);
  DMA_K(3,0);DMA_C(3);DMA_V(1,SLOTB);
  ROT();
  kload8(kf,kp0+sl_cur);
  PREFILL(pB0,pB1,1); if(FOX){ WAIT_BAR(3); }else{ WAIT_BAR(2); }
  s16x4 vlo[NVB],vhi[NVB]; u32x4 pw0,pw1,pw2,pw3;
  #define PKW(P,B) cvtpk_s(P[B],P[B+1])
  #define PAF(k) __builtin_bit_cast(bf16x8,pw##k)
  #define VFR(j) (bf16x8){vlo[(j)%NVB][0],vlo[(j)%NVB][1],vlo[(j)%NVB][2],vlo[(j)%NVB][3],vhi[(j)%NVB][0],vhi[(j)%NVB][1],vhi[(j)%NVB][2],vhi[(j)%NVB][3]}
  #define PIN(x) asm volatile("":"+v"(x))
  #define MX3(a,b,c) __builtin_fmaxf(__builtin_fmaxf((a),(b)),(c))
  #define GAPA(MF,A0,A1,A2,A3,W0,W1,PW) do{ MF; sacc+=(f32x2_t){A0,A1}; sacc+=(f32x2_t){A2,A3}; PIN(sacc); W0; W1; PIN(PW); SBAR(); }while(0)
  #define EX(v) __builtin_amdgcn_exp2f(v)
  #define GAPB(MF,VR,BX_,X,B) do{ MF; VR; BX_; X[B]=EX(X[B]); X[B+1]=EX(X[B+1]); X[B+2]=EX(X[B+2]); X[B+3]=EX(X[B+3]); PIN(X); SBAR(); }while(0)
  #define VOFF(j) ((((j)&1)*4096)+(((j)>>1)*1024))
  #define VRD(j) do{ if((j)>=0&&(j)<8){ vlo[(j)%NVB]=vtr(vp_+VOFF(j)); vhi[(j)%NVB]=vtr(vp_+VOFF(j)+512); } }while(0)
  #define KRD(G,j) do{ if(G){ kload2(kf,kp0+sl_next,j); SBAR(); } }while(0)
  #define BSUBX(X,g) do{ const f32x2_t nm_={nmh_,nmh_}; const f32x2_t a_=nm_-(f32x2_t){bt[0],bt[1]}, b_=nm_-(f32x2_t){bt[2],bt[3]}; X[4*(g)+0]=a_.x; X[4*(g)+1]=a_.y; X[4*(g)+2]=b_.x; X[4*(g)+3]=b_.y; }while(0)
  #define BXX(Y0,Y1,j,G) do{ if(FOX&&(G)){ if((j)>=1&&(j)<=4){BSUBX(Y0,((j)-1)&3);} if((j)>=5){BSUBX(Y1,((j)-5)&3);} if((j)<8){ bt=*(lds_f4ptr)(cbn_+(((j)&3)*32+((j)>>2)*128)); } } }while(0)
  #define STEP(C0,C1,P0,P1,t,GK,GV,GL) do{ SBAR(); f32x4v bt; const lds_cptr cbn_=cb0+((((t)+1)&3)<<8); \
    const lds_cptr vp_=vp0+sl_prev; \
    VRD(0-(8-NVB)); SBAR(); f32x2_t sacc={P0[0],P0[1]}; \
    GAPA(C0=__builtin_amdgcn_mfma_f32_32x32x16_bf16(kf[0],qr[0],C0,0,0,0), P0[2],P0[3],P0[4],P0[5],     pw0[0]=PKW(P0,0), pw0[1]=PKW(P0,2), pw0); \
    VRD(1-(8-NVB)); SBAR(); GAPA(C1=__builtin_amdgcn_mfma_f32_32x32x16_bf16(kf[1],qr[0],C1,0,0,0), P0[6],P0[7],P0[8],P0[9],     pw0[2]=PKW(P0,4), pw0[3]=PKW(P0,6), pw0); \
    VRD(2-(8-NVB)); SBAR(); GAPA(C0=__builtin_amdgcn_mfma_f32_32x32x16_bf16(kf[2],qr[1],C0,0,0,0),   P0[10],P0[11],P0[12],P0[13], pw1[0]=PKW(P0,8), pw1[1]=PKW(P0,10), pw1); \
    VRD(3-(8-NVB)); SBAR(); GAPA(C1=__builtin_amdgcn_mfma_f32_32x32x16_bf16(kf[3],qr[1],C1,0,0,0),   P0[14],P0[15],P1[0],P1[1],   pw1[2]=PKW(P0,12),pw1[3]=PKW(P0,14), pw1); \
    VRD(4-(8-NVB)); SBAR(); GAPA(C0=__builtin_amdgcn_mfma_f32_32x32x16_bf16(kf[4],qr[2],C0,0,0,0),   P1[2],P1[3],P1[4],P1[5],     pw2[0]=PKW(P1,0), pw2[1]=PKW(P1,2), pw2); \
    VRD(5-(8-NVB)); SBAR(); GAPA(C1=__builtin_amdgcn_mfma_f32_32x32x16_bf16(kf[5],qr[2],C1,0,0,0),   P1[6],P1[7],P1[8],P1[9],     pw2[2]=PKW(P1,4), pw2[3]=PKW(P1,6), pw2); \
    VRD(6-(8-NVB)); SBAR(); GAPA(C0=__builtin_amdgcn_mfma_f32_32x32x16_bf16(kf[6],qr[3],C0,0,0,0),   P1[10],P1[11],P1[12],P1[13], pw3[0]=PKW(P1,8), pw3[1]=PKW(P1,10), pw3); \
    VRD(7-(8-NVB)); SBAR(); GAPA(C1=__builtin_amdgcn_mfma_f32_32x32x16_bf16(kf[7],qr[3],C1,0,0,0),   P1[14],P1[15],0.f,0.f,       pw3[2]=PKW(P1,12),pw3[3]=PKW(P1,14), pw3); \
    l_reg+=sacc.x+sacc.y; \
    if(GK){DMA_K((t)+3,sl_cur);DMA_C((t)+3);} if(GV){DMA_V((t)+1,sl_next);} \
    CMASK(C0,C1,t); \
    { float a=MX3(C0[0],C0[1],C1[0]),b=MX3(C0[2],C0[3],C1[1]); a=MX3(a,C1[2],C1[3]); \
      _Pragma("unroll") for(int r=4;r<16;r+=4){a=MX3(a,C0[r],C0[r+1]);b=MX3(b,C0[r+2],C0[r+3]);a=MX3(a,C1[r],C1[r+1]);b=MX3(b,C1[r+2],C1[r+3]);} \
      float rm=__builtin_fmaxf(a,b); { auto rr=__builtin_amdgcn_permlane32_swap(__float_as_uint(rm),__float_as_uint(rm),false,false); rm=__builtin_fmaxf(__uint_as_float(rr[0]),__uint_as_float(rr[1])); } \
      resc=false; \
      if(__builtin_expect(__any(rm>(float)THRL),0)){ const float dl=__builtin_fmaxf(rm,0.f); mhat+=dl; \
        _Pragma("unroll") for(int r=0;r<16;++r){C0[r]-=dl;C1[r]-=dl;} \
        const float f=__builtin_amdgcn_exp2f(-dl); l_reg*=f; if(hi==0)wsf[r32]=f; resc=true; } } \
    const float nmh_=-mhat; SBAR(); \
    GAPB(o[0]=__builtin_amdgcn_mfma_f32_32x32x16_bf16(PAF(0),VFR(0),o[0],0,0,0), VRD(0+NVB), BXX(P0,P1,0,GL), C0,0); \
    GAPB(o[1]=__builtin_amdgcn_mfma_f32_32x32x16_bf16(PAF(0),VFR(1),o[1],0,0,0), VRD(1+NVB), BXX(P0,P1,1,GL), C0,4); \
    KRD(GL,0); GAPB(o[0]=__builtin_amdgcn_mfma_f32_32x32x16_bf16(PAF(1),VFR(2),o[0],0,0,0), VRD(2+NVB), BXX(P0,P1,2,GL), C0,8); \
    KRD(GL,1); GAPB(o[1]=__builtin_amdgcn_mfma_f32_32x32x16_bf16(PAF(1),VFR(3),o[1],0,0,0), VRD(3+NVB), BXX(P0,P1,3,GL), C0,12); \
    KRD(GL,2); GAPB(o[0]=__builtin_amdgcn_mfma_f32_32x32x16_bf16(PAF(2),VFR(4),o[0],0,0,0), VRD(4+NVB), BXX(P0,P1,4,GL), C1,0); \
    KRD(GL,3); GAPB(o[1]=__builtin_amdgcn_mfma_f32_32x32x16_bf16(PAF(2),VFR(5),o[1],0,0,0), VRD(5+NVB), BXX(P0,P1,5,GL), C1,4); \
    GAPB(o[0]=__builtin_amdgcn_mfma_f32_32x32x16_bf16(PAF(3),VFR(6),o[0],0,0,0), VRD(6+NVB), BXX(P0,P1,6,GL), C1,8); \
    GAPB(o[1]=__builtin_amdgcn_mfma_f32_32x32x16_bf16(PAF(3),VFR(7),o[1],0,0,0), VRD(7+NVB), BXX(P0,P1,7,GL), C1,12); \
    BXX(P0,P1,8,GL); if(!FOX&&(GL)){ PREFILL(P0,P1,(t)+1); } \
    }while(0)
  int t=1;
  #undef CMASK
  #define CMASK(P0,P1,t) do{}while(0)
  for(;t+5<NT;t+=2){
    STEP(pB0,pB1,pA0,pA1,t,true,true,true);     if(FOX){WAIT_BAR(3);}else{WAIT_BAR(2);} RESC(); ROT();
    STEP(pA0,pA1,pB0,pB1,t+1,true,true,true);   if(FOX){WAIT_BAR(3);}else{WAIT_BAR(2);} RESC(); ROT();
  }
  #undef CMASK
  #define CMASK(P0,P1,t) do{int jb_=(t)-(NT-4); if(!FOX||jb_>=0)cmask<!FOX>(P0,P1,jb_,qrel,hi);}while(0)
  #define ENDW(tt) do{ if((tt)+3<NT){ if(FOX){WAIT_BAR(3);}else{WAIT_BAR(2);} } else if((tt)+2<NT){WAIT_BAR(1);} else {WAIT_BAR(0);} }while(0)
  for(;t+1<NT;t+=2){
    STEP(pB0,pB1,pA0,pA1,t,(t+3<NT),(t+1<NT),(t+1<NT));       ENDW(t);   RESC(); ROT();
    STEP(pA0,pA1,pB0,pB1,t+1,(t+4<NT),(t+2<NT),(t+2<NT));     ENDW(t+1); RESC(); ROT();
  }
  STEP(pB0,pB1,pA0,pA1,NT-1,false,false,false); RESC();
  { float sacc=pB0[0]+pB0[1]; _Pragma("unroll") for(int r=2;r<16;++r)sacc+=pB0[r]; _Pragma("unroll") for(int r=0;r<16;++r)sacc+=pB1[r]; l_reg+=sacc;
    pw0=(u32x4){PKW(pB0,0),PKW(pB0,2),PKW(pB0,4),PKW(pB0,6)};pw1=(u32x4){PKW(pB0,8),PKW(pB0,10),PKW(pB0,12),PKW(pB0,14)};pw2=(u32x4){PKW(pB1,0),PKW(pB1,2),PKW(pB1,4),PKW(pB1,6)};pw3=(u32x4){PKW(pB1,8),PKW(pB1,10),PKW(pB1,12),PKW(pB1,14)};
    SBAR(); pv(o,vb0+sl_cur,PAF(0),PAF(1),PAF(2),PAF(3)); }
  #undef PKW
  #undef PAF
  #undef VFR
  #undef PIN
  #undef MX3
  #undef GAPA
  #undef GAPB
  #undef EX
  #undef VRD
  #undef VOFF
  #undef KRD
  #undef STEP
  #undef ENDW
  {auto rr=__builtin_amdgcn_permlane32_swap(__float_as_uint(l_reg),__float_as_uint(l_reg),false,false);l_reg=__uint_as_float(rr[0])+__uint_as_float(rr[1]);}
  if(!FOX) l_reg+=__builtin_amdgcn_exp2f(sink2-mhat);
  if(hi==0)wsf[32+r32]=l_reg;asm volatile("s_waitcnt lgkmcnt(0)":::"memory");
  float rli[16];
  #pragma unroll
  for(int r=0;r<16;++r)rli[r]=__builtin_amdgcn_rcpf(wsf[32+crow(r,hi)]);
  bf16*Ow=O+(rowbase+q0+wid*QBLK)*DM+h*D;
  { bf16*stg=(bf16*)(shm+LDS_OST)+wid*2048;
    #pragma unroll
    for(int r=0;r<16;++r){const int orow=crow(r,hi);
      #pragma unroll
      for(int d0=0;d0<2;++d0)stg[orow*64+d0*32+r32]=(bf16)(cvtpk_s(o[d0][r]*rli[r],0.f)&0xffffu);}
    asm volatile("s_waitcnt lgkmcnt(0)":::"memory");
    #pragma unroll
    for(int i=0;i<4;++i){const int row=i*8+(lane>>3),ch=lane&7; const u32x4 v=*(const u32x4*)(stg+row*64+ch*8); ATTN_STORE16(Ow+(long)row*DM+ch*8,v);} }
  asm volatile("s_waitcnt lgkmcnt(0)\n\ts_barrier":::"memory");
  #undef DMA_K
  #undef DMA_V
  #undef DMA_C
  #undef PREFILL
  #undef BSUBX
  #undef BXX
  #undef CMASK
  #undef START
  #undef RESC
  #undef ROT
}
constexpr int ATTN_LDS_BYTES=LDS_BYTES;
#undef SBAR
#undef WAIT_BAR
}

#ifndef REP_PHASE
#define REP_PHASE 0
#endif
#ifndef FUSED_FINAL
#define FUSED_FINAL 0
#endif
#ifndef NAIVE_SWA
#define NAIVE_SWA 0
#endif
#ifndef NAIVE_FOX
#define NAIVE_FOX 0
#endif
#define LAS __attribute__((address_space(3)))
typedef unsigned short bf16;
typedef float f32x4 __attribute__((ext_vector_type(4)));
typedef unsigned v4u __attribute__((ext_vector_type(4)));
typedef unsigned v2u __attribute__((ext_vector_type(2)));
constexpr int NWAVES = 8;
constexpr int RING_BYTES = 131072, LDS_BYTES = 147456;

__device__ __forceinline__ float wave_sum(float v) {
#pragma unroll
    for (int o = 1; o < 64; o <<= 1) v += __shfl_xor(v, o);
    return v;
}
#define LDS_WAIT() asm volatile("s_waitcnt lgkmcnt(0)" ::: "memory")

#define XB_TMO      128
#define XB_XCNT(j)  (256  + 64 * (j))
#define XB_XSUB(j)  (1280 + 64 * (j))
#define XB_XGEN(j)  (2304 + 64 * (j))
#define XB_TOP      3328
#define XB_TOPGEN   3392
#define XCD_BAR_WORDS 3456
#define XB_SPIN_CAP (1u << 18)

__device__ __forceinline__ unsigned xb_ld(unsigned* p)              { return __hip_atomic_load(p, __ATOMIC_RELAXED, __HIP_MEMORY_SCOPE_AGENT); }
__device__ __forceinline__ unsigned xb_add(unsigned* p, unsigned v) { return __hip_atomic_fetch_add(p, v, __ATOMIC_RELAXED, __HIP_MEMORY_SCOPE_AGENT); }
__device__ __forceinline__ unsigned xb_xcc_id() { return (unsigned)__builtin_amdgcn_s_getreg((3 << 11) | 20) & 0xFu; }
#define XB_SPIN(cond, bar) do { unsigned _sp = 0; while (cond) { __builtin_amdgcn_s_sleep(1); \
    if ((++_sp & 255u) == 0u) { if (xb_ld(&(bar)[XB_TMO])) break; if (_sp > XB_SPIN_CAP) { atomicAdd(&(bar)[XB_TMO], 1u); break; } } } } while (0)

struct XcdBarrier {
    unsigned* bar; unsigned x;
    volatile LAS unsigned* st;
};

__device__ __forceinline__ XcdBarrier xcd_barrier_post(unsigned* bar, volatile LAS unsigned* st) {
    XcdBarrier b; b.bar = bar; b.x = xb_xcc_id(); b.st = st;
    if (threadIdx.x == 0) (void)xb_add(&bar[XB_XCNT(b.x)], 1u);
    return b;
}
__device__ __forceinline__ void xcd_barrier_complete(unsigned* bar, unsigned x, unsigned& nloc, unsigned& nx) {
    const unsigned G = gridDim.x * gridDim.y * gridDim.z;
    unsigned sum, cnt, mine, sp = 0u;
    for (;;) {
        sum = 0u; cnt = 0u; mine = 0u;
#pragma unroll
        for (unsigned j = 0; j < 16; ++j) { const unsigned c = xb_ld(&bar[XB_XCNT(j)]); sum += c; cnt += (c > 0u) ? 1u : 0u; mine = (j == x) ? c : mine; }
        if (sum == G) break;
        __builtin_amdgcn_s_sleep(1);
        if ((++sp & 255u) == 0u) { if (xb_ld(&bar[XB_TMO])) break; if (sp > XB_SPIN_CAP) { atomicAdd(&bar[XB_TMO], 1u); break; } }
    }
    nloc = mine > 0u ? mine : 1u; nx = cnt > 0u ? cnt : 1u;
}

__device__ __forceinline__ void xcd_barrier(const XcdBarrier& b) {
    asm volatile("s_waitcnt vmcnt(0)" ::: "memory");
    __syncthreads();
    if (threadIdx.x == 0) {
        unsigned* bar = b.bar;
        __builtin_amdgcn_s_waitcnt(0);
        unsigned nloc = b.st[0], nx = b.st[1];
        if (nloc == 0u) { xcd_barrier_complete(bar, b.x, nloc, nx); b.st[0] = nloc; b.st[1] = nx; }
        const unsigned old = xb_add(&bar[XB_XSUB(b.x)], 1u);
        const unsigned gen = old / nloc;
        if (old + 1u == (gen + 1u) * nloc) {
            __builtin_amdgcn_fence(__ATOMIC_RELEASE, "agent");
            asm volatile("s_waitcnt vmcnt(0)" ::: "memory");
            const unsigned og = xb_add(&bar[XB_TOP], 1u);
            const unsigned tg = og / nx;
            if (og + 1u == (tg + 1u) * nx) xb_add(&bar[XB_TOPGEN], 1u);
            else XB_SPIN(xb_ld(&bar[XB_TOPGEN]) == tg, bar);
            __builtin_amdgcn_fence(__ATOMIC_ACQUIRE, "agent");
            xb_add(&bar[XB_XGEN(b.x)], 1u);
            asm volatile("s_waitcnt vmcnt(0)" ::: "memory");
        } else {
            XB_SPIN(xb_ld(&bar[XB_XGEN(b.x)]) == gen, bar);
            __builtin_amdgcn_fence(__ATOMIC_ACQUIRE, "agent");
            asm volatile("s_waitcnt vmcnt(0)" ::: "memory");
        }
    }
    __syncthreads();
}


__device__ __forceinline__ void tr_item(const float* W, int K, int N, bf16* WT, int dst_row0, int src_col0, int nvalid, int kb, const float* kscale, LAS float* scr, int lane) {
    const int k0 = 64 * kb, c = lane & 31;
    float tv[32];
    const float* wp = W + (size_t)(k0 + (lane >> 5)) * N + src_col0 + c;
#pragma unroll
    for (int i = 0; i < 32; ++i) { tv[i] = 0.f; if (c < nvalid) tv[i] = __builtin_nontemporal_load(wp + (size_t)(2 * i) * N); }
#pragma unroll
    for (int i = 0; i < 32; ++i) { const int kk = 2 * i + (lane >> 5); float v = tv[i]; if (kscale) v *= kscale[k0 + kk]; scr[kk * 33 + c] = v; }
    LDS_WAIT(); asm volatile("" ::: "memory");
    const int ch = lane & 7;
#pragma unroll
    for (int j = 0; j < 4; ++j) { const int n = (lane >> 3) + 8 * j; const LAS float* s = scr + (8 * ch) * 33 + n;
        v4u o; o.x = pg8::cvt_pk_bf16(s[0 * 33], s[1 * 33]); o.y = pg8::cvt_pk_bf16(s[2 * 33], s[3 * 33]); o.z = pg8::cvt_pk_bf16(s[4 * 33], s[5 * 33]); o.w = pg8::cvt_pk_bf16(s[6 * 33], s[7 * 33]);
        *(v4u*)(WT + (size_t)(dst_row0 + n) * K + k0 + 8 * ch) = o; }
    LDS_WAIT(); asm volatile("" ::: "memory");
}
__device__ __forceinline__ void win_map(int db, int& src, int& nv) {
    const int pn = db >> 3, bj = (db >> 2) & 1, wc = db & 3; nv = 32;
    if (pn < 4) src = (4 * pn + wc) * 64 + 32 * bj;
    else if (pn == 4) src = (wc < 2 ? 1024 + wc * 64 : 1152 + (wc - 2) * 64) + 32 * bj;
    else if (pn < 17) { const int t = pn - 5; src = 1280 + (t >> 2) * 1024 + (4 * (t & 3) + wc) * 64 + 32 * bj; }
    else if (pn < 33) src = 4368 + (db - 136) * 32;
    else { src = 4352; nv = (db == 264) ? 16 : 0; }
}

struct Args { const float* x; const int* pos; const float* attn_norm; const float* w_in; const float* fbias; const float* sinks; const float* w_bs; const float* w_bf;
              const float* w_out; const float* mlp_norm; const float* w_up; const float* w_dn; const float* final_norm; float* out; unsigned char* ws; long long fused_final; };

__device__ __forceinline__ void rms_row_to_bf16(const float* xrow, const float* gain, bf16* orow, int lane) {
    const f32x4* xr = (const f32x4*)xrow + lane; f32x4 v[8]; float s = 0.f;
#pragma unroll
    for (int j = 0; j < 8; ++j) { v[j] = xr[64 * j]; s += (v[j].x * v[j].x + v[j].y * v[j].y) + (v[j].z * v[j].z + v[j].w * v[j].w); }
    const float rstd = __builtin_amdgcn_rsqf(wave_sum(s) * (1.f / DM) + RMS_EPS);
    const f32x4* gr = (const f32x4*)gain + lane; v2u* o8 = (v2u*)orow + lane;
#pragma unroll
    for (int j = 0; j < 8; ++j) { const f32x4 g = gr[64 * j]; v2u w; w.x = pg8::cvt_pk_bf16(v[j].x * rstd * g.x, v[j].y * rstd * g.y); w.y = pg8::cvt_pk_bf16(v[j].z * rstd * g.z, v[j].w * rstd * g.w); o8[64 * j] = w; }
}

__device__ __forceinline__ void rms_row2_to_bf16(const float* x0, const float* x1, const float* gain, bf16* o0, bf16* o1, int lane) {
    const f32x4* xr0 = (const f32x4*)x0 + lane; const f32x4* xr1 = (const f32x4*)x1 + lane; f32x4 v[8], w[8]; float s = 0.f, t = 0.f;
#pragma unroll
    for (int j = 0; j < 8; ++j) { v[j] = __builtin_nontemporal_load(xr0 + 64 * j); w[j] = __builtin_nontemporal_load(xr1 + 64 * j); }
#pragma unroll
    for (int j = 0; j < 8; ++j) { s += (v[j].x * v[j].x + v[j].y * v[j].y) + (v[j].z * v[j].z + v[j].w * v[j].w); t += (w[j].x * w[j].x + w[j].y * w[j].y) + (w[j].z * w[j].z + w[j].w * w[j].w); }
    const float rs = __builtin_amdgcn_rsqf(wave_sum(s) * (1.f / DM) + RMS_EPS), rt = __builtin_amdgcn_rsqf(wave_sum(t) * (1.f / DM) + RMS_EPS);
    const f32x4* gr = (const f32x4*)gain + lane; v2u* p0 = (v2u*)o0 + lane; v2u* p1 = (v2u*)o1 + lane;
#pragma unroll
    for (int j = 0; j < 8; ++j) { const f32x4 g = gr[64 * j]; v2u a, c;
        a.x = pg8::cvt_pk_bf16(v[j].x * rs * g.x, v[j].y * rs * g.y); a.y = pg8::cvt_pk_bf16(v[j].z * rs * g.z, v[j].w * rs * g.w);
        c.x = pg8::cvt_pk_bf16(w[j].x * rt * g.x, w[j].y * rt * g.y); c.y = pg8::cvt_pk_bf16(w[j].z * rt * g.z, w[j].w * rt * g.w);
        p0[64 * j] = a; p1[64 * j] = c; }
}
__device__ __forceinline__ void p0_prologue(const Args& a, LAS unsigned char* lds, int vcu, int G, int wave, int lane) {
    unsigned char* ws = a.ws;
    LAS float* scr = (LAS float*)(lds + wave * 16384);
    const int gw = vcu * NWAVES + wave, NGW = G * NWAVES;
    constexpr int I_IN = (NIN / 32) * (DM / 64), I_BS = (DM / 32) * (1024 / 64), I_OUT = (DM / 32) * (DM / 64), I_UP = (DFF / 32) * (DM / 64), I_DN = (DM / 32) * (DFF / 64);
    constexpr int NITEMS = I_IN + 2 * I_BS + I_OUT + I_UP + I_DN;
    for (int it = gw; it < NITEMS; it += NGW) {
        int r = it;
        if (r < I_IN) { const int db = r / (DM / 64), kb = r % (DM / 64); int src, nv; win_map(db, src, nv); tr_item(a.w_in, DM, DIN, (bf16*)(ws + WS_WIN), db * 32, src, nv, kb, nullptr, scr, lane); continue; } r -= I_IN;
        if (r < I_BS) { const int db = r / 16, kb = r % 16; tr_item(a.w_bs, 1024, DM, (bf16*)(ws + WS_WBS), db * 32, db * 32, 32, kb, nullptr, scr, lane); continue; } r -= I_BS;
        if (r < I_BS) { const int db = r / 16, kb = r % 16; tr_item(a.w_bf, 1024, DM, (bf16*)(ws + WS_WBF), db * 32, db * 32, 32, kb, nullptr, scr, lane); continue; } r -= I_BS;
        if (r < I_OUT) { const int db = r / 32, kb = r % 32; tr_item(a.w_out, DM, DM, (bf16*)(ws + WS_WOUT), db * 32, db * 32, 32, kb, nullptr, scr, lane); continue; } r -= I_OUT;
        if (r < I_UP) { const int db = r / 32, kb = r % 32; tr_item(a.w_up, DM, DFF, (bf16*)(ws + WS_WUP), db * 32, db * 32, 32, kb, a.mlp_norm, scr, lane); continue; } r -= I_UP;
        { const int db = r / 128, kb = r % 128; tr_item(a.w_dn, DFF, DM, (bf16*)(ws + WS_WDN), db * 32, db * 32, 32, kb, nullptr, scr, lane); }
    }
    for (int m = gw; m < M; m += 2 * NGW) rms_row2_to_bf16(a.x + (size_t)m * DM, a.x + (size_t)(m + NGW) * DM, a.attn_norm, (bf16*)(ws + WS_XN) + (size_t)m * DM, (bf16*)(ws + WS_XN) + (size_t)(m + NGW) * DM, lane);
    float* cs = (float*)(ws + WS_CS);
    for (int e = gw * 64 + lane; e < M * 32; e += NGW * 64) {
        const int tok = e >> 5, i = e & 31;
        const float inv_freq = powf(10000.0f, -(float)(2 * i) / 64.0f);
        const float ang = (float)a.pos[tok] * inv_freq;
        double rev = (double)ang * 0.15915494309189535; rev -= floor(rev);
        const float rf = (float)rev;
        cs[e] = __builtin_amdgcn_cosf(rf); cs[(size_t)M * 32 + e] = __builtin_amdgcn_sinf(rf);
    }
}

__device__ __forceinline__ void cumsum_unit(const Args& a, int bh, LAS unsigned char* lds) {
    const float* FL = (const float*)(a.ws + WS_FL); float* Cp = (float*)(a.ws + WS_C);
    LAS double* sh = (LAS double*)lds;
    const int b = bh >> 4, h = bh & 15, tid = threadIdx.x, s0 = tid * 16; const float fb = a.fbias[h];
    float ls[16]; double run = 0.0;
#pragma unroll
    for (int i = 0; i < 16; ++i) { const float z = FL[(size_t)(b * SEQ + s0 + i) * 16 + h] + fb; const float v = fminf(z, 0.f) - log1pf(expf(-fabsf(z))); ls[i] = v; run += (double)v; }
    sh[tid] = run; __syncthreads();
    double pre = 0.0; for (int k = 0; k < tid; ++k) pre += sh[k];
#pragma unroll
    for (int i = 0; i < 16; ++i) { pre += (double)ls[i]; Cp[(size_t)bh * SEQ + s0 + i] = (float)(pre * 1.4426950408889634); }
    __syncthreads();
}

__device__ __forceinline__ void naive_swa_unit(const Args& a, int unit) {
    const bf16* AQ = (const bf16*)(a.ws + WS_AQ); const bf16* AK = (const bf16*)(a.ws + WS_AK); const bf16* AV = (const bf16*)(a.ws + WS_AV); bf16* OA = (bf16*)(a.ws + WS_OA);
    const int tid = threadIdx.x, head = tid & 15, tok = unit * 32 + (tid >> 4), b = tok / SEQ, s = tok % SEQ, kvh = head >> 3;
    float q[64], o[64]; float m = -INFINITY, l = 0.f;
    { const v4u* qp = (const v4u*)(AQ + (size_t)tok * 1024 + head * 64);
#pragma unroll
      for (int c = 0; c < 8; ++c) { const v4u w = qp[c];
#pragma unroll
          for (int e = 0; e < 4; ++e) { q[8 * c + 2 * e] = pg8::bf_lo(w[e]); q[8 * c + 2 * e + 1] = pg8::bf_hi(w[e]); } } }
#pragma unroll
    for (int d = 0; d < 64; ++d) o[d] = 0.f;
    for (int i = 0; i < 128; ++i) {
        const int j = s - i; const bool valid = j >= 0; const int jj = valid ? j : 0;
        const v4u* kp = (const v4u*)(AK + (size_t)(b * SEQ + jj) * 128 + kvh * 64); const v4u* vp = (const v4u*)(AV + (size_t)(b * SEQ + jj) * 128 + kvh * 64);
        float dot = 0.f;
#pragma unroll
        for (int c = 0; c < 8; ++c) { const v4u w = kp[c];
#pragma unroll
            for (int e = 0; e < 4; ++e) { dot += q[8 * c + 2 * e] * pg8::bf_lo(w[e]); dot += q[8 * c + 2 * e + 1] * pg8::bf_hi(w[e]); } }
        const float lg = valid ? dot : -INFINITY;
        const float mn = fmaxf(m, lg), al = __builtin_amdgcn_exp2f(m - mn), p = __builtin_amdgcn_exp2f(lg - mn);
        l = l * al + p; m = mn;
#pragma unroll
        for (int c = 0; c < 8; ++c) { const v4u w = vp[c];
#pragma unroll
            for (int e = 0; e < 4; ++e) { o[8 * c + 2 * e] = o[8 * c + 2 * e] * al + p * pg8::bf_lo(w[e]); o[8 * c + 2 * e + 1] = o[8 * c + 2 * e + 1] * al + p * pg8::bf_hi(w[e]); } }
    }
    { const float sk = a.sinks[head] * LOG2E; const float m2 = fmaxf(m, sk), al = __builtin_amdgcn_exp2f(m - m2); l = l * al + __builtin_amdgcn_exp2f(sk - m2);
      const float rl = al / l;
      v4u* op = (v4u*)(OA + (size_t)tok * 1024 + head * 64);
#pragma unroll
      for (int c = 0; c < 8; ++c) { v4u w;
#pragma unroll
          for (int e = 0; e < 4; ++e) w[e] = pg8::cvt_pk_bf16(o[8 * c + 2 * e] * rl, o[8 * c + 2 * e + 1] * rl);
          op[c] = w; } }
}
__device__ __forceinline__ void naive_fox_unit(const Args& a, int bh, int qblk) {
    const bf16* FQ = (const bf16*)(a.ws + WS_FQ); const bf16* FK = (const bf16*)(a.ws + WS_FK); const bf16* FV = (const bf16*)(a.ws + WS_FV); bf16* OB = (bf16*)(a.ws + WS_OB);
    const float* Cp = (const float*)(a.ws + WS_C) + (size_t)bh * SEQ;
    const int tid = threadIdx.x, b = bh >> 4, h = bh & 15, s = qblk * 512 + tid; const size_t tok = (size_t)b * SEQ + s;
    float q[64], o[64]; float m = -INFINITY, l = 0.f;
    { const v4u* qp = (const v4u*)(FQ + tok * 1024 + h * 64);
#pragma unroll
      for (int c = 0; c < 8; ++c) { const v4u w = qp[c];
#pragma unroll
          for (int e = 0; e < 4; ++e) { q[8 * c + 2 * e] = pg8::bf_lo(w[e]); q[8 * c + 2 * e + 1] = pg8::bf_hi(w[e]); } } }
#pragma unroll
    for (int d = 0; d < 64; ++d) o[d] = 0.f;
    const float cq = Cp[s];
    const int jend = __builtin_amdgcn_readfirstlane(qblk * 512 + (tid | 63));
    for (int j = 0; j <= jend; ++j) {
        const v4u* kp = (const v4u*)(FK + ((size_t)b * SEQ + j) * 1024 + h * 64); const v4u* vp = (const v4u*)(FV + ((size_t)b * SEQ + j) * 1024 + h * 64);
        float dot = 0.f;
#pragma unroll
        for (int c = 0; c < 8; ++c) { const v4u w = kp[c];
#pragma unroll
            for (int e = 0; e < 4; ++e) { dot += q[8 * c + 2 * e] * pg8::bf_lo(w[e]); dot += q[8 * c + 2 * e + 1] * pg8::bf_hi(w[e]); } }
        float lg = dot + (cq - Cp[j]); lg = (j <= s) ? lg : -INFINITY;
        const float mn = fmaxf(m, lg), al = __builtin_amdgcn_exp2f(m - mn), p = __builtin_amdgcn_exp2f(lg - mn);
        l = l * al + p; m = mn;
#pragma unroll
        for (int c = 0; c < 8; ++c) { const v4u w = vp[c];
#pragma unroll
            for (int e = 0; e < 4; ++e) { o[8 * c + 2 * e] = o[8 * c + 2 * e] * al + p * pg8::bf_lo(w[e]); o[8 * c + 2 * e + 1] = o[8 * c + 2 * e + 1] * al + p * pg8::bf_hi(w[e]); } }
    }
    { const float rl = 1.0f / l; v4u* op = (v4u*)(OB + tok * 1024 + h * 64);
#pragma unroll
      for (int c = 0; c < 8; ++c) { v4u w;
#pragma unroll
          for (int e = 0; e < 4; ++e) w[e] = pg8::cvt_pk_bf16(o[8 * c + 2 * e] * rl, o[8 * c + 2 * e + 1] * rl);
          op[c] = w; } }
}

__global__ void __launch_bounds__(NWAVES * 64, 2) mega_fwd(Args a) {
    extern __shared__ __attribute__((aligned(16))) unsigned char lds_raw[];
    LAS unsigned char* lds = (LAS unsigned char*)lds_raw;
    cg::grid_group grid = cg::this_grid();
    int tid_ = threadIdx.x; asm volatile("" : "+v"(tid_));
    const int tid = tid_, lane = tid & 63, wave = __builtin_amdgcn_readfirstlane(tid >> 6);
    const int G = gridDim.x, bx = blockIdx.x, vcu = (G % 8 == 0) ? (bx % 8) * (G / 8) + bx / 8 : bx;
    unsigned char* ws = a.ws;
    float* SS1 = (float*)(ws + WS_CTL); float* SS2 = SS1 + M;
#define GRID_SYNC_CG() do { asm volatile("s_waitcnt vmcnt(0) lgkmcnt(0)" ::: "memory"); grid.sync(); } while (0)
#define GRID_SYNC() xcd_barrier(xbar)
    if (tid < 2) ((LAS unsigned*)(lds + RING_BYTES))[tid] = 0u;
    __syncthreads();
    const XcdBarrier xbar = xcd_barrier_post((unsigned*)(ws + WS_CTL + 786432), (volatile LAS unsigned*)(lds + RING_BYTES));

    for (int rp_ = 0; rp_ < (REP_PHASE == 100 ? 2 : 1); ++rp_) { p0_prologue(a, lds, vcu, G, wave, lane); __syncthreads(); }
    GRID_SYNC_CG();

    {
        pg8::Gemm g{(const bf16*)(ws + WS_XN), (const bf16*)(ws + WS_WIN), nullptr, nullptr, DM};
        pg8::StaticOrder S; S.init(M, NIN, G, bx);
        pg8::EpiIn E{ws};
        for (int rp_ = 0; rp_ < (REP_PHASE == 1 ? 2 : 1); ++rp_) pg8::gemm_phase<pg8::EpiIn, pg8::StaticOrder, true, true>(lds, g, S, E);
    }
    GRID_SYNC();

    for (int u = bx; u < 64; u += G) cumsum_unit(a, u, lds);
#if NAIVE_SWA
    for (int u = bx; u < M / 32; u += G) naive_swa_unit(a, u);
#else
    for (int rp_ = 0; rp_ < (REP_PHASE == 2 ? 2 : 1); ++rp_)
    for (int u = vcu; u < 2048; u += G) { const int bh = u >> 5, qb = u & 31, b_ = bh >> 4, h_ = bh & 15;
        attn_body::attn_unit<8, false, 128>(b_, h_, qb, (const bf16*)(ws + WS_AQ), (const bf16*)(ws + WS_AK), (const bf16*)(ws + WS_AV), (bf16*)(ws + WS_OA), nullptr, a.sinks[h_] * LOG2E, (char*)lds_raw); }
#endif
    GRID_SYNC();

#if NAIVE_FOX
    for (int u = bx; u < 1024; u += G) { const int r = u >> 6, i = r >> 2, hi4 = r & 3, qblk = (i & 1) ? 4 * i + 3 - hi4 : 4 * i + hi4; naive_fox_unit(a, u & 63, qblk); }
#else
    for (int rp_ = 0; rp_ < (REP_PHASE == 3 ? 2 : 1); ++rp_)
    for (int e = vcu; e < 2048; e += G) { const int cuv = e & 255, i = e >> 8, bh = (cuv >> 3) + 32 * (i >> 2), s_ = cuv & 7, k_ = i & 3, qb = k_ == 0 ? s_ : (k_ == 1 ? 15 - s_ : (k_ == 2 ? 16 + s_ : 31 - s_));
        attn_body::attn_unit<8, true, 1024>(bh >> 4, bh & 15, qb, (const bf16*)(ws + WS_FQ), (const bf16*)(ws + WS_FK), (const bf16*)(ws + WS_FV), (bf16*)(ws + WS_OB), (const float*)(ws + WS_C) + (size_t)bh * SEQ, 0.f, (char*)lds_raw); }
#endif
    GRID_SYNC();

    {
        pg8::Gemm g{(const bf16*)(ws + WS_OA), (const bf16*)(ws + WS_WBS), (const bf16*)(ws + WS_OB), (const bf16*)(ws + WS_WBF), 1024};
        pg8::PairOrder S; S.s.init(M, DM, G, bx);
        pg8::EpiBranch E{(const unsigned char*)(ws + WS_G), (bf16*)(ws + WS_MG)};
        for (int rp_ = 0; rp_ < (REP_PHASE == 4 ? 2 : 1); ++rp_) pg8::gemm_phase<pg8::EpiBranch, pg8::PairOrder, true, true>(lds, g, S, E);
    }
    GRID_SYNC();

    {
        pg8::Gemm g{(const bf16*)(ws + WS_MG), (const bf16*)(ws + WS_WOUT), nullptr, nullptr, DM};
        pg8::StaticOrder S; S.init(M, DM, G, bx);
        pg8::EpiResB<false> E{a.x, (bf16*)(ws + WS_X1B), SS1};
        pg8::gemm_phase<pg8::EpiResB<false>, pg8::StaticOrder, true, true>(lds, g, S, E);
    }
    GRID_SYNC();

    {
        pg8::Gemm g{(const bf16*)(ws + WS_X1B), (const bf16*)(ws + WS_WUP), nullptr, nullptr, DM};
        pg8::StaticOrder S; S.init(M, DFF, G, bx);
        pg8::EpiUp E{SS1, (bf16*)(ws + WS_U)};
        for (int rp_ = 0; rp_ < (REP_PHASE == 6 ? 2 : 1); ++rp_) pg8::gemm_phase<pg8::EpiUp, pg8::StaticOrder, true, true>(lds, g, S, E);
    }
    GRID_SYNC();

    {
        pg8::Gemm g{(const bf16*)(ws + WS_U), (const bf16*)(ws + WS_WDN), nullptr, nullptr, DFF};
        pg8::StaticOrder S; S.init(M, DM, G, bx);
        pg8::EpiResB<true> E{(const void*)(ws + WS_X1B), (bf16*)(ws + WS_X2B), SS2};
        pg8::gemm_phase<pg8::EpiResB<true>, pg8::StaticOrder, true, true>(lds, g, S, E);
    }
    GRID_SYNC();

    {
        const int gw = vcu * NWAVES + wave, NGW = G * NWAVES;
        for (int m = gw; m < M; m += NGW) {
            const float rstd = __builtin_amdgcn_rsqf(SS2[m] * (1.f / DM) + RMS_EPS);
            f32x4* xr = (f32x4*)(a.out + (size_t)m * DM) + lane; const f32x4* gr = (const f32x4*)a.final_norm + lane; const v2u* br = (const v2u*)((const bf16*)(ws + WS_X2B) + (size_t)m * DM) + lane;
            v2u w[8];
#pragma unroll
            for (int j = 0; j < 8; ++j) w[j] = __builtin_nontemporal_load(br + 64 * j);
#pragma unroll
            for (int j = 0; j < 8; ++j) { const f32x4 g = gr[64 * j]; const f32x4 v = (f32x4){pg8::bf_lo(w[j].x), pg8::bf_hi(w[j].x), pg8::bf_lo(w[j].y), pg8::bf_hi(w[j].y)}; __builtin_nontemporal_store(v * rstd * g, xr + 64 * j); }
        }
    }
}

extern "C" void kernel_launch(void* const* d_in, const int* in_sizes, int n_in, void* d_out, int out_size, void* d_ws, size_t ws_size, hipStream_t stream) {
    static int grid = 0; static int fused_final = 0;
    if (grid == 0) {
        if (n_in != 13 || in_sizes[0] != M * DM || out_size != M * DM || ws_size < WS_END) { fprintf(stderr, "kernel_launch: unexpected shapes (n_in %d, in0 %d, out %d, ws %zu)\n", n_in, n_in > 0 ? in_sizes[0] : -1, out_size, ws_size); grid = -1; return; }
        int dev = 0, cus = 0, per_cu = 0;
        if (hipGetDevice(&dev) != hipSuccess || hipDeviceGetAttribute(&cus, hipDeviceAttributeMultiprocessorCount, dev) != hipSuccess) { grid = -1; return; }
        if (hipFuncSetAttribute((const void*)mega_fwd, hipFuncAttributeMaxDynamicSharedMemorySize, LDS_BYTES) != hipSuccess) { fprintf(stderr, "kernel_launch: hipFuncSetAttribute failed\n"); grid = -1; return; }
        if (hipOccupancyMaxActiveBlocksPerMultiprocessor(&per_cu, (const void*)mega_fwd, NWAVES * 64, LDS_BYTES) != hipSuccess || per_cu < 1) { fprintf(stderr, "kernel_launch: occupancy query says %d\n", per_cu); per_cu = 1; }
        (void)hipGetLastError();
        grid = cus * 1;
        { pg8::StaticOrder S; S.init(M, DM, grid, 0); bool ok = (M / 256) * (DM / 256) == 4 * grid;
          for (int c = 0; c < grid && ok; ++c) { S.c = c; for (int i = 0; i < 4 && ok; i += 2) { pg8::Unit u0, u1; ok = S.next(i, u0) && S.next(i + 1, u1) && u0.pm == u1.pm && u1.pn == u0.pn + 4 && u0.pn < 4 && u0.f == 0 && u1.f == 1; } }
          fused_final = (ok && FUSED_FINAL) ? 1 : 0; if (!ok) fprintf(stderr, "kernel_launch: note: unit order does not pair tiles; using the separate final-norm pass\n"); }
    }
    if (grid < 0) return;
    (void)hipMemsetAsync((char*)d_ws + WS_CTL, 0, CTL_ZERO_BYTES, stream);
    Args a{};
    a.x = (const float*)d_in[0]; a.pos = (const int*)d_in[1]; a.attn_norm = (const float*)d_in[2]; a.w_in = (const float*)d_in[3]; a.fbias = (const float*)d_in[4]; a.sinks = (const float*)d_in[5];
    a.w_bs = (const float*)d_in[6]; a.w_bf = (const float*)d_in[7]; a.w_out = (const float*)d_in[8]; a.mlp_norm = (const float*)d_in[9]; a.w_up = (const float*)d_in[10]; a.w_dn = (const float*)d_in[11];
    a.final_norm = (const float*)d_in[12]; a.out = (float*)d_out; a.ws = (unsigned char*)d_ws; a.fused_final = fused_final;
    void* kargs[] = {&a};
    const hipError_t le = hipLaunchCooperativeKernel((const void*)mega_fwd, dim3(grid), dim3(NWAVES * 64), kargs, LDS_BYTES, stream);
    if (le != hipSuccess) fprintf(stderr, "kernel_launch: cooperative launch failed: %s (grid %d)\n", hipGetErrorString(le), grid);
}
```

```cpp
#include <hip/hip_runtime.h>
#include <hip/hip_cooperative_groups.h>
#include <cstdio>
#include <cstdint>
namespace cg = cooperative_groups;

constexpr int BATCH = 4, SEQ = 8192, DM = 2048, M = BATCH * SEQ, DFF = 8192, NIN = 8704  , DIN = 8464;
constexpr float RMS_EPS = 1e-6f;
constexpr float LOG2E = 1.4426950408889634f;
constexpr float C2 = 0.125f * 1.4426950408889634f;

constexpr size_t MiB = 1u << 20;
constexpr size_t WS_CTL = 0, CTL_ZERO_BYTES = 1 * MiB;
constexpr size_t WS_WIN = 1 * MiB, WS_WBS = 35 * MiB, WS_WBF = 39 * MiB, WS_WOUT = 43 * MiB, WS_WUP = 51 * MiB, WS_WDN = 83 * MiB;
constexpr size_t WS_CS = 115 * MiB;
constexpr size_t WS_FL = 123 * MiB, WS_C = 125 * MiB;
constexpr size_t WS_FK = 128 * MiB, WS_FV = 192 * MiB, WS_X1B = 128 * MiB;
constexpr size_t WS_XN = 256 * MiB, WS_MG = 256 * MiB;
constexpr size_t WS_AQ = 384 * MiB, WS_FQ = 448 * MiB, WS_G = 512 * MiB;
constexpr size_t WS_U = 256 * MiB;
constexpr size_t WS_AK = 768 * MiB, WS_AV = 776 * MiB, WS_OA = 784 * MiB, WS_OB = 848 * MiB, WS_END = 912 * MiB;
constexpr size_t WS_X2B = 784 * MiB;

namespace pg8 {
#define PG8_LAS __attribute__((address_space(3)))
typedef unsigned short bf16_t;
typedef short bf16x8 __attribute__((ext_vector_type(8)));
typedef float f32x4 __attribute__((ext_vector_type(4)));
typedef unsigned u32x4 __attribute__((ext_vector_type(4)));
typedef unsigned u32x2 __attribute__((ext_vector_type(2)));
constexpr int BM = 256, BK = 64, HALF = 128, HTB = HALF * BK * 2  , STAGE_BYTES = 8 * HTB, NXCD = 8, WGM = 8;

__host__ __device__ __forceinline__ int lds_byte(int r, int c) { const int st = (r >> 4) * 2 + (c >> 5), rr = r & 15, cc = c & 31, ob = rr * 64 + cc * 2; return st * 1024 + (ob ^ (((ob >> 9) & 1) << 5)); }
__host__ __device__ __forceinline__ void stage_rc(int b, int& R, int& C) { const int st = b / 1024, sb = b % 1024, swz = sb ^ (((sb >> 9) & 1) << 5); R = (st >> 1) * 16 + swz / 64; C = (st & 1) * 32 + (swz % 64) / 2; }
__host__ __device__ __forceinline__ int perm32(int rho) { const int n = rho >> 4, i = rho & 15; return 8 * (i >> 2) + 4 * n + (i & 3); }

struct Unit { int pm, pn, z, f; };
struct Gemm { const bf16_t* A0; const bf16_t* B0; const bf16_t* A1; const bf16_t* B1; int K; };

struct StaticOrder {
    int nM, nN, nwg, G, c;
    __host__ __device__ void init(int M_, int N_, int G_, int c_) { nM = M_ / BM; nN = N_ / BM; nwg = nM * nN; G = G_; c = c_; }
    __host__ __device__ bool next(int i, Unit& u) const {
        const long L = (long)i * G + c; if (L >= nwg) return false;
        int wgid = (int)L; { const int q = nwg / NXCD, r = nwg % NXCD, xcd = wgid % NXCD, off = wgid / NXCD; wgid = (xcd < r ? xcd * (q + 1) : r * (q + 1) + (xcd - r) * q) + off; }
        const int nig = WGM * nN, gid = wgid / nig, fm = gid * WGM, gsz = (nM - fm) < WGM ? (nM - fm) : WGM;
        u.pm = fm + ((wgid % nig) % gsz); u.pn = (wgid % nig) / gsz; u.z = 0; u.f = i & 1; return true;
    }
};
struct PairOrder {
    StaticOrder s;
    __host__ __device__ bool next(int i, Unit& u) const { const bool ok = s.next(i >> 1, u); u.z = i & 1; return ok; }
};

__device__ __forceinline__ unsigned cvt_pk_bf16(float lo, float hi) { unsigned r; asm("v_cvt_pk_bf16_f32 %0, %1, %2" : "=v"(r) : "v"(lo), "v"(hi)); return r; }
__device__ __forceinline__ float bf_lo(unsigned w) { return __uint_as_float(w << 16); }
__device__ __forceinline__ float bf_hi(unsigned w) { return __uint_as_float(w & 0xffff0000u); }
__device__ __forceinline__ float sigmoidf_(float x) { return __builtin_amdgcn_rcpf(1.0f + __builtin_amdgcn_exp2f(-x * LOG2E)); }


struct EpiIn {
    static constexpr bool PERM = true;
    unsigned char* ws;
    __device__ __forceinline__ bool keep(const Unit&) const { return false; }
    __device__ __forceinline__ void operator()(f32x4 (&acc)[2][2][4][2], const Unit& u, int wr, int wc, int fr, int fq) const {
        const int pn = u.pn; const int row0 = u.pm * BM + wr * 64 + fr;
        if (pn <= 16) {
            size_t doff; int pitch, colbase; bool rope = false; float sc = 1.f;
            if (pn < 4) { doff = WS_AQ; pitch = 1024; colbase = (4 * pn + wc) * 64; rope = true; sc = C2; }
            else if (pn == 4) { if (wc < 2) { doff = WS_AK; pitch = 128; colbase = wc * 64; rope = true; } else { doff = WS_AV; pitch = 128; colbase = (wc - 2) * 64; } }
            else { const int t = pn - 5, seg = t >> 2, tin = t & 3; doff = WS_FQ; if (seg == 1) doff = WS_FK; if (seg == 2) doff = WS_FV; pitch = 1024; colbase = (4 * tin + wc) * 64; sc = seg == 0 ? C2 : 1.f; }
            bf16_t* dst = (bf16_t*)(ws + doff); const float* cs = (const float*)(ws + WS_CS);
#pragma unroll
            for (int ai = 0; ai < 2; ++ai) {
                f32x4 cc[4][4];
                if (rope) {
#pragma unroll
                    for (int m = 0; m < 4; ++m) { const float* cp = cs + (size_t)(row0 + ai * HALF + m * 16) * 32 + 8 * fq; const float* sp = cp + (size_t)M * 32;
                        cc[m][0] = *(const f32x4*)cp; cc[m][1] = *(const f32x4*)(cp + 4); cc[m][2] = *(const f32x4*)sp; cc[m][3] = *(const f32x4*)(sp + 4); }
                    asm volatile("" ::: "memory");
                }
#pragma unroll
                for (int m = 0; m < 4; ++m) {
                    const int row = row0 + ai * HALF + m * 16;
                    f32x4 v00 = acc[ai][0][m][0], v01 = acc[ai][0][m][1], v10 = acc[ai][1][m][0], v11 = acc[ai][1][m][1];
                    if (rope) {
                        const f32x4 c0 = cc[m][0], c1 = cc[m][1], s0 = cc[m][2], s1 = cc[m][3];
                        const f32x4 o00 = v00 * c0 - v10 * s0, o10 = v10 * c0 + v00 * s0, o01 = v01 * c1 - v11 * s1, o11 = v11 * c1 + v01 * s1;
                        v00 = o00; v10 = o10; v01 = o01; v11 = o11;
                    }
                    v00 = v00 * sc; v01 = v01 * sc; v10 = v10 * sc; v11 = v11 * sc;
                    bf16_t* rp = dst + (size_t)row * pitch + colbase + 8 * fq;
                    u32x4 w0, w1;
                    w0.x = cvt_pk_bf16(v00[0], v00[1]); w0.y = cvt_pk_bf16(v00[2], v00[3]); w0.z = cvt_pk_bf16(v01[0], v01[1]); w0.w = cvt_pk_bf16(v01[2], v01[3]);
                    w1.x = cvt_pk_bf16(v10[0], v10[1]); w1.y = cvt_pk_bf16(v10[2], v10[3]); w1.z = cvt_pk_bf16(v11[0], v11[1]); w1.w = cvt_pk_bf16(v11[2], v11[3]);
                    *(u32x4*)rp = w0; *(u32x4*)(rp + 32) = w1;
                }
                asm volatile("" ::: "memory");
            }
        } else if (pn <= 32) {
            const int col0 = (pn - 17) * BM + wc * 32 + 8 * fq;
#pragma unroll
            for (int ai = 0; ai < 2; ++ai)
#pragma unroll
                for (int m = 0; m < 4; ++m) {
                    unsigned char* rp = ws + WS_G + (size_t)(row0 + ai * HALF + m * 16) * 4096 + col0;
#pragma unroll
                    for (int bj = 0; bj < 2; ++bj) {
                        const f32x4 a = acc[ai][bj][m][0], b = acc[ai][bj][m][1]; u32x2 w; w.x = 0u; w.y = 0u;
#pragma unroll
                        for (int i = 0; i < 4; ++i) {
                            const float qa = __builtin_amdgcn_rcpf(__builtin_fmaf(__builtin_amdgcn_exp2f(a[i]), 1.0f / 255.0f, 1.0f / 255.0f)), qb = __builtin_amdgcn_rcpf(__builtin_fmaf(__builtin_amdgcn_exp2f(b[i]), 1.0f / 255.0f, 1.0f / 255.0f));
                            w.x = __builtin_amdgcn_cvt_pk_u8_f32(fmaxf(qa, 1.0f), i, w.x); w.y = __builtin_amdgcn_cvt_pk_u8_f32(fmaxf(qb, 1.0f), i, w.y); }
                        *(u32x2*)(rp + bj * HALF) = w;
                    }
                }
        } else {
            if (wc == 0 && fq < 2) {
#pragma unroll
                for (int ai = 0; ai < 2; ++ai)
#pragma unroll
                    for (int m = 0; m < 4; ++m) {
                        float* rp = (float*)(ws + WS_FL) + (size_t)(row0 + ai * HALF + m * 16) * 16 + 8 * fq;
                        *(f32x4*)rp = acc[ai][0][m][0]; *(f32x4*)(rp + 4) = acc[ai][0][m][1];
                    }
            }
        }
    }
};

struct EpiBranch {
    static constexpr bool PERM = true;
    const unsigned char* G; bf16_t* MG;
    __device__ __forceinline__ bool keep(const Unit& u) const { return u.z == 0; }
    __device__ __forceinline__ void operator()(f32x4 (&acc)[2][2][4][2], const Unit& u, int wr, int wc, int fr, int fq) const {
        const int row0 = u.pm * BM + wr * 64 + fr, col0 = u.pn * BM + wc * 32 + 8 * fq; const int z = u.z;
#pragma unroll
        for (int ai = 0; ai < 2; ++ai) {
            u32x2 gbv[4][2], gav[4][2];
#pragma unroll
            for (int m = 0; m < 4; ++m)
#pragma unroll
                for (int bj = 0; bj < 2; ++bj) { const unsigned char* gp = G + (size_t)(row0 + ai * HALF + m * 16) * 4096 + col0 + bj * HALF;
                    gbv[m][bj] = *(const u32x2*)(gp + 2048); if (z == 0) gav[m][bj] = *(const u32x2*)gp; }
            asm volatile("" ::: "memory");
#pragma unroll
            for (int m = 0; m < 4; ++m) {
                const size_t row = (size_t)(row0 + ai * HALF + m * 16);
#pragma unroll
                for (int bj = 0; bj < 2; ++bj) {
                    const u32x2 gb = gbv[m][bj];
                    float sb[8];
#pragma unroll
                    for (int i = 0; i < 4; ++i) { sb[i] = (float)((gb.x >> (8 * i)) & 0xffu); sb[4 + i] = (float)((gb.y >> (8 * i)) & 0xffu); }
                    if (z == 0) {
                        const u32x2 ga = gav[m][bj];
#pragma unroll
                        for (int i = 0; i < 4; ++i) {
                            acc[ai][bj][m][0][i] *= (float)((ga.x >> (8 * i)) & 0xffu) * __builtin_amdgcn_rcpf(sb[i]);
                            acc[ai][bj][m][1][i] *= (float)((ga.y >> (8 * i)) & 0xffu) * __builtin_amdgcn_rcpf(sb[4 + i]);
                        }
                    } else {
#pragma unroll
                        for (int i = 0; i < 8; ++i) sb[i] *= (1.0f / 255.0f);
                        const f32x4 a = acc[ai][bj][m][0], b = acc[ai][bj][m][1]; u32x4 w;
                        w.x = cvt_pk_bf16(a[0] * sb[0], a[1] * sb[1]); w.y = cvt_pk_bf16(a[2] * sb[2], a[3] * sb[3]);
                        w.z = cvt_pk_bf16(b[0] * sb[4], b[1] * sb[5]); w.w = cvt_pk_bf16(b[2] * sb[6], b[3] * sb[7]);
                        *(u32x4*)(MG + row * 2048 + col0 + bj * HALF) = w;
                    }
                }
            }
            asm volatile("" ::: "memory");
        }
    }
};

template <bool WRITE_BF> struct EpiRes {
    static constexpr bool PERM = false;
    const float* base; float* out; bf16_t* xb; float* ss;
    __device__ __forceinline__ bool keep(const Unit&) const { return false; }
    __device__ __forceinline__ void operator()(f32x4 (&acc)[2][2][4][2], const Unit& u, int wr, int wc, int fr, int fq) const {
        const int row0 = u.pm * BM + wr * 64 + fr, col0 = u.pn * BM + wc * 32 + 4 * fq;
#pragma unroll
        for (int ai = 0; ai < 2; ++ai) {
            f32x4 pre[4][2][2];
#pragma unroll
            for (int m = 0; m < 4; ++m)
#pragma unroll
                for (int bj = 0; bj < 2; ++bj)
#pragma unroll
                    for (int n = 0; n < 2; ++n) pre[m][bj][n] = *(const f32x4*)(base + (size_t)(row0 + ai * HALF + m * 16) * DM + col0 + bj * HALF + n * 16);
            asm volatile("" ::: "memory");
#pragma unroll
            for (int m = 0; m < 4; ++m) {
                const size_t row = (size_t)(row0 + ai * HALF + m * 16); const size_t off = row * DM + col0; float q = 0.f;
#pragma unroll
                for (int bj = 0; bj < 2; ++bj)
#pragma unroll
                    for (int n = 0; n < 2; ++n) {
                        const size_t o = off + bj * HALF + n * 16;
                        const f32x4 v = pre[m][bj][n] + acc[ai][bj][m][n];
                        *(f32x4*)(out + o) = v; q += (v[0] * v[0] + v[1] * v[1]) + (v[2] * v[2] + v[3] * v[3]);
                        if (WRITE_BF) { u32x2 w; w.x = cvt_pk_bf16(v[0], v[1]); w.y = cvt_pk_bf16(v[2], v[3]); *(u32x2*)(xb + o) = w; }
                    }
                q += __shfl_xor(q, 16); q += __shfl_xor(q, 32);
                if (fq == 0) atomicAdd(ss + row, q);
            }
            asm volatile("" ::: "memory");
        }
    }
};

struct EpiFinal {
    static constexpr bool PERM = false;
    float* out; float* ss; unsigned* cnt; const float* gain;
    __device__ __forceinline__ bool keep(const Unit&) const { return false; }
    __device__ __forceinline__ void operator()(f32x4 (&acc)[2][2][4][2], const Unit& u, int wr, int wc, int fr, int fq) const {
        const int row0 = u.pm * BM + wr * 64 + fr, col0 = u.pn * BM + wc * 32 + 4 * fq; const bool second = u.f != 0;
#pragma unroll
        for (int ai = 0; ai < 2; ++ai) {
            f32x4 pre[4][2][2];
#pragma unroll
            for (int m = 0; m < 4; ++m)
#pragma unroll
                for (int bj = 0; bj < 2; ++bj)
#pragma unroll
                    for (int n = 0; n < 2; ++n) pre[m][bj][n] = *(const f32x4*)(out + (size_t)(row0 + ai * HALF + m * 16) * DM + col0 + bj * HALF + n * 16);
            asm volatile("" ::: "memory");
#pragma unroll
            for (int m = 0; m < 4; ++m) {
                const size_t row = (size_t)(row0 + ai * HALF + m * 16); const size_t off = row * DM + col0; float q = 0.f;
#pragma unroll
                for (int bj = 0; bj < 2; ++bj)
#pragma unroll
                    for (int n = 0; n < 2; ++n) {
                        const f32x4 v = pre[m][bj][n] + acc[ai][bj][m][n]; acc[ai][bj][m][n] = v;
                        q += (v[0] * v[0] + v[1] * v[1]) + (v[2] * v[2] + v[3] * v[3]);
                        if (!second) *(f32x4*)(out + off + bj * HALF + n * 16) = v;
                    }
                q += __shfl_xor(q, 16); q += __shfl_xor(q, 32);
                if (fq == 0) atomicAdd(ss + row, q);
            }
            asm volatile("" ::: "memory");
        }
        asm volatile("s_waitcnt vmcnt(0)" ::: "memory");
        unsigned* pc = cnt + 16 * u.pm;
        if ((threadIdx.x & 63) == 0) __hip_atomic_fetch_add(pc, 1u, __ATOMIC_RELAXED, __HIP_MEMORY_SCOPE_AGENT);
        if (!second) return;
        { const unsigned long long t0 = __builtin_amdgcn_s_memrealtime();
          while ((unsigned)__builtin_amdgcn_readfirstlane(__hip_atomic_load(pc, __ATOMIC_RELAXED, __HIP_MEMORY_SCOPE_AGENT)) < 64u) {
              if (__builtin_amdgcn_s_memrealtime() - t0 > 2000000ull) break;
              __builtin_amdgcn_s_sleep(4); }
          asm volatile("" ::: "memory"); }
#pragma unroll
        for (int ai = 0; ai < 2; ++ai)
#pragma unroll
            for (int m = 0; m < 4; ++m) {
                const size_t row = (size_t)(row0 + ai * HALF + m * 16); const size_t off = row * DM + col0;
                const float rstd = __builtin_amdgcn_rsqf(__hip_atomic_load(ss + row, __ATOMIC_RELAXED, __HIP_MEMORY_SCOPE_AGENT) * (1.0f / DM) + RMS_EPS);
#pragma unroll
                for (int bj = 0; bj < 2; ++bj)
#pragma unroll
                    for (int n = 0; n < 2; ++n) {
                        const size_t o = off + bj * HALF + n * 16; const int c = col0 + bj * HALF + n * 16;
                        const f32x4 gB = *(const f32x4*)(gain + c), gA = *(const f32x4*)(gain + c - 1024), vA = *(const f32x4*)(out + o - 1024);
                        *(f32x4*)(out + o) = acc[ai][bj][m][n] * rstd * gB;
                        *(f32x4*)(out + o - 1024) = vA * rstd * gA;
                    }
            }
    }
};

template <bool BASE_BF> struct EpiResB {
    static constexpr bool PERM = true;
    const void* base; bf16_t* yb; float* ss;
    __device__ __forceinline__ bool keep(const Unit&) const { return false; }
    __device__ __forceinline__ void operator()(f32x4 (&acc)[2][2][4][2], const Unit& u, int wr, int wc, int fr, int fq) const {
        const int row0 = u.pm * BM + wr * 64 + fr, col0 = u.pn * BM + wc * 32 + 8 * fq;
#pragma unroll
        for (int ai = 0; ai < 2; ++ai) {
            f32x4 pf[4][2][2]; u32x4 pb[4][2];
#pragma unroll
            for (int m = 0; m < 4; ++m)
#pragma unroll
                for (int bj = 0; bj < 2; ++bj) { const size_t o = (size_t)(row0 + ai * HALF + m * 16) * DM + col0 + bj * HALF;
                    if (BASE_BF) pb[m][bj] = *(const u32x4*)((const bf16_t*)base + o);
                    else { pf[m][bj][0] = *(const f32x4*)((const float*)base + o); pf[m][bj][1] = *(const f32x4*)((const float*)base + o + 4); } }
            asm volatile("" ::: "memory");
#pragma unroll
            for (int m = 0; m < 4; ++m) {
                const size_t row = (size_t)(row0 + ai * HALF + m * 16); float q = 0.f;
#pragma unroll
                for (int bj = 0; bj < 2; ++bj) {
                    f32x4 x0, x1;
                    if (BASE_BF) { const u32x4 w = pb[m][bj]; x0 = (f32x4){bf_lo(w.x), bf_hi(w.x), bf_lo(w.y), bf_hi(w.y)}; x1 = (f32x4){bf_lo(w.z), bf_hi(w.z), bf_lo(w.w), bf_hi(w.w)}; }
                    else { x0 = pf[m][bj][0]; x1 = pf[m][bj][1]; }
                    const f32x4 v0 = x0 + acc[ai][bj][m][0], v1 = x1 + acc[ai][bj][m][1];
                    q += ((v0[0] * v0[0] + v0[1] * v0[1]) + (v0[2] * v0[2] + v0[3] * v0[3])) + ((v1[0] * v1[0] + v1[1] * v1[1]) + (v1[2] * v1[2] + v1[3] * v1[3]));
                    u32x4 w; w.x = cvt_pk_bf16(v0[0], v0[1]); w.y = cvt_pk_bf16(v0[2], v0[3]); w.z = cvt_pk_bf16(v1[0], v1[1]); w.w = cvt_pk_bf16(v1[2], v1[3]);
                    *(u32x4*)(yb + row * DM + col0 + bj * HALF) = w;
                }
                q += __shfl_xor(q, 16); q += __shfl_xor(q, 32);
                if (fq == 0) atomicAdd(ss + row, q);
            }
            asm volatile("" ::: "memory");
        }
    }
};

struct EpiUp {
    static constexpr bool PERM = true;
    const float* ss; bf16_t* U;
    __device__ __forceinline__ bool keep(const Unit&) const { return false; }
    __device__ __forceinline__ void operator()(f32x4 (&acc)[2][2][4][2], const Unit& u, int wr, int wc, int fr, int fq) const {
        const int row0 = u.pm * BM + wr * 64 + fr, col0 = u.pn * BM + wc * 32 + 8 * fq;
        float rs[2][4];
#pragma unroll
        for (int ai = 0; ai < 2; ++ai)
#pragma unroll
            for (int m = 0; m < 4; ++m) rs[ai][m] = ss[row0 + ai * HALF + m * 16];
        asm volatile("" ::: "memory");
#pragma unroll
        for (int ai = 0; ai < 2; ++ai)
#pragma unroll
            for (int m = 0; m < 4; ++m) {
                const size_t row = (size_t)(row0 + ai * HALF + m * 16);
                const float rstd = __builtin_amdgcn_rsqf(rs[ai][m] * (1.0f / DM) + RMS_EPS);
#pragma unroll
                for (int bj = 0; bj < 2; ++bj) {
                    f32x4 a = acc[ai][bj][m][0] * rstd, b = acc[ai][bj][m][1] * rstd; u32x4 w;
#pragma unroll
                    for (int i = 0; i < 4; ++i) { a[i] = fmaxf(a[i], 0.f); a[i] *= a[i]; b[i] = fmaxf(b[i], 0.f); b[i] *= b[i]; }
                    w.x = cvt_pk_bf16(a[0], a[1]); w.y = cvt_pk_bf16(a[2], a[3]); w.z = cvt_pk_bf16(b[0], b[1]); w.w = cvt_pk_bf16(b[2], b[3]);
                    *(u32x4*)(U + row * DFF + col0 + bj * HALF) = w;
                }
            }
    }
};

template <class Epi, class Sched, bool ALIGN_EPI = false, bool SP2 = false>
__device__ __forceinline__ void gemm_phase(PG8_LAS unsigned char* lds, const Gemm g, const Sched& S, const Epi& E) {
    int tid_ = threadIdx.x; asm volatile("" : "+v"(tid_));
    const int tid = tid_, wid = __builtin_amdgcn_readfirstlane(tid >> 6), lane = tid & 63, wr = wid >> 2, wc = wid & 3, fr = lane & 15, fq = lane >> 4;
    const int K = g.K, nt = K / BK;
    unsigned voffA[2], voffB[2];
#pragma unroll
    for (int i = 0; i < 2; ++i) { int R, C; stage_rc(tid * 16 + i * 8192, R, C); const int Rb = Epi::PERM ? ((R & ~31) + perm32(R & 31)) : R;
        voffA[i] = (unsigned)(R * K + C) * 2u; voffB[i] = (unsigned)(Rb * K + C) * 2u; }
    const size_t kstep = (size_t)(BK * 2);
    const size_t hstep = (size_t)HALF * K * 2;
    const size_t tstep = 2 * hstep;
    const unsigned ldsw = (unsigned)wid * 1024u;
    const int aoff = lds_byte(wr * 64 + fr, fq * 8), boff = lds_byte(wc * 32 + fr, fq * 8);
#define PG8_SA(b, h) (((b) * 2 + (h)) * HTB)
#define PG8_SB(b, h) ((4 + (b) * 2 + (h)) * HTB)
#define PG8_STAGE(bufoff, gbase, voff) do { _Pragma("unroll") for (int _i = 0; _i < 2; ++_i) \
        __builtin_amdgcn_global_load_lds((const unsigned*)((const char*)(gbase) + (voff)[_i]), (PG8_LAS unsigned*)(lds + (bufoff) + ldsw + _i * 8192), 16, 0, 0); } while (0)
#define PG8_LDA(dst, b, h) do { _Pragma("unroll") for (int m = 0; m < 4; ++m) _Pragma("unroll") for (int k = 0; k < 2; ++k) dst[m][k] = *(const PG8_LAS bf16x8*)(lds + PG8_SA(b, h) + aoff + m * 2048 + k * 1024); } while (0)
#define PG8_LDB(dst, b, h) do { _Pragma("unroll") for (int n = 0; n < 2; ++n) _Pragma("unroll") for (int k = 0; k < 2; ++k) dst[n][k] = *(const PG8_LAS bf16x8*)(lds + PG8_SB(b, h) + boff + n * 2048 + k * 1024); } while (0)
#define PG8_MMA(ai, bj, At, Bt) do { __builtin_amdgcn_s_setprio(1); _Pragma("unroll") for (int m = 0; m < 4; ++m) _Pragma("unroll") for (int n = 0; n < 2; ++n) _Pragma("unroll") for (int k = 0; k < 2; ++k) \
        acc[ai][bj][m][n] = __builtin_amdgcn_mfma_f32_16x16x32_bf16(Bt[n][k], At[m][k], acc[ai][bj][m][n], 0, 0, 0); __builtin_amdgcn_s_setprio(0); } while (0)
#define PG8_WAIT_V(n) asm volatile("s_waitcnt vmcnt(" #n ")" ::: "memory")
#define PG8_WAIT_L(n) asm volatile("s_waitcnt lgkmcnt(" #n ")" ::: "memory")
#define PG8_BAR __builtin_amdgcn_s_barrier()
#define PG8_SCHED __builtin_amdgcn_sched_barrier(0)
    Unit cur, nxt; int ui = 0;
    if (!S.next(0, cur)) return;
    f32x4 acc[2][2][4][2];
#pragma unroll
    for (int a = 0; a < 2; ++a)
#pragma unroll
        for (int b = 0; b < 2; ++b)
#pragma unroll
            for (int m = 0; m < 4; ++m)
#pragma unroll
                for (int n = 0; n < 2; ++n) acc[a][b][m][n] = (f32x4){0.f, 0.f, 0.f, 0.f};
    bf16x8 At[4][2], B0[2][2], B1[2][2];
    const char* cA = (const char*)(cur.z ? g.A1 : g.A0) + (size_t)cur.pm * tstep; const char* cB = (const char*)(cur.z ? g.B1 : g.B0) + (size_t)cur.pn * tstep;
    if constexpr (SP2) {
        PG8_STAGE(PG8_SB(0, 0), cB, voffB); PG8_STAGE(PG8_SB(0, 1), cB + hstep, voffB); PG8_STAGE(PG8_SA(0, 0), cA, voffA); PG8_STAGE(PG8_SA(0, 1), cA + hstep, voffA);
        if (wr == 1) PG8_BAR;
        PG8_WAIT_V(2); PG8_BAR;
        PG8_STAGE(PG8_SB(1, 0), cB + kstep, voffB); PG8_STAGE(PG8_SA(1, 0), cA + kstep, voffA); PG8_STAGE(PG8_SB(1, 1), cB + hstep + kstep, voffB);
        PG8_WAIT_V(6); PG8_BAR;
    } else {
        PG8_STAGE(PG8_SB(0, 0), cB, voffB); PG8_STAGE(PG8_SA(0, 0), cA, voffA); PG8_STAGE(PG8_SB(0, 1), cB + hstep, voffB); PG8_STAGE(PG8_SA(0, 1), cA + hstep, voffA);
        if (wr == 1) PG8_BAR;
        PG8_WAIT_V(4); PG8_BAR;
        PG8_STAGE(PG8_SB(1, 0), cB + kstep, voffB); PG8_STAGE(PG8_SA(1, 0), cA + kstep, voffA); PG8_STAGE(PG8_SB(1, 1), cB + hstep + kstep, voffB);
        PG8_WAIT_V(6); PG8_BAR;
    }
    for (;;) {
        const bool has_next = S.next(ui + 1, nxt);
        const char* nA = has_next ? (const char*)(nxt.z ? g.A1 : g.A0) + (size_t)nxt.pm * tstep : cA; const char* nB = has_next ? (const char*)(nxt.z ? g.B1 : g.B0) + (size_t)nxt.pn * tstep : cB;
        for (int t = 0; t < nt; t += 2) {
            const bool last = (t == nt - 2);
            const char* a1 = cA + (size_t)(t + 1) * kstep;
            const char* a2 = last ? nA : cA + (size_t)(t + 2) * kstep; const char* b2 = last ? nB : cB + (size_t)(t + 2) * kstep;
            const char* a3 = a2 + kstep; const char* b3 = b2 + kstep;
            if constexpr (SP2) {
            PG8_LDB(B0, 0, 0); PG8_LDB(B1, 0, 1); PG8_SCHED; PG8_LDA(At, 0, 0); PG8_STAGE(PG8_SA(1, 1), a1 + hstep, voffA);
            PG8_WAIT_V(8); PG8_WAIT_L(0); PG8_BAR; PG8_MMA(0, 0, At, B0); PG8_MMA(0, 1, At, B1); PG8_BAR; PG8_SCHED;
            PG8_LDA(At, 0, 1); PG8_STAGE(PG8_SB(0, 0), b2, voffB); PG8_STAGE(PG8_SB(0, 1), b2 + hstep, voffB); PG8_STAGE(PG8_SA(0, 0), a2, voffA);
            PG8_WAIT_V(8); PG8_WAIT_L(0); PG8_BAR; PG8_MMA(1, 0, At, B0); PG8_MMA(1, 1, At, B1); PG8_BAR; PG8_SCHED;
            PG8_LDB(B0, 1, 0); PG8_LDB(B1, 1, 1); PG8_SCHED; PG8_LDA(At, 1, 0); PG8_STAGE(PG8_SA(0, 1), a2 + hstep, voffA);
            PG8_WAIT_V(8); PG8_WAIT_L(0); PG8_BAR; PG8_MMA(0, 0, At, B0); PG8_MMA(0, 1, At, B1); PG8_BAR; PG8_SCHED;
            PG8_LDA(At, 1, 1); PG8_STAGE(PG8_SB(1, 0), b3, voffB); PG8_STAGE(PG8_SB(1, 1), b3 + hstep, voffB); PG8_STAGE(PG8_SA(1, 0), a3, voffA);
            PG8_WAIT_V(8); PG8_WAIT_L(0); PG8_BAR; PG8_MMA(1, 0, At, B0); PG8_MMA(1, 1, At, B1); PG8_BAR; PG8_SCHED;
            } else {
            PG8_LDB(B0, 0, 0); PG8_SCHED; PG8_LDA(At, 0, 0); PG8_STAGE(PG8_SA(1, 1), a1 + hstep, voffA);
            PG8_WAIT_L(8); PG8_BAR; PG8_WAIT_L(0); PG8_MMA(0, 0, At, B0); PG8_BAR; PG8_SCHED;
            PG8_LDB(B1, 0, 1); PG8_STAGE(PG8_SB(0, 0), b2, voffB);
            PG8_BAR; PG8_WAIT_L(0); PG8_MMA(0, 1, At, B1); PG8_BAR;
            PG8_LDA(At, 0, 1); PG8_STAGE(PG8_SA(0, 0), a2, voffA);
            PG8_BAR; PG8_WAIT_L(0); PG8_MMA(1, 0, At, B0); PG8_BAR; PG8_SCHED;
            PG8_STAGE(PG8_SB(0, 1), b2 + hstep, voffB);
            PG8_WAIT_V(6); PG8_BAR; PG8_MMA(1, 1, At, B1); PG8_BAR;
            PG8_LDB(B0, 1, 0); PG8_SCHED; PG8_LDA(At, 1, 0); PG8_STAGE(PG8_SA(0, 1), a2 + hstep, voffA);
            PG8_WAIT_L(8); PG8_BAR; PG8_WAIT_L(0); PG8_MMA(0, 0, At, B0); PG8_BAR; PG8_SCHED;
            PG8_LDB(B1, 1, 1); PG8_STAGE(PG8_SB(1, 0), b3, voffB);
            PG8_BAR; PG8_WAIT_L(0); PG8_MMA(0, 1, At, B1); PG8_BAR;
            PG8_LDA(At, 1, 1); PG8_STAGE(PG8_SA(1, 0), a3, voffA);
            PG8_BAR; PG8_WAIT_L(0); PG8_MMA(1, 0, At, B0); PG8_BAR; PG8_SCHED;
            PG8_STAGE(PG8_SB(1, 1), b3 + hstep, voffB);
            PG8_WAIT_V(6); PG8_BAR; PG8_MMA(1, 1, At, B1); PG8_BAR;
            }
        }
        if constexpr (ALIGN_EPI) { if (wr == 0) PG8_BAR; }
        E(acc, cur, wr, wc, fr, fq);
        if (!has_next) break;
        if (!E.keep(cur))
#pragma unroll
        for (int a = 0; a < 2; ++a)
#pragma unroll
            for (int b = 0; b < 2; ++b)
#pragma unroll
                for (int m = 0; m < 4; ++m)
#pragma unroll
                    for (int n = 0; n < 2; ++n) acc[a][b][m][n] = (f32x4){0.f, 0.f, 0.f, 0.f};
        cur = nxt; cA = nA; cB = nB; ++ui;
        if constexpr (ALIGN_EPI) { if (wr == 1) PG8_BAR; }
    }
    PG8_WAIT_V(0);
    if constexpr (!ALIGN_EPI) { if (wr == 0) PG8_BAR; }
    PG8_BAR;
#undef PG8_SA
#undef PG8_SB
#undef PG8_STAGE
#undef PG8_LDA
#undef PG8_LDB
#undef PG8_MMA
#undef PG8_WAIT_V
#undef PG8_WAIT_L
#undef PG8_BAR
#undef PG8_SCHED
}
}


namespace attn_body {
using bf16=unsigned short;
using bf16x8=__attribute__((ext_vector_type(8)))short;
using s16x4=__attribute__((ext_vector_type(4)))short;
using f32x16=__attribute__((ext_vector_type(16)))float;
using u32x4=__attribute__((ext_vector_type(4)))unsigned;
using f32x4v=__attribute__((ext_vector_type(4)))float;
constexpr int BATCH=4,NHEAD=16,SEQ=8192,D=64,DM=NHEAD*D;
constexpr int NW=8,QBLK=32,QB=QBLK*NW,KVBLK=64,NQB=SEQ/QB;
constexpr int ATTN_PITCH=DM, ATTN_UNIT_ROWS=QB;
__device__ __forceinline__ int crow(int r,int hi){return (r&3)+8*(r>>2)+4*hi;}
#define SBAR() __builtin_amdgcn_sched_barrier(0)
template<bool SWA> __device__ __forceinline__ void cmask(f32x16&p0,f32x16&p1,int jb,int qrel,int hi){
  const float NEG=-INFINITY; int kb=64*jb+4*hi;
  #pragma unroll
  for(int r=0;r<16;++r){int kv=kb+(r&3)+8*(r>>2);
    if(SWA){ if(kv>qrel||kv<=qrel-128)p0[r]=NEG; if(kv+32>qrel||kv+32<=qrel-128)p1[r]=NEG; }
    else{ if(kv>qrel)p0[r]=NEG; if(kv+32>qrel)p1[r]=NEG; } }
}

constexpr int NSLOT=3, SLOTB=8192;
#ifndef NVB
#define NVB 8
#endif
constexpr int LDS_K=0, LDS_V=NSLOT*SLOTB, LDS_WS=2*NSLOT*SLOTB, LDS_OST=LDS_WS+NW*64*4, LDS_CB=LDS_OST+NW*4096, LDS_BYTES=LDS_CB+4*256;
constexpr float C2=0.125f*1.4426950408889634f;
__device__ __forceinline__ void glds16(const void*gsrc,unsigned lds_dst){unsigned keep;
  asm volatile("s_mov_b32 %0, m0\n\ts_mov_b32 m0, %2\n\ts_nop 0\n\tglobal_load_lds_dwordx4 %1, off\n\ts_mov_b32 m0, %0":"=&s"(keep):"v"(gsrc),"s"(lds_dst):"memory");}
__device__ __forceinline__ void glds4(const void*gsrc,unsigned lds_dst){unsigned keep;
  asm volatile("s_mov_b32 %0, m0\n\ts_mov_b32 m0, %2\n\ts_nop 0\n\tglobal_load_lds_dword %1, off\n\ts_mov_b32 m0, %0":"=&s"(keep):"v"(gsrc),"s"(lds_dst):"memory");}
__device__ __forceinline__ float max3f(float a,float b,float c){float r;asm("v_max3_f32 %0, %1, %2, %3":"=v"(r):"v"(a),"v"(b),"v"(c));return r;}
__device__ __forceinline__ float max2f(float a,float b){float r;asm("v_max_f32_e32 %0, %1, %2":"=v"(r):"v"(a),"v"(b));return r;}
__device__ __forceinline__ float fadd_s(float a,float b){float r;asm("v_add_f32_e32 %0, %1, %2":"=v"(r):"v"(a),"v"(b));return r;}
__device__ __forceinline__ float fsub_s(float a,float b){float r;asm("v_sub_f32_e32 %0, %1, %2":"=v"(r):"v"(a),"v"(b));return r;}
typedef float f32x2_t __attribute__((ext_vector_type(2))); typedef __bf16 bf16x2_t __attribute__((ext_vector_type(2)));
__device__ __forceinline__ unsigned cvtpk_s(float lo,float hi){f32x2_t v={lo,hi};bf16x2_t b=__builtin_convertvector(v,bf16x2_t);return __builtin_bit_cast(unsigned,b);}
#define WAIT_BAR(N) asm volatile("s_waitcnt vmcnt(" #N ") lgkmcnt(0)\n\ts_barrier":::"memory")

__device__ __forceinline__ void qkt(f32x16&p0,f32x16&p1,const char*Kslot,const bf16x8*qr,int r32,int hi){
  const char*kb=Kslot+hi*1024+r32*16;
  #pragma unroll
  for(int d0=0;d0<4;++d0){
    const bf16x8 b0=*reinterpret_cast<const bf16x8*>(kb+d0*2048);
    const bf16x8 b1=*reinterpret_cast<const bf16x8*>(kb+d0*2048+512);
    {p0=__builtin_amdgcn_mfma_f32_32x32x16_bf16(b0,qr[d0],p0,0,0,0);p1=__builtin_amdgcn_mfma_f32_32x32x16_bf16(b1,qr[d0],p1,0,0,0);}}
}
typedef __attribute__((address_space(3))) const char* lds_cptr;
typedef short v4i16_t __attribute__((ext_vector_type(4)));
__device__ __forceinline__ void kload8(bf16x8*kf,lds_cptr kp){
  kf[0]=*(const __attribute__((address_space(3))) bf16x8*)(kp);      kf[1]=*(const __attribute__((address_space(3))) bf16x8*)(kp+512);
  kf[2]=*(const __attribute__((address_space(3))) bf16x8*)(kp+2048); kf[3]=*(const __attribute__((address_space(3))) bf16x8*)(kp+2560);
  kf[4]=*(const __attribute__((address_space(3))) bf16x8*)(kp+4096); kf[5]=*(const __attribute__((address_space(3))) bf16x8*)(kp+4608);
  kf[6]=*(const __attribute__((address_space(3))) bf16x8*)(kp+6144); kf[7]=*(const __attribute__((address_space(3))) bf16x8*)(kp+6656);
}
__device__ __forceinline__ void kload2(bf16x8*kf,lds_cptr kp,int j){ kf[2*j]=*(const __attribute__((address_space(3))) bf16x8*)(kp+j*2048); kf[2*j+1]=*(const __attribute__((address_space(3))) bf16x8*)(kp+j*2048+512); }
__device__ __forceinline__ s16x4 vtr(lds_cptr p){ return __builtin_bit_cast(s16x4,__builtin_amdgcn_ds_read_tr16_b64_v4i16((__attribute__((address_space(3))) v4i16_t*)p)); }
__device__ __forceinline__ float rowmax(const f32x16&p0,const f32x16&p1){
  float a=max3f(p0[0],p0[1],p1[0]),b=max3f(p0[2],p0[3],p1[1]);a=max3f(a,p1[2],p1[3]);
  #pragma unroll
  for(int r=4;r<16;r+=4){a=max3f(a,p0[r],p0[r+1]);b=max3f(b,p0[r+2],p0[r+3]);a=max3f(a,p1[r],p1[r+1]);b=max3f(b,p1[r+2],p1[r+3]);}
  const float m=max2f(a,b);
  auto rr=__builtin_amdgcn_permlane32_swap(__float_as_uint(m),__float_as_uint(m),false,false);
  return max2f(__uint_as_float(rr[0]),__uint_as_float(rr[1]));
}
__device__ __forceinline__ void pv(f32x16*o,int vb,bf16x8 pa0,bf16x8 pa1,bf16x8 pa2,bf16x8 pa3){
  #pragma unroll
  for(int d0=0;d0<2;++d0){s16x4 lo[4],hi[4];
    #pragma unroll
    for(int ks=0;ks<4;++ks){
      asm volatile("ds_read_b64_tr_b16 %0,%1 offset:%c2":"=&v"(lo[ks]):"v"(vb),"i"(d0*4096+ks*1024):"memory");
      asm volatile("ds_read_b64_tr_b16 %0,%1 offset:%c2":"=&v"(hi[ks]):"v"(vb),"i"(d0*4096+ks*1024+512):"memory");}
    asm volatile("s_waitcnt lgkmcnt(0)":::"memory");SBAR();
    #define PK(k) (bf16x8){lo[k][0],lo[k][1],lo[k][2],lo[k][3],hi[k][0],hi[k][1],hi[k][2],hi[k][3]}
    o[d0]=__builtin_amdgcn_mfma_f32_32x32x16_bf16(pa0,PK(0),o[d0],0,0,0);
    o[d0]=__builtin_amdgcn_mfma_f32_32x32x16_bf16(pa1,PK(1),o[d0],0,0,0);
    o[d0]=__builtin_amdgcn_mfma_f32_32x32x16_bf16(pa2,PK(2),o[d0],0,0,0);
    o[d0]=__builtin_amdgcn_mfma_f32_32x32x16_bf16(pa3,PK(3),o[d0],0,0,0);
    #undef PK
  }
}

typedef __attribute__((address_space(3))) const f32x4v* lds_f4ptr;
__device__ __forceinline__ void fill_bias(f32x16&c0,f32x16&c1,lds_cptr cb,float negmh){
  #pragma unroll
  for(int g=0;g<4;++g){ const f32x4v v=*(lds_f4ptr)(cb+g*32), w=*(lds_f4ptr)(cb+128+g*32);
    #pragma unroll
    for(int i=0;i<4;i+=2){ const f32x2_t nm={negmh,negmh}; const f32x2_t a=nm-(f32x2_t){v[i],v[i+1]}, b=nm-(f32x2_t){w[i],w[i+1]}; c0[4*g+i]=a.x; c0[4*g+i+1]=a.y; c1[4*g+i]=b.x; c1[4*g+i+1]=b.y; } }
}
#ifndef ATTN_STORE16
#define ATTN_STORE16(p,v) (*(u32x4*)(p)=(v))
#endif
template<int THRL,bool FOX,int KP> __device__ __forceinline__ void attn_unit(int b,int h,int qb,const bf16*Q,const bf16*__restrict__ K,const bf16*__restrict__ V,bf16*O,const float*__restrict__ Cb,float sink2,char*shm){
  int tid_=threadIdx.x; asm volatile("":"+v"(tid_));
  const int tid=tid_,lane=tid&63,r32=lane&31,hi=lane>>5; const int wid=__builtin_amdgcn_readfirstlane(tid>>6);
  const long rowbase=(long)b*SEQ; const int q0=qb*QB;
  const bf16*Qw=Q+(rowbase+q0+wid*QBLK)*DM+h*D;
  const int kvh=FOX?h:(h>>3); const int T0=FOX?0:(qb==0?0:4*qb-2);
  const bf16*Kh=K+(rowbase+(long)T0*KVBLK)*KP+kvh*D,*Vh=V+(rowbase+(long)T0*KVBLK)*KP+kvh*D; const float*Cs=FOX?Cb+lane:nullptr;
  const unsigned lds0=(unsigned)(uintptr_t)shm;
  float*wsf=(float*)(shm+LDS_WS)+wid*64;
  const bf16*ksrc=Kh+(long)lane*KP+wid*8;
  const bf16*vsrc=Vh+(long)(16*(wid&3)+(lane>>2))*KP+(wid>>2)*32+(lane&3)*8;
  const unsigned kdst=lds0+LDS_K+wid*1024, vdst=lds0+LDS_V+wid*1024;
  #define DMA_K(t,slot) glds16(ksrc+(long)(t)*KVBLK*KP,(unsigned)__builtin_amdgcn_readfirstlane(kdst+(slot)))
  #define DMA_C(t) do{ if(FOX) glds4(Cs+(long)(t)*KVBLK,(unsigned)__builtin_amdgcn_readfirstlane(lds0+LDS_CB+(((t)&3)<<8))); }while(0)
  #define PREFILL(X0,X1,t) do{ if(FOX){ fill_bias(X0,X1,cb0+(((t)&3)<<8),-mhat); } else { _Pragma("unroll") for(int r=0;r<16;++r){X0[r]=-mhat;X1[r]=-mhat;} } }while(0)
  #define DMA_V(t,slot) glds16(vsrc+(long)(t)*KVBLK*KP,(unsigned)__builtin_amdgcn_readfirstlane(vdst+(slot)))
  const int vb0=(int)(lds0+LDS_V)+((lane>>4)&1)*32+(lane&3)*8+(4*hi+((lane&15)>>2))*64;
  const char*Kbase=shm+LDS_K; bf16x8 kf[8];
  const lds_cptr shm3=(lds_cptr)shm; const lds_cptr cb0=shm3+LDS_CB+hi*16; const lds_cptr kp0=shm3+LDS_K+hi*1024+r32*16; const lds_cptr vp0=shm3+LDS_V+((lane>>4)&1)*32+(lane&3)*8+(4*hi+((lane&15)>>2))*64;
  const int NT=FOX?(q0+QB)/KVBLK:(qb==0?4:6);
  DMA_K(0,0);DMA_C(0);DMA_V(0,0);DMA_K(1,SLOTB);DMA_C(1);
  bf16x8 qr[4];
  #pragma unroll
  for(int d0=0;d0<4;++d0)qr[d0]=*reinterpret_cast<const bf16x8*>(&Qw[(long)r32*DM+d0*16+hi*8]);
  float mhat=FOX?-Cb[q0+wid*QBLK+r32]:0.f,l_reg=0.f;    f32x16 o[2];o[0]=f32x16{};o[1]=f32x16{};
  const int qrel=wid*QBLK+r32;
  #define CMASK(P0,P1,t) do{int jb_=(t)-(NT-4); if(!FOX||jb_>=0)cmask<!FOX>(P0,P1,jb_,qrel,hi);}while(0)
  bool resc=false;
  #define START(P0,P1) do{ float rm=__builtin_fmaxf(rowmax(P0,P1),0.f); resc=false;     \
    { const float dl=rm; mhat=fadd_s(mhat,dl); \
      _Pragma("unroll") for(int r=0;r<16;++r){P0[r]=fsub_s(P0[r],dl);P1[r]=fsub_s(P1[r],dl);} } \
    _Pragma("unroll") for(int r=0;r<16;++r)P0[r]=__builtin_amdgcn_exp2f(P0[r]); }while(0)
  #define RESC() do{ if(resc){ asm volatile("s_waitcnt lgkmcnt(0)":::"memory"); \
      _Pragma("unroll") for(int d_=0;d_<2;++d_) _Pragma("unroll") for(int r=0;r<16;++r)o[d_][r]*=wsf[crow(r,hi)]; } }while(0)
  f32x16 pA0,pA1,pB0,pB1;
  int sl_prev=0,sl_cur=0,sl_next=SLOTB;
  #define ROT() do{sl_prev=sl_cur;sl_cur=sl_next;sl_next=(sl_next==(NSLOT-1)*SLOTB)?0:sl_next+SLOTB;}while(0)
  DMA_K(2,2*SLOTB);DMA_C(2);
  if(FOX){WAIT_BAR(5);}else{WAIT_BAR(3);}
  PREFILL(pA0,pA1,0); qkt(pA0,pA1,Kbase,qr,r32,hi);asm volatile("s_nop 15\n\ts_nop 7":"+v"(pA0),"+v"(pA1));CMASK(pA0,pA1,0);
  START(pA0,pA1);
  _Pragma("unroll") for(int r=0;r<16;++r)pA1[r]=__builtin_amdgcn_exp2f(pA1[r]);
  WAIT_BAR(0);
  DMA_K(3,0);DMA_C(3);DMA_V(1,SLOTB);
  ROT();
  kload8(kf,kp0+sl_cur);
  PREFILL(pB0,pB1,1); if(FOX){ WAIT_BAR(3); }else{ WAIT_BAR(2); }
  s16x4 vlo[NVB],vhi[NVB]; u32x4 pw0,pw1,pw2,pw3;
  #define PKW(P,B) cvtpk_s(P[B],P[B+1])
  #define PAF(k) __builtin_bit_cast(bf16x8,pw##k)
  #define VFR(j) (bf16x8){vlo[(j)%NVB][0],vlo[(j)%NVB][1],vlo[(j)%NVB][2],vlo[(j)%NVB][3],vhi[(j)%NVB][0],vhi[(j)%NVB][1],vhi[(j)%NVB][2],vhi[(j)%NVB][3]}
  #define PIN(x) asm volatile("":"+v"(x))
  #define MX3(a,b,c) __builtin_fmaxf(__builtin_fmaxf((a),(b)),(c))
  #define GAPA(MF,A0,A1,A2,A3,W0,W1,PW) do{ MF; sacc+=(f32x2_t){A0,A1}; sacc+=(f32x2_t){A2,A3}; PIN(sacc); W0; W1; PIN(PW); SBAR(); }while(0)
  #define EX(v) __builtin_amdgcn_exp2f(v)
  #define GAPB(MF,VR,BX_,X,B) do{ MF; VR; BX_; X[B]=EX(X[B]); X[B+1]=EX(X[B+1]); X[B+2]=EX(X[B+2]); X[B+3]=EX(X[B+3]); PIN(X); SBAR(); }while(0)
  #define VOFF(j) ((((j)&1)*4096)+(((j)>>1)*1024))
  #define VRD(j) do{ if((j)>=0&&(j)<8){ vlo[(j)%NVB]=vtr(vp_+VOFF(j)); vhi[(j)%NVB]=vtr(vp_+VOFF(j)+512); } }while(0)
  #define KRD(G,j) do{ if(G){ kload2(kf,kp0+sl_next,j); SBAR(); } }while(0)
  #define BSUBX(X,g) do{ const f32x2_t nm_={nmh_,nmh_}; const f32x2_t a_=nm_-(f32x2_t){bt[0],bt[1]}, b_=nm_-(f32x2_t){bt[2],bt[3]}; X[4*(g)+0]=a_.x; X[4*(g)+1]=a_.y; X[4*(g)+2]=b_.x; X[4*(g)+3]=b_.y; }while(0)
  #define BXX(Y0,Y1,j,G) do{ if(FOX&&(G)){ if((j)>=1&&(j)<=4){BSUBX(Y0,((j)-1)&3);} if((j)>=5){BSUBX(Y1,((j)-5)&3);} if((j)<8){ bt=*(lds_f4ptr)(cbn_+(((j)&3)*32+((j)>>2)*128)); } } }while(0)
  #define STEP(C0,C1,P0,P1,t,GK,GV,GL) do{ SBAR(); f32x4v bt; const lds_cptr cbn_=cb0+((((t)+1)&3)<<8); \
    const lds_cptr vp_=vp0+sl_prev; \
    VRD(0-(8-NVB)); SBAR(); f32x2_t sacc={P0[0],P0[1]}; \
    GAPA(C0=__builtin_amdgcn_mfma_f32_32x32x16_bf16(kf[0],qr[0],C0,0,0,0), P0[2],P0[3],P0[4],P0[5],     pw0[0]=PKW(P0,0), pw0[1]=PKW(P0,2), pw0); \
    VRD(1-(8-NVB)); SBAR(); GAPA(C1=__builtin_amdgcn_mfma_f32_32x32x16_bf16(kf[1],qr[0],C1,0,0,0), P0[6],P0[7],P0[8],P0[9],     pw0[2]=PKW(P0,4), pw0[3]=PKW(P0,6), pw0); \
    VRD(2-(8-NVB)); SBAR(); GAPA(C0=__builtin_amdgcn_mfma_f32_32x32x16_bf16(kf[2],qr[1],C0,0,0,0),   P0[10],P0[11],P0[12],P0[13], pw1[0]=PKW(P0,8), pw1[1]=PKW(P0,10), pw1); \
    VRD(3-(8-NVB)); SBAR(); GAPA(C1=__builtin_amdgcn_mfma_f32_32x32x16_bf16(kf[3],qr[1],C1,0,0,0),   P0[14],P0[15],P1[0],P1[1],   pw1[2]=PKW(P0,12),pw1[3]=PKW(P0,14), pw1); \
    VRD(4-(8-NVB)); SBAR(); GAPA(C0=__builtin_amdgcn_mfma_f32_32x32x16_bf16(kf[4],qr[2],C0,0,0,0),   P1[2],P1[3],P1[4],P1[5],     pw2[0]=PKW(P1,0), pw2[1]=PKW(P1,2), pw2); \
    VRD(5-(8-NVB)); SBAR(); GAPA(C1=__builtin_amdgcn_mfma_f32_32x32x16_bf16(kf[5],qr[2],C1,0,0,0),   P1[6],P1[7],P1[8],P1[9],     pw2[2]=PKW(P1,4), pw2[3]=PKW(P1,6), pw2); \
    VRD(6-(8-NVB)); SBAR(); GAPA(C0=__builtin_amdgcn_mfma_f32_32x32x16_bf16(kf[6],qr[3],C0,0,0,0),   P1[10],P1[11],P1[12],P1[13], pw3[0]=PKW(P1,8), pw3[1]=PKW(P1,10), pw3); \
    VRD(7-(8-NVB)); SBAR(); GAPA(C1=__builtin_amdgcn_mfma_f32_32x32x16_bf16(kf[7],qr[3],C1,0,0,0),   P1[14],P1[15],0.f,0.f,       pw3[2]=PKW(P1,12),pw3[3]=PKW(P1,14), pw3); \
    l_reg+=sacc.x+sacc.y; \
    if(GK){DMA_K((t)+3,sl_cur);DMA_C((t)+3);} if(GV){DMA_V((t)+1,sl_next);} \
    CMASK(C0,C1,t); \
    { float a=MX3(C0[0],C0[1],C1[0]),b=MX3(C0[2],C0[3],C1[1]); a=MX3(a,C1[2],C1[3]); \
      _Pragma("unroll") for(int r=4;r<16;r+=4){a=MX3(a,C0[r],C0[r+1]);b=MX3(b,C0[r+2],C0[r+3]);a=MX3(a,C1[r],C1[r+1]);b=MX3(b,C1[r+2],C1[r+3]);} \
      float rm=__builtin_fmaxf(a,b); { auto rr=__builtin_amdgcn_permlane32_swap(__float_as_uint(rm),__float_as_uint(rm),false,false); rm=__builtin_fmaxf(__uint_as_float(rr[0]),__uint_as_float(rr[1])); } \
      resc=false; \
      if(__builtin_expect(__any(rm>(float)THRL),0)){ const float dl=__builtin_fmaxf(rm,0.f); mhat+=dl; \
        _Pragma("unroll") for(int r=0;r<16;++r){C0[r]-=dl;C1[r]-=dl;} \
        const float f=__builtin_amdgcn_exp2f(-dl); l_reg*=f; if(hi==0)wsf[r32]=f; resc=true; } } \
    const float nmh_=-mhat; SBAR(); \
    GAPB(o[0]=__builtin_amdgcn_mfma_f32_32x32x16_bf16(PAF(0),VFR(0),o[0],0,0,0), VRD(0+NVB), BXX(P0,P1,0,GL), C0,0); \
    GAPB(o[1]=__builtin_amdgcn_mfma_f32_32x32x16_bf16(PAF(0),VFR(1),o[1],0,0,0), VRD(1+NVB), BXX(P0,P1,1,GL), C0,4); \
    KRD(GL,0); GAPB(o[0]=__builtin_amdgcn_mfma_f32_32x32x16_bf16(PAF(1),VFR(2),o[0],0,0,0), VRD(2+NVB), BXX(P0,P1,2,GL), C0,8); \
    KRD(GL,1); GAPB(o[1]=__builtin_amdgcn_mfma_f32_32x32x16_bf16(PAF(1),VFR(3),o[1],0,0,0), VRD(3+NVB), BXX(P0,P1,3,GL), C0,12); \
    KRD(GL,2); GAPB(o[0]=__builtin_amdgcn_mfma_f32_32x32x16_bf16(PAF(2),VFR(4),o[0],0,0,0), VRD(4+NVB), BXX(P0,P1,4,GL), C1,0); \
    KRD(GL,3); GAPB(o[1]=__builtin_amdgcn_mfma_f32_32x32x16_bf16(PAF(2),VFR(5),o[1],0,0,0), VRD(5+NVB), BXX(P0,P1,5,GL), C1,4); \
    GAPB(o[0]=__builtin_amdgcn_mfma_f32_32x32x16_bf16(PAF(3),VFR(6),o[0],0,0,0), VRD(6+NVB), BXX(P0,P1,6,GL), C1,8); \
    GAPB(o[1]=__builtin_amdgcn_mfma_f32_32x32x16_bf16(PAF(3),VFR(7),o[1],0,0,0), VRD(7+NVB), BXX(P0,P1,7,GL), C1,12); \
    BXX(P0,P1,8,GL); if(!FOX&&(GL)){ PREFILL(P0,P1,(t)+1); } \
    }while(0)
  int t=1;
  #undef CMASK
  #define CMASK(P0,P1,t) do{}while(0)
  for(;t+5<NT;t+=2){
    STEP(pB0,pB1,pA0,pA1,t,true,true,true);     if(FOX){WAIT_BAR(3);}else{WAIT_BAR(2);} RESC(); ROT();
    STEP(pA0,pA1,pB0,pB1,t+1,true,true,true);   if(FOX){WAIT_BAR(3);}else{WAIT_BAR(2);} RESC(); ROT();
  }
  #undef CMASK
  #define CMASK(P0,P1,t) do{int jb_=(t)-(NT-4); if(!FOX||jb_>=0)cmask<!FOX>(P0,P1,jb_,qrel,hi);}while(0)
  #define ENDW(tt) do{ if((tt)+3<NT){ if(FOX){WAIT_BAR(3);}else{WAIT_BAR(2);} } else if((tt)+2<NT){WAIT_BAR(1);} else {WAIT_BAR(0);} }while(0)
  for(;t+1<NT;t+=2){
    STEP(pB0,pB1,pA0,pA1,t,(t+3<NT),(t+1<NT),(t+1<NT));       ENDW(t);   RESC(); ROT();
    STEP(pA0,pA1,pB0,pB1,t+1,(t+4<NT),(t+2<NT),(t+2<NT));     ENDW(t+1); RESC(); ROT();
  }
  STEP(pB0,pB1,pA0,pA1,NT-1,false,false,false); RESC();
  { float sacc=pB0[0]+pB0[1]; _Pragma("unroll") for(int r=2;r<16;++r)sacc+=pB0[r]; _Pragma("unroll") for(int r=0;r<16;++r)sacc+=pB1[r]; l_reg+=sacc;
    pw0=(u32x4){PKW(pB0,0),PKW(pB0,2),PKW(pB0,4),PKW(pB0,6)};pw1=(u32x4){PKW(pB0,8),PKW(pB0,10),PKW(pB0,12),PKW(pB0,14)};pw2=(u32x4){PKW(pB1,0),PKW(pB1,2),PKW(pB1,4),PKW(pB1,6)};pw3=(u32x4){PKW(pB1,8),PKW(pB1,10),PKW(pB1,12),PKW(pB1,14)};
    SBAR(); pv(o,vb0+sl_cur,PAF(0),PAF(1),PAF(2),PAF(3)); }
  #undef PKW
  #undef PAF
  #undef VFR
  #undef PIN
  #undef MX3
  #undef GAPA
  #undef GAPB
  #undef EX
  #undef VRD
  #undef VOFF
  #undef KRD
  #undef STEP
  #undef ENDW
  {auto rr=__builtin_amdgcn_permlane32_swap(__float_as_uint(l_reg),__float_as_uint(l_reg),false,false);l_reg=__uint_as_float(rr[0])+__uint_as_float(rr[1]);}
  if(!FOX) l_reg+=__builtin_amdgcn_exp2f(sink2-mhat);
  if(hi==0)wsf[32+r32]=l_reg;asm volatile("s_waitcnt lgkmcnt(0)":::"memory");
  float rli[16];
  #pragma unroll
  for(int r=0;r<16;++r)rli[r]=__builtin_amdgcn_rcpf(wsf[32+crow(r,hi)]);
  bf16*Ow=O+(rowbase+q0+wid*QBLK)*DM+h*D;
  { bf16*stg=(bf16*)(shm+LDS_OST)+wid*2048;
    #pragma unroll
    for(int r=0;r<16;++r){const int orow=crow(r,hi);
      #pragma unroll
      for(int d0=0;d0<2;++d0)stg[orow*64+d0*32+r32]=(bf16)(cvtpk_s(o[d0][r]*rli[r],0.f)&0xffffu);}
    asm volatile("s_waitcnt lgkmcnt(0)":::"memory");
    #pragma unroll
    for(int i=0;i<4;++i){const int row=i*8+(lane>>3),ch=lane&7; const u32x4 v=*(const u32x4*)(stg+row*64+ch*8); ATTN_STORE16(Ow+(long)row*DM+ch*8,v);} }
  asm volatile("s_waitcnt lgkmcnt(0)\n\ts_barrier":::"memory");
  #undef DMA_K
  #undef DMA_V
  #undef DMA_C
  #undef PREFILL
  #undef BSUBX
  #undef BXX
  #undef CMASK
  #undef START
  #undef RESC
  #undef ROT
}
constexpr int ATTN_LDS_BYTES=LDS_BYTES;
#undef SBAR
#undef WAIT_BAR
}

#ifndef REP_PHASE
#define REP_PHASE 0
#endif
#ifndef FUSED_FINAL
#define FUSED_FINAL 0
#endif
#ifndef NAIVE_SWA
#define NAIVE_SWA 0
#endif
#ifndef NAIVE_FOX
#define NAIVE_FOX 0
#endif
#define LAS __attribute__((address_space(3)))
typedef unsigned short bf16;
typedef float f32x4 __attribute__((ext_vector_type(4)));
typedef unsigned v4u __attribute__((ext_vector_type(4)));
typedef unsigned v2u __attribute__((ext_vector_type(2)));
constexpr int NWAVES = 8;
constexpr int RING_BYTES = 131072, LDS_BYTES = 147456;

__device__ __forceinline__ float wave_sum(float v) {
#pragma unroll
    for (int o = 1; o < 64; o <<= 1) v += __shfl_xor(v, o);
    return v;
}
#define LDS_WAIT() asm volatile("s_waitcnt lgkmcnt(0)" ::: "memory")

#define XB_TMO      128
#define XB_XCNT(j)  (256  + 64 * (j))
#define XB_XSUB(j)  (1280 + 64 * (j))
#define XB_XGEN(j)  (2304 + 64 * (j))
#define XB_TOP      3328
#define XB_TOPGEN   3392
#define XCD_BAR_WORDS 3456
#define XB_SPIN_CAP (1u << 18)

__device__ __forceinline__ unsigned xb_ld(unsigned* p)              { return __hip_atomic_load(p, __ATOMIC_RELAXED, __HIP_MEMORY_SCOPE_AGENT); }
__device__ __forceinline__ unsigned xb_add(unsigned* p, unsigned v) { return __hip_atomic_fetch_add(p, v, __ATOMIC_RELAXED, __HIP_MEMORY_SCOPE_AGENT); }
__device__ __forceinline__ unsigned xb_xcc_id() { return (unsigned)__builtin_amdgcn_s_getreg((3 << 11) | 20) & 0xFu; }
#define XB_SPIN(cond, bar) do { unsigned _sp = 0; while (cond) { __builtin_amdgcn_s_sleep(1); \
    if ((++_sp & 255u) == 0u) { if (xb_ld(&(bar)[XB_TMO])) break; if (_sp > XB_SPIN_CAP) { atomicAdd(&(bar)[XB_TMO], 1u); break; } } } } while (0)

struct XcdBarrier {
    unsigned* bar; unsigned x;
    volatile LAS unsigned* st;
};

__device__ __forceinline__ XcdBarrier xcd_barrier_post(unsigned* bar, volatile LAS unsigned* st) {
    XcdBarrier b; b.bar = bar; b.x = xb_xcc_id(); b.st = st;
    if (threadIdx.x == 0) (void)xb_add(&bar[XB_XCNT(b.x)], 1u);
    return b;
}
__device__ __forceinline__ void xcd_barrier_complete(unsigned* bar, unsigned x, unsigned& nloc, unsigned& nx) {
    const unsigned G = gridDim.x * gridDim.y * gridDim.z;
    unsigned sum, cnt, mine, sp = 0u;
    for (;;) {
        sum = 0u; cnt = 0u; mine = 0u;
#pragma unroll
        for (unsigned j = 0; j < 16; ++j) { const unsigned c = xb_ld(&bar[XB_XCNT(j)]); sum += c; cnt += (c > 0u) ? 1u : 0u; mine = (j == x) ? c : mine; }
        if (sum == G) break;
        __builtin_amdgcn_s_sleep(1);
        if ((++sp & 255u) == 0u) { if (xb_ld(&bar[XB_TMO])) break; if (sp > XB_SPIN_CAP) { atomicAdd(&bar[XB_TMO], 1u); break; } }
    }
    nloc = mine > 0u ? mine : 1u; nx = cnt > 0u ? cnt : 1u;
}

__device__ __forceinline__ void xcd_barrier(const XcdBarrier& b) {
    asm volatile("s_waitcnt vmcnt(0)" ::: "memory");
    __syncthreads();
    if (threadIdx.x == 0) {
        unsigned* bar = b.bar;
        __builtin_amdgcn_s_waitcnt(0);
        unsigned nloc = b.st[0], nx = b.st[1];
        if (nloc == 0u) { xcd_barrier_complete(bar, b.x, nloc, nx); b.st[0] = nloc; b.st[1] = nx; }
        const unsigned old = xb_add(&bar[XB_XSUB(b.x)], 1u);
        const unsigned gen = old / nloc;
        if (old + 1u == (gen + 1u) * nloc) {
            __builtin_amdgcn_fence(__ATOMIC_RELEASE, "agent");
            asm volatile("s_waitcnt vmcnt(0)" ::: "memory");
            const unsigned og = xb_add(&bar[XB_TOP], 1u);
            const unsigned tg = og / nx;
            if (og + 1u == (tg + 1u) * nx) xb_add(&bar[XB_TOPGEN], 1u);
            else XB_SPIN(xb_ld(&bar[XB_TOPGEN]) == tg, bar);
            __builtin_amdgcn_fence(__ATOMIC_ACQUIRE, "agent");
            xb_add(&bar[XB_XGEN(b.x)], 1u);
            asm volatile("s_waitcnt vmcnt(0)" ::: "memory");
        } else {
            XB_SPIN(xb_ld(&bar[XB_XGEN(b.x)]) == gen, bar);
            __builtin_amdgcn_fence(__ATOMIC_ACQUIRE, "agent");
            asm volatile("s_waitcnt vmcnt(0)" ::: "memory");
        }
    }
    __syncthreads();
}


__device__ __forceinline__ void tr_item(const float* W, int K, int N, bf16* WT, int dst_row0, int src_col0, int nvalid, int kb, const float* kscale, float cscale, LAS float* scr, int lane) {
    const int k0 = 64 * kb, c = lane & 31;
    float tv[32];
    const float* wp = W + (size_t)(k0 + (lane >> 5)) * N + src_col0 + c;
#pragma unroll
    for (int i = 0; i < 32; ++i) { tv[i] = 0.f; if (c < nvalid) tv[i] = __builtin_nontemporal_load(wp + (size_t)(2 * i) * N); }
#pragma unroll
    for (int i = 0; i < 32; ++i) { const int kk = 2 * i + (lane >> 5); float v = tv[i] * cscale; if (kscale) v *= kscale[k0 + kk]; scr[kk * 33 + c] = v; }
    LDS_WAIT(); asm volatile("" ::: "memory");
    const int ch = lane & 7;
#pragma unroll
    for (int j = 0; j < 4; ++j) { const int n = (lane >> 3) + 8 * j; const LAS float* s = scr + (8 * ch) * 33 + n;
        v4u o; o.x = pg8::cvt_pk_bf16(s[0 * 33], s[1 * 33]); o.y = pg8::cvt_pk_bf16(s[2 * 33], s[3 * 33]); o.z = pg8::cvt_pk_bf16(s[4 * 33], s[5 * 33]); o.w = pg8::cvt_pk_bf16(s[6 * 33], s[7 * 33]);
        *(v4u*)(WT + (size_t)(dst_row0 + n) * K + k0 + 8 * ch) = o; }
    LDS_WAIT(); asm volatile("" ::: "memory");
}
__device__ __forceinline__ void win_map(int db, int& src, int& nv) {
    const int pn = db >> 3, bj = (db >> 2) & 1, wc = db & 3; nv = 32;
    if (pn < 4) src = (4 * pn + wc) * 64 + 32 * bj;
    else if (pn == 4) src = (wc < 2 ? 1024 + wc * 64 : 1152 + (wc - 2) * 64) + 32 * bj;
    else if (pn < 17) { const int t = pn - 5; src = 1280 + (t >> 2) * 1024 + (4 * (t & 3) + wc) * 64 + 32 * bj; }
    else if (pn < 33) src = 4368 + (db - 136) * 32;
    else { src = 4352; nv = (db == 264) ? 16 : 0; }
}

struct Args { const float* x; const int* pos; const float* attn_norm; const float* w_in; const float* fbias; const float* sinks; const float* w_bs; const float* w_bf;
              const float* w_out; const float* mlp_norm; const float* w_up; const float* w_dn; const float* final_norm; float* out; unsigned char* ws; long long fused_final; };

__device__ __forceinline__ void rms_row_to_bf16(const float* xrow, const float* gain, bf16* orow, int lane) {
    const f32x4* xr = (const f32x4*)xrow + lane; f32x4 v[8]; float s = 0.f;
#pragma unroll
    for (int j = 0; j < 8; ++j) { v[j] = xr[64 * j]; s += (v[j].x * v[j].x + v[j].y * v[j].y) + (v[j].z * v[j].z + v[j].w * v[j].w); }
    const float rstd = __builtin_amdgcn_rsqf(wave_sum(s) * (1.f / DM) + RMS_EPS);
    const f32x4* gr = (const f32x4*)gain + lane; v2u* o8 = (v2u*)orow + lane;
#pragma unroll
    for (int j = 0; j < 8; ++j) { const f32x4 g = gr[64 * j]; v2u w; w.x = pg8::cvt_pk_bf16(v[j].x * rstd * g.x, v[j].y * rstd * g.y); w.y = pg8::cvt_pk_bf16(v[j].z * rstd * g.z, v[j].w * rstd * g.w); o8[64 * j] = w; }
}

__device__ __forceinline__ void rms_row2_to_bf16(const float* x0, const float* x1, const float* gain, bf16* o0, bf16* o1, int lane) {
    const f32x4* xr0 = (const f32x4*)x0 + lane; const f32x4* xr1 = (const f32x4*)x1 + lane; f32x4 v[8], w[8]; float s = 0.f, t = 0.f;
#pragma unroll
    for (int j = 0; j < 8; ++j) { v[j] = __builtin_nontemporal_load(xr0 + 64 * j); w[j] = __builtin_nontemporal_load(xr1 + 64 * j); }
#pragma unroll
    for (int j = 0; j < 8; ++j) { s += (v[j].x * v[j].x + v[j].y * v[j].y) + (v[j].z * v[j].z + v[j].w * v[j].w); t += (w[j].x * w[j].x + w[j].y * w[j].y) + (w[j].z * w[j].z + w[j].w * w[j].w); }
    const float rs = __builtin_amdgcn_rsqf(wave_sum(s) * (1.f / DM) + RMS_EPS), rt = __builtin_amdgcn_rsqf(wave_sum(t) * (1.f / DM) + RMS_EPS);
    const f32x4* gr = (const f32x4*)gain + lane; v2u* p0 = (v2u*)o0 + lane; v2u* p1 = (v2u*)o1 + lane;
#pragma unroll
    for (int j = 0; j < 8; ++j) { const f32x4 g = gr[64 * j]; v2u a, c;
        a.x = pg8::cvt_pk_bf16(v[j].x * rs * g.x, v[j].y * rs * g.y); a.y = pg8::cvt_pk_bf16(v[j].z * rs * g.z, v[j].w * rs * g.w);
        c.x = pg8::cvt_pk_bf16(w[j].x * rt * g.x, w[j].y * rt * g.y); c.y = pg8::cvt_pk_bf16(w[j].z * rt * g.z, w[j].w * rt * g.w);
        p0[64 * j] = a; p1[64 * j] = c; }
}
__device__ __forceinline__ void p0_prologue(const Args& a, LAS unsigned char* lds, int vcu, int G, int wave, int lane) {
    unsigned char* ws = a.ws;
    LAS float* scr = (LAS float*)(lds + wave * 16384);
    const int gw = vcu * NWAVES + wave, NGW = G * NWAVES;
    constexpr int I_IN = (NIN / 32) * (DM / 64), I_BS = (DM / 32) * (1024 / 64), I_OUT = (DM / 32) * (DM / 64), I_UP = (DFF / 32) * (DM / 64), I_DN = (DM / 32) * (DFF / 64);
    constexpr int NITEMS = I_IN + 2 * I_BS + I_OUT + I_UP + I_DN;
    for (int it = gw; it < NITEMS; it += NGW) {
        int r = it;
        if (r < I_IN) { const int db = r / (DM / 64), kb = r % (DM / 64); int src, nv; win_map(db, src, nv); const float csc = (db >= 136 && db < 264) ? -LOG2E : 1.0f;
            tr_item(a.w_in, DM, DIN, (bf16*)(ws + WS_WIN), db * 32, src, nv, kb, nullptr, csc, scr, lane); continue; } r -= I_IN;
        if (r < I_BS) { const int db = r / 16, kb = r % 16; tr_item(a.w_bs, 1024, DM, (bf16*)(ws + WS_WBS), db * 32, db * 32, 32, kb, nullptr, 1.0f, scr, lane); continue; } r -= I_BS;
        if (r < I_BS) { const int db = r / 16, kb = r % 16; tr_item(a.w_bf, 1024, DM, (bf16*)(ws + WS_WBF), db * 32, db * 32, 32, kb, nullptr, 1.0f, scr, lane); continue; } r -= I_BS;
        if (r < I_OUT) { const int db = r / 32, kb = r % 32; tr_item(a.w_out, DM, DM, (bf16*)(ws + WS_WOUT), db * 32, db * 32, 32, kb, nullptr, 1.0f, scr, lane); continue; } r -= I_OUT;
        if (r < I_UP) { const int db = r / 32, kb = r % 32; tr_item(a.w_up, DM, DFF, (bf16*)(ws + WS_WUP), db * 32, db * 32, 32, kb, a.mlp_norm, 1.0f, scr, lane); continue; } r -= I_UP;
        { const int db = r / 128, kb = r % 128; tr_item(a.w_dn, DFF, DM, (bf16*)(ws + WS_WDN), db * 32, db * 32, 32, kb, nullptr, 1.0f, scr, lane); }
    }
    for (int m = gw; m < M; m += 2 * NGW) rms_row2_to_bf16(a.x + (size_t)m * DM, a.x + (size_t)(m + NGW) * DM, a.attn_norm, (bf16*)(ws + WS_XN) + (size_t)m * DM, (bf16*)(ws + WS_XN) + (size_t)(m + NGW) * DM, lane);
    float* cs = (float*)(ws + WS_CS);
    for (int e = gw * 64 + lane; e < M * 32; e += NGW * 64) {
        const int tok = e >> 5, i = e & 31;
        const float inv_freq = powf(10000.0f, -(float)(2 * i) / 64.0f);
        const float ang = (float)a.pos[tok] * inv_freq;
        double rev = (double)ang * 0.15915494309189535; rev -= floor(rev);
        const float rf = (float)rev;
        cs[e] = __builtin_amdgcn_cosf(rf); cs[(size_t)M * 32 + e] = __builtin_amdgcn_sinf(rf);
    }
}

__device__ __forceinline__ void cumsum_unit(const Args& a, int bh, LAS unsigned char* lds) {
    const float* FL = (const float*)(a.ws + WS_FL); float* Cp = (float*)(a.ws + WS_C);
    LAS double* sh = (LAS double*)lds;
    const int b = bh >> 4, h = bh & 15, tid = threadIdx.x, s0 = tid * 16; const float fb = a.fbias[h];
    float ls[16]; double run = 0.0;
#pragma unroll
    for (int i = 0; i < 16; ++i) { const float z = FL[(size_t)(b * SEQ + s0 + i) * 16 + h] + fb; const float v = fminf(z, 0.f) - log1pf(expf(-fabsf(z))); ls[i] = v; run += (double)v; }
    sh[tid] = run; __syncthreads();
    double pre = 0.0; for (int k = 0; k < tid; ++k) pre += sh[k];
#pragma unroll
    for (int i = 0; i < 16; ++i) { pre += (double)ls[i]; Cp[(size_t)bh * SEQ + s0 + i] = (float)(pre * 1.4426950408889634); }
    __syncthreads();
}

__device__ __forceinline__ void naive_swa_unit(const Args& a, int unit) {
    const bf16* AQ = (const bf16*)(a.ws + WS_AQ); const bf16* AK = (const bf16*)(a.ws + WS_AK); const bf16* AV = (const bf16*)(a.ws + WS_AV); bf16* OA = (bf16*)(a.ws + WS_OA);
    const int tid = threadIdx.x, head = tid & 15, tok = unit * 32 + (tid >> 4), b = tok / SEQ, s = tok % SEQ, kvh = head >> 3;
    float q[64], o[64]; float m = -INFINITY, l = 0.f;
    { const v4u* qp = (const v4u*)(AQ + (size_t)tok * 1024 + head * 64);
#pragma unroll
      for (int c = 0; c < 8; ++c) { const v4u w = qp[c];
#pragma unroll
          for (int e = 0; e < 4; ++e) { q[8 * c + 2 * e] = pg8::bf_lo(w[e]); q[8 * c + 2 * e + 1] = pg8::bf_hi(w[e]); } } }
#pragma unroll
    for (int d = 0; d < 64; ++d) o[d] = 0.f;
    for (int i = 0; i < 128; ++i) {
        const int j = s - i; const bool valid = j >= 0; const int jj = valid ? j : 0;
        const v4u* kp = (const v4u*)(AK + (size_t)(b * SEQ + jj) * 128 + kvh * 64); const v4u* vp = (const v4u*)(AV + (size_t)(b * SEQ + jj) * 128 + kvh * 64);
        float dot = 0.f;
#pragma unroll
        for (int c = 0; c < 8; ++c) { const v4u w = kp[c];
#pragma unroll
            for (int e = 0; e < 4; ++e) { dot += q[8 * c + 2 * e] * pg8::bf_lo(w[e]); dot += q[8 * c + 2 * e + 1] * pg8::bf_hi(w[e]); } }
        const float lg = valid ? dot : -INFINITY;
        const float mn = fmaxf(m, lg), al = __builtin_amdgcn_exp2f(m - mn), p = __builtin_amdgcn_exp2f(lg - mn);
        l = l * al + p; m = mn;
#pragma unroll
        for (int c = 0; c < 8; ++c) { const v4u w = vp[c];
#pragma unroll
            for (int e = 0; e < 4; ++e) { o[8 * c + 2 * e] = o[8 * c + 2 * e] * al + p * pg8::bf_lo(w[e]); o[8 * c + 2 * e + 1] = o[8 * c + 2 * e + 1] * al + p * pg8::bf_hi(w[e]); } }
    }
    { const float sk = a.sinks[head] * LOG2E; const float m2 = fmaxf(m, sk), al = __builtin_amdgcn_exp2f(m - m2); l = l * al + __builtin_amdgcn_exp2f(sk - m2);
      const float rl = al / l;
      v4u* op = (v4u*)(OA + (size_t)tok * 1024 + head * 64);
#pragma unroll
      for (int c = 0; c < 8; ++c) { v4u w;
#pragma unroll
          for (int e = 0; e < 4; ++e) w[e] = pg8::cvt_pk_bf16(o[8 * c + 2 * e] * rl, o[8 * c + 2 * e + 1] * rl);
          op[c] = w; } }
}
__device__ __forceinline__ void naive_fox_unit(const Args& a, int bh, int qblk) {
    const bf16* FQ = (const bf16*)(a.ws + WS_FQ); const bf16* FK = (const bf16*)(a.ws + WS_FK); const bf16* FV = (const bf16*)(a.ws + WS_FV); bf16* OB = (bf16*)(a.ws + WS_OB);
    const float* Cp = (const float*)(a.ws + WS_C) + (size_t)bh * SEQ;
    const int tid = threadIdx.x, b = bh >> 4, h = bh & 15, s = qblk * 512 + tid; const size_t tok = (size_t)b * SEQ + s;
    float q[64], o[64]; float m = -INFINITY, l = 0.f;
    { const v4u* qp = (const v4u*)(FQ + tok * 1024 + h * 64);
#pragma unroll
      for (int c = 0; c < 8; ++c) { const v4u w = qp[c];
#pragma unroll
          for (int e = 0; e < 4; ++e) { q[8 * c + 2 * e] = pg8::bf_lo(w[e]); q[8 * c + 2 * e + 1] = pg8::bf_hi(w[e]); } } }
#pragma unroll
    for (int d = 0; d < 64; ++d) o[d] = 0.f;
    const float cq = Cp[s];
    const int jend = __builtin_amdgcn_readfirstlane(qblk * 512 + (tid | 63));
    for (int j = 0; j <= jend; ++j) {
        const v4u* kp = (const v4u*)(FK + ((size_t)b * SEQ + j) * 1024 + h * 64); const v4u* vp = (const v4u*)(FV + ((size_t)b * SEQ + j) * 1024 + h * 64);
        float dot = 0.f;
#pragma unroll
        for (int c = 0; c < 8; ++c) { const v4u w = kp[c];
#pragma unroll
            for (int e = 0; e < 4; ++e) { dot += q[8 * c + 2 * e] * pg8::bf_lo(w[e]); dot += q[8 * c + 2 * e + 1] * pg8::bf_hi(w[e]); } }
        float lg = dot + (cq - Cp[j]); lg = (j <= s) ? lg : -INFINITY;
        const float mn = fmaxf(m, lg), al = __builtin_amdgcn_exp2f(m - mn), p = __builtin_amdgcn_exp2f(lg - mn);
        l = l * al + p; m = mn;
#pragma unroll
        for (int c = 0; c < 8; ++c) { const v4u w = vp[c];
#pragma unroll
            for (int e = 0; e < 4; ++e) { o[8 * c + 2 * e] = o[8 * c + 2 * e] * al + p * pg8::bf_lo(w[e]); o[8 * c + 2 * e + 1] = o[8 * c + 2 * e + 1] * al + p * pg8::bf_hi(w[e]); } }
    }
    { const float rl = 1.0f / l; v4u* op = (v4u*)(OB + tok * 1024 + h * 64);
#pragma unroll
      for (int c = 0; c < 8; ++c) { v4u w;
#pragma unroll
          for (int e = 0; e < 4; ++e) w[e] = pg8::cvt_pk_bf16(o[8 * c + 2 * e] * rl, o[8 * c + 2 * e + 1] * rl);
          op[c] = w; } }
}

__global__ void __launch_bounds__(NWAVES * 64, 2) mega_fwd(Args a) {
    extern __shared__ __attribute__((aligned(16))) unsigned char lds_raw[];
    LAS unsigned char* lds = (LAS unsigned char*)lds_raw;
    cg::grid_group grid = cg::this_grid();
    int tid_ = threadIdx.x; asm volatile("" : "+v"(tid_));
    const int tid = tid_, lane = tid & 63, wave = __builtin_amdgcn_readfirstlane(tid >> 6);
    const int G = gridDim.x, bx = blockIdx.x, vcu = (G % 8 == 0) ? (bx % 8) * (G / 8) + bx / 8 : bx;
    unsigned char* ws = a.ws;
    float* SS1 = (float*)(ws + WS_CTL); float* SS2 = SS1 + M;
#define GRID_SYNC_CG() do { asm volatile("s_waitcnt vmcnt(0) lgkmcnt(0)" ::: "memory"); grid.sync(); } while (0)
#define GRID_SYNC() xcd_barrier(xbar)
    if (tid < 2) ((LAS unsigned*)(lds + RING_BYTES))[tid] = 0u;
    __syncthreads();
    const XcdBarrier xbar = xcd_barrier_post((unsigned*)(ws + WS_CTL + 786432), (volatile LAS unsigned*)(lds + RING_BYTES));

    for (int rp_ = 0; rp_ < (REP_PHASE == 100 ? 2 : 1); ++rp_) { p0_prologue(a, lds, vcu, G, wave, lane); __syncthreads(); }
    GRID_SYNC_CG();

    {
        pg8::Gemm g{(const bf16*)(ws + WS_XN), (const bf16*)(ws + WS_WIN), nullptr, nullptr, DM};
        pg8::StaticOrder S; S.init(M, NIN, G, bx);
        pg8::EpiIn E{ws};
        for (int rp_ = 0; rp_ < (REP_PHASE == 1 ? 2 : 1); ++rp_) pg8::gemm_phase<pg8::EpiIn, pg8::StaticOrder, true, true>(lds, g, S, E);
    }
    GRID_SYNC();

    for (int u = bx; u < 64; u += G) cumsum_unit(a, u, lds);
#if NAIVE_SWA
    for (int u = bx; u < M / 32; u += G) naive_swa_unit(a, u);
#else
    for (int rp_ = 0; rp_ < (REP_PHASE == 2 ? 2 : 1); ++rp_)
    for (int u = vcu; u < 2048; u += G) { const int bh = u >> 5, qb = u & 31, b_ = bh >> 4, h_ = bh & 15;
        attn_body::attn_unit<8, false, 128>(b_, h_, qb, (const bf16*)(ws + WS_AQ), (const bf16*)(ws + WS_AK), (const bf16*)(ws + WS_AV), (bf16*)(ws + WS_OA), nullptr, a.sinks[h_] * LOG2E, (char*)lds_raw); }
#endif
    GRID_SYNC();

#if NAIVE_FOX
    for (int u = bx; u < 1024; u += G) { const int r = u >> 6, i = r >> 2, hi4 = r & 3, qblk = (i & 1) ? 4 * i + 3 - hi4 : 4 * i + hi4; naive_fox_unit(a, u & 63, qblk); }
#else
    for (int rp_ = 0; rp_ < (REP_PHASE == 3 ? 2 : 1); ++rp_)
    for (int e = vcu; e < 2048; e += G) { const int cuv = e & 255, i = e >> 8, bh = (cuv >> 3) + 32 * (i >> 2), s_ = cuv & 7, k_ = i & 3, qb = k_ == 0 ? s_ : (k_ == 1 ? 15 - s_ : (k_ == 2 ? 16 + s_ : 31 - s_));
        attn_body::attn_unit<8, true, 1024>(bh >> 4, bh & 15, qb, (const bf16*)(ws + WS_FQ), (const bf16*)(ws + WS_FK), (const bf16*)(ws + WS_FV), (bf16*)(ws + WS_OB), (const float*)(ws + WS_C) + (size_t)bh * SEQ, 0.f, (char*)lds_raw); }
#endif
    GRID_SYNC();

    {
        pg8::Gemm g{(const bf16*)(ws + WS_OA), (const bf16*)(ws + WS_WBS), (const bf16*)(ws + WS_OB), (const bf16*)(ws + WS_WBF), 1024};
        pg8::PairOrder S; S.s.init(M, DM, G, bx);
        pg8::EpiBranch E{(const unsigned char*)(ws + WS_G), (bf16*)(ws + WS_MG)};
        for (int rp_ = 0; rp_ < (REP_PHASE == 4 ? 2 : 1); ++rp_) pg8::gemm_phase<pg8::EpiBranch, pg8::PairOrder, true, true>(lds, g, S, E);
    }
    GRID_SYNC();

    {
        pg8::Gemm g{(const bf16*)(ws + WS_MG), (const bf16*)(ws + WS_WOUT), nullptr, nullptr, DM};
        pg8::StaticOrder S; S.init(M, DM, G, bx);
        pg8::EpiResB<false> E{a.x, (bf16*)(ws + WS_X1B), SS1};
        pg8::gemm_phase<pg8::EpiResB<false>, pg8::StaticOrder, true, true>(lds, g, S, E);
    }
    GRID_SYNC();

    {
        pg8::Gemm g{(const bf16*)(ws + WS_X1B), (const bf16*)(ws + WS_WUP), nullptr, nullptr, DM};
        pg8::StaticOrder S; S.init(M, DFF, G, bx);
        pg8::EpiUp E{SS1, (bf16*)(ws + WS_U)};
        for (int rp_ = 0; rp_ < (REP_PHASE == 6 ? 2 : 1); ++rp_) pg8::gemm_phase<pg8::EpiUp, pg8::StaticOrder, true, true>(lds, g, S, E);
    }
    GRID_SYNC();

    {
        pg8::Gemm g{(const bf16*)(ws + WS_U), (const bf16*)(ws + WS_WDN), nullptr, nullptr, DFF};
        pg8::StaticOrder S; S.init(M, DM, G, bx);
        pg8::EpiResB<true> E{(const void*)(ws + WS_X1B), (bf16*)(ws + WS_X2B), SS2};
        pg8::gemm_phase<pg8::EpiResB<true>, pg8::StaticOrder, true, true>(lds, g, S, E);
    }
    GRID_SYNC();

    {
        const int gw = vcu * NWAVES + wave, NGW = G * NWAVES;
        for (int m = gw; m < M; m += NGW) {
            const float rstd = __builtin_amdgcn_rsqf(SS2[m] * (1.f / DM) + RMS_EPS);
            f32x4* xr = (f32x4*)(a.out + (size_t)m * DM) + lane; const f32x4* gr = (const f32x4*)a.final_norm + lane; const v2u* br = (const v2u*)((const bf16*)(ws + WS_X2B) + (size_t)m * DM) + lane;
            v2u w[8];
#pragma unroll
            for (int j = 0; j < 8; ++j) w[j] = __builtin_nontemporal_load(br + 64 * j);
#pragma unroll
            for (int j = 0; j < 8; ++j) { const f32x4 g = gr[64 * j]; const f32x4 v = (f32x4){pg8::bf_lo(w[j].x), pg8::bf_hi(w[j].x), pg8::bf_lo(w[j].y), pg8::bf_hi(w[j].y)}; __builtin_nontemporal_store(v * rstd * g, xr + 64 * j); }
        }
    }
}

extern "C" void kernel_launch(void* const* d_in, const int* in_sizes, int n_in, void* d_out, int out_size, void* d_ws, size_t ws_size, hipStream_t stream) {
    static int grid = 0; static int fused_final = 0;
    if (grid == 0) {
        if (n_in != 13 || in_sizes[0] != M * DM || out_size != M * DM || ws_size < WS_END) { fprintf(stderr, "kernel_launch: unexpected shapes (n_in %d, in0 %d, out %d, ws %zu)\n", n_in, n_in > 0 ? in_sizes[0] : -1, out_size, ws_size); grid = -1; return; }
        int dev = 0, cus = 0, per_cu = 0;
        if (hipGetDevice(&dev) != hipSuccess || hipDeviceGetAttribute(&cus, hipDeviceAttributeMultiprocessorCount, dev) != hipSuccess) { grid = -1; return; }
        if (hipFuncSetAttribute((const void*)mega_fwd, hipFuncAttributeMaxDynamicSharedMemorySize, LDS_BYTES) != hipSuccess) { fprintf(stderr, "kernel_launch: hipFuncSetAttribute failed\n"); grid = -1; return; }
        if (hipOccupancyMaxActiveBlocksPerMultiprocessor(&per_cu, (const void*)mega_fwd, NWAVES * 64, LDS_BYTES) != hipSuccess || per_cu < 1) { fprintf(stderr, "kernel_launch: occupancy query says %d\n", per_cu); per_cu = 1; }
        (void)hipGetLastError();
        grid = cus * 1;
        { pg8::StaticOrder S; S.init(M, DM, grid, 0); bool ok = (M / 256) * (DM / 256) == 4 * grid;
          for (int c = 0; c < grid && ok; ++c) { S.c = c; for (int i = 0; i < 4 && ok; i += 2) { pg8::Unit u0, u1; ok = S.next(i, u0) && S.next(i + 1, u1) && u0.pm == u1.pm && u1.pn == u0.pn + 4 && u0.pn < 4 && u0.f == 0 && u1.f == 1; } }
          fused_final = (ok && FUSED_FINAL) ? 1 : 0; if (!ok) fprintf(stderr, "kernel_launch: note: unit order does not pair tiles; using the separate final-norm pass\n"); }
    }
    if (grid < 0) return;
    (void)hipMemsetAsync((char*)d_ws + WS_CTL, 0, CTL_ZERO_BYTES, stream);
    Args a{};
    a.x = (const float*)d_in[0]; a.pos = (const int*)d_in[1]; a.attn_norm = (const float*)d_in[2]; a.w_in = (const float*)d_in[3]; a.fbias = (const float*)d_in[4]; a.sinks = (const float*)d_in[5];
    a.w_bs = (const float*)d_in[6]; a.w_bf = (const float*)d_in[7]; a.w_out = (const float*)d_in[8]; a.mlp_norm = (const float*)d_in[9]; a.w_up = (const float*)d_in[10]; a.w_dn = (const float*)d_in[11];
    a.final_norm = (const float*)d_in[12]; a.out = (float*)d_out; a.ws = (unsigned char*)d_ws; a.fused_final = fused_final;
    void* kargs[] = {&a};
    const hipError_t le = hipLaunchCooperativeKernel((const void*)mega_fwd, dim3(grid), dim3(NWAVES * 64), kargs, LDS_BYTES, stream);
    if (le != hipSuccess) fprintf(stderr, "kernel_launch: cooperative launch failed: %s (grid %d)\n", hipGetErrorString(le), grid);
}
```

```cpp
#include <hip/hip_runtime.h>
#include <hip/hip_cooperative_groups.h>
#include <cstdio>
#include <cstdint>
namespace cg = cooperative_groups;

constexpr int BATCH = 4, SEQ = 8192, DM = 2048, M = BATCH * SEQ, DFF = 8192, NIN = 8704  , DIN = 8464;
constexpr float RMS_EPS = 1e-6f;
constexpr float LOG2E = 1.4426950408889634f;
constexpr float C2 = 0.125f * 1.4426950408889634f;

constexpr size_t MiB = 1u << 20;
constexpr size_t WS_CTL = 0, CTL_ZERO_BYTES = 1 * MiB;
constexpr size_t WS_WIN = 1 * MiB, WS_WBS = 35 * MiB, WS_WBF = 39 * MiB, WS_WOUT = 43 * MiB, WS_WUP = 51 * MiB, WS_WDN = 83 * MiB;
constexpr size_t WS_CS = 115 * MiB;
constexpr size_t WS_FL = 123 * MiB, WS_C = 125 * MiB;
constexpr size_t WS_FK = 128 * MiB, WS_FV = 192 * MiB, WS_X1B = 128 * MiB;
constexpr size_t WS_XN = 256 * MiB, WS_MG = 256 * MiB;
constexpr size_t WS_AQ = 384 * MiB, WS_FQ = 448 * MiB, WS_G = 512 * MiB;
constexpr size_t WS_U = 256 * MiB;
constexpr size_t WS_AK = 768 * MiB, WS_AV = 776 * MiB, WS_OA = 784 * MiB, WS_OB = 848 * MiB, WS_END = 912 * MiB;
constexpr size_t WS_X2B = 784 * MiB;

namespace pg8 {
#define PG8_LAS __attribute__((address_space(3)))
typedef unsigned short bf16_t;
typedef short bf16x8 __attribute__((ext_vector_type(8)));
typedef float f32x4 __attribute__((ext_vector_type(4)));
typedef unsigned u32x4 __attribute__((ext_vector_type(4)));
typedef unsigned u32x2 __attribute__((ext_vector_type(2)));
constexpr int BM = 256, BK = 64, HALF = 128, HTB = HALF * BK * 2  , STAGE_BYTES = 8 * HTB, NXCD = 8, WGM = 8;

__host__ __device__ __forceinline__ int lds_byte(int r, int c) { const int st = (r >> 4) * 2 + (c >> 5), rr = r & 15, cc = c & 31, ob = rr * 64 + cc * 2; return st * 1024 + (ob ^ (((ob >> 9) & 1) << 5)); }
__host__ __device__ __forceinline__ void stage_rc(int b, int& R, int& C) { const int st = b / 1024, sb = b % 1024, swz = sb ^ (((sb >> 9) & 1) << 5); R = (st >> 1) * 16 + swz / 64; C = (st & 1) * 32 + (swz % 64) / 2; }
__host__ __device__ __forceinline__ int perm32(int rho) { const int n = rho >> 4, i = rho & 15; return 8 * (i >> 2) + 4 * n + (i & 3); }

struct Unit { int pm, pn, z, f; };
struct Gemm { const bf16_t* A0; const bf16_t* B0; const bf16_t* A1; const bf16_t* B1; int K; };

struct StaticOrder {
    int nM, nN, nwg, G, c;
    __host__ __device__ void init(int M_, int N_, int G_, int c_) { nM = M_ / BM; nN = N_ / BM; nwg = nM * nN; G = G_; c = c_; }
    __host__ __device__ bool next(int i, Unit& u) const {
        const long L = (long)i * G + c; if (L >= nwg) return false;
        int wgid = (int)L; { const int q = nwg / NXCD, r = nwg % NXCD, xcd = wgid % NXCD, off = wgid / NXCD; wgid = (xcd < r ? xcd * (q + 1) : r * (q + 1) + (xcd - r) * q) + off; }
        const int nig = WGM * nN, gid = wgid / nig, fm = gid * WGM, gsz = (nM - fm) < WGM ? (nM - fm) : WGM;
        u.pm = fm + ((wgid % nig) % gsz); u.pn = (wgid % nig) / gsz; u.z = 0; u.f = i & 1; return true;
    }
};
struct PairOrder {
    StaticOrder s;
    __host__ __device__ bool next(int i, Unit& u) const { const bool ok = s.next(i >> 1, u); u.z = i & 1; return ok; }
};

__device__ __forceinline__ unsigned cvt_pk_bf16(float lo, float hi) { unsigned r; asm("v_cvt_pk_bf16_f32 %0, %1, %2" : "=v"(r) : "v"(lo), "v"(hi)); return r; }
__device__ __forceinline__ float bf_lo(unsigned w) { return __uint_as_float(w << 16); }
__device__ __forceinline__ float bf_hi(unsigned w) { return __uint_as_float(w & 0xffff0000u); }
__device__ __forceinline__ float sigmoidf_(float x) { return __builtin_amdgcn_rcpf(1.0f + __builtin_amdgcn_exp2f(-x * LOG2E)); }


struct EpiIn {
    static constexpr bool PERM = true;
    unsigned char* ws;
    __device__ __forceinline__ bool keep(const Unit&) const { return false; }
    __device__ __forceinline__ void operator()(f32x4 (&acc)[2][2][4][2], const Unit& u, int wr, int wc, int fr, int fq) const {
        const int pn = u.pn; const int row0 = u.pm * BM + wr * 64 + fr;
        if (pn <= 16) {
            size_t doff; int pitch, colbase; bool rope = false;
            if (pn < 4) { doff = WS_AQ; pitch = 1024; colbase = (4 * pn + wc) * 64; rope = true; }
            else if (pn == 4) { if (wc < 2) { doff = WS_AK; pitch = 128; colbase = wc * 64; rope = true; } else { doff = WS_AV; pitch = 128; colbase = (wc - 2) * 64; } }
            else { const int t = pn - 5, seg = t >> 2, tin = t & 3; doff = WS_FQ; if (seg == 1) doff = WS_FK; if (seg == 2) doff = WS_FV; pitch = 1024; colbase = (4 * tin + wc) * 64; }
            bf16_t* dst = (bf16_t*)(ws + doff); const float* cs = (const float*)(ws + WS_CS);
#pragma unroll
            for (int ai = 0; ai < 2; ++ai) {
                f32x4 cc[4][4];
                if (rope) {
#pragma unroll
                    for (int m = 0; m < 4; ++m) { const float* cp = cs + (size_t)(row0 + ai * HALF + m * 16) * 32 + 8 * fq; const float* sp = cp + (size_t)M * 32;
                        cc[m][0] = *(const f32x4*)cp; cc[m][1] = *(const f32x4*)(cp + 4); cc[m][2] = *(const f32x4*)sp; cc[m][3] = *(const f32x4*)(sp + 4); }
                    asm volatile("" ::: "memory");
                }
#pragma unroll
                for (int m = 0; m < 4; ++m) {
                    const int row = row0 + ai * HALF + m * 16;
                    f32x4 v00 = acc[ai][0][m][0], v01 = acc[ai][0][m][1], v10 = acc[ai][1][m][0], v11 = acc[ai][1][m][1];
                    if (rope) {
                        const f32x4 c0 = cc[m][0], c1 = cc[m][1], s0 = cc[m][2], s1 = cc[m][3];
                        const f32x4 o00 = v00 * c0 - v10 * s0, o10 = v10 * c0 + v00 * s0, o01 = v01 * c1 - v11 * s1, o11 = v11 * c1 + v01 * s1;
                        v00 = o00; v10 = o10; v01 = o01; v11 = o11;
                    }
                    bf16_t* rp = dst + (size_t)row * pitch + colbase + 8 * fq;
                    u32x4 w0, w1;
                    w0.x = cvt_pk_bf16(v00[0], v00[1]); w0.y = cvt_pk_bf16(v00[2], v00[3]); w0.z = cvt_pk_bf16(v01[0], v01[1]); w0.w = cvt_pk_bf16(v01[2], v01[3]);
                    w1.x = cvt_pk_bf16(v10[0], v10[1]); w1.y = cvt_pk_bf16(v10[2], v10[3]); w1.z = cvt_pk_bf16(v11[0], v11[1]); w1.w = cvt_pk_bf16(v11[2], v11[3]);
                    *(u32x4*)rp = w0; *(u32x4*)(rp + 32) = w1;
                }
                asm volatile("" ::: "memory");
            }
        } else if (pn <= 32) {
            const int col0 = (pn - 17) * BM + wc * 32 + 8 * fq;
#pragma unroll
            for (int ai = 0; ai < 2; ++ai)
#pragma unroll
                for (int m = 0; m < 4; ++m) {
                    unsigned char* rp = ws + WS_G + (size_t)(row0 + ai * HALF + m * 16) * 4096 + col0;
#pragma unroll
                    for (int bj = 0; bj < 2; ++bj) {
                        const f32x4 a = acc[ai][bj][m][0], b = acc[ai][bj][m][1]; u32x2 w; w.x = 0u; w.y = 0u;
#pragma unroll
                        for (int i = 0; i < 4; ++i) {
                            const float qa = __builtin_amdgcn_rcpf(__builtin_fmaf(__builtin_amdgcn_exp2f(a[i]), 1.0f / 255.0f, 1.0f / 255.0f)), qb = __builtin_amdgcn_rcpf(__builtin_fmaf(__builtin_amdgcn_exp2f(b[i]), 1.0f / 255.0f, 1.0f / 255.0f));
                            w.x = __builtin_amdgcn_cvt_pk_u8_f32(fmaxf(qa, 1.0f), i, w.x); w.y = __builtin_amdgcn_cvt_pk_u8_f32(fmaxf(qb, 1.0f), i, w.y); }
                        *(u32x2*)(rp + bj * HALF) = w;
                    }
                }
        } else {
            if (wc == 0 && fq < 2) {
#pragma unroll
                for (int ai = 0; ai < 2; ++ai)
#pragma unroll
                    for (int m = 0; m < 4; ++m) {
                        float* rp = (float*)(ws + WS_FL) + (size_t)(row0 + ai * HALF + m * 16) * 16 + 8 * fq;
                        *(f32x4*)rp = acc[ai][0][m][0]; *(f32x4*)(rp + 4) = acc[ai][0][m][1];
                    }
            }
        }
    }
};

struct EpiBranch {
    static constexpr bool PERM = true;
    const unsigned char* G; bf16_t* MG;
    __device__ __forceinline__ bool keep(const Unit& u) const { return u.z == 0; }
    __device__ __forceinline__ void operator()(f32x4 (&acc)[2][2][4][2], const Unit& u, int wr, int wc, int fr, int fq) const {
        const int row0 = u.pm * BM + wr * 64 + fr, col0 = u.pn * BM + wc * 32 + 8 * fq; const int z = u.z;
#pragma unroll
        for (int ai = 0; ai < 2; ++ai) {
            u32x2 gbv[4][2], gav[4][2];
#pragma unroll
            for (int m = 0; m < 4; ++m)
#pragma unroll
                for (int bj = 0; bj < 2; ++bj) { const unsigned char* gp = G + (size_t)(row0 + ai * HALF + m * 16) * 4096 + col0 + bj * HALF;
                    gbv[m][bj] = *(const u32x2*)(gp + 2048); if (z == 0) gav[m][bj] = *(const u32x2*)gp; }
            asm volatile("" ::: "memory");
#pragma unroll
            for (int m = 0; m < 4; ++m) {
                const size_t row = (size_t)(row0 + ai * HALF + m * 16);
#pragma unroll
                for (int bj = 0; bj < 2; ++bj) {
                    const u32x2 gb = gbv[m][bj];
                    float sb[8];
#pragma unroll
                    for (int i = 0; i < 4; ++i) { sb[i] = (float)((gb.x >> (8 * i)) & 0xffu); sb[4 + i] = (float)((gb.y >> (8 * i)) & 0xffu); }
                    if (z == 0) {
                        const u32x2 ga = gav[m][bj];
#pragma unroll
                        for (int i = 0; i < 4; ++i) {
                            acc[ai][bj][m][0][i] *= (float)((ga.x >> (8 * i)) & 0xffu) * __builtin_amdgcn_rcpf(sb[i]);
                            acc[ai][bj][m][1][i] *= (float)((ga.y >> (8 * i)) & 0xffu) * __builtin_amdgcn_rcpf(sb[4 + i]);
                        }
                    } else {
#pragma unroll
                        for (int i = 0; i < 8; ++i) sb[i] *= (1.0f / 255.0f);
                        const f32x4 a = acc[ai][bj][m][0], b = acc[ai][bj][m][1]; u32x4 w;
                        w.x = cvt_pk_bf16(a[0] * sb[0], a[1] * sb[1]); w.y = cvt_pk_bf16(a[2] * sb[2], a[3] * sb[3]);
                        w.z = cvt_pk_bf16(b[0] * sb[4], b[1] * sb[5]); w.w = cvt_pk_bf16(b[2] * sb[6], b[3] * sb[7]);
                        *(u32x4*)(MG + row * 2048 + col0 + bj * HALF) = w;
                    }
                }
            }
            asm volatile("" ::: "memory");
        }
    }
};

template <bool WRITE_BF> struct EpiRes {
    static constexpr bool PERM = false;
    const float* base; float* out; bf16_t* xb; float* ss;
    __device__ __forceinline__ bool keep(const Unit&) const { return false; }
    __device__ __forceinline__ void operator()(f32x4 (&acc)[2][2][4][2], const Unit& u, int wr, int wc, int fr, int fq) const {
        const int row0 = u.pm * BM + wr * 64 + fr, col0 = u.pn * BM + wc * 32 + 4 * fq;
#pragma unroll
        for (int ai = 0; ai < 2; ++ai) {
            f32x4 pre[4][2][2];
#pragma unroll
            for (int m = 0; m < 4; ++m)
#pragma unroll
                for (int bj = 0; bj < 2; ++bj)
#pragma unroll
                    for (int n = 0; n < 2; ++n) pre[m][bj][n] = *(const f32x4*)(base + (size_t)(row0 + ai * HALF + m * 16) * DM + col0 + bj * HALF + n * 16);
            asm volatile("" ::: "memory");
#pragma unroll
            for (int m = 0; m < 4; ++m) {
                const size_t row = (size_t)(row0 + ai * HALF + m * 16); const size_t off = row * DM + col0; float q = 0.f;
#pragma unroll
                for (int bj = 0; bj < 2; ++bj)
#pragma unroll
                    for (int n = 0; n < 2; ++n) {
                        const size_t o = off + bj * HALF + n * 16;
                        const f32x4 v = pre[m][bj][n] + acc[ai][bj][m][n];
                        *(f32x4*)(out + o) = v; q += (v[0] * v[0] + v[1] * v[1]) + (v[2] * v[2] + v[3] * v[3]);
                        if (WRITE_BF) { u32x2 w; w.x = cvt_pk_bf16(v[0], v[1]); w.y = cvt_pk_bf16(v[2], v[3]); *(u32x2*)(xb + o) = w; }
                    }
                q += __shfl_xor(q, 16); q += __shfl_xor(q, 32);
                if (fq == 0) atomicAdd(ss + row, q);
            }
            asm volatile("" ::: "memory");
        }
    }
};

struct EpiFinal {
    static constexpr bool PERM = false;
    float* out; float* ss; unsigned* cnt; const float* gain;
    __device__ __forceinline__ bool keep(const Unit&) const { return false; }
    __device__ __forceinline__ void operator()(f32x4 (&acc)[2][2][4][2], const Unit& u, int wr, int wc, int fr, int fq) const {
        const int row0 = u.pm * BM + wr * 64 + fr, col0 = u.pn * BM + wc * 32 + 4 * fq; const bool second = u.f != 0;
#pragma unroll
        for (int ai = 0; ai < 2; ++ai) {
            f32x4 pre[4][2][2];
#pragma unroll
            for (int m = 0; m < 4; ++m)
#pragma unroll
                for (int bj = 0; bj < 2; ++bj)
#pragma unroll
                    for (int n = 0; n < 2; ++n) pre[m][bj][n] = *(const f32x4*)(out + (size_t)(row0 + ai * HALF + m * 16) * DM + col0 + bj * HALF + n * 16);
            asm volatile("" ::: "memory");
#pragma unroll
            for (int m = 0; m < 4; ++m) {
                const size_t row = (size_t)(row0 + ai * HALF + m * 16); const size_t off = row * DM + col0; float q = 0.f;
#pragma unroll
                for (int bj = 0; bj < 2; ++bj)
#pragma unroll
                    for (int n = 0; n < 2; ++n) {
                        const f32x4 v = pre[m][bj][n] + acc[ai][bj][m][n]; acc[ai][bj][m][n] = v;
                        q += (v[0] * v[0] + v[1] * v[1]) + (v[2] * v[2] + v[3] * v[3]);
                        if (!second) *(f32x4*)(out + off + bj * HALF + n * 16) = v;
                    }
                q += __shfl_xor(q, 16); q += __shfl_xor(q, 32);
                if (fq == 0) atomicAdd(ss + row, q);
            }
            asm volatile("" ::: "memory");
        }
        asm volatile("s_waitcnt vmcnt(0)" ::: "memory");
        unsigned* pc = cnt + 16 * u.pm;
        if ((threadIdx.x & 63) == 0) __hip_atomic_fetch_add(pc, 1u, __ATOMIC_RELAXED, __HIP_MEMORY_SCOPE_AGENT);
        if (!second) return;
        { const unsigned long long t0 = __builtin_amdgcn_s_memrealtime();
          while ((unsigned)__builtin_amdgcn_readfirstlane(__hip_atomic_load(pc, __ATOMIC_RELAXED, __HIP_MEMORY_SCOPE_AGENT)) < 64u) {
              if (__builtin_amdgcn_s_memrealtime() - t0 > 2000000ull) break;
              __builtin_amdgcn_s_sleep(4); }
          asm volatile("" ::: "memory"); }
#pragma unroll
        for (int ai = 0; ai < 2; ++ai)
#pragma unroll
            for (int m = 0; m < 4; ++m) {
                const size_t row = (size_t)(row0 + ai * HALF + m * 16); const size_t off = row * DM + col0;
                const float rstd = __builtin_amdgcn_rsqf(__hip_atomic_load(ss + row, __ATOMIC_RELAXED, __HIP_MEMORY_SCOPE_AGENT) * (1.0f / DM) + RMS_EPS);
#pragma unroll
                for (int bj = 0; bj < 2; ++bj)
#pragma unroll
                    for (int n = 0; n < 2; ++n) {
                        const size_t o = off + bj * HALF + n * 16; const int c = col0 + bj * HALF + n * 16;
                        const f32x4 gB = *(const f32x4*)(gain + c), gA = *(const f32x4*)(gain + c - 1024), vA = *(const f32x4*)(out + o - 1024);
                        *(f32x4*)(out + o) = acc[ai][bj][m][n] * rstd * gB;
                        *(f32x4*)(out + o - 1024) = vA * rstd * gA;
                    }
            }
    }
};

template <bool BASE_BF> struct EpiResB {
    static constexpr bool PERM = true;
    const void* base; bf16_t* yb; float* ss;
    __device__ __forceinline__ bool keep(const Unit&) const { return false; }
    __device__ __forceinline__ void operator()(f32x4 (&acc)[2][2][4][2], const Unit& u, int wr, int wc, int fr, int fq) const {
        const int row0 = u.pm * BM + wr * 64 + fr, col0 = u.pn * BM + wc * 32 + 8 * fq;
#pragma unroll
        for (int ai = 0; ai < 2; ++ai) {
            f32x4 pf[4][2][2]; u32x4 pb[4][2];
#pragma unroll
            for (int m = 0; m < 4; ++m)
#pragma unroll
                for (int bj = 0; bj < 2; ++bj) { const size_t o = (size_t)(row0 + ai * HALF + m * 16) * DM + col0 + bj * HALF;
                    if (BASE_BF) pb[m][bj] = *(const u32x4*)((const bf16_t*)base + o);
                    else { pf[m][bj][0] = *(const f32x4*)((const float*)base + o); pf[m][bj][1] = *(const f32x4*)((const float*)base + o + 4); } }
            asm volatile("" ::: "memory");
#pragma unroll
            for (int m = 0; m < 4; ++m) {
                const size_t row = (size_t)(row0 + ai * HALF + m * 16); float q = 0.f;
#pragma unroll
                for (int bj = 0; bj < 2; ++bj) {
                    f32x4 x0, x1;
                    if (BASE_BF) { const u32x4 w = pb[m][bj]; x0 = (f32x4){bf_lo(w.x), bf_hi(w.x), bf_lo(w.y), bf_hi(w.y)}; x1 = (f32x4){bf_lo(w.z), bf_hi(w.z), bf_lo(w.w), bf_hi(w.w)}; }
                    else { x0 = pf[m][bj][0]; x1 = pf[m][bj][1]; }
                    const f32x4 v0 = x0 + acc[ai][bj][m][0], v1 = x1 + acc[ai][bj][m][1];
                    q += ((v0[0] * v0[0] + v0[1] * v0[1]) + (v0[2] * v0[2] + v0[3] * v0[3])) + ((v1[0] * v1[0] + v1[1] * v1[1]) + (v1[2] * v1[2] + v1[3] * v1[3]));
                    u32x4 w; w.x = cvt_pk_bf16(v0[0], v0[1]); w.y = cvt_pk_bf16(v0[2], v0[3]); w.z = cvt_pk_bf16(v1[0], v1[1]); w.w = cvt_pk_bf16(v1[2], v1[3]);
                    *(u32x4*)(yb + row * DM + col0 + bj * HALF) = w;
                }
                q += __shfl_xor(q, 16); q += __shfl_xor(q, 32);
                if (fq == 0) atomicAdd(ss + row, q);
            }
            asm volatile("" ::: "memory");
        }
    }
};

struct EpiUp {
    static constexpr bool PERM = true;
    const float* ss; bf16_t* U;
    __device__ __forceinline__ bool keep(const Unit&) const { return false; }
    __device__ __forceinline__ void operator()(f32x4 (&acc)[2][2][4][2], const Unit& u, int wr, int wc, int fr, int fq) const {
        const int row0 = u.pm * BM + wr * 64 + fr, col0 = u.pn * BM + wc * 32 + 8 * fq;
        float rs[2][4];
#pragma unroll
        for (int ai = 0; ai < 2; ++ai)
#pragma unroll
            for (int m = 0; m < 4; ++m) rs[ai][m] = ss[row0 + ai * HALF + m * 16];
        asm volatile("" ::: "memory");
#pragma unroll
        for (int ai = 0; ai < 2; ++ai)
#pragma unroll
            for (int m = 0; m < 4; ++m) {
                const size_t row = (size_t)(row0 + ai * HALF + m * 16);
                const float rstd = __builtin_amdgcn_rsqf(rs[ai][m] * (1.0f / DM) + RMS_EPS);
#pragma unroll
                for (int bj = 0; bj < 2; ++bj) {
                    f32x4 a = acc[ai][bj][m][0] * rstd, b = acc[ai][bj][m][1] * rstd; u32x4 w;
#pragma unroll
                    for (int i = 0; i < 4; ++i) { a[i] = fmaxf(a[i], 0.f); a[i] *= a[i]; b[i] = fmaxf(b[i], 0.f); b[i] *= b[i]; }
                    w.x = cvt_pk_bf16(a[0], a[1]); w.y = cvt_pk_bf16(a[2], a[3]); w.z = cvt_pk_bf16(b[0], b[1]); w.w = cvt_pk_bf16(b[2], b[3]);
                    *(u32x4*)(U + row * DFF + col0 + bj * HALF) = w;
                }
            }
    }
};

template <class Epi, class Sched, bool ALIGN_EPI = false, bool SP2 = false>
__device__ __forceinline__ void gemm_phase(PG8_LAS unsigned char* lds, const Gemm g, const Sched& S, const Epi& E) {
    int tid_ = threadIdx.x; asm volatile("" : "+v"(tid_));
    const int tid = tid_, wid = __builtin_amdgcn_readfirstlane(tid >> 6), lane = tid & 63, wr = wid >> 2, wc = wid & 3, fr = lane & 15, fq = lane >> 4;
    const int K = g.K, nt = K / BK;
    unsigned voffA[2], voffB[2];
#pragma unroll
    for (int i = 0; i < 2; ++i) { int R, C; stage_rc(tid * 16 + i * 8192, R, C); const int Rb = Epi::PERM ? ((R & ~31) + perm32(R & 31)) : R;
        voffA[i] = (unsigned)(R * K + C) * 2u; voffB[i] = (unsigned)(Rb * K + C) * 2u; }
    const size_t kstep = (size_t)(BK * 2);
    const size_t hstep = (size_t)HALF * K * 2;
    const size_t tstep = 2 * hstep;
    const unsigned ldsw = (unsigned)wid * 1024u;
    const int aoff = lds_byte(wr * 64 + fr, fq * 8), boff = lds_byte(wc * 32 + fr, fq * 8);
#define PG8_SA(b, h) (((b) * 2 + (h)) * HTB)
#define PG8_SB(b, h) ((4 + (b) * 2 + (h)) * HTB)
#define PG8_STAGE(bufoff, gbase, voff) do { _Pragma("unroll") for (int _i = 0; _i < 2; ++_i) \
        __builtin_amdgcn_global_load_lds((const unsigned*)((const char*)(gbase) + (voff)[_i]), (PG8_LAS unsigned*)(lds + (bufoff) + ldsw + _i * 8192), 16, 0, 0); } while (0)
#define PG8_LDA(dst, b, h) do { _Pragma("unroll") for (int m = 0; m < 4; ++m) _Pragma("unroll") for (int k = 0; k < 2; ++k) dst[m][k] = *(const PG8_LAS bf16x8*)(lds + PG8_SA(b, h) + aoff + m * 2048 + k * 1024); } while (0)
#define PG8_LDB(dst, b, h) do { _Pragma("unroll") for (int n = 0; n < 2; ++n) _Pragma("unroll") for (int k = 0; k < 2; ++k) dst[n][k] = *(const PG8_LAS bf16x8*)(lds + PG8_SB(b, h) + boff + n * 2048 + k * 1024); } while (0)
#define PG8_MMA(ai, bj, At, Bt) do { __builtin_amdgcn_s_setprio(1); _Pragma("unroll") for (int m = 0; m < 4; ++m) _Pragma("unroll") for (int n = 0; n < 2; ++n) _Pragma("unroll") for (int k = 0; k < 2; ++k) \
        acc[ai][bj][m][n] = __builtin_amdgcn_mfma_f32_16x16x32_bf16(Bt[n][k], At[m][k], acc[ai][bj][m][n], 0, 0, 0); __builtin_amdgcn_s_setprio(0); } while (0)
#define PG8_WAIT_V(n) asm volatile("s_waitcnt vmcnt(" #n ")" ::: "memory")
#define PG8_WAIT_L(n) asm volatile("s_waitcnt lgkmcnt(" #n ")" ::: "memory")
#define PG8_BAR __builtin_amdgcn_s_barrier()
#define PG8_SCHED __builtin_amdgcn_sched_barrier(0)
    Unit cur, nxt; int ui = 0;
    if (!S.next(0, cur)) return;
    f32x4 acc[2][2][4][2];
#pragma unroll
    for (int a = 0; a < 2; ++a)
#pragma unroll
        for (int b = 0; b < 2; ++b)
#pragma unroll
            for (int m = 0; m < 4; ++m)
#pragma unroll
                for (int n = 0; n < 2; ++n) acc[a][b][m][n] = (f32x4){0.f, 0.f, 0.f, 0.f};
    bf16x8 At[4][2], B0[2][2], B1[2][2];
    const char* cA = (const char*)(cur.z ? g.A1 : g.A0) + (size_t)cur.pm * tstep; const char* cB = (const char*)(cur.z ? g.B1 : g.B0) + (size_t)cur.pn * tstep;
    if constexpr (SP2) {
        PG8_STAGE(PG8_SB(0, 0), cB, voffB); PG8_STAGE(PG8_SB(0, 1), cB + hstep, voffB); PG8_STAGE(PG8_SA(0, 0), cA, voffA); PG8_STAGE(PG8_SA(0, 1), cA + hstep, voffA);
        if (wr == 1) PG8_BAR;
        PG8_WAIT_V(2); PG8_BAR;
        PG8_STAGE(PG8_SB(1, 0), cB + kstep, voffB); PG8_STAGE(PG8_SA(1, 0), cA + kstep, voffA); PG8_STAGE(PG8_SB(1, 1), cB + hstep + kstep, voffB);
        PG8_WAIT_V(6); PG8_BAR;
    } else {
        PG8_STAGE(PG8_SB(0, 0), cB, voffB); PG8_STAGE(PG8_SA(0, 0), cA, voffA); PG8_STAGE(PG8_SB(0, 1), cB + hstep, voffB); PG8_STAGE(PG8_SA(0, 1), cA + hstep, voffA);
        if (wr == 1) PG8_BAR;
        PG8_WAIT_V(4); PG8_BAR;
        PG8_STAGE(PG8_SB(1, 0), cB + kstep, voffB); PG8_STAGE(PG8_SA(1, 0), cA + kstep, voffA); PG8_STAGE(PG8_SB(1, 1), cB + hstep + kstep, voffB);
        PG8_WAIT_V(6); PG8_BAR;
    }
    for (;;) {
        const bool has_next = S.next(ui + 1, nxt);
        const char* nA = has_next ? (const char*)(nxt.z ? g.A1 : g.A0) + (size_t)nxt.pm * tstep : cA; const char* nB = has_next ? (const char*)(nxt.z ? g.B1 : g.B0) + (size_t)nxt.pn * tstep : cB;
        for (int t = 0; t < nt; t += 2) {
            const bool last = (t == nt - 2);
            const char* a1 = cA + (size_t)(t + 1) * kstep;
            const char* a2 = last ? nA : cA + (size_t)(t + 2) * kstep; const char* b2 = last ? nB : cB + (size_t)(t + 2) * kstep;
            const char* a3 = a2 + kstep; const char* b3 = b2 + kstep;
            if constexpr (SP2) {
            PG8_LDB(B0, 0, 0); PG8_LDB(B1, 0, 1); PG8_SCHED; PG8_LDA(At, 0, 0); PG8_STAGE(PG8_SA(1, 1), a1 + hstep, voffA);
            PG8_WAIT_V(8); PG8_WAIT_L(0); PG8_BAR; PG8_MMA(0, 0, At, B0); PG8_MMA(0, 1, At, B1); PG8_BAR; PG8_SCHED;
            PG8_LDA(At, 0, 1); PG8_STAGE(PG8_SB(0, 0), b2, voffB); PG8_STAGE(PG8_SB(0, 1), b2 + hstep, voffB); PG8_STAGE(PG8_SA(0, 0), a2, voffA);
            PG8_WAIT_V(8); PG8_WAIT_L(0); PG8_BAR; PG8_MMA(1, 0, At, B0); PG8_MMA(1, 1, At, B1); PG8_BAR; PG8_SCHED;
            PG8_LDB(B0, 1, 0); PG8_LDB(B1, 1, 1); PG8_SCHED; PG8_LDA(At, 1, 0); PG8_STAGE(PG8_SA(0, 1), a2 + hstep, voffA);
            PG8_WAIT_V(8); PG8_WAIT_L(0); PG8_BAR; PG8_MMA(0, 0, At, B0); PG8_MMA(0, 1, At, B1); PG8_BAR; PG8_SCHED;
            PG8_LDA(At, 1, 1); PG8_STAGE(PG8_SB(1, 0), b3, voffB); PG8_STAGE(PG8_SB(1, 1), b3 + hstep, voffB); PG8_STAGE(PG8_SA(1, 0), a3, voffA);
            PG8_WAIT_V(8); PG8_WAIT_L(0); PG8_BAR; PG8_MMA(1, 0, At, B0); PG8_MMA(1, 1, At, B1); PG8_BAR; PG8_SCHED;
            } else {
            PG8_LDB(B0, 0, 0); PG8_SCHED; PG8_LDA(At, 0, 0); PG8_STAGE(PG8_SA(1, 1), a1 + hstep, voffA);
            PG8_WAIT_L(8); PG8_BAR; PG8_WAIT_L(0); PG8_MMA(0, 0, At, B0); PG8_BAR; PG8_SCHED;
            PG8_LDB(B1, 0, 1); PG8_STAGE(PG8_SB(0, 0), b2, voffB);
            PG8_BAR; PG8_WAIT_L(0); PG8_MMA(0, 1, At, B1); PG8_BAR;
            PG8_LDA(At, 0, 1); PG8_STAGE(PG8_SA(0, 0), a2, voffA);
            PG8_BAR; PG8_WAIT_L(0); PG8_MMA(1, 0, At, B0); PG8_BAR; PG8_SCHED;
            PG8_STAGE(PG8_SB(0, 1), b2 + hstep, voffB);
            PG8_WAIT_V(6); PG8_BAR; PG8_MMA(1, 1, At, B1); PG8_BAR;
            PG8_LDB(B0, 1, 0); PG8_SCHED; PG8_LDA(At, 1, 0); PG8_STAGE(PG8_SA(0, 1), a2 + hstep, voffA);
            PG8_WAIT_L(8); PG8_BAR; PG8_WAIT_L(0); PG8_MMA(0, 0, At, B0); PG8_BAR; PG8_SCHED;
            PG8_LDB(B1, 1, 1); PG8_STAGE(PG8_SB(1, 0), b3, voffB);
            PG8_BAR; PG8_WAIT_L(0); PG8_MMA(0, 1, At, B1); PG8_BAR;
            PG8_LDA(At, 1, 1); PG8_STAGE(PG8_SA(1, 0), a3, voffA);
            PG8_BAR; PG8_WAIT_L(0); PG8_MMA(1, 0, At, B0); PG8_BAR; PG8_SCHED;
            PG8_STAGE(PG8_SB(1, 1), b3 + hstep, voffB);
            PG8_WAIT_V(6); PG8_BAR; PG8_MMA(1, 1, At, B1); PG8_BAR;
            }
        }
        if constexpr (ALIGN_EPI) { if (wr == 0) PG8_BAR; }
        E(acc, cur, wr, wc, fr, fq);
        if (!has_next) break;
        if (!E.keep(cur))
#pragma unroll
        for (int a = 0; a < 2; ++a)
#pragma unroll
            for (int b = 0; b < 2; ++b)
#pragma unroll
                for (int m = 0; m < 4; ++m)
#pragma unroll
                    for (int n = 0; n < 2; ++n) acc[a][b][m][n] = (f32x4){0.f, 0.f, 0.f, 0.f};
        cur = nxt; cA = nA; cB = nB; ++ui;
        if constexpr (ALIGN_EPI) { if (wr == 1) PG8_BAR; }
    }
    PG8_WAIT_V(0);
    if constexpr (!ALIGN_EPI) { if (wr == 0) PG8_BAR; }
    PG8_BAR;
#undef PG8_SA
#undef PG8_SB
#undef PG8_STAGE
#undef PG8_LDA
#undef PG8_LDB
#undef PG8_MMA
#undef PG8_WAIT_V
#undef PG8_WAIT_L
#undef PG8_BAR
#undef PG8_SCHED
}
}


namespace attn_body {
using bf16=unsigned short;
using bf16x8=__attribute__((ext_vector_type(8)))short;
using s16x4=__attribute__((ext_vector_type(4)))short;
using f32x16=__attribute__((ext_vector_type(16)))float;
using u32x4=__attribute__((ext_vector_type(4)))unsigned;
using f32x4v=__attribute__((ext_vector_type(4)))float;
constexpr int BATCH=4,NHEAD=16,SEQ=8192,D=64,DM=NHEAD*D;
constexpr int NW=8,QBLK=32,QB=QBLK*NW,KVBLK=64,NQB=SEQ/QB;
constexpr int ATTN_PITCH=DM, ATTN_UNIT_ROWS=QB;
__device__ __forceinline__ int crow(int r,int hi){return (r&3)+8*(r>>2)+4*hi;}
#define SBAR() __builtin_amdgcn_sched_barrier(0)
template<bool SWA> __device__ __forceinline__ void cmask(f32x16&p0,f32x16&p1,int jb,int qrel,int hi){
  const float NEG=-INFINITY; int kb=64*jb+4*hi;
  #pragma unroll
  for(int r=0;r<16;++r){int kv=kb+(r&3)+8*(r>>2);
    if(SWA){ if(kv>qrel||kv<=qrel-128)p0[r]=NEG; if(kv+32>qrel||kv+32<=qrel-128)p1[r]=NEG; }
    else{ if(kv>qrel)p0[r]=NEG; if(kv+32>qrel)p1[r]=NEG; } }
}

constexpr int NSLOT=3, SLOTB=8192;
#ifndef NVB
#define NVB 8
#endif
constexpr int LDS_K=0, LDS_V=NSLOT*SLOTB, LDS_WS=2*NSLOT*SLOTB, LDS_OST=LDS_WS+NW*64*4, LDS_CB=LDS_OST+NW*4096, LDS_BYTES=LDS_CB+4*256;
constexpr float C2=0.125f*1.4426950408889634f;
__device__ __forceinline__ void glds16(const void*gsrc,unsigned lds_dst){unsigned keep;
  asm volatile("s_mov_b32 %0, m0\n\ts_mov_b32 m0, %2\n\ts_nop 0\n\tglobal_load_lds_dwordx4 %1, off\n\ts_mov_b32 m0, %0":"=&s"(keep):"v"(gsrc),"s"(lds_dst):"memory");}
__device__ __forceinline__ void glds4(const void*gsrc,unsigned lds_dst){unsigned keep;
  asm volatile("s_mov_b32 %0, m0\n\ts_mov_b32 m0, %2\n\ts_nop 0\n\tglobal_load_lds_dword %1, off\n\ts_mov_b32 m0, %0":"=&s"(keep):"v"(gsrc),"s"(lds_dst):"memory");}
__device__ __forceinline__ float max3f(float a,float b,float c){float r;asm("v_max3_f32 %0, %1, %2, %3":"=v"(r):"v"(a),"v"(b),"v"(c));return r;}
__device__ __forceinline__ float max2f(float a,float b){float r;asm("v_max_f32_e32 %0, %1, %2":"=v"(r):"v"(a),"v"(b));return r;}
__device__ __forceinline__ float fadd_s(float a,float b){float r;asm("v_add_f32_e32 %0, %1, %2":"=v"(r):"v"(a),"v"(b));return r;}
__device__ __forceinline__ float fsub_s(float a,float b){float r;asm("v_sub_f32_e32 %0, %1, %2":"=v"(r):"v"(a),"v"(b));return r;}
typedef float f32x2_t __attribute__((ext_vector_type(2))); typedef __bf16 bf16x2_t __attribute__((ext_vector_type(2)));
__device__ __forceinline__ unsigned cvtpk_s(float lo,float hi){f32x2_t v={lo,hi};bf16x2_t b=__builtin_convertvector(v,bf16x2_t);return __builtin_bit_cast(unsigned,b);}
#define WAIT_BAR(N) asm volatile("s_waitcnt vmcnt(" #N ") lgkmcnt(0)\n\ts_barrier":::"memory")

__device__ __forceinline__ void qkt(f32x16&p0,f32x16&p1,const char*Kslot,const bf16x8*qr,int r32,int hi){
  const char*kb=Kslot+hi*1024+r32*16;
  #pragma unroll
  for(int d0=0;d0<4;++d0){
    const bf16x8 b0=*reinterpret_cast<const bf16x8*>(kb+d0*2048);
    const bf16x8 b1=*reinterpret_cast<const bf16x8*>(kb+d0*2048+512);
    {p0=__builtin_amdgcn_mfma_f32_32x32x16_bf16(b0,qr[d0],p0,0,0,0);p1=__builtin_amdgcn_mfma_f32_32x32x16_bf16(b1,qr[d0],p1,0,0,0);}}
}
typedef __attribute__((address_space(3))) const char* lds_cptr;
typedef short v4i16_t __attribute__((ext_vector_type(4)));
__device__ __forceinline__ void kload8(bf16x8*kf,lds_cptr kp){
  kf[0]=*(const __attribute__((address_space(3))) bf16x8*)(kp);      kf[1]=*(const __attribute__((address_space(3))) bf16x8*)(kp+512);
  kf[2]=*(const __attribute__((address_space(3))) bf16x8*)(kp+2048); kf[3]=*(const __attribute__((address_space(3))) bf16x8*)(kp+2560);
  kf[4]=*(const __attribute__((address_space(3))) bf16x8*)(kp+4096); kf[5]=*(const __attribute__((address_space(3))) bf16x8*)(kp+4608);
  kf[6]=*(const __attribute__((address_space(3))) bf16x8*)(kp+6144); kf[7]=*(const __attribute__((address_space(3))) bf16x8*)(kp+6656);
}
__device__ __forceinline__ void kload2(bf16x8*kf,lds_cptr kp,int j){ kf[2*j]=*(const __attribute__((address_space(3))) bf16x8*)(kp+j*2048); kf[2*j+1]=*(const __attribute__((address_space(3))) bf16x8*)(kp+j*2048+512); }
__device__ __forceinline__ s16x4 vtr(lds_cptr p){ return __builtin_bit_cast(s16x4,__builtin_amdgcn_ds_read_tr16_b64_v4i16((__attribute__((address_space(3))) v4i16_t*)p)); }
__device__ __forceinline__ float rowmax(const f32x16&p0,const f32x16&p1){
  float a=max3f(p0[0],p0[1],p1[0]),b=max3f(p0[2],p0[3],p1[1]);a=max3f(a,p1[2],p1[3]);
  #pragma unroll
  for(int r=4;r<16;r+=4){a=max3f(a,p0[r],p0[r+1]);b=max3f(b,p0[r+2],p0[r+3]);a=max3f(a,p1[r],p1[r+1]);b=max3f(b,p1[r+2],p1[r+3]);}
  const float m=max2f(a,b);
  auto rr=__builtin_amdgcn_permlane32_swap(__float_as_uint(m),__float_as_uint(m),false,false);
  return max2f(__uint_as_float(rr[0]),__uint_as_float(rr[1]));
}
__device__ __forceinline__ void pv(f32x16*o,int vb,bf16x8 pa0,bf16x8 pa1,bf16x8 pa2,bf16x8 pa3){
  #pragma unroll
  for(int d0=0;d0<2;++d0){s16x4 lo[4],hi[4];
    #pragma unroll
    for(int ks=0;ks<4;++ks){
      asm volatile("ds_read_b64_tr_b16 %0,%1 offset:%c2":"=&v"(lo[ks]):"v"(vb),"i"(d0*4096+ks*1024):"memory");
      asm volatile("ds_read_b64_tr_b16 %0,%1 offset:%c2":"=&v"(hi[ks]):"v"(vb),"i"(d0*4096+ks*1024+512):"memory");}
    asm volatile("s_waitcnt lgkmcnt(0)":::"memory");SBAR();
    #define PK(k) (bf16x8){lo[k][0],lo[k][1],lo[k][2],lo[k][3],hi[k][0],hi[k][1],hi[k][2],hi[k][3]}
    o[d0]=__builtin_amdgcn_mfma_f32_32x32x16_bf16(pa0,PK(0),o[d0],0,0,0);
    o[d0]=__builtin_amdgcn_mfma_f32_32x32x16_bf16(pa1,PK(1),o[d0],0,0,0);
    o[d0]=__builtin_amdgcn_mfma_f32_32x32x16_bf16(pa2,PK(2),o[d0],0,0,0);
    o[d0]=__builtin_amdgcn_mfma_f32_32x32x16_bf16(pa3,PK(3),o[d0],0,0,0);
    #undef PK
  }
}

typedef __attribute__((address_space(3))) const f32x4v* lds_f4ptr;
__device__ __forceinline__ void fill_bias(f32x16&c0,f32x16&c1,lds_cptr cb,float negmh){
  #pragma unroll
  for(int g=0;g<4;++g){ const f32x4v v=*(lds_f4ptr)(cb+g*32), w=*(lds_f4ptr)(cb+128+g*32);
    #pragma unroll
    for(int i=0;i<4;i+=2){ const f32x2_t nm={negmh,negmh}; const f32x2_t a=nm-(f32x2_t){v[i],v[i+1]}, b=nm-(f32x2_t){w[i],w[i+1]}; c0[4*g+i]=a.x; c0[4*g+i+1]=a.y; c1[4*g+i]=b.x; c1[4*g+i+1]=b.y; } }
}
#ifndef ATTN_STORE16
#define ATTN_STORE16(p,v) (*(u32x4*)(p)=(v))
#endif
template<int THRL,bool FOX,int KP> __device__ __forceinline__ void attn_unit(int b,int h,int qb,const bf16*Q,const bf16*__restrict__ K,const bf16*__restrict__ V,bf16*O,const float*__restrict__ Cb,float sink2,char*shm){
  int tid_=threadIdx.x; asm volatile("":"+v"(tid_));
  const int tid=tid_,lane=tid&63,r32=lane&31,hi=lane>>5; const int wid=__builtin_amdgcn_readfirstlane(tid>>6);
  const long rowbase=(long)b*SEQ; const int q0=qb*QB;
  const bf16*Qw=Q+(rowbase+q0+wid*QBLK)*DM+h*D;
  const int kvh=FOX?h:(h>>3); const int T0=FOX?0:(qb==0?0:4*qb-2);
  const bf16*Kh=K+(rowbase+(long)T0*KVBLK)*KP+kvh*D,*Vh=V+(rowbase+(long)T0*KVBLK)*KP+kvh*D; const float*Cs=FOX?Cb+lane:nullptr;
  const unsigned lds0=(unsigned)(uintptr_t)shm;
  float*wsf=(float*)(shm+LDS_WS)+wid*64;
  const bf16*ksrc=Kh+(long)lane*KP+wid*8;
  const bf16*vsrc=Vh+(long)(16*(wid&3)+(lane>>2))*KP+(wid>>2)*32+(lane&3)*8;
  const unsigned kdst=lds0+LDS_K+wid*1024, vdst=lds0+LDS_V+wid*1024;
  #define DMA_K(t,slot) glds16(ksrc+(long)(t)*KVBLK*KP,(unsigned)__builtin_amdgcn_readfirstlane(kdst+(slot)))
  #define DMA_C(t) do{ if(FOX) glds4(Cs+(long)(t)*KVBLK,(unsigned)__builtin_amdgcn_readfirstlane(lds0+LDS_CB+(((t)&3)<<8))); }while(0)
  #define PREFILL(X0,X1,t) do{ if(FOX){ fill_bias(X0,X1,cb0+(((t)&3)<<8),-mhat); } else { _Pragma("unroll") for(int r=0;r<16;++r){X0[r]=-mhat;X1[r]=-mhat;} } }while(0)
  #define DMA_V(t,slot) glds16(vsrc+(long)(t)*KVBLK*KP,(unsigned)__builtin_amdgcn_readfirstlane(vdst+(slot)))
  const int vb0=(int)(lds0+LDS_V)+((lane>>4)&1)*32+(lane&3)*8+(4*hi+((lane&15)>>2))*64;
  const char*Kbase=shm+LDS_K; bf16x8 kf[8];
  const lds_cptr shm3=(lds_cptr)shm; const lds_cptr cb0=shm3+LDS_CB+hi*16; const lds_cptr kp0=shm3+LDS_K+hi*1024+r32*16; const lds_cptr vp0=shm3+LDS_V+((lane>>4)&1)*32+(lane&3)*8+(4*hi+((lane&15)>>2))*64;
  const int NT=FOX?(q0+QB)/KVBLK:(qb==0?4:6);
  DMA_K(0,0);DMA_C(0);DMA_V(0,0);DMA_K(1,SLOTB);DMA_C(1);
  bf16x8 qr[4];
  #pragma unroll
  for(int d0=0;d0<4;++d0)qr[d0]=*reinterpret_cast<const bf16x8*>(&Qw[(long)r32*DM+d0*16+hi*8]);
  float mhat=FOX?-Cb[q0+wid*QBLK+r32]:0.f,l_reg=0.f;    f32x16 o[2];o[0]=f32x16{};o[1]=f32x16{};
  const int qrel=wid*QBLK+r32;
  #define CMASK(P0,P1,t) do{int jb_=(t)-(NT-4); if(!FOX||jb_>=0)cmask<!FOX>(P0,P1,jb_,qrel,hi);}while(0)
  bool resc=false;
  #define START(P0,P1) do{ float rm=__builtin_fmaxf(rowmax(P0,P1),0.f); resc=false;     \
    { const float dl=rm; mhat=fadd_s(mhat,dl); \
      _Pragma("unroll") for(int r=0;r<16;++r){P0[r]=fsub_s(P0[r],dl);P1[r]=fsub_s(P1[r],dl);} } \
    _Pragma("unroll") for(int r=0;r<16;++r)P0[r]=__builtin_amdgcn_exp2f(P0[r]); }while(0)
  #define RESC() do{ if(resc){ asm volatile("s_waitcnt lgkmcnt(0)":::"memory"); \
      _Pragma("unroll") for(int d_=0;d_<2;++d_) _Pragma("unroll") for(int r=0;r<16;++r)o[d_][r]*=wsf[crow(r,hi)]; } }while(0)
  f32x16 pA0,pA1,pB0,pB1;
  int sl_prev=0,sl_cur=0,sl_next=SLOTB;
  #define ROT() do{sl_prev=sl_cur;sl_cur=sl_next;sl_next=(sl_next==(NSLOT-1)*SLOTB)?0:sl_next+SLOTB;}while(0)
  DMA_K(2,2*SLOTB);DMA_C(2);
  if(FOX){WAIT_BAR(5);}else{WAIT_BAR(3);}
  PREFILL(pA0,pA1,0); qkt(pA0,pA1,Kbase,qr,r32,hi);asm volatile("s_nop 15\n\ts_nop 7":"+v"(pA0),"+v"(pA1));CMASK(pA0,pA1,0);
  START(pA0,pA1);
  _Pragma("unroll") for(int r=0;r<16;++r)pA1[r]=__builtin_amdgcn_exp2f(pA1[r]);
  WAIT_BAR(0);
  DMA_K(3,0);DMA_C(3);DMA_V(1,SLOTB);
  ROT();
  kload8(kf,kp0+sl_cur);
  PREFILL(pB0,pB1,1); if(FOX){ WAIT_BAR(3); }else{ WAIT_BAR(2); }
  s16x4 vlo[NVB],vhi[NVB]; u32x4 pw0,pw1,pw2,pw3;
  #define PKW(P,B) cvtpk_s(P[B],P[B+1])
  #define PAF(k) __builtin_bit_cast(bf16x8,pw##k)
  #define VFR(j) (bf16x8){vlo[(j)%NVB][0],vlo[(j)%NVB][1],vlo[(j)%NVB][2],vlo[(j)%NVB][3],vhi[(j)%NVB][0],vhi[(j)%NVB][1],vhi[(j)%NVB][2],vhi[(j)%NVB][3]}
  #define PIN(x) asm volatile("":"+v"(x))
  #define MX3(a,b,c) __builtin_fmaxf(__builtin_fmaxf((a),(b)),(c))
  #define GAPA(MF,A0,A1,A2,A3,W0,W1,PW) do{ MF; sacc+=(f32x2_t){A0,A1}; sacc+=(f32x2_t){A2,A3}; PIN(sacc); W0; W1; PIN(PW); SBAR(); }while(0)
  #define EX(v) __builtin_amdgcn_exp2f(v)
  #define GAPB(MF,VR,BX_,X,B) do{ MF; VR; BX_; X[B]=EX(X[B]); X[B+1]=EX(X[B+1]); X[B+2]=EX(X[B+2]); X[B+3]=EX(X[B+3]); PIN(X); SBAR(); }while(0)
  #define VOFF(j) ((((j)&1)*4096)+(((j)>>1)*1024))
  #define VRD(j) do{ if((j)>=0&&(j)<8){ vlo[(j)%NVB]=vtr(vp_+VOFF(j)); vhi[(j)%NVB]=vtr(vp_+VOFF(j)+512); } }while(0)
  #define KRD(G,j) do{ if(G){ kload2(kf,kp0+sl_next,j); SBAR(); } }while(0)
  #define BSUBX(X,g) do{ const f32x2_t nm_={nmh_,nmh_}; const f32x2_t a_=nm_-(f32x2_t){bt[0],bt[1]}, b_=nm_-(f32x2_t){bt[2],bt[3]}; X[4*(g)+0]=a_.x; X[4*(g)+1]=a_.y; X[4*(g)+2]=b_.x; X[4*(g)+3]=b_.y; }while(0)
  #define BXX(Y0,Y1,j,G) do{ if(FOX&&(G)){ if((j)>=1&&(j)<=4){BSUBX(Y0,((j)-1)&3);} if((j)>=5){BSUBX(Y1,((j)-5)&3);} if((j)<8){ bt=*(lds_f4ptr)(cbn_+(((j)&3)*32+((j)>>2)*128)); } } }while(0)
  #define STEP(C0,C1,P0,P1,t,GK,GV,GL) do{ SBAR(); f32x4v bt; const lds_cptr cbn_=cb0+((((t)+1)&3)<<8); \
    const lds_cptr vp_=vp0+sl_prev; \
    VRD(0-(8-NVB)); SBAR(); f32x2_t sacc={P0[0],P0[1]}; \
    GAPA(C0=__builtin_amdgcn_mfma_f32_32x32x16_bf16(kf[0],qr[0],C0,0,0,0), P0[2],P0[3],P0[4],P0[5],     pw0[0]=PKW(P0,0), pw0[1]=PKW(P0,2), pw0); \
    VRD(1-(8-NVB)); SBAR(); GAPA(C1=__builtin_amdgcn_mfma_f32_32x32x16_bf16(kf[1],qr[0],C1,0,0,0), P0[6],P0[7],P0[8],P0[9],     pw0[2]=PKW(P0,4), pw0[3]=PKW(P0,6), pw0); \
    VRD(2-(8-NVB)); SBAR(); GAPA(C0=__builtin_amdgcn_mfma_f32_32x32x16_bf16(kf[2],qr[1],C0,0,0,0),   P0[10],P0[11],P0[12],P0[13], pw1[0]=PKW(P0,8), pw1[1]=PKW(P0,10), pw1); \
    VRD(3-(8-NVB)); SBAR(); GAPA(C1=__builtin_amdgcn_mfma_f32_32x32x16_bf16(kf[3],qr[1],C1,0,0,0),   P0[14],P0[15],P1[0],P1[1],   pw1[2]=PKW(P0,12),pw1[3]=PKW(P0,14), pw1); \
    VRD(4-(8-NVB)); SBAR(); GAPA(C0=__builtin_amdgcn_mfma_f32_32x32x16_bf16(kf[4],qr[2],C0,0,0,0),   P1[2],P1[3],P1[4],P1[5],     pw2[0]=PKW(P1,0), pw2[1]=PKW(P1,2), pw2); \
    VRD(5-(8-NVB)); SBAR(); GAPA(C1=__builtin_amdgcn_mfma_f32_32x32x16_bf16(kf[5],qr[2],C1,0,0,0),   P1[6],P1[7],P1[8],P1[9],     pw2[2]=PKW(P1,4), pw2[3]=PKW(P1,6), pw2); \
    VRD(6-(8-NVB)); SBAR(); GAPA(C0=__builtin_amdgcn_mfma_f32_32x32x16_bf16(kf[6],qr[3],C0,0,0,0),   P1[10],P1[11],P1[12],P1[13], pw3[0]=PKW(P1,8), pw3[1]=PKW(P1,10), pw3); \
    VRD(7-(8-NVB)); SBAR(); GAPA(C1=__builtin_amdgcn_mfma_f32_32x32x16_bf16(kf[7],qr[3],C1,0,0,0),   P1[14],P1[15],0.f,0.f,       pw3[2]=PKW(P1,12),pw3[3]=PKW(P1,14), pw3); \
    l_reg+=sacc.x+sacc.y; \
    if(GK){DMA_K((t)+3,sl_cur);DMA_C((t)+3);} if(GV){DMA_V((t)+1,sl_next);} \
    CMASK(C0,C1,t); \
    { float a=MX3(C0[0],C0[1],C1[0]),b=MX3(C0[2],C0[3],C1[1]); a=MX3(a,C1[2],C1[3]); \
      _Pragma("unroll") for(int r=4;r<16;r+=4){a=MX3(a,C0[r],C0[r+1]);b=MX3(b,C0[r+2],C0[r+3]);a=MX3(a,C1[r],C1[r+1]);b=MX3(b,C1[r+2],C1[r+3]);} \
      float rm=__builtin_fmaxf(a,b); { auto rr=__builtin_amdgcn_permlane32_swap(__float_as_uint(rm),__float_as_uint(rm),false,false); rm=__builtin_fmaxf(__uint_as_float(rr[0]),__uint_as_float(rr[1])); } \
      resc=false; \
      if(__builtin_expect(__any(rm>(float)THRL),0)){ const float dl=__builtin_fmaxf(rm,0.f); mhat+=dl; \
        _Pragma("unroll") for(int r=0;r<16;++r){C0[r]-=dl;C1[r]-=dl;} \
        const float f=__builtin_amdgcn_exp2f(-dl); l_reg*=f; if(hi==0)wsf[r32]=f; resc=true; } } \
    const float nmh_=-mhat; SBAR(); \
    GAPB(o[0]=__builtin_amdgcn_mfma_f32_32x32x16_bf16(PAF(0),VFR(0),o[0],0,0,0), VRD(0+NVB), BXX(P0,P1,0,GL), C0,0); \
    GAPB(o[1]=__builtin_amdgcn_mfma_f32_32x32x16_bf16(PAF(0),VFR(1),o[1],0,0,0), VRD(1+NVB), BXX(P0,P1,1,GL), C0,4); \
    KRD(GL,0); GAPB(o[0]=__builtin_amdgcn_mfma_f32_32x32x16_bf16(PAF(1),VFR(2),o[0],0,0,0), VRD(2+NVB), BXX(P0,P1,2,GL), C0,8); \
    KRD(GL,1); GAPB(o[1]=__builtin_amdgcn_mfma_f32_32x32x16_bf16(PAF(1),VFR(3),o[1],0,0,0), VRD(3+NVB), BXX(P0,P1,3,GL), C0,12); \
    KRD(GL,2); GAPB(o[0]=__builtin_amdgcn_mfma_f32_32x32x16_bf16(PAF(2),VFR(4),o[0],0,0,0), VRD(4+NVB), BXX(P0,P1,4,GL), C1,0); \
    KRD(GL,3); GAPB(o[1]=__builtin_amdgcn_mfma_f32_32x32x16_bf16(PAF(2),VFR(5),o[1],0,0,0), VRD(5+NVB), BXX(P0,P1,5,GL), C1,4); \
    GAPB(o[0]=__builtin_amdgcn_mfma_f32_32x32x16_bf16(PAF(3),VFR(6),o[0],0,0,0), VRD(6+NVB), BXX(P0,P1,6,GL), C1,8); \
    GAPB(o[1]=__builtin_amdgcn_mfma_f32_32x32x16_bf16(PAF(3),VFR(7),o[1],0,0,0), VRD(7+NVB), BXX(P0,P1,7,GL), C1,12); \
    BXX(P0,P1,8,GL); if(!FOX&&(GL)){ PREFILL(P0,P1,(t)+1); } \
    }while(0)
  int t=1;
  #undef CMASK
  #define CMASK(P0,P1,t) do{}while(0)
  for(;t+5<NT;t+=2){
    STEP(pB0,pB1,pA0,pA1,t,true,true,true);     if(FOX){WAIT_BAR(3);}else{WAIT_BAR(2);} RESC(); ROT();
    STEP(pA0,pA1,pB0,pB1,t+1,true,true,true);   if(FOX){WAIT_BAR(3);}else{WAIT_BAR(2);} RESC(); ROT();
  }
  #undef CMASK
  #define CMASK(P0,P1,t) do{int jb_=(t)-(NT-4); if(!FOX||jb_>=0)cmask<!FOX>(P0,P1,jb_,qrel,hi);}while(0)
  #define ENDW(tt) do{ if((tt)+3<NT){ if(FOX){WAIT_BAR(3);}else{WAIT_BAR(2);} } else if((tt)+2<NT){WAIT_BAR(1);} else {WAIT_BAR(0);} }while(0)
  for(;t+1<NT;t+=2){
    STEP(pB0,pB1,pA0,pA1,t,(t+3<NT),(t+1<NT),(t+1<NT));       ENDW(t);   RESC(); ROT();
    STEP(pA0,pA1,pB0,pB1,t+1,(t+4<NT),(t+2<NT),(t+2<NT));     ENDW(t+1); RESC(); ROT();
  }
  STEP(pB0,pB1,pA0,pA1,NT-1,false,false,false); RESC();
  { float sacc=pB0[0]+pB0[1]; _Pragma("unroll") for(int r=2;r<16;++r)sacc+=pB0[r]; _Pragma("unroll") for(int r=0;r<16;++r)sacc+=pB1[r]; l_reg+=sacc;
    pw0=(u32x4){PKW(pB0,0),PKW(pB0,2),PKW(pB0,4),PKW(pB0,6)};pw1=(u32x4){PKW(pB0,8),PKW(pB0,10),PKW(pB0,12),PKW(pB0,14)};pw2=(u32x4){PKW(pB1,0),PKW(pB1,2),PKW(pB1,4),PKW(pB1,6)};pw3=(u32x4){PKW(pB1,8),PKW(pB1,10),PKW(pB1,12),PKW(pB1,14)};
    SBAR(); pv(o,vb0+sl_cur,PAF(0),PAF(1),PAF(2),PAF(3)); }
  #undef PKW
  #undef PAF
  #undef VFR
  #undef PIN
  #undef MX3
  #undef GAPA
  #undef GAPB
  #undef EX
  #undef VRD
  #undef VOFF
  #undef KRD
  #undef STEP
  #undef ENDW
  {auto rr=__builtin_amdgcn_permlane32_swap(__float_as_uint(l_reg),__float_as_uint(l_reg),false,false);l_reg=__uint_as_float(rr[0])+__uint_as_float(rr[1]);}
  if(!FOX) l_reg+=__builtin_amdgcn_exp2f(sink2-mhat);
  if(hi==0)wsf[32+r32]=l_reg;asm volatile("s_waitcnt lgkmcnt(0)":::"memory");
  float rli[16];
  #pragma unroll
  for(int r=0;r<16;++r)rli[r]=__builtin_amdgcn_rcpf(wsf[32+crow(r,hi)]);
  bf16*Ow=O+(rowbase+q0+wid*QBLK)*DM+h*D;
  { bf16*stg=(bf16*)(shm+LDS_OST)+wid*2048;
    #pragma unroll
    for(int r=0;r<16;++r){const int orow=crow(r,hi);
      #pragma unroll
      for(int d0=0;d0<2;++d0)stg[orow*64+d0*32+r32]=(bf16)(cvtpk_s(o[d0][r]*rli[r],0.f)&0xffffu);}
    asm volatile("s_waitcnt lgkmcnt(0)":::"memory");
    #pragma unroll
    for(int i=0;i<4;++i){const int row=i*8+(lane>>3),ch=lane&7; const u32x4 v=*(const u32x4*)(stg+row*64+ch*8); ATTN_STORE16(Ow+(long)row*DM+ch*8,v);} }
  asm volatile("s_waitcnt lgkmcnt(0)\n\ts_barrier":::"memory");
  #undef DMA_K
  #undef DMA_V
  #undef DMA_C
  #undef PREFILL
  #undef BSUBX
  #undef BXX
  #undef CMASK
  #undef START
  #undef RESC
  #undef ROT
}
constexpr int ATTN_LDS_BYTES=LDS_BYTES;
#undef SBAR
#undef WAIT_BAR
}

#ifndef REP_PHASE
#define REP_PHASE 0
#endif
#ifndef FUSED_FINAL
#define FUSED_FINAL 0
#endif
#ifndef NAIVE_SWA
#define NAIVE_SWA 0
#endif
#ifndef NAIVE_FOX
#define NAIVE_FOX 0
#endif
#define LAS __attribute__((address_space(3)))
typedef unsigned short bf16;
typedef float f32x4 __attribute__((ext_vector_type(4)));
typedef unsigned v4u __attribute__((ext_vector_type(4)));
typedef unsigned v2u __attribute__((ext_vector_type(2)));
constexpr int NWAVES = 8;
constexpr int RING_BYTES = 131072, LDS_BYTES = 147456;

__device__ __forceinline__ float wave_sum(float v) {
#pragma unroll
    for (int o = 1; o < 64; o <<= 1) v += __shfl_xor(v, o);
    return v;
}
#define LDS_WAIT() asm volatile("s_waitcnt lgkmcnt(0)" ::: "memory")

#define XB_TMO      128
#define XB_XCNT(j)  (256  + 64 * (j))
#define XB_XSUB(j)  (1280 + 64 * (j))
#define XB_XGEN(j)  (2304 + 64 * (j))
#define XB_TOP      3328
#define XB_TOPGEN   3392
#define XCD_BAR_WORDS 3456
#define XB_SPIN_CAP (1u << 18)

__device__ __forceinline__ unsigned xb_ld(unsigned* p)              { return __hip_atomic_load(p, __ATOMIC_RELAXED, __HIP_MEMORY_SCOPE_AGENT); }
__device__ __forceinline__ unsigned xb_add(unsigned* p, unsigned v) { return __hip_atomic_fetch_add(p, v, __ATOMIC_RELAXED, __HIP_MEMORY_SCOPE_AGENT); }
__device__ __forceinline__ unsigned xb_xcc_id() { return (unsigned)__builtin_amdgcn_s_getreg((3 << 11) | 20) & 0xFu; }
#define XB_SPIN(cond, bar) do { unsigned _sp = 0; while (cond) { __builtin_amdgcn_s_sleep(1); \
    if ((++_sp & 255u) == 0u) { if (xb_ld(&(bar)[XB_TMO])) break; if (_sp > XB_SPIN_CAP) { atomicAdd(&(bar)[XB_TMO], 1u); break; } } } } while (0)

struct XcdBarrier {
    unsigned* bar; unsigned x;
    volatile LAS unsigned* st;
};

__device__ __forceinline__ XcdBarrier xcd_barrier_post(unsigned* bar, volatile LAS unsigned* st) {
    XcdBarrier b; b.bar = bar; b.x = xb_xcc_id(); b.st = st;
    if (threadIdx.x == 0) (void)xb_add(&bar[XB_XCNT(b.x)], 1u);
    return b;
}
__device__ __forceinline__ void xcd_barrier_complete(unsigned* bar, unsigned x, unsigned& nloc, unsigned& nx) {
    const unsigned G = gridDim.x * gridDim.y * gridDim.z;
    unsigned sum, cnt, mine, sp = 0u;
    for (;;) {
        sum = 0u; cnt = 0u; mine = 0u;
#pragma unroll
        for (unsigned j = 0; j < 16; ++j) { const unsigned c = xb_ld(&bar[XB_XCNT(j)]); sum += c; cnt += (c > 0u) ? 1u : 0u; mine = (j == x) ? c : mine; }
        if (sum == G) break;
        __builtin_amdgcn_s_sleep(1);
        if ((++sp & 255u) == 0u) { if (xb_ld(&bar[XB_TMO])) break; if (sp > XB_SPIN_CAP) { atomicAdd(&bar[XB_TMO], 1u); break; } }
    }
    nloc = mine > 0u ? mine : 1u; nx = cnt > 0u ? cnt : 1u;
}

__device__ __forceinline__ void xcd_barrier(const XcdBarrier& b) {
    asm volatile("s_waitcnt vmcnt(0)" ::: "memory");
    __syncthreads();
    if (threadIdx.x == 0) {
        unsigned* bar = b.bar;
        __builtin_amdgcn_s_waitcnt(0);
        unsigned nloc = b.st[0], nx = b.st[1];
        if (nloc == 0u) { xcd_barrier_complete(bar, b.x, nloc, nx); b.st[0] = nloc; b.st[1] = nx; }
        const unsigned old = xb_add(&bar[XB_XSUB(b.x)], 1u);
        const unsigned gen = old / nloc;
        if (old + 1u == (gen + 1u) * nloc) {
            __builtin_amdgcn_fence(__ATOMIC_RELEASE, "agent");
            asm volatile("s_waitcnt vmcnt(0)" ::: "memory");
            const unsigned og = xb_add(&bar[XB_TOP], 1u);
            const unsigned tg = og / nx;
            if (og + 1u == (tg + 1u) * nx) xb_add(&bar[XB_TOPGEN], 1u);
            else XB_SPIN(xb_ld(&bar[XB_TOPGEN]) == tg, bar);
            __builtin_amdgcn_fence(__ATOMIC_ACQUIRE, "agent");
            xb_add(&bar[XB_XGEN(b.x)], 1u);
            asm volatile("s_waitcnt vmcnt(0)" ::: "memory");
        } else {
            XB_SPIN(xb_ld(&bar[XB_XGEN(b.x)]) == gen, bar);
            __builtin_amdgcn_fence(__ATOMIC_ACQUIRE, "agent");
            asm volatile("s_waitcnt vmcnt(0)" ::: "memory");
        }
    }
    __syncthreads();
}


__device__ __forceinline__ void tr_item(const float* W, int K, int N, bf16* WT, int dst_row0, int src_col0, int nvalid, int kb, const float* kscale, float cscale, LAS float* scr, int lane) {
    const int k0 = 64 * kb, c = lane & 31;
    float tv[32];
    const float* wp = W + (size_t)(k0 + (lane >> 5)) * N + src_col0 + c;
#pragma unroll
    for (int i = 0; i < 32; ++i) { tv[i] = 0.f; if (c < nvalid) tv[i] = __builtin_nontemporal_load(wp + (size_t)(2 * i) * N); }
#pragma unroll
    for (int i = 0; i < 32; ++i) { const int kk = 2 * i + (lane >> 5); float v = tv[i] * cscale; if (kscale) v *= kscale[k0 + kk]; scr[kk * 33 + c] = v; }
    LDS_WAIT(); asm volatile("" ::: "memory");
    const int ch = lane & 7;
#pragma unroll
    for (int j = 0; j < 4; ++j) { const int n = (lane >> 3) + 8 * j; const LAS float* s = scr + (8 * ch) * 33 + n;
        v4u o; o.x = pg8::cvt_pk_bf16(s[0 * 33], s[1 * 33]); o.y = pg8::cvt_pk_bf16(s[2 * 33], s[3 * 33]); o.z = pg8::cvt_pk_bf16(s[4 * 33], s[5 * 33]); o.w = pg8::cvt_pk_bf16(s[6 * 33], s[7 * 33]);
        *(v4u*)(WT + (size_t)(dst_row0 + n) * K + k0 + 8 * ch) = o; }
    LDS_WAIT(); asm volatile("" ::: "memory");
}
__device__ __forceinline__ void win_map(int db, int& src, int& nv) {
    const int pn = db >> 3, bj = (db >> 2) & 1, wc = db & 3; nv = 32;
    if (pn < 4) src = (4 * pn + wc) * 64 + 32 * bj;
    else if (pn == 4) src = (wc < 2 ? 1024 + wc * 64 : 1152 + (wc - 2) * 64) + 32 * bj;
    else if (pn < 17) { const int t = pn - 5; src = 1280 + (t >> 2) * 1024 + (4 * (t & 3) + wc) * 64 + 32 * bj; }
    else if (pn < 33) src = 4368 + (db - 136) * 32;
    else { src = 4352; nv = (db == 264) ? 16 : 0; }
}

struct Args { const float* x; const int* pos; const float* attn_norm; const float* w_in; const float* fbias; const float* sinks; const float* w_bs; const float* w_bf;
              const float* w_out; const float* mlp_norm; const float* w_up; const float* w_dn; const float* final_norm; float* out; unsigned char* ws; long long fused_final; };

__device__ __forceinline__ void rms_row_to_bf16(const float* xrow, const float* gain, bf16* orow, int lane) {
    const f32x4* xr = (const f32x4*)xrow + lane; f32x4 v[8]; float s = 0.f;
#pragma unroll
    for (int j = 0; j < 8; ++j) { v[j] = xr[64 * j]; s += (v[j].x * v[j].x + v[j].y * v[j].y) + (v[j].z * v[j].z + v[j].w * v[j].w); }
    const float rstd = __builtin_amdgcn_rsqf(wave_sum(s) * (1.f / DM) + RMS_EPS);
    const f32x4* gr = (const f32x4*)gain + lane; v2u* o8 = (v2u*)orow + lane;
#pragma unroll
    for (int j = 0; j < 8; ++j) { const f32x4 g = gr[64 * j]; v2u w; w.x = pg8::cvt_pk_bf16(v[j].x * rstd * g.x, v[j].y * rstd * g.y); w.y = pg8::cvt_pk_bf16(v[j].z * rstd * g.z, v[j].w * rstd * g.w); o8[64 * j] = w; }
}

__device__ __forceinline__ void rms_row2_to_bf16(const float* x0, const float* x1, const float* gain, bf16* o0, bf16* o1, int lane) {
    const f32x4* xr0 = (const f32x4*)x0 + lane; const f32x4* xr1 = (const f32x4*)x1 + lane; f32x4 v[8], w[8]; float s = 0.f, t = 0.f;
#pragma unroll
    for (int j = 0; j < 8; ++j) { v[j] = __builtin_nontemporal_load(xr0 + 64 * j); w[j] = __builtin_nontemporal_load(xr1 + 64 * j); }
#pragma unroll
    for (int j = 0; j < 8; ++j) { s += (v[j].x * v[j].x + v[j].y * v[j].y) + (v[j].z * v[j].z + v[j].w * v[j].w); t += (w[j].x * w[j].x + w[j].y * w[j].y) + (w[j].z * w[j].z + w[j].w * w[j].w); }
    const float rs = __builtin_amdgcn_rsqf(wave_sum(s) * (1.f / DM) + RMS_EPS), rt = __builtin_amdgcn_rsqf(wave_sum(t) * (1.f / DM) + RMS_EPS);
    const f32x4* gr = (const f32x4*)gain + lane; v2u* p0 = (v2u*)o0 + lane; v2u* p1 = (v2u*)o1 + lane;
#pragma unroll
    for (int j = 0; j < 8; ++j) { const f32x4 g = gr[64 * j]; v2u a, c;
        a.x = pg8::cvt_pk_bf16(v[j].x * rs * g.x, v[j].y * rs * g.y); a.y = pg8::cvt_pk_bf16(v[j].z * rs * g.z, v[j].w * rs * g.w);
        c.x = pg8::cvt_pk_bf16(w[j].x * rt * g.x, w[j].y * rt * g.y); c.y = pg8::cvt_pk_bf16(w[j].z * rt * g.z, w[j].w * rt * g.w);
        p0[64 * j] = a; p1[64 * j] = c; }
}
__device__ __forceinline__ void p0_prologue(const Args& a, LAS unsigned char* lds, int vcu, int G, int wave, int lane) {
    unsigned char* ws = a.ws;
    LAS float* scr = (LAS float*)(lds + wave * 16384);
    const int gw = vcu * NWAVES + wave, NGW = G * NWAVES;
    constexpr int I_IN = (NIN / 32) * (DM / 64), I_BS = (DM / 32) * (1024 / 64), I_OUT = (DM / 32) * (DM / 64), I_UP = (DFF / 32) * (DM / 64), I_DN = (DM / 32) * (DFF / 64);
    constexpr int NITEMS = I_IN + 2 * I_BS + I_OUT + I_UP + I_DN;
    for (int it = gw; it < NITEMS; it += NGW) {
        int r = it;
        if (r < I_IN) { const int db = r / (DM / 64), kb = r % (DM / 64); int src, nv; win_map(db, src, nv); const float csc = (db >= 136 && db < 264) ? -LOG2E : ((db < 32 || (db >= 40 && db < 72)) ? C2 : 1.0f);
            tr_item(a.w_in, DM, DIN, (bf16*)(ws + WS_WIN), db * 32, src, nv, kb, nullptr, csc, scr, lane); continue; } r -= I_IN;
        if (r < I_BS) { const int db = r / 16, kb = r % 16; tr_item(a.w_bs, 1024, DM, (bf16*)(ws + WS_WBS), db * 32, db * 32, 32, kb, nullptr, 1.0f, scr, lane); continue; } r -= I_BS;
        if (r < I_BS) { const int db = r / 16, kb = r % 16; tr_item(a.w_bf, 1024, DM, (bf16*)(ws + WS_WBF), db * 32, db * 32, 32, kb, nullptr, 1.0f, scr, lane); continue; } r -= I_BS;
        if (r < I_OUT) { const int db = r / 32, kb = r % 32; tr_item(a.w_out, DM, DM, (bf16*)(ws + WS_WOUT), db * 32, db * 32, 32, kb, nullptr, 1.0f, scr, lane); continue; } r -= I_OUT;
        if (r < I_UP) { const int db = r / 32, kb = r % 32; tr_item(a.w_up, DM, DFF, (bf16*)(ws + WS_WUP), db * 32, db * 32, 32, kb, a.mlp_norm, 1.0f, scr, lane); continue; } r -= I_UP;
        { const int db = r / 128, kb = r % 128; tr_item(a.w_dn, DFF, DM, (bf16*)(ws + WS_WDN), db * 32, db * 32, 32, kb, nullptr, 1.0f, scr, lane); }
    }
    for (int m = gw; m < M; m += 2 * NGW) rms_row2_to_bf16(a.x + (size_t)m * DM, a.x + (size_t)(m + NGW) * DM, a.attn_norm, (bf16*)(ws + WS_XN) + (size_t)m * DM, (bf16*)(ws + WS_XN) + (size_t)(m + NGW) * DM, lane);
    float* cs = (float*)(ws + WS_CS);
    for (int e = gw * 64 + lane; e < M * 32; e += NGW * 64) {
        const int tok = e >> 5, i = e & 31;
        const float inv_freq = powf(10000.0f, -(float)(2 * i) / 64.0f);
        const float ang = (float)a.pos[tok] * inv_freq;
        double rev = (double)ang * 0.15915494309189535; rev -= floor(rev);
        const float rf = (float)rev;
        cs[e] = __builtin_amdgcn_cosf(rf); cs[(size_t)M * 32 + e] = __builtin_amdgcn_sinf(rf);
    }
}

__device__ __forceinline__ void cumsum_unit(const Args& a, int bh, LAS unsigned char* lds) {
    const float* FL = (const float*)(a.ws + WS_FL); float* Cp = (float*)(a.ws + WS_C);
    LAS double* sh = (LAS double*)lds;
    const int b = bh >> 4, h = bh & 15, tid = threadIdx.x, s0 = tid * 16; const float fb = a.fbias[h];
    float ls[16]; double run = 0.0;
#pragma unroll
    for (int i = 0; i < 16; ++i) { const float z = FL[(size_t)(b * SEQ + s0 + i) * 16 + h] + fb; const float v = fminf(z, 0.f) - log1pf(expf(-fabsf(z))); ls[i] = v; run += (double)v; }
    sh[tid] = run; __syncthreads();
    double pre = 0.0; for (int k = 0; k < tid; ++k) pre += sh[k];
#pragma unroll
    for (int i = 0; i < 16; ++i) { pre += (double)ls[i]; Cp[(size_t)bh * SEQ + s0 + i] = (float)(pre * 1.4426950408889634); }
    __syncthreads();
}

__device__ __forceinline__ void naive_swa_unit(const Args& a, int unit) {
    const bf16* AQ = (const bf16*)(a.ws + WS_AQ); const bf16* AK = (const bf16*)(a.ws + WS_AK); const bf16* AV = (const bf16*)(a.ws + WS_AV); bf16* OA = (bf16*)(a.ws + WS_OA);
    const int tid = threadIdx.x, head = tid & 15, tok = unit * 32 + (tid >> 4), b = tok / SEQ, s = tok % SEQ, kvh = head >> 3;
    float q[64], o[64]; float m = -INFINITY, l = 0.f;
    { const v4u* qp = (const v4u*)(AQ + (size_t)tok * 1024 + head * 64);
#pragma unroll
      for (int c = 0; c < 8; ++c) { const v4u w = qp[c];
#pragma unroll
          for (int e = 0; e < 4; ++e) { q[8 * c + 2 * e] = pg8::bf_lo(w[e]); q[8 * c + 2 * e + 1] = pg8::bf_hi(w[e]); } } }
#pragma unroll
    for (int d = 0; d < 64; ++d) o[d] = 0.f;
    for (int i = 0; i < 128; ++i) {
        const int j = s - i; const bool valid = j >= 0; const int jj = valid ? j : 0;
        const v4u* kp = (const v4u*)(AK + (size_t)(b * SEQ + jj) * 128 + kvh * 64); const v4u* vp = (const v4u*)(AV + (size_t)(b * SEQ + jj) * 128 + kvh * 64);
        float dot = 0.f;
#pragma unroll
        for (int c = 0; c < 8; ++c) { const v4u w = kp[c];
#pragma unroll
            for (int e = 0; e < 4; ++e) { dot += q[8 * c + 2 * e] * pg8::bf_lo(w[e]); dot += q[8 * c + 2 * e + 1] * pg8::bf_hi(w[e]); } }
        const float lg = valid ? dot : -INFINITY;
        const float mn = fmaxf(m, lg), al = __builtin_amdgcn_exp2f(m - mn), p = __builtin_amdgcn_exp2f(lg - mn);
        l = l * al + p; m = mn;
#pragma unroll
        for (int c = 0; c < 8; ++c) { const v4u w = vp[c];
#pragma unroll
            for (int e = 0; e < 4; ++e) { o[8 * c + 2 * e] = o[8 * c + 2 * e] * al + p * pg8::bf_lo(w[e]); o[8 * c + 2 * e + 1] = o[8 * c + 2 * e + 1] * al + p * pg8::bf_hi(w[e]); } }
    }
    { const float sk = a.sinks[head] * LOG2E; const float m2 = fmaxf(m, sk), al = __builtin_amdgcn_exp2f(m - m2); l = l * al + __builtin_amdgcn_exp2f(sk - m2);
      const float rl = al / l;
      v4u* op = (v4u*)(OA + (size_t)tok * 1024 + head * 64);
#pragma unroll
      for (int c = 0; c < 8; ++c) { v4u w;
#pragma unroll
          for (int e = 0; e < 4; ++e) w[e] = pg8::cvt_pk_bf16(o[8 * c + 2 * e] * rl, o[8 * c + 2 * e + 1] * rl);
          op[c] = w; } }
}
__device__ __forceinline__ void naive_fox_unit(const Args& a, int bh, int qblk) {
    const bf16* FQ = (const bf16*)(a.ws + WS_FQ); const bf16* FK = (const bf16*)(a.ws + WS_FK); const bf16* FV = (const bf16*)(a.ws + WS_FV); bf16* OB = (bf16*)(a.ws + WS_OB);
    const float* Cp = (const float*)(a.ws + WS_C) + (size_t)bh * SEQ;
    const int tid = threadIdx.x, b = bh >> 4, h = bh & 15, s = qblk * 512 + tid; const size_t tok = (size_t)b * SEQ + s;
    float q[64], o[64]; float m = -INFINITY, l = 0.f;
    { const v4u* qp = (const v4u*)(FQ + tok * 1024 + h * 64);
#pragma unroll
      for (int c = 0; c < 8; ++c) { const v4u w = qp[c];
#pragma unroll
          for (int e = 0; e < 4; ++e) { q[8 * c + 2 * e] = pg8::bf_lo(w[e]); q[8 * c + 2 * e + 1] = pg8::bf_hi(w[e]); } } }
#pragma unroll
    for (int d = 0; d < 64; ++d) o[d] = 0.f;
    const float cq = Cp[s];
    const int jend = __builtin_amdgcn_readfirstlane(qblk * 512 + (tid | 63));
    for (int j = 0; j <= jend; ++j) {
        const v4u* kp = (const v4u*)(FK + ((size_t)b * SEQ + j) * 1024 + h * 64); const v4u* vp = (const v4u*)(FV + ((size_t)b * SEQ + j) * 1024 + h * 64);
        float dot = 0.f;
#pragma unroll
        for (int c = 0; c < 8; ++c) { const v4u w = kp[c];
#pragma unroll
            for (int e = 0; e < 4; ++e) { dot += q[8 * c + 2 * e] * pg8::bf_lo(w[e]); dot += q[8 * c + 2 * e + 1] * pg8::bf_hi(w[e]); } }
        float lg = dot + (cq - Cp[j]); lg = (j <= s) ? lg : -INFINITY;
        const float mn = fmaxf(m, lg), al = __builtin_amdgcn_exp2f(m - mn), p = __builtin_amdgcn_exp2f(lg - mn);
        l = l * al + p; m = mn;
#pragma unroll
        for (int c = 0; c < 8; ++c) { const v4u w = vp[c];
#pragma unroll
            for (int e = 0; e < 4; ++e) { o[8 * c + 2 * e] = o[8 * c + 2 * e] * al + p * pg8::bf_lo(w[e]); o[8 * c + 2 * e + 1] = o[8 * c + 2 * e + 1] * al + p * pg8::bf_hi(w[e]); } }
    }
    { const float rl = 1.0f / l; v4u* op = (v4u*)(OB + tok * 1024 + h * 64);
#pragma unroll
      for (int c = 0; c < 8; ++c) { v4u w;
#pragma unroll
          for (int e = 0; e < 4; ++e) w[e] = pg8::cvt_pk_bf16(o[8 * c + 2 * e] * rl, o[8 * c + 2 * e + 1] * rl);
          op[c] = w; } }
}

__global__ void __launch_bounds__(NWAVES * 64, 2) mega_fwd(Args a) {
    extern __shared__ __attribute__((aligned(16))) unsigned char lds_raw[];
    LAS unsigned char* lds = (LAS unsigned char*)lds_raw;
    cg::grid_group grid = cg::this_grid();
    int tid_ = threadIdx.x; asm volatile("" : "+v"(tid_));
    const int tid = tid_, lane = tid & 63, wave = __builtin_amdgcn_readfirstlane(tid >> 6);
    const int G = gridDim.x, bx = blockIdx.x, vcu = (G % 8 == 0) ? (bx % 8) * (G / 8) + bx / 8 : bx;
    unsigned char* ws = a.ws;
    float* SS1 = (float*)(ws + WS_CTL); float* SS2 = SS1 + M;
#define GRID_SYNC_CG() do { asm volatile("s_waitcnt vmcnt(0) lgkmcnt(0)" ::: "memory"); grid.sync(); } while (0)
#define GRID_SYNC() xcd_barrier(xbar)
    if (tid < 2) ((LAS unsigned*)(lds + RING_BYTES))[tid] = 0u;
    __syncthreads();
    const XcdBarrier xbar = xcd_barrier_post((unsigned*)(ws + WS_CTL + 786432), (volatile LAS unsigned*)(lds + RING_BYTES));

    for (int rp_ = 0; rp_ < (REP_PHASE == 100 ? 2 : 1); ++rp_) { p0_prologue(a, lds, vcu, G, wave, lane); __syncthreads(); }
    if (a.ws == nullptr) GRID_SYNC_CG();
    GRID_SYNC();

    {
        pg8::Gemm g{(const bf16*)(ws + WS_XN), (const bf16*)(ws + WS_WIN), nullptr, nullptr, DM};
        pg8::StaticOrder S; S.init(M, NIN, G, bx);
        pg8::EpiIn E{ws};
        for (int rp_ = 0; rp_ < (REP_PHASE == 1 ? 2 : 1); ++rp_) pg8::gemm_phase<pg8::EpiIn, pg8::StaticOrder, true, true>(lds, g, S, E);
    }
    GRID_SYNC();

    for (int u = bx; u < 64; u += G) cumsum_unit(a, u, lds);
#if NAIVE_SWA
    for (int u = bx; u < M / 32; u += G) naive_swa_unit(a, u);
#else
    for (int rp_ = 0; rp_ < (REP_PHASE == 2 ? 2 : 1); ++rp_)
    for (int u = vcu; u < 2048; u += G) { const int bh = u >> 5, qb = u & 31, b_ = bh >> 4, h_ = bh & 15;
        attn_body::attn_unit<8, false, 128>(b_, h_, qb, (const bf16*)(ws + WS_AQ), (const bf16*)(ws + WS_AK), (const bf16*)(ws + WS_AV), (bf16*)(ws + WS_OA), nullptr, a.sinks[h_] * LOG2E, (char*)lds_raw); }
#endif
    GRID_SYNC();

#if NAIVE_FOX
    for (int u = bx; u < 1024; u += G) { const int r = u >> 6, i = r >> 2, hi4 = r & 3, qblk = (i & 1) ? 4 * i + 3 - hi4 : 4 * i + hi4; naive_fox_unit(a, u & 63, qblk); }
#else
    for (int rp_ = 0; rp_ < (REP_PHASE == 3 ? 2 : 1); ++rp_)
    for (int e = vcu; e < 2048; e += G) { const int cuv = e & 255, i = e >> 8, bh = (cuv >> 4) + 16 * (i >> 1), s_ = cuv & 15, qb = (i & 1) ? 31 - s_ : s_;
        attn_body::attn_unit<8, true, 1024>(bh >> 4, bh & 15, qb, (const bf16*)(ws + WS_FQ), (const bf16*)(ws + WS_FK), (const bf16*)(ws + WS_FV), (bf16*)(ws + WS_OB), (const float*)(ws + WS_C) + (size_t)bh * SEQ, 0.f, (char*)lds_raw); }
#endif
    GRID_SYNC();

    {
        pg8::Gemm g{(const bf16*)(ws + WS_OA), (const bf16*)(ws + WS_WBS), (const bf16*)(ws + WS_OB), (const bf16*)(ws + WS_WBF), 1024};
        pg8::PairOrder S; S.s.init(M, DM, G, bx);
        pg8::EpiBranch E{(const unsigned char*)(ws + WS_G), (bf16*)(ws + WS_MG)};
        for (int rp_ = 0; rp_ < (REP_PHASE == 4 ? 2 : 1); ++rp_) pg8::gemm_phase<pg8::EpiBranch, pg8::PairOrder, true, true>(lds, g, S, E);
    }
    GRID_SYNC();

    {
        pg8::Gemm g{(const bf16*)(ws + WS_MG), (const bf16*)(ws + WS_WOUT), nullptr, nullptr, DM};
        pg8::StaticOrder S; S.init(M, DM, G, bx);
        pg8::EpiResB<false> E{a.x, (bf16*)(ws + WS_X1B), SS1};
        pg8::gemm_phase<pg8::EpiResB<false>, pg8::StaticOrder, true, true>(lds, g, S, E);
    }
    GRID_SYNC();

    {
        pg8::Gemm g{(const bf16*)(ws + WS_X1B), (const bf16*)(ws + WS_WUP), nullptr, nullptr, DM};
        pg8::StaticOrder S; S.init(M, DFF, G, bx);
        pg8::EpiUp E{SS1, (bf16*)(ws + WS_U)};
        for (int rp_ = 0; rp_ < (REP_PHASE == 6 ? 2 : 1); ++rp_) pg8::gemm_phase<pg8::EpiUp, pg8::StaticOrder, true, true>(lds, g, S, E);
    }
    GRID_SYNC();

    {
        pg8::Gemm g{(const bf16*)(ws + WS_U), (const bf16*)(ws + WS_WDN), nullptr, nullptr, DFF};
        pg8::StaticOrder S; S.init(M, DM, G, bx);
        pg8::EpiResB<true> E{(const void*)(ws + WS_X1B), (bf16*)(ws + WS_X2B), SS2};
        pg8::gemm_phase<pg8::EpiResB<true>, pg8::StaticOrder, true, true>(lds, g, S, E);
    }
    GRID_SYNC();

    {
        const int gw = vcu * NWAVES + wave, NGW = G * NWAVES;
        for (int m = gw; m < M; m += NGW) {
            const float rstd = __builtin_amdgcn_rsqf(SS2[m] * (1.f / DM) + RMS_EPS);
            f32x4* xr = (f32x4*)(a.out + (size_t)m * DM) + lane; const f32x4* gr = (const f32x4*)a.final_norm + lane; const v2u* br = (const v2u*)((const bf16*)(ws + WS_X2B) + (size_t)m * DM) + lane;
            v2u w[8];
#pragma unroll
            for (int j = 0; j < 8; ++j) w[j] = __builtin_nontemporal_load(br + 64 * j);
#pragma unroll
            for (int j = 0; j < 8; ++j) { const f32x4 g = gr[64 * j]; const f32x4 v = (f32x4){pg8::bf_lo(w[j].x), pg8::bf_hi(w[j].x), pg8::bf_lo(w[j].y), pg8::bf_hi(w[j].y)}; __builtin_nontemporal_store(v * rstd * g, xr + 64 * j); }
        }
    }
}

extern "C" void kernel_launch(void* const* d_in, const int* in_sizes, int n_in, void* d_out, int out_size, void* d_ws, size_t ws_size, hipStream_t stream) {
    static int grid = 0; static int fused_final = 0;
    if (grid == 0) {
        if (n_in != 13 || in_sizes[0] != M * DM || out_size != M * DM || ws_size < WS_END) { fprintf(stderr, "kernel_launch: unexpected shapes (n_in %d, in0 %d, out %d, ws %zu)\n", n_in, n_in > 0 ? in_sizes[0] : -1, out_size, ws_size); grid = -1; return; }
        int dev = 0, cus = 0, per_cu = 0;
        if (hipGetDevice(&dev) != hipSuccess || hipDeviceGetAttribute(&cus, hipDeviceAttributeMultiprocessorCount, dev) != hipSuccess) { grid = -1; return; }
        if (hipFuncSetAttribute((const void*)mega_fwd, hipFuncAttributeMaxDynamicSharedMemorySize, LDS_BYTES) != hipSuccess) { fprintf(stderr, "kernel_launch: hipFuncSetAttribute failed\n"); grid = -1; return; }
        if (hipOccupancyMaxActiveBlocksPerMultiprocessor(&per_cu, (const void*)mega_fwd, NWAVES * 64, LDS_BYTES) != hipSuccess || per_cu < 1) { fprintf(stderr, "kernel_launch: occupancy query says %d\n", per_cu); per_cu = 1; }
        (void)hipGetLastError();
        grid = cus * 1;
        { pg8::StaticOrder S; S.init(M, DM, grid, 0); bool ok = (M / 256) * (DM / 256) == 4 * grid;
          for (int c = 0; c < grid && ok; ++c) { S.c = c; for (int i = 0; i < 4 && ok; i += 2) { pg8::Unit u0, u1; ok = S.next(i, u0) && S.next(i + 1, u1) && u0.pm == u1.pm && u1.pn == u0.pn + 4 && u0.pn < 4 && u0.f == 0 && u1.f == 1; } }
          fused_final = (ok && FUSED_FINAL) ? 1 : 0; if (!ok) fprintf(stderr, "kernel_launch: note: unit order does not pair tiles; using the separate final-norm pass\n"); }
    }
    if (grid < 0) return;
    (void)hipMemsetAsync((char*)d_ws + WS_CTL, 0, CTL_ZERO_BYTES, stream);
    Args a{};
    a.x = (const float*)d_in[0]; a.pos = (const int*)d_in[1]; a.attn_norm = (const float*)d_in[2]; a.w_in = (const float*)d_in[3]; a.fbias = (const float*)d_in[4]; a.sinks = (const float*)d_in[5];
    a.w_bs = (const float*)d_in[6]; a.w_bf = (const float*)d_in[7]; a.w_out = (const float*)d_in[8]; a.mlp_norm = (const float*)d_in[9]; a.w_up = (const float*)d_in[10]; a.w_dn = (const float*)d_in[11];
    a.final_norm = (const float*)d_in[12]; a.out = (float*)d_out; a.ws = (unsigned char*)d_ws; a.fused_final = fused_final;
    void* kargs[] = {&a};
    const hipError_t le = hipLaunchCooperativeKernel((const void*)mega_fwd, dim3(grid), dim3(NWAVES * 64), kargs, LDS_BYTES, stream);
    if (le != hipSuccess) fprintf(stderr, "kernel_launch: cooperative launch failed: %s (grid %d)\n", hipGetErrorString(le), grid);
}
```

```cpp
#include <hip/hip_runtime.h>
#include <hip/hip_cooperative_groups.h>
#include <cstdio>
#include <cstdint>
namespace cg = cooperative_groups;

constexpr int BATCH = 4, SEQ = 8192, DM = 2048, M = BATCH * SEQ, DFF = 8192, NIN = 4608  , NGATE = 4096, DIN = 8464;
constexpr float RMS_EPS = 1e-6f;
constexpr float LOG2E = 1.4426950408889634f;
constexpr float C2 = 0.125f * 1.4426950408889634f;

constexpr size_t MiB = 1u << 20;
constexpr size_t WS_CTL = 0, CTL_ZERO_BYTES = 1 * MiB;
constexpr size_t WS_WIN = 1 * MiB, WS_WBS = 35 * MiB, WS_WBF = 39 * MiB, WS_WOUT = 43 * MiB, WS_WUP = 51 * MiB, WS_WDN = 83 * MiB;
constexpr size_t WS_CS = 115 * MiB;
constexpr size_t WS_FL = 123 * MiB, WS_C = 125 * MiB;
constexpr size_t WS_FK = 128 * MiB, WS_FV = 192 * MiB, WS_X1B = 128 * MiB;
constexpr size_t WS_XN = 256 * MiB, WS_MG = 256 * MiB;
constexpr size_t WS_AQ = 384 * MiB, WS_FQ = 448 * MiB, WS_G = 512 * MiB;
constexpr size_t WS_U = 256 * MiB;
constexpr size_t WS_AK = 768 * MiB, WS_AV = 776 * MiB, WS_OA = 784 * MiB, WS_OB = 848 * MiB, WS_END = 912 * MiB;
constexpr size_t WS_XN8 = 920 * MiB, WS_WG8 = 21 * MiB, WS_END3 = 984 * MiB;
constexpr size_t WS_X2B = 784 * MiB;

namespace pg8 {
#define PG8_LAS __attribute__((address_space(3)))
typedef unsigned short bf16_t;
typedef short bf16x8 __attribute__((ext_vector_type(8)));
typedef float f32x4 __attribute__((ext_vector_type(4)));
typedef unsigned u32x4 __attribute__((ext_vector_type(4)));
typedef unsigned u32x2 __attribute__((ext_vector_type(2)));
typedef int v4i_t __attribute__((ext_vector_type(4)));
typedef int v8i_t __attribute__((ext_vector_type(8)));
constexpr int BM = 256, BK = 64, HALF = 128, HTB = HALF * BK * 2  , STAGE_BYTES = 8 * HTB, NXCD = 8, WGM = 8;

__host__ __device__ __forceinline__ int lds_byte(int r, int c) { const int st = (r >> 4) * 2 + (c >> 5), rr = r & 15, cc = c & 31, ob = rr * 64 + cc * 2; return st * 1024 + (ob ^ (((ob >> 9) & 1) << 5)); }
__host__ __device__ __forceinline__ void stage_rc(int b, int& R, int& C) { const int st = b / 1024, sb = b % 1024, swz = sb ^ (((sb >> 9) & 1) << 5); R = (st >> 1) * 16 + swz / 64; C = (st & 1) * 32 + (swz % 64) / 2; }
__host__ __device__ __forceinline__ int perm32(int rho) { const int n = rho >> 4, i = rho & 15; return 8 * (i >> 2) + 4 * n + (i & 3); }

struct Unit { int pm, pn, z, f; };
struct Gemm { const bf16_t* A0; const bf16_t* B0; const bf16_t* A1; const bf16_t* B1; int K; };

struct StaticOrder {
    int nM, nN, nwg, G, c;
    __host__ __device__ void init(int M_, int N_, int G_, int c_) { nM = M_ / BM; nN = N_ / BM; nwg = nM * nN; G = G_; c = c_; }
    __host__ __device__ bool next(int i, Unit& u) const {
        const long L = (long)i * G + c; if (L >= nwg) return false;
        int wgid = (int)L; { const int q = nwg / NXCD, r = nwg % NXCD, xcd = wgid % NXCD, off = wgid / NXCD; wgid = (xcd < r ? xcd * (q + 1) : r * (q + 1) + (xcd - r) * q) + off; }
        const int nig = WGM * nN, gid = wgid / nig, fm = gid * WGM, gsz = (nM - fm) < WGM ? (nM - fm) : WGM;
        u.pm = fm + ((wgid % nig) % gsz); u.pn = (wgid % nig) / gsz; u.z = 0; u.f = i & 1; return true;
    }
};
struct PairOrder {
    StaticOrder s;
    __host__ __device__ bool next(int i, Unit& u) const { const bool ok = s.next(i >> 1, u); u.z = i & 1; return ok; }
};

__device__ __forceinline__ unsigned cvt_pk_bf16(float lo, float hi) { unsigned r; asm("v_cvt_pk_bf16_f32 %0, %1, %2" : "=v"(r) : "v"(lo), "v"(hi)); return r; }
__device__ __forceinline__ float bf_lo(unsigned w) { return __uint_as_float(w << 16); }
__device__ __forceinline__ float bf_hi(unsigned w) { return __uint_as_float(w & 0xffff0000u); }
__device__ __forceinline__ float sigmoidf_(float x) { return __builtin_amdgcn_rcpf(1.0f + __builtin_amdgcn_exp2f(-x * LOG2E)); }


struct EpiIn {
    static constexpr bool PERM = true;
    unsigned char* ws;
    __device__ __forceinline__ bool keep(const Unit&) const { return false; }
    __device__ __forceinline__ void operator()(f32x4 (&acc)[2][2][4][2], const Unit& u, int wr, int wc, int fr, int fq) const {
        const int pn = u.pn; const int row0 = u.pm * BM + wr * 64 + fr;
        if (pn <= 16) {
            size_t doff; int pitch, colbase; bool rope = false;
            if (pn < 4) { doff = WS_AQ; pitch = 1024; colbase = (4 * pn + wc) * 64; rope = true; }
            else if (pn == 4) { if (wc < 2) { doff = WS_AK; pitch = 128; colbase = wc * 64; rope = true; } else { doff = WS_AV; pitch = 128; colbase = (wc - 2) * 64; } }
            else { const int t = pn - 5, seg = t >> 2, tin = t & 3; doff = WS_FQ; if (seg == 1) doff = WS_FK; if (seg == 2) doff = WS_FV; pitch = 1024; colbase = (4 * tin + wc) * 64; }
            bf16_t* dst = (bf16_t*)(ws + doff); const float* cs = (const float*)(ws + WS_CS);
#pragma unroll
            for (int ai = 0; ai < 2; ++ai) {
                f32x4 cc[4][4];
                if (rope) {
#pragma unroll
                    for (int m = 0; m < 4; ++m) { const float* cp = cs + (size_t)(row0 + ai * HALF + m * 16) * 32 + 8 * fq; const float* sp = cp + (size_t)M * 32;
                        cc[m][0] = *(const f32x4*)cp; cc[m][1] = *(const f32x4*)(cp + 4); cc[m][2] = *(const f32x4*)sp; cc[m][3] = *(const f32x4*)(sp + 4); }
                    asm volatile("" ::: "memory");
                }
#pragma unroll
                for (int m = 0; m < 4; ++m) {
                    const int row = row0 + ai * HALF + m * 16;
                    f32x4 v00 = acc[ai][0][m][0], v01 = acc[ai][0][m][1], v10 = acc[ai][1][m][0], v11 = acc[ai][1][m][1];
                    if (rope) {
                        const f32x4 c0 = cc[m][0], c1 = cc[m][1], s0 = cc[m][2], s1 = cc[m][3];
                        const f32x4 o00 = v00 * c0 - v10 * s0, o10 = v10 * c0 + v00 * s0, o01 = v01 * c1 - v11 * s1, o11 = v11 * c1 + v01 * s1;
                        v00 = o00; v10 = o10; v01 = o01; v11 = o11;
                    }
                    bf16_t* rp = dst + (size_t)row * pitch + colbase + 8 * fq;
                    u32x4 w0, w1;
                    w0.x = cvt_pk_bf16(v00[0], v00[1]); w0.y = cvt_pk_bf16(v00[2], v00[3]); w0.z = cvt_pk_bf16(v01[0], v01[1]); w0.w = cvt_pk_bf16(v01[2], v01[3]);
                    w1.x = cvt_pk_bf16(v10[0], v10[1]); w1.y = cvt_pk_bf16(v10[2], v10[3]); w1.z = cvt_pk_bf16(v11[0], v11[1]); w1.w = cvt_pk_bf16(v11[2], v11[3]);
                    *(u32x4*)rp = w0; *(u32x4*)(rp + 32) = w1;
                }
                asm volatile("" ::: "memory");
            }
        } else {
            if (wc == 0 && fq < 2) {
#pragma unroll
                for (int ai = 0; ai < 2; ++ai)
#pragma unroll
                    for (int m = 0; m < 4; ++m) {
                        float* rp = (float*)(ws + WS_FL) + (size_t)(row0 + ai * HALF + m * 16) * 16 + 8 * fq;
                        *(f32x4*)rp = acc[ai][0][m][0]; *(f32x4*)(rp + 4) = acc[ai][0][m][1];
                    }
            }
        }
    }
};

struct EpiGate {
    static constexpr bool PERM = true;
    unsigned char* G;
    __device__ __forceinline__ bool keep(const Unit&) const { return false; }
    __device__ __forceinline__ void operator()(f32x4 (&acc)[2][2][4][2], const Unit& u, int wr, int wc, int fr, int fq) const {
        const int row0 = u.pm * BM + wr * 64 + fr, col0 = u.pn * BM + wc * 32 + 8 * fq;
#pragma unroll
        for (int ai = 0; ai < 2; ++ai)
#pragma unroll
            for (int m = 0; m < 4; ++m) {
                unsigned char* rp = G + (size_t)(row0 + ai * HALF + m * 16) * 4096 + col0;
#pragma unroll
                for (int bj = 0; bj < 2; ++bj) {
                    const f32x4 a = acc[ai][bj][m][0], b = acc[ai][bj][m][1]; u32x2 w; w.x = 0u; w.y = 0u;
#pragma unroll
                    for (int i = 0; i < 4; ++i) {
                        const float qa = __builtin_amdgcn_rcpf(__builtin_fmaf(__builtin_amdgcn_exp2f(a[i] * (1.0f / 512.0f)), 1.0f / 255.0f, 1.0f / 255.0f)), qb = __builtin_amdgcn_rcpf(__builtin_fmaf(__builtin_amdgcn_exp2f(b[i] * (1.0f / 512.0f)), 1.0f / 255.0f, 1.0f / 255.0f));
                        w.x = __builtin_amdgcn_cvt_pk_u8_f32(fmaxf(qa, 1.0f), i, w.x); w.y = __builtin_amdgcn_cvt_pk_u8_f32(fmaxf(qb, 1.0f), i, w.y); }
                    *(u32x2*)(rp + bj * HALF) = w;
                }
            }
    }
};

struct EpiBranch {
    static constexpr bool PERM = true;
    const unsigned char* G; bf16_t* MG;
    __device__ __forceinline__ bool keep(const Unit& u) const { return u.z == 0; }
    __device__ __forceinline__ void operator()(f32x4 (&acc)[2][2][4][2], const Unit& u, int wr, int wc, int fr, int fq) const {
        const int row0 = u.pm * BM + wr * 64 + fr, col0 = u.pn * BM + wc * 32 + 8 * fq; const int z = u.z;
#pragma unroll
        for (int ai = 0; ai < 2; ++ai) {
            u32x2 gbv[4][2], gav[4][2];
#pragma unroll
            for (int m = 0; m < 4; ++m)
#pragma unroll
                for (int bj = 0; bj < 2; ++bj) { const unsigned char* gp = G + (size_t)(row0 + ai * HALF + m * 16) * 4096 + col0 + bj * HALF;
                    gbv[m][bj] = *(const u32x2*)(gp + 2048); if (z == 0) gav[m][bj] = *(const u32x2*)gp; }
            asm volatile("" ::: "memory");
#pragma unroll
            for (int m = 0; m < 4; ++m) {
                const size_t row = (size_t)(row0 + ai * HALF + m * 16);
#pragma unroll
                for (int bj = 0; bj < 2; ++bj) {
                    const u32x2 gb = gbv[m][bj];
                    float sb[8];
#pragma unroll
                    for (int i = 0; i < 4; ++i) { sb[i] = (float)((gb.x >> (8 * i)) & 0xffu); sb[4 + i] = (float)((gb.y >> (8 * i)) & 0xffu); }
                    if (z == 0) {
                        const u32x2 ga = gav[m][bj];
#pragma unroll
                        for (int i = 0; i < 4; ++i) {
                            acc[ai][bj][m][0][i] *= (float)((ga.x >> (8 * i)) & 0xffu) * __builtin_amdgcn_rcpf(sb[i]);
                            acc[ai][bj][m][1][i] *= (float)((ga.y >> (8 * i)) & 0xffu) * __builtin_amdgcn_rcpf(sb[4 + i]);
                        }
                    } else {
#pragma unroll
                        for (int i = 0; i < 8; ++i) sb[i] *= (1.0f / 255.0f);
                        const f32x4 a = acc[ai][bj][m][0], b = acc[ai][bj][m][1]; u32x4 w;
                        w.x = cvt_pk_bf16(a[0] * sb[0], a[1] * sb[1]); w.y = cvt_pk_bf16(a[2] * sb[2], a[3] * sb[3]);
                        w.z = cvt_pk_bf16(b[0] * sb[4], b[1] * sb[5]); w.w = cvt_pk_bf16(b[2] * sb[6], b[3] * sb[7]);
                        *(u32x4*)(MG + row * 2048 + col0 + bj * HALF) = w;
                    }
                }
            }
            asm volatile("" ::: "memory");
        }
    }
};

template <bool WRITE_BF> struct EpiRes {
    static constexpr bool PERM = false;
    const float* base; float* out; bf16_t* xb; float* ss;
    __device__ __forceinline__ bool keep(const Unit&) const { return false; }
    __device__ __forceinline__ void operator()(f32x4 (&acc)[2][2][4][2], const Unit& u, int wr, int wc, int fr, int fq) const {
        const int row0 = u.pm * BM + wr * 64 + fr, col0 = u.pn * BM + wc * 32 + 4 * fq;
#pragma unroll
        for (int ai = 0; ai < 2; ++ai) {
            f32x4 pre[4][2][2];
#pragma unroll
            for (int m = 0; m < 4; ++m)
#pragma unroll
                for (int bj = 0; bj < 2; ++bj)
#pragma unroll
                    for (int n = 0; n < 2; ++n) pre[m][bj][n] = *(const f32x4*)(base + (size_t)(row0 + ai * HALF + m * 16) * DM + col0 + bj * HALF + n * 16);
            asm volatile("" ::: "memory");
#pragma unroll
            for (int m = 0; m < 4; ++m) {
                const size_t row = (size_t)(row0 + ai * HALF + m * 16); const size_t off = row * DM + col0; float q = 0.f;
#pragma unroll
                for (int bj = 0; bj < 2; ++bj)
#pragma unroll
                    for (int n = 0; n < 2; ++n) {
                        const size_t o = off + bj * HALF + n * 16;
                        const f32x4 v = pre[m][bj][n] + acc[ai][bj][m][n];
                        *(f32x4*)(out + o) = v; q += (v[0] * v[0] + v[1] * v[1]) + (v[2] * v[2] + v[3] * v[3]);
                        if (WRITE_BF) { u32x2 w; w.x = cvt_pk_bf16(v[0], v[1]); w.y = cvt_pk_bf16(v[2], v[3]); *(u32x2*)(xb + o) = w; }
                    }
                q += __shfl_xor(q, 16); q += __shfl_xor(q, 32);
                if (fq == 0) atomicAdd(ss + row, q);
            }
            asm volatile("" ::: "memory");
        }
    }
};

struct EpiFinal {
    static constexpr bool PERM = false;
    float* out; float* ss; unsigned* cnt; const float* gain;
    __device__ __forceinline__ bool keep(const Unit&) const { return false; }
    __device__ __forceinline__ void operator()(f32x4 (&acc)[2][2][4][2], const Unit& u, int wr, int wc, int fr, int fq) const {
        const int row0 = u.pm * BM + wr * 64 + fr, col0 = u.pn * BM + wc * 32 + 4 * fq; const bool second = u.f != 0;
#pragma unroll
        for (int ai = 0; ai < 2; ++ai) {
            f32x4 pre[4][2][2];
#pragma unroll
            for (int m = 0; m < 4; ++m)
#pragma unroll
                for (int bj = 0; bj < 2; ++bj)
#pragma unroll
                    for (int n = 0; n < 2; ++n) pre[m][bj][n] = *(const f32x4*)(out + (size_t)(row0 + ai * HALF + m * 16) * DM + col0 + bj * HALF + n * 16);
            asm volatile("" ::: "memory");
#pragma unroll
            for (int m = 0; m < 4; ++m) {
                const size_t row = (size_t)(row0 + ai * HALF + m * 16); const size_t off = row * DM + col0; float q = 0.f;
#pragma unroll
                for (int bj = 0; bj < 2; ++bj)
#pragma unroll
                    for (int n = 0; n < 2; ++n) {
                        const f32x4 v = pre[m][bj][n] + acc[ai][bj][m][n]; acc[ai][bj][m][n] = v;
                        q += (v[0] * v[0] + v[1] * v[1]) + (v[2] * v[2] + v[3] * v[3]);
                        if (!second) *(f32x4*)(out + off + bj * HALF + n * 16) = v;
                    }
                q += __shfl_xor(q, 16); q += __shfl_xor(q, 32);
                if (fq == 0) atomicAdd(ss + row, q);
            }
            asm volatile("" ::: "memory");
        }
        asm volatile("s_waitcnt vmcnt(0)" ::: "memory");
        unsigned* pc = cnt + 16 * u.pm;
        if ((threadIdx.x & 63) == 0) __hip_atomic_fetch_add(pc, 1u, __ATOMIC_RELAXED, __HIP_MEMORY_SCOPE_AGENT);
        if (!second) return;
        { const unsigned long long t0 = __builtin_amdgcn_s_memrealtime();
          while ((unsigned)__builtin_amdgcn_readfirstlane(__hip_atomic_load(pc, __ATOMIC_RELAXED, __HIP_MEMORY_SCOPE_AGENT)) < 64u) {
              if (__builtin_amdgcn_s_memrealtime() - t0 > 2000000ull) break;
              __builtin_amdgcn_s_sleep(4); }
          asm volatile("" ::: "memory"); }
#pragma unroll
        for (int ai = 0; ai < 2; ++ai)
#pragma unroll
            for (int m = 0; m < 4; ++m) {
                const size_t row = (size_t)(row0 + ai * HALF + m * 16); const size_t off = row * DM + col0;
                const float rstd = __builtin_amdgcn_rsqf(__hip_atomic_load(ss + row, __ATOMIC_RELAXED, __HIP_MEMORY_SCOPE_AGENT) * (1.0f / DM) + RMS_EPS);
#pragma unroll
                for (int bj = 0; bj < 2; ++bj)
#pragma unroll
                    for (int n = 0; n < 2; ++n) {
                        const size_t o = off + bj * HALF + n * 16; const int c = col0 + bj * HALF + n * 16;
                        const f32x4 gB = *(const f32x4*)(gain + c), gA = *(const f32x4*)(gain + c - 1024), vA = *(const f32x4*)(out + o - 1024);
                        *(f32x4*)(out + o) = acc[ai][bj][m][n] * rstd * gB;
                        *(f32x4*)(out + o - 1024) = vA * rstd * gA;
                    }
            }
    }
};

template <bool BASE_BF> struct EpiResB {
    static constexpr bool PERM = true;
    const void* base; bf16_t* yb; float* ss;
    __device__ __forceinline__ bool keep(const Unit&) const { return false; }
    __device__ __forceinline__ void operator()(f32x4 (&acc)[2][2][4][2], const Unit& u, int wr, int wc, int fr, int fq) const {
        const int row0 = u.pm * BM + wr * 64 + fr, col0 = u.pn * BM + wc * 32 + 8 * fq;
#pragma unroll
        for (int ai = 0; ai < 2; ++ai) {
            f32x4 pf[4][2][2]; u32x4 pb[4][2];
#pragma unroll
            for (int m = 0; m < 4; ++m)
#pragma unroll
                for (int bj = 0; bj < 2; ++bj) { const size_t o = (size_t)(row0 + ai * HALF + m * 16) * DM + col0 + bj * HALF;
                    if (BASE_BF) pb[m][bj] = *(const u32x4*)((const bf16_t*)base + o);
                    else { pf[m][bj][0] = *(const f32x4*)((const float*)base + o); pf[m][bj][1] = *(const f32x4*)((const float*)base + o + 4); } }
            asm volatile("" ::: "memory");
#pragma unroll
            for (int m = 0; m < 4; ++m) {
                const size_t row = (size_t)(row0 + ai * HALF + m * 16); float q = 0.f;
#pragma unroll
                for (int bj = 0; bj < 2; ++bj) {
                    f32x4 x0, x1;
                    if (BASE_BF) { const u32x4 w = pb[m][bj]; x0 = (f32x4){bf_lo(w.x), bf_hi(w.x), bf_lo(w.y), bf_hi(w.y)}; x1 = (f32x4){bf_lo(w.z), bf_hi(w.z), bf_lo(w.w), bf_hi(w.w)}; }
                    else { x0 = pf[m][bj][0]; x1 = pf[m][bj][1]; }
                    const f32x4 v0 = x0 + acc[ai][bj][m][0], v1 = x1 + acc[ai][bj][m][1];
                    q += ((v0[0] * v0[0] + v0[1] * v0[1]) + (v0[2] * v0[2] + v0[3] * v0[3])) + ((v1[0] * v1[0] + v1[1] * v1[1]) + (v1[2] * v1[2] + v1[3] * v1[3]));
                    u32x4 w; w.x = cvt_pk_bf16(v0[0], v0[1]); w.y = cvt_pk_bf16(v0[2], v0[3]); w.z = cvt_pk_bf16(v1[0], v1[1]); w.w = cvt_pk_bf16(v1[2], v1[3]);
                    *(u32x4*)(yb + row * DM + col0 + bj * HALF) = w;
                }
                q += __shfl_xor(q, 16); q += __shfl_xor(q, 32);
                if (fq == 0) atomicAdd(ss + row, q);
            }
            asm volatile("" ::: "memory");
        }
    }
};

struct EpiUp {
    static constexpr bool PERM = true;
    const float* ss; bf16_t* U;
    __device__ __forceinline__ bool keep(const Unit&) const { return false; }
    __device__ __forceinline__ void operator()(f32x4 (&acc)[2][2][4][2], const Unit& u, int wr, int wc, int fr, int fq) const {
        const int row0 = u.pm * BM + wr * 64 + fr, col0 = u.pn * BM + wc * 32 + 8 * fq;
        float rs[2][4];
#pragma unroll
        for (int ai = 0; ai < 2; ++ai)
#pragma unroll
            for (int m = 0; m < 4; ++m) rs[ai][m] = ss[row0 + ai * HALF + m * 16];
        asm volatile("" ::: "memory");
#pragma unroll
        for (int ai = 0; ai < 2; ++ai)
#pragma unroll
            for (int m = 0; m < 4; ++m) {
                const size_t row = (size_t)(row0 + ai * HALF + m * 16);
                const float rstd = __builtin_amdgcn_rsqf(rs[ai][m] * (1.0f / DM) + RMS_EPS);
#pragma unroll
                for (int bj = 0; bj < 2; ++bj) {
                    f32x4 a = acc[ai][bj][m][0] * rstd, b = acc[ai][bj][m][1] * rstd; u32x4 w;
#pragma unroll
                    for (int i = 0; i < 4; ++i) { a[i] = fmaxf(a[i], 0.f); a[i] *= a[i]; b[i] = fmaxf(b[i], 0.f); b[i] *= b[i]; }
                    w.x = cvt_pk_bf16(a[0], a[1]); w.y = cvt_pk_bf16(a[2], a[3]); w.z = cvt_pk_bf16(b[0], b[1]); w.w = cvt_pk_bf16(b[2], b[3]);
                    *(u32x4*)(U + row * DFF + col0 + bj * HALF) = w;
                }
            }
    }
};

template <class Epi, class Sched, bool ALIGN_EPI = false, bool SP2 = false, bool FP8 = false>
__device__ __forceinline__ void gemm_phase(PG8_LAS unsigned char* lds, const Gemm g, const Sched& S, const Epi& E) {
    int tid_ = threadIdx.x; asm volatile("" : "+v"(tid_));
    const int tid = tid_, wid = __builtin_amdgcn_readfirstlane(tid >> 6), lane = tid & 63, wr = wid >> 2, wc = wid & 3, fr = lane & 15, fq = lane >> 4;
    const int K = g.K, nt = K / BK;
    unsigned voffA[2], voffB[2];
#pragma unroll
    for (int i = 0; i < 2; ++i) { int R, C; stage_rc(tid * 16 + i * 8192, R, C); const int Rb = Epi::PERM ? ((R & ~31) + perm32(R & 31)) : R;
        voffA[i] = (unsigned)(R * K + C) * 2u; voffB[i] = (unsigned)(Rb * K + C) * 2u; }
    const size_t kstep = (size_t)(BK * 2);
    const size_t hstep = (size_t)HALF * K * 2;
    const size_t tstep = 2 * hstep;
    const unsigned ldsw = (unsigned)wid * 1024u;
    const int aoff = lds_byte(wr * 64 + fr, fq * 8), boff = lds_byte(wc * 32 + fr, fq * 8);
#define PG8_SA(b, h) (((b) * 2 + (h)) * HTB)
#define PG8_SB(b, h) ((4 + (b) * 2 + (h)) * HTB)
#define PG8_STAGE(bufoff, gbase, voff) do { _Pragma("unroll") for (int _i = 0; _i < 2; ++_i) \
        __builtin_amdgcn_global_load_lds((const unsigned*)((const char*)(gbase) + (voff)[_i]), (PG8_LAS unsigned*)(lds + (bufoff) + ldsw + _i * 8192), 16, 0, 0); } while (0)
#define PG8_LDA(dst, b, h) do { _Pragma("unroll") for (int m = 0; m < 4; ++m) { if constexpr (FP8) { dst##8[m].lo = *(const PG8_LAS v4i_t*)(lds + PG8_SA(b, h) + aoff + m * 2048); dst##8[m].hi = *(const PG8_LAS v4i_t*)(lds + PG8_SA(b, h) + aoff + m * 2048 + 1024); } \
        else { _Pragma("unroll") for (int k = 0; k < 2; ++k) dst[m][k] = *(const PG8_LAS bf16x8*)(lds + PG8_SA(b, h) + aoff + m * 2048 + k * 1024); } } } while (0)
#define PG8_LDB(dst, b, h) do { _Pragma("unroll") for (int n = 0; n < 2; ++n) { if constexpr (FP8) { dst##8[n].lo = *(const PG8_LAS v4i_t*)(lds + PG8_SB(b, h) + boff + n * 2048); dst##8[n].hi = *(const PG8_LAS v4i_t*)(lds + PG8_SB(b, h) + boff + n * 2048 + 1024); } \
        else { _Pragma("unroll") for (int k = 0; k < 2; ++k) dst[n][k] = *(const PG8_LAS bf16x8*)(lds + PG8_SB(b, h) + boff + n * 2048 + k * 1024); } } } while (0)
#define PG8_MMA(ai, bj, At, Bt) do { __builtin_amdgcn_s_setprio(1); _Pragma("unroll") for (int m = 0; m < 4; ++m) _Pragma("unroll") for (int n = 0; n < 2; ++n) { \
        if constexpr (FP8) {   \
            asm volatile("v_mfma_scale_f32_16x16x128_f8f6f4 %0, %1, %2, %0, %3, %3 op_sel_hi:[0,0,0]" : "+v"(acc[ai][bj][m][n]) : "v"(Bt##8[n]), "v"(At##8[m]), "v"(sc1_));   \
        } else { _Pragma("unroll") for (int k = 0; k < 2; ++k) acc[ai][bj][m][n] = __builtin_amdgcn_mfma_f32_16x16x32_bf16(Bt[n][k], At[m][k], acc[ai][bj][m][n], 0, 0, 0); } } \
        __builtin_amdgcn_s_setprio(0); } while (0)
#define PG8_WAIT_V(n) asm volatile("s_waitcnt vmcnt(" #n ")" ::: "memory")
#define PG8_WAIT_L(n) asm volatile("s_waitcnt lgkmcnt(" #n ")" ::: "memory")
#define PG8_BAR __builtin_amdgcn_s_barrier()
#define PG8_SCHED __builtin_amdgcn_sched_barrier(0)
    Unit cur, nxt; int ui = 0;
    if (!S.next(0, cur)) return;
    f32x4 acc[2][2][4][2];
#pragma unroll
    for (int a = 0; a < 2; ++a)
#pragma unroll
        for (int b = 0; b < 2; ++b)
#pragma unroll
            for (int m = 0; m < 4; ++m)
#pragma unroll
                for (int n = 0; n < 2; ++n) acc[a][b][m][n] = (f32x4){0.f, 0.f, 0.f, 0.f};
    int sc1_ = 0x7f7f7f7f; asm volatile("" : "+v"(sc1_));
    bf16x8 At[4][2], B0[2][2], B1[2][2]; v8i_t At8[4], B08[2], B18[2];
    const char* cA = (const char*)(cur.z ? g.A1 : g.A0) + (size_t)cur.pm * tstep; const char* cB = (const char*)(cur.z ? g.B1 : g.B0) + (size_t)cur.pn * tstep;
    if constexpr (SP2) {
        PG8_STAGE(PG8_SB(0, 0), cB, voffB); PG8_STAGE(PG8_SB(0, 1), cB + hstep, voffB); PG8_STAGE(PG8_SA(0, 0), cA, voffA); PG8_STAGE(PG8_SA(0, 1), cA + hstep, voffA);
        if (wr == 1) PG8_BAR;
        PG8_WAIT_V(2); PG8_BAR;
        PG8_STAGE(PG8_SB(1, 0), cB + kstep, voffB); PG8_STAGE(PG8_SA(1, 0), cA + kstep, voffA); PG8_STAGE(PG8_SB(1, 1), cB + hstep + kstep, voffB);
        PG8_WAIT_V(6); PG8_BAR;
    } else {
        PG8_STAGE(PG8_SB(0, 0), cB, voffB); PG8_STAGE(PG8_SA(0, 0), cA, voffA); PG8_STAGE(PG8_SB(0, 1), cB + hstep, voffB); PG8_STAGE(PG8_SA(0, 1), cA + hstep, voffA);
        if (wr == 1) PG8_BAR;
        PG8_WAIT_V(4); PG8_BAR;
        PG8_STAGE(PG8_SB(1, 0), cB + kstep, voffB); PG8_STAGE(PG8_SA(1, 0), cA + kstep, voffA); PG8_STAGE(PG8_SB(1, 1), cB + hstep + kstep, voffB);
        PG8_WAIT_V(6); PG8_BAR;
    }
    for (;;) {
        const bool has_next = S.next(ui + 1, nxt);
        const char* nA = has_next ? (const char*)(nxt.z ? g.A1 : g.A0) + (size_t)nxt.pm * tstep : cA; const char* nB = has_next ? (const char*)(nxt.z ? g.B1 : g.B0) + (size_t)nxt.pn * tstep : cB;
        for (int t = 0; t < nt; t += 2) {
            const bool last = (t == nt - 2);
            const char* a1 = cA + (size_t)(t + 1) * kstep;
            const char* a2 = last ? nA : cA + (size_t)(t + 2) * kstep; const char* b2 = last ? nB : cB + (size_t)(t + 2) * kstep;
            const char* a3 = a2 + kstep; const char* b3 = b2 + kstep;
            if constexpr (SP2) {
            PG8_LDB(B0, 0, 0); PG8_LDB(B1, 0, 1); PG8_SCHED; PG8_LDA(At, 0, 0); PG8_STAGE(PG8_SA(1, 1), a1 + hstep, voffA);
            PG8_WAIT_V(8); PG8_WAIT_L(0); PG8_BAR; PG8_MMA(0, 0, At, B0); PG8_MMA(0, 1, At, B1); PG8_BAR; PG8_SCHED;
            PG8_LDA(At, 0, 1); PG8_STAGE(PG8_SB(0, 0), b2, voffB); PG8_STAGE(PG8_SB(0, 1), b2 + hstep, voffB); PG8_STAGE(PG8_SA(0, 0), a2, voffA);
            PG8_WAIT_V(8); PG8_WAIT_L(0); PG8_BAR; PG8_MMA(1, 0, At, B0); PG8_MMA(1, 1, At, B1); PG8_BAR; PG8_SCHED;
            PG8_LDB(B0, 1, 0); PG8_LDB(B1, 1, 1); PG8_SCHED; PG8_LDA(At, 1, 0); PG8_STAGE(PG8_SA(0, 1), a2 + hstep, voffA);
            PG8_WAIT_V(8); PG8_WAIT_L(0); PG8_BAR; PG8_MMA(0, 0, At, B0); PG8_MMA(0, 1, At, B1); PG8_BAR; PG8_SCHED;
            PG8_LDA(At, 1, 1); PG8_STAGE(PG8_SB(1, 0), b3, voffB); PG8_STAGE(PG8_SB(1, 1), b3 + hstep, voffB); PG8_STAGE(PG8_SA(1, 0), a3, voffA);
            PG8_WAIT_V(8); PG8_WAIT_L(0); PG8_BAR; PG8_MMA(1, 0, At, B0); PG8_MMA(1, 1, At, B1); PG8_BAR; PG8_SCHED;
            } else {
            PG8_LDB(B0, 0, 0); PG8_SCHED; PG8_LDA(At, 0, 0); PG8_STAGE(PG8_SA(1, 1), a1 + hstep, voffA);
            PG8_WAIT_L(8); PG8_BAR; PG8_WAIT_L(0); PG8_MMA(0, 0, At, B0); PG8_BAR; PG8_SCHED;
            PG8_LDB(B1, 0, 1); PG8_STAGE(PG8_SB(0, 0), b2, voffB);
            PG8_BAR; PG8_WAIT_L(0); PG8_MMA(0, 1, At, B1); PG8_BAR;
            PG8_LDA(At, 0, 1); PG8_STAGE(PG8_SA(0, 0), a2, voffA);
            PG8_BAR; PG8_WAIT_L(0); PG8_MMA(1, 0, At, B0); PG8_BAR; PG8_SCHED;
            PG8_STAGE(PG8_SB(0, 1), b2 + hstep, voffB);
            PG8_WAIT_V(6); PG8_BAR; PG8_MMA(1, 1, At, B1); PG8_BAR;
            PG8_LDB(B0, 1, 0); PG8_SCHED; PG8_LDA(At, 1, 0); PG8_STAGE(PG8_SA(0, 1), a2 + hstep, voffA);
            PG8_WAIT_L(8); PG8_BAR; PG8_WAIT_L(0); PG8_MMA(0, 0, At, B0); PG8_BAR; PG8_SCHED;
            PG8_LDB(B1, 1, 1); PG8_STAGE(PG8_SB(1, 0), b3, voffB);
            PG8_BAR; PG8_WAIT_L(0); PG8_MMA(0, 1, At, B1); PG8_BAR;
            PG8_LDA(At, 1, 1); PG8_STAGE(PG8_SA(1, 0), a3, voffA);
            PG8_BAR; PG8_WAIT_L(0); PG8_MMA(1, 0, At, B0); PG8_BAR; PG8_SCHED;
            PG8_STAGE(PG8_SB(1, 1), b3 + hstep, voffB);
            PG8_WAIT_V(6); PG8_BAR; PG8_MMA(1, 1, At, B1); PG8_BAR;
            }
        }
        if constexpr (ALIGN_EPI) { if (wr == 0) PG8_BAR; }
        if constexpr (FP8) asm volatile("s_nop 15\n\ts_nop 7" ::: "memory");
        E(acc, cur, wr, wc, fr, fq);
        if (!has_next) break;
        if (!E.keep(cur))
#pragma unroll
        for (int a = 0; a < 2; ++a)
#pragma unroll
            for (int b = 0; b < 2; ++b)
#pragma unroll
                for (int m = 0; m < 4; ++m)
#pragma unroll
                    for (int n = 0; n < 2; ++n) acc[a][b][m][n] = (f32x4){0.f, 0.f, 0.f, 0.f};
        cur = nxt; cA = nA; cB = nB; ++ui;
        if constexpr (ALIGN_EPI) { if (wr == 1) PG8_BAR; }
    }
    PG8_WAIT_V(0);
    if constexpr (!ALIGN_EPI) { if (wr == 0) PG8_BAR; }
    PG8_BAR;
#undef PG8_SA
#undef PG8_SB
#undef PG8_STAGE
#undef PG8_LDA
#undef PG8_LDB
#undef PG8_MMA
#undef PG8_WAIT_V
#undef PG8_WAIT_L
#undef PG8_BAR
#undef PG8_SCHED
}
}


namespace attn_body {
using bf16=unsigned short;
using bf16x8=__attribute__((ext_vector_type(8)))short;
using s16x4=__attribute__((ext_vector_type(4)))short;
using f32x16=__attribute__((ext_vector_type(16)))float;
using u32x4=__attribute__((ext_vector_type(4)))unsigned;
using f32x4v=__attribute__((ext_vector_type(4)))float;
constexpr int BATCH=4,NHEAD=16,SEQ=8192,D=64,DM=NHEAD*D;
constexpr int NW=8,QBLK=32,QB=QBLK*NW,KVBLK=64,NQB=SEQ/QB;
constexpr int ATTN_PITCH=DM, ATTN_UNIT_ROWS=QB;
__device__ __forceinline__ int crow(int r,int hi){return (r&3)+8*(r>>2)+4*hi;}
#define SBAR() __builtin_amdgcn_sched_barrier(0)
template<bool SWA> __device__ __forceinline__ void cmask(f32x16&p0,f32x16&p1,int jb,int qrel,int hi){
  const float NEG=-INFINITY; int kb=64*jb+4*hi;
  #pragma unroll
  for(int r=0;r<16;++r){int kv=kb+(r&3)+8*(r>>2);
    if(SWA){ if(kv>qrel||kv<=qrel-128)p0[r]=NEG; if(kv+32>qrel||kv+32<=qrel-128)p1[r]=NEG; }
    else{ if(kv>qrel)p0[r]=NEG; if(kv+32>qrel)p1[r]=NEG; } }
}

constexpr int NSLOT=3, SLOTB=8192;
#ifndef NVB
#define NVB 8
#endif
constexpr int LDS_K=0, LDS_V=NSLOT*SLOTB, LDS_WS=2*NSLOT*SLOTB, LDS_OST=LDS_WS+NW*64*4, LDS_CB=LDS_OST+NW*4096, LDS_BYTES=LDS_CB+4*256;
constexpr float C2=0.125f*1.4426950408889634f;
__device__ __forceinline__ void glds16(const void*gsrc,unsigned lds_dst){unsigned keep;
  asm volatile("s_mov_b32 %0, m0\n\ts_mov_b32 m0, %2\n\ts_nop 0\n\tglobal_load_lds_dwordx4 %1, off\n\ts_mov_b32 m0, %0":"=&s"(keep):"v"(gsrc),"s"(lds_dst):"memory");}
__device__ __forceinline__ void glds4(const void*gsrc,unsigned lds_dst){unsigned keep;
  asm volatile("s_mov_b32 %0, m0\n\ts_mov_b32 m0, %2\n\ts_nop 0\n\tglobal_load_lds_dword %1, off\n\ts_mov_b32 m0, %0":"=&s"(keep):"v"(gsrc),"s"(lds_dst):"memory");}
__device__ __forceinline__ float max3f(float a,float b,float c){float r;asm("v_max3_f32 %0, %1, %2, %3":"=v"(r):"v"(a),"v"(b),"v"(c));return r;}
__device__ __forceinline__ float max2f(float a,float b){float r;asm("v_max_f32_e32 %0, %1, %2":"=v"(r):"v"(a),"v"(b));return r;}
__device__ __forceinline__ float fadd_s(float a,float b){float r;asm("v_add_f32_e32 %0, %1, %2":"=v"(r):"v"(a),"v"(b));return r;}
__device__ __forceinline__ float fsub_s(float a,float b){float r;asm("v_sub_f32_e32 %0, %1, %2":"=v"(r):"v"(a),"v"(b));return r;}
typedef float f32x2_t __attribute__((ext_vector_type(2))); typedef __bf16 bf16x2_t __attribute__((ext_vector_type(2)));
__device__ __forceinline__ unsigned cvtpk_s(float lo,float hi){f32x2_t v={lo,hi};bf16x2_t b=__builtin_convertvector(v,bf16x2_t);return __builtin_bit_cast(unsigned,b);}
#define WAIT_BAR(N) asm volatile("s_waitcnt vmcnt(" #N ") lgkmcnt(0)\n\ts_barrier":::"memory")

__device__ __forceinline__ void qkt(f32x16&p0,f32x16&p1,const char*Kslot,const bf16x8*qr,int r32,int hi){
  const char*kb=Kslot+hi*1024+r32*16;
  #pragma unroll
  for(int d0=0;d0<4;++d0){
    const bf16x8 b0=*reinterpret_cast<const bf16x8*>(kb+d0*2048);
    const bf16x8 b1=*reinterpret_cast<const bf16x8*>(kb+d0*2048+512);
    {p0=__builtin_amdgcn_mfma_f32_32x32x16_bf16(b0,qr[d0],p0,0,0,0);p1=__builtin_amdgcn_mfma_f32_32x32x16_bf16(b1,qr[d0],p1,0,0,0);}}
}
typedef __attribute__((address_space(3))) const char* lds_cptr;
typedef short v4i16_t __attribute__((ext_vector_type(4)));
__device__ __forceinline__ void kload8(bf16x8*kf,lds_cptr kp){
  kf[0]=*(const __attribute__((address_space(3))) bf16x8*)(kp);      kf[1]=*(const __attribute__((address_space(3))) bf16x8*)(kp+512);
  kf[2]=*(const __attribute__((address_space(3))) bf16x8*)(kp+2048); kf[3]=*(const __attribute__((address_space(3))) bf16x8*)(kp+2560);
  kf[4]=*(const __attribute__((address_space(3))) bf16x8*)(kp+4096); kf[5]=*(const __attribute__((address_space(3))) bf16x8*)(kp+4608);
  kf[6]=*(const __attribute__((address_space(3))) bf16x8*)(kp+6144); kf[7]=*(const __attribute__((address_space(3))) bf16x8*)(kp+6656);
}
__device__ __forceinline__ void kload2(bf16x8*kf,lds_cptr kp,int j){ kf[2*j]=*(const __attribute__((address_space(3))) bf16x8*)(kp+j*2048); kf[2*j+1]=*(const __attribute__((address_space(3))) bf16x8*)(kp+j*2048+512); }
__device__ __forceinline__ s16x4 vtr(lds_cptr p){ return __builtin_bit_cast(s16x4,__builtin_amdgcn_ds_read_tr16_b64_v4i16((__attribute__((address_space(3))) v4i16_t*)p)); }
__device__ __forceinline__ float rowmax(const f32x16&p0,const f32x16&p1){
  float a=max3f(p0[0],p0[1],p1[0]),b=max3f(p0[2],p0[3],p1[1]);a=max3f(a,p1[2],p1[3]);
  #pragma unroll
  for(int r=4;r<16;r+=4){a=max3f(a,p0[r],p0[r+1]);b=max3f(b,p0[r+2],p0[r+3]);a=max3f(a,p1[r],p1[r+1]);b=max3f(b,p1[r+2],p1[r+3]);}
  const float m=max2f(a,b);
  auto rr=__builtin_amdgcn_permlane32_swap(__float_as_uint(m),__float_as_uint(m),false,false);
  return max2f(__uint_as_float(rr[0]),__uint_as_float(rr[1]));
}
__device__ __forceinline__ void pv(f32x16*o,int vb,bf16x8 pa0,bf16x8 pa1,bf16x8 pa2,bf16x8 pa3){
  #pragma unroll
  for(int d0=0;d0<2;++d0){s16x4 lo[4],hi[4];
    #pragma unroll
    for(int ks=0;ks<4;++ks){
      asm volatile("ds_read_b64_tr_b16 %0,%1 offset:%c2":"=&v"(lo[ks]):"v"(vb),"i"(d0*4096+ks*1024):"memory");
      asm volatile("ds_read_b64_tr_b16 %0,%1 offset:%c2":"=&v"(hi[ks]):"v"(vb),"i"(d0*4096+ks*1024+512):"memory");}
    asm volatile("s_waitcnt lgkmcnt(0)":::"memory");SBAR();
    #define PK(k) (bf16x8){lo[k][0],lo[k][1],lo[k][2],lo[k][3],hi[k][0],hi[k][1],hi[k][2],hi[k][3]}
    o[d0]=__builtin_amdgcn_mfma_f32_32x32x16_bf16(pa0,PK(0),o[d0],0,0,0);
    o[d0]=__builtin_amdgcn_mfma_f32_32x32x16_bf16(pa1,PK(1),o[d0],0,0,0);
    o[d0]=__builtin_amdgcn_mfma_f32_32x32x16_bf16(pa2,PK(2),o[d0],0,0,0);
    o[d0]=__builtin_amdgcn_mfma_f32_32x32x16_bf16(pa3,PK(3),o[d0],0,0,0);
    #undef PK
  }
}

typedef __attribute__((address_space(3))) const f32x4v* lds_f4ptr;
__device__ __forceinline__ void fill_bias(f32x16&c0,f32x16&c1,lds_cptr cb,float negmh){
  #pragma unroll
  for(int g=0;g<4;++g){ const f32x4v v=*(lds_f4ptr)(cb+g*32), w=*(lds_f4ptr)(cb+128+g*32);
    #pragma unroll
    for(int i=0;i<4;i+=2){ const f32x2_t nm={negmh,negmh}; const f32x2_t a=nm-(f32x2_t){v[i],v[i+1]}, b=nm-(f32x2_t){w[i],w[i+1]}; c0[4*g+i]=a.x; c0[4*g+i+1]=a.y; c1[4*g+i]=b.x; c1[4*g+i+1]=b.y; } }
}
#ifndef ATTN_STORE16
#define ATTN_STORE16(p,v) (*(u32x4*)(p)=(v))
#endif
template<int THRL,bool FOX,int KP> __device__ __forceinline__ void attn_unit(int b,int h,int qb,const bf16*Q,const bf16*__restrict__ K,const bf16*__restrict__ V,bf16*O,const float*__restrict__ Cb,float sink2,char*shm){
  int tid_=threadIdx.x; asm volatile("":"+v"(tid_));
  const int tid=tid_,lane=tid&63,r32=lane&31,hi=lane>>5; const int wid=__builtin_amdgcn_readfirstlane(tid>>6);
  const long rowbase=(long)b*SEQ; const int q0=qb*QB;
  const bf16*Qw=Q+(rowbase+q0+wid*QBLK)*DM+h*D;
  const int kvh=FOX?h:(h>>3); const int T0=FOX?0:(qb==0?0:4*qb-2);
  const bf16*Kh=K+(rowbase+(long)T0*KVBLK)*KP+kvh*D,*Vh=V+(rowbase+(long)T0*KVBLK)*KP+kvh*D; const float*Cs=FOX?Cb+lane:nullptr;
  const unsigned lds0=(unsigned)(uintptr_t)shm;
  float*wsf=(float*)(shm+LDS_WS)+wid*64;
  const bf16*ksrc=Kh+(long)lane*KP+wid*8;
  const bf16*vsrc=Vh+(long)(16*(wid&3)+(lane>>2))*KP+(wid>>2)*32+(lane&3)*8;
  const unsigned kdst=lds0+LDS_K+wid*1024, vdst=lds0+LDS_V+wid*1024;
  #define DMA_K(t,slot) glds16(ksrc+(long)(t)*KVBLK*KP,(unsigned)__builtin_amdgcn_readfirstlane(kdst+(slot)))
  #define DMA_C(t) do{ if(FOX) glds4(Cs+(long)(t)*KVBLK,(unsigned)__builtin_amdgcn_readfirstlane(lds0+LDS_CB+(((t)&3)<<8))); }while(0)
  #define PREFILL(X0,X1,t) do{ if(FOX){ fill_bias(X0,X1,cb0+(((t)&3)<<8),-mhat); } else { _Pragma("unroll") for(int r=0;r<16;++r){X0[r]=-mhat;X1[r]=-mhat;} } }while(0)
  #define DMA_V(t,slot) glds16(vsrc+(long)(t)*KVBLK*KP,(unsigned)__builtin_amdgcn_readfirstlane(vdst+(slot)))
  const int vb0=(int)(lds0+LDS_V)+((lane>>4)&1)*32+(lane&3)*8+(4*hi+((lane&15)>>2))*64;
  const char*Kbase=shm+LDS_K; bf16x8 kf[8];
  const lds_cptr shm3=(lds_cptr)shm; const lds_cptr cb0=shm3+LDS_CB+hi*16; const lds_cptr kp0=shm3+LDS_K+hi*1024+r32*16; const lds_cptr vp0=shm3+LDS_V+((lane>>4)&1)*32+(lane&3)*8+(4*hi+((lane&15)>>2))*64;
  const int NT=FOX?(q0+QB)/KVBLK:(qb==0?4:6);
  DMA_K(0,0);DMA_C(0);DMA_V(0,0);DMA_K(1,SLOTB);DMA_C(1);
  bf16x8 qr[4];
  #pragma unroll
  for(int d0=0;d0<4;++d0)qr[d0]=*reinterpret_cast<const bf16x8*>(&Qw[(long)r32*DM+d0*16+hi*8]);
  float mhat=FOX?-Cb[q0+wid*QBLK+r32]:0.f,l_reg=0.f;    f32x16 o[2];o[0]=f32x16{};o[1]=f32x16{};
  const int qrel=wid*QBLK+r32;
  #define CMASK(P0,P1,t) do{int jb_=(t)-(NT-4); if(!FOX||jb_>=0)cmask<!FOX>(P0,P1,jb_,qrel,hi);}while(0)
  bool resc=false;
  #define START(P0,P1) do{ float rm=__builtin_fmaxf(rowmax(P0,P1),0.f); resc=false;     \
    { const float dl=rm; mhat=fadd_s(mhat,dl); \
      _Pragma("unroll") for(int r=0;r<16;++r){P0[r]=fsub_s(P0[r],dl);P1[r]=fsub_s(P1[r],dl);} } \
    _Pragma("unroll") for(int r=0;r<16;++r)P0[r]=__builtin_amdgcn_exp2f(P0[r]); }while(0)
  #define RESC() do{ if(resc){ asm volatile("s_waitcnt lgkmcnt(0)":::"memory"); \
      _Pragma("unroll") for(int d_=0;d_<2;++d_) _Pragma("unroll") for(int r=0;r<16;++r)o[d_][r]*=wsf[crow(r,hi)]; } }while(0)
  f32x16 pA0,pA1,pB0,pB1;
  int sl_prev=0,sl_cur=0,sl_next=SLOTB;
  #define ROT() do{sl_prev=sl_cur;sl_cur=sl_next;sl_next=(sl_next==(NSLOT-1)*SLOTB)?0:sl_next+SLOTB;}while(0)
  DMA_K(2,2*SLOTB);DMA_C(2);
  if(FOX){WAIT_BAR(5);}else{WAIT_BAR(3);}
  PREFILL(pA0,pA1,0); qkt(pA0,pA1,Kbase,qr,r32,hi);asm volatile("s_nop 15\n\ts_nop 7":"+v"(pA0),"+v"(pA1));CMASK(pA0,pA1,0);
  START(pA0,pA1);
  _Pragma("unroll") for(int r=0;r<16;++r)pA1[r]=__builtin_amdgcn_exp2f(pA1[r]);
  WAIT_BAR(0);
  DMA_K(3,0);DMA_C(3);DMA_V(1,SLOTB);
  ROT();
  kload8(kf,kp0+sl_cur);
  PREFILL(pB0,pB1,1); if(FOX){ WAIT_BAR(3); }else{ WAIT_BAR(2); }
  s16x4 vlo[NVB],vhi[NVB]; u32x4 pw0,pw1,pw2,pw3;
  #define PKW(P,B) cvtpk_s(P[B],P[B+1])
  #define PAF(k) __builtin_bit_cast(bf16x8,pw##k)
  #define VFR(j) (bf16x8){vlo[(j)%NVB][0],vlo[(j)%NVB][1],vlo[(j)%NVB][2],vlo[(j)%NVB][3],vhi[(j)%NVB][0],vhi[(j)%NVB][1],vhi[(j)%NVB][2],vhi[(j)%NVB][3]}
  #define PIN(x) asm volatile("":"+v"(x))
  #define MX3(a,b,c) __builtin_fmaxf(__builtin_fmaxf((a),(b)),(c))
  #define GAPA(MF,A0,A1,A2,A3,W0,W1,PW) do{ MF; sacc+=(f32x2_t){A0,A1}; sacc+=(f32x2_t){A2,A3}; PIN(sacc); W0; W1; PIN(PW); SBAR(); }while(0)
  #define EX(v) __builtin_amdgcn_exp2f(v)
  #define GAPB(MF,VR,BX_,X,B) do{ MF; VR; BX_; X[B]=EX(X[B]); X[B+1]=EX(X[B+1]); X[B+2]=EX(X[B+2]); X[B+3]=EX(X[B+3]); PIN(X); SBAR(); }while(0)
  #define VOFF(j) ((((j)&1)*4096)+(((j)>>1)*1024))
  #define VRD(j) do{ if((j)>=0&&(j)<8){ vlo[(j)%NVB]=vtr(vp_+VOFF(j)); vhi[(j)%NVB]=vtr(vp_+VOFF(j)+512); } }while(0)
  #define KRD(G,j) do{ if(G){ kload2(kf,kp0+sl_next,j); SBAR(); } }while(0)
  #define BSUBX(X,g) do{ const f32x2_t nm_={nmh_,nmh_}; const f32x2_t a_=nm_-(f32x2_t){bt[0],bt[1]}, b_=nm_-(f32x2_t){bt[2],bt[3]}; X[4*(g)+0]=a_.x; X[4*(g)+1]=a_.y; X[4*(g)+2]=b_.x; X[4*(g)+3]=b_.y; }while(0)
  #define BXX(Y0,Y1,j,G) do{ if(FOX&&(G)){ if((j)>=1&&(j)<=4){BSUBX(Y0,((j)-1)&3);} if((j)>=5){BSUBX(Y1,((j)-5)&3);} if((j)<8){ bt=*(lds_f4ptr)(cbn_+(((j)&3)*32+((j)>>2)*128)); } } }while(0)
  #define STEP(C0,C1,P0,P1,t,GK,GV,GL) do{ SBAR(); f32x4v bt; const lds_cptr cbn_=cb0+((((t)+1)&3)<<8); \
    const lds_cptr vp_=vp0+sl_prev; \
    VRD(0-(8-NVB)); SBAR(); f32x2_t sacc={P0[0],P0[1]}; \
    GAPA(C0=__builtin_amdgcn_mfma_f32_32x32x16_bf16(kf[0],qr[0],C0,0,0,0), P0[2],P0[3],P0[4],P0[5],     pw0[0]=PKW(P0,0), pw0[1]=PKW(P0,2), pw0); \
    VRD(1-(8-NVB)); SBAR(); GAPA(C1=__builtin_amdgcn_mfma_f32_32x32x16_bf16(kf[1],qr[0],C1,0,0,0), P0[6],P0[7],P0[8],P0[9],     pw0[2]=PKW(P0,4), pw0[3]=PKW(P0,6), pw0); \
    VRD(2-(8-NVB)); SBAR(); GAPA(C0=__builtin_amdgcn_mfma_f32_32x32x16_bf16(kf[2],qr[1],C0,0,0,0),   P0[10],P0[11],P0[12],P0[13], pw1[0]=PKW(P0,8), pw1[1]=PKW(P0,10), pw1); \
    VRD(3-(8-NVB)); SBAR(); GAPA(C1=__builtin_amdgcn_mfma_f32_32x32x16_bf16(kf[3],qr[1],C1,0,0,0),   P0[14],P0[15],P1[0],P1[1],   pw1[2]=PKW(P0,12),pw1[3]=PKW(P0,14), pw1); \
    VRD(4-(8-NVB)); SBAR(); GAPA(C0=__builtin_amdgcn_mfma_f32_32x32x16_bf16(kf[4],qr[2],C0,0,0,0),   P1[2],P1[3],P1[4],P1[5],     pw2[0]=PKW(P1,0), pw2[1]=PKW(P1,2), pw2); \
    VRD(5-(8-NVB)); SBAR(); GAPA(C1=__builtin_amdgcn_mfma_f32_32x32x16_bf16(kf[5],qr[2],C1,0,0,0),   P1[6],P1[7],P1[8],P1[9],     pw2[2]=PKW(P1,4), pw2[3]=PKW(P1,6), pw2); \
    VRD(6-(8-NVB)); SBAR(); GAPA(C0=__builtin_amdgcn_mfma_f32_32x32x16_bf16(kf[6],qr[3],C0,0,0,0),   P1[10],P1[11],P1[12],P1[13], pw3[0]=PKW(P1,8), pw3[1]=PKW(P1,10), pw3); \
    VRD(7-(8-NVB)); SBAR(); GAPA(C1=__builtin_amdgcn_mfma_f32_32x32x16_bf16(kf[7],qr[3],C1,0,0,0),   P1[14],P1[15],0.f,0.f,       pw3[2]=PKW(P1,12),pw3[3]=PKW(P1,14), pw3); \
    l_reg+=sacc.x+sacc.y; \
    if(GK){DMA_K((t)+3,sl_cur);DMA_C((t)+3);} if(GV){DMA_V((t)+1,sl_next);} \
    CMASK(C0,C1,t); \
    { float a=MX3(C0[0],C0[1],C1[0]),b=MX3(C0[2],C0[3],C1[1]); a=MX3(a,C1[2],C1[3]); \
      _Pragma("unroll") for(int r=4;r<16;r+=4){a=MX3(a,C0[r],C0[r+1]);b=MX3(b,C0[r+2],C0[r+3]);a=MX3(a,C1[r],C1[r+1]);b=MX3(b,C1[r+2],C1[r+3]);} \
      float rm=__builtin_fmaxf(a,b); { auto rr=__builtin_amdgcn_permlane32_swap(__float_as_uint(rm),__float_as_uint(rm),false,false); rm=__builtin_fmaxf(__uint_as_float(rr[0]),__uint_as_float(rr[1])); } \
      resc=false; \
      if(__builtin_expect(__any(rm>(float)THRL),0)){ const float dl=__builtin_fmaxf(rm,0.f); mhat+=dl; \
        _Pragma("unroll") for(int r=0;r<16;++r){C0[r]-=dl;C1[r]-=dl;} \
        const float f=__builtin_amdgcn_exp2f(-dl); l_reg*=f; if(hi==0)wsf[r32]=f; resc=true; } } \
    const float nmh_=-mhat; SBAR(); \
    GAPB(o[0]=__builtin_amdgcn_mfma_f32_32x32x16_bf16(PAF(0),VFR(0),o[0],0,0,0), VRD(0+NVB), BXX(P0,P1,0,GL), C0,0); \
    GAPB(o[1]=__builtin_amdgcn_mfma_f32_32x32x16_bf16(PAF(0),VFR(1),o[1],0,0,0), VRD(1+NVB), BXX(P0,P1,1,GL), C0,4); \
    KRD(GL,0); GAPB(o[0]=__builtin_amdgcn_mfma_f32_32x32x16_bf16(PAF(1),VFR(2),o[0],0,0,0), VRD(2+NVB), BXX(P0,P1,2,GL), C0,8); \
    KRD(GL,1); GAPB(o[1]=__builtin_amdgcn_mfma_f32_32x32x16_bf16(PAF(1),VFR(3),o[1],0,0,0), VRD(3+NVB), BXX(P0,P1,3,GL), C0,12); \
    KRD(GL,2); GAPB(o[0]=__builtin_amdgcn_mfma_f32_32x32x16_bf16(PAF(2),VFR(4),o[0],0,0,0), VRD(4+NVB), BXX(P0,P1,4,GL), C1,0); \
    KRD(GL,3); GAPB(o[1]=__builtin_amdgcn_mfma_f32_32x32x16_bf16(PAF(2),VFR(5),o[1],0,0,0), VRD(5+NVB), BXX(P0,P1,5,GL), C1,4); \
    GAPB(o[0]=__builtin_amdgcn_mfma_f32_32x32x16_bf16(PAF(3),VFR(6),o[0],0,0,0), VRD(6+NVB), BXX(P0,P1,6,GL), C1,8); \
    GAPB(o[1]=__builtin_amdgcn_mfma_f32_32x32x16_bf16(PAF(3),VFR(7),o[1],0,0,0), VRD(7+NVB), BXX(P0,P1,7,GL), C1,12); \
    BXX(P0,P1,8,GL); if(!FOX&&(GL)){ PREFILL(P0,P1,(t)+1); } \
    }while(0)
  int t=1;
  #undef CMASK
  #define CMASK(P0,P1,t) do{}while(0)
  for(;t+5<NT;t+=2){
    STEP(pB0,pB1,pA0,pA1,t,true,true,true);     if(FOX){WAIT_BAR(3);}else{WAIT_BAR(2);} RESC(); ROT();
    STEP(pA0,pA1,pB0,pB1,t+1,true,true,true);   if(FOX){WAIT_BAR(3);}else{WAIT_BAR(2);} RESC(); ROT();
  }
  #undef CMASK
  #define CMASK(P0,P1,t) do{int jb_=(t)-(NT-4); if(!FOX||jb_>=0)cmask<!FOX>(P0,P1,jb_,qrel,hi);}while(0)
  #define ENDW(tt) do{ if((tt)+3<NT){ if(FOX){WAIT_BAR(3);}else{WAIT_BAR(2);} } else if((tt)+2<NT){WAIT_BAR(1);} else {WAIT_BAR(0);} }while(0)
  for(;t+1<NT;t+=2){
    STEP(pB0,pB1,pA0,pA1,t,(t+3<NT),(t+1<NT),(t+1<NT));       ENDW(t);   RESC(); ROT();
    STEP(pA0,pA1,pB0,pB1,t+1,(t+4<NT),(t+2<NT),(t+2<NT));     ENDW(t+1); RESC(); ROT();
  }
  STEP(pB0,pB1,pA0,pA1,NT-1,false,false,false); RESC();
  { float sacc=pB0[0]+pB0[1]; _Pragma("unroll") for(int r=2;r<16;++r)sacc+=pB0[r]; _Pragma("unroll") for(int r=0;r<16;++r)sacc+=pB1[r]; l_reg+=sacc;
    pw0=(u32x4){PKW(pB0,0),PKW(pB0,2),PKW(pB0,4),PKW(pB0,6)};pw1=(u32x4){PKW(pB0,8),PKW(pB0,10),PKW(pB0,12),PKW(pB0,14)};pw2=(u32x4){PKW(pB1,0),PKW(pB1,2),PKW(pB1,4),PKW(pB1,6)};pw3=(u32x4){PKW(pB1,8),PKW(pB1,10),PKW(pB1,12),PKW(pB1,14)};
    SBAR(); pv(o,vb0+sl_cur,PAF(0),PAF(1),PAF(2),PAF(3)); }
  #undef PKW
  #undef PAF
  #undef VFR
  #undef PIN
  #undef MX3
  #undef GAPA
  #undef GAPB
  #undef EX
  #undef VRD
  #undef VOFF
  #undef KRD
  #undef STEP
  #undef ENDW
  {auto rr=__builtin_amdgcn_permlane32_swap(__float_as_uint(l_reg),__float_as_uint(l_reg),false,false);l_reg=__uint_as_float(rr[0])+__uint_as_float(rr[1]);}
  if(!FOX) l_reg+=__builtin_amdgcn_exp2f(sink2-mhat);
  if(hi==0)wsf[32+r32]=l_reg;asm volatile("s_waitcnt lgkmcnt(0)":::"memory");
  float rli[16];
  #pragma unroll
  for(int r=0;r<16;++r)rli[r]=__builtin_amdgcn_rcpf(wsf[32+crow(r,hi)]);
  bf16*Ow=O+(rowbase+q0+wid*QBLK)*DM+h*D;
  { bf16*stg=(bf16*)(shm+LDS_OST)+wid*2048;
    #pragma unroll
    for(int r=0;r<16;++r){const int orow=crow(r,hi);
      #pragma unroll
      for(int d0=0;d0<2;++d0)stg[orow*64+d0*32+r32]=(bf16)(cvtpk_s(o[d0][r]*rli[r],0.f)&0xffffu);}
    asm volatile("s_waitcnt lgkmcnt(0)":::"memory");
    #pragma unroll
    for(int i=0;i<4;++i){const int row=i*8+(lane>>3),ch=lane&7; const u32x4 v=*(const u32x4*)(stg+row*64+ch*8); ATTN_STORE16(Ow+(long)row*DM+ch*8,v);} }
  asm volatile("s_waitcnt lgkmcnt(0)\n\ts_barrier":::"memory");
  #undef DMA_K
  #undef DMA_V
  #undef DMA_C
  #undef PREFILL
  #undef BSUBX
  #undef BXX
  #undef CMASK
  #undef START
  #undef RESC
  #undef ROT
}
constexpr int ATTN_LDS_BYTES=LDS_BYTES;
#undef SBAR
#undef WAIT_BAR
}

#ifndef REP_PHASE
#define REP_PHASE 0
#endif
#ifndef FUSED_FINAL
#define FUSED_FINAL 0
#endif
#ifndef NAIVE_SWA
#define NAIVE_SWA 0
#endif
#ifndef NAIVE_FOX
#define NAIVE_FOX 0
#endif
#define LAS __attribute__((address_space(3)))
typedef unsigned short bf16;
typedef float f32x4 __attribute__((ext_vector_type(4)));
typedef unsigned v4u __attribute__((ext_vector_type(4)));
typedef unsigned v2u __attribute__((ext_vector_type(2)));
constexpr int NWAVES = 8;
constexpr int RING_BYTES = 131072, LDS_BYTES = 147456;

__device__ __forceinline__ float wave_sum(float v) {
#pragma unroll
    for (int o = 1; o < 64; o <<= 1) v += __shfl_xor(v, o);
    return v;
}
#define LDS_WAIT() asm volatile("s_waitcnt lgkmcnt(0)" ::: "memory")

#define XB_TMO      128
#define XB_XCNT(j)  (256  + 64 * (j))
#define XB_XSUB(j)  (1280 + 64 * (j))
#define XB_XGEN(j)  (2304 + 64 * (j))
#define XB_TOP      3328
#define XB_TOPGEN   3392
#define XCD_BAR_WORDS 3456
#define XB_SPIN_CAP (1u << 18)

__device__ __forceinline__ unsigned xb_ld(unsigned* p)              { return __hip_atomic_load(p, __ATOMIC_RELAXED, __HIP_MEMORY_SCOPE_AGENT); }
__device__ __forceinline__ unsigned xb_add(unsigned* p, unsigned v) { return __hip_atomic_fetch_add(p, v, __ATOMIC_RELAXED, __HIP_MEMORY_SCOPE_AGENT); }
__device__ __forceinline__ unsigned xb_xcc_id() { return (unsigned)__builtin_amdgcn_s_getreg((3 << 11) | 20) & 0xFu; }
#define XB_SPIN(cond, bar) do { unsigned _sp = 0; while (cond) { __builtin_amdgcn_s_sleep(1); \
    if ((++_sp & 255u) == 0u) { if (xb_ld(&(bar)[XB_TMO])) break; if (_sp > XB_SPIN_CAP) { atomicAdd(&(bar)[XB_TMO], 1u); break; } } } } while (0)

struct XcdBarrier {
    unsigned* bar; unsigned x;
    volatile LAS unsigned* st;
};

__device__ __forceinline__ XcdBarrier xcd_barrier_post(unsigned* bar, volatile LAS unsigned* st) {
    XcdBarrier b; b.bar = bar; b.x = xb_xcc_id(); b.st = st;
    if (threadIdx.x == 0) (void)xb_add(&bar[XB_XCNT(b.x)], 1u);
    return b;
}
__device__ __forceinline__ void xcd_barrier_complete(unsigned* bar, unsigned x, unsigned& nloc, unsigned& nx) {
    const unsigned G = gridDim.x * gridDim.y * gridDim.z;
    unsigned sum, cnt, mine, sp = 0u;
    for (;;) {
        sum = 0u; cnt = 0u; mine = 0u;
#pragma unroll
        for (unsigned j = 0; j < 16; ++j) { const unsigned c = xb_ld(&bar[XB_XCNT(j)]); sum += c; cnt += (c > 0u) ? 1u : 0u; mine = (j == x) ? c : mine; }
        if (sum == G) break;
        __builtin_amdgcn_s_sleep(1);
        if ((++sp & 255u) == 0u) { if (xb_ld(&bar[XB_TMO])) break; if (sp > XB_SPIN_CAP) { atomicAdd(&bar[XB_TMO], 1u); break; } }
    }
    nloc = mine > 0u ? mine : 1u; nx = cnt > 0u ? cnt : 1u;
}

__device__ __forceinline__ void xcd_barrier(const XcdBarrier& b) {
    asm volatile("s_waitcnt vmcnt(0)" ::: "memory");
    __syncthreads();
    if (threadIdx.x == 0) {
        unsigned* bar = b.bar;
        __builtin_amdgcn_s_waitcnt(0);
        unsigned nloc = b.st[0], nx = b.st[1];
        if (nloc == 0u) { xcd_barrier_complete(bar, b.x, nloc, nx); b.st[0] = nloc; b.st[1] = nx; }
        const unsigned old = xb_add(&bar[XB_XSUB(b.x)], 1u);
        const unsigned gen = old / nloc;
        if (old + 1u == (gen + 1u) * nloc) {
            __builtin_amdgcn_fence(__ATOMIC_RELEASE, "agent");
            asm volatile("s_waitcnt vmcnt(0)" ::: "memory");
            const unsigned og = xb_add(&bar[XB_TOP], 1u);
            const unsigned tg = og / nx;
            if (og + 1u == (tg + 1u) * nx) xb_add(&bar[XB_TOPGEN], 1u);
            else XB_SPIN(xb_ld(&bar[XB_TOPGEN]) == tg, bar);
            __builtin_amdgcn_fence(__ATOMIC_ACQUIRE, "agent");
            xb_add(&bar[XB_XGEN(b.x)], 1u);
            asm volatile("s_waitcnt vmcnt(0)" ::: "memory");
        } else {
            XB_SPIN(xb_ld(&bar[XB_XGEN(b.x)]) == gen, bar);
            __builtin_amdgcn_fence(__ATOMIC_ACQUIRE, "agent");
            asm volatile("s_waitcnt vmcnt(0)" ::: "memory");
        }
    }
    __syncthreads();
}


__device__ __forceinline__ void tr_item(const float* W, int K, int N, bf16* WT, int dst_row0, int src_col0, int nvalid, int kb, const float* kscale, float cscale, LAS float* scr, int lane) {
    const int k0 = 64 * kb, c = lane & 31;
    float tv[32];
    const float* wp = W + (size_t)(k0 + (lane >> 5)) * N + src_col0 + c;
#pragma unroll
    for (int i = 0; i < 32; ++i) { tv[i] = 0.f; if (c < nvalid) tv[i] = __builtin_nontemporal_load(wp + (size_t)(2 * i) * N); }
#pragma unroll
    for (int i = 0; i < 32; ++i) { const int kk = 2 * i + (lane >> 5); float v = tv[i] * cscale; if (kscale) v *= kscale[k0 + kk]; scr[kk * 33 + c] = v; }
    LDS_WAIT(); asm volatile("" ::: "memory");
    const int ch = lane & 7;
#pragma unroll
    for (int j = 0; j < 4; ++j) { const int n = (lane >> 3) + 8 * j; const LAS float* s = scr + (8 * ch) * 33 + n;
        v4u o; o.x = pg8::cvt_pk_bf16(s[0 * 33], s[1 * 33]); o.y = pg8::cvt_pk_bf16(s[2 * 33], s[3 * 33]); o.z = pg8::cvt_pk_bf16(s[4 * 33], s[5 * 33]); o.w = pg8::cvt_pk_bf16(s[6 * 33], s[7 * 33]);
        *(v4u*)(WT + (size_t)(dst_row0 + n) * K + k0 + 8 * ch) = o; }
    LDS_WAIT(); asm volatile("" ::: "memory");
}
__device__ __forceinline__ void tr_item8(const float* W, int K, int N, unsigned char* WT8, int dst_row0, int src_col0, int kb, float cscale, LAS float* scr, int lane) {
    const int k0 = 64 * kb, c = lane & 31;
    float tv[32];
    const float* wp = W + (size_t)(k0 + (lane >> 5)) * N + src_col0 + c;
#pragma unroll
    for (int i = 0; i < 32; ++i) tv[i] = __builtin_nontemporal_load(wp + (size_t)(2 * i) * N);
#pragma unroll
    for (int i = 0; i < 32; ++i) { const int kk = 2 * i + (lane >> 5); scr[kk * 33 + c] = tv[i] * cscale; }
    LDS_WAIT(); asm volatile("" ::: "memory");
    const int ch = lane & 7;
#pragma unroll
    for (int j = 0; j < 4; ++j) { const int n = (lane >> 3) + 8 * j; const LAS float* s = scr + (8 * ch) * 33 + n;
        int w0 = 0, w1 = 0; w0 = __builtin_amdgcn_cvt_pk_fp8_f32(s[0 * 33], s[1 * 33], w0, false); w0 = __builtin_amdgcn_cvt_pk_fp8_f32(s[2 * 33], s[3 * 33], w0, true);
        w1 = __builtin_amdgcn_cvt_pk_fp8_f32(s[4 * 33], s[5 * 33], w1, false); w1 = __builtin_amdgcn_cvt_pk_fp8_f32(s[6 * 33], s[7 * 33], w1, true);
        v2u o; o.x = (unsigned)w0; o.y = (unsigned)w1; *(v2u*)(WT8 + (size_t)(dst_row0 + n) * K + k0 + 8 * ch) = o; }
    LDS_WAIT(); asm volatile("" ::: "memory");
}
__device__ __forceinline__ void win_map(int db, int& src, int& nv) {
    const int pn = db >> 3, bj = (db >> 2) & 1, wc = db & 3; nv = 32;
    if (pn < 4) src = (4 * pn + wc) * 64 + 32 * bj;
    else if (pn == 4) src = (wc < 2 ? 1024 + wc * 64 : 1152 + (wc - 2) * 64) + 32 * bj;
    else if (pn < 17) { const int t = pn - 5; src = 1280 + (t >> 2) * 1024 + (4 * (t & 3) + wc) * 64 + 32 * bj; }
    else { src = 4352; nv = (db == 136) ? 16 : 0; }
}

struct Args { const float* x; const int* pos; const float* attn_norm; const float* w_in; const float* fbias; const float* sinks; const float* w_bs; const float* w_bf;
              const float* w_out; const float* mlp_norm; const float* w_up; const float* w_dn; const float* final_norm; float* out; unsigned char* ws; long long fused_final; };

__device__ __forceinline__ void rms_row_to_bf16(const float* xrow, const float* gain, bf16* orow, int lane) {
    const f32x4* xr = (const f32x4*)xrow + lane; f32x4 v[8]; float s = 0.f;
#pragma unroll
    for (int j = 0; j < 8; ++j) { v[j] = xr[64 * j]; s += (v[j].x * v[j].x + v[j].y * v[j].y) + (v[j].z * v[j].z + v[j].w * v[j].w); }
    const float rstd = __builtin_amdgcn_rsqf(wave_sum(s) * (1.f / DM) + RMS_EPS);
    const f32x4* gr = (const f32x4*)gain + lane; v2u* o8 = (v2u*)orow + lane;
#pragma unroll
    for (int j = 0; j < 8; ++j) { const f32x4 g = gr[64 * j]; v2u w; w.x = pg8::cvt_pk_bf16(v[j].x * rstd * g.x, v[j].y * rstd * g.y); w.y = pg8::cvt_pk_bf16(v[j].z * rstd * g.z, v[j].w * rstd * g.w); o8[64 * j] = w; }
}

__device__ __forceinline__ void rms_row2_to_bf16(const float* x0, const float* x1, const float* gain, bf16* o0, bf16* o1, unsigned char* q0, unsigned char* q1, int lane) {
    const f32x4* xr0 = (const f32x4*)x0 + lane; const f32x4* xr1 = (const f32x4*)x1 + lane; f32x4 v[8], w[8]; float s = 0.f, t = 0.f;
#pragma unroll
    for (int j = 0; j < 8; ++j) { v[j] = __builtin_nontemporal_load(xr0 + 64 * j); w[j] = __builtin_nontemporal_load(xr1 + 64 * j); }
#pragma unroll
    for (int j = 0; j < 8; ++j) { s += (v[j].x * v[j].x + v[j].y * v[j].y) + (v[j].z * v[j].z + v[j].w * v[j].w); t += (w[j].x * w[j].x + w[j].y * w[j].y) + (w[j].z * w[j].z + w[j].w * w[j].w); }
    const float rs = __builtin_amdgcn_rsqf(wave_sum(s) * (1.f / DM) + RMS_EPS), rt = __builtin_amdgcn_rsqf(wave_sum(t) * (1.f / DM) + RMS_EPS);
    const f32x4* gr = (const f32x4*)gain + lane; v2u* p0 = (v2u*)o0 + lane; v2u* p1 = (v2u*)o1 + lane;
#pragma unroll
    for (int j = 0; j < 8; ++j) { const f32x4 g = gr[64 * j]; v2u a, c;
        a.x = pg8::cvt_pk_bf16(v[j].x * rs * g.x, v[j].y * rs * g.y); a.y = pg8::cvt_pk_bf16(v[j].z * rs * g.z, v[j].w * rs * g.w);
        c.x = pg8::cvt_pk_bf16(w[j].x * rt * g.x, w[j].y * rt * g.y); c.y = pg8::cvt_pk_bf16(w[j].z * rt * g.z, w[j].w * rt * g.w);
        p0[64 * j] = a; p1[64 * j] = c;
        int e0 = 0, e1 = 0;
        e0 = __builtin_amdgcn_cvt_pk_fp8_f32(8.f * v[j].x * rs * g.x, 8.f * v[j].y * rs * g.y, e0, false); e0 = __builtin_amdgcn_cvt_pk_fp8_f32(8.f * v[j].z * rs * g.z, 8.f * v[j].w * rs * g.w, e0, true);
        e1 = __builtin_amdgcn_cvt_pk_fp8_f32(8.f * w[j].x * rt * g.x, 8.f * w[j].y * rt * g.y, e1, false); e1 = __builtin_amdgcn_cvt_pk_fp8_f32(8.f * w[j].z * rt * g.z, 8.f * w[j].w * rt * g.w, e1, true);
        ((unsigned*)q0)[lane + 64 * j] = (unsigned)e0; ((unsigned*)q1)[lane + 64 * j] = (unsigned)e1; }
}
__device__ __forceinline__ void p0_prologue(const Args& a, LAS unsigned char* lds, int vcu, int G, int wave, int lane) {
    unsigned char* ws = a.ws;
    LAS float* scr = (LAS float*)(lds + wave * 16384);
    const int gw = vcu * NWAVES + wave, NGW = G * NWAVES;
    constexpr int I_IN = (NIN / 32) * (DM / 64), I_BS = (DM / 32) * (1024 / 64), I_OUT = (DM / 32) * (DM / 64), I_UP = (DFF / 32) * (DM / 64), I_DN = (DM / 32) * (DFF / 64);
    constexpr int I_G = (NGATE / 32) * (DM / 64);
    constexpr int NITEMS = I_IN + 2 * I_BS + I_OUT + I_UP + I_DN + I_G;
    for (int it = gw; it < NITEMS; it += NGW) {
        int r = it;
        if (r < I_IN) { const int db = r / (DM / 64), kb = r % (DM / 64); int src, nv; win_map(db, src, nv); const float csc = (db < 32 || (db >= 40 && db < 72)) ? C2 : 1.0f;
            tr_item(a.w_in, DM, DIN, (bf16*)(ws + WS_WIN), db * 32, src, nv, kb, nullptr, csc, scr, lane); continue; } r -= I_IN;
        if (r < I_BS) { const int db = r / 16, kb = r % 16; tr_item(a.w_bs, 1024, DM, (bf16*)(ws + WS_WBS), db * 32, db * 32, 32, kb, nullptr, 1.0f, scr, lane); continue; } r -= I_BS;
        if (r < I_BS) { const int db = r / 16, kb = r % 16; tr_item(a.w_bf, 1024, DM, (bf16*)(ws + WS_WBF), db * 32, db * 32, 32, kb, nullptr, 1.0f, scr, lane); continue; } r -= I_BS;
        if (r < I_OUT) { const int db = r / 32, kb = r % 32; tr_item(a.w_out, DM, DM, (bf16*)(ws + WS_WOUT), db * 32, db * 32, 32, kb, nullptr, 1.0f, scr, lane); continue; } r -= I_OUT;
        if (r < I_UP) { const int db = r / 32, kb = r % 32; tr_item(a.w_up, DM, DFF, (bf16*)(ws + WS_WUP), db * 32, db * 32, 32, kb, a.mlp_norm, 1.0f, scr, lane); continue; } r -= I_UP;
        if (r < I_DN) { const int db = r / 128, kb = r % 128; tr_item(a.w_dn, DFF, DM, (bf16*)(ws + WS_WDN), db * 32, db * 32, 32, kb, nullptr, 1.0f, scr, lane); continue; } r -= I_DN;
        { const int db = r / 32, kb = r % 32; tr_item8(a.w_in, DM, DIN, ws + WS_WG8, db * 32, 4368 + db * 32, kb, -64.0f * LOG2E, scr, lane); }
    }
    for (int m = gw; m < M; m += 2 * NGW) rms_row2_to_bf16(a.x + (size_t)m * DM, a.x + (size_t)(m + NGW) * DM, a.attn_norm, (bf16*)(ws + WS_XN) + (size_t)m * DM, (bf16*)(ws + WS_XN) + (size_t)(m + NGW) * DM, ws + WS_XN8 + (size_t)m * DM, ws + WS_XN8 + (size_t)(m + NGW) * DM, lane);
    float* cs = (float*)(ws + WS_CS);
    for (int e = gw * 64 + lane; e < M * 32; e += NGW * 64) {
        const int tok = e >> 5, i = e & 31;
        const float inv_freq = powf(10000.0f, -(float)(2 * i) / 64.0f);
        const float ang = (float)a.pos[tok] * inv_freq;
        double rev = (double)ang * 0.15915494309189535; rev -= floor(rev);
        const float rf = (float)rev;
        cs[e] = __builtin_amdgcn_cosf(rf); cs[(size_t)M * 32 + e] = __builtin_amdgcn_sinf(rf);
    }
}

__device__ __forceinline__ void cumsum_unit(const Args& a, int bh, LAS unsigned char* lds) {
    const float* FL = (const float*)(a.ws + WS_FL); float* Cp = (float*)(a.ws + WS_C);
    LAS double* sh = (LAS double*)lds;
    const int b = bh >> 4, h = bh & 15, tid = threadIdx.x, s0 = tid * 16; const float fb = a.fbias[h];
    float ls[16]; double run = 0.0;
#pragma unroll
    for (int i = 0; i < 16; ++i) { const float z = FL[(size_t)(b * SEQ + s0 + i) * 16 + h] + fb; const float v = fminf(z, 0.f) - log1pf(expf(-fabsf(z))); ls[i] = v; run += (double)v; }
    sh[tid] = run; __syncthreads();
    double pre = 0.0; for (int k = 0; k < tid; ++k) pre += sh[k];
#pragma unroll
    for (int i = 0; i < 16; ++i) { pre += (double)ls[i]; Cp[(size_t)bh * SEQ + s0 + i] = (float)(pre * 1.4426950408889634); }
    __syncthreads();
}

__device__ __forceinline__ void naive_swa_unit(const Args& a, int unit) {
    const bf16* AQ = (const bf16*)(a.ws + WS_AQ); const bf16* AK = (const bf16*)(a.ws + WS_AK); const bf16* AV = (const bf16*)(a.ws + WS_AV); bf16* OA = (bf16*)(a.ws + WS_OA);
    const int tid = threadIdx.x, head = tid & 15, tok = unit * 32 + (tid >> 4), b = tok / SEQ, s = tok % SEQ, kvh = head >> 3;
    float q[64], o[64]; float m = -INFINITY, l = 0.f;
    { const v4u* qp = (const v4u*)(AQ + (size_t)tok * 1024 + head * 64);
#pragma unroll
      for (int c = 0; c < 8; ++c) { const v4u w = qp[c];
#pragma unroll
          for (int e = 0; e < 4; ++e) { q[8 * c + 2 * e] = pg8::bf_lo(w[e]); q[8 * c + 2 * e + 1] = pg8::bf_hi(w[e]); } } }
#pragma unroll
    for (int d = 0; d < 64; ++d) o[d] = 0.f;
    for (int i = 0; i < 128; ++i) {
        const int j = s - i; const bool valid = j >= 0; const int jj = valid ? j : 0;
        const v4u* kp = (const v4u*)(AK + (size_t)(b * SEQ + jj) * 128 + kvh * 64); const v4u* vp = (const v4u*)(AV + (size_t)(b * SEQ + jj) * 128 + kvh * 64);
        float dot = 0.f;
#pragma unroll
        for (int c = 0; c < 8; ++c) { const v4u w = kp[c];
#pragma unroll
            for (int e = 0; e < 4; ++e) { dot += q[8 * c + 2 * e] * pg8::bf_lo(w[e]); dot += q[8 * c + 2 * e + 1] * pg8::bf_hi(w[e]); } }
        const float lg = valid ? dot : -INFINITY;
        const float mn = fmaxf(m, lg), al = __builtin_amdgcn_exp2f(m - mn), p = __builtin_amdgcn_exp2f(lg - mn);
        l = l * al + p; m = mn;
#pragma unroll
        for (int c = 0; c < 8; ++c) { const v4u w = vp[c];
#pragma unroll
            for (int e = 0; e < 4; ++e) { o[8 * c + 2 * e] = o[8 * c + 2 * e] * al + p * pg8::bf_lo(w[e]); o[8 * c + 2 * e + 1] = o[8 * c + 2 * e + 1] * al + p * pg8::bf_hi(w[e]); } }
    }
    { const float sk = a.sinks[head] * LOG2E; const float m2 = fmaxf(m, sk), al = __builtin_amdgcn_exp2f(m - m2); l = l * al + __builtin_amdgcn_exp2f(sk - m2);
      const float rl = al / l;
      v4u* op = (v4u*)(OA + (size_t)tok * 1024 + head * 64);
#pragma unroll
      for (int c = 0; c < 8; ++c) { v4u w;
#pragma unroll
          for (int e = 0; e < 4; ++e) w[e] = pg8::cvt_pk_bf16(o[8 * c + 2 * e] * rl, o[8 * c + 2 * e + 1] * rl);
          op[c] = w; } }
}
__device__ __forceinline__ void naive_fox_unit(const Args& a, int bh, int qblk) {
    const bf16* FQ = (const bf16*)(a.ws + WS_FQ); const bf16* FK = (const bf16*)(a.ws + WS_FK); const bf16* FV = (const bf16*)(a.ws + WS_FV); bf16* OB = (bf16*)(a.ws + WS_OB);
    const float* Cp = (const float*)(a.ws + WS_C) + (size_t)bh * SEQ;
    const int tid = threadIdx.x, b = bh >> 4, h = bh & 15, s = qblk * 512 + tid; const size_t tok = (size_t)b * SEQ + s;
    float q[64], o[64]; float m = -INFINITY, l = 0.f;
    { const v4u* qp = (const v4u*)(FQ + tok * 1024 + h * 64);
#pragma unroll
      for (int c = 0; c < 8; ++c) { const v4u w = qp[c];
#pragma unroll
          for (int e = 0; e < 4; ++e) { q[8 * c + 2 * e] = pg8::bf_lo(w[e]); q[8 * c + 2 * e + 1] = pg8::bf_hi(w[e]); } } }
#pragma unroll
    for (int d = 0; d < 64; ++d) o[d] = 0.f;
    const float cq = Cp[s];
    const int jend = __builtin_amdgcn_readfirstlane(qblk * 512 + (tid | 63));
    for (int j = 0; j <= jend; ++j) {
        const v4u* kp = (const v4u*)(FK + ((size_t)b * SEQ + j) * 1024 + h * 64); const v4u* vp = (const v4u*)(FV + ((size_t)b * SEQ + j) * 1024 + h * 64);
        float dot = 0.f;
#pragma unroll
        for (int c = 0; c < 8; ++c) { const v4u w = kp[c];
#pragma unroll
            for (int e = 0; e < 4; ++e) { dot += q[8 * c + 2 * e] * pg8::bf_lo(w[e]); dot += q[8 * c + 2 * e + 1] * pg8::bf_hi(w[e]); } }
        float lg = dot + (cq - Cp[j]); lg = (j <= s) ? lg : -INFINITY;
        const float mn = fmaxf(m, lg), al = __builtin_amdgcn_exp2f(m - mn), p = __builtin_amdgcn_exp2f(lg - mn);
        l = l * al + p; m = mn;
#pragma unroll
        for (int c = 0; c < 8; ++c) { const v4u w = vp[c];
#pragma unroll
            for (int e = 0; e < 4; ++e) { o[8 * c + 2 * e] = o[8 * c + 2 * e] * al + p * pg8::bf_lo(w[e]); o[8 * c + 2 * e + 1] = o[8 * c + 2 * e + 1] * al + p * pg8::bf_hi(w[e]); } }
    }
    { const float rl = 1.0f / l; v4u* op = (v4u*)(OB + tok * 1024 + h * 64);
#pragma unroll
      for (int c = 0; c < 8; ++c) { v4u w;
#pragma unroll
          for (int e = 0; e < 4; ++e) w[e] = pg8::cvt_pk_bf16(o[8 * c + 2 * e] * rl, o[8 * c + 2 * e + 1] * rl);
          op[c] = w; } }
}

__global__ void __launch_bounds__(NWAVES * 64, 2) mega_fwd(Args a) {
    extern __shared__ __attribute__((aligned(16))) unsigned char lds_raw[];
    LAS unsigned char* lds = (LAS unsigned char*)lds_raw;
    cg::grid_group grid = cg::this_grid();
    int tid_ = threadIdx.x; asm volatile("" : "+v"(tid_));
    const int tid = tid_, lane = tid & 63, wave = __builtin_amdgcn_readfirstlane(tid >> 6);
    const int G = gridDim.x, bx = blockIdx.x, vcu = (G % 8 == 0) ? (bx % 8) * (G / 8) + bx / 8 : bx;
    unsigned char* ws = a.ws;
    float* SS1 = (float*)(ws + WS_CTL); float* SS2 = SS1 + M;
#define GRID_SYNC_CG() do { asm volatile("s_waitcnt vmcnt(0) lgkmcnt(0)" ::: "memory"); grid.sync(); } while (0)
#define GRID_SYNC() xcd_barrier(xbar)
    if (tid < 2) ((LAS unsigned*)(lds + RING_BYTES))[tid] = 0u;
    __syncthreads();
    const XcdBarrier xbar = xcd_barrier_post((unsigned*)(ws + WS_CTL + 786432), (volatile LAS unsigned*)(lds + RING_BYTES));

    for (int rp_ = 0; rp_ < (REP_PHASE == 100 ? 2 : 1); ++rp_) { p0_prologue(a, lds, vcu, G, wave, lane); __syncthreads(); }
    if (a.ws == nullptr) GRID_SYNC_CG();
    GRID_SYNC();

    {
        pg8::Gemm g{(const bf16*)(ws + WS_XN), (const bf16*)(ws + WS_WIN), nullptr, nullptr, DM};
        pg8::StaticOrder S; S.init(M, NIN, G, bx);
        pg8::EpiIn E{ws};
        for (int rp_ = 0; rp_ < (REP_PHASE == 1 ? 2 : 1); ++rp_) pg8::gemm_phase<pg8::EpiIn, pg8::StaticOrder, true, true>(lds, g, S, E);
        pg8::Gemm g8{(const bf16*)(ws + WS_XN8), (const bf16*)(ws + WS_WG8), nullptr, nullptr, DM / 2};
        pg8::StaticOrder S8; S8.init(M, NGATE, G, bx);
        pg8::EpiGate E8{ws + WS_G};
        for (int rp_ = 0; rp_ < (REP_PHASE == 12 ? 2 : 1); ++rp_) pg8::gemm_phase<pg8::EpiGate, pg8::StaticOrder, true, true, true>(lds, g8, S8, E8);
    }
    GRID_SYNC();

    for (int u = bx; u < 64; u += G) cumsum_unit(a, u, lds);
#if NAIVE_SWA
    for (int u = bx; u < M / 32; u += G) naive_swa_unit(a, u);
#else
    for (int rp_ = 0; rp_ < (REP_PHASE == 2 ? 2 : 1); ++rp_)
    for (int u = vcu; u < 2048; u += G) { const int bh = u >> 5, qb = u & 31, b_ = bh >> 4, h_ = bh & 15;
        attn_body::attn_unit<8, false, 128>(b_, h_, qb, (const bf16*)(ws + WS_AQ), (const bf16*)(ws + WS_AK), (const bf16*)(ws + WS_AV), (bf16*)(ws + WS_OA), nullptr, a.sinks[h_] * LOG2E, (char*)lds_raw); }
#endif
    GRID_SYNC();

#if NAIVE_FOX
    for (int u = bx; u < 1024; u += G) { const int r = u >> 6, i = r >> 2, hi4 = r & 3, qblk = (i & 1) ? 4 * i + 3 - hi4 : 4 * i + hi4; naive_fox_unit(a, u & 63, qblk); }
#else
    for (int rp_ = 0; rp_ < (REP_PHASE == 3 ? 2 : 1); ++rp_)
    for (int e = vcu; e < 2048; e += G) { const int cuv = e & 255, i = e >> 8, bh = (cuv >> 4) + 16 * (i >> 1), s_ = cuv & 15, qb = (i & 1) ? 31 - s_ : s_;
        attn_body::attn_unit<8, true, 1024>(bh >> 4, bh & 15, qb, (const bf16*)(ws + WS_FQ), (const bf16*)(ws + WS_FK), (const bf16*)(ws + WS_FV), (bf16*)(ws + WS_OB), (const float*)(ws + WS_C) + (size_t)bh * SEQ, 0.f, (char*)lds_raw); }
#endif
    GRID_SYNC();

    {
        pg8::Gemm g{(const bf16*)(ws + WS_OA), (const bf16*)(ws + WS_WBS), (const bf16*)(ws + WS_OB), (const bf16*)(ws + WS_WBF), 1024};
        pg8::PairOrder S; S.s.init(M, DM, G, bx);
        pg8::EpiBranch E{(const unsigned char*)(ws + WS_G), (bf16*)(ws + WS_MG)};
        for (int rp_ = 0; rp_ < (REP_PHASE == 4 ? 2 : 1); ++rp_) pg8::gemm_phase<pg8::EpiBranch, pg8::PairOrder, true, true>(lds, g, S, E);
    }
    GRID_SYNC();

    {
        pg8::Gemm g{(const bf16*)(ws + WS_MG), (const bf16*)(ws + WS_WOUT), nullptr, nullptr, DM};
        pg8::StaticOrder S; S.init(M, DM, G, bx);
        pg8::EpiResB<false> E{a.x, (bf16*)(ws + WS_X1B), SS1};
        pg8::gemm_phase<pg8::EpiResB<false>, pg8::StaticOrder, true, true>(lds, g, S, E);
    }
    GRID_SYNC();

    {
        pg8::Gemm g{(const bf16*)(ws + WS_X1B), (const bf16*)(ws + WS_WUP), nullptr, nullptr, DM};
        pg8::StaticOrder S; S.init(M, DFF, G, bx);
        pg8::EpiUp E{SS1, (bf16*)(ws + WS_U)};
        for (int rp_ = 0; rp_ < (REP_PHASE == 6 ? 2 : 1); ++rp_) pg8::gemm_phase<pg8::EpiUp, pg8::StaticOrder, true, true>(lds, g, S, E);
    }
    GRID_SYNC();

    {
        pg8::Gemm g{(const bf16*)(ws + WS_U), (const bf16*)(ws + WS_WDN), nullptr, nullptr, DFF};
        pg8::StaticOrder S; S.init(M, DM, G, bx);
        pg8::EpiResB<true> E{(const void*)(ws + WS_X1B), (bf16*)(ws + WS_X2B), SS2};
        pg8::gemm_phase<pg8::EpiResB<true>, pg8::StaticOrder, true, true>(lds, g, S, E);
    }
    GRID_SYNC();

    {
        const int gw = vcu * NWAVES + wave, NGW = G * NWAVES;
        for (int m = gw; m < M; m += NGW) {
            const float rstd = __builtin_amdgcn_rsqf(SS2[m] * (1.f / DM) + RMS_EPS);
            f32x4* xr = (f32x4*)(a.out + (size_t)m * DM) + lane; const f32x4* gr = (const f32x4*)a.final_norm + lane; const v2u* br = (const v2u*)((const bf16*)(ws + WS_X2B) + (size_t)m * DM) + lane;
            v2u w[8];
#pragma unroll
            for (int j = 0; j < 8; ++j) w[j] = __builtin_nontemporal_load(br + 64 * j);
#pragma unroll
            for (int j = 0; j < 8; ++j) { const f32x4 g = gr[64 * j]; const f32x4 v = (f32x4){pg8::bf_lo(w[j].x), pg8::bf_hi(w[j].x), pg8::bf_lo(w[j].y), pg8::bf_hi(w[j].y)}; __builtin_nontemporal_store(v * rstd * g, xr + 64 * j); }
        }
    }
}

extern "C" void kernel_launch(void* const* d_in, const int* in_sizes, int n_in, void* d_out, int out_size, void* d_ws, size_t ws_size, hipStream_t stream) {
    static int grid = 0; static int fused_final = 0;
    if (grid == 0) {
        if (n_in != 13 || in_sizes[0] != M * DM || out_size != M * DM || ws_size < WS_END3) { fprintf(stderr, "kernel_launch: unexpected shapes (n_in %d, in0 %d, out %d, ws %zu)\n", n_in, n_in > 0 ? in_sizes[0] : -1, out_size, ws_size); grid = -1; return; }
        int dev = 0, cus = 0, per_cu = 0;
        if (hipGetDevice(&dev) != hipSuccess || hipDeviceGetAttribute(&cus, hipDeviceAttributeMultiprocessorCount, dev) != hipSuccess) { grid = -1; return; }
        if (hipFuncSetAttribute((const void*)mega_fwd, hipFuncAttributeMaxDynamicSharedMemorySize, LDS_BYTES) != hipSuccess) { fprintf(stderr, "kernel_launch: hipFuncSetAttribute failed\n"); grid = -1; return; }
        if (hipOccupancyMaxActiveBlocksPerMultiprocessor(&per_cu, (const void*)mega_fwd, NWAVES * 64, LDS_BYTES) != hipSuccess || per_cu < 1) { fprintf(stderr, "kernel_launch: occupancy query says %d\n", per_cu); per_cu = 1; }
        (void)hipGetLastError();
        grid = cus * 1;
        { pg8::StaticOrder S; S.init(M, DM, grid, 0); bool ok = (M / 256) * (DM / 256) == 4 * grid;
          for (int c = 0; c < grid && ok; ++c) { S.c = c; for (int i = 0; i < 4 && ok; i += 2) { pg8::Unit u0, u1; ok = S.next(i, u0) && S.next(i + 1, u1) && u0.pm == u1.pm && u1.pn == u0.pn + 4 && u0.pn < 4 && u0.f == 0 && u1.f == 1; } }
          fused_final = (ok && FUSED_FINAL) ? 1 : 0; if (!ok) fprintf(stderr, "kernel_launch: note: unit order does not pair tiles; using the separate final-norm pass\n"); }
    }
    if (grid < 0) return;
    (void)hipMemsetAsync((char*)d_ws + WS_CTL, 0, CTL_ZERO_BYTES, stream);
    Args a{};
    a.x = (const float*)d_in[0]; a.pos = (const int*)d_in[1]; a.attn_norm = (const float*)d_in[2]; a.w_in = (const float*)d_in[3]; a.fbias = (const float*)d_in[4]; a.sinks = (const float*)d_in[5];
    a.w_bs = (const float*)d_in[6]; a.w_bf = (const float*)d_in[7]; a.w_out = (const float*)d_in[8]; a.mlp_norm = (const float*)d_in[9]; a.w_up = (const float*)d_in[10]; a.w_dn = (const float*)d_in[11];
    a.final_norm = (const float*)d_in[12]; a.out = (float*)d_out; a.ws = (unsigned char*)d_ws; a.fused_final = fused_final;
    void* kargs[] = {&a};
    const hipError_t le = hipLaunchCooperativeKernel((const void*)mega_fwd, dim3(grid), dim3(NWAVES * 64), kargs, LDS_BYTES, stream);
    if (le != hipSuccess) fprintf(stderr, "kernel_launch: cooperative launch failed: %s (grid %d)\n", hipGetErrorString(le), grid);
}
```

```cpp
#include <hip/hip_runtime.h>
#include <hip/hip_cooperative_groups.h>
#include <cstdio>
#include <cstdint>
namespace cg = cooperative_groups;

constexpr int BATCH = 4, SEQ = 8192, DM = 2048, M = BATCH * SEQ, DFF = 8192, NIN = 4608  , NGATE = 4096, DIN = 8464;
constexpr float RMS_EPS = 1e-6f;
constexpr float LOG2E = 1.4426950408889634f;
constexpr float C2 = 0.125f * 1.4426950408889634f;

constexpr size_t MiB = 1u << 20;
constexpr size_t WS_CTL = 0, CTL_ZERO_BYTES = 1 * MiB;
constexpr size_t WS_WIN = 1 * MiB, WS_WBS = 35 * MiB, WS_WBF = 39 * MiB, WS_WOUT = 43 * MiB, WS_WUP = 51 * MiB, WS_WDN = 83 * MiB;
constexpr size_t WS_CS = 115 * MiB;
constexpr size_t WS_FL = 123 * MiB, WS_C = 125 * MiB;
constexpr size_t WS_FK = 128 * MiB, WS_FV = 192 * MiB, WS_X1B = 128 * MiB;
constexpr size_t WS_XN = 256 * MiB, WS_MG = 256 * MiB;
constexpr size_t WS_AQ = 384 * MiB, WS_FQ = 448 * MiB, WS_G = 512 * MiB;
constexpr size_t WS_U = 256 * MiB;
constexpr size_t WS_AK = 768 * MiB, WS_AV = 776 * MiB, WS_OA = 784 * MiB, WS_OB = 848 * MiB, WS_END = 912 * MiB;
constexpr size_t WS_XN8 = 920 * MiB, WS_WG8 = 21 * MiB, WS_END3 = 984 * MiB;
constexpr size_t WS_X2B = 784 * MiB;

namespace pg8 {
#define PG8_LAS __attribute__((address_space(3)))
typedef unsigned short bf16_t;
typedef short bf16x8 __attribute__((ext_vector_type(8)));
typedef float f32x4 __attribute__((ext_vector_type(4)));
typedef unsigned u32x4 __attribute__((ext_vector_type(4)));
typedef unsigned u32x2 __attribute__((ext_vector_type(2)));
typedef int v4i_t __attribute__((ext_vector_type(4)));
typedef int v8i_t __attribute__((ext_vector_type(8)));
constexpr int BM = 256, BK = 64, HALF = 128, HTB = HALF * BK * 2  , STAGE_BYTES = 8 * HTB, NXCD = 8, WGM = 8;

__host__ __device__ __forceinline__ int lds_byte(int r, int c) { const int st = (r >> 4) * 2 + (c >> 5), rr = r & 15, cc = c & 31, ob = rr * 64 + cc * 2; return st * 1024 + (ob ^ (((ob >> 9) & 1) << 5)); }
__host__ __device__ __forceinline__ void stage_rc(int b, int& R, int& C) { const int st = b / 1024, sb = b % 1024, swz = sb ^ (((sb >> 9) & 1) << 5); R = (st >> 1) * 16 + swz / 64; C = (st & 1) * 32 + (swz % 64) / 2; }
__host__ __device__ __forceinline__ int perm32(int rho) { const int n = rho >> 4, i = rho & 15; return 8 * (i >> 2) + 4 * n + (i & 3); }

struct Unit { int pm, pn, z, f; };
struct Gemm { const bf16_t* A0; const bf16_t* B0; const bf16_t* A1; const bf16_t* B1; int K; };

struct StaticOrder {
    int nM, nN, nwg, G, c;
    __host__ __device__ void init(int M_, int N_, int G_, int c_) { nM = M_ / BM; nN = N_ / BM; nwg = nM * nN; G = G_; c = c_; }
    __host__ __device__ bool next(int i, Unit& u) const {
        const long L = (long)i * G + c; if (L >= nwg) return false;
        int wgid = (int)L; { const int q = nwg / NXCD, r = nwg % NXCD, xcd = wgid % NXCD, off = wgid / NXCD; wgid = (xcd < r ? xcd * (q + 1) : r * (q + 1) + (xcd - r) * q) + off; }
        const int nig = WGM * nN, gid = wgid / nig, fm = gid * WGM, gsz = (nM - fm) < WGM ? (nM - fm) : WGM;
        u.pm = fm + ((wgid % nig) % gsz); u.pn = (wgid % nig) / gsz; u.z = 0; u.f = i & 1; return true;
    }
};
struct PairOrder {
    StaticOrder s;
    __host__ __device__ bool next(int i, Unit& u) const { const bool ok = s.next(i >> 1, u); u.z = i & 1; return ok; }
};

__device__ __forceinline__ unsigned cvt_pk_bf16(float lo, float hi) { unsigned r; asm("v_cvt_pk_bf16_f32 %0, %1, %2" : "=v"(r) : "v"(lo), "v"(hi)); return r; }
__device__ __forceinline__ float bf_lo(unsigned w) { return __uint_as_float(w << 16); }
__device__ __forceinline__ float bf_hi(unsigned w) { return __uint_as_float(w & 0xffff0000u); }
__device__ __forceinline__ float sigmoidf_(float x) { return __builtin_amdgcn_rcpf(1.0f + __builtin_amdgcn_exp2f(-x * LOG2E)); }


struct EpiIn {
    static constexpr bool PERM = true; static constexpr int SC_W = 0x79797979, SC_A = 0x7c7c7c7c;
    unsigned char* ws;
    __device__ __forceinline__ bool keep(const Unit&) const { return false; }
    __device__ __forceinline__ void operator()(f32x4 (&acc)[2][2][4][2], const Unit& u, int wr, int wc, int fr, int fq) const {
        const int pn = u.pn; const int row0 = u.pm * BM + wr * 64 + fr;
        if (pn <= 16) {
            size_t doff; int pitch, colbase; bool rope = false;
            if (pn < 4) { doff = WS_AQ; pitch = 1024; colbase = (4 * pn + wc) * 64; rope = true; }
            else if (pn == 4) { if (wc < 2) { doff = WS_AK; pitch = 128; colbase = wc * 64; rope = true; } else { doff = WS_AV; pitch = 128; colbase = (wc - 2) * 64; } }
            else { const int t = pn - 5, seg = t >> 2, tin = t & 3; doff = WS_FQ; if (seg == 1) doff = WS_FK; if (seg == 2) doff = WS_FV; pitch = 1024; colbase = (4 * tin + wc) * 64; }
            bf16_t* dst = (bf16_t*)(ws + doff); const float* cs = (const float*)(ws + WS_CS);
#pragma unroll
            for (int ai = 0; ai < 2; ++ai) {
                f32x4 cc[4][4];
                if (rope) {
#pragma unroll
                    for (int m = 0; m < 4; ++m) { const float* cp = cs + (size_t)(row0 + ai * HALF + m * 16) * 32 + 8 * fq; const float* sp = cp + (size_t)M * 32;
                        cc[m][0] = *(const f32x4*)cp; cc[m][1] = *(const f32x4*)(cp + 4); cc[m][2] = *(const f32x4*)sp; cc[m][3] = *(const f32x4*)(sp + 4); }
                    asm volatile("" ::: "memory");
                }
#pragma unroll
                for (int m = 0; m < 4; ++m) {
                    const int row = row0 + ai * HALF + m * 16;
                    f32x4 v00 = acc[ai][0][m][0], v01 = acc[ai][0][m][1], v10 = acc[ai][1][m][0], v11 = acc[ai][1][m][1];
                    if (rope) {
                        const f32x4 c0 = cc[m][0], c1 = cc[m][1], s0 = cc[m][2], s1 = cc[m][3];
                        const f32x4 o00 = v00 * c0 - v10 * s0, o10 = v10 * c0 + v00 * s0, o01 = v01 * c1 - v11 * s1, o11 = v11 * c1 + v01 * s1;
                        v00 = o00; v10 = o10; v01 = o01; v11 = o11;
                    }
                    bf16_t* rp = dst + (size_t)row * pitch + colbase + 8 * fq;
                    u32x4 w0, w1;
                    w0.x = cvt_pk_bf16(v00[0], v00[1]); w0.y = cvt_pk_bf16(v00[2], v00[3]); w0.z = cvt_pk_bf16(v01[0], v01[1]); w0.w = cvt_pk_bf16(v01[2], v01[3]);
                    w1.x = cvt_pk_bf16(v10[0], v10[1]); w1.y = cvt_pk_bf16(v10[2], v10[3]); w1.z = cvt_pk_bf16(v11[0], v11[1]); w1.w = cvt_pk_bf16(v11[2], v11[3]);
                    *(u32x4*)rp = w0; *(u32x4*)(rp + 32) = w1;
                }
                asm volatile("" ::: "memory");
            }
        } else {
            if (wc == 0 && fq < 2) {
#pragma unroll
                for (int ai = 0; ai < 2; ++ai)
#pragma unroll
                    for (int m = 0; m < 4; ++m) {
                        float* rp = (float*)(ws + WS_FL) + (size_t)(row0 + ai * HALF + m * 16) * 16 + 8 * fq;
                        *(f32x4*)rp = acc[ai][0][m][0]; *(f32x4*)(rp + 4) = acc[ai][0][m][1];
                    }
            }
        }
    }
};

struct EpiGate {
    static constexpr bool PERM = true; static constexpr int SC_W = 0x79797979, SC_A = 0x7c7c7c7c;
    unsigned char* G;
    __device__ __forceinline__ bool keep(const Unit&) const { return false; }
    __device__ __forceinline__ void operator()(f32x4 (&acc)[2][2][4][2], const Unit& u, int wr, int wc, int fr, int fq) const {
        const int row0 = u.pm * BM + wr * 64 + fr, col0 = u.pn * BM + wc * 32 + 8 * fq;
#pragma unroll
        for (int ai = 0; ai < 2; ++ai)
#pragma unroll
            for (int m = 0; m < 4; ++m) {
                unsigned char* rp = G + (size_t)(row0 + ai * HALF + m * 16) * 4096 + col0;
#pragma unroll
                for (int bj = 0; bj < 2; ++bj) {
                    const f32x4 a = acc[ai][bj][m][0], b = acc[ai][bj][m][1]; u32x2 w; w.x = 0u; w.y = 0u;
#pragma unroll
                    for (int i = 0; i < 4; ++i) {
                        const float qa = __builtin_amdgcn_rcpf(__builtin_fmaf(__builtin_amdgcn_exp2f(a[i]), 1.0f / 255.0f, 1.0f / 255.0f)), qb = __builtin_amdgcn_rcpf(__builtin_fmaf(__builtin_amdgcn_exp2f(b[i]), 1.0f / 255.0f, 1.0f / 255.0f));
                        w.x = __builtin_amdgcn_cvt_pk_u8_f32(fmaxf(qa, 1.0f), i, w.x); w.y = __builtin_amdgcn_cvt_pk_u8_f32(fmaxf(qb, 1.0f), i, w.y); }
                    *(u32x2*)(rp + bj * HALF) = w;
                }
            }
    }
};

struct EpiBranch {
    static constexpr bool PERM = true; static constexpr int SC_W = 0x79797979, SC_A = 0x7c7c7c7c;
    const unsigned char* G; unsigned char* MG;
    __device__ __forceinline__ bool keep(const Unit& u) const { return u.z == 0; }
    __device__ __forceinline__ void operator()(f32x4 (&acc)[2][2][4][2], const Unit& u, int wr, int wc, int fr, int fq) const {
        const int row0 = u.pm * BM + wr * 64 + fr, col0 = u.pn * BM + wc * 32 + 8 * fq; const int z = u.z;
#pragma unroll
        for (int ai = 0; ai < 2; ++ai) {
            u32x2 gbv[4][2], gav[4][2];
#pragma unroll
            for (int m = 0; m < 4; ++m)
#pragma unroll
                for (int bj = 0; bj < 2; ++bj) { const unsigned char* gp = G + (size_t)(row0 + ai * HALF + m * 16) * 4096 + col0 + bj * HALF;
                    gbv[m][bj] = *(const u32x2*)(gp + 2048); if (z == 0) gav[m][bj] = *(const u32x2*)gp; }
            asm volatile("" ::: "memory");
#pragma unroll
            for (int m = 0; m < 4; ++m) {
                const size_t row = (size_t)(row0 + ai * HALF + m * 16);
#pragma unroll
                for (int bj = 0; bj < 2; ++bj) {
                    const u32x2 gb = gbv[m][bj];
                    float sb[8];
#pragma unroll
                    for (int i = 0; i < 4; ++i) { sb[i] = (float)((gb.x >> (8 * i)) & 0xffu); sb[4 + i] = (float)((gb.y >> (8 * i)) & 0xffu); }
                    if (z == 0) {
                        const u32x2 ga = gav[m][bj];
#pragma unroll
                        for (int i = 0; i < 4; ++i) {
                            acc[ai][bj][m][0][i] *= (float)((ga.x >> (8 * i)) & 0xffu) * __builtin_amdgcn_rcpf(sb[i]);
                            acc[ai][bj][m][1][i] *= (float)((ga.y >> (8 * i)) & 0xffu) * __builtin_amdgcn_rcpf(sb[4 + i]);
                        }
                    } else {
#pragma unroll
                        for (int i = 0; i < 8; ++i) sb[i] *= (16.0f / 255.0f);
                        const f32x4 a = acc[ai][bj][m][0], b = acc[ai][bj][m][1]; u32x4 w;
                        int w0 = 0, w1 = 0;
                        w0 = __builtin_amdgcn_cvt_pk_fp8_f32(a[0] * sb[0], a[1] * sb[1], w0, false); w0 = __builtin_amdgcn_cvt_pk_fp8_f32(a[2] * sb[2], a[3] * sb[3], w0, true);
                        w1 = __builtin_amdgcn_cvt_pk_fp8_f32(b[0] * sb[4], b[1] * sb[5], w1, false); w1 = __builtin_amdgcn_cvt_pk_fp8_f32(b[2] * sb[6], b[3] * sb[7], w1, true);
                        u32x2 wv; wv.x = (unsigned)w0; wv.y = (unsigned)w1; (void)w;
                        *(u32x2*)(MG + row * 2048 + col0 + bj * HALF) = wv;
                    }
                }
            }
            asm volatile("" ::: "memory");
        }
    }
};

template <bool WRITE_BF> struct EpiRes {
    static constexpr bool PERM = false; static constexpr int SC_W = 0x79797979, SC_A = 0x7c7c7c7c;
    const float* base; float* out; bf16_t* xb; float* ss;
    __device__ __forceinline__ bool keep(const Unit&) const { return false; }
    __device__ __forceinline__ void operator()(f32x4 (&acc)[2][2][4][2], const Unit& u, int wr, int wc, int fr, int fq) const {
        const int row0 = u.pm * BM + wr * 64 + fr, col0 = u.pn * BM + wc * 32 + 4 * fq;
#pragma unroll
        for (int ai = 0; ai < 2; ++ai) {
            f32x4 pre[4][2][2];
#pragma unroll
            for (int m = 0; m < 4; ++m)
#pragma unroll
                for (int bj = 0; bj < 2; ++bj)
#pragma unroll
                    for (int n = 0; n < 2; ++n) pre[m][bj][n] = *(const f32x4*)(base + (size_t)(row0 + ai * HALF + m * 16) * DM + col0 + bj * HALF + n * 16);
            asm volatile("" ::: "memory");
#pragma unroll
            for (int m = 0; m < 4; ++m) {
                const size_t row = (size_t)(row0 + ai * HALF + m * 16); const size_t off = row * DM + col0; float q = 0.f;
#pragma unroll
                for (int bj = 0; bj < 2; ++bj)
#pragma unroll
                    for (int n = 0; n < 2; ++n) {
                        const size_t o = off + bj * HALF + n * 16;
                        const f32x4 v = pre[m][bj][n] + acc[ai][bj][m][n];
                        *(f32x4*)(out + o) = v; q += (v[0] * v[0] + v[1] * v[1]) + (v[2] * v[2] + v[3] * v[3]);
                        if (WRITE_BF) { u32x2 w; w.x = cvt_pk_bf16(v[0], v[1]); w.y = cvt_pk_bf16(v[2], v[3]); *(u32x2*)(xb + o) = w; }
                    }
                q += __shfl_xor(q, 16); q += __shfl_xor(q, 32);
                if (fq == 0) atomicAdd(ss + row, q);
            }
            asm volatile("" ::: "memory");
        }
    }
};

struct EpiFinal {
    static constexpr bool PERM = false; static constexpr int SC_W = 0x79797979, SC_A = 0x7c7c7c7c;
    float* out; float* ss; unsigned* cnt; const float* gain;
    __device__ __forceinline__ bool keep(const Unit&) const { return false; }
    __device__ __forceinline__ void operator()(f32x4 (&acc)[2][2][4][2], const Unit& u, int wr, int wc, int fr, int fq) const {
        const int row0 = u.pm * BM + wr * 64 + fr, col0 = u.pn * BM + wc * 32 + 4 * fq; const bool second = u.f != 0;
#pragma unroll
        for (int ai = 0; ai < 2; ++ai) {
            f32x4 pre[4][2][2];
#pragma unroll
            for (int m = 0; m < 4; ++m)
#pragma unroll
                for (int bj = 0; bj < 2; ++bj)
#pragma unroll
                    for (int n = 0; n < 2; ++n) pre[m][bj][n] = *(const f32x4*)(out + (size_t)(row0 + ai * HALF + m * 16) * DM + col0 + bj * HALF + n * 16);
            asm volatile("" ::: "memory");
#pragma unroll
            for (int m = 0; m < 4; ++m) {
                const size_t row = (size_t)(row0 + ai * HALF + m * 16); const size_t off = row * DM + col0; float q = 0.f;
#pragma unroll
                for (int bj = 0; bj < 2; ++bj)
#pragma unroll
                    for (int n = 0; n < 2; ++n) {
                        const f32x4 v = pre[m][bj][n] + acc[ai][bj][m][n]; acc[ai][bj][m][n] = v;
                        q += (v[0] * v[0] + v[1] * v[1]) + (v[2] * v[2] + v[3] * v[3]);
                        if (!second) *(f32x4*)(out + off + bj * HALF + n * 16) = v;
                    }
                q += __shfl_xor(q, 16); q += __shfl_xor(q, 32);
                if (fq == 0) atomicAdd(ss + row, q);
            }
            asm volatile("" ::: "memory");
        }
        asm volatile("s_waitcnt vmcnt(0)" ::: "memory");
        unsigned* pc = cnt + 16 * u.pm;
        if ((threadIdx.x & 63) == 0) __hip_atomic_fetch_add(pc, 1u, __ATOMIC_RELAXED, __HIP_MEMORY_SCOPE_AGENT);
        if (!second) return;
        { const unsigned long long t0 = __builtin_amdgcn_s_memrealtime();
          while ((unsigned)__builtin_amdgcn_readfirstlane(__hip_atomic_load(pc, __ATOMIC_RELAXED, __HIP_MEMORY_SCOPE_AGENT)) < 64u) {
              if (__builtin_amdgcn_s_memrealtime() - t0 > 2000000ull) break;
              __builtin_amdgcn_s_sleep(4); }
          asm volatile("" ::: "memory"); }
#pragma unroll
        for (int ai = 0; ai < 2; ++ai)
#pragma unroll
            for (int m = 0; m < 4; ++m) {
                const size_t row = (size_t)(row0 + ai * HALF + m * 16); const size_t off = row * DM + col0;
                const float rstd = __builtin_amdgcn_rsqf(__hip_atomic_load(ss + row, __ATOMIC_RELAXED, __HIP_MEMORY_SCOPE_AGENT) * (1.0f / DM) + RMS_EPS);
#pragma unroll
                for (int bj = 0; bj < 2; ++bj)
#pragma unroll
                    for (int n = 0; n < 2; ++n) {
                        const size_t o = off + bj * HALF + n * 16; const int c = col0 + bj * HALF + n * 16;
                        const f32x4 gB = *(const f32x4*)(gain + c), gA = *(const f32x4*)(gain + c - 1024), vA = *(const f32x4*)(out + o - 1024);
                        *(f32x4*)(out + o) = acc[ai][bj][m][n] * rstd * gB;
                        *(f32x4*)(out + o - 1024) = vA * rstd * gA;
                    }
            }
    }
};

template <bool BASE_BF> struct EpiResB {
    static constexpr bool PERM = true; static constexpr int SC_W = 0x79797979, SC_A = 0x7b7b7b7b;
    const void* base; bf16_t* yb; float* ss;
    __device__ __forceinline__ bool keep(const Unit&) const { return false; }
    __device__ __forceinline__ void operator()(f32x4 (&acc)[2][2][4][2], const Unit& u, int wr, int wc, int fr, int fq) const {
        const int row0 = u.pm * BM + wr * 64 + fr, col0 = u.pn * BM + wc * 32 + 8 * fq;
#pragma unroll
        for (int ai = 0; ai < 2; ++ai) {
            f32x4 pf[4][2][2]; u32x4 pb[4][2];
#pragma unroll
            for (int m = 0; m < 4; ++m)
#pragma unroll
                for (int bj = 0; bj < 2; ++bj) { const size_t o = (size_t)(row0 + ai * HALF + m * 16) * DM + col0 + bj * HALF;
                    if (BASE_BF) pb[m][bj] = *(const u32x4*)((const bf16_t*)base + o);
                    else { pf[m][bj][0] = *(const f32x4*)((const float*)base + o); pf[m][bj][1] = *(const f32x4*)((const float*)base + o + 4); } }
            asm volatile("" ::: "memory");
#pragma unroll
            for (int m = 0; m < 4; ++m) {
                const size_t row = (size_t)(row0 + ai * HALF + m * 16); float q = 0.f;
#pragma unroll
                for (int bj = 0; bj < 2; ++bj) {
                    f32x4 x0, x1;
                    if (BASE_BF) { const u32x4 w = pb[m][bj]; x0 = (f32x4){bf_lo(w.x), bf_hi(w.x), bf_lo(w.y), bf_hi(w.y)}; x1 = (f32x4){bf_lo(w.z), bf_hi(w.z), bf_lo(w.w), bf_hi(w.w)}; }
                    else { x0 = pf[m][bj][0]; x1 = pf[m][bj][1]; }
                    const f32x4 v0 = x0 + acc[ai][bj][m][0], v1 = x1 + acc[ai][bj][m][1];
                    q += ((v0[0] * v0[0] + v0[1] * v0[1]) + (v0[2] * v0[2] + v0[3] * v0[3])) + ((v1[0] * v1[0] + v1[1] * v1[1]) + (v1[2] * v1[2] + v1[3] * v1[3]));
                    u32x4 w; w.x = cvt_pk_bf16(v0[0], v0[1]); w.y = cvt_pk_bf16(v0[2], v0[3]); w.z = cvt_pk_bf16(v1[0], v1[1]); w.w = cvt_pk_bf16(v1[2], v1[3]);
                    *(u32x4*)(yb + row * DM + col0 + bj * HALF) = w;
                }
                q += __shfl_xor(q, 16); q += __shfl_xor(q, 32);
                if (fq == 0) atomicAdd(ss + row, q);
            }
            asm volatile("" ::: "memory");
        }
    }
};

struct EpiUp {
    static constexpr bool PERM = true; static constexpr int SC_W = 0x79797979, SC_A = 0x7c7c7c7c;
    const float* ss; bf16_t* U;
    __device__ __forceinline__ bool keep(const Unit&) const { return false; }
    __device__ __forceinline__ void operator()(f32x4 (&acc)[2][2][4][2], const Unit& u, int wr, int wc, int fr, int fq) const {
        const int row0 = u.pm * BM + wr * 64 + fr, col0 = u.pn * BM + wc * 32 + 8 * fq;
        float rs[2][4];
#pragma unroll
        for (int ai = 0; ai < 2; ++ai)
#pragma unroll
            for (int m = 0; m < 4; ++m) rs[ai][m] = ss[row0 + ai * HALF + m * 16];
        asm volatile("" ::: "memory");
#pragma unroll
        for (int ai = 0; ai < 2; ++ai)
#pragma unroll
            for (int m = 0; m < 4; ++m) {
                const size_t row = (size_t)(row0 + ai * HALF + m * 16);
                const float rstd = __builtin_amdgcn_rsqf(rs[ai][m] * (1.0f / DM) + RMS_EPS);
#pragma unroll
                for (int bj = 0; bj < 2; ++bj) {
                    f32x4 a = acc[ai][bj][m][0] * rstd, b = acc[ai][bj][m][1] * rstd; u32x4 w;
#pragma unroll
                    for (int i = 0; i < 4; ++i) { a[i] = fmaxf(a[i], 0.f); a[i] *= a[i]; b[i] = fmaxf(b[i], 0.f); b[i] *= b[i]; }
                    w.x = cvt_pk_bf16(a[0], a[1]); w.y = cvt_pk_bf16(a[2], a[3]); w.z = cvt_pk_bf16(b[0], b[1]); w.w = cvt_pk_bf16(b[2], b[3]);
                    *(u32x4*)(U + row * DFF + col0 + bj * HALF) = w;
                }
            }
    }
};

template <class Epi, class Sched, bool ALIGN_EPI = false, bool SP2 = false, bool FP8 = false>
__device__ __forceinline__ void gemm_phase(PG8_LAS unsigned char* lds, const Gemm g, const Sched& S, const Epi& E) {
    int tid_ = threadIdx.x; asm volatile("" : "+v"(tid_));
    const int tid = tid_, wid = __builtin_amdgcn_readfirstlane(tid >> 6), lane = tid & 63, wr = wid >> 2, wc = wid & 3, fr = lane & 15, fq = lane >> 4;
    const int K = g.K, nt = K / BK;
    unsigned voffA[2], voffB[2];
#pragma unroll
    for (int i = 0; i < 2; ++i) { int R, C; stage_rc(tid * 16 + i * 8192, R, C); const int Rb = Epi::PERM ? ((R & ~31) + perm32(R & 31)) : R;
        voffA[i] = (unsigned)(R * K + C) * 2u; voffB[i] = (unsigned)(Rb * K + C) * 2u; }
    const size_t kstep = (size_t)(BK * 2);
    const size_t hstep = (size_t)HALF * K * 2;
    const size_t tstep = 2 * hstep;
    const unsigned ldsw = (unsigned)wid * 1024u;
    const int aoff = lds_byte(wr * 64 + fr, fq * 8), boff = lds_byte(wc * 32 + fr, fq * 8);
#define PG8_SA(b, h) (((b) * 2 + (h)) * HTB)
#define PG8_SB(b, h) ((4 + (b) * 2 + (h)) * HTB)
#define PG8_STAGE(bufoff, gbase, voff) do { _Pragma("unroll") for (int _i = 0; _i < 2; ++_i) \
        __builtin_amdgcn_global_load_lds((const unsigned*)((const char*)(gbase) + (voff)[_i]), (PG8_LAS unsigned*)(lds + (bufoff) + ldsw + _i * 8192), 16, 0, 0); } while (0)
#define PG8_LDA(dst, b, h) do { _Pragma("unroll") for (int m = 0; m < 4; ++m) { if constexpr (FP8) { dst##8[m].lo = *(const PG8_LAS v4i_t*)(lds + PG8_SA(b, h) + aoff + m * 2048); dst##8[m].hi = *(const PG8_LAS v4i_t*)(lds + PG8_SA(b, h) + aoff + m * 2048 + 1024); } \
        else { _Pragma("unroll") for (int k = 0; k < 2; ++k) dst[m][k] = *(const PG8_LAS bf16x8*)(lds + PG8_SA(b, h) + aoff + m * 2048 + k * 1024); } } } while (0)
#define PG8_LDB(dst, b, h) do { _Pragma("unroll") for (int n = 0; n < 2; ++n) { if constexpr (FP8) { dst##8[n].lo = *(const PG8_LAS v4i_t*)(lds + PG8_SB(b, h) + boff + n * 2048); dst##8[n].hi = *(const PG8_LAS v4i_t*)(lds + PG8_SB(b, h) + boff + n * 2048 + 1024); } \
        else { _Pragma("unroll") for (int k = 0; k < 2; ++k) dst[n][k] = *(const PG8_LAS bf16x8*)(lds + PG8_SB(b, h) + boff + n * 2048 + k * 1024); } } } while (0)
#define PG8_MMA(ai, bj, At, Bt) do { __builtin_amdgcn_s_setprio(1); _Pragma("unroll") for (int m = 0; m < 4; ++m) _Pragma("unroll") for (int n = 0; n < 2; ++n) { \
        if constexpr (FP8) {   \
            asm volatile("v_mfma_scale_f32_16x16x128_f8f6f4 %0, %1, %2, %0, %3, %4 op_sel_hi:[0,0,0]" : "+v"(acc[ai][bj][m][n]) : "v"(Bt##8[n]), "v"(At##8[m]), "v"(sc1_), "v"(sc2_));   \
        } else { _Pragma("unroll") for (int k = 0; k < 2; ++k) acc[ai][bj][m][n] = __builtin_amdgcn_mfma_f32_16x16x32_bf16(Bt[n][k], At[m][k], acc[ai][bj][m][n], 0, 0, 0); } } \
        __builtin_amdgcn_s_setprio(0); } while (0)
#define PG8_WAIT_V(n) asm volatile("s_waitcnt vmcnt(" #n ")" ::: "memory")
#define PG8_WAIT_L(n) asm volatile("s_waitcnt lgkmcnt(" #n ")" ::: "memory")
#define PG8_BAR __builtin_amdgcn_s_barrier()
#define PG8_SCHED __builtin_amdgcn_sched_barrier(0)
    Unit cur, nxt; int ui = 0;
    if (!S.next(0, cur)) return;
    f32x4 acc[2][2][4][2];
#pragma unroll
    for (int a = 0; a < 2; ++a)
#pragma unroll
        for (int b = 0; b < 2; ++b)
#pragma unroll
            for (int m = 0; m < 4; ++m)
#pragma unroll
                for (int n = 0; n < 2; ++n) acc[a][b][m][n] = (f32x4){0.f, 0.f, 0.f, 0.f};
    int sc1_ = Epi::SC_W, sc2_ = Epi::SC_A; asm volatile("" : "+v"(sc1_), "+v"(sc2_));
    bf16x8 At[4][2], B0[2][2], B1[2][2]; v8i_t At8[4], B08[2], B18[2];
    const char* cA = (const char*)(cur.z ? g.A1 : g.A0) + (size_t)cur.pm * tstep; const char* cB = (const char*)(cur.z ? g.B1 : g.B0) + (size_t)cur.pn * tstep;
    if constexpr (SP2) {
        PG8_STAGE(PG8_SB(0, 0), cB, voffB); PG8_STAGE(PG8_SB(0, 1), cB + hstep, voffB); PG8_STAGE(PG8_SA(0, 0), cA, voffA); PG8_STAGE(PG8_SA(0, 1), cA + hstep, voffA);
        if (wr == 1) PG8_BAR;
        PG8_WAIT_V(2); PG8_BAR;
        PG8_STAGE(PG8_SB(1, 0), cB + kstep, voffB); PG8_STAGE(PG8_SA(1, 0), cA + kstep, voffA); PG8_STAGE(PG8_SB(1, 1), cB + hstep + kstep, voffB);
        PG8_WAIT_V(6); PG8_BAR;
    } else {
        PG8_STAGE(PG8_SB(0, 0), cB, voffB); PG8_STAGE(PG8_SA(0, 0), cA, voffA); PG8_STAGE(PG8_SB(0, 1), cB + hstep, voffB); PG8_STAGE(PG8_SA(0, 1), cA + hstep, voffA);
        if (wr == 1) PG8_BAR;
        PG8_WAIT_V(4); PG8_BAR;
        PG8_STAGE(PG8_SB(1, 0), cB + kstep, voffB); PG8_STAGE(PG8_SA(1, 0), cA + kstep, voffA); PG8_STAGE(PG8_SB(1, 1), cB + hstep + kstep, voffB);
        PG8_WAIT_V(6); PG8_BAR;
    }
    for (;;) {
        const bool has_next = S.next(ui + 1, nxt);
        const char* nA = has_next ? (const char*)(nxt.z ? g.A1 : g.A0) + (size_t)nxt.pm * tstep : cA; const char* nB = has_next ? (const char*)(nxt.z ? g.B1 : g.B0) + (size_t)nxt.pn * tstep : cB;
        for (int t = 0; t < nt; t += 2) {
            const bool last = (t == nt - 2);
            const char* a1 = cA + (size_t)(t + 1) * kstep;
            const char* a2 = last ? nA : cA + (size_t)(t + 2) * kstep; const char* b2 = last ? nB : cB + (size_t)(t + 2) * kstep;
            const char* a3 = a2 + kstep; const char* b3 = b2 + kstep;
            if constexpr (SP2) {
            PG8_LDB(B0, 0, 0); PG8_LDB(B1, 0, 1); PG8_SCHED; PG8_LDA(At, 0, 0); PG8_STAGE(PG8_SA(1, 1), a1 + hstep, voffA);
            PG8_WAIT_V(8); PG8_WAIT_L(0); PG8_BAR; PG8_MMA(0, 0, At, B0); PG8_MMA(0, 1, At, B1); PG8_BAR; PG8_SCHED;
            PG8_LDA(At, 0, 1); PG8_STAGE(PG8_SB(0, 0), b2, voffB); PG8_STAGE(PG8_SB(0, 1), b2 + hstep, voffB); PG8_STAGE(PG8_SA(0, 0), a2, voffA);
            PG8_WAIT_V(8); PG8_WAIT_L(0); PG8_BAR; PG8_MMA(1, 0, At, B0); PG8_MMA(1, 1, At, B1); PG8_BAR; PG8_SCHED;
            PG8_LDB(B0, 1, 0); PG8_LDB(B1, 1, 1); PG8_SCHED; PG8_LDA(At, 1, 0); PG8_STAGE(PG8_SA(0, 1), a2 + hstep, voffA);
            PG8_WAIT_V(8); PG8_WAIT_L(0); PG8_BAR; PG8_MMA(0, 0, At, B0); PG8_MMA(0, 1, At, B1); PG8_BAR; PG8_SCHED;
            PG8_LDA(At, 1, 1); PG8_STAGE(PG8_SB(1, 0), b3, voffB); PG8_STAGE(PG8_SB(1, 1), b3 + hstep, voffB); PG8_STAGE(PG8_SA(1, 0), a3, voffA);
            PG8_WAIT_V(8); PG8_WAIT_L(0); PG8_BAR; PG8_MMA(1, 0, At, B0); PG8_MMA(1, 1, At, B1); PG8_BAR; PG8_SCHED;
            } else {
            PG8_LDB(B0, 0, 0); PG8_SCHED; PG8_LDA(At, 0, 0); PG8_STAGE(PG8_SA(1, 1), a1 + hstep, voffA);
            PG8_WAIT_L(8); PG8_BAR; PG8_WAIT_L(0); PG8_MMA(0, 0, At, B0); PG8_BAR; PG8_SCHED;
            PG8_LDB(B1, 0, 1); PG8_STAGE(PG8_SB(0, 0), b2, voffB);
            PG8_BAR; PG8_WAIT_L(0); PG8_MMA(0, 1, At, B1); PG8_BAR;
            PG8_LDA(At, 0, 1); PG8_STAGE(PG8_SA(0, 0), a2, voffA);
            PG8_BAR; PG8_WAIT_L(0); PG8_MMA(1, 0, At, B0); PG8_BAR; PG8_SCHED;
            PG8_STAGE(PG8_SB(0, 1), b2 + hstep, voffB);
            PG8_WAIT_V(6); PG8_BAR; PG8_MMA(1, 1, At, B1); PG8_BAR;
            PG8_LDB(B0, 1, 0); PG8_SCHED; PG8_LDA(At, 1, 0); PG8_STAGE(PG8_SA(0, 1), a2 + hstep, voffA);
            PG8_WAIT_L(8); PG8_BAR; PG8_WAIT_L(0); PG8_MMA(0, 0, At, B0); PG8_BAR; PG8_SCHED;
            PG8_LDB(B1, 1, 1); PG8_STAGE(PG8_SB(1, 0), b3, voffB);
            PG8_BAR; PG8_WAIT_L(0); PG8_MMA(0, 1, At, B1); PG8_BAR;
            PG8_LDA(At, 1, 1); PG8_STAGE(PG8_SA(1, 0), a3, voffA);
            PG8_BAR; PG8_WAIT_L(0); PG8_MMA(1, 0, At, B0); PG8_BAR; PG8_SCHED;
            PG8_STAGE(PG8_SB(1, 1), b3 + hstep, voffB);
            PG8_WAIT_V(6); PG8_BAR; PG8_MMA(1, 1, At, B1); PG8_BAR;
            }
        }
        if constexpr (ALIGN_EPI) { if (wr == 0) PG8_BAR; }
        if constexpr (FP8) asm volatile("s_nop 15\n\ts_nop 7" ::: "memory");
        E(acc, cur, wr, wc, fr, fq);
        if (!has_next) break;
        if (!E.keep(cur))
#pragma unroll
        for (int a = 0; a < 2; ++a)
#pragma unroll
            for (int b = 0; b < 2; ++b)
#pragma unroll
                for (int m = 0; m < 4; ++m)
#pragma unroll
                    for (int n = 0; n < 2; ++n) acc[a][b][m][n] = (f32x4){0.f, 0.f, 0.f, 0.f};
        cur = nxt; cA = nA; cB = nB; ++ui;
        if constexpr (ALIGN_EPI) { if (wr == 1) PG8_BAR; }
    }
    PG8_WAIT_V(0);
    if constexpr (!ALIGN_EPI) { if (wr == 0) PG8_BAR; }
    PG8_BAR;
#undef PG8_SA
#undef PG8_SB
#undef PG8_STAGE
#undef PG8_LDA
#undef PG8_LDB
#undef PG8_MMA
#undef PG8_WAIT_V
#undef PG8_WAIT_L
#undef PG8_BAR
#undef PG8_SCHED
}
}


namespace attn_body {
using bf16=unsigned short;
using bf16x8=__attribute__((ext_vector_type(8)))short;
using s16x4=__attribute__((ext_vector_type(4)))short;
using f32x16=__attribute__((ext_vector_type(16)))float;
using u32x4=__attribute__((ext_vector_type(4)))unsigned;
using f32x4v=__attribute__((ext_vector_type(4)))float;
constexpr int BATCH=4,NHEAD=16,SEQ=8192,D=64,DM=NHEAD*D;
constexpr int NW=8,QBLK=32,QB=QBLK*NW,KVBLK=64,NQB=SEQ/QB;
constexpr int ATTN_PITCH=DM, ATTN_UNIT_ROWS=QB;
__device__ __forceinline__ int crow(int r,int hi){return (r&3)+8*(r>>2)+4*hi;}
#define SBAR() __builtin_amdgcn_sched_barrier(0)
template<bool SWA> __device__ __forceinline__ void cmask(f32x16&p0,f32x16&p1,int jb,int qrel,int hi){
  const float NEG=-INFINITY; int kb=64*jb+4*hi;
  #pragma unroll
  for(int r=0;r<16;++r){int kv=kb+(r&3)+8*(r>>2);
    if(SWA){ if(kv>qrel||kv<=qrel-128)p0[r]=NEG; if(kv+32>qrel||kv+32<=qrel-128)p1[r]=NEG; }
    else{ if(kv>qrel)p0[r]=NEG; if(kv+32>qrel)p1[r]=NEG; } }
}

constexpr int NSLOT=3, SLOTB=8192;
#ifndef NVB
#define NVB 8
#endif
constexpr int LDS_K=0, LDS_V=NSLOT*SLOTB, LDS_WS=2*NSLOT*SLOTB, LDS_OST=LDS_WS+NW*64*4, LDS_CB=LDS_OST+NW*4096, LDS_BYTES=LDS_CB+4*256;
constexpr float C2=0.125f*1.4426950408889634f;
__device__ __forceinline__ void glds16(const void*gsrc,unsigned lds_dst){unsigned keep;
  asm volatile("s_mov_b32 %0, m0\n\ts_mov_b32 m0, %2\n\ts_nop 0\n\tglobal_load_lds_dwordx4 %1, off\n\ts_mov_b32 m0, %0":"=&s"(keep):"v"(gsrc),"s"(lds_dst):"memory");}
__device__ __forceinline__ void glds4(const void*gsrc,unsigned lds_dst){unsigned keep;
  asm volatile("s_mov_b32 %0, m0\n\ts_mov_b32 m0, %2\n\ts_nop 0\n\tglobal_load_lds_dword %1, off\n\ts_mov_b32 m0, %0":"=&s"(keep):"v"(gsrc),"s"(lds_dst):"memory");}
__device__ __forceinline__ float max3f(float a,float b,float c){float r;asm("v_max3_f32 %0, %1, %2, %3":"=v"(r):"v"(a),"v"(b),"v"(c));return r;}
__device__ __forceinline__ float max2f(float a,float b){float r;asm("v_max_f32_e32 %0, %1, %2":"=v"(r):"v"(a),"v"(b));return r;}
__device__ __forceinline__ float fadd_s(float a,float b){float r;asm("v_add_f32_e32 %0, %1, %2":"=v"(r):"v"(a),"v"(b));return r;}
__device__ __forceinline__ float fsub_s(float a,float b){float r;asm("v_sub_f32_e32 %0, %1, %2":"=v"(r):"v"(a),"v"(b));return r;}
typedef float f32x2_t __attribute__((ext_vector_type(2))); typedef __bf16 bf16x2_t __attribute__((ext_vector_type(2)));
__device__ __forceinline__ unsigned cvtpk_s(float lo,float hi){f32x2_t v={lo,hi};bf16x2_t b=__builtin_convertvector(v,bf16x2_t);return __builtin_bit_cast(unsigned,b);}
#define WAIT_BAR(N) asm volatile("s_waitcnt vmcnt(" #N ") lgkmcnt(0)\n\ts_barrier":::"memory")

__device__ __forceinline__ void qkt(f32x16&p0,f32x16&p1,const char*Kslot,const bf16x8*qr,int r32,int hi){
  const char*kb=Kslot+hi*1024+r32*16;
  #pragma unroll
  for(int d0=0;d0<4;++d0){
    const bf16x8 b0=*reinterpret_cast<const bf16x8*>(kb+d0*2048);
    const bf16x8 b1=*reinterpret_cast<const bf16x8*>(kb+d0*2048+512);
    {p0=__builtin_amdgcn_mfma_f32_32x32x16_bf16(b0,qr[d0],p0,0,0,0);p1=__builtin_amdgcn_mfma_f32_32x32x16_bf16(b1,qr[d0],p1,0,0,0);}}
}
typedef __attribute__((address_space(3))) const char* lds_cptr;
typedef short v4i16_t __attribute__((ext_vector_type(4)));
__device__ __forceinline__ void kload8(bf16x8*kf,lds_cptr kp){
  kf[0]=*(const __attribute__((address_space(3))) bf16x8*)(kp);      kf[1]=*(const __attribute__((address_space(3))) bf16x8*)(kp+512);
  kf[2]=*(const __attribute__((address_space(3))) bf16x8*)(kp+2048); kf[3]=*(const __attribute__((address_space(3))) bf16x8*)(kp+2560);
  kf[4]=*(const __attribute__((address_space(3))) bf16x8*)(kp+4096); kf[5]=*(const __attribute__((address_space(3))) bf16x8*)(kp+4608);
  kf[6]=*(const __attribute__((address_space(3))) bf16x8*)(kp+6144); kf[7]=*(const __attribute__((address_space(3))) bf16x8*)(kp+6656);
}
__device__ __forceinline__ void kload2(bf16x8*kf,lds_cptr kp,int j){ kf[2*j]=*(const __attribute__((address_space(3))) bf16x8*)(kp+j*2048); kf[2*j+1]=*(const __attribute__((address_space(3))) bf16x8*)(kp+j*2048+512); }
__device__ __forceinline__ s16x4 vtr(lds_cptr p){ return __builtin_bit_cast(s16x4,__builtin_amdgcn_ds_read_tr16_b64_v4i16((__attribute__((address_space(3))) v4i16_t*)p)); }
__device__ __forceinline__ float rowmax(const f32x16&p0,const f32x16&p1){
  float a=max3f(p0[0],p0[1],p1[0]),b=max3f(p0[2],p0[3],p1[1]);a=max3f(a,p1[2],p1[3]);
  #pragma unroll
  for(int r=4;r<16;r+=4){a=max3f(a,p0[r],p0[r+1]);b=max3f(b,p0[r+2],p0[r+3]);a=max3f(a,p1[r],p1[r+1]);b=max3f(b,p1[r+2],p1[r+3]);}
  const float m=max2f(a,b);
  auto rr=__builtin_amdgcn_permlane32_swap(__float_as_uint(m),__float_as_uint(m),false,false);
  return max2f(__uint_as_float(rr[0]),__uint_as_float(rr[1]));
}
__device__ __forceinline__ void pv(f32x16*o,int vb,bf16x8 pa0,bf16x8 pa1,bf16x8 pa2,bf16x8 pa3){
  #pragma unroll
  for(int d0=0;d0<2;++d0){s16x4 lo[4],hi[4];
    #pragma unroll
    for(int ks=0;ks<4;++ks){
      asm volatile("ds_read_b64_tr_b16 %0,%1 offset:%c2":"=&v"(lo[ks]):"v"(vb),"i"(d0*4096+ks*1024):"memory");
      asm volatile("ds_read_b64_tr_b16 %0,%1 offset:%c2":"=&v"(hi[ks]):"v"(vb),"i"(d0*4096+ks*1024+512):"memory");}
    asm volatile("s_waitcnt lgkmcnt(0)":::"memory");SBAR();
    #define PK(k) (bf16x8){lo[k][0],lo[k][1],lo[k][2],lo[k][3],hi[k][0],hi[k][1],hi[k][2],hi[k][3]}
    o[d0]=__builtin_amdgcn_mfma_f32_32x32x16_bf16(pa0,PK(0),o[d0],0,0,0);
    o[d0]=__builtin_amdgcn_mfma_f32_32x32x16_bf16(pa1,PK(1),o[d0],0,0,0);
    o[d0]=__builtin_amdgcn_mfma_f32_32x32x16_bf16(pa2,PK(2),o[d0],0,0,0);
    o[d0]=__builtin_amdgcn_mfma_f32_32x32x16_bf16(pa3,PK(3),o[d0],0,0,0);
    #undef PK
  }
}

typedef __attribute__((address_space(3))) const f32x4v* lds_f4ptr;
__device__ __forceinline__ void fill_bias(f32x16&c0,f32x16&c1,lds_cptr cb,float negmh){
  #pragma unroll
  for(int g=0;g<4;++g){ const f32x4v v=*(lds_f4ptr)(cb+g*32), w=*(lds_f4ptr)(cb+128+g*32);
    #pragma unroll
    for(int i=0;i<4;i+=2){ const f32x2_t nm={negmh,negmh}; const f32x2_t a=nm-(f32x2_t){v[i],v[i+1]}, b=nm-(f32x2_t){w[i],w[i+1]}; c0[4*g+i]=a.x; c0[4*g+i+1]=a.y; c1[4*g+i]=b.x; c1[4*g+i+1]=b.y; } }
}
#ifndef ATTN_STORE16
#define ATTN_STORE16(p,v) (*(u32x4*)(p)=(v))
#endif
template<int THRL,bool FOX,int KP> __device__ __forceinline__ void attn_unit(int b,int h,int qb,const bf16*Q,const bf16*__restrict__ K,const bf16*__restrict__ V,bf16*O,const float*__restrict__ Cb,float sink2,char*shm){
  int tid_=threadIdx.x; asm volatile("":"+v"(tid_));
  const int tid=tid_,lane=tid&63,r32=lane&31,hi=lane>>5; const int wid=__builtin_amdgcn_readfirstlane(tid>>6);
  const long rowbase=(long)b*SEQ; const int q0=qb*QB;
  const bf16*Qw=Q+(rowbase+q0+wid*QBLK)*DM+h*D;
  const int kvh=FOX?h:(h>>3); const int T0=FOX?0:(qb==0?0:4*qb-2);
  const bf16*Kh=K+(rowbase+(long)T0*KVBLK)*KP+kvh*D,*Vh=V+(rowbase+(long)T0*KVBLK)*KP+kvh*D; const float*Cs=FOX?Cb+lane:nullptr;
  const unsigned lds0=(unsigned)(uintptr_t)shm;
  float*wsf=(float*)(shm+LDS_WS)+wid*64;
  const bf16*ksrc=Kh+(long)lane*KP+wid*8;
  const bf16*vsrc=Vh+(long)(16*(wid&3)+(lane>>2))*KP+(wid>>2)*32+(lane&3)*8;
  const unsigned kdst=lds0+LDS_K+wid*1024, vdst=lds0+LDS_V+wid*1024;
  #define DMA_K(t,slot) glds16(ksrc+(long)(t)*KVBLK*KP,(unsigned)__builtin_amdgcn_readfirstlane(kdst+(slot)))
  #define DMA_C(t) do{ if(FOX) glds4(Cs+(long)(t)*KVBLK,(unsigned)__builtin_amdgcn_readfirstlane(lds0+LDS_CB+(((t)&3)<<8))); }while(0)
  #define PREFILL(X0,X1,t) do{ if(FOX){ fill_bias(X0,X1,cb0+(((t)&3)<<8),-mhat); } else { _Pragma("unroll") for(int r=0;r<16;++r){X0[r]=-mhat;X1[r]=-mhat;} } }while(0)
  #define DMA_V(t,slot) glds16(vsrc+(long)(t)*KVBLK*KP,(unsigned)__builtin_amdgcn_readfirstlane(vdst+(slot)))
  const int vb0=(int)(lds0+LDS_V)+((lane>>4)&1)*32+(lane&3)*8+(4*hi+((lane&15)>>2))*64;
  const char*Kbase=shm+LDS_K; bf16x8 kf[8];
  const lds_cptr shm3=(lds_cptr)shm; const lds_cptr cb0=shm3+LDS_CB+hi*16; const lds_cptr kp0=shm3+LDS_K+hi*1024+r32*16; const lds_cptr vp0=shm3+LDS_V+((lane>>4)&1)*32+(lane&3)*8+(4*hi+((lane&15)>>2))*64;
  const int NT=FOX?(q0+QB)/KVBLK:(qb==0?4:6);
  DMA_K(0,0);DMA_C(0);DMA_V(0,0);DMA_K(1,SLOTB);DMA_C(1);
  bf16x8 qr[4];
  #pragma unroll
  for(int d0=0;d0<4;++d0)qr[d0]=*reinterpret_cast<const bf16x8*>(&Qw[(long)r32*DM+d0*16+hi*8]);
  float mhat=FOX?-Cb[q0+wid*QBLK+r32]:0.f,l_reg=0.f;    f32x16 o[2];o[0]=f32x16{};o[1]=f32x16{};
  const int qrel=wid*QBLK+r32;
  #define CMASK(P0,P1,t) do{int jb_=(t)-(NT-4); if(!FOX||jb_>=0)cmask<!FOX>(P0,P1,jb_,qrel,hi);}while(0)
  bool resc=false;
  #define START(P0,P1) do{ float rm=__builtin_fmaxf(rowmax(P0,P1),0.f); resc=false;     \
    { const float dl=rm; mhat=fadd_s(mhat,dl); \
      _Pragma("unroll") for(int r=0;r<16;++r){P0[r]=fsub_s(P0[r],dl);P1[r]=fsub_s(P1[r],dl);} } \
    _Pragma("unroll") for(int r=0;r<16;++r)P0[r]=__builtin_amdgcn_exp2f(P0[r]); }while(0)
  #define RESC() do{ if(resc){ asm volatile("s_waitcnt lgkmcnt(0)":::"memory"); \
      _Pragma("unroll") for(int d_=0;d_<2;++d_) _Pragma("unroll") for(int r=0;r<16;++r)o[d_][r]*=wsf[crow(r,hi)]; } }while(0)
  f32x16 pA0,pA1,pB0,pB1;
  int sl_prev=0,sl_cur=0,sl_next=SLOTB;
  #define ROT() do{sl_prev=sl_cur;sl_cur=sl_next;sl_next=(sl_next==(NSLOT-1)*SLOTB)?0:sl_next+SLOTB;}while(0)
  DMA_K(2,2*SLOTB);DMA_C(2);
  if(FOX){WAIT_BAR(5);}else{WAIT_BAR(3);}
  PREFILL(pA0,pA1,0); qkt(pA0,pA1,Kbase,qr,r32,hi);asm volatile("s_nop 15\n\ts_nop 7":"+v"(pA0),"+v"(pA1));CMASK(pA0,pA1,0);
  START(pA0,pA1);
  _Pragma("unroll") for(int r=0;r<16;++r)pA1[r]=__builtin_amdgcn_exp2f(pA1[r]);
  WAIT_BAR(0);
  DMA_K(3,0);DMA_C(3);DMA_V(1,SLOTB);
  ROT();
  kload8(kf,kp0+sl_cur);
  PREFILL(pB0,pB1,1); if(FOX){ WAIT_BAR(3); }else{ WAIT_BAR(2); }
  s16x4 vlo[NVB],vhi[NVB]; u32x4 pw0,pw1,pw2,pw3;
  #define PKW(P,B) cvtpk_s(P[B],P[B+1])
  #define PAF(k) __builtin_bit_cast(bf16x8,pw##k)
  #define VFR(j) (bf16x8){vlo[(j)%NVB][0],vlo[(j)%NVB][1],vlo[(j)%NVB][2],vlo[(j)%NVB][3],vhi[(j)%NVB][0],vhi[(j)%NVB][1],vhi[(j)%NVB][2],vhi[(j)%NVB][3]}
  #define PIN(x) asm volatile("":"+v"(x))
  #define MX3(a,b,c) __builtin_fmaxf(__builtin_fmaxf((a),(b)),(c))
  #define GAPA(MF,A0,A1,A2,A3,W0,W1,PW) do{ MF; sacc+=(f32x2_t){A0,A1}; sacc+=(f32x2_t){A2,A3}; PIN(sacc); W0; W1; PIN(PW); SBAR(); }while(0)
  #define EX(v) __builtin_amdgcn_exp2f(v)
  #define GAPB(MF,VR,BX_,X,B) do{ MF; VR; BX_; X[B]=EX(X[B]); X[B+1]=EX(X[B+1]); X[B+2]=EX(X[B+2]); X[B+3]=EX(X[B+3]); PIN(X); SBAR(); }while(0)
  #define VOFF(j) ((((j)&1)*4096)+(((j)>>1)*1024))
  #define VRD(j) do{ if((j)>=0&&(j)<8){ vlo[(j)%NVB]=vtr(vp_+VOFF(j)); vhi[(j)%NVB]=vtr(vp_+VOFF(j)+512); } }while(0)
  #define KRD(G,j) do{ if(G){ kload2(kf,kp0+sl_next,j); SBAR(); } }while(0)
  #define BSUBX(X,g) do{ const f32x2_t nm_={nmh_,nmh_}; const f32x2_t a_=nm_-(f32x2_t){bt[0],bt[1]}, b_=nm_-(f32x2_t){bt[2],bt[3]}; X[4*(g)+0]=a_.x; X[4*(g)+1]=a_.y; X[4*(g)+2]=b_.x; X[4*(g)+3]=b_.y; }while(0)
  #define BXX(Y0,Y1,j,G) do{ if(FOX&&(G)){ if((j)>=1&&(j)<=4){BSUBX(Y0,((j)-1)&3);} if((j)>=5){BSUBX(Y1,((j)-5)&3);} if((j)<8){ bt=*(lds_f4ptr)(cbn_+(((j)&3)*32+((j)>>2)*128)); } } }while(0)
  #define STEP(C0,C1,P0,P1,t,GK,GV,GL) do{ SBAR(); f32x4v bt; const lds_cptr cbn_=cb0+((((t)+1)&3)<<8); \
    const lds_cptr vp_=vp0+sl_prev; \
    VRD(0-(8-NVB)); SBAR(); f32x2_t sacc={P0[0],P0[1]}; \
    GAPA(C0=__builtin_amdgcn_mfma_f32_32x32x16_bf16(kf[0],qr[0],C0,0,0,0), P0[2],P0[3],P0[4],P0[5],     pw0[0]=PKW(P0,0), pw0[1]=PKW(P0,2), pw0); \
    VRD(1-(8-NVB)); SBAR(); GAPA(C1=__builtin_amdgcn_mfma_f32_32x32x16_bf16(kf[1],qr[0],C1,0,0,0), P0[6],P0[7],P0[8],P0[9],     pw0[2]=PKW(P0,4), pw0[3]=PKW(P0,6), pw0); \
    VRD(2-(8-NVB)); SBAR(); GAPA(C0=__builtin_amdgcn_mfma_f32_32x32x16_bf16(kf[2],qr[1],C0,0,0,0),   P0[10],P0[11],P0[12],P0[13], pw1[0]=PKW(P0,8), pw1[1]=PKW(P0,10), pw1); \
    VRD(3-(8-NVB)); SBAR(); GAPA(C1=__builtin_amdgcn_mfma_f32_32x32x16_bf16(kf[3],qr[1],C1,0,0,0),   P0[14],P0[15],P1[0],P1[1],   pw1[2]=PKW(P0,12),pw1[3]=PKW(P0,14), pw1); \
    VRD(4-(8-NVB)); SBAR(); GAPA(C0=__builtin_amdgcn_mfma_f32_32x32x16_bf16(kf[4],qr[2],C0,0,0,0),   P1[2],P1[3],P1[4],P1[5],     pw2[0]=PKW(P1,0), pw2[1]=PKW(P1,2), pw2); \
    VRD(5-(8-NVB)); SBAR(); GAPA(C1=__builtin_amdgcn_mfma_f32_32x32x16_bf16(kf[5],qr[2],C1,0,0,0),   P1[6],P1[7],P1[8],P1[9],     pw2[2]=PKW(P1,4), pw2[3]=PKW(P1,6), pw2); \
    VRD(6-(8-NVB)); SBAR(); GAPA(C0=__builtin_amdgcn_mfma_f32_32x32x16_bf16(kf[6],qr[3],C0,0,0,0),   P1[10],P1[11],P1[12],P1[13], pw3[0]=PKW(P1,8), pw3[1]=PKW(P1,10), pw3); \
    VRD(7-(8-NVB)); SBAR(); GAPA(C1=__builtin_amdgcn_mfma_f32_32x32x16_bf16(kf[7],qr[3],C1,0,0,0),   P1[14],P1[15],0.f,0.f,       pw3[2]=PKW(P1,12),pw3[3]=PKW(P1,14), pw3); \
    l_reg+=sacc.x+sacc.y; \
    if(GK){DMA_K((t)+3,sl_cur);DMA_C((t)+3);} if(GV){DMA_V((t)+1,sl_next);} \
    CMASK(C0,C1,t); \
    { float a=MX3(C0[0],C0[1],C1[0]),b=MX3(C0[2],C0[3],C1[1]); a=MX3(a,C1[2],C1[3]); \
      _Pragma("unroll") for(int r=4;r<16;r+=4){a=MX3(a,C0[r],C0[r+1]);b=MX3(b,C0[r+2],C0[r+3]);a=MX3(a,C1[r],C1[r+1]);b=MX3(b,C1[r+2],C1[r+3]);} \
      float rm=__builtin_fmaxf(a,b); { auto rr=__builtin_amdgcn_permlane32_swap(__float_as_uint(rm),__float_as_uint(rm),false,false); rm=__builtin_fmaxf(__uint_as_float(rr[0]),__uint_as_float(rr[1])); } \
      resc=false; \
      if(__builtin_expect(__any(rm>(float)THRL),0)){ const float dl=__builtin_fmaxf(rm,0.f); mhat+=dl; \
        _Pragma("unroll") for(int r=0;r<16;++r){C0[r]-=dl;C1[r]-=dl;} \
        const float f=__builtin_amdgcn_exp2f(-dl); l_reg*=f; if(hi==0)wsf[r32]=f; resc=true; } } \
    const float nmh_=-mhat; SBAR(); \
    GAPB(o[0]=__builtin_amdgcn_mfma_f32_32x32x16_bf16(PAF(0),VFR(0),o[0],0,0,0), VRD(0+NVB), BXX(P0,P1,0,GL), C0,0); \
    GAPB(o[1]=__builtin_amdgcn_mfma_f32_32x32x16_bf16(PAF(0),VFR(1),o[1],0,0,0), VRD(1+NVB), BXX(P0,P1,1,GL), C0,4); \
    KRD(GL,0); GAPB(o[0]=__builtin_amdgcn_mfma_f32_32x32x16_bf16(PAF(1),VFR(2),o[0],0,0,0), VRD(2+NVB), BXX(P0,P1,2,GL), C0,8); \
    KRD(GL,1); GAPB(o[1]=__builtin_amdgcn_mfma_f32_32x32x16_bf16(PAF(1),VFR(3),o[1],0,0,0), VRD(3+NVB), BXX(P0,P1,3,GL), C0,12); \
    KRD(GL,2); GAPB(o[0]=__builtin_amdgcn_mfma_f32_32x32x16_bf16(PAF(2),VFR(4),o[0],0,0,0), VRD(4+NVB), BXX(P0,P1,4,GL), C1,0); \
    KRD(GL,3); GAPB(o[1]=__builtin_amdgcn_mfma_f32_32x32x16_bf16(PAF(2),VFR(5),o[1],0,0,0), VRD(5+NVB), BXX(P0,P1,5,GL), C1,4); \
    GAPB(o[0]=__builtin_amdgcn_mfma_f32_32x32x16_bf16(PAF(3),VFR(6),o[0],0,0,0), VRD(6+NVB), BXX(P0,P1,6,GL), C1,8); \
    GAPB(o[1]=__builtin_amdgcn_mfma_f32_32x32x16_bf16(PAF(3),VFR(7),o[1],0,0,0), VRD(7+NVB), BXX(P0,P1,7,GL), C1,12); \
    BXX(P0,P1,8,GL); if(!FOX&&(GL)){ PREFILL(P0,P1,(t)+1); } \
    }while(0)
  int t=1;
  #undef CMASK
  #define CMASK(P0,P1,t) do{}while(0)
  for(;t+5<NT;t+=2){
    STEP(pB0,pB1,pA0,pA1,t,true,true,true);     if(FOX){WAIT_BAR(3);}else{WAIT_BAR(2);} RESC(); ROT();
    STEP(pA0,pA1,pB0,pB1,t+1,true,true,true);   if(FOX){WAIT_BAR(3);}else{WAIT_BAR(2);} RESC(); ROT();
  }
  #undef CMASK
  #define CMASK(P0,P1,t) do{int jb_=(t)-(NT-4); if(!FOX||jb_>=0)cmask<!FOX>(P0,P1,jb_,qrel,hi);}while(0)
  #define ENDW(tt) do{ if((tt)+3<NT){ if(FOX){WAIT_BAR(3);}else{WAIT_BAR(2);} } else if((tt)+2<NT){WAIT_BAR(1);} else {WAIT_BAR(0);} }while(0)
  for(;t+1<NT;t+=2){
    STEP(pB0,pB1,pA0,pA1,t,(t+3<NT),(t+1<NT),(t+1<NT));       ENDW(t);   RESC(); ROT();
    STEP(pA0,pA1,pB0,pB1,t+1,(t+4<NT),(t+2<NT),(t+2<NT));     ENDW(t+1); RESC(); ROT();
  }
  STEP(pB0,pB1,pA0,pA1,NT-1,false,false,false); RESC();
  { float sacc=pB0[0]+pB0[1]; _Pragma("unroll") for(int r=2;r<16;++r)sacc+=pB0[r]; _Pragma("unroll") for(int r=0;r<16;++r)sacc+=pB1[r]; l_reg+=sacc;
    pw0=(u32x4){PKW(pB0,0),PKW(pB0,2),PKW(pB0,4),PKW(pB0,6)};pw1=(u32x4){PKW(pB0,8),PKW(pB0,10),PKW(pB0,12),PKW(pB0,14)};pw2=(u32x4){PKW(pB1,0),PKW(pB1,2),PKW(pB1,4),PKW(pB1,6)};pw3=(u32x4){PKW(pB1,8),PKW(pB1,10),PKW(pB1,12),PKW(pB1,14)};
    SBAR(); pv(o,vb0+sl_cur,PAF(0),PAF(1),PAF(2),PAF(3)); }
  #undef PKW
  #undef PAF
  #undef VFR
  #undef PIN
  #undef MX3
  #undef GAPA
  #undef GAPB
  #undef EX
  #undef VRD
  #undef VOFF
  #undef KRD
  #undef STEP
  #undef ENDW
  {auto rr=__builtin_amdgcn_permlane32_swap(__float_as_uint(l_reg),__float_as_uint(l_reg),false,false);l_reg=__uint_as_float(rr[0])+__uint_as_float(rr[1]);}
  if(!FOX) l_reg+=__builtin_amdgcn_exp2f(sink2-mhat);
  if(hi==0)wsf[32+r32]=l_reg;asm volatile("s_waitcnt lgkmcnt(0)":::"memory");
  float rli[16];
  #pragma unroll
  for(int r=0;r<16;++r)rli[r]=__builtin_amdgcn_rcpf(wsf[32+crow(r,hi)]);
  bf16*Ow=O+(rowbase+q0+wid*QBLK)*DM+h*D;
  { bf16*stg=(bf16*)(shm+LDS_OST)+wid*2048;
    #pragma unroll
    for(int r=0;r<16;++r){const int orow=crow(r,hi);
      #pragma unroll
      for(int d0=0;d0<2;++d0)stg[orow*64+d0*32+r32]=(bf16)(cvtpk_s(o[d0][r]*rli[r],0.f)&0xffffu);}
    asm volatile("s_waitcnt lgkmcnt(0)":::"memory");
    #pragma unroll
    for(int i=0;i<4;++i){const int row=i*8+(lane>>3),ch=lane&7; const u32x4 v=*(const u32x4*)(stg+row*64+ch*8); ATTN_STORE16(Ow+(long)row*DM+ch*8,v);} }
  asm volatile("s_waitcnt lgkmcnt(0)\n\ts_barrier":::"memory");
  #undef DMA_K
  #undef DMA_V
  #undef DMA_C
  #undef PREFILL
  #undef BSUBX
  #undef BXX
  #undef CMASK
  #undef START
  #undef RESC
  #undef ROT
}
constexpr int ATTN_LDS_BYTES=LDS_BYTES;
#undef SBAR
#undef WAIT_BAR
}

#ifndef REP_PHASE
#define REP_PHASE 0
#endif
#ifndef FUSED_FINAL
#define FUSED_FINAL 0
#endif
#ifndef NAIVE_SWA
#define NAIVE_SWA 0
#endif
#ifndef NAIVE_FOX
#define NAIVE_FOX 0
#endif
#define LAS __attribute__((address_space(3)))
typedef unsigned short bf16;
typedef float f32x4 __attribute__((ext_vector_type(4)));
typedef unsigned v4u __attribute__((ext_vector_type(4)));
typedef unsigned v2u __attribute__((ext_vector_type(2)));
constexpr int NWAVES = 8;
constexpr int RING_BYTES = 131072, LDS_BYTES = 147456;

__device__ __forceinline__ float wave_sum(float v) {
#pragma unroll
    for (int o = 1; o < 64; o <<= 1) v += __shfl_xor(v, o);
    return v;
}
#define LDS_WAIT() asm volatile("s_waitcnt lgkmcnt(0)" ::: "memory")

#define XB_TMO      128
#define XB_XCNT(j)  (256  + 64 * (j))
#define XB_XSUB(j)  (1280 + 64 * (j))
#define XB_XGEN(j)  (2304 + 64 * (j))
#define XB_TOP      3328
#define XB_TOPGEN   3392
#define XCD_BAR_WORDS 3456
#define XB_SPIN_CAP (1u << 18)

__device__ __forceinline__ unsigned xb_ld(unsigned* p)              { return __hip_atomic_load(p, __ATOMIC_RELAXED, __HIP_MEMORY_SCOPE_AGENT); }
__device__ __forceinline__ unsigned xb_add(unsigned* p, unsigned v) { return __hip_atomic_fetch_add(p, v, __ATOMIC_RELAXED, __HIP_MEMORY_SCOPE_AGENT); }
__device__ __forceinline__ unsigned xb_xcc_id() { return (unsigned)__builtin_amdgcn_s_getreg((3 << 11) | 20) & 0xFu; }
#define XB_SPIN(cond, bar) do { unsigned _sp = 0; while (cond) { __builtin_amdgcn_s_sleep(1); \
    if ((++_sp & 255u) == 0u) { if (xb_ld(&(bar)[XB_TMO])) break; if (_sp > XB_SPIN_CAP) { atomicAdd(&(bar)[XB_TMO], 1u); break; } } } } while (0)

struct XcdBarrier {
    unsigned* bar; unsigned x;
    volatile LAS unsigned* st;
};

__device__ __forceinline__ XcdBarrier xcd_barrier_post(unsigned* bar, volatile LAS unsigned* st) {
    XcdBarrier b; b.bar = bar; b.x = xb_xcc_id(); b.st = st;
    if (threadIdx.x == 0) (void)xb_add(&bar[XB_XCNT(b.x)], 1u);
    return b;
}
__device__ __forceinline__ void xcd_barrier_complete(unsigned* bar, unsigned x, unsigned& nloc, unsigned& nx) {
    const unsigned G = gridDim.x * gridDim.y * gridDim.z;
    unsigned sum, cnt, mine, sp = 0u;
    for (;;) {
        sum = 0u; cnt = 0u; mine = 0u;
#pragma unroll
        for (unsigned j = 0; j < 16; ++j) { const unsigned c = xb_ld(&bar[XB_XCNT(j)]); sum += c; cnt += (c > 0u) ? 1u : 0u; mine = (j == x) ? c : mine; }
        if (sum == G) break;
        __builtin_amdgcn_s_sleep(1);
        if ((++sp & 255u) == 0u) { if (xb_ld(&bar[XB_TMO])) break; if (sp > XB_SPIN_CAP) { atomicAdd(&bar[XB_TMO], 1u); break; } }
    }
    nloc = mine > 0u ? mine : 1u; nx = cnt > 0u ? cnt : 1u;
}

__device__ __forceinline__ void xcd_barrier(const XcdBarrier& b) {
    asm volatile("s_waitcnt vmcnt(0)" ::: "memory");
    __syncthreads();
    if (threadIdx.x == 0) {
        unsigned* bar = b.bar;
        __builtin_amdgcn_s_waitcnt(0);
        unsigned nloc = b.st[0], nx = b.st[1];
        if (nloc == 0u) { xcd_barrier_complete(bar, b.x, nloc, nx); b.st[0] = nloc; b.st[1] = nx; }
        const unsigned old = xb_add(&bar[XB_XSUB(b.x)], 1u);
        const unsigned gen = old / nloc;
        if (old + 1u == (gen + 1u) * nloc) {
            __builtin_amdgcn_fence(__ATOMIC_RELEASE, "agent");
            asm volatile("s_waitcnt vmcnt(0)" ::: "memory");
            const unsigned og = xb_add(&bar[XB_TOP], 1u);
            const unsigned tg = og / nx;
            if (og + 1u == (tg + 1u) * nx) xb_add(&bar[XB_TOPGEN], 1u);
            else XB_SPIN(xb_ld(&bar[XB_TOPGEN]) == tg, bar);
            __builtin_amdgcn_fence(__ATOMIC_ACQUIRE, "agent");
            xb_add(&bar[XB_XGEN(b.x)], 1u);
            asm volatile("s_waitcnt vmcnt(0)" ::: "memory");
        } else {
            XB_SPIN(xb_ld(&bar[XB_XGEN(b.x)]) == gen, bar);
            __builtin_amdgcn_fence(__ATOMIC_ACQUIRE, "agent");
            asm volatile("s_waitcnt vmcnt(0)" ::: "memory");
        }
    }
    __syncthreads();
}


__device__ __forceinline__ void tr_item(const float* W, int K, int N, bf16* WT, int dst_row0, int src_col0, int nvalid, int kb, const float* kscale, float cscale, LAS float* scr, int lane) {
    const int k0 = 64 * kb, c = lane & 31;
    float tv[32];
    const float* wp = W + (size_t)(k0 + (lane >> 5)) * N + src_col0 + c;
#pragma unroll
    for (int i = 0; i < 32; ++i) { tv[i] = 0.f; if (c < nvalid) tv[i] = __builtin_nontemporal_load(wp + (size_t)(2 * i) * N); }
#pragma unroll
    for (int i = 0; i < 32; ++i) { const int kk = 2 * i + (lane >> 5); float v = tv[i] * cscale; if (kscale) v *= kscale[k0 + kk]; scr[kk * 33 + c] = v; }
    LDS_WAIT(); asm volatile("" ::: "memory");
    const int ch = lane & 7;
#pragma unroll
    for (int j = 0; j < 4; ++j) { const int n = (lane >> 3) + 8 * j; const LAS float* s = scr + (8 * ch) * 33 + n;
        v4u o; o.x = pg8::cvt_pk_bf16(s[0 * 33], s[1 * 33]); o.y = pg8::cvt_pk_bf16(s[2 * 33], s[3 * 33]); o.z = pg8::cvt_pk_bf16(s[4 * 33], s[5 * 33]); o.w = pg8::cvt_pk_bf16(s[6 * 33], s[7 * 33]);
        *(v4u*)(WT + (size_t)(dst_row0 + n) * K + k0 + 8 * ch) = o; }
    LDS_WAIT(); asm volatile("" ::: "memory");
}
__device__ __forceinline__ void tr_item8(const float* W, int K, int N, unsigned char* WT8, int dst_row0, int src_col0, int kb, float cscale, LAS float* scr, int lane) {
    const int k0 = 64 * kb, c = lane & 31;
    float tv[32];
    const float* wp = W + (size_t)(k0 + (lane >> 5)) * N + src_col0 + c;
#pragma unroll
    for (int i = 0; i < 32; ++i) tv[i] = __builtin_nontemporal_load(wp + (size_t)(2 * i) * N);
#pragma unroll
    for (int i = 0; i < 32; ++i) { const int kk = 2 * i + (lane >> 5); scr[kk * 33 + c] = tv[i] * cscale; }
    LDS_WAIT(); asm volatile("" ::: "memory");
    const int ch = lane & 7;
#pragma unroll
    for (int j = 0; j < 4; ++j) { const int n = (lane >> 3) + 8 * j; const LAS float* s = scr + (8 * ch) * 33 + n;
        int w0 = 0, w1 = 0; w0 = __builtin_amdgcn_cvt_pk_fp8_f32(s[0 * 33], s[1 * 33], w0, false); w0 = __builtin_amdgcn_cvt_pk_fp8_f32(s[2 * 33], s[3 * 33], w0, true);
        w1 = __builtin_amdgcn_cvt_pk_fp8_f32(s[4 * 33], s[5 * 33], w1, false); w1 = __builtin_amdgcn_cvt_pk_fp8_f32(s[6 * 33], s[7 * 33], w1, true);
        v2u o; o.x = (unsigned)w0; o.y = (unsigned)w1; *(v2u*)(WT8 + (size_t)(dst_row0 + n) * K + k0 + 8 * ch) = o; }
    LDS_WAIT(); asm volatile("" ::: "memory");
}
__device__ __forceinline__ void win_map(int db, int& src, int& nv) {
    const int pn = db >> 3, bj = (db >> 2) & 1, wc = db & 3; nv = 32;
    if (pn < 4) src = (4 * pn + wc) * 64 + 32 * bj;
    else if (pn == 4) src = (wc < 2 ? 1024 + wc * 64 : 1152 + (wc - 2) * 64) + 32 * bj;
    else if (pn < 17) { const int t = pn - 5; src = 1280 + (t >> 2) * 1024 + (4 * (t & 3) + wc) * 64 + 32 * bj; }
    else { src = 4352; nv = (db == 136) ? 16 : 0; }
}

struct Args { const float* x; const int* pos; const float* attn_norm; const float* w_in; const float* fbias; const float* sinks; const float* w_bs; const float* w_bf;
              const float* w_out; const float* mlp_norm; const float* w_up; const float* w_dn; const float* final_norm; float* out; unsigned char* ws; long long fused_final; };

__device__ __forceinline__ void rms_row_to_bf16(const float* xrow, const float* gain, bf16* orow, int lane) {
    const f32x4* xr = (const f32x4*)xrow + lane; f32x4 v[8]; float s = 0.f;
#pragma unroll
    for (int j = 0; j < 8; ++j) { v[j] = xr[64 * j]; s += (v[j].x * v[j].x + v[j].y * v[j].y) + (v[j].z * v[j].z + v[j].w * v[j].w); }
    const float rstd = __builtin_amdgcn_rsqf(wave_sum(s) * (1.f / DM) + RMS_EPS);
    const f32x4* gr = (const f32x4*)gain + lane; v2u* o8 = (v2u*)orow + lane;
#pragma unroll
    for (int j = 0; j < 8; ++j) { const f32x4 g = gr[64 * j]; v2u w; w.x = pg8::cvt_pk_bf16(v[j].x * rstd * g.x, v[j].y * rstd * g.y); w.y = pg8::cvt_pk_bf16(v[j].z * rstd * g.z, v[j].w * rstd * g.w); o8[64 * j] = w; }
}

__device__ __forceinline__ void rms_row2_to_bf16(const float* x0, const float* x1, const float* gain, bf16* o0, bf16* o1, unsigned char* q0, unsigned char* q1, int lane) {
    const f32x4* xr0 = (const f32x4*)x0 + lane; const f32x4* xr1 = (const f32x4*)x1 + lane; f32x4 v[8], w[8]; float s = 0.f, t = 0.f;
#pragma unroll
    for (int j = 0; j < 8; ++j) { v[j] = __builtin_nontemporal_load(xr0 + 64 * j); w[j] = __builtin_nontemporal_load(xr1 + 64 * j); }
#pragma unroll
    for (int j = 0; j < 8; ++j) { s += (v[j].x * v[j].x + v[j].y * v[j].y) + (v[j].z * v[j].z + v[j].w * v[j].w); t += (w[j].x * w[j].x + w[j].y * w[j].y) + (w[j].z * w[j].z + w[j].w * w[j].w); }
    const float rs = __builtin_amdgcn_rsqf(wave_sum(s) * (1.f / DM) + RMS_EPS), rt = __builtin_amdgcn_rsqf(wave_sum(t) * (1.f / DM) + RMS_EPS);
    const f32x4* gr = (const f32x4*)gain + lane; v2u* p0 = (v2u*)o0 + lane; v2u* p1 = (v2u*)o1 + lane;
#pragma unroll
    for (int j = 0; j < 8; ++j) { const f32x4 g = gr[64 * j]; v2u a, c;
        a.x = pg8::cvt_pk_bf16(v[j].x * rs * g.x, v[j].y * rs * g.y); a.y = pg8::cvt_pk_bf16(v[j].z * rs * g.z, v[j].w * rs * g.w);
        c.x = pg8::cvt_pk_bf16(w[j].x * rt * g.x, w[j].y * rt * g.y); c.y = pg8::cvt_pk_bf16(w[j].z * rt * g.z, w[j].w * rt * g.w);
        p0[64 * j] = a; p1[64 * j] = c;
        int e0 = 0, e1 = 0;
        e0 = __builtin_amdgcn_cvt_pk_fp8_f32(8.f * v[j].x * rs * g.x, 8.f * v[j].y * rs * g.y, e0, false); e0 = __builtin_amdgcn_cvt_pk_fp8_f32(8.f * v[j].z * rs * g.z, 8.f * v[j].w * rs * g.w, e0, true);
        e1 = __builtin_amdgcn_cvt_pk_fp8_f32(8.f * w[j].x * rt * g.x, 8.f * w[j].y * rt * g.y, e1, false); e1 = __builtin_amdgcn_cvt_pk_fp8_f32(8.f * w[j].z * rt * g.z, 8.f * w[j].w * rt * g.w, e1, true);
        ((unsigned*)q0)[lane + 64 * j] = (unsigned)e0; ((unsigned*)q1)[lane + 64 * j] = (unsigned)e1; }
}
__device__ __forceinline__ void p0_prologue(const Args& a, LAS unsigned char* lds, int vcu, int G, int wave, int lane) {
    unsigned char* ws = a.ws;
    LAS float* scr = (LAS float*)(lds + wave * 16384);
    const int gw = vcu * NWAVES + wave, NGW = G * NWAVES;
    constexpr int I_IN = (NIN / 32) * (DM / 64), I_BS = (DM / 32) * (1024 / 64), I_OUT = (DM / 32) * (DM / 64), I_UP = (DFF / 32) * (DM / 64), I_DN = (DM / 32) * (DFF / 64);
    constexpr int I_G = (NGATE / 32) * (DM / 64);
    constexpr int NITEMS = I_IN + 2 * I_BS + I_OUT + I_UP + I_DN + I_G;
    for (int it = gw; it < NITEMS; it += NGW) {
        int r = it;
        if (r < I_IN) { const int db = r / (DM / 64), kb = r % (DM / 64); int src, nv; win_map(db, src, nv); const float csc = (db < 32 || (db >= 40 && db < 72)) ? C2 : 1.0f;
            tr_item(a.w_in, DM, DIN, (bf16*)(ws + WS_WIN), db * 32, src, nv, kb, nullptr, csc, scr, lane); continue; } r -= I_IN;
        if (r < I_BS) { const int db = r / 16, kb = r % 16; tr_item(a.w_bs, 1024, DM, (bf16*)(ws + WS_WBS), db * 32, db * 32, 32, kb, nullptr, 1.0f, scr, lane); continue; } r -= I_BS;
        if (r < I_BS) { const int db = r / 16, kb = r % 16; tr_item(a.w_bf, 1024, DM, (bf16*)(ws + WS_WBF), db * 32, db * 32, 32, kb, nullptr, 1.0f, scr, lane); continue; } r -= I_BS;
        if (r < I_OUT) { const int db = r / 32, kb = r % 32; tr_item8(a.w_out, DM, DM, ws + WS_WOUT, db * 32, db * 32, kb, 64.0f, scr, lane); continue; } r -= I_OUT;
        if (r < I_UP) { const int db = r / 32, kb = r % 32; tr_item(a.w_up, DM, DFF, (bf16*)(ws + WS_WUP), db * 32, db * 32, 32, kb, a.mlp_norm, 1.0f, scr, lane); continue; } r -= I_UP;
        if (r < I_DN) { const int db = r / 128, kb = r % 128; tr_item(a.w_dn, DFF, DM, (bf16*)(ws + WS_WDN), db * 32, db * 32, 32, kb, nullptr, 1.0f, scr, lane); continue; } r -= I_DN;
        { const int db = r / 32, kb = r % 32; tr_item8(a.w_in, DM, DIN, ws + WS_WG8, db * 32, 4368 + db * 32, kb, -64.0f * LOG2E, scr, lane); }
    }
    for (int m = gw; m < M; m += 2 * NGW) rms_row2_to_bf16(a.x + (size_t)m * DM, a.x + (size_t)(m + NGW) * DM, a.attn_norm, (bf16*)(ws + WS_XN) + (size_t)m * DM, (bf16*)(ws + WS_XN) + (size_t)(m + NGW) * DM, ws + WS_XN8 + (size_t)m * DM, ws + WS_XN8 + (size_t)(m + NGW) * DM, lane);
    float* cs = (float*)(ws + WS_CS);
    for (int e = gw * 64 + lane; e < M * 32; e += NGW * 64) {
        const int tok = e >> 5, i = e & 31;
        const float inv_freq = powf(10000.0f, -(float)(2 * i) / 64.0f);
        const float ang = (float)a.pos[tok] * inv_freq;
        double rev = (double)ang * 0.15915494309189535; rev -= floor(rev);
        const float rf = (float)rev;
        cs[e] = __builtin_amdgcn_cosf(rf); cs[(size_t)M * 32 + e] = __builtin_amdgcn_sinf(rf);
    }
}

__device__ __forceinline__ void cumsum_unit(const Args& a, int bh, LAS unsigned char* lds) {
    const float* FL = (const float*)(a.ws + WS_FL); float* Cp = (float*)(a.ws + WS_C);
    LAS double* sh = (LAS double*)lds;
    const int b = bh >> 4, h = bh & 15, tid = threadIdx.x, s0 = tid * 16; const float fb = a.fbias[h];
    float ls[16]; double run = 0.0;
#pragma unroll
    for (int i = 0; i < 16; ++i) { const float z = FL[(size_t)(b * SEQ + s0 + i) * 16 + h] + fb; const float v = fminf(z, 0.f) - log1pf(expf(-fabsf(z))); ls[i] = v; run += (double)v; }
    sh[tid] = run; __syncthreads();
    double pre = 0.0; for (int k = 0; k < tid; ++k) pre += sh[k];
#pragma unroll
    for (int i = 0; i < 16; ++i) { pre += (double)ls[i]; Cp[(size_t)bh * SEQ + s0 + i] = (float)(pre * 1.4426950408889634); }
    __syncthreads();
}

__device__ __forceinline__ void naive_swa_unit(const Args& a, int unit) {
    const bf16* AQ = (const bf16*)(a.ws + WS_AQ); const bf16* AK = (const bf16*)(a.ws + WS_AK); const bf16* AV = (const bf16*)(a.ws + WS_AV); bf16* OA = (bf16*)(a.ws + WS_OA);
    const int tid = threadIdx.x, head = tid & 15, tok = unit * 32 + (tid >> 4), b = tok / SEQ, s = tok % SEQ, kvh = head >> 3;
    float q[64], o[64]; float m = -INFINITY, l = 0.f;
    { const v4u* qp = (const v4u*)(AQ + (size_t)tok * 1024 + head * 64);
#pragma unroll
      for (int c = 0; c < 8; ++c) { const v4u w = qp[c];
#pragma unroll
          for (int e = 0; e < 4; ++e) { q[8 * c + 2 * e] = pg8::bf_lo(w[e]); q[8 * c + 2 * e + 1] = pg8::bf_hi(w[e]); } } }
#pragma unroll
    for (int d = 0; d < 64; ++d) o[d] = 0.f;
    for (int i = 0; i < 128; ++i) {
        const int j = s - i; const bool valid = j >= 0; const int jj = valid ? j : 0;
        const v4u* kp = (const v4u*)(AK + (size_t)(b * SEQ + jj) * 128 + kvh * 64); const v4u* vp = (const v4u*)(AV + (size_t)(b * SEQ + jj) * 128 + kvh * 64);
        float dot = 0.f;
#pragma unroll
        for (int c = 0; c < 8; ++c) { const v4u w = kp[c];
#pragma unroll
            for (int e = 0; e < 4; ++e) { dot += q[8 * c + 2 * e] * pg8::bf_lo(w[e]); dot += q[8 * c + 2 * e + 1] * pg8::bf_hi(w[e]); } }
        const float lg = valid ? dot : -INFINITY;
        const float mn = fmaxf(m, lg), al = __builtin_amdgcn_exp2f(m - mn), p = __builtin_amdgcn_exp2f(lg - mn);
        l = l * al + p; m = mn;
#pragma unroll
        for (int c = 0; c < 8; ++c) { const v4u w = vp[c];
#pragma unroll
            for (int e = 0; e < 4; ++e) { o[8 * c + 2 * e] = o[8 * c + 2 * e] * al + p * pg8::bf_lo(w[e]); o[8 * c + 2 * e + 1] = o[8 * c + 2 * e + 1] * al + p * pg8::bf_hi(w[e]); } }
    }
    { const float sk = a.sinks[head] * LOG2E; const float m2 = fmaxf(m, sk), al = __builtin_amdgcn_exp2f(m - m2); l = l * al + __builtin_amdgcn_exp2f(sk - m2);
      const float rl = al / l;
      v4u* op = (v4u*)(OA + (size_t)tok * 1024 + head * 64);
#pragma unroll
      for (int c = 0; c < 8; ++c) { v4u w;
#pragma unroll
          for (int e = 0; e < 4; ++e) w[e] = pg8::cvt_pk_bf16(o[8 * c + 2 * e] * rl, o[8 * c + 2 * e + 1] * rl);
          op[c] = w; } }
}
__device__ __forceinline__ void naive_fox_unit(const Args& a, int bh, int qblk) {
    const bf16* FQ = (const bf16*)(a.ws + WS_FQ); const bf16* FK = (const bf16*)(a.ws + WS_FK); const bf16* FV = (const bf16*)(a.ws + WS_FV); bf16* OB = (bf16*)(a.ws + WS_OB);
    const float* Cp = (const float*)(a.ws + WS_C) + (size_t)bh * SEQ;
    const int tid = threadIdx.x, b = bh >> 4, h = bh & 15, s = qblk * 512 + tid; const size_t tok = (size_t)b * SEQ + s;
    float q[64], o[64]; float m = -INFINITY, l = 0.f;
    { const v4u* qp = (const v4u*)(FQ + tok * 1024 + h * 64);
#pragma unroll
      for (int c = 0; c < 8; ++c) { const v4u w = qp[c];
#pragma unroll
          for (int e = 0; e < 4; ++e) { q[8 * c + 2 * e] = pg8::bf_lo(w[e]); q[8 * c + 2 * e + 1] = pg8::bf_hi(w[e]); } } }
#pragma unroll
    for (int d = 0; d < 64; ++d) o[d] = 0.f;
    const float cq = Cp[s];
    const int jend = __builtin_amdgcn_readfirstlane(qblk * 512 + (tid | 63));
    for (int j = 0; j <= jend; ++j) {
        const v4u* kp = (const v4u*)(FK + ((size_t)b * SEQ + j) * 1024 + h * 64); const v4u* vp = (const v4u*)(FV + ((size_t)b * SEQ + j) * 1024 + h * 64);
        float dot = 0.f;
#pragma unroll
        for (int c = 0; c < 8; ++c) { const v4u w = kp[c];
#pragma unroll
            for (int e = 0; e < 4; ++e) { dot += q[8 * c + 2 * e] * pg8::bf_lo(w[e]); dot += q[8 * c + 2 * e + 1] * pg8::bf_hi(w[e]); } }
        float lg = dot + (cq - Cp[j]); lg = (j <= s) ? lg : -INFINITY;
        const float mn = fmaxf(m, lg), al = __builtin_amdgcn_exp2f(m - mn), p = __builtin_amdgcn_exp2f(lg - mn);
        l = l * al + p; m = mn;
#pragma unroll
        for (int c = 0; c < 8; ++c) { const v4u w = vp[c];
#pragma unroll
            for (int e = 0; e < 4; ++e) { o[8 * c + 2 * e] = o[8 * c + 2 * e] * al + p * pg8::bf_lo(w[e]); o[8 * c + 2 * e + 1] = o[8 * c + 2 * e + 1] * al + p * pg8::bf_hi(w[e]); } }
    }
    { const float rl = 1.0f / l; v4u* op = (v4u*)(OB + tok * 1024 + h * 64);
#pragma unroll
      for (int c = 0; c < 8; ++c) { v4u w;
#pragma unroll
          for (int e = 0; e < 4; ++e) w[e] = pg8::cvt_pk_bf16(o[8 * c + 2 * e] * rl, o[8 * c + 2 * e + 1] * rl);
          op[c] = w; } }
}

__global__ void __launch_bounds__(NWAVES * 64, 2) mega_fwd(Args a) {
    extern __shared__ __attribute__((aligned(16))) unsigned char lds_raw[];
    LAS unsigned char* lds = (LAS unsigned char*)lds_raw;
    cg::grid_group grid = cg::this_grid();
    int tid_ = threadIdx.x; asm volatile("" : "+v"(tid_));
    const int tid = tid_, lane = tid & 63, wave = __builtin_amdgcn_readfirstlane(tid >> 6);
    const int G = gridDim.x, bx = blockIdx.x, vcu = (G % 8 == 0) ? (bx % 8) * (G / 8) + bx / 8 : bx;
    unsigned char* ws = a.ws;
    float* SS1 = (float*)(ws + WS_CTL); float* SS2 = SS1 + M;
#define GRID_SYNC_CG() do { asm volatile("s_waitcnt vmcnt(0) lgkmcnt(0)" ::: "memory"); grid.sync(); } while (0)
#define GRID_SYNC() xcd_barrier(xbar)
    if (tid < 2) ((LAS unsigned*)(lds + RING_BYTES))[tid] = 0u;
    __syncthreads();
    const XcdBarrier xbar = xcd_barrier_post((unsigned*)(ws + WS_CTL + 786432), (volatile LAS unsigned*)(lds + RING_BYTES));

    for (int rp_ = 0; rp_ < (REP_PHASE == 100 ? 2 : 1); ++rp_) { p0_prologue(a, lds, vcu, G, wave, lane); __syncthreads(); }
    if (a.ws == nullptr) GRID_SYNC_CG();
    GRID_SYNC();

    {
        pg8::Gemm g{(const bf16*)(ws + WS_XN), (const bf16*)(ws + WS_WIN), nullptr, nullptr, DM};
        pg8::StaticOrder S; S.init(M, NIN, G, bx);
        pg8::EpiIn E{ws};
        for (int rp_ = 0; rp_ < (REP_PHASE == 1 ? 2 : 1); ++rp_) pg8::gemm_phase<pg8::EpiIn, pg8::StaticOrder, true, true>(lds, g, S, E);
        pg8::Gemm g8{(const bf16*)(ws + WS_XN8), (const bf16*)(ws + WS_WG8), nullptr, nullptr, DM / 2};
        pg8::StaticOrder S8; S8.init(M, NGATE, G, bx);
        pg8::EpiGate E8{ws + WS_G};
        for (int rp_ = 0; rp_ < (REP_PHASE == 12 ? 2 : 1); ++rp_) pg8::gemm_phase<pg8::EpiGate, pg8::StaticOrder, true, true, true>(lds, g8, S8, E8);
    }
    GRID_SYNC();

    for (int u = bx; u < 64; u += G) cumsum_unit(a, u, lds);
#if NAIVE_SWA
    for (int u = bx; u < M / 32; u += G) naive_swa_unit(a, u);
#else
    for (int rp_ = 0; rp_ < (REP_PHASE == 2 ? 2 : 1); ++rp_)
    for (int u = vcu; u < 2048; u += G) { const int bh = u >> 5, qb = u & 31, b_ = bh >> 4, h_ = bh & 15;
        attn_body::attn_unit<8, false, 128>(b_, h_, qb, (const bf16*)(ws + WS_AQ), (const bf16*)(ws + WS_AK), (const bf16*)(ws + WS_AV), (bf16*)(ws + WS_OA), nullptr, a.sinks[h_] * LOG2E, (char*)lds_raw); }
#endif
    GRID_SYNC();

#if NAIVE_FOX
    for (int u = bx; u < 1024; u += G) { const int r = u >> 6, i = r >> 2, hi4 = r & 3, qblk = (i & 1) ? 4 * i + 3 - hi4 : 4 * i + hi4; naive_fox_unit(a, u & 63, qblk); }
#else
    for (int rp_ = 0; rp_ < (REP_PHASE == 3 ? 2 : 1); ++rp_)
    for (int e = vcu; e < 2048; e += G) { const int cuv = e & 255, i = e >> 8, bh = (cuv >> 4) + 16 * (i >> 1), s_ = cuv & 15, qb = (i & 1) ? 31 - s_ : s_;
        attn_body::attn_unit<8, true, 1024>(bh >> 4, bh & 15, qb, (const bf16*)(ws + WS_FQ), (const bf16*)(ws + WS_FK), (const bf16*)(ws + WS_FV), (bf16*)(ws + WS_OB), (const float*)(ws + WS_C) + (size_t)bh * SEQ, 0.f, (char*)lds_raw); }
#endif
    GRID_SYNC();

    {
        pg8::Gemm g{(const bf16*)(ws + WS_OA), (const bf16*)(ws + WS_WBS), (const bf16*)(ws + WS_OB), (const bf16*)(ws + WS_WBF), 1024};
        pg8::PairOrder S; S.s.init(M, DM, G, bx);
        pg8::EpiBranch E{(const unsigned char*)(ws + WS_G), ws + WS_MG};
        for (int rp_ = 0; rp_ < (REP_PHASE == 4 ? 2 : 1); ++rp_) pg8::gemm_phase<pg8::EpiBranch, pg8::PairOrder, true, true>(lds, g, S, E);
    }
    GRID_SYNC();

    {
        pg8::Gemm g{(const bf16*)(ws + WS_MG), (const bf16*)(ws + WS_WOUT), nullptr, nullptr, DM / 2};
        pg8::StaticOrder S; S.init(M, DM, G, bx);
        pg8::EpiResB<false> E{a.x, (bf16*)(ws + WS_X1B), SS1};
        pg8::gemm_phase<pg8::EpiResB<false>, pg8::StaticOrder, true, true, true>(lds, g, S, E);
    }
    GRID_SYNC();

    {
        pg8::Gemm g{(const bf16*)(ws + WS_X1B), (const bf16*)(ws + WS_WUP), nullptr, nullptr, DM};
        pg8::StaticOrder S; S.init(M, DFF, G, bx);
        pg8::EpiUp E{SS1, (bf16*)(ws + WS_U)};
        for (int rp_ = 0; rp_ < (REP_PHASE == 6 ? 2 : 1); ++rp_) pg8::gemm_phase<pg8::EpiUp, pg8::StaticOrder, true, true>(lds, g, S, E);
    }
    GRID_SYNC();

    {
        pg8::Gemm g{(const bf16*)(ws + WS_U), (const bf16*)(ws + WS_WDN), nullptr, nullptr, DFF};
        pg8::StaticOrder S; S.init(M, DM, G, bx);
        pg8::EpiResB<true> E{(const void*)(ws + WS_X1B), (bf16*)(ws + WS_X2B), SS2};
        pg8::gemm_phase<pg8::EpiResB<true>, pg8::StaticOrder, true, true>(lds, g, S, E);
    }
    GRID_SYNC();

    {
        const int gw = vcu * NWAVES + wave, NGW = G * NWAVES;
        for (int m = gw; m < M; m += NGW) {
            const float rstd = __builtin_amdgcn_rsqf(SS2[m] * (1.f / DM) + RMS_EPS);
            f32x4* xr = (f32x4*)(a.out + (size_t)m * DM) + lane; const f32x4* gr = (const f32x4*)a.final_norm + lane; const v2u* br = (const v2u*)((const bf16*)(ws + WS_X2B) + (size_t)m * DM) + lane;
            v2u w[8];
#pragma unroll
            for (int j = 0; j < 8; ++j) w[j] = __builtin_nontemporal_load(br + 64 * j);
#pragma unroll
            for (int j = 0; j < 8; ++j) { const f32x4 g = gr[64 * j]; const f32x4 v = (f32x4){pg8::bf_lo(w[j].x), pg8::bf_hi(w[j].x), pg8::bf_lo(w[j].y), pg8::bf_hi(w[j].y)}; __builtin_nontemporal_store(v * rstd * g, xr + 64 * j); }
        }
    }
}

extern "C" void kernel_launch(void* const* d_in, const int* in_sizes, int n_in, void* d_out, int out_size, void* d_ws, size_t ws_size, hipStream_t stream) {
    static int grid = 0; static int fused_final = 0;
    if (grid == 0) {
        if (n_in != 13 || in_sizes[0] != M * DM || out_size != M * DM || ws_size < WS_END3) { fprintf(stderr, "kernel_launch: unexpected shapes (n_in %d, in0 %d, out %d, ws %zu)\n", n_in, n_in > 0 ? in_sizes[0] : -1, out_size, ws_size); grid = -1; return; }
        int dev = 0, cus = 0, per_cu = 0;
        if (hipGetDevice(&dev) != hipSuccess || hipDeviceGetAttribute(&cus, hipDeviceAttributeMultiprocessorCount, dev) != hipSuccess) { grid = -1; return; }
        if (hipFuncSetAttribute((const void*)mega_fwd, hipFuncAttributeMaxDynamicSharedMemorySize, LDS_BYTES) != hipSuccess) { fprintf(stderr, "kernel_launch: hipFuncSetAttribute failed\n"); grid = -1; return; }
        if (hipOccupancyMaxActiveBlocksPerMultiprocessor(&per_cu, (const void*)mega_fwd, NWAVES * 64, LDS_BYTES) != hipSuccess || per_cu < 1) { fprintf(stderr, "kernel_launch: occupancy query says %d\n", per_cu); per_cu = 1; }
        (void)hipGetLastError();
        grid = cus * 1;
        { pg8::StaticOrder S; S.init(M, DM, grid, 0); bool ok = (M / 256) * (DM / 256) == 4 * grid;
          for (int c = 0; c < grid && ok; ++c) { S.c = c; for (int i = 0; i < 4 && ok; i += 2) { pg8::Unit u0, u1; ok = S.next(i, u0) && S.next(i + 1, u1) && u0.pm == u1.pm && u1.pn == u0.pn + 4 && u0.pn < 4 && u0.f == 0 && u1.f == 1; } }
          fused_final = (ok && FUSED_FINAL) ? 1 : 0; if (!ok) fprintf(stderr, "kernel_launch: note: unit order does not pair tiles; using the separate final-norm pass\n"); }
    }
    if (grid < 0) return;
    (void)hipMemsetAsync((char*)d_ws + WS_CTL, 0, CTL_ZERO_BYTES, stream);
    Args a{};
    a.x = (const float*)d_in[0]; a.pos = (const int*)d_in[1]; a.attn_norm = (const float*)d_in[2]; a.w_in = (const float*)d_in[3]; a.fbias = (const float*)d_in[4]; a.sinks = (const float*)d_in[5];
    a.w_bs = (const float*)d_in[6]; a.w_bf = (const float*)d_in[7]; a.w_out = (const float*)d_in[8]; a.mlp_norm = (const float*)d_in[9]; a.w_up = (const float*)d_in[10]; a.w_dn = (const float*)d_in[11];
    a.final_norm = (const float*)d_in[12]; a.out = (float*)d_out; a.ws = (unsigned char*)d_ws; a.fused_final = fused_final;
    void* kargs[] = {&a};
    const hipError_t le = hipLaunchCooperativeKernel((const void*)mega_fwd, dim3(grid), dim3(NWAVES * 64), kargs, LDS_BYTES, stream);
    if (le != hipSuccess) fprintf(stderr, "kernel_launch: cooperative launch failed: %s (grid %d)\n", hipGetErrorString(le), grid);
}
```

```cpp
#include <hip/hip_runtime.h>
#include <hip/hip_cooperative_groups.h>
#include <cstdio>
#include <cstdint>
namespace cg = cooperative_groups;

constexpr int BATCH = 4, SEQ = 8192, DM = 2048, M = BATCH * SEQ, DFF = 8192, NIN = 3584  , NGATE = 5120  , DIN = 8464;
constexpr float RMS_EPS = 1e-6f;
constexpr float LOG2E = 1.4426950408889634f;
constexpr float C2 = 0.125f * 1.4426950408889634f;

constexpr size_t MiB = 1u << 20;
constexpr size_t WS_CTL = 0, CTL_ZERO_BYTES = 1 * MiB;
constexpr size_t WS_WIN = 1 * MiB, WS_WBS = 35 * MiB, WS_WBF = 39 * MiB, WS_WOUT = 43 * MiB, WS_WUP = 51 * MiB, WS_WDN = 83 * MiB;
constexpr size_t WS_CS = 115 * MiB;
constexpr size_t WS_FL = 123 * MiB, WS_C = 125 * MiB;
constexpr size_t WS_FK = 128 * MiB, WS_FV = 192 * MiB, WS_X1B = 128 * MiB;
constexpr size_t WS_XN = 256 * MiB, WS_MG = 256 * MiB;
constexpr size_t WS_AQ = 384 * MiB, WS_FQ = 448 * MiB, WS_G = 512 * MiB;
constexpr size_t WS_U = 256 * MiB;
constexpr size_t WS_AK = 768 * MiB, WS_AV = 776 * MiB, WS_OA = 784 * MiB, WS_OB = 848 * MiB, WS_END = 912 * MiB;
constexpr size_t WS_XN8 = 920 * MiB, WS_WG8 = 21 * MiB, WS_END3 = 984 * MiB;
constexpr size_t WS_X2B = 784 * MiB;

namespace pg8 {
#define PG8_LAS __attribute__((address_space(3)))
typedef unsigned short bf16_t;
typedef short bf16x8 __attribute__((ext_vector_type(8)));
typedef float f32x4 __attribute__((ext_vector_type(4)));
typedef unsigned u32x4 __attribute__((ext_vector_type(4)));
typedef unsigned u32x2 __attribute__((ext_vector_type(2)));
typedef int v4i_t __attribute__((ext_vector_type(4)));
typedef int v8i_t __attribute__((ext_vector_type(8)));
constexpr int BM = 256, BK = 64, HALF = 128, HTB = HALF * BK * 2  , STAGE_BYTES = 8 * HTB, NXCD = 8, WGM = 8;

__host__ __device__ __forceinline__ int lds_byte(int r, int c) { const int st = (r >> 4) * 2 + (c >> 5), rr = r & 15, cc = c & 31, ob = rr * 64 + cc * 2; return st * 1024 + (ob ^ (((ob >> 9) & 1) << 5)); }
__host__ __device__ __forceinline__ void stage_rc(int b, int& R, int& C) { const int st = b / 1024, sb = b % 1024, swz = sb ^ (((sb >> 9) & 1) << 5); R = (st >> 1) * 16 + swz / 64; C = (st & 1) * 32 + (swz % 64) / 2; }
__host__ __device__ __forceinline__ int perm32(int rho) { const int n = rho >> 4, i = rho & 15; return 8 * (i >> 2) + 4 * n + (i & 3); }

struct Unit { int pm, pn, z, f; };
struct Gemm { const bf16_t* A0; const bf16_t* B0; const bf16_t* A1; const bf16_t* B1; int K; };

struct StaticOrder {
    int nM, nN, nwg, G, c;
    __host__ __device__ void init(int M_, int N_, int G_, int c_) { nM = M_ / BM; nN = N_ / BM; nwg = nM * nN; G = G_; c = c_; }
    __host__ __device__ bool next(int i, Unit& u) const {
        const long L = (long)i * G + c; if (L >= nwg) return false;
        int wgid = (int)L; { const int q = nwg / NXCD, r = nwg % NXCD, xcd = wgid % NXCD, off = wgid / NXCD; wgid = (xcd < r ? xcd * (q + 1) : r * (q + 1) + (xcd - r) * q) + off; }
        const int nig = WGM * nN, gid = wgid / nig, fm = gid * WGM, gsz = (nM - fm) < WGM ? (nM - fm) : WGM;
        u.pm = fm + ((wgid % nig) % gsz); u.pn = (wgid % nig) / gsz; u.z = 0; u.f = i & 1; return true;
    }
};
struct PairOrder {
    StaticOrder s;
    __host__ __device__ bool next(int i, Unit& u) const { const bool ok = s.next(i >> 1, u); u.z = i & 1; return ok; }
};

__device__ __forceinline__ unsigned cvt_pk_bf16(float lo, float hi) { unsigned r; asm("v_cvt_pk_bf16_f32 %0, %1, %2" : "=v"(r) : "v"(lo), "v"(hi)); return r; }
__device__ __forceinline__ float bf_lo(unsigned w) { return __uint_as_float(w << 16); }
__device__ __forceinline__ float bf_hi(unsigned w) { return __uint_as_float(w & 0xffff0000u); }
__device__ __forceinline__ float sigmoidf_(float x) { return __builtin_amdgcn_rcpf(1.0f + __builtin_amdgcn_exp2f(-x * LOG2E)); }


__device__ __forceinline__ void epi_headsplit(f32x4 (&acc)[2][2][4][2], unsigned char* ws, size_t doff, int pitch, int colbase, bool rope, int row0, int fq) {
    bf16_t* dst = (bf16_t*)(ws + doff); const float* cs = (const float*)(ws + WS_CS);
#pragma unroll
    for (int ai = 0; ai < 2; ++ai) {
        f32x4 cc[4][4];
        if (rope) {
#pragma unroll
            for (int m = 0; m < 4; ++m) { const float* cp = cs + (size_t)(row0 + ai * HALF + m * 16) * 32 + 8 * fq; const float* sp = cp + (size_t)M * 32;
                cc[m][0] = *(const f32x4*)cp; cc[m][1] = *(const f32x4*)(cp + 4); cc[m][2] = *(const f32x4*)sp; cc[m][3] = *(const f32x4*)(sp + 4); }
            asm volatile("" ::: "memory");
        }
#pragma unroll
        for (int m = 0; m < 4; ++m) {
            const int row = row0 + ai * HALF + m * 16;
            f32x4 v00 = acc[ai][0][m][0], v01 = acc[ai][0][m][1], v10 = acc[ai][1][m][0], v11 = acc[ai][1][m][1];
            if (rope) {
                const f32x4 c0 = cc[m][0], c1 = cc[m][1], s0 = cc[m][2], s1 = cc[m][3];
                const f32x4 o00 = v00 * c0 - v10 * s0, o10 = v10 * c0 + v00 * s0, o01 = v01 * c1 - v11 * s1, o11 = v11 * c1 + v01 * s1;
                v00 = o00; v10 = o10; v01 = o01; v11 = o11;
            }
            bf16_t* rp = dst + (size_t)row * pitch + colbase + 8 * fq;
            u32x4 w0, w1;
            w0.x = cvt_pk_bf16(v00[0], v00[1]); w0.y = cvt_pk_bf16(v00[2], v00[3]); w0.z = cvt_pk_bf16(v01[0], v01[1]); w0.w = cvt_pk_bf16(v01[2], v01[3]);
            w1.x = cvt_pk_bf16(v10[0], v10[1]); w1.y = cvt_pk_bf16(v10[2], v10[3]); w1.z = cvt_pk_bf16(v11[0], v11[1]); w1.w = cvt_pk_bf16(v11[2], v11[3]);
            *(u32x4*)rp = w0; *(u32x4*)(rp + 32) = w1;
        }
        asm volatile("" ::: "memory");
    }
}
struct EpiIn {
    static constexpr bool PERM = true; static constexpr int SC_W = 0x79797979, SC_A = 0x7c7c7c7c;
    unsigned char* ws;
    __device__ __forceinline__ bool keep(const Unit&) const { return false; }
    __device__ __forceinline__ void operator()(f32x4 (&acc)[2][2][4][2], const Unit& u, int wr, int wc, int fr, int fq) const {
        const int pn = u.pn; const int row0 = u.pm * BM + wr * 64 + fr;
        if (pn <= 12) {
            size_t doff; int pitch, colbase; bool rope = false;
            if (pn == 0) { if (wc < 2) { doff = WS_AK; pitch = 128; colbase = wc * 64; rope = true; } else { doff = WS_AV; pitch = 128; colbase = (wc - 2) * 64; } }
            else { const int t = pn - 1, tin = t & 3, seg = t >> 2; doff = WS_FQ; if (seg == 1) doff = WS_FK; if (seg == 2) doff = WS_FV; pitch = 1024; colbase = (4 * tin + wc) * 64; }
            epi_headsplit(acc, ws, doff, pitch, colbase, rope, row0, fq);
        } else {
            if (wc == 0 && fq < 2) {
#pragma unroll
                for (int ai = 0; ai < 2; ++ai)
#pragma unroll
                    for (int m = 0; m < 4; ++m) {
                        float* rp = (float*)(ws + WS_FL) + (size_t)(row0 + ai * HALF + m * 16) * 16 + 8 * fq;
                        *(f32x4*)rp = acc[ai][0][m][0]; *(f32x4*)(rp + 4) = acc[ai][0][m][1];
                    }
            }
        }
    }
};

struct EpiGate {
    static constexpr bool PERM = true; static constexpr int SC_W = 0x79797979, SC_A = 0x7c7c7c7c;
    unsigned char* G; unsigned char* ws;
    __device__ __forceinline__ bool keep(const Unit&) const { return false; }
    __device__ __forceinline__ void operator()(f32x4 (&acc)[2][2][4][2], const Unit& u, int wr, int wc, int fr, int fq) const {
        const int row0 = u.pm * BM + wr * 64 + fr, col0 = u.pn * BM + wc * 32 + 8 * fq;
        if (u.pn >= 16) {
            const int tq = u.pn - 16; epi_headsplit(acc, ws, WS_AQ, 1024, (4 * tq + wc) * 64, true, row0, fq); return; }
#pragma unroll
        for (int ai = 0; ai < 2; ++ai)
#pragma unroll
            for (int m = 0; m < 4; ++m) {
                unsigned char* rp = G + (size_t)(row0 + ai * HALF + m * 16) * 4096 + col0;
#pragma unroll
                for (int bj = 0; bj < 2; ++bj) {
                    const f32x4 a = acc[ai][bj][m][0], b = acc[ai][bj][m][1]; u32x2 w; w.x = 0u; w.y = 0u;
#pragma unroll
                    for (int i = 0; i < 4; ++i) {
                        const float qa = __builtin_amdgcn_rcpf(__builtin_fmaf(__builtin_amdgcn_exp2f(a[i]), 1.0f / 255.0f, 1.0f / 255.0f)), qb = __builtin_amdgcn_rcpf(__builtin_fmaf(__builtin_amdgcn_exp2f(b[i]), 1.0f / 255.0f, 1.0f / 255.0f));
                        w.x = __builtin_amdgcn_cvt_pk_u8_f32(fmaxf(qa, 1.0f), i, w.x); w.y = __builtin_amdgcn_cvt_pk_u8_f32(fmaxf(qb, 1.0f), i, w.y); }
                    *(u32x2*)(rp + bj * HALF) = w;
                }
            }
    }
};

struct EpiBranch {
    static constexpr bool PERM = true; static constexpr int SC_W = 0x79797979, SC_A = 0x7c7c7c7c;
    const unsigned char* G; unsigned char* MG;
    __device__ __forceinline__ bool keep(const Unit& u) const { return u.z == 0; }
    __device__ __forceinline__ void operator()(f32x4 (&acc)[2][2][4][2], const Unit& u, int wr, int wc, int fr, int fq) const {
        const int row0 = u.pm * BM + wr * 64 + fr, col0 = u.pn * BM + wc * 32 + 8 * fq; const int z = u.z;
#pragma unroll
        for (int ai = 0; ai < 2; ++ai) {
            u32x2 gbv[4][2], gav[4][2];
#pragma unroll
            for (int m = 0; m < 4; ++m)
#pragma unroll
                for (int bj = 0; bj < 2; ++bj) { const unsigned char* gp = G + (size_t)(row0 + ai * HALF + m * 16) * 4096 + col0 + bj * HALF;
                    gbv[m][bj] = *(const u32x2*)(gp + 2048); if (z == 0) gav[m][bj] = *(const u32x2*)gp; }
            asm volatile("" ::: "memory");
#pragma unroll
            for (int m = 0; m < 4; ++m) {
                const size_t row = (size_t)(row0 + ai * HALF + m * 16);
#pragma unroll
                for (int bj = 0; bj < 2; ++bj) {
                    const u32x2 gb = gbv[m][bj];
                    float sb[8];
#pragma unroll
                    for (int i = 0; i < 4; ++i) { sb[i] = (float)((gb.x >> (8 * i)) & 0xffu); sb[4 + i] = (float)((gb.y >> (8 * i)) & 0xffu); }
                    if (z == 0) {
                        const u32x2 ga = gav[m][bj];
#pragma unroll
                        for (int i = 0; i < 4; ++i) {
                            acc[ai][bj][m][0][i] *= (float)((ga.x >> (8 * i)) & 0xffu) * __builtin_amdgcn_rcpf(sb[i]);
                            acc[ai][bj][m][1][i] *= (float)((ga.y >> (8 * i)) & 0xffu) * __builtin_amdgcn_rcpf(sb[4 + i]);
                        }
                    } else {
#pragma unroll
                        for (int i = 0; i < 8; ++i) sb[i] *= (16.0f / 255.0f);
                        const f32x4 a = acc[ai][bj][m][0], b = acc[ai][bj][m][1]; u32x4 w;
                        int w0 = 0, w1 = 0;
                        w0 = __builtin_amdgcn_cvt_pk_fp8_f32(a[0] * sb[0], a[1] * sb[1], w0, false); w0 = __builtin_amdgcn_cvt_pk_fp8_f32(a[2] * sb[2], a[3] * sb[3], w0, true);
                        w1 = __builtin_amdgcn_cvt_pk_fp8_f32(b[0] * sb[4], b[1] * sb[5], w1, false); w1 = __builtin_amdgcn_cvt_pk_fp8_f32(b[2] * sb[6], b[3] * sb[7], w1, true);
                        u32x2 wv; wv.x = (unsigned)w0; wv.y = (unsigned)w1; (void)w;
                        *(u32x2*)(MG + row * 2048 + col0 + bj * HALF) = wv;
                    }
                }
            }
            asm volatile("" ::: "memory");
        }
    }
};

template <bool WRITE_BF> struct EpiRes {
    static constexpr bool PERM = false; static constexpr int SC_W = 0x79797979, SC_A = 0x7c7c7c7c;
    const float* base; float* out; bf16_t* xb; float* ss;
    __device__ __forceinline__ bool keep(const Unit&) const { return false; }
    __device__ __forceinline__ void operator()(f32x4 (&acc)[2][2][4][2], const Unit& u, int wr, int wc, int fr, int fq) const {
        const int row0 = u.pm * BM + wr * 64 + fr, col0 = u.pn * BM + wc * 32 + 4 * fq;
#pragma unroll
        for (int ai = 0; ai < 2; ++ai) {
            f32x4 pre[4][2][2];
#pragma unroll
            for (int m = 0; m < 4; ++m)
#pragma unroll
                for (int bj = 0; bj < 2; ++bj)
#pragma unroll
                    for (int n = 0; n < 2; ++n) pre[m][bj][n] = *(const f32x4*)(base + (size_t)(row0 + ai * HALF + m * 16) * DM + col0 + bj * HALF + n * 16);
            asm volatile("" ::: "memory");
#pragma unroll
            for (int m = 0; m < 4; ++m) {
                const size_t row = (size_t)(row0 + ai * HALF + m * 16); const size_t off = row * DM + col0; float q = 0.f;
#pragma unroll
                for (int bj = 0; bj < 2; ++bj)
#pragma unroll
                    for (int n = 0; n < 2; ++n) {
                        const size_t o = off + bj * HALF + n * 16;
                        const f32x4 v = pre[m][bj][n] + acc[ai][bj][m][n];
                        *(f32x4*)(out + o) = v; q += (v[0] * v[0] + v[1] * v[1]) + (v[2] * v[2] + v[3] * v[3]);
                        if (WRITE_BF) { u32x2 w; w.x = cvt_pk_bf16(v[0], v[1]); w.y = cvt_pk_bf16(v[2], v[3]); *(u32x2*)(xb + o) = w; }
                    }
                q += __shfl_xor(q, 16); q += __shfl_xor(q, 32);
                if (fq == 0) atomicAdd(ss + row, q);
            }
            asm volatile("" ::: "memory");
        }
    }
};

struct EpiFinal {
    static constexpr bool PERM = false; static constexpr int SC_W = 0x79797979, SC_A = 0x7c7c7c7c;
    float* out; float* ss; unsigned* cnt; const float* gain;
    __device__ __forceinline__ bool keep(const Unit&) const { return false; }
    __device__ __forceinline__ void operator()(f32x4 (&acc)[2][2][4][2], const Unit& u, int wr, int wc, int fr, int fq) const {
        const int row0 = u.pm * BM + wr * 64 + fr, col0 = u.pn * BM + wc * 32 + 4 * fq; const bool second = u.f != 0;
#pragma unroll
        for (int ai = 0; ai < 2; ++ai) {
            f32x4 pre[4][2][2];
#pragma unroll
            for (int m = 0; m < 4; ++m)
#pragma unroll
                for (int bj = 0; bj < 2; ++bj)
#pragma unroll
                    for (int n = 0; n < 2; ++n) pre[m][bj][n] = *(const f32x4*)(out + (size_t)(row0 + ai * HALF + m * 16) * DM + col0 + bj * HALF + n * 16);
            asm volatile("" ::: "memory");
#pragma unroll
            for (int m = 0; m < 4; ++m) {
                const size_t row = (size_t)(row0 + ai * HALF + m * 16); const size_t off = row * DM + col0; float q = 0.f;
#pragma unroll
                for (int bj = 0; bj < 2; ++bj)
#pragma unroll
                    for (int n = 0; n < 2; ++n) {
                        const f32x4 v = pre[m][bj][n] + acc[ai][bj][m][n]; acc[ai][bj][m][n] = v;
                        q += (v[0] * v[0] + v[1] * v[1]) + (v[2] * v[2] + v[3] * v[3]);
                        if (!second) *(f32x4*)(out + off + bj * HALF + n * 16) = v;
                    }
                q += __shfl_xor(q, 16); q += __shfl_xor(q, 32);
                if (fq == 0) atomicAdd(ss + row, q);
            }
            asm volatile("" ::: "memory");
        }
        asm volatile("s_waitcnt vmcnt(0)" ::: "memory");
        unsigned* pc = cnt + 16 * u.pm;
        if ((threadIdx.x & 63) == 0) __hip_atomic_fetch_add(pc, 1u, __ATOMIC_RELAXED, __HIP_MEMORY_SCOPE_AGENT);
        if (!second) return;
        { const unsigned long long t0 = __builtin_amdgcn_s_memrealtime();
          while ((unsigned)__builtin_amdgcn_readfirstlane(__hip_atomic_load(pc, __ATOMIC_RELAXED, __HIP_MEMORY_SCOPE_AGENT)) < 64u) {
              if (__builtin_amdgcn_s_memrealtime() - t0 > 2000000ull) break;
              __builtin_amdgcn_s_sleep(4); }
          asm volatile("" ::: "memory"); }
#pragma unroll
        for (int ai = 0; ai < 2; ++ai)
#pragma unroll
            for (int m = 0; m < 4; ++m) {
                const size_t row = (size_t)(row0 + ai * HALF + m * 16); const size_t off = row * DM + col0;
                const float rstd = __builtin_amdgcn_rsqf(__hip_atomic_load(ss + row, __ATOMIC_RELAXED, __HIP_MEMORY_SCOPE_AGENT) * (1.0f / DM) + RMS_EPS);
#pragma unroll
                for (int bj = 0; bj < 2; ++bj)
#pragma unroll
                    for (int n = 0; n < 2; ++n) {
                        const size_t o = off + bj * HALF + n * 16; const int c = col0 + bj * HALF + n * 16;
                        const f32x4 gB = *(const f32x4*)(gain + c), gA = *(const f32x4*)(gain + c - 1024), vA = *(const f32x4*)(out + o - 1024);
                        *(f32x4*)(out + o) = acc[ai][bj][m][n] * rstd * gB;
                        *(f32x4*)(out + o - 1024) = vA * rstd * gA;
                    }
            }
    }
};

template <bool BASE_BF> struct EpiResB {
    static constexpr bool PERM = true; static constexpr int SC_W = 0x79797979, SC_A = 0x7b7b7b7b;
    const void* base; bf16_t* yb; float* ss;
    __device__ __forceinline__ bool keep(const Unit&) const { return false; }
    __device__ __forceinline__ void operator()(f32x4 (&acc)[2][2][4][2], const Unit& u, int wr, int wc, int fr, int fq) const {
        const int row0 = u.pm * BM + wr * 64 + fr, col0 = u.pn * BM + wc * 32 + 8 * fq;
#pragma unroll
        for (int ai = 0; ai < 2; ++ai) {
            f32x4 pf[4][2][2]; u32x4 pb[4][2];
#pragma unroll
            for (int m = 0; m < 4; ++m)
#pragma unroll
                for (int bj = 0; bj < 2; ++bj) { const size_t o = (size_t)(row0 + ai * HALF + m * 16) * DM + col0 + bj * HALF;
                    if (BASE_BF) pb[m][bj] = *(const u32x4*)((const bf16_t*)base + o);
                    else { pf[m][bj][0] = *(const f32x4*)((const float*)base + o); pf[m][bj][1] = *(const f32x4*)((const float*)base + o + 4); } }
            asm volatile("" ::: "memory");
#pragma unroll
            for (int m = 0; m < 4; ++m) {
                const size_t row = (size_t)(row0 + ai * HALF + m * 16); float q = 0.f;
#pragma unroll
                for (int bj = 0; bj < 2; ++bj) {
                    f32x4 x0, x1;
                    if (BASE_BF) { const u32x4 w = pb[m][bj]; x0 = (f32x4){bf_lo(w.x), bf_hi(w.x), bf_lo(w.y), bf_hi(w.y)}; x1 = (f32x4){bf_lo(w.z), bf_hi(w.z), bf_lo(w.w), bf_hi(w.w)}; }
                    else { x0 = pf[m][bj][0]; x1 = pf[m][bj][1]; }
                    const f32x4 v0 = x0 + acc[ai][bj][m][0], v1 = x1 + acc[ai][bj][m][1];
                    q += ((v0[0] * v0[0] + v0[1] * v0[1]) + (v0[2] * v0[2] + v0[3] * v0[3])) + ((v1[0] * v1[0] + v1[1] * v1[1]) + (v1[2] * v1[2] + v1[3] * v1[3]));
                    u32x4 w; w.x = cvt_pk_bf16(v0[0], v0[1]); w.y = cvt_pk_bf16(v0[2], v0[3]); w.z = cvt_pk_bf16(v1[0], v1[1]); w.w = cvt_pk_bf16(v1[2], v1[3]);
                    *(u32x4*)(yb + row * DM + col0 + bj * HALF) = w;
                }
                q += __shfl_xor(q, 16); q += __shfl_xor(q, 32);
                if (fq == 0) atomicAdd(ss + row, q);
            }
            asm volatile("" ::: "memory");
        }
    }
};

struct EpiUp {
    static constexpr bool PERM = true; static constexpr int SC_W = 0x79797979, SC_A = 0x7c7c7c7c;
    const float* ss; bf16_t* U;
    __device__ __forceinline__ bool keep(const Unit&) const { return false; }
    __device__ __forceinline__ void operator()(f32x4 (&acc)[2][2][4][2], const Unit& u, int wr, int wc, int fr, int fq) const {
        const int row0 = u.pm * BM + wr * 64 + fr, col0 = u.pn * BM + wc * 32 + 8 * fq;
        float rs[2][4];
#pragma unroll
        for (int ai = 0; ai < 2; ++ai)
#pragma unroll
            for (int m = 0; m < 4; ++m) rs[ai][m] = ss[row0 + ai * HALF + m * 16];
        asm volatile("" ::: "memory");
#pragma unroll
        for (int ai = 0; ai < 2; ++ai)
#pragma unroll
            for (int m = 0; m < 4; ++m) {
                const size_t row = (size_t)(row0 + ai * HALF + m * 16);
                const float rstd = __builtin_amdgcn_rsqf(rs[ai][m] * (1.0f / DM) + RMS_EPS);
#pragma unroll
                for (int bj = 0; bj < 2; ++bj) {
                    f32x4 a = acc[ai][bj][m][0] * rstd, b = acc[ai][bj][m][1] * rstd; u32x4 w;
#pragma unroll
                    for (int i = 0; i < 4; ++i) { a[i] = fmaxf(a[i], 0.f); a[i] *= a[i]; b[i] = fmaxf(b[i], 0.f); b[i] *= b[i]; }
                    w.x = cvt_pk_bf16(a[0], a[1]); w.y = cvt_pk_bf16(a[2], a[3]); w.z = cvt_pk_bf16(b[0], b[1]); w.w = cvt_pk_bf16(b[2], b[3]);
                    *(u32x4*)(U + row * DFF + col0 + bj * HALF) = w;
                }
            }
    }
};

template <class Epi, class Sched, bool ALIGN_EPI = false, bool SP2 = false, bool FP8 = false>
__device__ __forceinline__ void gemm_phase(PG8_LAS unsigned char* lds, const Gemm g, const Sched& S, const Epi& E) {
    int tid_ = threadIdx.x; asm volatile("" : "+v"(tid_));
    const int tid = tid_, wid = __builtin_amdgcn_readfirstlane(tid >> 6), lane = tid & 63, wr = wid >> 2, wc = wid & 3, fr = lane & 15, fq = lane >> 4;
    const int K = g.K, nt = K / BK;
    unsigned voffA[2], voffB[2];
#pragma unroll
    for (int i = 0; i < 2; ++i) { int R, C; stage_rc(tid * 16 + i * 8192, R, C); const int Rb = Epi::PERM ? ((R & ~31) + perm32(R & 31)) : R;
        voffA[i] = (unsigned)(R * K + C) * 2u; voffB[i] = (unsigned)(Rb * K + C) * 2u; }
    const size_t kstep = (size_t)(BK * 2);
    const size_t hstep = (size_t)HALF * K * 2;
    const size_t tstep = 2 * hstep;
    const unsigned ldsw = (unsigned)wid * 1024u;
    const int aoff = lds_byte(wr * 64 + fr, fq * 8), boff = lds_byte(wc * 32 + fr, fq * 8);
#define PG8_SA(b, h) (((b) * 2 + (h)) * HTB)
#define PG8_SB(b, h) ((4 + (b) * 2 + (h)) * HTB)
#define PG8_STAGE(bufoff, gbase, voff) do { _Pragma("unroll") for (int _i = 0; _i < 2; ++_i) \
        __builtin_amdgcn_global_load_lds((const unsigned*)((const char*)(gbase) + (voff)[_i]), (PG8_LAS unsigned*)(lds + (bufoff) + ldsw + _i * 8192), 16, 0, 0); } while (0)
#define PG8_LDA(dst, b, h) do { _Pragma("unroll") for (int m = 0; m < 4; ++m) { if constexpr (FP8) { dst##8[m].lo = *(const PG8_LAS v4i_t*)(lds + PG8_SA(b, h) + aoff + m * 2048); dst##8[m].hi = *(const PG8_LAS v4i_t*)(lds + PG8_SA(b, h) + aoff + m * 2048 + 1024); } \
        else { _Pragma("unroll") for (int k = 0; k < 2; ++k) dst[m][k] = *(const PG8_LAS bf16x8*)(lds + PG8_SA(b, h) + aoff + m * 2048 + k * 1024); } } } while (0)
#define PG8_LDB(dst, b, h) do { _Pragma("unroll") for (int n = 0; n < 2; ++n) { if constexpr (FP8) { dst##8[n].lo = *(const PG8_LAS v4i_t*)(lds + PG8_SB(b, h) + boff + n * 2048); dst##8[n].hi = *(const PG8_LAS v4i_t*)(lds + PG8_SB(b, h) + boff + n * 2048 + 1024); } \
        else { _Pragma("unroll") for (int k = 0; k < 2; ++k) dst[n][k] = *(const PG8_LAS bf16x8*)(lds + PG8_SB(b, h) + boff + n * 2048 + k * 1024); } } } while (0)
#define PG8_MMA(ai, bj, At, Bt) do { __builtin_amdgcn_s_setprio(1); _Pragma("unroll") for (int m = 0; m < 4; ++m) _Pragma("unroll") for (int n = 0; n < 2; ++n) { \
        if constexpr (FP8) {   \
            asm volatile("v_mfma_scale_f32_16x16x128_f8f6f4 %0, %1, %2, %0, %3, %4 op_sel_hi:[0,0,0]" : "+v"(acc[ai][bj][m][n]) : "v"(Bt##8[n]), "v"(At##8[m]), "v"(sc1_), "v"(sc2_));   \
        } else { _Pragma("unroll") for (int k = 0; k < 2; ++k) acc[ai][bj][m][n] = __builtin_amdgcn_mfma_f32_16x16x32_bf16(Bt[n][k], At[m][k], acc[ai][bj][m][n], 0, 0, 0); } } \
        __builtin_amdgcn_s_setprio(0); } while (0)
#define PG8_WAIT_V(n) asm volatile("s_waitcnt vmcnt(" #n ")" ::: "memory")
#define PG8_WAIT_L(n) asm volatile("s_waitcnt lgkmcnt(" #n ")" ::: "memory")
#define PG8_BAR __builtin_amdgcn_s_barrier()
#define PG8_SCHED __builtin_amdgcn_sched_barrier(0)
    Unit cur, nxt; int ui = 0;
    if (!S.next(0, cur)) return;
    f32x4 acc[2][2][4][2];
#pragma unroll
    for (int a = 0; a < 2; ++a)
#pragma unroll
        for (int b = 0; b < 2; ++b)
#pragma unroll
            for (int m = 0; m < 4; ++m)
#pragma unroll
                for (int n = 0; n < 2; ++n) acc[a][b][m][n] = (f32x4){0.f, 0.f, 0.f, 0.f};
    int sc1_ = Epi::SC_W, sc2_ = Epi::SC_A; asm volatile("" : "+v"(sc1_), "+v"(sc2_));
    bf16x8 At[4][2], B0[2][2], B1[2][2]; v8i_t At8[4], B08[2], B18[2];
    const char* cA = (const char*)(cur.z ? g.A1 : g.A0) + (size_t)cur.pm * tstep; const char* cB = (const char*)(cur.z ? g.B1 : g.B0) + (size_t)cur.pn * tstep;
    if constexpr (SP2) {
        PG8_STAGE(PG8_SB(0, 0), cB, voffB); PG8_STAGE(PG8_SB(0, 1), cB + hstep, voffB); PG8_STAGE(PG8_SA(0, 0), cA, voffA); PG8_STAGE(PG8_SA(0, 1), cA + hstep, voffA);
        if (wr == 1) PG8_BAR;
        PG8_WAIT_V(2); PG8_BAR;
        PG8_STAGE(PG8_SB(1, 0), cB + kstep, voffB); PG8_STAGE(PG8_SA(1, 0), cA + kstep, voffA); PG8_STAGE(PG8_SB(1, 1), cB + hstep + kstep, voffB);
        PG8_WAIT_V(6); PG8_BAR;
    } else {
        PG8_STAGE(PG8_SB(0, 0), cB, voffB); PG8_STAGE(PG8_SA(0, 0), cA, voffA); PG8_STAGE(PG8_SB(0, 1), cB + hstep, voffB); PG8_STAGE(PG8_SA(0, 1), cA + hstep, voffA);
        if (wr == 1) PG8_BAR;
        PG8_WAIT_V(4); PG8_BAR;
        PG8_STAGE(PG8_SB(1, 0), cB + kstep, voffB); PG8_STAGE(PG8_SA(1, 0), cA + kstep, voffA); PG8_STAGE(PG8_SB(1, 1), cB + hstep + kstep, voffB);
        PG8_WAIT_V(6); PG8_BAR;
    }
    for (;;) {
        const bool has_next = S.next(ui + 1, nxt);
        const char* nA = has_next ? (const char*)(nxt.z ? g.A1 : g.A0) + (size_t)nxt.pm * tstep : cA; const char* nB = has_next ? (const char*)(nxt.z ? g.B1 : g.B0) + (size_t)nxt.pn * tstep : cB;
        for (int t = 0; t < nt; t += 2) {
            const bool last = (t == nt - 2);
            const char* a1 = cA + (size_t)(t + 1) * kstep;
            const char* a2 = last ? nA : cA + (size_t)(t + 2) * kstep; const char* b2 = last ? nB : cB + (size_t)(t + 2) * kstep;
            const char* a3 = a2 + kstep; const char* b3 = b2 + kstep;
            if constexpr (SP2) {
            PG8_LDB(B0, 0, 0); PG8_LDB(B1, 0, 1); PG8_SCHED; PG8_LDA(At, 0, 0); PG8_STAGE(PG8_SA(1, 1), a1 + hstep, voffA);
            PG8_WAIT_V(8); PG8_WAIT_L(0); PG8_BAR; PG8_MMA(0, 0, At, B0); PG8_MMA(0, 1, At, B1); PG8_BAR; PG8_SCHED;
            PG8_LDA(At, 0, 1); PG8_STAGE(PG8_SB(0, 0), b2, voffB); PG8_STAGE(PG8_SB(0, 1), b2 + hstep, voffB); PG8_STAGE(PG8_SA(0, 0), a2, voffA);
            PG8_WAIT_V(8); PG8_WAIT_L(0); PG8_BAR; PG8_MMA(1, 0, At, B0); PG8_MMA(1, 1, At, B1); PG8_BAR; PG8_SCHED;
            PG8_LDB(B0, 1, 0); PG8_LDB(B1, 1, 1); PG8_SCHED; PG8_LDA(At, 1, 0); PG8_STAGE(PG8_SA(0, 1), a2 + hstep, voffA);
            PG8_WAIT_V(8); PG8_WAIT_L(0); PG8_BAR; PG8_MMA(0, 0, At, B0); PG8_MMA(0, 1, At, B1); PG8_BAR; PG8_SCHED;
            PG8_LDA(At, 1, 1); PG8_STAGE(PG8_SB(1, 0), b3, voffB); PG8_STAGE(PG8_SB(1, 1), b3 + hstep, voffB); PG8_STAGE(PG8_SA(1, 0), a3, voffA);
            PG8_WAIT_V(8); PG8_WAIT_L(0); PG8_BAR; PG8_MMA(1, 0, At, B0); PG8_MMA(1, 1, At, B1); PG8_BAR; PG8_SCHED;
            } else {
            PG8_LDB(B0, 0, 0); PG8_SCHED; PG8_LDA(At, 0, 0); PG8_STAGE(PG8_SA(1, 1), a1 + hstep, voffA);
            PG8_WAIT_L(8); PG8_BAR; PG8_WAIT_L(0); PG8_MMA(0, 0, At, B0); PG8_BAR; PG8_SCHED;
            PG8_LDB(B1, 0, 1); PG8_STAGE(PG8_SB(0, 0), b2, voffB);
            PG8_BAR; PG8_WAIT_L(0); PG8_MMA(0, 1, At, B1); PG8_BAR;
            PG8_LDA(At, 0, 1); PG8_STAGE(PG8_SA(0, 0), a2, voffA);
            PG8_BAR; PG8_WAIT_L(0); PG8_MMA(1, 0, At, B0); PG8_BAR; PG8_SCHED;
            PG8_STAGE(PG8_SB(0, 1), b2 + hstep, voffB);
            PG8_WAIT_V(6); PG8_BAR; PG8_MMA(1, 1, At, B1); PG8_BAR;
            PG8_LDB(B0, 1, 0); PG8_SCHED; PG8_LDA(At, 1, 0); PG8_STAGE(PG8_SA(0, 1), a2 + hstep, voffA);
            PG8_WAIT_L(8); PG8_BAR; PG8_WAIT_L(0); PG8_MMA(0, 0, At, B0); PG8_BAR; PG8_SCHED;
            PG8_LDB(B1, 1, 1); PG8_STAGE(PG8_SB(1, 0), b3, voffB);
            PG8_BAR; PG8_WAIT_L(0); PG8_MMA(0, 1, At, B1); PG8_BAR;
            PG8_LDA(At, 1, 1); PG8_STAGE(PG8_SA(1, 0), a3, voffA);
            PG8_BAR; PG8_WAIT_L(0); PG8_MMA(1, 0, At, B0); PG8_BAR; PG8_SCHED;
            PG8_STAGE(PG8_SB(1, 1), b3 + hstep, voffB);
            PG8_WAIT_V(6); PG8_BAR; PG8_MMA(1, 1, At, B1); PG8_BAR;
            }
        }
        if constexpr (ALIGN_EPI) { if (wr == 0) PG8_BAR; }
        if constexpr (FP8) asm volatile("s_nop 15\n\ts_nop 7" ::: "memory");
        E(acc, cur, wr, wc, fr, fq);
        if (!has_next) break;
        if (!E.keep(cur))
#pragma unroll
        for (int a = 0; a < 2; ++a)
#pragma unroll
            for (int b = 0; b < 2; ++b)
#pragma unroll
                for (int m = 0; m < 4; ++m)
#pragma unroll
                    for (int n = 0; n < 2; ++n) acc[a][b][m][n] = (f32x4){0.f, 0.f, 0.f, 0.f};
        cur = nxt; cA = nA; cB = nB; ++ui;
        if constexpr (ALIGN_EPI) { if (wr == 1) PG8_BAR; }
    }
    PG8_WAIT_V(0);
    if constexpr (!ALIGN_EPI) { if (wr == 0) PG8_BAR; }
    PG8_BAR;
#undef PG8_SA
#undef PG8_SB
#undef PG8_STAGE
#undef PG8_LDA
#undef PG8_LDB
#undef PG8_MMA
#undef PG8_WAIT_V
#undef PG8_WAIT_L
#undef PG8_BAR
#undef PG8_SCHED
}
}


namespace attn_body {
using bf16=unsigned short;
using bf16x8=__attribute__((ext_vector_type(8)))short;
using s16x4=__attribute__((ext_vector_type(4)))short;
using f32x16=__attribute__((ext_vector_type(16)))float;
using u32x4=__attribute__((ext_vector_type(4)))unsigned;
using f32x4v=__attribute__((ext_vector_type(4)))float;
constexpr int BATCH=4,NHEAD=16,SEQ=8192,D=64,DM=NHEAD*D;
constexpr int NW=8,QBLK=32,QB=QBLK*NW,KVBLK=64,NQB=SEQ/QB;
constexpr int ATTN_PITCH=DM, ATTN_UNIT_ROWS=QB;
__device__ __forceinline__ int crow(int r,int hi){return (r&3)+8*(r>>2)+4*hi;}
#define SBAR() __builtin_amdgcn_sched_barrier(0)
template<bool SWA> __device__ __forceinline__ void cmask(f32x16&p0,f32x16&p1,int jb,int qrel,int hi){
  const float NEG=-INFINITY; int kb=64*jb+4*hi;
  #pragma unroll
  for(int r=0;r<16;++r){int kv=kb+(r&3)+8*(r>>2);
    if(SWA){ if(kv>qrel||kv<=qrel-128)p0[r]=NEG; if(kv+32>qrel||kv+32<=qrel-128)p1[r]=NEG; }
    else{ if(kv>qrel)p0[r]=NEG; if(kv+32>qrel)p1[r]=NEG; } }
}

constexpr int NSLOT=3, SLOTB=8192;
#ifndef NVB
#define NVB 8
#endif
constexpr int LDS_K=0, LDS_V=NSLOT*SLOTB, LDS_WS=2*NSLOT*SLOTB, LDS_OST=LDS_WS+NW*64*4, LDS_CB=LDS_OST+NW*4096, LDS_BYTES=LDS_CB+4*256;
constexpr float C2=0.125f*1.4426950408889634f;
__device__ __forceinline__ void glds16(const void*gsrc,unsigned lds_dst){unsigned keep;
  asm volatile("s_mov_b32 %0, m0\n\ts_mov_b32 m0, %2\n\ts_nop 0\n\tglobal_load_lds_dwordx4 %1, off\n\ts_mov_b32 m0, %0":"=&s"(keep):"v"(gsrc),"s"(lds_dst):"memory");}
__device__ __forceinline__ void glds4(const void*gsrc,unsigned lds_dst){unsigned keep;
  asm volatile("s_mov_b32 %0, m0\n\ts_mov_b32 m0, %2\n\ts_nop 0\n\tglobal_load_lds_dword %1, off\n\ts_mov_b32 m0, %0":"=&s"(keep):"v"(gsrc),"s"(lds_dst):"memory");}
__device__ __forceinline__ float max3f(float a,float b,float c){float r;asm("v_max3_f32 %0, %1, %2, %3":"=v"(r):"v"(a),"v"(b),"v"(c));return r;}
__device__ __forceinline__ float max2f(float a,float b){float r;asm("v_max_f32_e32 %0, %1, %2":"=v"(r):"v"(a),"v"(b));return r;}
__device__ __forceinline__ float fadd_s(float a,float b){float r;asm("v_add_f32_e32 %0, %1, %2":"=v"(r):"v"(a),"v"(b));return r;}
__device__ __forceinline__ float fsub_s(float a,float b){float r;asm("v_sub_f32_e32 %0, %1, %2":"=v"(r):"v"(a),"v"(b));return r;}
typedef float f32x2_t __attribute__((ext_vector_type(2))); typedef __bf16 bf16x2_t __attribute__((ext_vector_type(2)));
__device__ __forceinline__ unsigned cvtpk_s(float lo,float hi){f32x2_t v={lo,hi};bf16x2_t b=__builtin_convertvector(v,bf16x2_t);return __builtin_bit_cast(unsigned,b);}
#define WAIT_BAR(N) asm volatile("s_waitcnt vmcnt(" #N ") lgkmcnt(0)\n\ts_barrier":::"memory")

__device__ __forceinline__ void qkt(f32x16&p0,f32x16&p1,const char*Kslot,const bf16x8*qr,int r32,int hi){
  const char*kb=Kslot+hi*1024+r32*16;
  #pragma unroll
  for(int d0=0;d0<4;++d0){
    const bf16x8 b0=*reinterpret_cast<const bf16x8*>(kb+d0*2048);
    const bf16x8 b1=*reinterpret_cast<const bf16x8*>(kb+d0*2048+512);
    {p0=__builtin_amdgcn_mfma_f32_32x32x16_bf16(b0,qr[d0],p0,0,0,0);p1=__builtin_amdgcn_mfma_f32_32x32x16_bf16(b1,qr[d0],p1,0,0,0);}}
}
typedef __attribute__((address_space(3))) const char* lds_cptr;
typedef short v4i16_t __attribute__((ext_vector_type(4)));
__device__ __forceinline__ void kload8(bf16x8*kf,lds_cptr kp){
  kf[0]=*(const __attribute__((address_space(3))) bf16x8*)(kp);      kf[1]=*(const __attribute__((address_space(3))) bf16x8*)(kp+512);
  kf[2]=*(const __attribute__((address_space(3))) bf16x8*)(kp+2048); kf[3]=*(const __attribute__((address_space(3))) bf16x8*)(kp+2560);
  kf[4]=*(const __attribute__((address_space(3))) bf16x8*)(kp+4096); kf[5]=*(const __attribute__((address_space(3))) bf16x8*)(kp+4608);
  kf[6]=*(const __attribute__((address_space(3))) bf16x8*)(kp+6144); kf[7]=*(const __attribute__((address_space(3))) bf16x8*)(kp+6656);
}
__device__ __forceinline__ void kload2(bf16x8*kf,lds_cptr kp,int j){ kf[2*j]=*(const __attribute__((address_space(3))) bf16x8*)(kp+j*2048); kf[2*j+1]=*(const __attribute__((address_space(3))) bf16x8*)(kp+j*2048+512); }
__device__ __forceinline__ s16x4 vtr(lds_cptr p){ return __builtin_bit_cast(s16x4,__builtin_amdgcn_ds_read_tr16_b64_v4i16((__attribute__((address_space(3))) v4i16_t*)p)); }
__device__ __forceinline__ float rowmax(const f32x16&p0,const f32x16&p1){
  float a=max3f(p0[0],p0[1],p1[0]),b=max3f(p0[2],p0[3],p1[1]);a=max3f(a,p1[2],p1[3]);
  #pragma unroll
  for(int r=4;r<16;r+=4){a=max3f(a,p0[r],p0[r+1]);b=max3f(b,p0[r+2],p0[r+3]);a=max3f(a,p1[r],p1[r+1]);b=max3f(b,p1[r+2],p1[r+3]);}
  const float m=max2f(a,b);
  auto rr=__builtin_amdgcn_permlane32_swap(__float_as_uint(m),__float_as_uint(m),false,false);
  return max2f(__uint_as_float(rr[0]),__uint_as_float(rr[1]));
}
__device__ __forceinline__ void pv(f32x16*o,int vb,bf16x8 pa0,bf16x8 pa1,bf16x8 pa2,bf16x8 pa3){
  #pragma unroll
  for(int d0=0;d0<2;++d0){s16x4 lo[4],hi[4];
    #pragma unroll
    for(int ks=0;ks<4;++ks){
      asm volatile("ds_read_b64_tr_b16 %0,%1 offset:%c2":"=&v"(lo[ks]):"v"(vb),"i"(d0*4096+ks*1024):"memory");
      asm volatile("ds_read_b64_tr_b16 %0,%1 offset:%c2":"=&v"(hi[ks]):"v"(vb),"i"(d0*4096+ks*1024+512):"memory");}
    asm volatile("s_waitcnt lgkmcnt(0)":::"memory");SBAR();
    #define PK(k) (bf16x8){lo[k][0],lo[k][1],lo[k][2],lo[k][3],hi[k][0],hi[k][1],hi[k][2],hi[k][3]}
    o[d0]=__builtin_amdgcn_mfma_f32_32x32x16_bf16(pa0,PK(0),o[d0],0,0,0);
    o[d0]=__builtin_amdgcn_mfma_f32_32x32x16_bf16(pa1,PK(1),o[d0],0,0,0);
    o[d0]=__builtin_amdgcn_mfma_f32_32x32x16_bf16(pa2,PK(2),o[d0],0,0,0);
    o[d0]=__builtin_amdgcn_mfma_f32_32x32x16_bf16(pa3,PK(3),o[d0],0,0,0);
    #undef PK
  }
}

typedef __attribute__((address_space(3))) const f32x4v* lds_f4ptr;
__device__ __forceinline__ void fill_bias(f32x16&c0,f32x16&c1,lds_cptr cb,float negmh){
  #pragma unroll
  for(int g=0;g<4;++g){ const f32x4v v=*(lds_f4ptr)(cb+g*32), w=*(lds_f4ptr)(cb+128+g*32);
    #pragma unroll
    for(int i=0;i<4;i+=2){ const f32x2_t nm={negmh,negmh}; const f32x2_t a=nm-(f32x2_t){v[i],v[i+1]}, b=nm-(f32x2_t){w[i],w[i+1]}; c0[4*g+i]=a.x; c0[4*g+i+1]=a.y; c1[4*g+i]=b.x; c1[4*g+i+1]=b.y; } }
}
#ifndef ATTN_STORE16
#define ATTN_STORE16(p,v) (*(u32x4*)(p)=(v))
#endif
template<int THRL,bool FOX,int KP> __device__ __forceinline__ void attn_unit(int b,int h,int qb,const bf16*Q,const bf16*__restrict__ K,const bf16*__restrict__ V,bf16*O,const float*__restrict__ Cb,float sink2,char*shm){
  int tid_=threadIdx.x; asm volatile("":"+v"(tid_));
  const int tid=tid_,lane=tid&63,r32=lane&31,hi=lane>>5; const int wid=__builtin_amdgcn_readfirstlane(tid>>6);
  const long rowbase=(long)b*SEQ; const int q0=qb*QB;
  const bf16*Qw=Q+(rowbase+q0+wid*QBLK)*DM+h*D;
  const int kvh=FOX?h:(h>>3); const int T0=FOX?0:(qb==0?0:4*qb-2);
  const bf16*Kh=K+(rowbase+(long)T0*KVBLK)*KP+kvh*D,*Vh=V+(rowbase+(long)T0*KVBLK)*KP+kvh*D; const float*Cs=FOX?Cb+lane:nullptr;
  const unsigned lds0=(unsigned)(uintptr_t)shm;
  float*wsf=(float*)(shm+LDS_WS)+wid*64;
  const bf16*ksrc=Kh+(long)lane*KP+wid*8;
  const bf16*vsrc=Vh+(long)(16*(wid&3)+(lane>>2))*KP+(wid>>2)*32+(lane&3)*8;
  const unsigned kdst=lds0+LDS_K+wid*1024, vdst=lds0+LDS_V+wid*1024;
  #define DMA_K(t,slot) glds16(ksrc+(long)(t)*KVBLK*KP,(unsigned)__builtin_amdgcn_readfirstlane(kdst+(slot)))
  #define DMA_C(t) do{ if(FOX) glds4(Cs+(long)(t)*KVBLK,(unsigned)__builtin_amdgcn_readfirstlane(lds0+LDS_CB+(((t)&3)<<8))); }while(0)
  #define PREFILL(X0,X1,t) do{ if(FOX){ fill_bias(X0,X1,cb0+(((t)&3)<<8),-mhat); } else { _Pragma("unroll") for(int r=0;r<16;++r){X0[r]=-mhat;X1[r]=-mhat;} } }while(0)
  #define DMA_V(t,slot) glds16(vsrc+(long)(t)*KVBLK*KP,(unsigned)__builtin_amdgcn_readfirstlane(vdst+(slot)))
  const int vb0=(int)(lds0+LDS_V)+((lane>>4)&1)*32+(lane&3)*8+(4*hi+((lane&15)>>2))*64;
  const char*Kbase=shm+LDS_K; bf16x8 kf[8];
  const lds_cptr shm3=(lds_cptr)shm; const lds_cptr cb0=shm3+LDS_CB+hi*16; const lds_cptr kp0=shm3+LDS_K+hi*1024+r32*16; const lds_cptr vp0=shm3+LDS_V+((lane>>4)&1)*32+(lane&3)*8+(4*hi+((lane&15)>>2))*64;
  const int NT=FOX?(q0+QB)/KVBLK:(qb==0?4:6);
  DMA_K(0,0);DMA_C(0);DMA_V(0,0);DMA_K(1,SLOTB);DMA_C(1);
  bf16x8 qr[4];
  #pragma unroll
  for(int d0=0;d0<4;++d0)qr[d0]=*reinterpret_cast<const bf16x8*>(&Qw[(long)r32*DM+d0*16+hi*8]);
  float mhat=FOX?-Cb[q0+wid*QBLK+r32]:0.f,l_reg=0.f;    f32x16 o[2];o[0]=f32x16{};o[1]=f32x16{};
  const int qrel=wid*QBLK+r32;
  #define CMASK(P0,P1,t) do{int jb_=(t)-(NT-4); if(!FOX||jb_>=0)cmask<!FOX>(P0,P1,jb_,qrel,hi);}while(0)
  bool resc=false;
  #define START(P0,P1) do{ float rm=__builtin_fmaxf(rowmax(P0,P1),0.f); resc=false;     \
    { const float dl=rm; mhat=fadd_s(mhat,dl); \
      _Pragma("unroll") for(int r=0;r<16;++r){P0[r]=fsub_s(P0[r],dl);P1[r]=fsub_s(P1[r],dl);} } \
    _Pragma("unroll") for(int r=0;r<16;++r)P0[r]=__builtin_amdgcn_exp2f(P0[r]); }while(0)
  #define RESC() do{ if(resc){ asm volatile("s_waitcnt lgkmcnt(0)":::"memory"); \
      _Pragma("unroll") for(int d_=0;d_<2;++d_) _Pragma("unroll") for(int r=0;r<16;++r)o[d_][r]*=wsf[crow(r,hi)]; } }while(0)
  f32x16 pA0,pA1,pB0,pB1;
  int sl_prev=0,sl_cur=0,sl_next=SLOTB;
  #define ROT() do{sl_prev=sl_cur;sl_cur=sl_next;sl_next=(sl_next==(NSLOT-1)*SLOTB)?0:sl_next+SLOTB;}while(0)
  DMA_K(2,2*SLOTB);DMA_C(2);
  if(FOX){WAIT_BAR(5);}else{WAIT_BAR(3);}
  PREFILL(pA0,pA1,0); qkt(pA0,pA1,Kbase,qr,r32,hi);asm volatile("s_nop 15\n\ts_nop 7":"+v"(pA0),"+v"(pA1));CMASK(pA0,pA1,0);
  START(pA0,pA1);
  _Pragma("unroll") for(int r=0;r<16;++r)pA1[r]=__builtin_amdgcn_exp2f(pA1[r]);
  WAIT_BAR(0);
  DMA_K(3,0);DMA_C(3);DMA_V(1,SLOTB);
  ROT();
  kload8(kf,kp0+sl_cur);
  PREFILL(pB0,pB1,1); if(FOX){ WAIT_BAR(3); }else{ WAIT_BAR(2); }
  s16x4 vlo[NVB],vhi[NVB]; u32x4 pw0,pw1,pw2,pw3;
  #define PKW(P,B) cvtpk_s(P[B],P[B+1])
  #define PAF(k) __builtin_bit_cast(bf16x8,pw##k)
  #define VFR(j) (bf16x8){vlo[(j)%NVB][0],vlo[(j)%NVB][1],vlo[(j)%NVB][2],vlo[(j)%NVB][3],vhi[(j)%NVB][0],vhi[(j)%NVB][1],vhi[(j)%NVB][2],vhi[(j)%NVB][3]}
  #define PIN(x) asm volatile("":"+v"(x))
  #define MX3(a,b,c) __builtin_fmaxf(__builtin_fmaxf((a),(b)),(c))
  #define GAPA(MF,A0,A1,A2,A3,W0,W1,PW) do{ MF; sacc+=(f32x2_t){A0,A1}; sacc+=(f32x2_t){A2,A3}; PIN(sacc); W0; W1; PIN(PW); SBAR(); }while(0)
  #define EX(v) __builtin_amdgcn_exp2f(v)
  #define GAPB(MF,VR,BX_,X,B) do{ MF; VR; BX_; X[B]=EX(X[B]); X[B+1]=EX(X[B+1]); X[B+2]=EX(X[B+2]); X[B+3]=EX(X[B+3]); PIN(X); SBAR(); }while(0)
  #define VOFF(j) ((((j)&1)*4096)+(((j)>>1)*1024))
  #define VRD(j) do{ if((j)>=0&&(j)<8){ vlo[(j)%NVB]=vtr(vp_+VOFF(j)); vhi[(j)%NVB]=vtr(vp_+VOFF(j)+512); } }while(0)
  #define KRD(G,j) do{ if(G){ kload2(kf,kp0+sl_next,j); SBAR(); } }while(0)
  #define BSUBX(X,g) do{ const f32x2_t nm_={nmh_,nmh_}; const f32x2_t a_=nm_-(f32x2_t){bt[0],bt[1]}, b_=nm_-(f32x2_t){bt[2],bt[3]}; X[4*(g)+0]=a_.x; X[4*(g)+1]=a_.y; X[4*(g)+2]=b_.x; X[4*(g)+3]=b_.y; }while(0)
  #define BXX(Y0,Y1,j,G) do{ if(FOX&&(G)){ if((j)>=1&&(j)<=4){BSUBX(Y0,((j)-1)&3);} if((j)>=5){BSUBX(Y1,((j)-5)&3);} if((j)<8){ bt=*(lds_f4ptr)(cbn_+(((j)&3)*32+((j)>>2)*128)); } } }while(0)
  #define STEP(C0,C1,P0,P1,t,GK,GV,GL) do{ SBAR(); f32x4v bt; const lds_cptr cbn_=cb0+((((t)+1)&3)<<8); \
    const lds_cptr vp_=vp0+sl_prev; \
    VRD(0-(8-NVB)); SBAR(); f32x2_t sacc={P0[0],P0[1]}; \
    GAPA(C0=__builtin_amdgcn_mfma_f32_32x32x16_bf16(kf[0],qr[0],C0,0,0,0), P0[2],P0[3],P0[4],P0[5],     pw0[0]=PKW(P0,0), pw0[1]=PKW(P0,2), pw0); \
    VRD(1-(8-NVB)); SBAR(); GAPA(C1=__builtin_amdgcn_mfma_f32_32x32x16_bf16(kf[1],qr[0],C1,0,0,0), P0[6],P0[7],P0[8],P0[9],     pw0[2]=PKW(P0,4), pw0[3]=PKW(P0,6), pw0); \
    VRD(2-(8-NVB)); SBAR(); GAPA(C0=__builtin_amdgcn_mfma_f32_32x32x16_bf16(kf[2],qr[1],C0,0,0,0),   P0[10],P0[11],P0[12],P0[13], pw1[0]=PKW(P0,8), pw1[1]=PKW(P0,10), pw1); \
    VRD(3-(8-NVB)); SBAR(); GAPA(C1=__builtin_amdgcn_mfma_f32_32x32x16_bf16(kf[3],qr[1],C1,0,0,0),   P0[14],P0[15],P1[0],P1[1],   pw1[2]=PKW(P0,12),pw1[3]=PKW(P0,14), pw1); \
    VRD(4-(8-NVB)); SBAR(); GAPA(C0=__builtin_amdgcn_mfma_f32_32x32x16_bf16(kf[4],qr[2],C0,0,0,0),   P1[2],P1[3],P1[4],P1[5],     pw2[0]=PKW(P1,0), pw2[1]=PKW(P1,2), pw2); \
    VRD(5-(8-NVB)); SBAR(); GAPA(C1=__builtin_amdgcn_mfma_f32_32x32x16_bf16(kf[5],qr[2],C1,0,0,0),   P1[6],P1[7],P1[8],P1[9],     pw2[2]=PKW(P1,4), pw2[3]=PKW(P1,6), pw2); \
    VRD(6-(8-NVB)); SBAR(); GAPA(C0=__builtin_amdgcn_mfma_f32_32x32x16_bf16(kf[6],qr[3],C0,0,0,0),   P1[10],P1[11],P1[12],P1[13], pw3[0]=PKW(P1,8), pw3[1]=PKW(P1,10), pw3); \
    VRD(7-(8-NVB)); SBAR(); GAPA(C1=__builtin_amdgcn_mfma_f32_32x32x16_bf16(kf[7],qr[3],C1,0,0,0),   P1[14],P1[15],0.f,0.f,       pw3[2]=PKW(P1,12),pw3[3]=PKW(P1,14), pw3); \
    l_reg+=sacc.x+sacc.y; \
    if(GK){DMA_K((t)+3,sl_cur);DMA_C((t)+3);} if(GV){DMA_V((t)+1,sl_next);} \
    CMASK(C0,C1,t); \
    { float a=MX3(C0[0],C0[1],C1[0]),b=MX3(C0[2],C0[3],C1[1]); a=MX3(a,C1[2],C1[3]); \
      _Pragma("unroll") for(int r=4;r<16;r+=4){a=MX3(a,C0[r],C0[r+1]);b=MX3(b,C0[r+2],C0[r+3]);a=MX3(a,C1[r],C1[r+1]);b=MX3(b,C1[r+2],C1[r+3]);} \
      float rm=__builtin_fmaxf(a,b); { auto rr=__builtin_amdgcn_permlane32_swap(__float_as_uint(rm),__float_as_uint(rm),false,false); rm=__builtin_fmaxf(__uint_as_float(rr[0]),__uint_as_float(rr[1])); } \
      resc=false; \
      if(__builtin_expect(__any(rm>(float)THRL),0)){ const float dl=__builtin_fmaxf(rm,0.f); mhat+=dl; \
        _Pragma("unroll") for(int r=0;r<16;++r){C0[r]-=dl;C1[r]-=dl;} \
        const float f=__builtin_amdgcn_exp2f(-dl); l_reg*=f; if(hi==0)wsf[r32]=f; resc=true; } } \
    const float nmh_=-mhat; SBAR(); \
    GAPB(o[0]=__builtin_amdgcn_mfma_f32_32x32x16_bf16(PAF(0),VFR(0),o[0],0,0,0), VRD(0+NVB), BXX(P0,P1,0,GL), C0,0); \
    GAPB(o[1]=__builtin_amdgcn_mfma_f32_32x32x16_bf16(PAF(0),VFR(1),o[1],0,0,0), VRD(1+NVB), BXX(P0,P1,1,GL), C0,4); \
    KRD(GL,0); GAPB(o[0]=__builtin_amdgcn_mfma_f32_32x32x16_bf16(PAF(1),VFR(2),o[0],0,0,0), VRD(2+NVB), BXX(P0,P1,2,GL), C0,8); \
    KRD(GL,1); GAPB(o[1]=__builtin_amdgcn_mfma_f32_32x32x16_bf16(PAF(1),VFR(3),o[1],0,0,0), VRD(3+NVB), BXX(P0,P1,3,GL), C0,12); \
    KRD(GL,2); GAPB(o[0]=__builtin_amdgcn_mfma_f32_32x32x16_bf16(PAF(2),VFR(4),o[0],0,0,0), VRD(4+NVB), BXX(P0,P1,4,GL), C1,0); \
    KRD(GL,3); GAPB(o[1]=__builtin_amdgcn_mfma_f32_32x32x16_bf16(PAF(2),VFR(5),o[1],0,0,0), VRD(5+NVB), BXX(P0,P1,5,GL), C1,4); \
    GAPB(o[0]=__builtin_amdgcn_mfma_f32_32x32x16_bf16(PAF(3),VFR(6),o[0],0,0,0), VRD(6+NVB), BXX(P0,P1,6,GL), C1,8); \
    GAPB(o[1]=__builtin_amdgcn_mfma_f32_32x32x16_bf16(PAF(3),VFR(7),o[1],0,0,0), VRD(7+NVB), BXX(P0,P1,7,GL), C1,12); \
    BXX(P0,P1,8,GL); if(!FOX&&(GL)){ PREFILL(P0,P1,(t)+1); } \
    }while(0)
  int t=1;
  #undef CMASK
  #define CMASK(P0,P1,t) do{}while(0)
  for(;t+5<NT;t+=2){
    STEP(pB0,pB1,pA0,pA1,t,true,true,true);     if(FOX){WAIT_BAR(3);}else{WAIT_BAR(2);} RESC(); ROT();
    STEP(pA0,pA1,pB0,pB1,t+1,true,true,true);   if(FOX){WAIT_BAR(3);}else{WAIT_BAR(2);} RESC(); ROT();
  }
  #undef CMASK
  #define CMASK(P0,P1,t) do{int jb_=(t)-(NT-4); if(!FOX||jb_>=0)cmask<!FOX>(P0,P1,jb_,qrel,hi);}while(0)
  #define ENDW(tt) do{ if((tt)+3<NT){ if(FOX){WAIT_BAR(3);}else{WAIT_BAR(2);} } else if((tt)+2<NT){WAIT_BAR(1);} else {WAIT_BAR(0);} }while(0)
  for(;t+1<NT;t+=2){
    STEP(pB0,pB1,pA0,pA1,t,(t+3<NT),(t+1<NT),(t+1<NT));       ENDW(t);   RESC(); ROT();
    STEP(pA0,pA1,pB0,pB1,t+1,(t+4<NT),(t+2<NT),(t+2<NT));     ENDW(t+1); RESC(); ROT();
  }
  STEP(pB0,pB1,pA0,pA1,NT-1,false,false,false); RESC();
  { float sacc=pB0[0]+pB0[1]; _Pragma("unroll") for(int r=2;r<16;++r)sacc+=pB0[r]; _Pragma("unroll") for(int r=0;r<16;++r)sacc+=pB1[r]; l_reg+=sacc;
    pw0=(u32x4){PKW(pB0,0),PKW(pB0,2),PKW(pB0,4),PKW(pB0,6)};pw1=(u32x4){PKW(pB0,8),PKW(pB0,10),PKW(pB0,12),PKW(pB0,14)};pw2=(u32x4){PKW(pB1,0),PKW(pB1,2),PKW(pB1,4),PKW(pB1,6)};pw3=(u32x4){PKW(pB1,8),PKW(pB1,10),PKW(pB1,12),PKW(pB1,14)};
    SBAR(); pv(o,vb0+sl_cur,PAF(0),PAF(1),PAF(2),PAF(3)); }
  #undef PKW
  #undef PAF
  #undef VFR
  #undef PIN
  #undef MX3
  #undef GAPA
  #undef GAPB
  #undef EX
  #undef VRD
  #undef VOFF
  #undef KRD
  #undef STEP
  #undef ENDW
  {auto rr=__builtin_amdgcn_permlane32_swap(__float_as_uint(l_reg),__float_as_uint(l_reg),false,false);l_reg=__uint_as_float(rr[0])+__uint_as_float(rr[1]);}
  if(!FOX) l_reg+=__builtin_amdgcn_exp2f(sink2-mhat);
  if(hi==0)wsf[32+r32]=l_reg;asm volatile("s_waitcnt lgkmcnt(0)":::"memory");
  float rli[16];
  #pragma unroll
  for(int r=0;r<16;++r)rli[r]=__builtin_amdgcn_rcpf(wsf[32+crow(r,hi)]);
  bf16*Ow=O+(rowbase+q0+wid*QBLK)*DM+h*D;
  { bf16*stg=(bf16*)(shm+LDS_OST)+wid*2048;
    #pragma unroll
    for(int r=0;r<16;++r){const int orow=crow(r,hi);
      #pragma unroll
      for(int d0=0;d0<2;++d0)stg[orow*64+d0*32+r32]=(bf16)(cvtpk_s(o[d0][r]*rli[r],0.f)&0xffffu);}
    asm volatile("s_waitcnt lgkmcnt(0)":::"memory");
    #pragma unroll
    for(int i=0;i<4;++i){const int row=i*8+(lane>>3),ch=lane&7; const u32x4 v=*(const u32x4*)(stg+row*64+ch*8); ATTN_STORE16(Ow+(long)row*DM+ch*8,v);} }
  asm volatile("s_waitcnt lgkmcnt(0)\n\ts_barrier":::"memory");
  #undef DMA_K
  #undef DMA_V
  #undef DMA_C
  #undef PREFILL
  #undef BSUBX
  #undef BXX
  #undef CMASK
  #undef START
  #undef RESC
  #undef ROT
}
constexpr int ATTN_LDS_BYTES=LDS_BYTES;
#undef SBAR
#undef WAIT_BAR
}

#ifndef REP_PHASE
#define REP_PHASE 0
#endif
#ifndef FUSED_FINAL
#define FUSED_FINAL 0
#endif
#ifndef NAIVE_SWA
#define NAIVE_SWA 0
#endif
#ifndef NAIVE_FOX
#define NAIVE_FOX 0
#endif
#define LAS __attribute__((address_space(3)))
typedef unsigned short bf16;
typedef float f32x4 __attribute__((ext_vector_type(4)));
typedef unsigned v4u __attribute__((ext_vector_type(4)));
typedef unsigned v2u __attribute__((ext_vector_type(2)));
constexpr int NWAVES = 8;
constexpr int RING_BYTES = 131072, LDS_BYTES = 147456;

__device__ __forceinline__ float wave_sum(float v) {
#pragma unroll
    for (int o = 1; o < 64; o <<= 1) v += __shfl_xor(v, o);
    return v;
}
#define LDS_WAIT() asm volatile("s_waitcnt lgkmcnt(0)" ::: "memory")

#define XB_TMO      128
#define XB_XCNT(j)  (256  + 64 * (j))
#define XB_XSUB(j)  (1280 + 64 * (j))
#define XB_XGEN(j)  (2304 + 64 * (j))
#define XB_TOP      3328
#define XB_TOPGEN   3392
#define XCD_BAR_WORDS 3456
#define XB_SPIN_CAP (1u << 18)

__device__ __forceinline__ unsigned xb_ld(unsigned* p)              { return __hip_atomic_load(p, __ATOMIC_RELAXED, __HIP_MEMORY_SCOPE_AGENT); }
__device__ __forceinline__ unsigned xb_add(unsigned* p, unsigned v) { return __hip_atomic_fetch_add(p, v, __ATOMIC_RELAXED, __HIP_MEMORY_SCOPE_AGENT); }
__device__ __forceinline__ unsigned xb_xcc_id() { return (unsigned)__builtin_amdgcn_s_getreg((3 << 11) | 20) & 0xFu; }
#define XB_SPIN(cond, bar) do { unsigned _sp = 0; while (cond) { __builtin_amdgcn_s_sleep(1); \
    if ((++_sp & 255u) == 0u) { if (xb_ld(&(bar)[XB_TMO])) break; if (_sp > XB_SPIN_CAP) { atomicAdd(&(bar)[XB_TMO], 1u); break; } } } } while (0)

struct XcdBarrier {
    unsigned* bar; unsigned x;
    volatile LAS unsigned* st;
};

__device__ __forceinline__ XcdBarrier xcd_barrier_post(unsigned* bar, volatile LAS unsigned* st) {
    XcdBarrier b; b.bar = bar; b.x = xb_xcc_id(); b.st = st;
    if (threadIdx.x == 0) (void)xb_add(&bar[XB_XCNT(b.x)], 1u);
    return b;
}
__device__ __forceinline__ void xcd_barrier_complete(unsigned* bar, unsigned x, unsigned& nloc, unsigned& nx) {
    const unsigned G = gridDim.x * gridDim.y * gridDim.z;
    unsigned sum, cnt, mine, sp = 0u;
    for (;;) {
        sum = 0u; cnt = 0u; mine = 0u;
#pragma unroll
        for (unsigned j = 0; j < 16; ++j) { const unsigned c = xb_ld(&bar[XB_XCNT(j)]); sum += c; cnt += (c > 0u) ? 1u : 0u; mine = (j == x) ? c : mine; }
        if (sum == G) break;
        __builtin_amdgcn_s_sleep(1);
        if ((++sp & 255u) == 0u) { if (xb_ld(&bar[XB_TMO])) break; if (sp > XB_SPIN_CAP) { atomicAdd(&bar[XB_TMO], 1u); break; } }
    }
    nloc = mine > 0u ? mine : 1u; nx = cnt > 0u ? cnt : 1u;
}

__device__ __forceinline__ void xcd_barrier(const XcdBarrier& b) {
    asm volatile("s_waitcnt vmcnt(0)" ::: "memory");
    __syncthreads();
    if (threadIdx.x == 0) {
        unsigned* bar = b.bar;
        __builtin_amdgcn_s_waitcnt(0);
        unsigned nloc = b.st[0], nx = b.st[1];
        if (nloc == 0u) { xcd_barrier_complete(bar, b.x, nloc, nx); b.st[0] = nloc; b.st[1] = nx; }
        const unsigned old = xb_add(&bar[XB_XSUB(b.x)], 1u);
        const unsigned gen = old / nloc;
        if (old + 1u == (gen + 1u) * nloc) {
            __builtin_amdgcn_fence(__ATOMIC_RELEASE, "agent");
            asm volatile("s_waitcnt vmcnt(0)" ::: "memory");
            const unsigned og = xb_add(&bar[XB_TOP], 1u);
            const unsigned tg = og / nx;
            if (og + 1u == (tg + 1u) * nx) xb_add(&bar[XB_TOPGEN], 1u);
            else XB_SPIN(xb_ld(&bar[XB_TOPGEN]) == tg, bar);
            __builtin_amdgcn_fence(__ATOMIC_ACQUIRE, "agent");
            xb_add(&bar[XB_XGEN(b.x)], 1u);
            asm volatile("s_waitcnt vmcnt(0)" ::: "memory");
        } else {
            XB_SPIN(xb_ld(&bar[XB_XGEN(b.x)]) == gen, bar);
            __builtin_amdgcn_fence(__ATOMIC_ACQUIRE, "agent");
            asm volatile("s_waitcnt vmcnt(0)" ::: "memory");
        }
    }
    __syncthreads();
}


__device__ __forceinline__ void tr_item(const float* W, int K, int N, bf16* WT, int dst_row0, int src_col0, int nvalid, int kb, const float* kscale, float cscale, LAS float* scr, int lane) {
    const int k0 = 64 * kb, c = lane & 31;
    float tv[32];
    const float* wp = W + (size_t)(k0 + (lane >> 5)) * N + src_col0 + c;
#pragma unroll
    for (int i = 0; i < 32; ++i) { tv[i] = 0.f; if (c < nvalid) tv[i] = __builtin_nontemporal_load(wp + (size_t)(2 * i) * N); }
#pragma unroll
    for (int i = 0; i < 32; ++i) { const int kk = 2 * i + (lane >> 5); float v = tv[i] * cscale; if (kscale) v *= kscale[k0 + kk]; scr[kk * 33 + c] = v; }
    LDS_WAIT(); asm volatile("" ::: "memory");
    const int ch = lane & 7;
#pragma unroll
    for (int j = 0; j < 4; ++j) { const int n = (lane >> 3) + 8 * j; const LAS float* s = scr + (8 * ch) * 33 + n;
        v4u o; o.x = pg8::cvt_pk_bf16(s[0 * 33], s[1 * 33]); o.y = pg8::cvt_pk_bf16(s[2 * 33], s[3 * 33]); o.z = pg8::cvt_pk_bf16(s[4 * 33], s[5 * 33]); o.w = pg8::cvt_pk_bf16(s[6 * 33], s[7 * 33]);
        *(v4u*)(WT + (size_t)(dst_row0 + n) * K + k0 + 8 * ch) = o; }
    LDS_WAIT(); asm volatile("" ::: "memory");
}
__device__ __forceinline__ void tr_item8(const float* W, int K, int N, unsigned char* WT8, int dst_row0, int src_col0, int kb, float cscale, LAS float* scr, int lane) {
    const int k0 = 64 * kb, c = lane & 31;
    float tv[32];
    const float* wp = W + (size_t)(k0 + (lane >> 5)) * N + src_col0 + c;
#pragma unroll
    for (int i = 0; i < 32; ++i) tv[i] = __builtin_nontemporal_load(wp + (size_t)(2 * i) * N);
#pragma unroll
    for (int i = 0; i < 32; ++i) { const int kk = 2 * i + (lane >> 5); scr[kk * 33 + c] = tv[i] * cscale; }
    LDS_WAIT(); asm volatile("" ::: "memory");
    const int ch = lane & 7;
#pragma unroll
    for (int j = 0; j < 4; ++j) { const int n = (lane >> 3) + 8 * j; const LAS float* s = scr + (8 * ch) * 33 + n;
        int w0 = 0, w1 = 0; w0 = __builtin_amdgcn_cvt_pk_fp8_f32(s[0 * 33], s[1 * 33], w0, false); w0 = __builtin_amdgcn_cvt_pk_fp8_f32(s[2 * 33], s[3 * 33], w0, true);
        w1 = __builtin_amdgcn_cvt_pk_fp8_f32(s[4 * 33], s[5 * 33], w1, false); w1 = __builtin_amdgcn_cvt_pk_fp8_f32(s[6 * 33], s[7 * 33], w1, true);
        v2u o; o.x = (unsigned)w0; o.y = (unsigned)w1; *(v2u*)(WT8 + (size_t)(dst_row0 + n) * K + k0 + 8 * ch) = o; }
    LDS_WAIT(); asm volatile("" ::: "memory");
}
__device__ __forceinline__ void win_map(int db, int& src, int& nv) {
    const int pn = db >> 3, bj = (db >> 2) & 1, wc = db & 3; nv = 32;
    if (pn == 0) src = (wc < 2 ? 1024 + wc * 64 : 1152 + (wc - 2) * 64) + 32 * bj;
    else if (pn < 13) { const int t = pn - 1; src = 1280 + (t >> 2) * 1024 + (4 * (t & 3) + wc) * 64 + 32 * bj; }
    else { src = 4352; nv = (db == 104) ? 16 : 0; }
}
__device__ __forceinline__ void wg8_map(int db, int& src, float& sc) {
    if (db < 128) { src = 4368 + db * 32; sc = -64.0f * LOG2E; return; }
    const int d = db - 128, t = d >> 3, bj = (d >> 2) & 1, wc = d & 3;
    src = (4 * t + wc) * 64 + 32 * bj; sc = 64.0f * C2;
}

struct Args { const float* x; const int* pos; const float* attn_norm; const float* w_in; const float* fbias; const float* sinks; const float* w_bs; const float* w_bf;
              const float* w_out; const float* mlp_norm; const float* w_up; const float* w_dn; const float* final_norm; float* out; unsigned char* ws; long long fused_final; };

__device__ __forceinline__ void rms_row_to_bf16(const float* xrow, const float* gain, bf16* orow, int lane) {
    const f32x4* xr = (const f32x4*)xrow + lane; f32x4 v[8]; float s = 0.f;
#pragma unroll
    for (int j = 0; j < 8; ++j) { v[j] = xr[64 * j]; s += (v[j].x * v[j].x + v[j].y * v[j].y) + (v[j].z * v[j].z + v[j].w * v[j].w); }
    const float rstd = __builtin_amdgcn_rsqf(wave_sum(s) * (1.f / DM) + RMS_EPS);
    const f32x4* gr = (const f32x4*)gain + lane; v2u* o8 = (v2u*)orow + lane;
#pragma unroll
    for (int j = 0; j < 8; ++j) { const f32x4 g = gr[64 * j]; v2u w; w.x = pg8::cvt_pk_bf16(v[j].x * rstd * g.x, v[j].y * rstd * g.y); w.y = pg8::cvt_pk_bf16(v[j].z * rstd * g.z, v[j].w * rstd * g.w); o8[64 * j] = w; }
}

__device__ __forceinline__ void rms_row2_to_bf16(const float* x0, const float* x1, const float* gain, bf16* o0, bf16* o1, unsigned char* q0, unsigned char* q1, int lane) {
    const f32x4* xr0 = (const f32x4*)x0 + lane; const f32x4* xr1 = (const f32x4*)x1 + lane; f32x4 v[8], w[8]; float s = 0.f, t = 0.f;
#pragma unroll
    for (int j = 0; j < 8; ++j) { v[j] = __builtin_nontemporal_load(xr0 + 64 * j); w[j] = __builtin_nontemporal_load(xr1 + 64 * j); }
#pragma unroll
    for (int j = 0; j < 8; ++j) { s += (v[j].x * v[j].x + v[j].y * v[j].y) + (v[j].z * v[j].z + v[j].w * v[j].w); t += (w[j].x * w[j].x + w[j].y * w[j].y) + (w[j].z * w[j].z + w[j].w * w[j].w); }
    const float rs = __builtin_amdgcn_rsqf(wave_sum(s) * (1.f / DM) + RMS_EPS), rt = __builtin_amdgcn_rsqf(wave_sum(t) * (1.f / DM) + RMS_EPS);
    const f32x4* gr = (const f32x4*)gain + lane; v2u* p0 = (v2u*)o0 + lane; v2u* p1 = (v2u*)o1 + lane;
#pragma unroll
    for (int j = 0; j < 8; ++j) { const f32x4 g = gr[64 * j]; v2u a, c;
        a.x = pg8::cvt_pk_bf16(v[j].x * rs * g.x, v[j].y * rs * g.y); a.y = pg8::cvt_pk_bf16(v[j].z * rs * g.z, v[j].w * rs * g.w);
        c.x = pg8::cvt_pk_bf16(w[j].x * rt * g.x, w[j].y * rt * g.y); c.y = pg8::cvt_pk_bf16(w[j].z * rt * g.z, w[j].w * rt * g.w);
        p0[64 * j] = a; p1[64 * j] = c;
        int e0 = 0, e1 = 0;
        e0 = __builtin_amdgcn_cvt_pk_fp8_f32(8.f * v[j].x * rs * g.x, 8.f * v[j].y * rs * g.y, e0, false); e0 = __builtin_amdgcn_cvt_pk_fp8_f32(8.f * v[j].z * rs * g.z, 8.f * v[j].w * rs * g.w, e0, true);
        e1 = __builtin_amdgcn_cvt_pk_fp8_f32(8.f * w[j].x * rt * g.x, 8.f * w[j].y * rt * g.y, e1, false); e1 = __builtin_amdgcn_cvt_pk_fp8_f32(8.f * w[j].z * rt * g.z, 8.f * w[j].w * rt * g.w, e1, true);
        ((unsigned*)q0)[lane + 64 * j] = (unsigned)e0; ((unsigned*)q1)[lane + 64 * j] = (unsigned)e1; }
}
__device__ __forceinline__ void p0_prologue(const Args& a, LAS unsigned char* lds, int vcu, int G, int wave, int lane) {
    unsigned char* ws = a.ws;
    LAS float* scr = (LAS float*)(lds + wave * 16384);
    const int gw = vcu * NWAVES + wave, NGW = G * NWAVES;
    constexpr int I_IN = (NIN / 32) * (DM / 64), I_BS = (DM / 32) * (1024 / 64), I_OUT = (DM / 32) * (DM / 64), I_UP = (DFF / 32) * (DM / 64), I_DN = (DM / 32) * (DFF / 64);
    constexpr int I_G = (NGATE / 32) * (DM / 64);
    constexpr int NITEMS = I_IN + 2 * I_BS + I_OUT + I_UP + I_DN + I_G;
    for (int it = gw; it < NITEMS; it += NGW) {
        int r = it;
        if (r < I_IN) { const int db = r / (DM / 64), kb = r % (DM / 64); int src, nv; win_map(db, src, nv); const float csc = (db >= 8 && db < 40) ? C2 : 1.0f;
            tr_item(a.w_in, DM, DIN, (bf16*)(ws + WS_WIN), db * 32, src, nv, kb, nullptr, csc, scr, lane); continue; } r -= I_IN;
        if (r < I_BS) { const int db = r / 16, kb = r % 16; tr_item(a.w_bs, 1024, DM, (bf16*)(ws + WS_WBS), db * 32, db * 32, 32, kb, nullptr, 1.0f, scr, lane); continue; } r -= I_BS;
        if (r < I_BS) { const int db = r / 16, kb = r % 16; tr_item(a.w_bf, 1024, DM, (bf16*)(ws + WS_WBF), db * 32, db * 32, 32, kb, nullptr, 1.0f, scr, lane); continue; } r -= I_BS;
        if (r < I_OUT) { const int db = r / 32, kb = r % 32; tr_item8(a.w_out, DM, DM, ws + WS_WOUT, db * 32, db * 32, kb, 64.0f, scr, lane); continue; } r -= I_OUT;
        if (r < I_UP) { const int db = r / 32, kb = r % 32; tr_item(a.w_up, DM, DFF, (bf16*)(ws + WS_WUP), db * 32, db * 32, 32, kb, a.mlp_norm, 1.0f, scr, lane); continue; } r -= I_UP;
        if (r < I_DN) { const int db = r / 128, kb = r % 128; tr_item(a.w_dn, DFF, DM, (bf16*)(ws + WS_WDN), db * 32, db * 32, 32, kb, nullptr, 1.0f, scr, lane); continue; } r -= I_DN;
        { const int db = r / 32, kb = r % 32; int src; float sc; wg8_map(db, src, sc); tr_item8(a.w_in, DM, DIN, ws + WS_WG8, db * 32, src, kb, sc, scr, lane); }
    }
    for (int m = gw; m < M; m += 2 * NGW) rms_row2_to_bf16(a.x + (size_t)m * DM, a.x + (size_t)(m + NGW) * DM, a.attn_norm, (bf16*)(ws + WS_XN) + (size_t)m * DM, (bf16*)(ws + WS_XN) + (size_t)(m + NGW) * DM, ws + WS_XN8 + (size_t)m * DM, ws + WS_XN8 + (size_t)(m + NGW) * DM, lane);
    float* cs = (float*)(ws + WS_CS);
    for (int e = gw * 64 + lane; e < M * 32; e += NGW * 64) {
        const int tok = e >> 5, i = e & 31;
        const float inv_freq = powf(10000.0f, -(float)(2 * i) / 64.0f);
        const float ang = (float)a.pos[tok] * inv_freq;
        double rev = (double)ang * 0.15915494309189535; rev -= floor(rev);
        const float rf = (float)rev;
        cs[e] = __builtin_amdgcn_cosf(rf); cs[(size_t)M * 32 + e] = __builtin_amdgcn_sinf(rf);
    }
}

__device__ __forceinline__ void cumsum_unit(const Args& a, int bh, LAS unsigned char* lds) {
    const float* FL = (const float*)(a.ws + WS_FL); float* Cp = (float*)(a.ws + WS_C);
    LAS double* sh = (LAS double*)lds;
    const int b = bh >> 4, h = bh & 15, tid = threadIdx.x, s0 = tid * 16; const float fb = a.fbias[h];
    float ls[16]; double run = 0.0;
#pragma unroll
    for (int i = 0; i < 16; ++i) { const float z = FL[(size_t)(b * SEQ + s0 + i) * 16 + h] + fb; const float v = fminf(z, 0.f) - log1pf(expf(-fabsf(z))); ls[i] = v; run += (double)v; }
    sh[tid] = run; __syncthreads();
    double pre = 0.0; for (int k = 0; k < tid; ++k) pre += sh[k];
#pragma unroll
    for (int i = 0; i < 16; ++i) { pre += (double)ls[i]; Cp[(size_t)bh * SEQ + s0 + i] = (float)(pre * 1.4426950408889634); }
    __syncthreads();
}

__device__ __forceinline__ void naive_swa_unit(const Args& a, int unit) {
    const bf16* AQ = (const bf16*)(a.ws + WS_AQ); const bf16* AK = (const bf16*)(a.ws + WS_AK); const bf16* AV = (const bf16*)(a.ws + WS_AV); bf16* OA = (bf16*)(a.ws + WS_OA);
    const int tid = threadIdx.x, head = tid & 15, tok = unit * 32 + (tid >> 4), b = tok / SEQ, s = tok % SEQ, kvh = head >> 3;
    float q[64], o[64]; float m = -INFINITY, l = 0.f;
    { const v4u* qp = (const v4u*)(AQ + (size_t)tok * 1024 + head * 64);
#pragma unroll
      for (int c = 0; c < 8; ++c) { const v4u w = qp[c];
#pragma unroll
          for (int e = 0; e < 4; ++e) { q[8 * c + 2 * e] = pg8::bf_lo(w[e]); q[8 * c + 2 * e + 1] = pg8::bf_hi(w[e]); } } }
#pragma unroll
    for (int d = 0; d < 64; ++d) o[d] = 0.f;
    for (int i = 0; i < 128; ++i) {
        const int j = s - i; const bool valid = j >= 0; const int jj = valid ? j : 0;
        const v4u* kp = (const v4u*)(AK + (size_t)(b * SEQ + jj) * 128 + kvh * 64); const v4u* vp = (const v4u*)(AV + (size_t)(b * SEQ + jj) * 128 + kvh * 64);
        float dot = 0.f;
#pragma unroll
        for (int c = 0; c < 8; ++c) { const v4u w = kp[c];
#pragma unroll
            for (int e = 0; e < 4; ++e) { dot += q[8 * c + 2 * e] * pg8::bf_lo(w[e]); dot += q[8 * c + 2 * e + 1] * pg8::bf_hi(w[e]); } }
        const float lg = valid ? dot : -INFINITY;
        const float mn = fmaxf(m, lg), al = __builtin_amdgcn_exp2f(m - mn), p = __builtin_amdgcn_exp2f(lg - mn);
        l = l * al + p; m = mn;
#pragma unroll
        for (int c = 0; c < 8; ++c) { const v4u w = vp[c];
#pragma unroll
            for (int e = 0; e < 4; ++e) { o[8 * c + 2 * e] = o[8 * c + 2 * e] * al + p * pg8::bf_lo(w[e]); o[8 * c + 2 * e + 1] = o[8 * c + 2 * e + 1] * al + p * pg8::bf_hi(w[e]); } }
    }
    { const float sk = a.sinks[head] * LOG2E; const float m2 = fmaxf(m, sk), al = __builtin_amdgcn_exp2f(m - m2); l = l * al + __builtin_amdgcn_exp2f(sk - m2);
      const float rl = al / l;
      v4u* op = (v4u*)(OA + (size_t)tok * 1024 + head * 64);
#pragma unroll
      for (int c = 0; c < 8; ++c) { v4u w;
#pragma unroll
          for (int e = 0; e < 4; ++e) w[e] = pg8::cvt_pk_bf16(o[8 * c + 2 * e] * rl, o[8 * c + 2 * e + 1] * rl);
          op[c] = w; } }
}
__device__ __forceinline__ void naive_fox_unit(const Args& a, int bh, int qblk) {
    const bf16* FQ = (const bf16*)(a.ws + WS_FQ); const bf16* FK = (const bf16*)(a.ws + WS_FK); const bf16* FV = (const bf16*)(a.ws + WS_FV); bf16* OB = (bf16*)(a.ws + WS_OB);
    const float* Cp = (const float*)(a.ws + WS_C) + (size_t)bh * SEQ;
    const int tid = threadIdx.x, b = bh >> 4, h = bh & 15, s = qblk * 512 + tid; const size_t tok = (size_t)b * SEQ + s;
    float q[64], o[64]; float m = -INFINITY, l = 0.f;
    { const v4u* qp = (const v4u*)(FQ + tok * 1024 + h * 64);
#pragma unroll
      for (int c = 0; c < 8; ++c) { const v4u w = qp[c];
#pragma unroll
          for (int e = 0; e < 4; ++e) { q[8 * c + 2 * e] = pg8::bf_lo(w[e]); q[8 * c + 2 * e + 1] = pg8::bf_hi(w[e]); } } }
#pragma unroll
    for (int d = 0; d < 64; ++d) o[d] = 0.f;
    const float cq = Cp[s];
    const int jend = __builtin_amdgcn_readfirstlane(qblk * 512 + (tid | 63));
    for (int j = 0; j <= jend; ++j) {
        const v4u* kp = (const v4u*)(FK + ((size_t)b * SEQ + j) * 1024 + h * 64); const v4u* vp = (const v4u*)(FV + ((size_t)b * SEQ + j) * 1024 + h * 64);
        float dot = 0.f;
#pragma unroll
        for (int c = 0; c < 8; ++c) { const v4u w = kp[c];
#pragma unroll
            for (int e = 0; e < 4; ++e) { dot += q[8 * c + 2 * e] * pg8::bf_lo(w[e]); dot += q[8 * c + 2 * e + 1] * pg8::bf_hi(w[e]); } }
        float lg = dot + (cq - Cp[j]); lg = (j <= s) ? lg : -INFINITY;
        const float mn = fmaxf(m, lg), al = __builtin_amdgcn_exp2f(m - mn), p = __builtin_amdgcn_exp2f(lg - mn);
        l = l * al + p; m = mn;
#pragma unroll
        for (int c = 0; c < 8; ++c) { const v4u w = vp[c];
#pragma unroll
            for (int e = 0; e < 4; ++e) { o[8 * c + 2 * e] = o[8 * c + 2 * e] * al + p * pg8::bf_lo(w[e]); o[8 * c + 2 * e + 1] = o[8 * c + 2 * e + 1] * al + p * pg8::bf_hi(w[e]); } }
    }
    { const float rl = 1.0f / l; v4u* op = (v4u*)(OB + tok * 1024 + h * 64);
#pragma unroll
      for (int c = 0; c < 8; ++c) { v4u w;
#pragma unroll
          for (int e = 0; e < 4; ++e) w[e] = pg8::cvt_pk_bf16(o[8 * c + 2 * e] * rl, o[8 * c + 2 * e + 1] * rl);
          op[c] = w; } }
}

__global__ void __launch_bounds__(NWAVES * 64, 2) mega_fwd(Args a) {
    extern __shared__ __attribute__((aligned(16))) unsigned char lds_raw[];
    LAS unsigned char* lds = (LAS unsigned char*)lds_raw;
    cg::grid_group grid = cg::this_grid();
    int tid_ = threadIdx.x; asm volatile("" : "+v"(tid_));
    const int tid = tid_, lane = tid & 63, wave = __builtin_amdgcn_readfirstlane(tid >> 6);
    const int G = gridDim.x, bx = blockIdx.x, vcu = (G % 8 == 0) ? (bx % 8) * (G / 8) + bx / 8 : bx;
    unsigned char* ws = a.ws;
    float* SS1 = (float*)(ws + WS_CTL); float* SS2 = SS1 + M;
#define GRID_SYNC_CG() do { asm volatile("s_waitcnt vmcnt(0) lgkmcnt(0)" ::: "memory"); grid.sync(); } while (0)
#define GRID_SYNC() xcd_barrier(xbar)
    if (tid < 2) ((LAS unsigned*)(lds + RING_BYTES))[tid] = 0u;
    __syncthreads();
    const XcdBarrier xbar = xcd_barrier_post((unsigned*)(ws + WS_CTL + 786432), (volatile LAS unsigned*)(lds + RING_BYTES));

    for (int rp_ = 0; rp_ < (REP_PHASE == 100 ? 2 : 1); ++rp_) { p0_prologue(a, lds, vcu, G, wave, lane); __syncthreads(); }
    if (a.ws == nullptr) GRID_SYNC_CG();
    GRID_SYNC();

    {
        pg8::Gemm g{(const bf16*)(ws + WS_XN), (const bf16*)(ws + WS_WIN), nullptr, nullptr, DM};
        pg8::StaticOrder S; S.init(M, NIN, G, bx);
        pg8::EpiIn E{ws};
        for (int rp_ = 0; rp_ < (REP_PHASE == 1 ? 2 : 1); ++rp_) pg8::gemm_phase<pg8::EpiIn, pg8::StaticOrder, true, true>(lds, g, S, E);
        pg8::Gemm g8{(const bf16*)(ws + WS_XN8), (const bf16*)(ws + WS_WG8), nullptr, nullptr, DM / 2};
        pg8::StaticOrder S8; S8.init(M, NGATE, G, bx);
        pg8::EpiGate E8{ws + WS_G, ws};
        for (int rp_ = 0; rp_ < (REP_PHASE == 12 ? 2 : 1); ++rp_) pg8::gemm_phase<pg8::EpiGate, pg8::StaticOrder, true, true, true>(lds, g8, S8, E8);
    }
    GRID_SYNC();

    for (int u = bx; u < 64; u += G) cumsum_unit(a, u, lds);
#if NAIVE_SWA
    for (int u = bx; u < M / 32; u += G) naive_swa_unit(a, u);
#else
    for (int rp_ = 0; rp_ < (REP_PHASE == 2 ? 2 : 1); ++rp_)
    for (int u = vcu; u < 2048; u += G) { const int bh = u >> 5, qb = u & 31, b_ = bh >> 4, h_ = bh & 15;
        attn_body::attn_unit<8, false, 128>(b_, h_, qb, (const bf16*)(ws + WS_AQ), (const bf16*)(ws + WS_AK), (const bf16*)(ws + WS_AV), (bf16*)(ws + WS_OA), nullptr, a.sinks[h_] * LOG2E, (char*)lds_raw); }
#endif
    GRID_SYNC();

#if NAIVE_FOX
    for (int u = bx; u < 1024; u += G) { const int r = u >> 6, i = r >> 2, hi4 = r & 3, qblk = (i & 1) ? 4 * i + 3 - hi4 : 4 * i + hi4; naive_fox_unit(a, u & 63, qblk); }
#else
    for (int rp_ = 0; rp_ < (REP_PHASE == 3 ? 2 : 1); ++rp_)
    for (int e = vcu; e < 2048; e += G) { const int cuv = e & 255, i = e >> 8, bh = (cuv >> 4) + 16 * (i >> 1), s_ = cuv & 15, qb = (i & 1) ? 31 - s_ : s_;
        attn_body::attn_unit<8, true, 1024>(bh >> 4, bh & 15, qb, (const bf16*)(ws + WS_FQ), (const bf16*)(ws + WS_FK), (const bf16*)(ws + WS_FV), (bf16*)(ws + WS_OB), (const float*)(ws + WS_C) + (size_t)bh * SEQ, 0.f, (char*)lds_raw); }
#endif
    GRID_SYNC();

    {
        pg8::Gemm g{(const bf16*)(ws + WS_OA), (const bf16*)(ws + WS_WBS), (const bf16*)(ws + WS_OB), (const bf16*)(ws + WS_WBF), 1024};
        pg8::PairOrder S; S.s.init(M, DM, G, bx);
        pg8::EpiBranch E{(const unsigned char*)(ws + WS_G), ws + WS_MG};
        for (int rp_ = 0; rp_ < (REP_PHASE == 4 ? 2 : 1); ++rp_) pg8::gemm_phase<pg8::EpiBranch, pg8::PairOrder, true, true>(lds, g, S, E);
    }
    GRID_SYNC();

    {
        pg8::Gemm g{(const bf16*)(ws + WS_MG), (const bf16*)(ws + WS_WOUT), nullptr, nullptr, DM / 2};
        pg8::StaticOrder S; S.init(M, DM, G, bx);
        pg8::EpiResB<false> E{a.x, (bf16*)(ws + WS_X1B), SS1};
        pg8::gemm_phase<pg8::EpiResB<false>, pg8::StaticOrder, true, true, true>(lds, g, S, E);
    }
    GRID_SYNC();

    {
        pg8::Gemm g{(const bf16*)(ws + WS_X1B), (const bf16*)(ws + WS_WUP), nullptr, nullptr, DM};
        pg8::StaticOrder S; S.init(M, DFF, G, bx);
        pg8::EpiUp E{SS1, (bf16*)(ws + WS_U)};
        for (int rp_ = 0; rp_ < (REP_PHASE == 6 ? 2 : 1); ++rp_) pg8::gemm_phase<pg8::EpiUp, pg8::StaticOrder, true, true>(lds, g, S, E);
    }
    GRID_SYNC();

    {
        pg8::Gemm g{(const bf16*)(ws + WS_U), (const bf16*)(ws + WS_WDN), nullptr, nullptr, DFF};
        pg8::StaticOrder S; S.init(M, DM, G, bx);
        pg8::EpiResB<true> E{(const void*)(ws + WS_X1B), (bf16*)(ws + WS_X2B), SS2};
        pg8::gemm_phase<pg8::EpiResB<true>, pg8::StaticOrder, true, true>(lds, g, S, E);
    }
    GRID_SYNC();

    {
        const int gw = vcu * NWAVES + wave, NGW = G * NWAVES;
        for (int m = gw; m < M; m += NGW) {
            const float rstd = __builtin_amdgcn_rsqf(SS2[m] * (1.f / DM) + RMS_EPS);
            f32x4* xr = (f32x4*)(a.out + (size_t)m * DM) + lane; const f32x4* gr = (const f32x4*)a.final_norm + lane; const v2u* br = (const v2u*)((const bf16*)(ws + WS_X2B) + (size_t)m * DM) + lane;
            v2u w[8];
#pragma unroll
            for (int j = 0; j < 8; ++j) w[j] = __builtin_nontemporal_load(br + 64 * j);
#pragma unroll
            for (int j = 0; j < 8; ++j) { const f32x4 g = gr[64 * j]; const f32x4 v = (f32x4){pg8::bf_lo(w[j].x), pg8::bf_hi(w[j].x), pg8::bf_lo(w[j].y), pg8::bf_hi(w[j].y)}; __builtin_nontemporal_store(v * rstd * g, xr + 64 * j); }
        }
    }
}

extern "C" void kernel_launch(void* const* d_in, const int* in_sizes, int n_in, void* d_out, int out_size, void* d_ws, size_t ws_size, hipStream_t stream) {
    static int grid = 0; static int fused_final = 0;
    if (grid == 0) {
        if (n_in != 13 || in_sizes[0] != M * DM || out_size != M * DM || ws_size < WS_END3) { fprintf(stderr, "kernel_launch: unexpected shapes (n_in %d, in0 %d, out %d, ws %zu)\n", n_in, n_in > 0 ? in_sizes[0] : -1, out_size, ws_size); grid = -1; return; }
        int dev = 0, cus = 0, per_cu = 0;
        if (hipGetDevice(&dev) != hipSuccess || hipDeviceGetAttribute(&cus, hipDeviceAttributeMultiprocessorCount, dev) != hipSuccess) { grid = -1; return; }
        if (hipFuncSetAttribute((const void*)mega_fwd, hipFuncAttributeMaxDynamicSharedMemorySize, LDS_BYTES) != hipSuccess) { fprintf(stderr, "kernel_launch: hipFuncSetAttribute failed\n"); grid = -1; return; }
        if (hipOccupancyMaxActiveBlocksPerMultiprocessor(&per_cu, (const void*)mega_fwd, NWAVES * 64, LDS_BYTES) != hipSuccess || per_cu < 1) { fprintf(stderr, "kernel_launch: occupancy query says %d\n", per_cu); per_cu = 1; }
        (void)hipGetLastError();
        grid = cus * 1;
        { pg8::StaticOrder S; S.init(M, DM, grid, 0); bool ok = (M / 256) * (DM / 256) == 4 * grid;
          for (int c = 0; c < grid && ok; ++c) { S.c = c; for (int i = 0; i < 4 && ok; i += 2) { pg8::Unit u0, u1; ok = S.next(i, u0) && S.next(i + 1, u1) && u0.pm == u1.pm && u1.pn == u0.pn + 4 && u0.pn < 4 && u0.f == 0 && u1.f == 1; } }
          fused_final = (ok && FUSED_FINAL) ? 1 : 0; if (!ok) fprintf(stderr, "kernel_launch: note: unit order does not pair tiles; using the separate final-norm pass\n"); }
    }
    if (grid < 0) return;
    (void)hipMemsetAsync((char*)d_ws + WS_CTL, 0, CTL_ZERO_BYTES, stream);
    Args a{};
    a.x = (const float*)d_in[0]; a.pos = (const int*)d_in[1]; a.attn_norm = (const float*)d_in[2]; a.w_in = (const float*)d_in[3]; a.fbias = (const float*)d_in[4]; a.sinks = (const float*)d_in[5];
    a.w_bs = (const float*)d_in[6]; a.w_bf = (const float*)d_in[7]; a.w_out = (const float*)d_in[8]; a.mlp_norm = (const float*)d_in[9]; a.w_up = (const float*)d_in[10]; a.w_dn = (const float*)d_in[11];
    a.final_norm = (const float*)d_in[12]; a.out = (float*)d_out; a.ws = (unsigned char*)d_ws; a.fused_final = fused_final;
    void* kargs[] = {&a};
    const hipError_t le = hipLaunchCooperativeKernel((const void*)mega_fwd, dim3(grid), dim3(NWAVES * 64), kargs, LDS_BYTES, stream);
    if (le != hipSuccess) fprintf(stderr, "kernel_launch: cooperative launch failed: %s (grid %d)\n", hipGetErrorString(le), grid);
}
```
